# Optimizing an MI355X kernel written in HIP

```python
import math
import jax, jax.numpy as jnp
from jax import lax
import numpy as np

D_MODEL = 1024
BATCH = 8
SEQ = 2048
DEPTH = 4

N_MIXERS = 3
N_A = (DEPTH + 2) // 3
N_B = (DEPTH + 1) // 3
N_C = DEPTH // 3
DEEPNORM_ALPHA = (2.0 * DEPTH) ** 0.25
DEEPNORM_BETA = (8.0 * DEPTH) ** -0.25
LN_EPS = 1e-5

LRU_WIDTH = D_MODEL
LRU_HEADS = 8
LRU_BLOCK = LRU_WIDTH // LRU_HEADS
CONV_WIDTH = 4
LRU_C = 8.0

RET_HEADS = 4
RET_QK = D_MODEL // RET_HEADS
RET_V = 2 * RET_QK
RET_QK_WIDTH = RET_HEADS * RET_QK
RET_V_WIDTH = RET_HEADS * RET_V
RET_CHUNK = 128
RET_EPS = 1e-6

ATTN_PATTERNS = ((128, 1), (512, 4), (2048, 16))
ATTN_GROUPS = len(ATTN_PATTERNS)
ATTN_HEADS = 16
ATTN_HEAD_DIM = D_MODEL // ATTN_HEADS
ATTN_WIDTH = ATTN_HEADS * ATTN_HEAD_DIM

N_EXPERTS = 32
TOP_K = 4
D_FF = D_MODEL
SWIGLU_LIMIT = 7.0
SWIGLU_ALPHA = 1.702
MOE_BLOCK = 256

kernel_name = "hybrid_rglru_retention_dilated_moe_deepnorm"


def layer_norm(x, gain, bias):
    xf = x.astype(jnp.float32)
    mu = jnp.mean(xf, axis=-1, keepdims=True)
    var = jnp.mean(jnp.square(xf - mu), axis=-1, keepdims=True)
    return ((xf - mu) * lax.rsqrt(var + LN_EPS) * gain + bias).astype(x.dtype)


def _linear_combine(left, right):
    a_l, b_l = left
    a_r, b_r = right
    return a_l * a_r, a_r * b_l + b_r


def rglru_mixer(x, w_in, conv_w, conv_b, w_rgate, b_rgate, w_igate, b_igate, lam, w_out):
    bsz, seq, _ = x.shape
    u = x @ w_in
    gate_branch, rec = u[..., :LRU_WIDTH], u[..., LRU_WIDTH:]
    rec = lax.conv_general_dilated(
        rec, conv_w[:, None, :], window_strides=(1,), padding=((CONV_WIDTH - 1, 0),),
        dimension_numbers=('NWC', 'WIO', 'NWC'), feature_group_count=LRU_WIDTH) + conv_b
    xb = rec.reshape(bsz, seq, LRU_HEADS, LRU_BLOCK)
    r = jax.nn.sigmoid(jnp.einsum('bshi,hij->bshj', xb, w_rgate).reshape(bsz, seq, LRU_WIDTH) + b_rgate)
    i = jax.nn.sigmoid(jnp.einsum('bshi,hij->bshj', xb, w_igate).reshape(bsz, seq, LRU_WIDTH) + b_igate)
    log_a = -LRU_C * r.astype(jnp.float32) * jax.nn.softplus(-lam.astype(jnp.float32))
    a = jnp.exp(log_a)
    b = jnp.sqrt(-jnp.expm1(2.0 * log_a)) * (i * rec).astype(jnp.float32)
    _, h = lax.associative_scan(_linear_combine, (a, b), axis=1)
    y = jax.nn.gelu(gate_branch) * h.astype(x.dtype)
    return y @ w_out


def retention_mixer(x, w_in, w_out):
    bsz, seq, _ = x.shape
    f32 = jnp.float32
    u = x @ w_in
    q, k, v, g = jnp.split(u, [RET_QK_WIDTH, 2 * RET_QK_WIDTH, 2 * RET_QK_WIDTH + RET_V_WIDTH], axis=-1)
    nc = seq // RET_CHUNK

    def chunks(t, d):
        return t.reshape(bsz, nc, RET_CHUNK, RET_HEADS, d).transpose(1, 0, 3, 2, 4).astype(f32)

    qc = chunks(q, RET_QK)
    kc = chunks(k, RET_QK) * RET_QK ** -0.5
    vc = chunks(v, RET_V)
    log_gamma = jnp.log1p(-jnp.exp2(-5.0 - jnp.arange(RET_HEADS, dtype=f32)))
    pos = jnp.arange(RET_CHUNK, dtype=f32)
    rel = pos[:, None] - pos[None, :]
    intra_decay = jnp.where(rel >= 0, jnp.exp(log_gamma[:, None, None] * jnp.maximum(rel, 0.0)), 0.0)
    query_decay = jnp.exp(log_gamma[:, None] * (pos + 1.0))
    key_decay = jnp.exp(log_gamma[:, None] * (RET_CHUNK - 1.0 - pos))
    chunk_decay = jnp.exp(log_gamma * RET_CHUNK)

    def step(state, inp):
        qi, ki, vi = inp
        intra = jnp.einsum('bhnd,bhmd->bhnm', qi, ki) * intra_decay
        out = (jnp.einsum('bhnm,bhmv->bhnv', intra, vi)
               + jnp.einsum('bhnd,bhdv->bhnv', qi, state) * query_decay[..., None])
        state = (chunk_decay[:, None, None] * state
                 + jnp.einsum('bhmd,bhmv->bhdv', ki * key_decay[..., None], vi))
        return state, out

    state0 = jnp.zeros((bsz, RET_HEADS, RET_QK, RET_V), f32)
    _, o = lax.scan(step, state0, (qc, kc, vc))
    o = o.transpose(1, 0, 3, 2, 4).reshape(bsz, seq, RET_HEADS, RET_V)
    o = o * lax.rsqrt(jnp.mean(o * o, axis=-1, keepdims=True) + RET_EPS)
    y = (jax.nn.silu(g.astype(f32)) * o.reshape(bsz, seq, RET_V_WIDTH)).astype(x.dtype)
    return y @ w_out


def _dilated_group(q, k, v, slopes, window, dilation):
    bsz, seq, h, dh = q.shape
    f32 = jnp.float32
    nw = window // dilation
    sub = seq // dilation
    nb = -(-sub // nw)
    pad = nb * nw - sub

    def to_sub(t):
        t = t.reshape(bsz, sub, dilation, h, dh).transpose(0, 2, 1, 3, 4).reshape(bsz * dilation, sub, h, dh)
        t = jnp.pad(t, ((0, 0), (0, pad), (0, 0), (0, 0)))
        return t.reshape(bsz * dilation, nb, nw, h, dh)

    def with_prev(t):
        prev = jnp.concatenate([jnp.zeros_like(t[:, :1]), t[:, :-1]], axis=1)
        return jnp.concatenate([prev, t], axis=2)

    qb = to_sub(q)
    kk = with_prev(to_sub(k))
    vv = with_prev(to_sub(v))
    scores = jnp.einsum('bnqhd,bnkhd->bnhqk', qb, kk, preferred_element_type=f32) * (dh ** -0.5)
    qi = jnp.arange(nw)[:, None]
    ki = jnp.arange(2 * nw)[None, :]
    steps = qi + nw - ki
    key_pos = (jnp.arange(nb)[:, None, None] - 1) * nw + ki
    valid = (steps >= 0) & (steps <= nw) & (key_pos >= 0)
    alibi = -slopes[:, None, None] * (steps * dilation).astype(f32)
    scores = jnp.where(valid[None, :, None], scores + alibi[None, None], -jnp.inf)
    m = jnp.max(scores, axis=-1)
    p = jnp.exp(scores - m[..., None])
    s = jnp.sum(p, axis=-1)
    o = jnp.einsum('bnhqk,bnkhd->bnqhd', p, vv.astype(f32))

    def from_sub(t):
        rest = t.shape[3:]
        t = t.reshape(bsz, dilation, nb * nw, *rest)[:, :, :sub]
        return jnp.swapaxes(t, 1, 2).reshape(bsz, seq, *rest)

    return from_sub(jnp.swapaxes(m, 2, 3)), from_sub(jnp.swapaxes(s, 2, 3)), from_sub(o)


def dilated_attention_mixer(x, w_in, w_out):
    bsz, seq, _ = x.shape
    u = (x @ w_in).reshape(bsz, seq, 3, ATTN_GROUPS, ATTN_HEADS, ATTN_HEAD_DIM)
    slopes = jnp.exp2(-8.0 * jnp.arange(1, ATTN_HEADS + 1, dtype=jnp.float32) / ATTN_HEADS)
    maxes, dens, nums = [], [], []
    for g, (window, dilation) in enumerate(ATTN_PATTERNS):
        m, s, o = _dilated_group(u[:, :, 0, g], u[:, :, 1, g], u[:, :, 2, g], slopes, window, dilation)
        maxes.append(m)
        dens.append(s)
        nums.append(o)
    m_all = jnp.stack(maxes)
    wgt = jnp.exp(m_all - jnp.max(m_all, axis=0))
    den = jnp.sum(wgt * jnp.stack(dens), axis=0)
    num = jnp.sum(wgt[..., None] * jnp.stack(nums), axis=0)
    y = (num / den[..., None]).reshape(bsz, seq, ATTN_WIDTH).astype(x.dtype)
    return y @ w_out


def moe_ffn(x, w_router, b_router, w_gu, b_gu, w_down, b_down):
    bsz, seq, d = x.shape
    t = bsz * seq
    xt = x.reshape(t, d)
    logits = (xt @ w_router + b_router).astype(jnp.float32)
    top_logit, top_exp = lax.top_k(logits, TOP_K)
    gates = jax.nn.softmax(top_logit, axis=-1)
    n_assign = t * TOP_K
    flat_exp = top_exp.reshape(n_assign)
    order = jnp.argsort(flat_exp)
    sorted_exp = flat_exp[order]
    counts = jnp.bincount(flat_exp, length=N_EXPERTS)
    padded = ((counts + MOE_BLOCK - 1) // MOE_BLOCK) * MOE_BLOCK
    pad_end = jnp.cumsum(padded)
    pad_start = pad_end - padded
    start = jnp.cumsum(counts) - counts
    dest_sorted = pad_start[sorted_exp] + jnp.arange(n_assign) - start[sorted_exp]
    n_blocks = -(-n_assign // MOE_BLOCK) + N_EXPERTS
    n_rows = n_blocks * MOE_BLOCK
    row_token = jnp.full((n_rows,), t, jnp.int32).at[dest_sorted].set((order // TOP_K).astype(jnp.int32))
    x_rows = jnp.concatenate([xt, jnp.zeros((1, d), xt.dtype)], axis=0)[row_token]
    x_rows = x_rows.reshape(n_blocks, MOE_BLOCK, d)
    block_exp = jnp.minimum(jnp.searchsorted(pad_end, jnp.arange(n_blocks) * MOE_BLOCK, side='right'),
                            N_EXPERTS - 1)

    def expert_block(args):
        xb, e = args
        gu = xb @ w_gu[e] + b_gu[e]
        gate, up = gu[:, :D_FF], gu[:, D_FF:]
        gate = jnp.minimum(gate, SWIGLU_LIMIT)
        up = jnp.clip(up, -SWIGLU_LIMIT, SWIGLU_LIMIT)
        hidden = (up + 1.0) * gate * jax.nn.sigmoid(SWIGLU_ALPHA * gate)
        return hidden @ w_down[e] + b_down[e]

    y_rows = lax.map(expert_block, (x_rows, block_exp)).reshape(n_rows, d)
    dest = jnp.zeros((n_assign,), dest_sorted.dtype).at[order].set(dest_sorted)
    y_sel = y_rows[dest].reshape(t, TOP_K, d)
    out = jnp.einsum('tk,tkd->td', gates.astype(x.dtype), y_sel)
    return out.reshape(bsz, seq, d)


def setup_inputs(seed: int = 0) -> dict:
    key = jax.random.key(seed)
    ks = jax.random.split(key, 24)
    f32 = jnp.float32

    def nrm(k, shape, scale):
        return jax.random.normal(k, shape, f32) * scale

    a0 = jax.random.uniform(ks[9], (N_A, LRU_WIDTH), f32, minval=0.9, maxval=0.999)
    root = a0 ** (1.0 / LRU_C)
    return {
        'x': nrm(ks[0], (BATCH, SEQ, D_MODEL), 1.0),
        'a_w_in': nrm(ks[1], (N_A, D_MODEL, 2 * LRU_WIDTH), D_MODEL ** -0.5),
        'a_conv_w': nrm(ks[2], (N_A, CONV_WIDTH, LRU_WIDTH), CONV_WIDTH ** -0.5),
        'a_conv_b': nrm(ks[3], (N_A, LRU_WIDTH), 0.02),
        'a_w_rgate': nrm(ks[4], (N_A, LRU_HEADS, LRU_BLOCK, LRU_BLOCK), LRU_BLOCK ** -0.5),
        'a_b_rgate': nrm(ks[5], (N_A, LRU_WIDTH), 0.02),
        'a_w_igate': nrm(ks[6], (N_A, LRU_HEADS, LRU_BLOCK, LRU_BLOCK), LRU_BLOCK ** -0.5),
        'a_b_igate': nrm(ks[7], (N_A, LRU_WIDTH), 0.02),
        'a_lambda': jnp.log(root) - jnp.log1p(-root),
        'a_w_out': nrm(ks[8], (N_A, LRU_WIDTH, D_MODEL), DEEPNORM_BETA * LRU_WIDTH ** -0.5),
        'b_w_in': nrm(ks[10], (N_B, D_MODEL, 2 * RET_QK_WIDTH + 2 * RET_V_WIDTH), D_MODEL ** -0.5),
        'b_w_out': nrm(ks[11], (N_B, RET_V_WIDTH, D_MODEL), DEEPNORM_BETA * RET_V_WIDTH ** -0.5),
        'c_w_in': nrm(ks[12], (N_C, D_MODEL, 3 * ATTN_GROUPS * ATTN_WIDTH), D_MODEL ** -0.5),
        'c_w_out': nrm(ks[13], (N_C, ATTN_WIDTH, D_MODEL), DEEPNORM_BETA * ATTN_WIDTH ** -0.5),
        'ln_gain': 1.0 + nrm(ks[14], (DEPTH, 2, D_MODEL), 0.02),
        'ln_bias': nrm(ks[15], (DEPTH, 2, D_MODEL), 0.02),
        'moe_w_router': nrm(ks[16], (DEPTH, D_MODEL, N_EXPERTS), D_MODEL ** -0.5),
        'moe_b_router': nrm(ks[17], (DEPTH, N_EXPERTS), 0.01),
        'moe_w_gu': nrm(ks[18], (DEPTH, N_EXPERTS, D_MODEL, 2 * D_FF), D_MODEL ** -0.5),
        'moe_b_gu': nrm(ks[19], (DEPTH, N_EXPERTS, 2 * D_FF), 0.02),
        'moe_w_down': nrm(ks[20], (DEPTH, N_EXPERTS, D_FF, D_MODEL), DEEPNORM_BETA * D_FF ** -0.5),
        'moe_b_down': nrm(ks[21], (DEPTH, N_EXPERTS, D_MODEL), 0.02),
    }


def reference(x, a_w_in, a_conv_w, a_conv_b, a_w_rgate, a_b_rgate, a_w_igate, a_b_igate, a_lambda,
              a_w_out, b_w_in, b_w_out, c_w_in, c_w_out, ln_gain, ln_bias, moe_w_router,
              moe_b_router, moe_w_gu, moe_b_gu, moe_w_down, moe_b_down):
    for layer in range(DEPTH):
        kind, idx = layer % N_MIXERS, layer // N_MIXERS
        if kind == 0:
            y = rglru_mixer(x, a_w_in[idx], a_conv_w[idx], a_conv_b[idx], a_w_rgate[idx], a_b_rgate[idx],
                            a_w_igate[idx], a_b_igate[idx], a_lambda[idx], a_w_out[idx])
        elif kind == 1:
            y = retention_mixer(x, b_w_in[idx], b_w_out[idx])
        else:
            y = dilated_attention_mixer(x, c_w_in[idx], c_w_out[idx])
        x = layer_norm(DEEPNORM_ALPHA * x + y, ln_gain[layer, 0], ln_bias[layer, 0])
        f = moe_ffn(x, moe_w_router[layer], moe_b_router[layer], moe_w_gu[layer], moe_b_gu[layer],
                    moe_w_down[layer], moe_b_down[layer])
        x = layer_norm(DEEPNORM_ALPHA * x + f, ln_gain[layer, 1], ln_bias[layer, 1])
    return x
```

```cpp
#include <hip/hip_runtime.h>
#include <stdint.h>
#include <stdio.h>

#ifndef MK_ONE_LAUNCH
#define MK_ONE_LAUNCH 0
#endif

#define LAS __attribute__((address_space(3)))
typedef unsigned short bf16_t;
typedef short bf16x8 __attribute__((ext_vector_type(8)));
typedef float f32x4 __attribute__((ext_vector_type(4)));
typedef unsigned u32x4 __attribute__((ext_vector_type(4)));
typedef unsigned u32x2 __attribute__((ext_vector_type(2)));

constexpr int T = 16384, D = 1024, SEQ = 2048, NBATCH = 8, DEPTH = 4;
constexpr int NEXP = 32, TOPK = 4;
constexpr int MAXROWS = 73728;
constexpr float DN_ALPHA = 1.681792830507429f;
constexpr float LN_EPS = 1e-5f;
constexpr int NTHREADS = 512;

constexpr size_t MB = 1ull << 20;
constexpr size_t WS_CTL = 0;
constexpr size_t CTL_BYTES = 65536;
constexpr size_t WS_AWIN = 1 * MB;
constexpr size_t WS_AWOUT = WS_AWIN + 8 * MB;
constexpr size_t WS_BWIN = WS_AWOUT + 4 * MB;
constexpr size_t WS_BWOUT = WS_BWIN + 12 * MB;
constexpr size_t WS_CWIN = WS_BWOUT + 4 * MB;
constexpr size_t WS_CWOUT = WS_CWIN + 18 * MB;
constexpr size_t WS_GU = WS_CWOUT + 2 * MB;
constexpr size_t WS_DN = WS_GU + 512 * MB;
constexpr size_t WS_XF = WS_DN + 256 * MB;
constexpr size_t WS_XB = WS_XF + 64 * MB;
constexpr size_t WS_U = WS_XB + 32 * MB;
constexpr size_t WS_YIN = WS_U + 288 * MB;
constexpr size_t WS_YMIX = WS_YIN + 64 * MB;
constexpr size_t WS_SCR = WS_YMIX + 64 * MB;
constexpr size_t WS_TOPE = WS_SCR + 128 * MB;
constexpr size_t WS_GATES = WS_TOPE + 256 * 1024;
constexpr size_t WS_POS = WS_GATES + 256 * 1024;
constexpr size_t WS_DEST = WS_POS + 256 * 1024;
constexpr size_t WS_ROWTOK = WS_DEST + 256 * 1024;
constexpr size_t WS_HID = WS_ROWTOK + 1 * MB;
constexpr size_t WS_YROWS = WS_HID + 144 * MB;
constexpr size_t WS_END = WS_YROWS + 288 * MB;

constexpr int CW_CNT = 4096;
constexpr int CW_MDYN = 8192;
constexpr int CW_TEXP = 12288;

#define XB_TMO      128
#define XB_XCNT(j)  (256  + 64 * (j))
#define XB_XSUB(j)  (1280 + 64 * (j))
#define XB_XGEN(j)  (2304 + 64 * (j))
#define XB_TOP      3328
#define XB_TOPGEN   3392
#define XCD_BAR_WORDS 3456
#define XB_SPIN_CAP (1u << 22)

__device__ __forceinline__ unsigned xb_ld(unsigned* p)              { return __hip_atomic_load(p, __ATOMIC_RELAXED, __HIP_MEMORY_SCOPE_AGENT); }
__device__ __forceinline__ unsigned xb_add(unsigned* p, unsigned v) { return __hip_atomic_fetch_add(p, v, __ATOMIC_RELAXED, __HIP_MEMORY_SCOPE_AGENT); }
__device__ __forceinline__ unsigned xb_xcc_id() { return (unsigned)__builtin_amdgcn_s_getreg((3 << 11) | 20) & 0xFu; }
#define XB_SPIN(cond, bar) do { unsigned _sp = 0; while (cond) { __builtin_amdgcn_s_sleep(1); \
    if ((++_sp & 255u) == 0u) { if (xb_ld(&(bar)[XB_TMO])) break; if (_sp > XB_SPIN_CAP) { atomicAdd(&(bar)[XB_TMO], 1u); break; } } } } while (0)

struct XcdBarrier { unsigned* bar; unsigned x; volatile LAS unsigned* st; };

__device__ __forceinline__ XcdBarrier xcd_barrier_post(unsigned* bar, volatile LAS unsigned* st) {
    XcdBarrier b; b.bar = bar; b.x = xb_xcc_id(); b.st = st;
    if (threadIdx.x == 0) (void)xb_add(&bar[XB_XCNT(b.x)], 1u);
    return b;
}
__device__ __forceinline__ void xcd_barrier_complete(unsigned* bar, unsigned x, unsigned& nloc, unsigned& nx) {
    const unsigned G = gridDim.x * gridDim.y * gridDim.z;
    unsigned sum, cnt, mine, sp = 0u;
    for (;;) {
        sum = 0u; cnt = 0u; mine = 0u;
#pragma unroll
        for (unsigned j = 0; j < 16; ++j) { const unsigned c = xb_ld(&bar[XB_XCNT(j)]); sum += c; cnt += (c > 0u) ? 1u : 0u; mine = (j == x) ? c : mine; }
        if (sum == G) break;
        __builtin_amdgcn_s_sleep(1);
        if ((++sp & 255u) == 0u) { if (xb_ld(&bar[XB_TMO])) break; if (sp > XB_SPIN_CAP) { atomicAdd(&bar[XB_TMO], 1u); break; } }
    }
    nloc = mine > 0u ? mine : 1u; nx = cnt > 0u ? cnt : 1u;
}
__device__ __forceinline__ void xcd_barrier(const XcdBarrier& b) {
    asm volatile("s_waitcnt vmcnt(0)" ::: "memory");
    __syncthreads();
    if (threadIdx.x == 0) {
        unsigned* bar = b.bar;
        __builtin_amdgcn_s_waitcnt(0);
        unsigned nloc = b.st[0], nx = b.st[1];
        if (nloc == 0u) { xcd_barrier_complete(bar, b.x, nloc, nx); b.st[0] = nloc; b.st[1] = nx; }
        const unsigned old = xb_add(&bar[XB_XSUB(b.x)], 1u);
        const unsigned gen = old / nloc;
        if (old + 1u == (gen + 1u) * nloc) {
            __builtin_amdgcn_fence(__ATOMIC_RELEASE, "agent");
            asm volatile("s_waitcnt vmcnt(0)" ::: "memory");
            const unsigned og = xb_add(&bar[XB_TOP], 1u);
            const unsigned tg = og / nx;
            if (og + 1u == (tg + 1u) * nx) xb_add(&bar[XB_TOPGEN], 1u);
            else XB_SPIN(xb_ld(&bar[XB_TOPGEN]) == tg, bar);
            __builtin_amdgcn_fence(__ATOMIC_ACQUIRE, "agent");
            xb_add(&bar[XB_XGEN(b.x)], 1u);
            asm volatile("s_waitcnt vmcnt(0)" ::: "memory");
        } else {
            XB_SPIN(xb_ld(&bar[XB_XGEN(b.x)]) == gen, bar);
            __builtin_amdgcn_fence(__ATOMIC_ACQUIRE, "agent");
            asm volatile("s_waitcnt vmcnt(0)" ::: "memory");
        }
    }
    __syncthreads();
}

__device__ __forceinline__ float bf2f(bf16_t v) { return __uint_as_float(((unsigned)v) << 16); }
__device__ __forceinline__ bf16_t f2bf(float f) { unsigned u = __float_as_uint(f); u += 0x7FFFu + ((u >> 16) & 1u); return (bf16_t)(u >> 16); }
__device__ __forceinline__ unsigned pack2(float lo, float hi) { return (unsigned)f2bf(lo) | ((unsigned)f2bf(hi) << 16); }
__device__ __forceinline__ float wave_sum(float v) {
#pragma unroll
    for (int o = 32; o >= 1; o >>= 1) v += __shfl_xor(v, o);
    return v;
}
__device__ __forceinline__ float wave_max(float v) {
#pragma unroll
    for (int o = 32; o >= 1; o >>= 1) v = fmaxf(v, __shfl_xor(v, o));
    return v;
}
__device__ __forceinline__ float sigmoidf_(float x) { return 1.0f / (1.0f + __expf(-x)); }
__device__ __forceinline__ float gelu_tanh(float x) { const float u = 0.7978845608028654f * (x + 0.044715f * x * x * x); return 0.5f * x * (1.0f + tanhf(u)); }
__device__ __forceinline__ float swiglu(float gate, float up) {
    const float g = fminf(gate, 7.0f), u = fminf(fmaxf(up, -7.0f), 7.0f);
    return (u + 1.0f) * g * sigmoidf_(1.702f * g);
}

struct Params {
    const float* x; const float* a_w_in; const float* a_conv_w; const float* a_conv_b; const float* a_w_rgate; const float* a_b_rgate;
    const float* a_w_igate; const float* a_b_igate; const float* a_lambda; const float* a_w_out; const float* b_w_in; const float* b_w_out;
    const float* c_w_in; const float* c_w_out; const float* ln_gain; const float* ln_bias; const float* moe_w_router; const float* moe_b_router;
    const float* moe_w_gu; const float* moe_b_gu; const float* moe_w_down; const float* moe_b_down;
    float* out; unsigned char* ws;
    int ph_lo, ph_hi;
};

__device__ void convert_job(LAS float* tile, const float* src, bf16_t* dst, int K, int N, int batch) {
    const int tid = threadIdx.x;
    const int tk = K / 64, tn = N / 64, per = tk * tn; const long total = (long)per * batch;
    for (long u = blockIdx.x; u < total; u += gridDim.x) {
        const int bidx = (int)(u / per), r = (int)(u % per), kt = r / tn, nt = r % tn;
        const float* s = src + (size_t)bidx * K * N + (size_t)(kt * 64) * N + nt * 64;
#pragma unroll
        for (int pass = 0; pass < 2; ++pass) {
            const int row = (tid >> 4) + 32 * pass, c4 = tid & 15;
            const f32x4 v = *(const f32x4*)(s + (size_t)row * N + c4 * 4);
            tile[row * 65 + c4 * 4 + 0] = v[0]; tile[row * 65 + c4 * 4 + 1] = v[1]; tile[row * 65 + c4 * 4 + 2] = v[2]; tile[row * 65 + c4 * 4 + 3] = v[3];
        }
        __syncthreads();
        {
            const int n = tid >> 3, k8 = tid & 7;
            float v[8];
#pragma unroll
            for (int j = 0; j < 8; ++j) v[j] = tile[(k8 * 8 + j) * 65 + n];
            u32x4 w; w.x = pack2(v[0], v[1]); w.y = pack2(v[2], v[3]); w.z = pack2(v[4], v[5]); w.w = pack2(v[6], v[7]);
            *(u32x4*)(dst + (size_t)bidx * N * K + (size_t)(nt * 64 + n) * K + kt * 64 + k8 * 8) = w;
        }
        __syncthreads();
    }
}

struct GemmS {
    const bf16_t* A; int lda;
    const bf16_t* Bt; int ldb;
    int M, N, K;
    const unsigned* Mdyn;
    const int* row_idx;
    const unsigned* tile_exp;
    size_t b_exp_stride;
    const float* bias; int bias_es;
    float* Cf; bf16_t* Cb; int ldc;
};
template <int MODE>
__device__ void gemm_simple(LAS unsigned char* lds, const GemmS& g) {
    const int tid = threadIdx.x, lane = tid & 63, wid = tid >> 6, wr = wid >> 1, wc = wid & 1, fr = lane & 15, fq = lane >> 4;
    const int M = g.Mdyn ? (int)*g.Mdyn : g.M;
    const int tiles_n = (MODE == 1) ? (g.N / 256) * 2 : g.N / 128;
    const int tiles_m = M / 128, nunits = tiles_m * tiles_n, nk = g.K / 32;
    LAS bf16_t* As = (LAS bf16_t*)lds;
    LAS bf16_t* Bs = As + 2 * 128 * 40;
    const int lrow = tid >> 2, lch = tid & 3;
    for (int u = blockIdx.x; u < nunits; u += gridDim.x) {
        const int tm = u / tiles_n, tn = u % tiles_n, m0 = tm * 128;
        const int e = (MODE != 0) ? (int)g.tile_exp[m0 >> 8] : 0;
        const bf16_t* Bbase = g.Bt + (size_t)e * g.b_exp_stride;
        int arow = m0 + lrow; if (MODE == 1) arow = g.row_idx[arow];
        int brow;
        if (MODE == 1) { const int bwc = lrow >> 6, ni = (lrow & 63) >> 4, r = lrow & 15; brow = ((ni & 1) ? 1024 : 0) + tn * 64 + bwc * 32 + (ni >> 1) * 16 + r; }
        else brow = tn * 128 + lrow;
        const bf16_t* ap = g.A + (size_t)arow * g.lda + lch * 8;
        const bf16_t* bp = Bbase + (size_t)brow * g.ldb + lch * 8;
        f32x4 acc[2][4];
#pragma unroll
        for (int mi = 0; mi < 2; ++mi)
#pragma unroll
            for (int ni = 0; ni < 4; ++ni) acc[mi][ni] = (f32x4){0.f, 0.f, 0.f, 0.f};
        u32x4 ra = *(const u32x4*)ap, rb = *(const u32x4*)bp;
        *(LAS u32x4*)(As + lrow * 40 + lch * 8) = ra; *(LAS u32x4*)(Bs + lrow * 40 + lch * 8) = rb;
        __syncthreads();
        for (int kt = 0; kt < nk; ++kt) {
            const int cur = kt & 1;
            if (kt + 1 < nk) { ra = *(const u32x4*)(ap + (kt + 1) * 32); rb = *(const u32x4*)(bp + (kt + 1) * 32); }
            bf16x8 af[2], bfr[4];
#pragma unroll
            for (int mi = 0; mi < 2; ++mi) af[mi] = *(const LAS bf16x8*)(As + cur * 5120 + (wr * 32 + mi * 16 + fr) * 40 + fq * 8);
#pragma unroll
            for (int ni = 0; ni < 4; ++ni) bfr[ni] = *(const LAS bf16x8*)(Bs + cur * 5120 + (wc * 64 + ni * 16 + fr) * 40 + fq * 8);
#pragma unroll
            for (int mi = 0; mi < 2; ++mi)
#pragma unroll
                for (int ni = 0; ni < 4; ++ni) acc[mi][ni] = __builtin_amdgcn_mfma_f32_16x16x32_bf16(bfr[ni], af[mi], acc[mi][ni], 0, 0, 0);
            if (kt + 1 < nk) { *(LAS u32x4*)(As + (cur ^ 1) * 5120 + lrow * 40 + lch * 8) = ra; *(LAS u32x4*)(Bs + (cur ^ 1) * 5120 + lrow * 40 + lch * 8) = rb; }
            __syncthreads();
        }
#pragma unroll
        for (int mi = 0; mi < 2; ++mi) {
            const int m = m0 + wr * 32 + mi * 16 + fr;
            if (MODE == 1) {
#pragma unroll
                for (int q = 0; q < 2; ++q) {
                    const int hc = tn * 64 + wc * 32 + q * 16 + 4 * fq;
                    const f32x4 bg = *(const f32x4*)(g.bias + (size_t)e * g.bias_es + hc), bu = *(const f32x4*)(g.bias + (size_t)e * g.bias_es + 1024 + hc);
                    const f32x4 gt = acc[mi][2 * q] + bg, up = acc[mi][2 * q + 1] + bu;
                    u32x2 w; w.x = pack2(swiglu(gt[0], up[0]), swiglu(gt[1], up[1])); w.y = pack2(swiglu(gt[2], up[2]), swiglu(gt[3], up[3]));
                    *(u32x2*)(g.Cb + (size_t)m * g.ldc + hc) = w;
                }
            } else {
#pragma unroll
                for (int ni = 0; ni < 4; ++ni) {
                    const int n = tn * 128 + wc * 64 + ni * 16 + 4 * fq;
                    f32x4 v = acc[mi][ni];
                    if (g.bias) v += *(const f32x4*)(g.bias + (size_t)e * g.bias_es + n);
                    if (g.Cf) *(f32x4*)(g.Cf + (size_t)m * g.ldc + n) = v;
                    else { u32x2 w; w.x = pack2(v[0], v[1]); w.y = pack2(v[2], v[3]); *(u32x2*)(g.Cb + (size_t)m * g.ldc + n) = w; }
                }
            }
        }
    }
}

__device__ void lru_gates_phase(LAS unsigned char* lds, const Params& p, int idx) {
    const int tid = threadIdx.x;
    LAS float* xc = (LAS float*)lds;
    const bf16_t* u = (const bf16_t*)(p.ws + WS_U);
    float* Aarr = (float*)(p.ws + WS_SCR); float* Barr = Aarr + (size_t)T * D;
    const float* conv_w = p.a_conv_w + (size_t)idx * 4 * D; const float* conv_b = p.a_conv_b + (size_t)idx * D;
    const float* w_r = p.a_w_rgate + (size_t)idx * 8 * 128 * 128; const float* w_i = p.a_w_igate + (size_t)idx * 8 * 128 * 128;
    const float* b_r = p.a_b_rgate + (size_t)idx * D; const float* b_i = p.a_b_igate + (size_t)idx * D; const float* lam = p.a_lambda + (size_t)idx * D;
    const int nunits = (T / 32) * 8;
    for (int un = blockIdx.x; un < nunits; un += gridDim.x) {
        const int tt = un >> 3, hd = un & 7, t0 = tt * 32;
        for (int i2 = tid; i2 < 32 * 128; i2 += NTHREADS) {
            const int tl = i2 >> 7, i = i2 & 127, c = hd * 128 + i, t = t0 + tl, s = t & (SEQ - 1);
            float acc = conv_b[c];
#pragma unroll
            for (int j = 0; j < 4; ++j) { const int sj = s - 3 + j; if (sj >= 0) acc += conv_w[j * D + c] * bf2f(u[(size_t)(t - 3 + j) * 2048 + 1024 + c]); }
            xc[tl * 128 + i] = acc;
        }
        __syncthreads();
        {
            const int j = tid & 127, tq = tid >> 7;
            float ar[8], ai[8];
#pragma unroll
            for (int q = 0; q < 8; ++q) { ar[q] = 0.f; ai[q] = 0.f; }
            for (int i = 0; i < 128; ++i) {
                const float wr_ = w_r[(size_t)(hd * 128 + i) * 128 + j], wi_ = w_i[(size_t)(hd * 128 + i) * 128 + j];
#pragma unroll
                for (int q = 0; q < 8; ++q) { const float xv = xc[(tq * 8 + q) * 128 + i]; ar[q] += xv * wr_; ai[q] += xv * wi_; }
            }
            const int c = hd * 128 + j;
            const float lm = lam[c];
            const float sp = (lm > 15.f) ? __expf(-lm) : log1pf(__expf(-lm));
            const float br = b_r[c], bi = b_i[c];
#pragma unroll
            for (int q = 0; q < 8; ++q) {
                const int tl = tq * 8 + q, t = t0 + tl;
                const float r = sigmoidf_(ar[q] + br), ig = sigmoidf_(ai[q] + bi);
                const float log_a = -8.0f * r * sp;
                const float a = __expf(log_a);
                const float bb = sqrtf(fmaxf(-expm1f(2.0f * log_a), 0.f)) * ig * xc[tl * 128 + j];
                Aarr[(size_t)t * D + c] = a; Barr[(size_t)t * D + c] = bb;
            }
        }
        __syncthreads();
    }
}
__device__ void lru_scan_phase(const Params& p) {
    const bf16_t* u = (const bf16_t*)(p.ws + WS_U);
    const float* Aarr = (const float*)(p.ws + WS_SCR); const float* Barr = Aarr + (size_t)T * D;
    bf16_t* yin = (bf16_t*)(p.ws + WS_YIN);
    const int nthr = NBATCH * D;
    for (int g = blockIdx.x * NTHREADS + threadIdx.x; g < nthr; g += gridDim.x * NTHREADS) {
        const int b = g / D, c = g % D;
        float h = 0.f;
#pragma unroll 8
        for (int s = 0; s < SEQ; ++s) {
            const size_t t = (size_t)b * SEQ + s;
            h = Aarr[t * D + c] * h + Barr[t * D + c];
            const float gt = bf2f(u[t * 2048 + c]);
            yin[t * D + c] = f2bf(gelu_tanh(gt) * h);
        }
    }
}

__device__ void ret_core_phase(LAS unsigned char* lds, const Params& p) {
    const int tid = threadIdx.x, lane = tid & 63, wid = tid >> 6;
    LAS float* red = (LAS float*)lds;
    const bf16_t* u = (const bf16_t*)(p.ws + WS_U);
    float* RO = (float*)(p.ws + WS_SCR);
    const int nunits = NBATCH * 4 * 64;
    for (int un = blockIdx.x; un < nunits; un += gridDim.x) {
        const int b = un >> 8, h = (un >> 6) & 3, vg = un & 63;
        const int d = tid & 255, half = tid >> 8, v0 = vg * 8 + half * 4;
        const float gamma = 1.0f - exp2f(-5.0f - (float)h);
        float S0 = 0.f, S1 = 0.f, S2 = 0.f, S3 = 0.f;
        for (int n = 0; n < SEQ; ++n) {
            const size_t t = (size_t)b * SEQ + n;
            const bf16_t* ur = u + t * 6144;
            const float qd = bf2f(ur[h * 256 + d]), kd = bf2f(ur[1024 + h * 256 + d]) * 0.0625f;
            const u32x2 vv = *(const u32x2*)(ur + 2048 + h * 512 + v0);
            const float x0 = __uint_as_float(vv.x << 16), x1 = __uint_as_float(vv.x & 0xffff0000u), x2 = __uint_as_float(vv.y << 16), x3 = __uint_as_float(vv.y & 0xffff0000u);
            S0 = gamma * S0 + kd * x0; S1 = gamma * S1 + kd * x1; S2 = gamma * S2 + kd * x2; S3 = gamma * S3 + kd * x3;
            const float p0 = wave_sum(qd * S0), p1 = wave_sum(qd * S1), p2 = wave_sum(qd * S2), p3 = wave_sum(qd * S3);
            LAS float* rb = red + (n & 1) * 32;
            if (lane == 0) { rb[wid * 4 + 0] = p0; rb[wid * 4 + 1] = p1; rb[wid * 4 + 2] = p2; rb[wid * 4 + 3] = p3; }
            __syncthreads();
            if (tid < 8) {
                const int hf = tid >> 2, j = tid & 3;
                const float o = rb[(hf * 4 + 0) * 4 + j] + rb[(hf * 4 + 1) * 4 + j] + rb[(hf * 4 + 2) * 4 + j] + rb[(hf * 4 + 3) * 4 + j];
                RO[t * 2048 + h * 512 + vg * 8 + hf * 4 + j] = o;
            }
        }
        __syncthreads();
    }
}
__device__ void ret_norm_phase(LAS unsigned char* lds, const Params& p) {
    const int tid = threadIdx.x, lane = tid & 63, wid = tid >> 6;
    LAS float* red = (LAS float*)lds;
    const bf16_t* u = (const bf16_t*)(p.ws + WS_U);
    const float* RO = (const float*)(p.ws + WS_SCR);
    bf16_t* yin = (bf16_t*)(p.ws + WS_YIN);
    for (int t = blockIdx.x; t < T; t += gridDim.x) {
        const f32x4 o = *(const f32x4*)(RO + (size_t)t * 2048 + tid * 4);
        const float ss = wave_sum(o[0] * o[0] + o[1] * o[1] + o[2] * o[2] + o[3] * o[3]);
        if (lane == 0) red[wid] = ss;
        __syncthreads();
        const float tot = red[(wid & ~1)] + red[(wid | 1)];
        const float rstd = rsqrtf(tot * (1.0f / 512.0f) + 1e-6f);
        const u32x2 gv = *(const u32x2*)(u + (size_t)t * 6144 + 4096 + tid * 4);
        const float g0 = __uint_as_float(gv.x << 16), g1 = __uint_as_float(gv.x & 0xffff0000u), g2 = __uint_as_float(gv.y << 16), g3 = __uint_as_float(gv.y & 0xffff0000u);
        u32x2 w; w.x = pack2(g0 * sigmoidf_(g0) * o[0] * rstd, g1 * sigmoidf_(g1) * o[1] * rstd); w.y = pack2(g2 * sigmoidf_(g2) * o[2] * rstd, g3 * sigmoidf_(g3) * o[3] * rstd);
        *(u32x2*)(yin + (size_t)t * 2048 + tid * 4) = w;
        __syncthreads();
    }
}

__device__ void attn_core_phase(LAS unsigned char* lds, const Params& p) {
    const int tid = threadIdx.x, lane = tid & 63, wid = tid >> 6;
    LAS float* qs = (LAS float*)lds + wid * 640;
    LAS float* ps = qs + 192;
    const bf16_t* u = (const bf16_t*)(p.ws + WS_U);
    bf16_t* yin = (bf16_t*)(p.ws + WS_YIN);
    const int niter = T * 16 / 8;
    for (int it = blockIdx.x; it < niter; it += gridDim.x) {
        const int wu = it * 8 + wid, t = wu >> 4, h = wu & 15, s = t & (SEQ - 1);
        const float slope = exp2f(-0.5f * (float)(h + 1));
        const bf16_t* ut = u + (size_t)t * 9216;
#pragma unroll
        for (int g = 0; g < 3; ++g) qs[g * 64 + lane] = bf2f(ut[g * 1024 + h * 64 + lane]);
        __syncthreads();
        float sc[3][3];
        float mx = -INFINITY;
#pragma unroll
        for (int g = 0; g < 3; ++g) {
            const int dl = (g == 0) ? 1 : (g == 1 ? 4 : 16);
#pragma unroll
            for (int ps_ = 0; ps_ < 3; ++ps_) {
                const int st = ps_ * 64 + lane;
                float v = -INFINITY;
                if (st <= 128 && s - st * dl >= 0) {
                    const bf16_t* kr = u + (size_t)(t - st * dl) * 9216 + (3 + g) * 1024 + h * 64;
                    float a = 0.f;
#pragma unroll
                    for (int c = 0; c < 8; ++c) {
                        const u32x4 kv = *(const u32x4*)(kr + c * 8);
                        a += qs[g * 64 + c * 8 + 0] * __uint_as_float(kv.x << 16) + qs[g * 64 + c * 8 + 1] * __uint_as_float(kv.x & 0xffff0000u);
                        a += qs[g * 64 + c * 8 + 2] * __uint_as_float(kv.y << 16) + qs[g * 64 + c * 8 + 3] * __uint_as_float(kv.y & 0xffff0000u);
                        a += qs[g * 64 + c * 8 + 4] * __uint_as_float(kv.z << 16) + qs[g * 64 + c * 8 + 5] * __uint_as_float(kv.z & 0xffff0000u);
                        a += qs[g * 64 + c * 8 + 6] * __uint_as_float(kv.w << 16) + qs[g * 64 + c * 8 + 7] * __uint_as_float(kv.w & 0xffff0000u);
                    }
                    v = a * 0.125f - slope * (float)(st * dl);
                }
                sc[g][ps_] = v; mx = fmaxf(mx, v);
            }
        }
        mx = wave_max(mx);
        float den = 0.f;
#pragma unroll
        for (int g = 0; g < 3; ++g)
#pragma unroll
            for (int ps_ = 0; ps_ < 3; ++ps_) {
                const int st = ps_ * 64 + lane;
                const float pv = (sc[g][ps_] == -INFINITY) ? 0.f : __expf(sc[g][ps_] - mx);
                den += pv;
                if (st <= 128) ps[g * 129 + st] = pv;
            }
        den = wave_sum(den);
        __syncthreads();
        float o = 0.f;
#pragma unroll
        for (int g = 0; g < 3; ++g) {
            const int dl = (g == 0) ? 1 : (g == 1 ? 4 : 16);
            const int nst = min(128, s / dl);
            for (int st = 0; st <= nst; ++st) o += ps[g * 129 + st] * bf2f(u[(size_t)(t - st * dl) * 9216 + (6 + g) * 1024 + h * 64 + lane]);
        }
        yin[(size_t)t * D + h * 64 + lane] = f2bf(o / den);
        __syncthreads();
    }
}

__device__ void ln_phase(const Params& p, int layer, int which) {
    const int tid = threadIdx.x, lane = tid & 63, wid = tid >> 6;
    float* xf = (float*)(p.ws + WS_XF); bf16_t* xb = (bf16_t*)(p.ws + WS_XB);
    const float* ymix = (const float*)(p.ws + WS_YMIX);
    const float* yrows = (const float*)(p.ws + WS_YROWS);
    int* tope = (int*)(p.ws + WS_TOPE); float* gates = (float*)(p.ws + WS_GATES); int* pos = (int*)(p.ws + WS_POS); const int* dest = (const int*)(p.ws + WS_DEST);
    unsigned* ctl = (unsigned*)(p.ws + WS_CTL);
    const float* gain = p.ln_gain + (size_t)(layer * 2 + which) * D; const float* bias = p.ln_bias + (size_t)(layer * 2 + which) * D;
    const float* wrt = p.moe_w_router + (size_t)layer * D * NEXP; const float* brt = p.moe_b_router + (size_t)layer * NEXP;
    for (int t = blockIdx.x * 8 + wid; t < T; t += gridDim.x * 8) {
        f32x4 z[4];
        if (which == 0) {
#pragma unroll
            for (int i = 0; i < 4; ++i) { const int c = 256 * i + 4 * lane; z[i] = DN_ALPHA * *(const f32x4*)(xf + (size_t)t * D + c) + *(const f32x4*)(ymix + (size_t)t * D + c); }
        } else {
            int dk[4]; float gk[4];
#pragma unroll
            for (int k = 0; k < 4; ++k) { dk[k] = dest[t * 4 + k]; gk[k] = gates[t * 4 + k]; }
#pragma unroll
            for (int i = 0; i < 4; ++i) {
                const int c = 256 * i + 4 * lane;
                f32x4 f = (f32x4){0.f, 0.f, 0.f, 0.f};
#pragma unroll
                for (int k = 0; k < 4; ++k) f += gk[k] * *(const f32x4*)(yrows + (size_t)dk[k] * D + c);
                z[i] = DN_ALPHA * *(const f32x4*)(xf + (size_t)t * D + c) + f;
            }
        }
        float sm = 0.f;
#pragma unroll
        for (int i = 0; i < 4; ++i) sm += (z[i][0] + z[i][1]) + (z[i][2] + z[i][3]);
        const float mean = wave_sum(sm) * (1.0f / D);
        float sq = 0.f;
#pragma unroll
        for (int i = 0; i < 4; ++i) { const f32x4 dd = z[i] - mean; sq += (dd[0] * dd[0] + dd[1] * dd[1]) + (dd[2] * dd[2] + dd[3] * dd[3]); }
        const float rstd = rsqrtf(wave_sum(sq) * (1.0f / D) + LN_EPS);
#pragma unroll
        for (int i = 0; i < 4; ++i) {
            const int c = 256 * i + 4 * lane;
            z[i] = (z[i] - mean) * rstd * *(const f32x4*)(gain + c) + *(const f32x4*)(bias + c);
            *(f32x4*)(xf + (size_t)t * D + c) = z[i];
            u32x2 w; w.x = pack2(z[i][0], z[i][1]); w.y = pack2(z[i][2], z[i][3]);
            *(u32x2*)(xb + (size_t)t * D + c) = w;
            if (which == 1 && layer == DEPTH - 1) *(f32x4*)(p.out + (size_t)t * D + c) = z[i];
        }
        if (which == 0) {
            float lg[NEXP];
#pragma unroll
            for (int e = 0; e < NEXP; ++e) lg[e] = 0.f;
#pragma unroll
            for (int i = 0; i < 4; ++i)
#pragma unroll
                for (int j = 0; j < 4; ++j) {
                    const int c = 256 * i + 4 * lane + j; const float xv = z[i][j];
#pragma unroll
                    for (int e4 = 0; e4 < NEXP / 4; ++e4) { const f32x4 w = *(const f32x4*)(wrt + (size_t)c * NEXP + e4 * 4); lg[e4 * 4 + 0] += xv * w[0]; lg[e4 * 4 + 1] += xv * w[1]; lg[e4 * 4 + 2] += xv * w[2]; lg[e4 * 4 + 3] += xv * w[3]; }
                }
#pragma unroll
            for (int e = 0; e < NEXP; ++e) lg[e] = wave_sum(lg[e]) + brt[e];
            int te[4]; float tv[4]; unsigned used = 0u;
#pragma unroll
            for (int k = 0; k < 4; ++k) {
                float best = -INFINITY; int bi = 0;
#pragma unroll
                for (int e = 0; e < NEXP; ++e) { const bool ok = !((used >> e) & 1u) && lg[e] > best; best = ok ? lg[e] : best; bi = ok ? e : bi; }
                te[k] = bi; tv[k] = best; used |= 1u << bi;
            }
            const float e1 = __expf(tv[1] - tv[0]), e2 = __expf(tv[2] - tv[0]), e3 = __expf(tv[3] - tv[0]);
            const float inv = 1.0f / (1.0f + e1 + e2 + e3);
            if (lane < 4) {
                const int k = lane;
                const int ee = (k == 0) ? te[0] : (k == 1 ? te[1] : (k == 2 ? te[2] : te[3]));
                const float gg = ((k == 0) ? 1.0f : (k == 1 ? e1 : (k == 2 ? e2 : e3))) * inv;
                tope[t * 4 + k] = ee; gates[t * 4 + k] = gg;
                pos[t * 4 + k] = (int)atomicAdd(ctl + CW_CNT + layer * 64 + ee, 1u);
            }
        }
    }
}

__device__ void moe_scatter_phase(LAS unsigned char* lds, const Params& p, int layer) {
    const int tid = threadIdx.x;
    LAS int* pstart = (LAS int*)lds;
    unsigned* ctl = (unsigned*)(p.ws + WS_CTL);
    const int* tope = (const int*)(p.ws + WS_TOPE); const int* pos = (const int*)(p.ws + WS_POS);
    int* dest = (int*)(p.ws + WS_DEST); int* rowtok = (int*)(p.ws + WS_ROWTOK);
    if (tid == 0) {
        int acc = 0;
        for (int e = 0; e < NEXP; ++e) { const int c = (int)ctl[CW_CNT + layer * 64 + e]; pstart[e] = acc; pstart[32 + e] = c; acc += ((c + 255) >> 8) << 8; }
        pstart[64] = acc;
        if (blockIdx.x == 0) {
            ctl[CW_MDYN + layer * 64] = (unsigned)acc;
            for (int e = 0; e < NEXP; ++e) { const int nb = (pstart[32 + e] + 255) >> 8; for (int b = 0; b < nb; ++b) ctl[CW_TEXP + layer * 512 + (pstart[e] >> 8) + b] = (unsigned)e; }
        }
    }
    __syncthreads();
    for (int i = blockIdx.x * NTHREADS + tid; i < T * TOPK; i += gridDim.x * NTHREADS) {
        const int e = tope[i], row = pstart[e] + pos[i];
        dest[i] = row; rowtok[row] = i >> 2;
    }
    for (int i = blockIdx.x * NTHREADS + tid; i < NEXP * 256; i += gridDim.x * NTHREADS) {
        const int e = i >> 8, r = i & 255, c = pstart[32 + e], padded = ((c + 255) >> 8) << 8;
        if (c + r < padded) rowtok[pstart[e] + c + r] = 0;
    }
    __syncthreads();
}

constexpr int PH_PER_LAYER = 9;
constexpr int NPHASES = 1 + DEPTH * PH_PER_LAYER;
constexpr int LDS_BYTES = 96 * 1024;


#define IN(k) (lo <= (k) && (k) < hi)
#if MK_ONE_LAUNCH
#define SEAM(k) do { if (IN(k) && IN((k) + 1)) xcd_barrier(bar); } while (0)
#else
#define SEAM(k) do {} while (0)
#endif
template <int layer>
__device__ __forceinline__ void run_layer(const Params& p, LAS unsigned char* lds, const XcdBarrier& bar) {
    const int lo = p.ph_lo, hi = p.ph_hi;
    unsigned char* ws = p.ws;
    unsigned* ctl = (unsigned*)(ws + WS_CTL);
        constexpr int base = 1 + layer * PH_PER_LAYER, kind = layer % 3, idx = layer / 3;
        if (IN(base + 0)) {
            GemmS g{}; g.A = (const bf16_t*)(ws + WS_XB); g.lda = D; g.ldb = D; g.M = T; g.K = D; g.Cb = (bf16_t*)(ws + WS_U);
            if (kind == 0) { g.Bt = (const bf16_t*)(ws + WS_AWIN) + (size_t)idx * 2048 * D; g.N = 2048; }
            else if (kind == 1) { g.Bt = (const bf16_t*)(ws + WS_BWIN); g.N = 6144; }
            else { g.Bt = (const bf16_t*)(ws + WS_CWIN); g.N = 9216; }
            g.ldc = g.N;
            gemm_simple<0>(lds, g);
        }
        SEAM(base + 0);
        if (IN(base + 1)) {
            if (kind == 0) lru_gates_phase(lds, p, idx);
            else if (kind == 1) ret_core_phase(lds, p);
            else attn_core_phase(lds, p);
        }
        SEAM(base + 1);
        if (IN(base + 2)) {
            if (kind == 0) lru_scan_phase(p);
            else if (kind == 1) ret_norm_phase(lds, p);
        }
        SEAM(base + 2);
        if (IN(base + 3)) {
            GemmS g{}; g.A = (const bf16_t*)(ws + WS_YIN); g.M = T; g.N = D; g.Cf = (float*)(ws + WS_YMIX); g.ldc = D;
            if (kind == 0) { g.Bt = (const bf16_t*)(ws + WS_AWOUT) + (size_t)idx * D * D; g.K = D; }
            else if (kind == 1) { g.Bt = (const bf16_t*)(ws + WS_BWOUT); g.K = 2048; }
            else { g.Bt = (const bf16_t*)(ws + WS_CWOUT); g.K = D; }
            g.lda = g.K; g.ldb = g.K;
            gemm_simple<0>(lds, g);
        }
        SEAM(base + 3);
        if (IN(base + 4)) ln_phase(p, layer, 0);
        SEAM(base + 4);
        if (IN(base + 5)) moe_scatter_phase(lds, p, layer);
        SEAM(base + 5);
        if (IN(base + 6)) {
            GemmS g{}; g.A = (const bf16_t*)(ws + WS_XB); g.lda = D; g.Bt = (const bf16_t*)(ws + WS_GU) + (size_t)layer * NEXP * 2048 * D; g.ldb = D; g.N = 2048; g.K = D;
            g.Mdyn = ctl + CW_MDYN + layer * 64; g.row_idx = (const int*)(ws + WS_ROWTOK); g.tile_exp = ctl + CW_TEXP + layer * 512; g.b_exp_stride = (size_t)2048 * D;
            g.bias = p.moe_b_gu + (size_t)layer * NEXP * 2048; g.bias_es = 2048; g.Cb = (bf16_t*)(ws + WS_HID); g.ldc = D;
            gemm_simple<1>(lds, g);
        }
        SEAM(base + 6);
        if (IN(base + 7)) {
            GemmS g{}; g.A = (const bf16_t*)(ws + WS_HID); g.lda = D; g.Bt = (const bf16_t*)(ws + WS_DN) + (size_t)layer * NEXP * D * D; g.ldb = D; g.N = D; g.K = D;
            g.Mdyn = ctl + CW_MDYN + layer * 64; g.tile_exp = ctl + CW_TEXP + layer * 512; g.b_exp_stride = (size_t)D * D;
            g.bias = p.moe_b_down + (size_t)layer * NEXP * D; g.bias_es = D; g.Cf = (float*)(ws + WS_YROWS); g.ldc = D;
            gemm_simple<2>(lds, g);
        }
        SEAM(base + 7);
        if (IN(base + 8)) ln_phase(p, layer, 1);
        SEAM(base + 8);
    }
#undef IN
#undef SEAM
__global__ void __launch_bounds__(NTHREADS, 2) fwd_kernel(Params p) {
    extern __shared__ __attribute__((aligned(16))) unsigned char lds_raw[];
    LAS unsigned char* lds = (LAS unsigned char*)lds_raw;
    const int lo = p.ph_lo, hi = p.ph_hi;
    unsigned char* ws = p.ws;
    unsigned* ctl = (unsigned*)(ws + WS_CTL);
#if MK_ONE_LAUNCH
    volatile LAS unsigned* bst = (volatile LAS unsigned*)(lds + LDS_BYTES - 16);
    if (threadIdx.x == 0) { bst[0] = 0u; bst[1] = 0u; bst[2] = 0u; bst[3] = 0u; }
    __syncthreads();
    XcdBarrier bar = xcd_barrier_post(ctl, bst);
#define GRID_BAR() xcd_barrier(bar)
#else
    XcdBarrier bar; bar.bar = ctl; bar.x = 0; bar.st = nullptr;
#define GRID_BAR() do {} while (0)
#endif
#define IN(k) (lo <= (k) && (k) < hi)
#define SEAM(k) do { if (IN(k) && IN((k) + 1)) GRID_BAR(); } while (0)

    if (IN(0)) {
        LAS float* tile = (LAS float*)lds;
        for (int l = 0; l < 2; ++l) {
            convert_job(tile, p.a_w_in + (size_t)l * D * 2048, (bf16_t*)(ws + WS_AWIN) + (size_t)l * 2048 * D, D, 2048, 1);
            convert_job(tile, p.a_w_out + (size_t)l * D * D, (bf16_t*)(ws + WS_AWOUT) + (size_t)l * D * D, D, D, 1);
        }
        convert_job(tile, p.b_w_in, (bf16_t*)(ws + WS_BWIN), D, 6144, 1);
        convert_job(tile, p.b_w_out, (bf16_t*)(ws + WS_BWOUT), 2048, D, 1);
        convert_job(tile, p.c_w_in, (bf16_t*)(ws + WS_CWIN), D, 9216, 1);
        convert_job(tile, p.c_w_out, (bf16_t*)(ws + WS_CWOUT), D, D, 1);
        convert_job(tile, p.moe_w_gu, (bf16_t*)(ws + WS_GU), D, 2048, DEPTH * NEXP);
        convert_job(tile, p.moe_w_down, (bf16_t*)(ws + WS_DN), D, D, DEPTH * NEXP);
        float* xf = (float*)(ws + WS_XF); bf16_t* xb = (bf16_t*)(ws + WS_XB);
        for (size_t i = (size_t)blockIdx.x * NTHREADS + threadIdx.x; i < (size_t)T * D / 4; i += (size_t)gridDim.x * NTHREADS) {
            const f32x4 v = *(const f32x4*)(p.x + i * 4);
            *(f32x4*)(xf + i * 4) = v;
            u32x2 w; w.x = pack2(v[0], v[1]); w.y = pack2(v[2], v[3]); *(u32x2*)(xb + i * 4) = w;
        }
    }
    SEAM(0);

    run_layer<0>(p, lds, bar); run_layer<1>(p, lds, bar); run_layer<2>(p, lds, bar); run_layer<3>(p, lds, bar);
#undef IN
#undef SEAM
}

extern "C" void kernel_launch(void* const* d_in, const int* in_sizes, int n_in, void* d_out, int out_size, void* d_ws, size_t ws_size, hipStream_t stream) {
    static int grid = 0;
    if (grid == 0) {
        if (n_in != 22 || out_size != T * D || ws_size < WS_END) { fprintf(stderr, "kernel_launch: unexpected shapes (n_in %d out %d ws %zu need %zu)\n", n_in, out_size, ws_size, (size_t)WS_END); grid = -1; return; }
        if (hipFuncSetAttribute((const void*)fwd_kernel, hipFuncAttributeMaxDynamicSharedMemorySize, LDS_BYTES) != hipSuccess) { fprintf(stderr, "kernel_launch: hipFuncSetAttribute failed\n"); grid = -1; return; }
        int dev = 0, cus = 0;
        if (hipGetDevice(&dev) != hipSuccess || hipDeviceGetAttribute(&cus, hipDeviceAttributeMultiprocessorCount, dev) != hipSuccess) { grid = -1; return; }
        grid = cus;
    }
    if (grid < 0) return;
    (void)hipMemsetAsync((char*)d_ws + WS_CTL, 0, CTL_BYTES, stream);
    Params p{};
    const float** pp = (const float**)&p;
    for (int i = 0; i < 22; ++i) pp[i] = (const float*)d_in[i];
    p.out = (float*)d_out; p.ws = (unsigned char*)d_ws;
#if MK_ONE_LAUNCH
    p.ph_lo = 0; p.ph_hi = NPHASES;
    hipLaunchKernelGGL(fwd_kernel, dim3(grid), dim3(NTHREADS), LDS_BYTES, stream, p);
#else
    for (int ph = 0; ph < NPHASES; ++ph) {
        if (ph > 0) { const int k = (ph - 1) % PH_PER_LAYER, layer = (ph - 1) / PH_PER_LAYER; if (k == 2 && layer % 3 == 2) continue; }
        p.ph_lo = ph; p.ph_hi = ph + 1;
        hipLaunchKernelGGL(fwd_kernel, dim3(grid), dim3(NTHREADS), LDS_BYTES, stream, p);
    }
#endif
}
```

```cpp
#include <hip/hip_runtime.h>
#include <stdint.h>
#include <stdio.h>

#ifndef MK_ONE_LAUNCH
#define MK_ONE_LAUNCH 1
#endif

#define LAS __attribute__((address_space(3)))
typedef unsigned short bf16_t;
typedef short bf16x8 __attribute__((ext_vector_type(8)));
typedef float f32x4 __attribute__((ext_vector_type(4)));
typedef unsigned u32x4 __attribute__((ext_vector_type(4)));
typedef unsigned u32x2 __attribute__((ext_vector_type(2)));

constexpr int T = 16384, D = 1024, SEQ = 2048, NBATCH = 8, DEPTH = 4;
constexpr int NEXP = 32, TOPK = 4;
constexpr int MAXROWS = 73728;
constexpr float DN_ALPHA = 1.681792830507429f;
constexpr float LN_EPS = 1e-5f;
constexpr int NTHREADS = 512;

constexpr size_t MB = 1ull << 20;
constexpr size_t WS_CTL = 0;
constexpr size_t CTL_BYTES = 65536;
constexpr size_t WS_AWIN = 1 * MB;
constexpr size_t WS_AWOUT = WS_AWIN + 8 * MB;
constexpr size_t WS_BWIN = WS_AWOUT + 4 * MB;
constexpr size_t WS_BWOUT = WS_BWIN + 12 * MB;
constexpr size_t WS_CWIN = WS_BWOUT + 4 * MB;
constexpr size_t WS_CWOUT = WS_CWIN + 18 * MB;
constexpr size_t WS_GU = WS_CWOUT + 2 * MB;
constexpr size_t WS_DN = WS_GU + 512 * MB;
constexpr size_t WS_XF = WS_DN + 256 * MB;
constexpr size_t WS_XB = WS_XF + 64 * MB;
constexpr size_t WS_U = WS_XB + 32 * MB;
constexpr size_t WS_YIN = WS_U + 288 * MB;
constexpr size_t WS_YMIX = WS_YIN + 64 * MB;
constexpr size_t WS_SCR = WS_YMIX + 64 * MB;
constexpr size_t WS_TOPE = WS_SCR + 128 * MB;
constexpr size_t WS_GATES = WS_TOPE + 256 * 1024;
constexpr size_t WS_POS = WS_GATES + 256 * 1024;
constexpr size_t WS_DEST = WS_POS + 256 * 1024;
constexpr size_t WS_ROWTOK = WS_DEST + 256 * 1024;
constexpr size_t WS_HID = WS_ROWTOK + 1 * MB;
constexpr size_t WS_YROWS = WS_HID + 144 * MB;
constexpr size_t WS_END = WS_YROWS + 288 * MB;

constexpr int CW_CNT = 4096;
constexpr int CW_MDYN = 8192;
constexpr int CW_TEXP = 12288;

#define XB_TMO      128
#define XB_XCNT(j)  (256  + 64 * (j))
#define XB_XSUB(j)  (1280 + 64 * (j))
#define XB_XGEN(j)  (2304 + 64 * (j))
#define XB_TOP      3328
#define XB_TOPGEN   3392
#define XCD_BAR_WORDS 3456
#define XB_SPIN_CAP (1u << 22)

__device__ __forceinline__ unsigned xb_ld(unsigned* p)              { return __hip_atomic_load(p, __ATOMIC_RELAXED, __HIP_MEMORY_SCOPE_AGENT); }
__device__ __forceinline__ unsigned xb_add(unsigned* p, unsigned v) { return __hip_atomic_fetch_add(p, v, __ATOMIC_RELAXED, __HIP_MEMORY_SCOPE_AGENT); }
__device__ __forceinline__ unsigned xb_xcc_id() { return (unsigned)__builtin_amdgcn_s_getreg((3 << 11) | 20) & 0xFu; }
#define XB_SPIN(cond, bar) do { unsigned _sp = 0; while (cond) { __builtin_amdgcn_s_sleep(1); \
    if ((++_sp & 255u) == 0u) { if (xb_ld(&(bar)[XB_TMO])) break; if (_sp > XB_SPIN_CAP) { atomicAdd(&(bar)[XB_TMO], 1u); break; } } } } while (0)

struct XcdBarrier { unsigned* bar; unsigned x; volatile LAS unsigned* st; };

__device__ __forceinline__ XcdBarrier xcd_barrier_post(unsigned* bar, volatile LAS unsigned* st) {
    XcdBarrier b; b.bar = bar; b.x = xb_xcc_id(); b.st = st;
    if (threadIdx.x == 0) (void)xb_add(&bar[XB_XCNT(b.x)], 1u);
    return b;
}
__device__ __forceinline__ void xcd_barrier_complete(unsigned* bar, unsigned x, unsigned& nloc, unsigned& nx) {
    const unsigned G = gridDim.x * gridDim.y * gridDim.z;
    unsigned sum, cnt, mine, sp = 0u;
    for (;;) {
        sum = 0u; cnt = 0u; mine = 0u;
#pragma unroll
        for (unsigned j = 0; j < 16; ++j) { const unsigned c = xb_ld(&bar[XB_XCNT(j)]); sum += c; cnt += (c > 0u) ? 1u : 0u; mine = (j == x) ? c : mine; }
        if (sum == G) break;
        __builtin_amdgcn_s_sleep(1);
        if ((++sp & 255u) == 0u) { if (xb_ld(&bar[XB_TMO])) break; if (sp > XB_SPIN_CAP) { atomicAdd(&bar[XB_TMO], 1u); break; } }
    }
    nloc = mine > 0u ? mine : 1u; nx = cnt > 0u ? cnt : 1u;
}
__device__ __noinline__ void xcd_barrier_nv(unsigned* bbar, unsigned bx, volatile LAS unsigned* bst) {
    XcdBarrier b; b.bar = bbar; b.x = bx; b.st = bst;
    asm volatile("s_waitcnt vmcnt(0)" ::: "memory");
    __syncthreads();
    if (threadIdx.x == 0) {
        unsigned* bar = b.bar;
        __builtin_amdgcn_s_waitcnt(0);
        unsigned nloc = b.st[0], nx = b.st[1];
        if (nloc == 0u) { xcd_barrier_complete(bar, b.x, nloc, nx); b.st[0] = nloc; b.st[1] = nx; }
        const unsigned old = xb_add(&bar[XB_XSUB(b.x)], 1u);
        const unsigned gen = old / nloc;
        if (old + 1u == (gen + 1u) * nloc) {
            __builtin_amdgcn_fence(__ATOMIC_RELEASE, "agent");
            asm volatile("s_waitcnt vmcnt(0)" ::: "memory");
            const unsigned og = xb_add(&bar[XB_TOP], 1u);
            const unsigned tg = og / nx;
            if (og + 1u == (tg + 1u) * nx) xb_add(&bar[XB_TOPGEN], 1u);
            else XB_SPIN(xb_ld(&bar[XB_TOPGEN]) == tg, bar);
            __builtin_amdgcn_fence(__ATOMIC_ACQUIRE, "agent");
            xb_add(&bar[XB_XGEN(b.x)], 1u);
            asm volatile("s_waitcnt vmcnt(0)" ::: "memory");
        } else {
            XB_SPIN(xb_ld(&bar[XB_XGEN(b.x)]) == gen, bar);
            __builtin_amdgcn_fence(__ATOMIC_ACQUIRE, "agent");
            asm volatile("s_waitcnt vmcnt(0)" ::: "memory");
        }
    }
    __syncthreads();
}

__device__ __forceinline__ float bf2f(bf16_t v) { return __uint_as_float(((unsigned)v) << 16); }
__device__ __forceinline__ bf16_t f2bf(float f) { unsigned u = __float_as_uint(f); u += 0x7FFFu + ((u >> 16) & 1u); return (bf16_t)(u >> 16); }
__device__ __forceinline__ unsigned pack2(float lo, float hi) { return (unsigned)f2bf(lo) | ((unsigned)f2bf(hi) << 16); }
__device__ __forceinline__ float wave_sum(float v) {
#pragma unroll
    for (int o = 32; o >= 1; o >>= 1) v += __shfl_xor(v, o);
    return v;
}
__device__ __forceinline__ float wave_max(float v) {
#pragma unroll
    for (int o = 32; o >= 1; o >>= 1) v = fmaxf(v, __shfl_xor(v, o));
    return v;
}
__device__ __forceinline__ float sigmoidf_(float x) { return 1.0f / (1.0f + __expf(-x)); }
__device__ __forceinline__ float gelu_tanh(float x) { const float u = 0.7978845608028654f * (x + 0.044715f * x * x * x); return 0.5f * x * (1.0f + tanhf(u)); }
__device__ __forceinline__ float swiglu(float gate, float up) {
    const float g = fminf(gate, 7.0f), u = fminf(fmaxf(up, -7.0f), 7.0f);
    return (u + 1.0f) * g * sigmoidf_(1.702f * g);
}

struct Params {
    const float* x; const float* a_w_in; const float* a_conv_w; const float* a_conv_b; const float* a_w_rgate; const float* a_b_rgate;
    const float* a_w_igate; const float* a_b_igate; const float* a_lambda; const float* a_w_out; const float* b_w_in; const float* b_w_out;
    const float* c_w_in; const float* c_w_out; const float* ln_gain; const float* ln_bias; const float* moe_w_router; const float* moe_b_router;
    const float* moe_w_gu; const float* moe_b_gu; const float* moe_w_down; const float* moe_b_down;
    float* out; unsigned char* ws;
    int ph_lo, ph_hi;
};

__device__ void convert_job(LAS float* tile, const float* src, bf16_t* dst, int K, int N, int batch) {
    const int tid = threadIdx.x;
    const int tk = K / 64, tn = N / 64, per = tk * tn; const long total = (long)per * batch;
    for (long u = blockIdx.x; u < total; u += gridDim.x) {
        const int bidx = (int)(u / per), r = (int)(u % per), kt = r / tn, nt = r % tn;
        const float* s = src + (size_t)bidx * K * N + (size_t)(kt * 64) * N + nt * 64;
#pragma unroll
        for (int pass = 0; pass < 2; ++pass) {
            const int row = (tid >> 4) + 32 * pass, c4 = tid & 15;
            const f32x4 v = *(const f32x4*)(s + (size_t)row * N + c4 * 4);
            tile[row * 65 + c4 * 4 + 0] = v[0]; tile[row * 65 + c4 * 4 + 1] = v[1]; tile[row * 65 + c4 * 4 + 2] = v[2]; tile[row * 65 + c4 * 4 + 3] = v[3];
        }
        __syncthreads();
        {
            const int n = tid >> 3, k8 = tid & 7;
            float v[8];
#pragma unroll
            for (int j = 0; j < 8; ++j) v[j] = tile[(k8 * 8 + j) * 65 + n];
            u32x4 w; w.x = pack2(v[0], v[1]); w.y = pack2(v[2], v[3]); w.z = pack2(v[4], v[5]); w.w = pack2(v[6], v[7]);
            *(u32x4*)(dst + (size_t)bidx * N * K + (size_t)(nt * 64 + n) * K + kt * 64 + k8 * 8) = w;
        }
        __syncthreads();
    }
}

struct GemmS {
    const bf16_t* A; int lda;
    const bf16_t* Bt; int ldb;
    int M, N, K;
    const unsigned* Mdyn;
    const int* row_idx;
    const unsigned* tile_exp;
    size_t b_exp_stride;
    const float* bias; int bias_es;
    float* Cf; bf16_t* Cb; int ldc;
};
template <int MODE>
__device__ void gemm_simple(LAS unsigned char* lds, const GemmS& g) {
    const int tid = threadIdx.x, lane = tid & 63, wid = tid >> 6, wr = wid >> 1, wc = wid & 1, fr = lane & 15, fq = lane >> 4;
    const int M = g.Mdyn ? (int)*g.Mdyn : g.M;
    const int tiles_n = (MODE == 1) ? (g.N / 256) * 2 : g.N / 128;
    const int tiles_m = M / 128, nunits = tiles_m * tiles_n, nk = g.K / 32;
    LAS bf16_t* As = (LAS bf16_t*)lds;
    LAS bf16_t* Bs = As + 2 * 128 * 40;
    const int lrow = tid >> 2, lch = tid & 3;
    for (int u = blockIdx.x; u < nunits; u += gridDim.x) {
        const int tm = u / tiles_n, tn = u % tiles_n, m0 = tm * 128;
        const int e = (MODE != 0) ? (int)g.tile_exp[m0 >> 8] : 0;
        const bf16_t* Bbase = g.Bt + (size_t)e * g.b_exp_stride;
        int arow = m0 + lrow; if (MODE == 1) arow = g.row_idx[arow];
        int brow;
        if (MODE == 1) { const int bwc = lrow >> 6, ni = (lrow & 63) >> 4, r = lrow & 15; brow = ((ni & 1) ? 1024 : 0) + tn * 64 + bwc * 32 + (ni >> 1) * 16 + r; }
        else brow = tn * 128 + lrow;
        const bf16_t* ap = g.A + (size_t)arow * g.lda + lch * 8;
        const bf16_t* bp = Bbase + (size_t)brow * g.ldb + lch * 8;
        f32x4 acc[2][4];
#pragma unroll
        for (int mi = 0; mi < 2; ++mi)
#pragma unroll
            for (int ni = 0; ni < 4; ++ni) acc[mi][ni] = (f32x4){0.f, 0.f, 0.f, 0.f};
        u32x4 ra = *(const u32x4*)ap, rb = *(const u32x4*)bp;
        *(LAS u32x4*)(As + lrow * 40 + lch * 8) = ra; *(LAS u32x4*)(Bs + lrow * 40 + lch * 8) = rb;
        __syncthreads();
        for (int kt = 0; kt < nk; ++kt) {
            const int cur = kt & 1;
            if (kt + 1 < nk) { ra = *(const u32x4*)(ap + (kt + 1) * 32); rb = *(const u32x4*)(bp + (kt + 1) * 32); }
            bf16x8 af[2], bfr[4];
#pragma unroll
            for (int mi = 0; mi < 2; ++mi) af[mi] = *(const LAS bf16x8*)(As + cur * 5120 + (wr * 32 + mi * 16 + fr) * 40 + fq * 8);
#pragma unroll
            for (int ni = 0; ni < 4; ++ni) bfr[ni] = *(const LAS bf16x8*)(Bs + cur * 5120 + (wc * 64 + ni * 16 + fr) * 40 + fq * 8);
#pragma unroll
            for (int mi = 0; mi < 2; ++mi)
#pragma unroll
                for (int ni = 0; ni < 4; ++ni) acc[mi][ni] = __builtin_amdgcn_mfma_f32_16x16x32_bf16(bfr[ni], af[mi], acc[mi][ni], 0, 0, 0);
            if (kt + 1 < nk) { *(LAS u32x4*)(As + (cur ^ 1) * 5120 + lrow * 40 + lch * 8) = ra; *(LAS u32x4*)(Bs + (cur ^ 1) * 5120 + lrow * 40 + lch * 8) = rb; }
            __syncthreads();
        }
#pragma unroll
        for (int mi = 0; mi < 2; ++mi) {
            const int m = m0 + wr * 32 + mi * 16 + fr;
            if (MODE == 1) {
#pragma unroll
                for (int q = 0; q < 2; ++q) {
                    const int hc = tn * 64 + wc * 32 + q * 16 + 4 * fq;
                    const f32x4 bg = *(const f32x4*)(g.bias + (size_t)e * g.bias_es + hc), bu = *(const f32x4*)(g.bias + (size_t)e * g.bias_es + 1024 + hc);
                    const f32x4 gt = acc[mi][2 * q] + bg, up = acc[mi][2 * q + 1] + bu;
                    u32x2 w; w.x = pack2(swiglu(gt[0], up[0]), swiglu(gt[1], up[1])); w.y = pack2(swiglu(gt[2], up[2]), swiglu(gt[3], up[3]));
                    *(u32x2*)(g.Cb + (size_t)m * g.ldc + hc) = w;
                }
            } else {
#pragma unroll
                for (int ni = 0; ni < 4; ++ni) {
                    const int n = tn * 128 + wc * 64 + ni * 16 + 4 * fq;
                    f32x4 v = acc[mi][ni];
                    if (g.bias) v += *(const f32x4*)(g.bias + (size_t)e * g.bias_es + n);
                    if (g.Cf) *(f32x4*)(g.Cf + (size_t)m * g.ldc + n) = v;
                    else { u32x2 w; w.x = pack2(v[0], v[1]); w.y = pack2(v[2], v[3]); *(u32x2*)(g.Cb + (size_t)m * g.ldc + n) = w; }
                }
            }
        }
    }
}

__device__ void lru_gates_phase(LAS unsigned char* lds, const Params& p, int idx) {
    const int tid = threadIdx.x;
    LAS float* xc = (LAS float*)lds;
    const bf16_t* u = (const bf16_t*)(p.ws + WS_U);
    float* Aarr = (float*)(p.ws + WS_SCR); float* Barr = Aarr + (size_t)T * D;
    const float* conv_w = p.a_conv_w + (size_t)idx * 4 * D; const float* conv_b = p.a_conv_b + (size_t)idx * D;
    const float* w_r = p.a_w_rgate + (size_t)idx * 8 * 128 * 128; const float* w_i = p.a_w_igate + (size_t)idx * 8 * 128 * 128;
    const float* b_r = p.a_b_rgate + (size_t)idx * D; const float* b_i = p.a_b_igate + (size_t)idx * D; const float* lam = p.a_lambda + (size_t)idx * D;
    const int nunits = (T / 32) * 8;
    for (int un = blockIdx.x; un < nunits; un += gridDim.x) {
        const int tt = un >> 3, hd = un & 7, t0 = tt * 32;
        for (int i2 = tid; i2 < 32 * 128; i2 += NTHREADS) {
            const int tl = i2 >> 7, i = i2 & 127, c = hd * 128 + i, t = t0 + tl, s = t & (SEQ - 1);
            float acc = conv_b[c];
#pragma unroll
            for (int j = 0; j < 4; ++j) { const int sj = s - 3 + j; if (sj >= 0) acc += conv_w[j * D + c] * bf2f(u[(size_t)(t - 3 + j) * 2048 + 1024 + c]); }
            xc[tl * 128 + i] = acc;
        }
        __syncthreads();
        {
            const int j = tid & 127, tq = tid >> 7;
            float ar[8], ai[8];
#pragma unroll
            for (int q = 0; q < 8; ++q) { ar[q] = 0.f; ai[q] = 0.f; }
            for (int i = 0; i < 128; ++i) {
                const float wr_ = w_r[(size_t)(hd * 128 + i) * 128 + j], wi_ = w_i[(size_t)(hd * 128 + i) * 128 + j];
#pragma unroll
                for (int q = 0; q < 8; ++q) { const float xv = xc[(tq * 8 + q) * 128 + i]; ar[q] += xv * wr_; ai[q] += xv * wi_; }
            }
            const int c = hd * 128 + j;
            const float lm = lam[c];
            const float sp = (lm > 15.f) ? __expf(-lm) : log1pf(__expf(-lm));
            const float br = b_r[c], bi = b_i[c];
#pragma unroll
            for (int q = 0; q < 8; ++q) {
                const int tl = tq * 8 + q, t = t0 + tl;
                const float r = sigmoidf_(ar[q] + br), ig = sigmoidf_(ai[q] + bi);
                const float log_a = -8.0f * r * sp;
                const float a = __expf(log_a);
                const float bb = sqrtf(fmaxf(-expm1f(2.0f * log_a), 0.f)) * ig * xc[tl * 128 + j];
                Aarr[(size_t)t * D + c] = a; Barr[(size_t)t * D + c] = bb;
            }
        }
        __syncthreads();
    }
}
__device__ void lru_scan_phase(const Params& p) {
    const bf16_t* u = (const bf16_t*)(p.ws + WS_U);
    const float* Aarr = (const float*)(p.ws + WS_SCR); const float* Barr = Aarr + (size_t)T * D;
    bf16_t* yin = (bf16_t*)(p.ws + WS_YIN);
    const int nthr = NBATCH * D;
    for (int g = blockIdx.x * NTHREADS + threadIdx.x; g < nthr; g += gridDim.x * NTHREADS) {
        const int b = g / D, c = g % D;
        float h = 0.f;
#pragma unroll 8
        for (int s = 0; s < SEQ; ++s) {
            const size_t t = (size_t)b * SEQ + s;
            h = Aarr[t * D + c] * h + Barr[t * D + c];
            const float gt = bf2f(u[t * 2048 + c]);
            yin[t * D + c] = f2bf(gelu_tanh(gt) * h);
        }
    }
}

__device__ void ret_core_phase(LAS unsigned char* lds, const Params& p) {
    const int tid = threadIdx.x, lane = tid & 63, wid = tid >> 6;
    LAS float* red = (LAS float*)lds;
    const bf16_t* u = (const bf16_t*)(p.ws + WS_U);
    float* RO = (float*)(p.ws + WS_SCR);
    const int nunits = NBATCH * 4 * 64;
    for (int un = blockIdx.x; un < nunits; un += gridDim.x) {
        const int b = un >> 8, h = (un >> 6) & 3, vg = un & 63;
        const int d = tid & 255, half = tid >> 8, v0 = vg * 8 + half * 4;
        const float gamma = 1.0f - exp2f(-5.0f - (float)h);
        float S0 = 0.f, S1 = 0.f, S2 = 0.f, S3 = 0.f;
        for (int n = 0; n < SEQ; ++n) {
            const size_t t = (size_t)b * SEQ + n;
            const bf16_t* ur = u + t * 6144;
            const float qd = bf2f(ur[h * 256 + d]), kd = bf2f(ur[1024 + h * 256 + d]) * 0.0625f;
            const u32x2 vv = *(const u32x2*)(ur + 2048 + h * 512 + v0);
            const float x0 = __uint_as_float(vv.x << 16), x1 = __uint_as_float(vv.x & 0xffff0000u), x2 = __uint_as_float(vv.y << 16), x3 = __uint_as_float(vv.y & 0xffff0000u);
            S0 = gamma * S0 + kd * x0; S1 = gamma * S1 + kd * x1; S2 = gamma * S2 + kd * x2; S3 = gamma * S3 + kd * x3;
            const float p0 = wave_sum(qd * S0), p1 = wave_sum(qd * S1), p2 = wave_sum(qd * S2), p3 = wave_sum(qd * S3);
            LAS float* rb = red + (n & 1) * 32;
            if (lane == 0) { rb[wid * 4 + 0] = p0; rb[wid * 4 + 1] = p1; rb[wid * 4 + 2] = p2; rb[wid * 4 + 3] = p3; }
            __syncthreads();
            if (tid < 8) {
                const int hf = tid >> 2, j = tid & 3;
                const float o = rb[(hf * 4 + 0) * 4 + j] + rb[(hf * 4 + 1) * 4 + j] + rb[(hf * 4 + 2) * 4 + j] + rb[(hf * 4 + 3) * 4 + j];
                RO[t * 2048 + h * 512 + vg * 8 + hf * 4 + j] = o;
            }
        }
        __syncthreads();
    }
}
__device__ void ret_norm_phase(LAS unsigned char* lds, const Params& p) {
    const int tid = threadIdx.x, lane = tid & 63, wid = tid >> 6;
    LAS float* red = (LAS float*)lds;
    const bf16_t* u = (const bf16_t*)(p.ws + WS_U);
    const float* RO = (const float*)(p.ws + WS_SCR);
    bf16_t* yin = (bf16_t*)(p.ws + WS_YIN);
    for (int t = blockIdx.x; t < T; t += gridDim.x) {
        const f32x4 o = *(const f32x4*)(RO + (size_t)t * 2048 + tid * 4);
        const float ss = wave_sum(o[0] * o[0] + o[1] * o[1] + o[2] * o[2] + o[3] * o[3]);
        if (lane == 0) red[wid] = ss;
        __syncthreads();
        const float tot = red[(wid & ~1)] + red[(wid | 1)];
        const float rstd = rsqrtf(tot * (1.0f / 512.0f) + 1e-6f);
        const u32x2 gv = *(const u32x2*)(u + (size_t)t * 6144 + 4096 + tid * 4);
        const float g0 = __uint_as_float(gv.x << 16), g1 = __uint_as_float(gv.x & 0xffff0000u), g2 = __uint_as_float(gv.y << 16), g3 = __uint_as_float(gv.y & 0xffff0000u);
        u32x2 w; w.x = pack2(g0 * sigmoidf_(g0) * o[0] * rstd, g1 * sigmoidf_(g1) * o[1] * rstd); w.y = pack2(g2 * sigmoidf_(g2) * o[2] * rstd, g3 * sigmoidf_(g3) * o[3] * rstd);
        *(u32x2*)(yin + (size_t)t * 2048 + tid * 4) = w;
        __syncthreads();
    }
}

__device__ void attn_core_phase(LAS unsigned char* lds, const Params& p) {
    const int tid = threadIdx.x, lane = tid & 63, wid = tid >> 6;
    LAS float* qs = (LAS float*)lds + wid * 640;
    LAS float* ps = qs + 192;
    const bf16_t* u = (const bf16_t*)(p.ws + WS_U);
    bf16_t* yin = (bf16_t*)(p.ws + WS_YIN);
    const int niter = T * 16 / 8;
    for (int it = blockIdx.x; it < niter; it += gridDim.x) {
        const int wu = it * 8 + wid, t = wu >> 4, h = wu & 15, s = t & (SEQ - 1);
        const float slope = exp2f(-0.5f * (float)(h + 1));
        const bf16_t* ut = u + (size_t)t * 9216;
#pragma unroll
        for (int g = 0; g < 3; ++g) qs[g * 64 + lane] = bf2f(ut[g * 1024 + h * 64 + lane]);
        __syncthreads();
        float sc[3][3];
        float mx = -INFINITY;
#pragma unroll
        for (int g = 0; g < 3; ++g) {
            const int dl = (g == 0) ? 1 : (g == 1 ? 4 : 16);
#pragma unroll
            for (int ps_ = 0; ps_ < 3; ++ps_) {
                const int st = ps_ * 64 + lane;
                float v = -INFINITY;
                if (st <= 128 && s - st * dl >= 0) {
                    const bf16_t* kr = u + (size_t)(t - st * dl) * 9216 + (3 + g) * 1024 + h * 64;
                    float a = 0.f;
#pragma unroll
                    for (int c = 0; c < 8; ++c) {
                        const u32x4 kv = *(const u32x4*)(kr + c * 8);
                        a += qs[g * 64 + c * 8 + 0] * __uint_as_float(kv.x << 16) + qs[g * 64 + c * 8 + 1] * __uint_as_float(kv.x & 0xffff0000u);
                        a += qs[g * 64 + c * 8 + 2] * __uint_as_float(kv.y << 16) + qs[g * 64 + c * 8 + 3] * __uint_as_float(kv.y & 0xffff0000u);
                        a += qs[g * 64 + c * 8 + 4] * __uint_as_float(kv.z << 16) + qs[g * 64 + c * 8 + 5] * __uint_as_float(kv.z & 0xffff0000u);
                        a += qs[g * 64 + c * 8 + 6] * __uint_as_float(kv.w << 16) + qs[g * 64 + c * 8 + 7] * __uint_as_float(kv.w & 0xffff0000u);
                    }
                    v = a * 0.125f - slope * (float)(st * dl);
                }
                sc[g][ps_] = v; mx = fmaxf(mx, v);
            }
        }
        mx = wave_max(mx);
        float den = 0.f;
#pragma unroll
        for (int g = 0; g < 3; ++g)
#pragma unroll
            for (int ps_ = 0; ps_ < 3; ++ps_) {
                const int st = ps_ * 64 + lane;
                const float pv = (sc[g][ps_] == -INFINITY) ? 0.f : __expf(sc[g][ps_] - mx);
                den += pv;
                if (st <= 128) ps[g * 129 + st] = pv;
            }
        den = wave_sum(den);
        __syncthreads();
        float o = 0.f;
#pragma unroll
        for (int g = 0; g < 3; ++g) {
            const int dl = (g == 0) ? 1 : (g == 1 ? 4 : 16);
            const int nst = min(128, s / dl);
            for (int st = 0; st <= nst; ++st) o += ps[g * 129 + st] * bf2f(u[(size_t)(t - st * dl) * 9216 + (6 + g) * 1024 + h * 64 + lane]);
        }
        yin[(size_t)t * D + h * 64 + lane] = f2bf(o / den);
        __syncthreads();
    }
}

__device__ void ln_phase(const Params& p, int layer, int which) {
    const int tid = threadIdx.x, lane = tid & 63, wid = tid >> 6;
    float* xf = (float*)(p.ws + WS_XF); bf16_t* xb = (bf16_t*)(p.ws + WS_XB);
    const float* ymix = (const float*)(p.ws + WS_YMIX);
    const float* yrows = (const float*)(p.ws + WS_YROWS);
    int* tope = (int*)(p.ws + WS_TOPE); float* gates = (float*)(p.ws + WS_GATES); int* pos = (int*)(p.ws + WS_POS); const int* dest = (const int*)(p.ws + WS_DEST);
    unsigned* ctl = (unsigned*)(p.ws + WS_CTL);
    const float* gain = p.ln_gain + (size_t)(layer * 2 + which) * D; const float* bias = p.ln_bias + (size_t)(layer * 2 + which) * D;
    const float* wrt = p.moe_w_router + (size_t)layer * D * NEXP; const float* brt = p.moe_b_router + (size_t)layer * NEXP;
    for (int t = blockIdx.x * 8 + wid; t < T; t += gridDim.x * 8) {
        f32x4 z[4];
        if (which == 0) {
#pragma unroll
            for (int i = 0; i < 4; ++i) { const int c = 256 * i + 4 * lane; z[i] = DN_ALPHA * *(const f32x4*)(xf + (size_t)t * D + c) + *(const f32x4*)(ymix + (size_t)t * D + c); }
        } else {
            int dk[4]; float gk[4];
#pragma unroll
            for (int k = 0; k < 4; ++k) { dk[k] = dest[t * 4 + k]; gk[k] = gates[t * 4 + k]; }
#pragma unroll
            for (int i = 0; i < 4; ++i) {
                const int c = 256 * i + 4 * lane;
                f32x4 f = (f32x4){0.f, 0.f, 0.f, 0.f};
#pragma unroll
                for (int k = 0; k < 4; ++k) f += gk[k] * *(const f32x4*)(yrows + (size_t)dk[k] * D + c);
                z[i] = DN_ALPHA * *(const f32x4*)(xf + (size_t)t * D + c) + f;
            }
        }
        float sm = 0.f;
#pragma unroll
        for (int i = 0; i < 4; ++i) sm += (z[i][0] + z[i][1]) + (z[i][2] + z[i][3]);
        const float mean = wave_sum(sm) * (1.0f / D);
        float sq = 0.f;
#pragma unroll
        for (int i = 0; i < 4; ++i) { const f32x4 dd = z[i] - mean; sq += (dd[0] * dd[0] + dd[1] * dd[1]) + (dd[2] * dd[2] + dd[3] * dd[3]); }
        const float rstd = rsqrtf(wave_sum(sq) * (1.0f / D) + LN_EPS);
#pragma unroll
        for (int i = 0; i < 4; ++i) {
            const int c = 256 * i + 4 * lane;
            z[i] = (z[i] - mean) * rstd * *(const f32x4*)(gain + c) + *(const f32x4*)(bias + c);
            *(f32x4*)(xf + (size_t)t * D + c) = z[i];
            u32x2 w; w.x = pack2(z[i][0], z[i][1]); w.y = pack2(z[i][2], z[i][3]);
            *(u32x2*)(xb + (size_t)t * D + c) = w;
            if (which == 1 && layer == DEPTH - 1) *(f32x4*)(p.out + (size_t)t * D + c) = z[i];
        }
        if (which == 0) {
            float lg[NEXP];
#pragma unroll
            for (int e = 0; e < NEXP; ++e) lg[e] = 0.f;
#pragma unroll
            for (int i = 0; i < 4; ++i)
#pragma unroll
                for (int j = 0; j < 4; ++j) {
                    const int c = 256 * i + 4 * lane + j; const float xv = z[i][j];
#pragma unroll
                    for (int e4 = 0; e4 < NEXP / 4; ++e4) { const f32x4 w = *(const f32x4*)(wrt + (size_t)c * NEXP + e4 * 4); lg[e4 * 4 + 0] += xv * w[0]; lg[e4 * 4 + 1] += xv * w[1]; lg[e4 * 4 + 2] += xv * w[2]; lg[e4 * 4 + 3] += xv * w[3]; }
                }
#pragma unroll
            for (int e = 0; e < NEXP; ++e) lg[e] = wave_sum(lg[e]) + brt[e];
            int te[4]; float tv[4]; unsigned used = 0u;
#pragma unroll
            for (int k = 0; k < 4; ++k) {
                float best = -INFINITY; int bi = 0;
#pragma unroll
                for (int e = 0; e < NEXP; ++e) { const bool ok = !((used >> e) & 1u) && lg[e] > best; best = ok ? lg[e] : best; bi = ok ? e : bi; }
                te[k] = bi; tv[k] = best; used |= 1u << bi;
            }
            const float e1 = __expf(tv[1] - tv[0]), e2 = __expf(tv[2] - tv[0]), e3 = __expf(tv[3] - tv[0]);
            const float inv = 1.0f / (1.0f + e1 + e2 + e3);
            if (lane < 4) {
                const int k = lane;
                const int ee = (k == 0) ? te[0] : (k == 1 ? te[1] : (k == 2 ? te[2] : te[3]));
                const float gg = ((k == 0) ? 1.0f : (k == 1 ? e1 : (k == 2 ? e2 : e3))) * inv;
                tope[t * 4 + k] = ee; gates[t * 4 + k] = gg;
                pos[t * 4 + k] = (int)atomicAdd(ctl + CW_CNT + layer * 64 + ee, 1u);
            }
        }
    }
}

__device__ void moe_scatter_phase(LAS unsigned char* lds, const Params& p, int layer) {
    const int tid = threadIdx.x;
    LAS int* pstart = (LAS int*)lds;
    unsigned* ctl = (unsigned*)(p.ws + WS_CTL);
    const int* tope = (const int*)(p.ws + WS_TOPE); const int* pos = (const int*)(p.ws + WS_POS);
    int* dest = (int*)(p.ws + WS_DEST); int* rowtok = (int*)(p.ws + WS_ROWTOK);
    if (tid == 0) {
        int acc = 0;
        for (int e = 0; e < NEXP; ++e) { const int c = (int)ctl[CW_CNT + layer * 64 + e]; pstart[e] = acc; pstart[32 + e] = c; acc += ((c + 255) >> 8) << 8; }
        pstart[64] = acc;
        if (blockIdx.x == 0) {
            ctl[CW_MDYN + layer * 64] = (unsigned)acc;
            for (int e = 0; e < NEXP; ++e) { const int nb = (pstart[32 + e] + 255) >> 8; for (int b = 0; b < nb; ++b) ctl[CW_TEXP + layer * 512 + (pstart[e] >> 8) + b] = (unsigned)e; }
        }
    }
    __syncthreads();
    for (int i = blockIdx.x * NTHREADS + tid; i < T * TOPK; i += gridDim.x * NTHREADS) {
        const int e = tope[i], row = pstart[e] + pos[i];
        dest[i] = row; rowtok[row] = i >> 2;
    }
    for (int i = blockIdx.x * NTHREADS + tid; i < NEXP * 256; i += gridDim.x * NTHREADS) {
        const int e = i >> 8, r = i & 255, c = pstart[32 + e], padded = ((c + 255) >> 8) << 8;
        if (c + r < padded) rowtok[pstart[e] + c + r] = 0;
    }
    __syncthreads();
}

constexpr int PH_PER_LAYER = 9;
constexpr int NPHASES = 1 + DEPTH * PH_PER_LAYER;
constexpr int LDS_BYTES = 96 * 1024;


#define IN(k) (lo <= (k) && (k) < hi)
#if MK_ONE_LAUNCH
#define SEAM(k) do { if (IN(k) && IN((k) + 1)) xcd_barrier_nv(bar.bar, bar.x, bar.st); } while (0)
#else
#define SEAM(k) do {} while (0)
#endif
template <int layer>
__device__ __forceinline__ void run_layer(const Params& p, LAS unsigned char* lds, const XcdBarrier& bar) {
    const int lo = p.ph_lo, hi = p.ph_hi;
    unsigned char* ws = p.ws;
    unsigned* ctl = (unsigned*)(ws + WS_CTL);
        constexpr int base = 1 + layer * PH_PER_LAYER, kind = layer % 3, idx = layer / 3;
        if (IN(base + 0)) {
            GemmS g{}; g.A = (const bf16_t*)(ws + WS_XB); g.lda = D; g.ldb = D; g.M = T; g.K = D; g.Cb = (bf16_t*)(ws + WS_U);
            if (kind == 0) { g.Bt = (const bf16_t*)(ws + WS_AWIN) + (size_t)idx * 2048 * D; g.N = 2048; }
            else if (kind == 1) { g.Bt = (const bf16_t*)(ws + WS_BWIN); g.N = 6144; }
            else { g.Bt = (const bf16_t*)(ws + WS_CWIN); g.N = 9216; }
            g.ldc = g.N;
            gemm_simple<0>(lds, g);
        }
        SEAM(base + 0);
        if (IN(base + 1)) {
            if (kind == 0) lru_gates_phase(lds, p, idx);
            else if (kind == 1) ret_core_phase(lds, p);
            else attn_core_phase(lds, p);
        }
        SEAM(base + 1);
        if (IN(base + 2)) {
            if (kind == 0) lru_scan_phase(p);
            else if (kind == 1) ret_norm_phase(lds, p);
        }
        SEAM(base + 2);
        if (IN(base + 3)) {
            GemmS g{}; g.A = (const bf16_t*)(ws + WS_YIN); g.M = T; g.N = D; g.Cf = (float*)(ws + WS_YMIX); g.ldc = D;
            if (kind == 0) { g.Bt = (const bf16_t*)(ws + WS_AWOUT) + (size_t)idx * D * D; g.K = D; }
            else if (kind == 1) { g.Bt = (const bf16_t*)(ws + WS_BWOUT); g.K = 2048; }
            else { g.Bt = (const bf16_t*)(ws + WS_CWOUT); g.K = D; }
            g.lda = g.K; g.ldb = g.K;
            gemm_simple<0>(lds, g);
        }
        SEAM(base + 3);
        if (IN(base + 4)) ln_phase(p, layer, 0);
        SEAM(base + 4);
        if (IN(base + 5)) moe_scatter_phase(lds, p, layer);
        SEAM(base + 5);
        if (IN(base + 6)) {
            GemmS g{}; g.A = (const bf16_t*)(ws + WS_XB); g.lda = D; g.Bt = (const bf16_t*)(ws + WS_GU) + (size_t)layer * NEXP * 2048 * D; g.ldb = D; g.N = 2048; g.K = D;
            g.Mdyn = ctl + CW_MDYN + layer * 64; g.row_idx = (const int*)(ws + WS_ROWTOK); g.tile_exp = ctl + CW_TEXP + layer * 512; g.b_exp_stride = (size_t)2048 * D;
            g.bias = p.moe_b_gu + (size_t)layer * NEXP * 2048; g.bias_es = 2048; g.Cb = (bf16_t*)(ws + WS_HID); g.ldc = D;
            gemm_simple<1>(lds, g);
        }
        SEAM(base + 6);
        if (IN(base + 7)) {
            GemmS g{}; g.A = (const bf16_t*)(ws + WS_HID); g.lda = D; g.Bt = (const bf16_t*)(ws + WS_DN) + (size_t)layer * NEXP * D * D; g.ldb = D; g.N = D; g.K = D;
            g.Mdyn = ctl + CW_MDYN + layer * 64; g.tile_exp = ctl + CW_TEXP + layer * 512; g.b_exp_stride = (size_t)D * D;
            g.bias = p.moe_b_down + (size_t)layer * NEXP * D; g.bias_es = D; g.Cf = (float*)(ws + WS_YROWS); g.ldc = D;
            gemm_simple<2>(lds, g);
        }
        SEAM(base + 7);
        if (IN(base + 8)) ln_phase(p, layer, 1);
        SEAM(base + 8);
    }
#undef IN
#undef SEAM
__global__ void __launch_bounds__(NTHREADS, 2) fwd_kernel(Params p) {
    extern __shared__ __attribute__((aligned(16))) unsigned char lds_raw[];
    LAS unsigned char* lds = (LAS unsigned char*)lds_raw;
    const int lo = p.ph_lo, hi = p.ph_hi;
    unsigned char* ws = p.ws;
    unsigned* ctl = (unsigned*)(ws + WS_CTL);
#if MK_ONE_LAUNCH
    volatile LAS unsigned* bst = (volatile LAS unsigned*)(lds + LDS_BYTES - 16);
    if (threadIdx.x == 0) { bst[0] = 0u; bst[1] = 0u; bst[2] = 0u; bst[3] = 0u; }
    __syncthreads();
    XcdBarrier bar = xcd_barrier_post(ctl, bst);
#define GRID_BAR() xcd_barrier_nv(bar.bar, bar.x, bar.st)
#else
    XcdBarrier bar; bar.bar = ctl; bar.x = 0; bar.st = nullptr;
#define GRID_BAR() do {} while (0)
#endif
#define IN(k) (lo <= (k) && (k) < hi)
#define SEAM(k) do { if (IN(k) && IN((k) + 1)) GRID_BAR(); } while (0)

    if (IN(0)) {
        LAS float* tile = (LAS float*)lds;
        for (int l = 0; l < 2; ++l) {
            convert_job(tile, p.a_w_in + (size_t)l * D * 2048, (bf16_t*)(ws + WS_AWIN) + (size_t)l * 2048 * D, D, 2048, 1);
            convert_job(tile, p.a_w_out + (size_t)l * D * D, (bf16_t*)(ws + WS_AWOUT) + (size_t)l * D * D, D, D, 1);
        }
        convert_job(tile, p.b_w_in, (bf16_t*)(ws + WS_BWIN), D, 6144, 1);
        convert_job(tile, p.b_w_out, (bf16_t*)(ws + WS_BWOUT), 2048, D, 1);
        convert_job(tile, p.c_w_in, (bf16_t*)(ws + WS_CWIN), D, 9216, 1);
        convert_job(tile, p.c_w_out, (bf16_t*)(ws + WS_CWOUT), D, D, 1);
        convert_job(tile, p.moe_w_gu, (bf16_t*)(ws + WS_GU), D, 2048, DEPTH * NEXP);
        convert_job(tile, p.moe_w_down, (bf16_t*)(ws + WS_DN), D, D, DEPTH * NEXP);
        float* xf = (float*)(ws + WS_XF); bf16_t* xb = (bf16_t*)(ws + WS_XB);
        for (size_t i = (size_t)blockIdx.x * NTHREADS + threadIdx.x; i < (size_t)T * D / 4; i += (size_t)gridDim.x * NTHREADS) {
            const f32x4 v = *(const f32x4*)(p.x + i * 4);
            *(f32x4*)(xf + i * 4) = v;
            u32x2 w; w.x = pack2(v[0], v[1]); w.y = pack2(v[2], v[3]); *(u32x2*)(xb + i * 4) = w;
        }
    }
    SEAM(0);

    run_layer<0>(p, lds, bar); run_layer<1>(p, lds, bar); run_layer<2>(p, lds, bar); run_layer<3>(p, lds, bar);
#undef IN
#undef SEAM
}

extern "C" void kernel_launch(void* const* d_in, const int* in_sizes, int n_in, void* d_out, int out_size, void* d_ws, size_t ws_size, hipStream_t stream) {
    static int grid = 0;
    if (grid == 0) {
        if (n_in != 22 || out_size != T * D || ws_size < WS_END) { fprintf(stderr, "kernel_launch: unexpected shapes (n_in %d out %d ws %zu need %zu)\n", n_in, out_size, ws_size, (size_t)WS_END); grid = -1; return; }
        if (hipFuncSetAttribute((const void*)fwd_kernel, hipFuncAttributeMaxDynamicSharedMemorySize, LDS_BYTES) != hipSuccess) { fprintf(stderr, "kernel_launch: hipFuncSetAttribute failed\n"); grid = -1; return; }
        int dev = 0, cus = 0;
        if (hipGetDevice(&dev) != hipSuccess || hipDeviceGetAttribute(&cus, hipDeviceAttributeMultiprocessorCount, dev) != hipSuccess) { grid = -1; return; }
        grid = cus;
    }
    if (grid < 0) return;
    (void)hipMemsetAsync((char*)d_ws + WS_CTL, 0, CTL_BYTES, stream);
    Params p{};
    const float** pp = (const float**)&p;
    for (int i = 0; i < 22; ++i) pp[i] = (const float*)d_in[i];
    p.out = (float*)d_out; p.ws = (unsigned char*)d_ws;
#if MK_ONE_LAUNCH
    p.ph_lo = 0; p.ph_hi = NPHASES;
    hipLaunchKernelGGL(fwd_kernel, dim3(grid), dim3(NTHREADS), LDS_BYTES, stream, p);
#else
    for (int ph = 0; ph < NPHASES; ++ph) {
        if (ph > 0) { const int k = (ph - 1) % PH_PER_LAYER, layer = (ph - 1) / PH_PER_LAYER; if (k == 2 && layer % 3 == 2) continue; }
        p.ph_lo = ph; p.ph_hi = ph + 1;
        hipLaunchKernelGGL(fwd_kernel, dim3(grid), dim3(NTHREADS), LDS_BYTES, stream, p);
    }
#endif
}
```

```cpp
#include <hip/hip_runtime.h>
#include <stdint.h>
#include <stdio.h>

#ifndef MK_ONE_LAUNCH
#define MK_ONE_LAUNCH 1
#endif

#define LAS __attribute__((address_space(3)))
typedef unsigned short bf16_t;
typedef short bf16x8 __attribute__((ext_vector_type(8)));
typedef float f32x4 __attribute__((ext_vector_type(4)));
typedef unsigned u32x4 __attribute__((ext_vector_type(4)));
typedef unsigned u32x2 __attribute__((ext_vector_type(2)));

constexpr int T = 16384, D = 1024, SEQ = 2048, NBATCH = 8, DEPTH = 4;
constexpr int NEXP = 32, TOPK = 4;
constexpr int MAXROWS = 73728;
constexpr float DN_ALPHA = 1.681792830507429f;
constexpr float LN_EPS = 1e-5f;
constexpr int NTHREADS = 512;

constexpr size_t MB = 1ull << 20;
constexpr size_t WS_CTL = 0;
constexpr size_t CTL_BYTES = 65536;
constexpr size_t WS_AWIN = 1 * MB;
constexpr size_t WS_AWOUT = WS_AWIN + 8 * MB;
constexpr size_t WS_BWIN = WS_AWOUT + 4 * MB;
constexpr size_t WS_BWOUT = WS_BWIN + 12 * MB;
constexpr size_t WS_CWIN = WS_BWOUT + 4 * MB;
constexpr size_t WS_CWOUT = WS_CWIN + 18 * MB;
constexpr size_t WS_GU = WS_CWOUT + 2 * MB;
constexpr size_t WS_DN = WS_GU + 512 * MB;
constexpr size_t WS_XF = WS_DN + 256 * MB;
constexpr size_t WS_XB = WS_XF + 64 * MB;
constexpr size_t WS_U = WS_XB + 32 * MB;
constexpr size_t WS_YIN = WS_U + 288 * MB;
constexpr size_t WS_YMIX = WS_YIN + 64 * MB;
constexpr size_t WS_SCR = WS_YMIX + 64 * MB;
constexpr size_t WS_TOPE = WS_SCR + 128 * MB;
constexpr size_t WS_GATES = WS_TOPE + 256 * 1024;
constexpr size_t WS_POS = WS_GATES + 256 * 1024;
constexpr size_t WS_DEST = WS_POS + 256 * 1024;
constexpr size_t WS_ROWTOK = WS_DEST + 256 * 1024;
constexpr size_t WS_HID = WS_ROWTOK + 1 * MB;
constexpr size_t WS_YROWS = WS_HID + 144 * MB;
constexpr size_t WS_END = WS_YROWS + 288 * MB;

constexpr int CW_CNT = 4096;
constexpr int CW_MDYN = 8192;
constexpr int CW_TEXP = 12288;

#define XB_TMO      128
#define XB_XCNT(j)  (256  + 64 * (j))
#define XB_XSUB(j)  (1280 + 64 * (j))
#define XB_XGEN(j)  (2304 + 64 * (j))
#define XB_TOP      3328
#define XB_TOPGEN   3392
#define XCD_BAR_WORDS 3456
#define XB_SPIN_CAP (1u << 22)

__device__ __forceinline__ unsigned xb_ld(unsigned* p)              { return __hip_atomic_load(p, __ATOMIC_RELAXED, __HIP_MEMORY_SCOPE_AGENT); }
__device__ __forceinline__ unsigned xb_add(unsigned* p, unsigned v) { return __hip_atomic_fetch_add(p, v, __ATOMIC_RELAXED, __HIP_MEMORY_SCOPE_AGENT); }
__device__ __forceinline__ unsigned xb_xcc_id() { return (unsigned)__builtin_amdgcn_s_getreg((3 << 11) | 20) & 0xFu; }
#define XB_SPIN(cond, bar) do { unsigned _sp = 0; while (cond) { __builtin_amdgcn_s_sleep(1); \
    if ((++_sp & 255u) == 0u) { if (xb_ld(&(bar)[XB_TMO])) break; if (_sp > XB_SPIN_CAP) { atomicAdd(&(bar)[XB_TMO], 1u); break; } } } } while (0)

struct XcdBarrier { unsigned* bar; unsigned x; volatile LAS unsigned* st; };

__device__ __forceinline__ XcdBarrier xcd_barrier_post(unsigned* bar, volatile LAS unsigned* st) {
    XcdBarrier b; b.bar = bar; b.x = xb_xcc_id(); b.st = st;
    if (threadIdx.x == 0) (void)xb_add(&bar[XB_XCNT(b.x)], 1u);
    return b;
}
__device__ __forceinline__ void xcd_barrier_complete(unsigned* bar, unsigned x, unsigned& nloc, unsigned& nx) {
    const unsigned G = gridDim.x * gridDim.y * gridDim.z;
    unsigned sum, cnt, mine, sp = 0u;
    for (;;) {
        sum = 0u; cnt = 0u; mine = 0u;
#pragma unroll
        for (unsigned j = 0; j < 16; ++j) { const unsigned c = xb_ld(&bar[XB_XCNT(j)]); sum += c; cnt += (c > 0u) ? 1u : 0u; mine = (j == x) ? c : mine; }
        if (sum == G) break;
        __builtin_amdgcn_s_sleep(1);
        if ((++sp & 255u) == 0u) { if (xb_ld(&bar[XB_TMO])) break; if (sp > XB_SPIN_CAP) { atomicAdd(&bar[XB_TMO], 1u); break; } }
    }
    nloc = mine > 0u ? mine : 1u; nx = cnt > 0u ? cnt : 1u;
}
__device__ __noinline__ void xcd_barrier_nv(unsigned* bbar, unsigned bx, volatile LAS unsigned* bst) {
    XcdBarrier b; b.bar = bbar; b.x = bx; b.st = bst;
    asm volatile("s_waitcnt vmcnt(0)" ::: "memory");
    __syncthreads();
    if (threadIdx.x == 0) {
        unsigned* bar = b.bar;
        __builtin_amdgcn_s_waitcnt(0);
        unsigned nloc = b.st[0], nx = b.st[1];
        if (nloc == 0u) { xcd_barrier_complete(bar, b.x, nloc, nx); b.st[0] = nloc; b.st[1] = nx; }
        const unsigned old = xb_add(&bar[XB_XSUB(b.x)], 1u);
        const unsigned gen = old / nloc;
        if (old + 1u == (gen + 1u) * nloc) {
            __builtin_amdgcn_fence(__ATOMIC_RELEASE, "agent");
            asm volatile("s_waitcnt vmcnt(0)" ::: "memory");
            const unsigned og = xb_add(&bar[XB_TOP], 1u);
            const unsigned tg = og / nx;
            if (og + 1u == (tg + 1u) * nx) xb_add(&bar[XB_TOPGEN], 1u);
            else XB_SPIN(xb_ld(&bar[XB_TOPGEN]) == tg, bar);
            __builtin_amdgcn_fence(__ATOMIC_ACQUIRE, "agent");
            xb_add(&bar[XB_XGEN(b.x)], 1u);
            asm volatile("s_waitcnt vmcnt(0)" ::: "memory");
        } else {
            XB_SPIN(xb_ld(&bar[XB_XGEN(b.x)]) == gen, bar);
            __builtin_amdgcn_fence(__ATOMIC_ACQUIRE, "agent");
            asm volatile("s_waitcnt vmcnt(0)" ::: "memory");
        }
    }
    __syncthreads();
}

__device__ __forceinline__ int tid_() { int t = threadIdx.x; asm volatile("" : "+v"(t)); return t; }
__device__ __forceinline__ float bf2f(bf16_t v) { return __uint_as_float(((unsigned)v) << 16); }
__device__ __forceinline__ bf16_t f2bf(float f) { unsigned u = __float_as_uint(f); u += 0x7FFFu + ((u >> 16) & 1u); return (bf16_t)(u >> 16); }
__device__ __forceinline__ unsigned pack2(float lo, float hi) { return (unsigned)f2bf(lo) | ((unsigned)f2bf(hi) << 16); }
__device__ __forceinline__ float wave_sum(float v) {
#pragma unroll
    for (int o = 32; o >= 1; o >>= 1) v += __shfl_xor(v, o);
    return v;
}
__device__ __forceinline__ float wave_max(float v) {
#pragma unroll
    for (int o = 32; o >= 1; o >>= 1) v = fmaxf(v, __shfl_xor(v, o));
    return v;
}
__device__ __forceinline__ float sigmoidf_(float x) { return 1.0f / (1.0f + __expf(-x)); }
__device__ __forceinline__ float gelu_tanh(float x) { const float u = 0.7978845608028654f * (x + 0.044715f * x * x * x); return 0.5f * x * (1.0f + tanhf(u)); }
__device__ __forceinline__ float swiglu(float gate, float up) {
    const float g = fminf(gate, 7.0f), u = fminf(fmaxf(up, -7.0f), 7.0f);
    return (u + 1.0f) * g * sigmoidf_(1.702f * g);
}

struct Params {
    const float* x; const float* a_w_in; const float* a_conv_w; const float* a_conv_b; const float* a_w_rgate; const float* a_b_rgate;
    const float* a_w_igate; const float* a_b_igate; const float* a_lambda; const float* a_w_out; const float* b_w_in; const float* b_w_out;
    const float* c_w_in; const float* c_w_out; const float* ln_gain; const float* ln_bias; const float* moe_w_router; const float* moe_b_router;
    const float* moe_w_gu; const float* moe_b_gu; const float* moe_w_down; const float* moe_b_down;
    float* out; unsigned char* ws;
    int ph_lo, ph_hi;
};

__device__ void convert_job(LAS float* tile, const float* src, bf16_t* dst, int K, int N, int batch) {
    const int tid = tid_();
    const int tk = K / 64, tn = N / 64, per = tk * tn; const long total = (long)per * batch;
    for (long u = blockIdx.x; u < total; u += gridDim.x) {
        const int bidx = (int)(u / per), r = (int)(u % per), kt = r / tn, nt = r % tn;
        const float* s = src + (size_t)bidx * K * N + (size_t)(kt * 64) * N + nt * 64;
#pragma unroll
        for (int pass = 0; pass < 2; ++pass) {
            const int row = (tid >> 4) + 32 * pass, c4 = tid & 15;
            const f32x4 v = *(const f32x4*)(s + (size_t)row * N + c4 * 4);
            tile[row * 65 + c4 * 4 + 0] = v[0]; tile[row * 65 + c4 * 4 + 1] = v[1]; tile[row * 65 + c4 * 4 + 2] = v[2]; tile[row * 65 + c4 * 4 + 3] = v[3];
        }
        __syncthreads();
        {
            const int n = tid >> 3, k8 = tid & 7;
            float v[8];
#pragma unroll
            for (int j = 0; j < 8; ++j) v[j] = tile[(k8 * 8 + j) * 65 + n];
            u32x4 w; w.x = pack2(v[0], v[1]); w.y = pack2(v[2], v[3]); w.z = pack2(v[4], v[5]); w.w = pack2(v[6], v[7]);
            *(u32x4*)(dst + (size_t)bidx * N * K + (size_t)(nt * 64 + n) * K + kt * 64 + k8 * 8) = w;
        }
        __syncthreads();
    }
}

struct GemmS {
    const bf16_t* A; int lda;
    const bf16_t* Bt; int ldb;
    int M, N, K;
    const unsigned* Mdyn;
    const int* row_idx;
    const unsigned* tile_exp;
    size_t b_exp_stride;
    const float* bias; int bias_es;
    float* Cf; bf16_t* Cb; int ldc;
};
template <int MODE>
__device__ void gemm_simple(LAS unsigned char* lds, const GemmS& g) {
    const int tid = tid_(), lane = tid & 63, wid = tid >> 6, wr = wid >> 1, wc = wid & 1, fr = lane & 15, fq = lane >> 4;
    const int M = g.Mdyn ? (int)*g.Mdyn : g.M;
    const int tiles_n = (MODE == 1) ? (g.N / 256) * 2 : g.N / 128;
    const int tiles_m = M / 128, nunits = tiles_m * tiles_n, nk = g.K / 32;
    LAS bf16_t* As = (LAS bf16_t*)lds;
    LAS bf16_t* Bs = As + 2 * 128 * 40;
    const int lrow = tid >> 2, lch = tid & 3;
    for (int u = blockIdx.x; u < nunits; u += gridDim.x) {
        const int tm = u / tiles_n, tn = u % tiles_n, m0 = tm * 128;
        const int e = (MODE != 0) ? (int)g.tile_exp[m0 >> 8] : 0;
        const bf16_t* Bbase = g.Bt + (size_t)e * g.b_exp_stride;
        int arow = m0 + lrow; if (MODE == 1) arow = g.row_idx[arow];
        int brow;
        if (MODE == 1) { const int bwc = lrow >> 6, ni = (lrow & 63) >> 4, r = lrow & 15; brow = ((ni & 1) ? 1024 : 0) + tn * 64 + bwc * 32 + (ni >> 1) * 16 + r; }
        else brow = tn * 128 + lrow;
        const bf16_t* ap = g.A + (size_t)arow * g.lda + lch * 8;
        const bf16_t* bp = Bbase + (size_t)brow * g.ldb + lch * 8;
        f32x4 acc[2][4];
#pragma unroll
        for (int mi = 0; mi < 2; ++mi)
#pragma unroll
            for (int ni = 0; ni < 4; ++ni) acc[mi][ni] = (f32x4){0.f, 0.f, 0.f, 0.f};
        u32x4 ra = *(const u32x4*)ap, rb = *(const u32x4*)bp;
        *(LAS u32x4*)(As + lrow * 40 + lch * 8) = ra; *(LAS u32x4*)(Bs + lrow * 40 + lch * 8) = rb;
        __syncthreads();
        for (int kt = 0; kt < nk; ++kt) {
            const int cur = kt & 1;
            if (kt + 1 < nk) { ra = *(const u32x4*)(ap + (kt + 1) * 32); rb = *(const u32x4*)(bp + (kt + 1) * 32); }
            bf16x8 af[2], bfr[4];
#pragma unroll
            for (int mi = 0; mi < 2; ++mi) af[mi] = *(const LAS bf16x8*)(As + cur * 5120 + (wr * 32 + mi * 16 + fr) * 40 + fq * 8);
#pragma unroll
            for (int ni = 0; ni < 4; ++ni) bfr[ni] = *(const LAS bf16x8*)(Bs + cur * 5120 + (wc * 64 + ni * 16 + fr) * 40 + fq * 8);
#pragma unroll
            for (int mi = 0; mi < 2; ++mi)
#pragma unroll
                for (int ni = 0; ni < 4; ++ni) acc[mi][ni] = __builtin_amdgcn_mfma_f32_16x16x32_bf16(bfr[ni], af[mi], acc[mi][ni], 0, 0, 0);
            if (kt + 1 < nk) { *(LAS u32x4*)(As + (cur ^ 1) * 5120 + lrow * 40 + lch * 8) = ra; *(LAS u32x4*)(Bs + (cur ^ 1) * 5120 + lrow * 40 + lch * 8) = rb; }
            __syncthreads();
        }
#pragma unroll
        for (int mi = 0; mi < 2; ++mi) {
            const int m = m0 + wr * 32 + mi * 16 + fr;
            if (MODE == 1) {
#pragma unroll
                for (int q = 0; q < 2; ++q) {
                    const int hc = tn * 64 + wc * 32 + q * 16 + 4 * fq;
                    const f32x4 bg = *(const f32x4*)(g.bias + (size_t)e * g.bias_es + hc), bu = *(const f32x4*)(g.bias + (size_t)e * g.bias_es + 1024 + hc);
                    const f32x4 gt = acc[mi][2 * q] + bg, up = acc[mi][2 * q + 1] + bu;
                    u32x2 w; w.x = pack2(swiglu(gt[0], up[0]), swiglu(gt[1], up[1])); w.y = pack2(swiglu(gt[2], up[2]), swiglu(gt[3], up[3]));
                    *(u32x2*)(g.Cb + (size_t)m * g.ldc + hc) = w;
                }
            } else {
#pragma unroll
                for (int ni = 0; ni < 4; ++ni) {
                    const int n = tn * 128 + wc * 64 + ni * 16 + 4 * fq;
                    f32x4 v = acc[mi][ni];
                    if (g.bias) v += *(const f32x4*)(g.bias + (size_t)e * g.bias_es + n);
                    if (g.Cf) *(f32x4*)(g.Cf + (size_t)m * g.ldc + n) = v;
                    else { u32x2 w; w.x = pack2(v[0], v[1]); w.y = pack2(v[2], v[3]); *(u32x2*)(g.Cb + (size_t)m * g.ldc + n) = w; }
                }
            }
        }
    }
}


namespace g8 {
constexpr int BM = 256, BK = 64, HALF = 128, HTB = HALF * BK * 2, STAGE_BYTES = 8 * HTB, NXCD = 8, WGM = 8;
__device__ __forceinline__ int lds_byte(int r, int c) { const int st = (r >> 4) * 2 + (c >> 5), rr = r & 15, cc = c & 31, ob = rr * 64 + cc * 2; return st * 1024 + (ob ^ (((ob >> 9) & 1) << 5)); }
__device__ __forceinline__ void stage_rc(int b, int& R, int& C) { const int st = b / 1024, sb = b % 1024, swz = sb ^ (((sb >> 9) & 1) << 5); R = (st >> 1) * 16 + swz / 64; C = (st & 1) * 32 + (swz % 64) / 2; }
__device__ __forceinline__ int perm32(int rho) { const int n = rho >> 4, i = rho & 15; return 8 * (i >> 2) + 4 * n + (i & 3); }
__device__ __forceinline__ unsigned cvt_pk_bf16(float lo, float hi) { unsigned r; asm volatile("v_cvt_pk_bf16_f32 %0, %1, %2" : "=v"(r) : "v"(lo), "v"(hi)); return r; }

struct Unit { const char* a0; const char* a1; const char* b0; const char* b1; const int* rows; int row0, col0, e; };

struct SchedPlain {
    const char* A; const char* Bt; size_t hstepA, hstepB; int nM, nN, nwg, G, c;
    __device__ __forceinline__ void init(const void* A_, const void* Bt_, int M, int N, int K, int G_, int c_) { A = (const char*)A_; Bt = (const char*)Bt_; hstepA = (size_t)HALF * K * 2; hstepB = hstepA; nM = M / BM; nN = N / BM; nwg = nM * nN; G = G_; c = c_; }
    __device__ __forceinline__ bool next(int i, Unit& u) const {
        const long L = (long)i * G + c; if (L >= nwg) return false;
        int wgid = (int)L; { const int q = nwg / NXCD, r = nwg % NXCD, xcd = wgid % NXCD, off = wgid / NXCD; wgid = (xcd < r ? xcd * (q + 1) : r * (q + 1) + (xcd - r) * q) + off; }
        const int nig = WGM * nN, gid = wgid / nig, fm = gid * WGM, gsz = (nM - fm) < WGM ? (nM - fm) : WGM;
        const int pm = fm + ((wgid % nig) % gsz), pn = (wgid % nig) / gsz;
        u.a0 = A + (size_t)pm * 2 * hstepA; u.a1 = u.a0 + hstepA; u.b0 = Bt + (size_t)pn * 2 * hstepB; u.b1 = u.b0 + hstepB; u.rows = nullptr; u.row0 = pm * BM; u.col0 = pn * BM; u.e = 0;
        return true;
    }
};
struct SchedGU {
    const char* A; const char* W; const int* rowtok; const unsigned* texp; int ntiles, G, c;
    __device__ __forceinline__ bool next(int i, Unit& u) const {
        const int L = i * G + c, rt = L >> 3, pn = L & 7; if (rt >= ntiles) return false;
        const int e = (int)texp[rt];
        u.a0 = A; u.a1 = A; u.rows = rowtok + rt * BM; u.b0 = W + ((size_t)e * 2048 + pn * 128) * (D * 2); u.b1 = u.b0 + (size_t)1024 * D * 2; u.row0 = rt * BM; u.col0 = pn * 128; u.e = e;
        return true;
    }
};
struct SchedDown {
    const char* A; const char* W; const unsigned* texp; int ntiles, G, c;
    __device__ __forceinline__ bool next(int i, Unit& u) const {
        const int L = i * G + c, rt = L >> 2, pn = L & 3; if (rt >= ntiles) return false;
        const int e = (int)texp[rt];
        u.a0 = A + (size_t)rt * BM * D * 2; u.a1 = u.a0 + (size_t)HALF * D * 2; u.rows = nullptr; u.b0 = W + ((size_t)e * 1024 + pn * BM) * (D * 2); u.b1 = u.b0 + (size_t)HALF * D * 2; u.row0 = rt * BM; u.col0 = pn * BM; u.e = e;
        return true;
    }
};

struct EpiF32 {
    static constexpr bool PERM = false;
    float* C; int ldc; const float* bias; int bias_es;
    __device__ __forceinline__ void operator()(const f32x4 (&acc)[2][2][4][2], const Unit& u, int wr, int wc, int fr, int fq) const {
        const int row0 = u.row0 + wr * 64 + fr, col0 = u.col0 + wc * 32 + 4 * fq;
        f32x4 bv[2][2];
#pragma unroll
        for (int bj = 0; bj < 2; ++bj)
#pragma unroll
            for (int n = 0; n < 2; ++n) bv[bj][n] = bias ? *(const f32x4*)(bias + (size_t)u.e * bias_es + col0 + bj * HALF + n * 16) : (f32x4){0.f, 0.f, 0.f, 0.f};
#pragma unroll
        for (int ai = 0; ai < 2; ++ai)
#pragma unroll
            for (int m = 0; m < 4; ++m) { float* rowp = C + (size_t)(row0 + ai * HALF + m * 16) * ldc + col0;
#pragma unroll
                for (int bj = 0; bj < 2; ++bj)
#pragma unroll
                    for (int n = 0; n < 2; ++n) *(f32x4*)(rowp + bj * HALF + n * 16) = acc[ai][bj][m][n] + bv[bj][n]; }
    }
};
struct EpiBf16 {
    static constexpr bool PERM = true;
    bf16_t* O; int ldc;
    __device__ __forceinline__ void operator()(const f32x4 (&acc)[2][2][4][2], const Unit& u, int wr, int wc, int fr, int fq) const {
        const int row0 = u.row0 + wr * 64 + fr, col0 = u.col0 + wc * 32 + 8 * fq;
#pragma unroll
        for (int ai = 0; ai < 2; ++ai)
#pragma unroll
            for (int m = 0; m < 4; ++m) { bf16_t* rowp = O + (size_t)(row0 + ai * HALF + m * 16) * ldc + col0;
#pragma unroll
                for (int bj = 0; bj < 2; ++bj) { const f32x4 v0 = acc[ai][bj][m][0], v1 = acc[ai][bj][m][1];
                    u32x4 w; w.x = cvt_pk_bf16(v0[0], v0[1]); w.y = cvt_pk_bf16(v0[2], v0[3]); w.z = cvt_pk_bf16(v1[0], v1[1]); w.w = cvt_pk_bf16(v1[2], v1[3]);
                    *(u32x4*)(rowp + bj * HALF) = w; } }
    }
};
struct EpiSwiglu {
    static constexpr bool PERM = true;
    bf16_t* O; const float* bias;
    __device__ __forceinline__ void operator()(const f32x4 (&acc)[2][2][4][2], const Unit& u, int wr, int wc, int fr, int fq) const {
        const int row0 = u.row0 + wr * 64 + fr, hc = u.col0 + wc * 32 + 8 * fq;
        const float* bp = bias + (size_t)u.e * 2048 + hc;
        const f32x4 bg0 = *(const f32x4*)(bp), bg1 = *(const f32x4*)(bp + 4), bu0 = *(const f32x4*)(bp + 1024), bu1 = *(const f32x4*)(bp + 1028);
#pragma unroll
        for (int ai = 0; ai < 2; ++ai)
#pragma unroll
            for (int m = 0; m < 4; ++m) {
                const f32x4 g0 = acc[ai][0][m][0] + bg0, g1 = acc[ai][0][m][1] + bg1, u0 = acc[ai][1][m][0] + bu0, u1 = acc[ai][1][m][1] + bu1;
                u32x4 w; w.x = cvt_pk_bf16(swiglu(g0[0], u0[0]), swiglu(g0[1], u0[1])); w.y = cvt_pk_bf16(swiglu(g0[2], u0[2]), swiglu(g0[3], u0[3]));
                w.z = cvt_pk_bf16(swiglu(g1[0], u1[0]), swiglu(g1[1], u1[1])); w.w = cvt_pk_bf16(swiglu(g1[2], u1[2]), swiglu(g1[3], u1[3]));
                *(u32x4*)(O + (size_t)(row0 + ai * HALF + m * 16) * D + hc) = w;
            }
    }
};

template <class Epi, class Sched, bool GATHER>
__device__ __forceinline__ void gemm_phase(LAS unsigned char* lds, const int K, const Sched& S, const Epi& E) {
    const int tid = tid_(), wid = __builtin_amdgcn_readfirstlane(tid >> 6), lane = tid & 63, wr = wid >> 2, wc = wid & 3, fr = lane & 15, fq = lane >> 4;
    const int nt = K / BK;
    int sR[2], sC[2];
    unsigned voffB[2];
#pragma unroll
    for (int i = 0; i < 2; ++i) { stage_rc(tid * 16 + i * 8192, sR[i], sC[i]); const int Rb = Epi::PERM ? ((sR[i] & ~31) + perm32(sR[i] & 31)) : sR[i]; voffB[i] = (unsigned)(Rb * K + sC[i]) * 2u; }
    unsigned cvA0[2], cvA1[2], nvA0[2], nvA1[2];
#define G8_VOFF(u, v0, v1) do { _Pragma("unroll") for (int _i = 0; _i < 2; ++_i) { \
        if (GATHER) { v0[_i] = (unsigned)((u).rows[sR[_i]] * K + sC[_i]) * 2u; v1[_i] = (unsigned)((u).rows[HALF + sR[_i]] * K + sC[_i]) * 2u; } \
        else { v0[_i] = (unsigned)(sR[_i] * K + sC[_i]) * 2u; v1[_i] = v0[_i]; } } } while (0)
    const size_t kstep = (size_t)(BK * 2);
    const unsigned ldsw = (unsigned)wid * 1024u;
    const int aoff = lds_byte(wr * 64 + fr, fq * 8), boff = lds_byte(wc * 32 + fr, fq * 8);
#define PG8_SA(b, h) (((b) * 2 + (h)) * HTB)
#define PG8_SB(b, h) ((4 + (b) * 2 + (h)) * HTB)
#define PG8_STAGE(bufoff, gbase, voff) do { _Pragma("unroll") for (int _i = 0; _i < 2; ++_i) \
        __builtin_amdgcn_global_load_lds((const unsigned*)((const char*)(gbase) + (voff)[_i]), (LAS unsigned*)(lds + (bufoff) + ldsw + _i * 8192), 16, 0, 0); } while (0)
#define PG8_LDA(dst, b, h) do { _Pragma("unroll") for (int m = 0; m < 4; ++m) _Pragma("unroll") for (int k = 0; k < 2; ++k) dst[m][k] = *(const LAS bf16x8*)(lds + PG8_SA(b, h) + aoff + m * 2048 + k * 1024); } while (0)
#define PG8_LDB(dst, b, h) do { _Pragma("unroll") for (int n = 0; n < 2; ++n) _Pragma("unroll") for (int k = 0; k < 2; ++k) dst[n][k] = *(const LAS bf16x8*)(lds + PG8_SB(b, h) + boff + n * 2048 + k * 1024); } while (0)
#define PG8_MMA(ai, bj, At, Bt) do { __builtin_amdgcn_s_setprio(1); _Pragma("unroll") for (int m = 0; m < 4; ++m) _Pragma("unroll") for (int n = 0; n < 2; ++n) _Pragma("unroll") for (int k = 0; k < 2; ++k) \
        acc[ai][bj][m][n] = __builtin_amdgcn_mfma_f32_16x16x32_bf16(Bt[n][k], At[m][k], acc[ai][bj][m][n], 0, 0, 0); __builtin_amdgcn_s_setprio(0); } while (0)
#define PG8_WAIT_V(n) asm volatile("s_waitcnt vmcnt(" #n ")" ::: "memory")
#define PG8_WAIT_L(n) asm volatile("s_waitcnt lgkmcnt(" #n ")" ::: "memory")
#define PG8_BAR __builtin_amdgcn_s_barrier()
#define PG8_SCHED __builtin_amdgcn_sched_barrier(0)
    Unit cur, nxt; int ui = 0;
    if (!S.next(0, cur)) return;
    f32x4 acc[2][2][4][2];
#pragma unroll
    for (int a = 0; a < 2; ++a)
#pragma unroll
        for (int b = 0; b < 2; ++b)
#pragma unroll
            for (int m = 0; m < 4; ++m)
#pragma unroll
                for (int n = 0; n < 2; ++n) acc[a][b][m][n] = (f32x4){0.f, 0.f, 0.f, 0.f};
    bf16x8 At[4][2], B0[2][2], B1[2][2];
    const char* cA0 = cur.a0; const char* cA1 = cur.a1; const char* cB0 = cur.b0; const char* cB1 = cur.b1;
    G8_VOFF(cur, cvA0, cvA1);
    PG8_STAGE(PG8_SB(0, 0), cB0, voffB); PG8_STAGE(PG8_SB(0, 1), cB1, voffB); PG8_STAGE(PG8_SA(0, 0), cA0, cvA0); PG8_STAGE(PG8_SA(0, 1), cA1, cvA1);
    if (wr == 1) PG8_BAR;
    PG8_WAIT_V(2); PG8_BAR;
    PG8_STAGE(PG8_SB(1, 0), cB0 + kstep, voffB); PG8_STAGE(PG8_SA(1, 0), cA0 + kstep, cvA0); PG8_STAGE(PG8_SB(1, 1), cB1 + kstep, voffB);
    PG8_WAIT_V(6); PG8_BAR;
    for (;;) {
        const bool has_next = S.next(ui + 1, nxt);
        const char* nA0 = has_next ? nxt.a0 : cA0; const char* nA1 = has_next ? nxt.a1 : cA1; const char* nB0 = has_next ? nxt.b0 : cB0; const char* nB1 = has_next ? nxt.b1 : cB1;
        if (GATHER) { if (has_next) { G8_VOFF(nxt, nvA0, nvA1); } else { nvA0[0] = cvA0[0]; nvA0[1] = cvA0[1]; nvA1[0] = cvA1[0]; nvA1[1] = cvA1[1]; } }
        for (int t = 0; t < nt; t += 2) {
            const bool last = (t == nt - 2);
            const char* a1_1 = cA1 + (size_t)(t + 1) * kstep;
            const char* a2_0 = last ? nA0 : cA0 + (size_t)(t + 2) * kstep; const char* a2_1 = last ? nA1 : cA1 + (size_t)(t + 2) * kstep;
            const char* b2_0 = last ? nB0 : cB0 + (size_t)(t + 2) * kstep; const char* b2_1 = last ? nB1 : cB1 + (size_t)(t + 2) * kstep;
            const char* a3_0 = a2_0 + kstep; const char* b3_0 = b2_0 + kstep; const char* b3_1 = b2_1 + kstep;
            unsigned vA0[2], vA1[2];
            if (GATHER) { vA0[0] = last ? nvA0[0] : cvA0[0]; vA0[1] = last ? nvA0[1] : cvA0[1]; vA1[0] = last ? nvA1[0] : cvA1[0]; vA1[1] = last ? nvA1[1] : cvA1[1]; }
            else { vA0[0] = cvA0[0]; vA0[1] = cvA0[1]; vA1[0] = cvA0[0]; vA1[1] = cvA0[1]; }
            PG8_LDB(B0, 0, 0); PG8_LDB(B1, 0, 1); PG8_SCHED; PG8_LDA(At, 0, 0); PG8_STAGE(PG8_SA(1, 1), a1_1, cvA1);
            PG8_WAIT_V(8); PG8_WAIT_L(0); PG8_BAR; PG8_MMA(0, 0, At, B0); PG8_MMA(0, 1, At, B1); PG8_BAR; PG8_SCHED;
            PG8_LDA(At, 0, 1); PG8_STAGE(PG8_SB(0, 0), b2_0, voffB); PG8_STAGE(PG8_SB(0, 1), b2_1, voffB); PG8_STAGE(PG8_SA(0, 0), a2_0, vA0);
            PG8_WAIT_V(8); PG8_WAIT_L(0); PG8_BAR; PG8_MMA(1, 0, At, B0); PG8_MMA(1, 1, At, B1); PG8_BAR; PG8_SCHED;
            PG8_LDB(B0, 1, 0); PG8_LDB(B1, 1, 1); PG8_SCHED; PG8_LDA(At, 1, 0); PG8_STAGE(PG8_SA(0, 1), a2_1, vA1);
            PG8_WAIT_V(8); PG8_WAIT_L(0); PG8_BAR; PG8_MMA(0, 0, At, B0); PG8_MMA(0, 1, At, B1); PG8_BAR; PG8_SCHED;
            PG8_LDA(At, 1, 1); PG8_STAGE(PG8_SB(1, 0), b3_0, voffB); PG8_STAGE(PG8_SB(1, 1), b3_1, voffB); PG8_STAGE(PG8_SA(1, 0), a3_0, vA0);
            PG8_WAIT_V(8); PG8_WAIT_L(0); PG8_BAR; PG8_MMA(1, 0, At, B0); PG8_MMA(1, 1, At, B1); PG8_BAR; PG8_SCHED;
        }
        if (wr == 0) PG8_BAR;
        E(acc, cur, wr, wc, fr, fq);
        if (!has_next) break;
#pragma unroll
        for (int a = 0; a < 2; ++a)
#pragma unroll
            for (int b = 0; b < 2; ++b)
#pragma unroll
                for (int m = 0; m < 4; ++m)
#pragma unroll
                    for (int n = 0; n < 2; ++n) acc[a][b][m][n] = (f32x4){0.f, 0.f, 0.f, 0.f};
        cur = nxt; cA0 = nA0; cA1 = nA1; cB0 = nB0; cB1 = nB1; ++ui;
        if (GATHER) { cvA0[0] = nvA0[0]; cvA0[1] = nvA0[1]; cvA1[0] = nvA1[0]; cvA1[1] = nvA1[1]; }
        if (wr == 1) PG8_BAR;
    }
    PG8_WAIT_V(0);
    PG8_BAR;
#undef G8_VOFF
#undef PG8_SA
#undef PG8_SB
#undef PG8_STAGE
#undef PG8_LDA
#undef PG8_LDB
#undef PG8_MMA
#undef PG8_WAIT_V
#undef PG8_WAIT_L
#undef PG8_BAR
#undef PG8_SCHED
}
}

__device__ void lru_gates_phase(LAS unsigned char* lds, const Params& p, int idx) {
    const int tid = tid_();
    LAS float* xc = (LAS float*)lds;
    const bf16_t* u = (const bf16_t*)(p.ws + WS_U);
    float* Aarr = (float*)(p.ws + WS_SCR); float* Barr = Aarr + (size_t)T * D;
    const float* conv_w = p.a_conv_w + (size_t)idx * 4 * D; const float* conv_b = p.a_conv_b + (size_t)idx * D;
    const float* w_r = p.a_w_rgate + (size_t)idx * 8 * 128 * 128; const float* w_i = p.a_w_igate + (size_t)idx * 8 * 128 * 128;
    const float* b_r = p.a_b_rgate + (size_t)idx * D; const float* b_i = p.a_b_igate + (size_t)idx * D; const float* lam = p.a_lambda + (size_t)idx * D;
    const int nunits = (T / 32) * 8;
    for (int un = blockIdx.x; un < nunits; un += gridDim.x) {
        const int tt = un >> 3, hd = un & 7, t0 = tt * 32;
        for (int i2 = tid; i2 < 32 * 128; i2 += NTHREADS) {
            const int tl = i2 >> 7, i = i2 & 127, c = hd * 128 + i, t = t0 + tl, s = t & (SEQ - 1);
            float acc = conv_b[c];
#pragma unroll
            for (int j = 0; j < 4; ++j) { const int sj = s - 3 + j; if (sj >= 0) acc += conv_w[j * D + c] * bf2f(u[(size_t)(t - 3 + j) * 2048 + 1024 + c]); }
            xc[tl * 128 + i] = acc;
        }
        __syncthreads();
        {
            const int j = tid & 127, tq = tid >> 7;
            float ar[8], ai[8];
#pragma unroll
            for (int q = 0; q < 8; ++q) { ar[q] = 0.f; ai[q] = 0.f; }
            for (int i = 0; i < 128; ++i) {
                const float wr_ = w_r[(size_t)(hd * 128 + i) * 128 + j], wi_ = w_i[(size_t)(hd * 128 + i) * 128 + j];
#pragma unroll
                for (int q = 0; q < 8; ++q) { const float xv = xc[(tq * 8 + q) * 128 + i]; ar[q] += xv * wr_; ai[q] += xv * wi_; }
            }
            const int c = hd * 128 + j;
            const float lm = lam[c];
            const float sp = (lm > 15.f) ? __expf(-lm) : log1pf(__expf(-lm));
            const float br = b_r[c], bi = b_i[c];
#pragma unroll
            for (int q = 0; q < 8; ++q) {
                const int tl = tq * 8 + q, t = t0 + tl;
                const float r = sigmoidf_(ar[q] + br), ig = sigmoidf_(ai[q] + bi);
                const float log_a = -8.0f * r * sp;
                const float a = __expf(log_a);
                const float bb = sqrtf(fmaxf(-expm1f(2.0f * log_a), 0.f)) * ig * xc[tl * 128 + j];
                Aarr[(size_t)t * D + c] = a; Barr[(size_t)t * D + c] = bb;
            }
        }
        __syncthreads();
    }
}
__device__ void lru_scan_phase(const Params& p) {
    const bf16_t* u = (const bf16_t*)(p.ws + WS_U);
    const float* Aarr = (const float*)(p.ws + WS_SCR); const float* Barr = Aarr + (size_t)T * D;
    bf16_t* yin = (bf16_t*)(p.ws + WS_YIN);
    const int nthr = NBATCH * D;
    for (int g = blockIdx.x * NTHREADS + threadIdx.x; g < nthr; g += gridDim.x * NTHREADS) {
        const int b = g / D, c = g % D;
        float h = 0.f;
#pragma unroll 8
        for (int s = 0; s < SEQ; ++s) {
            const size_t t = (size_t)b * SEQ + s;
            h = Aarr[t * D + c] * h + Barr[t * D + c];
            const float gt = bf2f(u[t * 2048 + c]);
            yin[t * D + c] = f2bf(gelu_tanh(gt) * h);
        }
    }
}

__device__ void ret_core_phase(LAS unsigned char* lds, const Params& p) {
    const int tid = tid_(), lane = tid & 63, wid = tid >> 6;
    LAS float* red = (LAS float*)lds;
    const bf16_t* u = (const bf16_t*)(p.ws + WS_U);
    float* RO = (float*)(p.ws + WS_SCR);
    const int nunits = NBATCH * 4 * 64;
    for (int un = blockIdx.x; un < nunits; un += gridDim.x) {
        const int b = un >> 8, h = (un >> 6) & 3, vg = un & 63;
        const int d = tid & 255, half = tid >> 8, v0 = vg * 8 + half * 4;
        const float gamma = 1.0f - exp2f(-5.0f - (float)h);
        float S0 = 0.f, S1 = 0.f, S2 = 0.f, S3 = 0.f;
        for (int n = 0; n < SEQ; ++n) {
            const size_t t = (size_t)b * SEQ + n;
            const bf16_t* ur = u + t * 6144;
            const float qd = bf2f(ur[h * 256 + d]), kd = bf2f(ur[1024 + h * 256 + d]) * 0.0625f;
            const u32x2 vv = *(const u32x2*)(ur + 2048 + h * 512 + v0);
            const float x0 = __uint_as_float(vv.x << 16), x1 = __uint_as_float(vv.x & 0xffff0000u), x2 = __uint_as_float(vv.y << 16), x3 = __uint_as_float(vv.y & 0xffff0000u);
            S0 = gamma * S0 + kd * x0; S1 = gamma * S1 + kd * x1; S2 = gamma * S2 + kd * x2; S3 = gamma * S3 + kd * x3;
            const float p0 = wave_sum(qd * S0), p1 = wave_sum(qd * S1), p2 = wave_sum(qd * S2), p3 = wave_sum(qd * S3);
            LAS float* rb = red + (n & 1) * 32;
            if (lane == 0) { rb[wid * 4 + 0] = p0; rb[wid * 4 + 1] = p1; rb[wid * 4 + 2] = p2; rb[wid * 4 + 3] = p3; }
            __syncthreads();
            if (tid < 8) {
                const int hf = tid >> 2, j = tid & 3;
                const float o = rb[(hf * 4 + 0) * 4 + j] + rb[(hf * 4 + 1) * 4 + j] + rb[(hf * 4 + 2) * 4 + j] + rb[(hf * 4 + 3) * 4 + j];
                RO[t * 2048 + h * 512 + vg * 8 + hf * 4 + j] = o;
            }
        }
        __syncthreads();
    }
}
__device__ void ret_norm_phase(LAS unsigned char* lds, const Params& p) {
    const int tid = tid_(), lane = tid & 63, wid = tid >> 6;
    LAS float* red = (LAS float*)lds;
    const bf16_t* u = (const bf16_t*)(p.ws + WS_U);
    const float* RO = (const float*)(p.ws + WS_SCR);
    bf16_t* yin = (bf16_t*)(p.ws + WS_YIN);
    for (int t = blockIdx.x; t < T; t += gridDim.x) {
        const f32x4 o = *(const f32x4*)(RO + (size_t)t * 2048 + tid * 4);
        const float ss = wave_sum(o[0] * o[0] + o[1] * o[1] + o[2] * o[2] + o[3] * o[3]);
        if (lane == 0) red[wid] = ss;
        __syncthreads();
        const float tot = red[(wid & ~1)] + red[(wid | 1)];
        const float rstd = rsqrtf(tot * (1.0f / 512.0f) + 1e-6f);
        const u32x2 gv = *(const u32x2*)(u + (size_t)t * 6144 + 4096 + tid * 4);
        const float g0 = __uint_as_float(gv.x << 16), g1 = __uint_as_float(gv.x & 0xffff0000u), g2 = __uint_as_float(gv.y << 16), g3 = __uint_as_float(gv.y & 0xffff0000u);
        u32x2 w; w.x = pack2(g0 * sigmoidf_(g0) * o[0] * rstd, g1 * sigmoidf_(g1) * o[1] * rstd); w.y = pack2(g2 * sigmoidf_(g2) * o[2] * rstd, g3 * sigmoidf_(g3) * o[3] * rstd);
        *(u32x2*)(yin + (size_t)t * 2048 + tid * 4) = w;
        __syncthreads();
    }
}

__device__ void attn_core_phase(LAS unsigned char* lds, const Params& p) {
    const int tid = tid_(), lane = tid & 63, wid = tid >> 6;
    LAS float* qs = (LAS float*)lds + wid * 640;
    LAS float* ps = qs + 192;
    const bf16_t* u = (const bf16_t*)(p.ws + WS_U);
    bf16_t* yin = (bf16_t*)(p.ws + WS_YIN);
    const int niter = T * 16 / 8;
    for (int it = blockIdx.x; it < niter; it += gridDim.x) {
        const int wu = it * 8 + wid, t = wu >> 4, h = wu & 15, s = t & (SEQ - 1);
        const float slope = exp2f(-0.5f * (float)(h + 1));
        const bf16_t* ut = u + (size_t)t * 9216;
#pragma unroll
        for (int g = 0; g < 3; ++g) qs[g * 64 + lane] = bf2f(ut[g * 1024 + h * 64 + lane]);
        __syncthreads();
        float sc[3][3];
        float mx = -INFINITY;
#pragma unroll
        for (int g = 0; g < 3; ++g) {
            const int dl = (g == 0) ? 1 : (g == 1 ? 4 : 16);
#pragma unroll
            for (int ps_ = 0; ps_ < 3; ++ps_) {
                const int st = ps_ * 64 + lane;
                float v = -INFINITY;
                if (st <= 128 && s - st * dl >= 0) {
                    const bf16_t* kr = u + (size_t)(t - st * dl) * 9216 + (3 + g) * 1024 + h * 64;
                    float a = 0.f;
#pragma unroll
                    for (int c = 0; c < 8; ++c) {
                        const u32x4 kv = *(const u32x4*)(kr + c * 8);
                        a += qs[g * 64 + c * 8 + 0] * __uint_as_float(kv.x << 16) + qs[g * 64 + c * 8 + 1] * __uint_as_float(kv.x & 0xffff0000u);
                        a += qs[g * 64 + c * 8 + 2] * __uint_as_float(kv.y << 16) + qs[g * 64 + c * 8 + 3] * __uint_as_float(kv.y & 0xffff0000u);
                        a += qs[g * 64 + c * 8 + 4] * __uint_as_float(kv.z << 16) + qs[g * 64 + c * 8 + 5] * __uint_as_float(kv.z & 0xffff0000u);
                        a += qs[g * 64 + c * 8 + 6] * __uint_as_float(kv.w << 16) + qs[g * 64 + c * 8 + 7] * __uint_as_float(kv.w & 0xffff0000u);
                    }
                    v = a * 0.125f - slope * (float)(st * dl);
                }
                sc[g][ps_] = v; mx = fmaxf(mx, v);
            }
        }
        mx = wave_max(mx);
        float den = 0.f;
#pragma unroll
        for (int g = 0; g < 3; ++g)
#pragma unroll
            for (int ps_ = 0; ps_ < 3; ++ps_) {
                const int st = ps_ * 64 + lane;
                const float pv = (sc[g][ps_] == -INFINITY) ? 0.f : __expf(sc[g][ps_] - mx);
                den += pv;
                if (st <= 128) ps[g * 129 + st] = pv;
            }
        den = wave_sum(den);
        __syncthreads();
        float o = 0.f;
#pragma unroll
        for (int g = 0; g < 3; ++g) {
            const int dl = (g == 0) ? 1 : (g == 1 ? 4 : 16);
            const int nst = min(128, s / dl);
            for (int st = 0; st <= nst; ++st) o += ps[g * 129 + st] * bf2f(u[(size_t)(t - st * dl) * 9216 + (6 + g) * 1024 + h * 64 + lane]);
        }
        yin[(size_t)t * D + h * 64 + lane] = f2bf(o / den);
        __syncthreads();
    }
}

__device__ void ln_phase(const Params& p, int layer, int which) {
    const int tid = tid_(), lane = tid & 63, wid = tid >> 6;
    float* xf = (float*)(p.ws + WS_XF); bf16_t* xb = (bf16_t*)(p.ws + WS_XB);
    const float* ymix = (const float*)(p.ws + WS_YMIX);
    const float* yrows = (const float*)(p.ws + WS_YROWS);
    int* tope = (int*)(p.ws + WS_TOPE); float* gates = (float*)(p.ws + WS_GATES); int* pos = (int*)(p.ws + WS_POS); const int* dest = (const int*)(p.ws + WS_DEST);
    unsigned* ctl = (unsigned*)(p.ws + WS_CTL);
    const float* gain = p.ln_gain + (size_t)(layer * 2 + which) * D; const float* bias = p.ln_bias + (size_t)(layer * 2 + which) * D;
    const float* wrt = p.moe_w_router + (size_t)layer * D * NEXP; const float* brt = p.moe_b_router + (size_t)layer * NEXP;
    for (int t = blockIdx.x * 8 + wid; t < T; t += gridDim.x * 8) {
        f32x4 z[4];
        if (which == 0) {
#pragma unroll
            for (int i = 0; i < 4; ++i) { const int c = 256 * i + 4 * lane; z[i] = DN_ALPHA * *(const f32x4*)(xf + (size_t)t * D + c) + *(const f32x4*)(ymix + (size_t)t * D + c); }
        } else {
            int dk[4]; float gk[4];
#pragma unroll
            for (int k = 0; k < 4; ++k) { dk[k] = dest[t * 4 + k]; gk[k] = gates[t * 4 + k]; }
#pragma unroll
            for (int i = 0; i < 4; ++i) {
                const int c = 256 * i + 4 * lane;
                f32x4 f = (f32x4){0.f, 0.f, 0.f, 0.f};
#pragma unroll
                for (int k = 0; k < 4; ++k) f += gk[k] * *(const f32x4*)(yrows + (size_t)dk[k] * D + c);
                z[i] = DN_ALPHA * *(const f32x4*)(xf + (size_t)t * D + c) + f;
            }
        }
        float sm = 0.f;
#pragma unroll
        for (int i = 0; i < 4; ++i) sm += (z[i][0] + z[i][1]) + (z[i][2] + z[i][3]);
        const float mean = wave_sum(sm) * (1.0f / D);
        float sq = 0.f;
#pragma unroll
        for (int i = 0; i < 4; ++i) { const f32x4 dd = z[i] - mean; sq += (dd[0] * dd[0] + dd[1] * dd[1]) + (dd[2] * dd[2] + dd[3] * dd[3]); }
        const float rstd = rsqrtf(wave_sum(sq) * (1.0f / D) + LN_EPS);
#pragma unroll
        for (int i = 0; i < 4; ++i) {
            const int c = 256 * i + 4 * lane;
            z[i] = (z[i] - mean) * rstd * *(const f32x4*)(gain + c) + *(const f32x4*)(bias + c);
            *(f32x4*)(xf + (size_t)t * D + c) = z[i];
            u32x2 w; w.x = pack2(z[i][0], z[i][1]); w.y = pack2(z[i][2], z[i][3]);
            *(u32x2*)(xb + (size_t)t * D + c) = w;
            if (which == 1 && layer == DEPTH - 1) *(f32x4*)(p.out + (size_t)t * D + c) = z[i];
        }
        if (which == 0) {
            const float* wrt_l = wrt; asm volatile("" : "+s"(wrt_l));
            float lg[NEXP];
#pragma unroll
            for (int e = 0; e < NEXP; ++e) lg[e] = 0.f;
#pragma unroll
            for (int i = 0; i < 4; ++i)
#pragma unroll
                for (int j = 0; j < 4; ++j) {
                    const int c = 256 * i + 4 * lane + j; const float xv = z[i][j];
#pragma unroll
                    for (int e4 = 0; e4 < NEXP / 4; ++e4) { const f32x4 w = *(const f32x4*)(wrt_l + (unsigned)(c * NEXP + e4 * 4)); lg[e4 * 4 + 0] += xv * w[0]; lg[e4 * 4 + 1] += xv * w[1]; lg[e4 * 4 + 2] += xv * w[2]; lg[e4 * 4 + 3] += xv * w[3]; }
                    if (j & 1) __builtin_amdgcn_sched_barrier(0);
                }
#pragma unroll
            for (int e = 0; e < NEXP; ++e) lg[e] = wave_sum(lg[e]) + brt[e];
            int te[4]; float tv[4]; unsigned used = 0u;
#pragma unroll
            for (int k = 0; k < 4; ++k) {
                float best = -INFINITY; int bi = 0;
#pragma unroll
                for (int e = 0; e < NEXP; ++e) { const bool ok = !((used >> e) & 1u) && lg[e] > best; best = ok ? lg[e] : best; bi = ok ? e : bi; }
                te[k] = bi; tv[k] = best; used |= 1u << bi;
            }
            const float e1 = __expf(tv[1] - tv[0]), e2 = __expf(tv[2] - tv[0]), e3 = __expf(tv[3] - tv[0]);
            const float inv = 1.0f / (1.0f + e1 + e2 + e3);
            if (lane < 4) {
                const int k = lane;
                const int ee = (k == 0) ? te[0] : (k == 1 ? te[1] : (k == 2 ? te[2] : te[3]));
                const float gg = ((k == 0) ? 1.0f : (k == 1 ? e1 : (k == 2 ? e2 : e3))) * inv;
                tope[t * 4 + k] = ee; gates[t * 4 + k] = gg;
                pos[t * 4 + k] = (int)atomicAdd(ctl + CW_CNT + layer * 64 + ee, 1u);
            }
        }
    }
}

__device__ void moe_scatter_phase(LAS unsigned char* lds, const Params& p, int layer) {
    const int tid = tid_();
    LAS int* pstart = (LAS int*)lds;
    unsigned* ctl = (unsigned*)(p.ws + WS_CTL);
    const int* tope = (const int*)(p.ws + WS_TOPE); const int* pos = (const int*)(p.ws + WS_POS);
    int* dest = (int*)(p.ws + WS_DEST); int* rowtok = (int*)(p.ws + WS_ROWTOK);
    if (tid == 0) {
        int acc = 0;
        for (int e = 0; e < NEXP; ++e) { const int c = (int)ctl[CW_CNT + layer * 64 + e]; pstart[e] = acc; pstart[32 + e] = c; acc += ((c + 255) >> 8) << 8; }
        pstart[64] = acc;
        if (blockIdx.x == 0) {
            ctl[CW_MDYN + layer * 64] = (unsigned)acc;
            for (int e = 0; e < NEXP; ++e) { const int nb = (pstart[32 + e] + 255) >> 8; for (int b = 0; b < nb; ++b) ctl[CW_TEXP + layer * 512 + (pstart[e] >> 8) + b] = (unsigned)e; }
        }
    }
    __syncthreads();
    for (int i = blockIdx.x * NTHREADS + tid; i < T * TOPK; i += gridDim.x * NTHREADS) {
        const int e = tope[i], row = pstart[e] + pos[i];
        dest[i] = row; rowtok[row] = i >> 2;
    }
    for (int i = blockIdx.x * NTHREADS + tid; i < NEXP * 256; i += gridDim.x * NTHREADS) {
        const int e = i >> 8, r = i & 255, c = pstart[32 + e], padded = ((c + 255) >> 8) << 8;
        if (c + r < padded) rowtok[pstart[e] + c + r] = 0;
    }
    __syncthreads();
}

constexpr int PH_PER_LAYER = 9;
constexpr int NPHASES = 1 + DEPTH * PH_PER_LAYER;
constexpr int LDS_BYTES = 132 * 1024;


#ifndef PHMASK
#define PHMASK 0x3FF
#endif
#define PHK(j) ((PHMASK >> (j)) & 1)
#define IN(k) (lo <= (k) && (k) < hi)
#if MK_ONE_LAUNCH
#define SEAM(k) do { if (IN(k) && IN((k) + 1)) xcd_barrier_nv(bar.bar, bar.x, bar.st); } while (0)
#else
#define SEAM(k) do {} while (0)
#endif
template <int layer>
__device__ __forceinline__ void run_layer(const Params& p, LAS unsigned char* lds, const XcdBarrier& bar) {
    const int lo = p.ph_lo, hi = p.ph_hi;
    unsigned char* ws = p.ws;
    unsigned* ctl = (unsigned*)(ws + WS_CTL);
        constexpr int base = 1 + layer * PH_PER_LAYER, kind = layer % 3, idx = layer / 3;
        if (PHK(1) && IN(base + 0)) {
            constexpr int N = (kind == 0) ? 2048 : (kind == 1 ? 6144 : 9216);
            const bf16_t* Bt = (kind == 0) ? (const bf16_t*)(ws + WS_AWIN) + (size_t)idx * 2048 * D : (kind == 1 ? (const bf16_t*)(ws + WS_BWIN) : (const bf16_t*)(ws + WS_CWIN));
            g8::SchedPlain S; S.init(ws + WS_XB, Bt, T, N, D, (int)gridDim.x, (int)blockIdx.x);
            g8::EpiBf16 E{(bf16_t*)(ws + WS_U), N};
            g8::gemm_phase<g8::EpiBf16, g8::SchedPlain, false>(lds, D, S, E);
        }
        SEAM(base + 0);
        if (PHK(2) && IN(base + 1)) {
            if (kind == 0) lru_gates_phase(lds, p, idx);
            else if (kind == 1) ret_core_phase(lds, p);
            else attn_core_phase(lds, p);
        }
        SEAM(base + 1);
        if (PHK(3) && IN(base + 2)) {
            if (kind == 0) lru_scan_phase(p);
            else if (kind == 1) ret_norm_phase(lds, p);
        }
        SEAM(base + 2);
        if (PHK(4) && IN(base + 3)) {
            constexpr int K = (kind == 1) ? 2048 : D;
            const bf16_t* Bt = (kind == 0) ? (const bf16_t*)(ws + WS_AWOUT) + (size_t)idx * D * D : (kind == 1 ? (const bf16_t*)(ws + WS_BWOUT) : (const bf16_t*)(ws + WS_CWOUT));
            g8::SchedPlain S; S.init(ws + WS_YIN, Bt, T, D, K, (int)gridDim.x, (int)blockIdx.x);
            g8::EpiF32 E{(float*)(ws + WS_YMIX), D, nullptr, 0};
            g8::gemm_phase<g8::EpiF32, g8::SchedPlain, false>(lds, K, S, E);
        }
        SEAM(base + 3);
        if (PHK(5) && IN(base + 4)) ln_phase(p, layer, 0);
        SEAM(base + 4);
        if (PHK(6) && IN(base + 5)) moe_scatter_phase(lds, p, layer);
        SEAM(base + 5);
        if (PHK(7) && IN(base + 6)) {
            g8::SchedGU S{(const char*)(ws + WS_XB), (const char*)((const bf16_t*)(ws + WS_GU) + (size_t)layer * NEXP * 2048 * D), (const int*)(ws + WS_ROWTOK), ctl + CW_TEXP + layer * 512,
                          (int)(ctl[CW_MDYN + layer * 64] >> 8), (int)gridDim.x, (int)blockIdx.x};
            g8::EpiSwiglu E{(bf16_t*)(ws + WS_HID), p.moe_b_gu + (size_t)layer * NEXP * 2048};
            g8::gemm_phase<g8::EpiSwiglu, g8::SchedGU, true>(lds, D, S, E);
        }
        SEAM(base + 6);
        if (PHK(8) && IN(base + 7)) {
            g8::SchedDown S{(const char*)(ws + WS_HID), (const char*)((const bf16_t*)(ws + WS_DN) + (size_t)layer * NEXP * D * D), ctl + CW_TEXP + layer * 512,
                            (int)(ctl[CW_MDYN + layer * 64] >> 8), (int)gridDim.x, (int)blockIdx.x};
            g8::EpiF32 E{(float*)(ws + WS_YROWS), D, p.moe_b_down + (size_t)layer * NEXP * D, D};
            g8::gemm_phase<g8::EpiF32, g8::SchedDown, false>(lds, D, S, E);
        }
        SEAM(base + 7);
        if (PHK(9) && IN(base + 8)) ln_phase(p, layer, 1);
        SEAM(base + 8);
    }
#undef IN
#undef SEAM
__global__ void __launch_bounds__(NTHREADS, 2) fwd_kernel(Params p) {
    extern __shared__ __attribute__((aligned(16))) unsigned char lds_raw[];
    LAS unsigned char* lds = (LAS unsigned char*)lds_raw;
    const int lo = p.ph_lo, hi = p.ph_hi;
    unsigned char* ws = p.ws;
    unsigned* ctl = (unsigned*)(ws + WS_CTL);
#if MK_ONE_LAUNCH
    volatile LAS unsigned* bst = (volatile LAS unsigned*)(lds + LDS_BYTES - 16);
    if (threadIdx.x == 0) { bst[0] = 0u; bst[1] = 0u; bst[2] = 0u; bst[3] = 0u; }
    __syncthreads();
    XcdBarrier bar = xcd_barrier_post(ctl, bst);
#define GRID_BAR() xcd_barrier_nv(bar.bar, bar.x, bar.st)
#else
    XcdBarrier bar; bar.bar = ctl; bar.x = 0; bar.st = nullptr;
#define GRID_BAR() do {} while (0)
#endif
#define IN(k) (lo <= (k) && (k) < hi)
#define SEAM(k) do { if (IN(k) && IN((k) + 1)) GRID_BAR(); } while (0)

    if (PHK(0) && IN(0)) {
        LAS float* tile = (LAS float*)lds;
        for (int l = 0; l < 2; ++l) {
            convert_job(tile, p.a_w_in + (size_t)l * D * 2048, (bf16_t*)(ws + WS_AWIN) + (size_t)l * 2048 * D, D, 2048, 1);
            convert_job(tile, p.a_w_out + (size_t)l * D * D, (bf16_t*)(ws + WS_AWOUT) + (size_t)l * D * D, D, D, 1);
        }
        convert_job(tile, p.b_w_in, (bf16_t*)(ws + WS_BWIN), D, 6144, 1);
        convert_job(tile, p.b_w_out, (bf16_t*)(ws + WS_BWOUT), 2048, D, 1);
        convert_job(tile, p.c_w_in, (bf16_t*)(ws + WS_CWIN), D, 9216, 1);
        convert_job(tile, p.c_w_out, (bf16_t*)(ws + WS_CWOUT), D, D, 1);
        convert_job(tile, p.moe_w_gu, (bf16_t*)(ws + WS_GU), D, 2048, DEPTH * NEXP);
        convert_job(tile, p.moe_w_down, (bf16_t*)(ws + WS_DN), D, D, DEPTH * NEXP);
        float* xf = (float*)(ws + WS_XF); bf16_t* xb = (bf16_t*)(ws + WS_XB);
        for (size_t i = (size_t)blockIdx.x * NTHREADS + threadIdx.x; i < (size_t)T * D / 4; i += (size_t)gridDim.x * NTHREADS) {
            const f32x4 v = *(const f32x4*)(p.x + i * 4);
            *(f32x4*)(xf + i * 4) = v;
            u32x2 w; w.x = pack2(v[0], v[1]); w.y = pack2(v[2], v[3]); *(u32x2*)(xb + i * 4) = w;
        }
    }
    SEAM(0);

    run_layer<0>(p, lds, bar); run_layer<1>(p, lds, bar); run_layer<2>(p, lds, bar); run_layer<3>(p, lds, bar);
#undef IN
#undef SEAM
}

extern "C" void kernel_launch(void* const* d_in, const int* in_sizes, int n_in, void* d_out, int out_size, void* d_ws, size_t ws_size, hipStream_t stream) {
    static int grid = 0;
    if (grid == 0) {
        if (n_in != 22 || out_size != T * D || ws_size < WS_END) { fprintf(stderr, "kernel_launch: unexpected shapes (n_in %d out %d ws %zu need %zu)\n", n_in, out_size, ws_size, (size_t)WS_END); grid = -1; return; }
        if (hipFuncSetAttribute((const void*)fwd_kernel, hipFuncAttributeMaxDynamicSharedMemorySize, LDS_BYTES) != hipSuccess) { fprintf(stderr, "kernel_launch: hipFuncSetAttribute failed\n"); grid = -1; return; }
        int dev = 0, cus = 0;
        if (hipGetDevice(&dev) != hipSuccess || hipDeviceGetAttribute(&cus, hipDeviceAttributeMultiprocessorCount, dev) != hipSuccess) { grid = -1; return; }
        grid = cus;
    }
    if (grid < 0) return;
    (void)hipMemsetAsync((char*)d_ws + WS_CTL, 0, CTL_BYTES, stream);
    Params p{};
    const float** pp = (const float**)&p;
    for (int i = 0; i < 22; ++i) pp[i] = (const float*)d_in[i];
    p.out = (float*)d_out; p.ws = (unsigned char*)d_ws;
#if MK_ONE_LAUNCH
    p.ph_lo = 0; p.ph_hi = NPHASES;
    hipLaunchKernelGGL(fwd_kernel, dim3(grid), dim3(NTHREADS), LDS_BYTES, stream, p);
#else
    for (int ph = 0; ph < NPHASES; ++ph) {
        if (ph > 0) { const int k = (ph - 1) % PH_PER_LAYER, layer = (ph - 1) / PH_PER_LAYER; if (k == 2 && layer % 3 == 2) continue; }
        p.ph_lo = ph; p.ph_hi = ph + 1;
        hipLaunchKernelGGL(fwd_kernel, dim3(grid), dim3(NTHREADS), LDS_BYTES, stream, p);
    }
#endif
}
```

```cpp
#include <hip/hip_runtime.h>
#include <stdint.h>
#include <stdio.h>

#ifndef MK_ONE_LAUNCH
#define MK_ONE_LAUNCH 1
#endif

#define LAS __attribute__((address_space(3)))
typedef unsigned short bf16_t;
typedef short bf16x8 __attribute__((ext_vector_type(8)));
typedef float f32x4 __attribute__((ext_vector_type(4)));
typedef unsigned u32x4 __attribute__((ext_vector_type(4)));
typedef unsigned u32x2 __attribute__((ext_vector_type(2)));

constexpr int T = 16384, D = 1024, SEQ = 2048, NBATCH = 8, DEPTH = 4;
constexpr int NEXP = 32, TOPK = 4;
constexpr int MAXROWS = 73728;
constexpr float DN_ALPHA = 1.681792830507429f;
constexpr float LN_EPS = 1e-5f;
constexpr int NTHREADS = 512;

constexpr size_t MB = 1ull << 20;
constexpr size_t WS_CTL = 0;
constexpr size_t CTL_BYTES = 65536;
constexpr size_t WS_AWIN = 1 * MB;
constexpr size_t WS_AWOUT = WS_AWIN + 8 * MB;
constexpr size_t WS_BWIN = WS_AWOUT + 4 * MB;
constexpr size_t WS_BWOUT = WS_BWIN + 12 * MB;
constexpr size_t WS_CWIN = WS_BWOUT + 4 * MB;
constexpr size_t WS_CWOUT = WS_CWIN + 18 * MB;
constexpr size_t WS_GU = WS_CWOUT + 2 * MB;
constexpr size_t WS_DN = WS_GU + 512 * MB;
constexpr size_t WS_XF = WS_DN + 256 * MB;
constexpr size_t WS_XB = WS_XF + 64 * MB;
constexpr size_t WS_U = WS_XB + 32 * MB;
constexpr size_t WS_YIN = WS_U + 288 * MB;
constexpr size_t WS_YMIX = WS_YIN + 64 * MB;
constexpr size_t WS_SCR = WS_YMIX + 64 * MB;
constexpr size_t WS_TOPE = WS_SCR + 128 * MB;
constexpr size_t WS_GATES = WS_TOPE + 256 * 1024;
constexpr size_t WS_POS = WS_GATES + 256 * 1024;
constexpr size_t WS_DEST = WS_POS + 256 * 1024;
constexpr size_t WS_ROWTOK = WS_DEST + 256 * 1024;
constexpr size_t WS_HID = WS_ROWTOK + 1 * MB;
constexpr size_t WS_YROWS = WS_HID + 144 * MB;
constexpr size_t WS_LSUM = WS_YROWS + 288 * MB;
constexpr size_t WS_AGT = WS_LSUM + 2 * MB;
constexpr size_t WS_END = WS_AGT + 1 * MB;

constexpr int CW_CNT = 4096;
constexpr int CW_MDYN = 8192;
constexpr int CW_TEXP = 12288;

#define XB_TMO      128
#define XB_XCNT(j)  (256  + 64 * (j))
#define XB_XSUB(j)  (1280 + 64 * (j))
#define XB_XGEN(j)  (2304 + 64 * (j))
#define XB_TOP      3328
#define XB_TOPGEN   3392
#define XCD_BAR_WORDS 3456
#define XB_SPIN_CAP (1u << 22)

__device__ __forceinline__ unsigned xb_ld(unsigned* p)              { return __hip_atomic_load(p, __ATOMIC_RELAXED, __HIP_MEMORY_SCOPE_AGENT); }
__device__ __forceinline__ unsigned xb_add(unsigned* p, unsigned v) { return __hip_atomic_fetch_add(p, v, __ATOMIC_RELAXED, __HIP_MEMORY_SCOPE_AGENT); }
__device__ __forceinline__ unsigned xb_xcc_id() { return (unsigned)__builtin_amdgcn_s_getreg((3 << 11) | 20) & 0xFu; }
#define XB_SPIN(cond, bar) do { unsigned _sp = 0; while (cond) { __builtin_amdgcn_s_sleep(1); \
    if ((++_sp & 255u) == 0u) { if (xb_ld(&(bar)[XB_TMO])) break; if (_sp > XB_SPIN_CAP) { atomicAdd(&(bar)[XB_TMO], 1u); break; } } } } while (0)

struct XcdBarrier { unsigned* bar; unsigned x; volatile LAS unsigned* st; };

__device__ __forceinline__ XcdBarrier xcd_barrier_post(unsigned* bar, volatile LAS unsigned* st) {
    XcdBarrier b; b.bar = bar; b.x = xb_xcc_id(); b.st = st;
    if (threadIdx.x == 0) (void)xb_add(&bar[XB_XCNT(b.x)], 1u);
    return b;
}
__device__ __forceinline__ void xcd_barrier_complete(unsigned* bar, unsigned x, unsigned& nloc, unsigned& nx) {
    const unsigned G = gridDim.x * gridDim.y * gridDim.z;
    unsigned sum, cnt, mine, sp = 0u;
    for (;;) {
        sum = 0u; cnt = 0u; mine = 0u;
#pragma unroll
        for (unsigned j = 0; j < 16; ++j) { const unsigned c = xb_ld(&bar[XB_XCNT(j)]); sum += c; cnt += (c > 0u) ? 1u : 0u; mine = (j == x) ? c : mine; }
        if (sum == G) break;
        __builtin_amdgcn_s_sleep(1);
        if ((++sp & 255u) == 0u) { if (xb_ld(&bar[XB_TMO])) break; if (sp > XB_SPIN_CAP) { atomicAdd(&bar[XB_TMO], 1u); break; } }
    }
    nloc = mine > 0u ? mine : 1u; nx = cnt > 0u ? cnt : 1u;
}
__device__ __noinline__ void xcd_barrier_nv(unsigned* bbar, unsigned bx, volatile LAS unsigned* bst) {
    XcdBarrier b; b.bar = bbar; b.x = bx; b.st = bst;
    asm volatile("s_waitcnt vmcnt(0)" ::: "memory");
    __syncthreads();
    if (threadIdx.x == 0) {
        unsigned* bar = b.bar;
        __builtin_amdgcn_s_waitcnt(0);
        unsigned nloc = b.st[0], nx = b.st[1];
        if (nloc == 0u) { xcd_barrier_complete(bar, b.x, nloc, nx); b.st[0] = nloc; b.st[1] = nx; }
        const unsigned old = xb_add(&bar[XB_XSUB(b.x)], 1u);
        const unsigned gen = old / nloc;
        if (old + 1u == (gen + 1u) * nloc) {
            __builtin_amdgcn_fence(__ATOMIC_RELEASE, "agent");
            asm volatile("s_waitcnt vmcnt(0)" ::: "memory");
            const unsigned og = xb_add(&bar[XB_TOP], 1u);
            const unsigned tg = og / nx;
            if (og + 1u == (tg + 1u) * nx) xb_add(&bar[XB_TOPGEN], 1u);
            else XB_SPIN(xb_ld(&bar[XB_TOPGEN]) == tg, bar);
            __builtin_amdgcn_fence(__ATOMIC_ACQUIRE, "agent");
            xb_add(&bar[XB_XGEN(b.x)], 1u);
            asm volatile("s_waitcnt vmcnt(0)" ::: "memory");
        } else {
            XB_SPIN(xb_ld(&bar[XB_XGEN(b.x)]) == gen, bar);
            __builtin_amdgcn_fence(__ATOMIC_ACQUIRE, "agent");
            asm volatile("s_waitcnt vmcnt(0)" ::: "memory");
        }
    }
    __syncthreads();
}

__device__ __forceinline__ int tid_() { int t = threadIdx.x; asm volatile("" : "+v"(t)); return t; }
__device__ __forceinline__ float bf2f(bf16_t v) { return __uint_as_float(((unsigned)v) << 16); }
__device__ __forceinline__ bf16_t f2bf(float f) { unsigned u = __float_as_uint(f); u += 0x7FFFu + ((u >> 16) & 1u); return (bf16_t)(u >> 16); }
__device__ __forceinline__ unsigned pack2(float lo, float hi) { return (unsigned)f2bf(lo) | ((unsigned)f2bf(hi) << 16); }
__device__ __forceinline__ float wave_sum(float v) {
#pragma unroll
    for (int o = 32; o >= 1; o >>= 1) v += __shfl_xor(v, o);
    return v;
}
__device__ __forceinline__ float wave_max(float v) {
#pragma unroll
    for (int o = 32; o >= 1; o >>= 1) v = fmaxf(v, __shfl_xor(v, o));
    return v;
}
__device__ __forceinline__ float sigmoidf_(float x) { return 1.0f / (1.0f + __expf(-x)); }
__device__ __forceinline__ float gelu_tanh(float x) { const float u = 0.7978845608028654f * (x + 0.044715f * x * x * x); return 0.5f * x * (1.0f + tanhf(u)); }
__device__ __forceinline__ float swiglu(float gate, float up) {
    const float g = fminf(gate, 7.0f), u = fminf(fmaxf(up, -7.0f), 7.0f);
    return (u + 1.0f) * g * sigmoidf_(1.702f * g);
}

struct Params {
    const float* x; const float* a_w_in; const float* a_conv_w; const float* a_conv_b; const float* a_w_rgate; const float* a_b_rgate;
    const float* a_w_igate; const float* a_b_igate; const float* a_lambda; const float* a_w_out; const float* b_w_in; const float* b_w_out;
    const float* c_w_in; const float* c_w_out; const float* ln_gain; const float* ln_bias; const float* moe_w_router; const float* moe_b_router;
    const float* moe_w_gu; const float* moe_b_gu; const float* moe_w_down; const float* moe_b_down;
    float* out; unsigned char* ws;
    int ph_lo, ph_hi;
};

__device__ void convert_job(LAS float* tile, const float* src, bf16_t* dst, int K, int N, int batch) {
    const int tid = tid_();
    const int tk = K / 64, tn = N / 64, per = tk * tn; const long total = (long)per * batch;
    for (long u = blockIdx.x; u < total; u += gridDim.x) {
        const int bidx = (int)(u / per), r = (int)(u % per), kt = r / tn, nt = r % tn;
        const float* s = src + (size_t)bidx * K * N + (size_t)(kt * 64) * N + nt * 64;
#pragma unroll
        for (int pass = 0; pass < 2; ++pass) {
            const int row = (tid >> 4) + 32 * pass, c4 = tid & 15;
            const f32x4 v = *(const f32x4*)(s + (size_t)row * N + c4 * 4);
            tile[row * 65 + c4 * 4 + 0] = v[0]; tile[row * 65 + c4 * 4 + 1] = v[1]; tile[row * 65 + c4 * 4 + 2] = v[2]; tile[row * 65 + c4 * 4 + 3] = v[3];
        }
        __syncthreads();
        {
            const int n = tid >> 3, k8 = tid & 7;
            float v[8];
#pragma unroll
            for (int j = 0; j < 8; ++j) v[j] = tile[(k8 * 8 + j) * 65 + n];
            u32x4 w; w.x = pack2(v[0], v[1]); w.y = pack2(v[2], v[3]); w.z = pack2(v[4], v[5]); w.w = pack2(v[6], v[7]);
            *(u32x4*)(dst + (size_t)bidx * N * K + (size_t)(nt * 64 + n) * K + kt * 64 + k8 * 8) = w;
        }
        __syncthreads();
    }
}

struct GemmS {
    const bf16_t* A; int lda;
    const bf16_t* Bt; int ldb;
    int M, N, K;
    const unsigned* Mdyn;
    const int* row_idx;
    const unsigned* tile_exp;
    size_t b_exp_stride;
    const float* bias; int bias_es;
    float* Cf; bf16_t* Cb; int ldc;
};
template <int MODE>
__device__ void gemm_simple(LAS unsigned char* lds, const GemmS& g) {
    const int tid = tid_(), lane = tid & 63, wid = tid >> 6, wr = wid >> 1, wc = wid & 1, fr = lane & 15, fq = lane >> 4;
    const int M = g.Mdyn ? (int)*g.Mdyn : g.M;
    const int tiles_n = (MODE == 1) ? (g.N / 256) * 2 : g.N / 128;
    const int tiles_m = M / 128, nunits = tiles_m * tiles_n, nk = g.K / 32;
    LAS bf16_t* As = (LAS bf16_t*)lds;
    LAS bf16_t* Bs = As + 2 * 128 * 40;
    const int lrow = tid >> 2, lch = tid & 3;
    for (int u = blockIdx.x; u < nunits; u += gridDim.x) {
        const int tm = u / tiles_n, tn = u % tiles_n, m0 = tm * 128;
        const int e = (MODE != 0) ? (int)g.tile_exp[m0 >> 8] : 0;
        const bf16_t* Bbase = g.Bt + (size_t)e * g.b_exp_stride;
        int arow = m0 + lrow; if (MODE == 1) arow = g.row_idx[arow];
        int brow;
        if (MODE == 1) { const int bwc = lrow >> 6, ni = (lrow & 63) >> 4, r = lrow & 15; brow = ((ni & 1) ? 1024 : 0) + tn * 64 + bwc * 32 + (ni >> 1) * 16 + r; }
        else brow = tn * 128 + lrow;
        const bf16_t* ap = g.A + (size_t)arow * g.lda + lch * 8;
        const bf16_t* bp = Bbase + (size_t)brow * g.ldb + lch * 8;
        f32x4 acc[2][4];
#pragma unroll
        for (int mi = 0; mi < 2; ++mi)
#pragma unroll
            for (int ni = 0; ni < 4; ++ni) acc[mi][ni] = (f32x4){0.f, 0.f, 0.f, 0.f};
        u32x4 ra = *(const u32x4*)ap, rb = *(const u32x4*)bp;
        *(LAS u32x4*)(As + lrow * 40 + lch * 8) = ra; *(LAS u32x4*)(Bs + lrow * 40 + lch * 8) = rb;
        __syncthreads();
        for (int kt = 0; kt < nk; ++kt) {
            const int cur = kt & 1;
            if (kt + 1 < nk) { ra = *(const u32x4*)(ap + (kt + 1) * 32); rb = *(const u32x4*)(bp + (kt + 1) * 32); }
            bf16x8 af[2], bfr[4];
#pragma unroll
            for (int mi = 0; mi < 2; ++mi) af[mi] = *(const LAS bf16x8*)(As + cur * 5120 + (wr * 32 + mi * 16 + fr) * 40 + fq * 8);
#pragma unroll
            for (int ni = 0; ni < 4; ++ni) bfr[ni] = *(const LAS bf16x8*)(Bs + cur * 5120 + (wc * 64 + ni * 16 + fr) * 40 + fq * 8);
#pragma unroll
            for (int mi = 0; mi < 2; ++mi)
#pragma unroll
                for (int ni = 0; ni < 4; ++ni) acc[mi][ni] = __builtin_amdgcn_mfma_f32_16x16x32_bf16(bfr[ni], af[mi], acc[mi][ni], 0, 0, 0);
            if (kt + 1 < nk) { *(LAS u32x4*)(As + (cur ^ 1) * 5120 + lrow * 40 + lch * 8) = ra; *(LAS u32x4*)(Bs + (cur ^ 1) * 5120 + lrow * 40 + lch * 8) = rb; }
            __syncthreads();
        }
#pragma unroll
        for (int mi = 0; mi < 2; ++mi) {
            const int m = m0 + wr * 32 + mi * 16 + fr;
            if (MODE == 1) {
#pragma unroll
                for (int q = 0; q < 2; ++q) {
                    const int hc = tn * 64 + wc * 32 + q * 16 + 4 * fq;
                    const f32x4 bg = *(const f32x4*)(g.bias + (size_t)e * g.bias_es + hc), bu = *(const f32x4*)(g.bias + (size_t)e * g.bias_es + 1024 + hc);
                    const f32x4 gt = acc[mi][2 * q] + bg, up = acc[mi][2 * q + 1] + bu;
                    u32x2 w; w.x = pack2(swiglu(gt[0], up[0]), swiglu(gt[1], up[1])); w.y = pack2(swiglu(gt[2], up[2]), swiglu(gt[3], up[3]));
                    *(u32x2*)(g.Cb + (size_t)m * g.ldc + hc) = w;
                }
            } else {
#pragma unroll
                for (int ni = 0; ni < 4; ++ni) {
                    const int n = tn * 128 + wc * 64 + ni * 16 + 4 * fq;
                    f32x4 v = acc[mi][ni];
                    if (g.bias) v += *(const f32x4*)(g.bias + (size_t)e * g.bias_es + n);
                    if (g.Cf) *(f32x4*)(g.Cf + (size_t)m * g.ldc + n) = v;
                    else { u32x2 w; w.x = pack2(v[0], v[1]); w.y = pack2(v[2], v[3]); *(u32x2*)(g.Cb + (size_t)m * g.ldc + n) = w; }
                }
            }
        }
    }
}


namespace g8 {
constexpr int BM = 256, BK = 64, HALF = 128, HTB = HALF * BK * 2, STAGE_BYTES = 8 * HTB, NXCD = 8, WGM = 8;
__device__ __forceinline__ int lds_byte(int r, int c) { const int st = (r >> 4) * 2 + (c >> 5), rr = r & 15, cc = c & 31, ob = rr * 64 + cc * 2; return st * 1024 + (ob ^ (((ob >> 9) & 1) << 5)); }
__device__ __forceinline__ void stage_rc(int b, int& R, int& C) { const int st = b / 1024, sb = b % 1024, swz = sb ^ (((sb >> 9) & 1) << 5); R = (st >> 1) * 16 + swz / 64; C = (st & 1) * 32 + (swz % 64) / 2; }
__device__ __forceinline__ int perm32(int rho) { const int n = rho >> 4, i = rho & 15; return 8 * (i >> 2) + 4 * n + (i & 3); }
__device__ __forceinline__ unsigned cvt_pk_bf16(float lo, float hi) { unsigned r; asm volatile("v_cvt_pk_bf16_f32 %0, %1, %2" : "=v"(r) : "v"(lo), "v"(hi)); return r; }

struct Unit { const char* a0; const char* a1; const char* b0; const char* b1; const int* rows; int row0, col0, e; };

struct SchedPlain {
    const char* A; const char* Bt; size_t hstepA, hstepB; int nM, nN, nwg, G, c;
    __device__ __forceinline__ void init(const void* A_, const void* Bt_, int M, int N, int K, int G_, int c_) { A = (const char*)A_; Bt = (const char*)Bt_; hstepA = (size_t)HALF * K * 2; hstepB = hstepA; nM = M / BM; nN = N / BM; nwg = nM * nN; G = G_; c = c_; }
    __device__ __forceinline__ bool next(int i, Unit& u) const {
        const long L = (long)i * G + c; if (L >= nwg) return false;
        int wgid = (int)L; { const int q = nwg / NXCD, r = nwg % NXCD, xcd = wgid % NXCD, off = wgid / NXCD; wgid = (xcd < r ? xcd * (q + 1) : r * (q + 1) + (xcd - r) * q) + off; }
        const int nig = WGM * nN, gid = wgid / nig, fm = gid * WGM, gsz = (nM - fm) < WGM ? (nM - fm) : WGM;
        const int pm = fm + ((wgid % nig) % gsz), pn = (wgid % nig) / gsz;
        u.a0 = A + (size_t)pm * 2 * hstepA; u.a1 = u.a0 + hstepA; u.b0 = Bt + (size_t)pn * 2 * hstepB; u.b1 = u.b0 + hstepB; u.rows = nullptr; u.row0 = pm * BM; u.col0 = pn * BM; u.e = 0;
        return true;
    }
};
struct SchedGU {
    const char* A; const char* W; const int* rowtok; const unsigned* texp; int ntiles, G, c;
    __device__ __forceinline__ bool next(int i, Unit& u) const {
        const int L = i * G + c, rt = L >> 3, pn = L & 7; if (rt >= ntiles) return false;
        const int e = (int)texp[rt];
        u.a0 = A; u.a1 = A; u.rows = rowtok + rt * BM; u.b0 = W + ((size_t)e * 2048 + pn * 128) * (D * 2); u.b1 = u.b0 + (size_t)1024 * D * 2; u.row0 = rt * BM; u.col0 = pn * 128; u.e = e;
        return true;
    }
};
struct SchedDown {
    const char* A; const char* W; const unsigned* texp; int ntiles, G, c;
    __device__ __forceinline__ bool next(int i, Unit& u) const {
        const int L = i * G + c, rt = L >> 2, pn = L & 3; if (rt >= ntiles) return false;
        const int e = (int)texp[rt];
        u.a0 = A + (size_t)rt * BM * D * 2; u.a1 = u.a0 + (size_t)HALF * D * 2; u.rows = nullptr; u.b0 = W + ((size_t)e * 1024 + pn * BM) * (D * 2); u.b1 = u.b0 + (size_t)HALF * D * 2; u.row0 = rt * BM; u.col0 = pn * BM; u.e = e;
        return true;
    }
};

struct EpiF32 {
    static constexpr bool PERM = false;
    float* C; int ldc; const float* bias; int bias_es;
    __device__ __forceinline__ void operator()(const f32x4 (&acc)[2][2][4][2], const Unit& u, int wr, int wc, int fr, int fq) const {
        const int row0 = u.row0 + wr * 64 + fr, col0 = u.col0 + wc * 32 + 4 * fq;
        f32x4 bv[2][2];
#pragma unroll
        for (int bj = 0; bj < 2; ++bj)
#pragma unroll
            for (int n = 0; n < 2; ++n) bv[bj][n] = bias ? *(const f32x4*)(bias + (size_t)u.e * bias_es + col0 + bj * HALF + n * 16) : (f32x4){0.f, 0.f, 0.f, 0.f};
#pragma unroll
        for (int ai = 0; ai < 2; ++ai)
#pragma unroll
            for (int m = 0; m < 4; ++m) { float* rowp = C + (size_t)(row0 + ai * HALF + m * 16) * ldc + col0;
#pragma unroll
                for (int bj = 0; bj < 2; ++bj)
#pragma unroll
                    for (int n = 0; n < 2; ++n) *(f32x4*)(rowp + bj * HALF + n * 16) = acc[ai][bj][m][n] + bv[bj][n]; }
    }
};
struct EpiBf16 {
    static constexpr bool PERM = true;
    bf16_t* O; int ldc;
    __device__ __forceinline__ void operator()(const f32x4 (&acc)[2][2][4][2], const Unit& u, int wr, int wc, int fr, int fq) const {
        const int row0 = u.row0 + wr * 64 + fr, col0 = u.col0 + wc * 32 + 8 * fq;
#pragma unroll
        for (int ai = 0; ai < 2; ++ai)
#pragma unroll
            for (int m = 0; m < 4; ++m) { bf16_t* rowp = O + (size_t)(row0 + ai * HALF + m * 16) * ldc + col0;
#pragma unroll
                for (int bj = 0; bj < 2; ++bj) { const f32x4 v0 = acc[ai][bj][m][0], v1 = acc[ai][bj][m][1];
                    u32x4 w; w.x = cvt_pk_bf16(v0[0], v0[1]); w.y = cvt_pk_bf16(v0[2], v0[3]); w.z = cvt_pk_bf16(v1[0], v1[1]); w.w = cvt_pk_bf16(v1[2], v1[3]);
                    *(u32x4*)(rowp + bj * HALF) = w; } }
    }
};
struct EpiSwiglu {
    static constexpr bool PERM = true;
    bf16_t* O; const float* bias;
    __device__ __forceinline__ void operator()(const f32x4 (&acc)[2][2][4][2], const Unit& u, int wr, int wc, int fr, int fq) const {
        const int row0 = u.row0 + wr * 64 + fr, hc = u.col0 + wc * 32 + 8 * fq;
        const float* bp = bias + (size_t)u.e * 2048 + hc;
        const f32x4 bg0 = *(const f32x4*)(bp), bg1 = *(const f32x4*)(bp + 4), bu0 = *(const f32x4*)(bp + 1024), bu1 = *(const f32x4*)(bp + 1028);
#pragma unroll
        for (int ai = 0; ai < 2; ++ai)
#pragma unroll
            for (int m = 0; m < 4; ++m) {
                const f32x4 g0 = acc[ai][0][m][0] + bg0, g1 = acc[ai][0][m][1] + bg1, u0 = acc[ai][1][m][0] + bu0, u1 = acc[ai][1][m][1] + bu1;
                u32x4 w; w.x = cvt_pk_bf16(swiglu(g0[0], u0[0]), swiglu(g0[1], u0[1])); w.y = cvt_pk_bf16(swiglu(g0[2], u0[2]), swiglu(g0[3], u0[3]));
                w.z = cvt_pk_bf16(swiglu(g1[0], u1[0]), swiglu(g1[1], u1[1])); w.w = cvt_pk_bf16(swiglu(g1[2], u1[2]), swiglu(g1[3], u1[3]));
                *(u32x4*)(O + (size_t)(row0 + ai * HALF + m * 16) * D + hc) = w;
            }
    }
};

template <class Epi, class Sched, bool GATHER>
__device__ __forceinline__ void gemm_phase(LAS unsigned char* lds, const int K, const Sched& S, const Epi& E) {
    const int tid = tid_(), wid = __builtin_amdgcn_readfirstlane(tid >> 6), lane = tid & 63, wr = wid >> 2, wc = wid & 3, fr = lane & 15, fq = lane >> 4;
    const int nt = K / BK;
    int sR[2], sC[2];
    unsigned voffB[2];
#pragma unroll
    for (int i = 0; i < 2; ++i) { stage_rc(tid * 16 + i * 8192, sR[i], sC[i]); const int Rb = Epi::PERM ? ((sR[i] & ~31) + perm32(sR[i] & 31)) : sR[i]; voffB[i] = (unsigned)(Rb * K + sC[i]) * 2u; }
    unsigned cvA0[2], cvA1[2], nvA0[2], nvA1[2];
#define G8_VOFF(u, v0, v1) do { _Pragma("unroll") for (int _i = 0; _i < 2; ++_i) { \
        if (GATHER) { v0[_i] = (unsigned)((u).rows[sR[_i]] * K + sC[_i]) * 2u; v1[_i] = (unsigned)((u).rows[HALF + sR[_i]] * K + sC[_i]) * 2u; } \
        else { v0[_i] = (unsigned)(sR[_i] * K + sC[_i]) * 2u; v1[_i] = v0[_i]; } } } while (0)
    const size_t kstep = (size_t)(BK * 2);
    const unsigned ldsw = (unsigned)wid * 1024u;
    const int aoff = lds_byte(wr * 64 + fr, fq * 8), boff = lds_byte(wc * 32 + fr, fq * 8);
#define PG8_SA(b, h) (((b) * 2 + (h)) * HTB)
#define PG8_SB(b, h) ((4 + (b) * 2 + (h)) * HTB)
#define PG8_STAGE(bufoff, gbase, voff) do { _Pragma("unroll") for (int _i = 0; _i < 2; ++_i) \
        __builtin_amdgcn_global_load_lds((const unsigned*)((const char*)(gbase) + (voff)[_i]), (LAS unsigned*)(lds + (bufoff) + ldsw + _i * 8192), 16, 0, 0); } while (0)
#define PG8_LDA(dst, b, h) do { _Pragma("unroll") for (int m = 0; m < 4; ++m) _Pragma("unroll") for (int k = 0; k < 2; ++k) dst[m][k] = *(const LAS bf16x8*)(lds + PG8_SA(b, h) + aoff + m * 2048 + k * 1024); } while (0)
#define PG8_LDB(dst, b, h) do { _Pragma("unroll") for (int n = 0; n < 2; ++n) _Pragma("unroll") for (int k = 0; k < 2; ++k) dst[n][k] = *(const LAS bf16x8*)(lds + PG8_SB(b, h) + boff + n * 2048 + k * 1024); } while (0)
#define PG8_MMA(ai, bj, At, Bt) do { __builtin_amdgcn_s_setprio(1); _Pragma("unroll") for (int m = 0; m < 4; ++m) _Pragma("unroll") for (int n = 0; n < 2; ++n) _Pragma("unroll") for (int k = 0; k < 2; ++k) \
        acc[ai][bj][m][n] = __builtin_amdgcn_mfma_f32_16x16x32_bf16(Bt[n][k], At[m][k], acc[ai][bj][m][n], 0, 0, 0); __builtin_amdgcn_s_setprio(0); } while (0)
#define PG8_WAIT_V(n) asm volatile("s_waitcnt vmcnt(" #n ")" ::: "memory")
#define PG8_WAIT_L(n) asm volatile("s_waitcnt lgkmcnt(" #n ")" ::: "memory")
#define PG8_BAR __builtin_amdgcn_s_barrier()
#define PG8_SCHED __builtin_amdgcn_sched_barrier(0)
    Unit cur, nxt; int ui = 0;
    if (!S.next(0, cur)) return;
    f32x4 acc[2][2][4][2];
#pragma unroll
    for (int a = 0; a < 2; ++a)
#pragma unroll
        for (int b = 0; b < 2; ++b)
#pragma unroll
            for (int m = 0; m < 4; ++m)
#pragma unroll
                for (int n = 0; n < 2; ++n) acc[a][b][m][n] = (f32x4){0.f, 0.f, 0.f, 0.f};
    bf16x8 At[4][2], B0[2][2], B1[2][2];
    const char* cA0 = cur.a0; const char* cA1 = cur.a1; const char* cB0 = cur.b0; const char* cB1 = cur.b1;
    G8_VOFF(cur, cvA0, cvA1);
    PG8_STAGE(PG8_SB(0, 0), cB0, voffB); PG8_STAGE(PG8_SB(0, 1), cB1, voffB); PG8_STAGE(PG8_SA(0, 0), cA0, cvA0); PG8_STAGE(PG8_SA(0, 1), cA1, cvA1);
    if (wr == 1) PG8_BAR;
    PG8_WAIT_V(2); PG8_BAR;
    PG8_STAGE(PG8_SB(1, 0), cB0 + kstep, voffB); PG8_STAGE(PG8_SA(1, 0), cA0 + kstep, cvA0); PG8_STAGE(PG8_SB(1, 1), cB1 + kstep, voffB);
    PG8_WAIT_V(6); PG8_BAR;
    for (;;) {
        const bool has_next = S.next(ui + 1, nxt);
        const char* nA0 = has_next ? nxt.a0 : cA0; const char* nA1 = has_next ? nxt.a1 : cA1; const char* nB0 = has_next ? nxt.b0 : cB0; const char* nB1 = has_next ? nxt.b1 : cB1;
        if (GATHER) { if (has_next) { G8_VOFF(nxt, nvA0, nvA1); } else { nvA0[0] = cvA0[0]; nvA0[1] = cvA0[1]; nvA1[0] = cvA1[0]; nvA1[1] = cvA1[1]; } }
        for (int t = 0; t < nt; t += 2) {
            const bool last = (t == nt - 2);
            const char* a1_1 = cA1 + (size_t)(t + 1) * kstep;
            const char* a2_0 = last ? nA0 : cA0 + (size_t)(t + 2) * kstep; const char* a2_1 = last ? nA1 : cA1 + (size_t)(t + 2) * kstep;
            const char* b2_0 = last ? nB0 : cB0 + (size_t)(t + 2) * kstep; const char* b2_1 = last ? nB1 : cB1 + (size_t)(t + 2) * kstep;
            const char* a3_0 = a2_0 + kstep; const char* b3_0 = b2_0 + kstep; const char* b3_1 = b2_1 + kstep;
            unsigned vA0[2], vA1[2];
            if (GATHER) { vA0[0] = last ? nvA0[0] : cvA0[0]; vA0[1] = last ? nvA0[1] : cvA0[1]; vA1[0] = last ? nvA1[0] : cvA1[0]; vA1[1] = last ? nvA1[1] : cvA1[1]; }
            else { vA0[0] = cvA0[0]; vA0[1] = cvA0[1]; vA1[0] = cvA0[0]; vA1[1] = cvA0[1]; }
            PG8_LDB(B0, 0, 0); PG8_LDB(B1, 0, 1); PG8_SCHED; PG8_LDA(At, 0, 0); PG8_STAGE(PG8_SA(1, 1), a1_1, cvA1);
            PG8_WAIT_V(8); PG8_WAIT_L(0); PG8_BAR; PG8_MMA(0, 0, At, B0); PG8_MMA(0, 1, At, B1); PG8_BAR; PG8_SCHED;
            PG8_LDA(At, 0, 1); PG8_STAGE(PG8_SB(0, 0), b2_0, voffB); PG8_STAGE(PG8_SB(0, 1), b2_1, voffB); PG8_STAGE(PG8_SA(0, 0), a2_0, vA0);
            PG8_WAIT_V(8); PG8_WAIT_L(0); PG8_BAR; PG8_MMA(1, 0, At, B0); PG8_MMA(1, 1, At, B1); PG8_BAR; PG8_SCHED;
            PG8_LDB(B0, 1, 0); PG8_LDB(B1, 1, 1); PG8_SCHED; PG8_LDA(At, 1, 0); PG8_STAGE(PG8_SA(0, 1), a2_1, vA1);
            PG8_WAIT_V(8); PG8_WAIT_L(0); PG8_BAR; PG8_MMA(0, 0, At, B0); PG8_MMA(0, 1, At, B1); PG8_BAR; PG8_SCHED;
            PG8_LDA(At, 1, 1); PG8_STAGE(PG8_SB(1, 0), b3_0, voffB); PG8_STAGE(PG8_SB(1, 1), b3_1, voffB); PG8_STAGE(PG8_SA(1, 0), a3_0, vA0);
            PG8_WAIT_V(8); PG8_WAIT_L(0); PG8_BAR; PG8_MMA(1, 0, At, B0); PG8_MMA(1, 1, At, B1); PG8_BAR; PG8_SCHED;
        }
        if (wr == 0) PG8_BAR;
        E(acc, cur, wr, wc, fr, fq);
        if (!has_next) break;
#pragma unroll
        for (int a = 0; a < 2; ++a)
#pragma unroll
            for (int b = 0; b < 2; ++b)
#pragma unroll
                for (int m = 0; m < 4; ++m)
#pragma unroll
                    for (int n = 0; n < 2; ++n) acc[a][b][m][n] = (f32x4){0.f, 0.f, 0.f, 0.f};
        cur = nxt; cA0 = nA0; cA1 = nA1; cB0 = nB0; cB1 = nB1; ++ui;
        if (GATHER) { cvA0[0] = nvA0[0]; cvA0[1] = nvA0[1]; cvA1[0] = nvA1[0]; cvA1[1] = nvA1[1]; }
        if (wr == 1) PG8_BAR;
    }
    PG8_WAIT_V(0);
    PG8_BAR;
#undef G8_VOFF
#undef PG8_SA
#undef PG8_SB
#undef PG8_STAGE
#undef PG8_LDA
#undef PG8_LDB
#undef PG8_MMA
#undef PG8_WAIT_V
#undef PG8_WAIT_L
#undef PG8_BAR
#undef PG8_SCHED
}
}

__device__ __forceinline__ float gelu_fast(float x) { const float u2 = 1.5957691216057308f * (x + 0.044715f * x * x * x); return x / (1.0f + __expf(-u2)); }
__device__ void lru_gates_phase(LAS unsigned char* lds, const Params& p, int idx) {
    const int tid = tid_(), lane = tid & 63, wid = tid >> 6, fr = lane & 15, fq = lane >> 4;
    LAS bf16_t* xcb = (LAS bf16_t*)lds;
    LAS float* xcf = (LAS float*)(lds + 17408);
    LAS float* sa = (LAS float*)(lds + 17408 + 33792);
    LAS float* sb = sa + 64 * 132;
    LAS float* comb = sb + 64 * 132;
    const bf16_t* u = (const bf16_t*)(p.ws + WS_U);
    float* Aarr = (float*)(p.ws + WS_SCR); float* Barr = Aarr + (size_t)T * D;
    float* SP = (float*)(p.ws + WS_LSUM); float* SH = SP + NBATCH * 32 * D;
    const int hd = blockIdx.x & 7, slot = blockIdx.x >> 3, nslots = gridDim.x >> 3;
    const float* conv_w = p.a_conv_w + (size_t)idx * 4 * D; const float* conv_b = p.a_conv_b + (size_t)idx * D;
    const bf16_t* wrt = (const bf16_t*)(p.ws + WS_AGT) + ((size_t)(idx * 2 + 0) * 8 + hd) * 128 * 128;
    const bf16_t* wit = (const bf16_t*)(p.ws + WS_AGT) + ((size_t)(idx * 2 + 1) * 8 + hd) * 128 * 128;
    bf16x8 Br[4], Bi[4];
#pragma unroll
    for (int ks = 0; ks < 4; ++ks) { Br[ks] = *(const bf16x8*)(wrt + (size_t)(16 * wid + fr) * 128 + 32 * ks + 8 * fq); Bi[ks] = *(const bf16x8*)(wit + (size_t)(16 * wid + fr) * 128 + 32 * ks + 8 * fq); }
    const int cg = hd * 128 + 16 * wid + 4 * fq;
    const f32x4 brv = *(const f32x4*)(p.a_b_rgate + (size_t)idx * D + cg), biv = *(const f32x4*)(p.a_b_igate + (size_t)idx * D + cg), lmv = *(const f32x4*)(p.a_lambda + (size_t)idx * D + cg);
    f32x4 spv;
#pragma unroll
    for (int r = 0; r < 4; ++r) spv[r] = (lmv[r] > 15.f) ? __expf(-lmv[r]) : log1pf(__expf(-lmv[r]));
    const int cc = (tid & 31) * 4, cch = hd * 128 + cc;
    f32x4 cw[4];
#pragma unroll
    for (int j = 0; j < 4; ++j) cw[j] = *(const f32x4*)(conv_w + j * D + cch);
    const f32x4 cb = *(const f32x4*)(conv_b + cch);
    for (int tile = slot; tile < T / 64; tile += nslots) {
        const int t0 = tile * 64;
#pragma unroll
        for (int k = 0; k < 4; ++k) {
            const int tl = (tid >> 5) + 16 * k, t = t0 + tl, s_ = t & (SEQ - 1);
            f32x4 acc = cb;
#pragma unroll
            for (int j = 0; j < 4; ++j) {
                if (s_ - 3 + j >= 0) {
                    const u32x2 rv = *(const u32x2*)(u + (size_t)(t - 3 + j) * 2048 + 1024 + cch);
                    acc[0] += cw[j][0] * __uint_as_float(rv.x << 16); acc[1] += cw[j][1] * __uint_as_float(rv.x & 0xffff0000u);
                    acc[2] += cw[j][2] * __uint_as_float(rv.y << 16); acc[3] += cw[j][3] * __uint_as_float(rv.y & 0xffff0000u);
                }
            }
            *(LAS f32x4*)(xcf + tl * 132 + cc) = acc;
            u32x2 w; w.x = pack2(acc[0], acc[1]); w.y = pack2(acc[2], acc[3]);
            *(LAS u32x2*)(xcb + tl * 136 + cc) = w;
        }
        __syncthreads();
        f32x4 ar[4], ai[4];
#pragma unroll
        for (int mt = 0; mt < 4; ++mt) { ar[mt] = (f32x4){0.f, 0.f, 0.f, 0.f}; ai[mt] = (f32x4){0.f, 0.f, 0.f, 0.f}; }
#pragma unroll
        for (int ks = 0; ks < 4; ++ks)
#pragma unroll
            for (int mt = 0; mt < 4; ++mt) {
                const bf16x8 af = *(const LAS bf16x8*)(xcb + (mt * 16 + fr) * 136 + 32 * ks + 8 * fq);
                ar[mt] = __builtin_amdgcn_mfma_f32_16x16x32_bf16(Br[ks], af, ar[mt], 0, 0, 0);
                ai[mt] = __builtin_amdgcn_mfma_f32_16x16x32_bf16(Bi[ks], af, ai[mt], 0, 0, 0);
            }
#pragma unroll
        for (int mt = 0; mt < 4; ++mt) {
            const int tl = mt * 16 + fr, cl = 16 * wid + 4 * fq;
            const f32x4 rec = *(const LAS f32x4*)(xcf + tl * 132 + cl);
            f32x4 av, bv;
#pragma unroll
            for (int r = 0; r < 4; ++r) {
                const float rg = sigmoidf_(ar[mt][r] + brv[r]), ig = sigmoidf_(ai[mt][r] + biv[r]);
                const float log_a = -8.0f * rg * spv[r];
                av[r] = __expf(log_a);
                bv[r] = sqrtf(fmaxf(-expm1f(2.0f * log_a), 0.f)) * ig * rec[r];
            }
            *(f32x4*)(Aarr + (size_t)(t0 + tl) * D + cg) = av; *(f32x4*)(Barr + (size_t)(t0 + tl) * D + cg) = bv;
            *(LAS f32x4*)(sa + tl * 132 + cl) = av; *(LAS f32x4*)(sb + tl * 132 + cl) = bv;
        }
        __syncthreads();
        {
            const int j = tid & 127, q = tid >> 7;
            float P = 1.f, H = 0.f;
#pragma unroll
            for (int s_ = 0; s_ < 16; ++s_) { const float a = sa[(q * 16 + s_) * 132 + j], bb = sb[(q * 16 + s_) * 132 + j]; H = a * H + bb; P *= a; }
            comb[(q * 128 + j) * 2 + 0] = P; comb[(q * 128 + j) * 2 + 1] = H;
        }
        __syncthreads();
        if (tid < 128) {
            float P = comb[tid * 2], H = comb[tid * 2 + 1];
#pragma unroll
            for (int q = 1; q < 4; ++q) { const float Pq = comb[(q * 128 + tid) * 2], Hq = comb[(q * 128 + tid) * 2 + 1]; H = Pq * H + Hq; P *= Pq; }
            SP[(size_t)tile * D + hd * 128 + tid] = P; SH[(size_t)tile * D + hd * 128 + tid] = H;
        }
    }
}
__device__ void lru_scan_phase(const Params& p) {
    const int tid = tid_();
    const bf16_t* u = (const bf16_t*)(p.ws + WS_U);
    const float* Aarr = (const float*)(p.ws + WS_SCR); const float* Barr = Aarr + (size_t)T * D;
    const float* SP = (const float*)(p.ws + WS_LSUM); const float* SH = SP + NBATCH * 32 * D;
    bf16_t* yin = (bf16_t*)(p.ws + WS_YIN);
    const int nunits = NBATCH * 32 * 2;
    for (int un = blockIdx.x; un < nunits; un += gridDim.x) {
        const int tile = un >> 1, c = (un & 1) * 512 + tid, b = tile >> 5, chunk = tile & 31;
        float h = 0.f;
        for (int k = 0; k < chunk; ++k) h = SP[(size_t)(b * 32 + k) * D + c] * h + SH[(size_t)(b * 32 + k) * D + c];
        const size_t tb = (size_t)tile * 64;
#pragma unroll 16
        for (int s_ = 0; s_ < 64; ++s_) {
            const size_t t = tb + s_;
            h = Aarr[t * D + c] * h + Barr[t * D + c];
            yin[t * D + c] = f2bf(gelu_fast(bf2f(u[t * 2048 + c])) * h);
        }
    }
}

typedef short s16x4 __attribute__((ext_vector_type(4)));
__device__ __forceinline__ s16x4 tr4(LAS const unsigned char* base, int row0, int col0, int stride, int lane) {
    const int q = (lane & 15) >> 2, pp = lane & 3;
    return __builtin_amdgcn_ds_read_tr16_b64_v4i16((LAS s16x4*)(base + (row0 + q) * stride + (col0 + 4 * pp) * 2));
}
__device__ __forceinline__ bf16x8 cat8(s16x4 a, s16x4 b) { return (bf16x8){a[0], a[1], a[2], a[3], b[0], b[1], b[2], b[3]}; }
__device__ void ret_core_phase(LAS unsigned char* lds, const Params& p) {
    const int tid = tid_(), lane = tid & 63, wid = tid >> 6, fr = lane & 15, fq = lane >> 4;
    constexpr int KS = 544, VS = 160, SS = 528;
    LAS unsigned char* Kl = lds;
    LAS unsigned char* Vl = lds + 128 * KS;
    LAS unsigned char* Sl = Vl + 128 * VS;
    const bf16_t* u = (const bf16_t*)(p.ws + WS_U);
    float* RO = (float*)(p.ws + WS_SCR);
    for (int un = blockIdx.x; un < NBATCH * 4 * 8; un += gridDim.x) {
        const int b = un >> 5, h = (un >> 3) & 3, vs = un & 7;
        const float lg2 = log2f(1.0f - exp2f(-5.0f - (float)h));
        f32x4 Sacc[2][4];
#pragma unroll
        for (int dt = 0; dt < 2; ++dt)
#pragma unroll
            for (int vt = 0; vt < 4; ++vt) Sacc[dt][vt] = (f32x4){0.f, 0.f, 0.f, 0.f};
        for (int i = tid; i < 64 * SS / 16; i += NTHREADS) ((LAS u32x4*)Sl)[i] = (u32x4){0u, 0u, 0u, 0u};
        for (int chunk = 0; chunk < 16; ++chunk) {
            const size_t t0 = (size_t)b * SEQ + chunk * 128;
#pragma unroll
            for (int i = 0; i < 8; ++i) {
                const int piece = tid + NTHREADS * i, m = piece >> 5, ch = piece & 31;
                const u32x4 kv = *(const u32x4*)(u + (t0 + m) * 6144 + 1024 + h * 256 + ch * 8);
                const float sc = exp2f(-(float)(m + 1) * lg2) * 0.0625f;
                u32x4 w;
                w.x = pack2(__uint_as_float(kv.x << 16) * sc, __uint_as_float(kv.x & 0xffff0000u) * sc); w.y = pack2(__uint_as_float(kv.y << 16) * sc, __uint_as_float(kv.y & 0xffff0000u) * sc);
                w.z = pack2(__uint_as_float(kv.z << 16) * sc, __uint_as_float(kv.z & 0xffff0000u) * sc); w.w = pack2(__uint_as_float(kv.w << 16) * sc, __uint_as_float(kv.w & 0xffff0000u) * sc);
                *(LAS u32x4*)(Kl + m * KS + ch * 16) = w;
            }
#pragma unroll
            for (int i = 0; i < 2; ++i) {
                const int piece = tid + NTHREADS * i, m = piece >> 3, ch = piece & 7;
                *(LAS u32x4*)(Vl + m * VS + ch * 16) = *(const u32x4*)(u + (t0 + m) * 6144 + 2048 + h * 512 + vs * 64 + ch * 8);
            }
            bf16x8 Qf[8];
#pragma unroll
            for (int ks = 0; ks < 8; ++ks) Qf[ks] = *(const bf16x8*)(u + (t0 + 16 * wid + fr) * 6144 + h * 256 + 32 * ks + 8 * fq);
            __syncthreads();
            f32x4 sc[8];
#pragma unroll
            for (int mt = 0; mt < 8; ++mt) {
                sc[mt] = (f32x4){0.f, 0.f, 0.f, 0.f};
#pragma unroll
                for (int ks = 0; ks < 8; ++ks) {
                    const bf16x8 kf = *(const LAS bf16x8*)(Kl + (16 * mt + fr) * KS + (32 * ks + 8 * fq) * 2);
                    sc[mt] = __builtin_amdgcn_mfma_f32_16x16x32_bf16(kf, Qf[ks], sc[mt], 0, 0, 0);
                }
            }
            bf16x8 pf[4];
            const int nloc = 16 * wid + fr;
#pragma unroll
            for (int ks2 = 0; ks2 < 4; ++ks2) {
                float v[8];
#pragma unroll
                for (int t = 0; t < 2; ++t)
#pragma unroll
                    for (int r = 0; r < 4; ++r) { const int m = 32 * ks2 + 16 * t + 4 * fq + r; v[4 * t + r] = (m <= nloc) ? sc[2 * ks2 + t][r] : 0.f; }
                u32x4 w; w.x = pack2(v[0], v[1]); w.y = pack2(v[2], v[3]); w.z = pack2(v[4], v[5]); w.w = pack2(v[6], v[7]);
                pf[ks2] = __builtin_bit_cast(bf16x8, w);
            }
            f32x4 O[4];
#pragma unroll
            for (int vt = 0; vt < 4; ++vt) {
                O[vt] = (f32x4){0.f, 0.f, 0.f, 0.f};
#pragma unroll
                for (int ks2 = 0; ks2 < 4; ++ks2) {
                    const bf16x8 vf = cat8(tr4(Vl, 32 * ks2 + 4 * fq, 16 * vt, VS, lane), tr4(Vl, 32 * ks2 + 16 + 4 * fq, 16 * vt, VS, lane));
                    O[vt] = __builtin_amdgcn_mfma_f32_16x16x32_bf16(pf[ks2], vf, O[vt], 0, 0, 0);
                }
#pragma unroll
                for (int ks = 0; ks < 8; ++ks) {
                    const bf16x8 sf = *(const LAS bf16x8*)(Sl + (16 * vt + fr) * SS + (32 * ks + 8 * fq) * 2);
                    O[vt] = __builtin_amdgcn_mfma_f32_16x16x32_bf16(Qf[ks], sf, O[vt], 0, 0, 0);
                }
            }
#pragma unroll
            for (int r = 0; r < 4; ++r) {
                const int n = 16 * wid + 4 * fq + r;
                const float qd = exp2f((float)(n + 1) * lg2);
                float* op = RO + (t0 + n) * 2048 + h * 512 + vs * 64 + fr;
#pragma unroll
                for (int vt = 0; vt < 4; ++vt) op[16 * vt] = O[vt][r] * qd;
            }
#pragma unroll
            for (int ks3 = 0; ks3 < 4; ++ks3) {
                bf16x8 kt[2], vf[4];
#pragma unroll
                for (int dt = 0; dt < 2; ++dt) kt[dt] = cat8(tr4(Kl, 32 * ks3 + 8 * fq, 32 * wid + 16 * dt, KS, lane), tr4(Kl, 32 * ks3 + 8 * fq + 4, 32 * wid + 16 * dt, KS, lane));
#pragma unroll
                for (int vt = 0; vt < 4; ++vt) vf[vt] = cat8(tr4(Vl, 32 * ks3 + 8 * fq, 16 * vt, VS, lane), tr4(Vl, 32 * ks3 + 8 * fq + 4, 16 * vt, VS, lane));
#pragma unroll
                for (int dt = 0; dt < 2; ++dt)
#pragma unroll
                    for (int vt = 0; vt < 4; ++vt) Sacc[dt][vt] = __builtin_amdgcn_mfma_f32_16x16x32_bf16(kt[dt], vf[vt], Sacc[dt][vt], 0, 0, 0);
            }
            __syncthreads();
            const float cd = exp2f(128.0f * lg2);
#pragma unroll
            for (int dt = 0; dt < 2; ++dt)
#pragma unroll
                for (int vt = 0; vt < 4; ++vt) {
                    Sacc[dt][vt] *= cd;
                    u32x2 w; w.x = pack2(Sacc[dt][vt][0], Sacc[dt][vt][1]); w.y = pack2(Sacc[dt][vt][2], Sacc[dt][vt][3]);
                    *(LAS u32x2*)(Sl + (16 * vt + fr) * SS + (32 * wid + 16 * dt + 4 * fq) * 2) = w;
                }
        }
        __syncthreads();
    }
}
__device__ void ret_norm_phase(LAS unsigned char* lds, const Params& p) {
    const int tid = tid_(), lane = tid & 63, wid = tid >> 6;
    LAS float* red = (LAS float*)lds;
    const bf16_t* u = (const bf16_t*)(p.ws + WS_U);
    const float* RO = (const float*)(p.ws + WS_SCR);
    bf16_t* yin = (bf16_t*)(p.ws + WS_YIN);
    for (int t = blockIdx.x; t < T; t += gridDim.x) {
        const f32x4 o = *(const f32x4*)(RO + (size_t)t * 2048 + tid * 4);
        const float ss = wave_sum(o[0] * o[0] + o[1] * o[1] + o[2] * o[2] + o[3] * o[3]);
        if (lane == 0) red[wid] = ss;
        __syncthreads();
        const float tot = red[(wid & ~1)] + red[(wid | 1)];
        const float rstd = rsqrtf(tot * (1.0f / 512.0f) + 1e-6f);
        const u32x2 gv = *(const u32x2*)(u + (size_t)t * 6144 + 4096 + tid * 4);
        const float g0 = __uint_as_float(gv.x << 16), g1 = __uint_as_float(gv.x & 0xffff0000u), g2 = __uint_as_float(gv.y << 16), g3 = __uint_as_float(gv.y & 0xffff0000u);
        u32x2 w; w.x = pack2(g0 * sigmoidf_(g0) * o[0] * rstd, g1 * sigmoidf_(g1) * o[1] * rstd); w.y = pack2(g2 * sigmoidf_(g2) * o[2] * rstd, g3 * sigmoidf_(g3) * o[3] * rstd);
        *(u32x2*)(yin + (size_t)t * 2048 + tid * 4) = w;
        __syncthreads();
    }
}

__device__ void attn_core_phase(LAS unsigned char* lds, const Params& p) {
    const int tid = tid_(), lane = tid & 63, wid = tid >> 6;
    LAS float* qs = (LAS float*)lds + wid * 640;
    LAS float* ps = qs + 192;
    const bf16_t* u = (const bf16_t*)(p.ws + WS_U);
    bf16_t* yin = (bf16_t*)(p.ws + WS_YIN);
    const int niter = T * 16 / 8;
    for (int it = blockIdx.x; it < niter; it += gridDim.x) {
        const int wu = it * 8 + wid, t = wu >> 4, h = wu & 15, s = t & (SEQ - 1);
        const float slope = exp2f(-0.5f * (float)(h + 1));
        const bf16_t* ut = u + (size_t)t * 9216;
#pragma unroll
        for (int g = 0; g < 3; ++g) qs[g * 64 + lane] = bf2f(ut[g * 1024 + h * 64 + lane]);
        __syncthreads();
        float sc[3][3];
        float mx = -INFINITY;
#pragma unroll
        for (int g = 0; g < 3; ++g) {
            const int dl = (g == 0) ? 1 : (g == 1 ? 4 : 16);
#pragma unroll
            for (int ps_ = 0; ps_ < 3; ++ps_) {
                const int st = ps_ * 64 + lane;
                float v = -INFINITY;
                if (st <= 128 && s - st * dl >= 0) {
                    const bf16_t* kr = u + (size_t)(t - st * dl) * 9216 + (3 + g) * 1024 + h * 64;
                    float a = 0.f;
#pragma unroll
                    for (int c = 0; c < 8; ++c) {
                        const u32x4 kv = *(const u32x4*)(kr + c * 8);
                        a += qs[g * 64 + c * 8 + 0] * __uint_as_float(kv.x << 16) + qs[g * 64 + c * 8 + 1] * __uint_as_float(kv.x & 0xffff0000u);
                        a += qs[g * 64 + c * 8 + 2] * __uint_as_float(kv.y << 16) + qs[g * 64 + c * 8 + 3] * __uint_as_float(kv.y & 0xffff0000u);
                        a += qs[g * 64 + c * 8 + 4] * __uint_as_float(kv.z << 16) + qs[g * 64 + c * 8 + 5] * __uint_as_float(kv.z & 0xffff0000u);
                        a += qs[g * 64 + c * 8 + 6] * __uint_as_float(kv.w << 16) + qs[g * 64 + c * 8 + 7] * __uint_as_float(kv.w & 0xffff0000u);
                    }
                    v = a * 0.125f - slope * (float)(st * dl);
                }
                sc[g][ps_] = v; mx = fmaxf(mx, v);
            }
        }
        mx = wave_max(mx);
        float den = 0.f;
#pragma unroll
        for (int g = 0; g < 3; ++g)
#pragma unroll
            for (int ps_ = 0; ps_ < 3; ++ps_) {
                const int st = ps_ * 64 + lane;
                const float pv = (sc[g][ps_] == -INFINITY) ? 0.f : __expf(sc[g][ps_] - mx);
                den += pv;
                if (st <= 128) ps[g * 129 + st] = pv;
            }
        den = wave_sum(den);
        __syncthreads();
        float o = 0.f;
#pragma unroll
        for (int g = 0; g < 3; ++g) {
            const int dl = (g == 0) ? 1 : (g == 1 ? 4 : 16);
            const int nst = min(128, s / dl);
            for (int st = 0; st <= nst; ++st) o += ps[g * 129 + st] * bf2f(u[(size_t)(t - st * dl) * 9216 + (6 + g) * 1024 + h * 64 + lane]);
        }
        yin[(size_t)t * D + h * 64 + lane] = f2bf(o / den);
        __syncthreads();
    }
}

__device__ void ln_phase(const Params& p, int layer, int which) {
    const int tid = tid_(), lane = tid & 63, wid = tid >> 6;
    float* xf = (float*)(p.ws + WS_XF); bf16_t* xb = (bf16_t*)(p.ws + WS_XB);
    const float* ymix = (const float*)(p.ws + WS_YMIX);
    const float* yrows = (const float*)(p.ws + WS_YROWS);
    int* tope = (int*)(p.ws + WS_TOPE); float* gates = (float*)(p.ws + WS_GATES); int* pos = (int*)(p.ws + WS_POS); const int* dest = (const int*)(p.ws + WS_DEST);
    unsigned* ctl = (unsigned*)(p.ws + WS_CTL);
    const float* gain = p.ln_gain + (size_t)(layer * 2 + which) * D; const float* bias = p.ln_bias + (size_t)(layer * 2 + which) * D;
    const float* wrt = p.moe_w_router + (size_t)layer * D * NEXP; const float* brt = p.moe_b_router + (size_t)layer * NEXP;
    for (int t = blockIdx.x * 8 + wid; t < T; t += gridDim.x * 8) {
        f32x4 z[4];
        if (which == 0) {
#pragma unroll
            for (int i = 0; i < 4; ++i) { const int c = 256 * i + 4 * lane; z[i] = DN_ALPHA * *(const f32x4*)(xf + (size_t)t * D + c) + *(const f32x4*)(ymix + (size_t)t * D + c); }
        } else {
            int dk[4]; float gk[4];
#pragma unroll
            for (int k = 0; k < 4; ++k) { dk[k] = dest[t * 4 + k]; gk[k] = gates[t * 4 + k]; }
#pragma unroll
            for (int i = 0; i < 4; ++i) {
                const int c = 256 * i + 4 * lane;
                f32x4 f = (f32x4){0.f, 0.f, 0.f, 0.f};
#pragma unroll
                for (int k = 0; k < 4; ++k) f += gk[k] * *(const f32x4*)(yrows + (size_t)dk[k] * D + c);
                z[i] = DN_ALPHA * *(const f32x4*)(xf + (size_t)t * D + c) + f;
            }
        }
        float sm = 0.f;
#pragma unroll
        for (int i = 0; i < 4; ++i) sm += (z[i][0] + z[i][1]) + (z[i][2] + z[i][3]);
        const float mean = wave_sum(sm) * (1.0f / D);
        float sq = 0.f;
#pragma unroll
        for (int i = 0; i < 4; ++i) { const f32x4 dd = z[i] - mean; sq += (dd[0] * dd[0] + dd[1] * dd[1]) + (dd[2] * dd[2] + dd[3] * dd[3]); }
        const float rstd = rsqrtf(wave_sum(sq) * (1.0f / D) + LN_EPS);
#pragma unroll
        for (int i = 0; i < 4; ++i) {
            const int c = 256 * i + 4 * lane;
            z[i] = (z[i] - mean) * rstd * *(const f32x4*)(gain + c) + *(const f32x4*)(bias + c);
            *(f32x4*)(xf + (size_t)t * D + c) = z[i];
            u32x2 w; w.x = pack2(z[i][0], z[i][1]); w.y = pack2(z[i][2], z[i][3]);
            *(u32x2*)(xb + (size_t)t * D + c) = w;
            if (which == 1 && layer == DEPTH - 1) *(f32x4*)(p.out + (size_t)t * D + c) = z[i];
        }
        if (which == 0) {
            const float* wrt_l = wrt; asm volatile("" : "+s"(wrt_l));
            float lg[NEXP];
#pragma unroll
            for (int e = 0; e < NEXP; ++e) lg[e] = 0.f;
#pragma unroll
            for (int i = 0; i < 4; ++i)
#pragma unroll
                for (int j = 0; j < 4; ++j) {
                    const int c = 256 * i + 4 * lane + j; const float xv = z[i][j];
#pragma unroll
                    for (int e4 = 0; e4 < NEXP / 4; ++e4) { const f32x4 w = *(const f32x4*)(wrt_l + (unsigned)(c * NEXP + e4 * 4)); lg[e4 * 4 + 0] += xv * w[0]; lg[e4 * 4 + 1] += xv * w[1]; lg[e4 * 4 + 2] += xv * w[2]; lg[e4 * 4 + 3] += xv * w[3]; }
                    if (j & 1) __builtin_amdgcn_sched_barrier(0);
                }
#pragma unroll
            for (int e = 0; e < NEXP; ++e) lg[e] = wave_sum(lg[e]) + brt[e];
            int te[4]; float tv[4]; unsigned used = 0u;
#pragma unroll
            for (int k = 0; k < 4; ++k) {
                float best = -INFINITY; int bi = 0;
#pragma unroll
                for (int e = 0; e < NEXP; ++e) { const bool ok = !((used >> e) & 1u) && lg[e] > best; best = ok ? lg[e] : best; bi = ok ? e : bi; }
                te[k] = bi; tv[k] = best; used |= 1u << bi;
            }
            const float e1 = __expf(tv[1] - tv[0]), e2 = __expf(tv[2] - tv[0]), e3 = __expf(tv[3] - tv[0]);
            const float inv = 1.0f / (1.0f + e1 + e2 + e3);
            if (lane < 4) {
                const int k = lane;
                const int ee = (k == 0) ? te[0] : (k == 1 ? te[1] : (k == 2 ? te[2] : te[3]));
                const float gg = ((k == 0) ? 1.0f : (k == 1 ? e1 : (k == 2 ? e2 : e3))) * inv;
                tope[t * 4 + k] = ee; gates[t * 4 + k] = gg;
                pos[t * 4 + k] = (int)atomicAdd(ctl + CW_CNT + layer * 64 + ee, 1u);
            }
        }
    }
}

__device__ void moe_scatter_phase(LAS unsigned char* lds, const Params& p, int layer) {
    const int tid = tid_();
    LAS int* pstart = (LAS int*)lds;
    unsigned* ctl = (unsigned*)(p.ws + WS_CTL);
    const int* tope = (const int*)(p.ws + WS_TOPE); const int* pos = (const int*)(p.ws + WS_POS);
    int* dest = (int*)(p.ws + WS_DEST); int* rowtok = (int*)(p.ws + WS_ROWTOK);
    if (tid == 0) {
        int acc = 0;
        for (int e = 0; e < NEXP; ++e) { const int c = (int)ctl[CW_CNT + layer * 64 + e]; pstart[e] = acc; pstart[32 + e] = c; acc += ((c + 255) >> 8) << 8; }
        pstart[64] = acc;
        if (blockIdx.x == 0) {
            ctl[CW_MDYN + layer * 64] = (unsigned)acc;
            for (int e = 0; e < NEXP; ++e) { const int nb = (pstart[32 + e] + 255) >> 8; for (int b = 0; b < nb; ++b) ctl[CW_TEXP + layer * 512 + (pstart[e] >> 8) + b] = (unsigned)e; }
        }
    }
    __syncthreads();
    for (int i = blockIdx.x * NTHREADS + tid; i < T * TOPK; i += gridDim.x * NTHREADS) {
        const int e = tope[i], row = pstart[e] + pos[i];
        dest[i] = row; rowtok[row] = i >> 2;
    }
    for (int i = blockIdx.x * NTHREADS + tid; i < NEXP * 256; i += gridDim.x * NTHREADS) {
        const int e = i >> 8, r = i & 255, c = pstart[32 + e], padded = ((c + 255) >> 8) << 8;
        if (c + r < padded) rowtok[pstart[e] + c + r] = 0;
    }
    __syncthreads();
}

constexpr int PH_PER_LAYER = 9;
constexpr int NPHASES = 1 + DEPTH * PH_PER_LAYER;
constexpr int LDS_BYTES = 132 * 1024;


#ifndef PHMASK
#define PHMASK 0x3FF
#endif
#define PHK(j) ((PHMASK >> (j)) & 1)
#define IN(k) (lo <= (k) && (k) < hi)
#if MK_ONE_LAUNCH
#define SEAM(k) do { if (IN(k) && IN((k) + 1)) xcd_barrier_nv(bar.bar, bar.x, bar.st); } while (0)
#else
#define SEAM(k) do {} while (0)
#endif
template <int layer>
__device__ __forceinline__ void run_layer(const Params& p, LAS unsigned char* lds, const XcdBarrier& bar) {
    const int lo = p.ph_lo, hi = p.ph_hi;
    unsigned char* ws = p.ws;
    unsigned* ctl = (unsigned*)(ws + WS_CTL);
        constexpr int base = 1 + layer * PH_PER_LAYER, kind = layer % 3, idx = layer / 3;
        if (PHK(1) && IN(base + 0)) {
            constexpr int N = (kind == 0) ? 2048 : (kind == 1 ? 6144 : 9216);
            const bf16_t* Bt = (kind == 0) ? (const bf16_t*)(ws + WS_AWIN) + (size_t)idx * 2048 * D : (kind == 1 ? (const bf16_t*)(ws + WS_BWIN) : (const bf16_t*)(ws + WS_CWIN));
            g8::SchedPlain S; S.init(ws + WS_XB, Bt, T, N, D, (int)gridDim.x, (int)blockIdx.x);
            g8::EpiBf16 E{(bf16_t*)(ws + WS_U), N};
            g8::gemm_phase<g8::EpiBf16, g8::SchedPlain, false>(lds, D, S, E);
        }
        SEAM(base + 0);
        if (PHK(2) && IN(base + 1)) {
            if (kind == 0) lru_gates_phase(lds, p, idx);
            else if (kind == 1) ret_core_phase(lds, p);
            else attn_core_phase(lds, p);
        }
        SEAM(base + 1);
        if (PHK(3) && IN(base + 2)) {
            if (kind == 0) lru_scan_phase(p);
            else if (kind == 1) ret_norm_phase(lds, p);
        }
        SEAM(base + 2);
        if (PHK(4) && IN(base + 3)) {
            constexpr int K = (kind == 1) ? 2048 : D;
            const bf16_t* Bt = (kind == 0) ? (const bf16_t*)(ws + WS_AWOUT) + (size_t)idx * D * D : (kind == 1 ? (const bf16_t*)(ws + WS_BWOUT) : (const bf16_t*)(ws + WS_CWOUT));
            g8::SchedPlain S; S.init(ws + WS_YIN, Bt, T, D, K, (int)gridDim.x, (int)blockIdx.x);
            g8::EpiF32 E{(float*)(ws + WS_YMIX), D, nullptr, 0};
            g8::gemm_phase<g8::EpiF32, g8::SchedPlain, false>(lds, K, S, E);
        }
        SEAM(base + 3);
        if (PHK(5) && IN(base + 4)) ln_phase(p, layer, 0);
        SEAM(base + 4);
        if (PHK(6) && IN(base + 5)) moe_scatter_phase(lds, p, layer);
        SEAM(base + 5);
        if (PHK(7) && IN(base + 6)) {
            g8::SchedGU S{(const char*)(ws + WS_XB), (const char*)((const bf16_t*)(ws + WS_GU) + (size_t)layer * NEXP * 2048 * D), (const int*)(ws + WS_ROWTOK), ctl + CW_TEXP + layer * 512,
                          (int)(ctl[CW_MDYN + layer * 64] >> 8), (int)gridDim.x, (int)blockIdx.x};
            g8::EpiSwiglu E{(bf16_t*)(ws + WS_HID), p.moe_b_gu + (size_t)layer * NEXP * 2048};
            g8::gemm_phase<g8::EpiSwiglu, g8::SchedGU, true>(lds, D, S, E);
        }
        SEAM(base + 6);
        if (PHK(8) && IN(base + 7)) {
            g8::SchedDown S{(const char*)(ws + WS_HID), (const char*)((const bf16_t*)(ws + WS_DN) + (size_t)layer * NEXP * D * D), ctl + CW_TEXP + layer * 512,
                            (int)(ctl[CW_MDYN + layer * 64] >> 8), (int)gridDim.x, (int)blockIdx.x};
            g8::EpiF32 E{(float*)(ws + WS_YROWS), D, p.moe_b_down + (size_t)layer * NEXP * D, D};
            g8::gemm_phase<g8::EpiF32, g8::SchedDown, false>(lds, D, S, E);
        }
        SEAM(base + 7);
        if (PHK(9) && IN(base + 8)) ln_phase(p, layer, 1);
        SEAM(base + 8);
    }
#undef IN
#undef SEAM
__global__ void __launch_bounds__(NTHREADS, 2) fwd_kernel(Params p) {
    extern __shared__ __attribute__((aligned(16))) unsigned char lds_raw[];
    LAS unsigned char* lds = (LAS unsigned char*)lds_raw;
    const int lo = p.ph_lo, hi = p.ph_hi;
    unsigned char* ws = p.ws;
    unsigned* ctl = (unsigned*)(ws + WS_CTL);
#if MK_ONE_LAUNCH
    volatile LAS unsigned* bst = (volatile LAS unsigned*)(lds + LDS_BYTES - 16);
    if (threadIdx.x == 0) { bst[0] = 0u; bst[1] = 0u; bst[2] = 0u; bst[3] = 0u; }
    __syncthreads();
    XcdBarrier bar = xcd_barrier_post(ctl, bst);
#define GRID_BAR() xcd_barrier_nv(bar.bar, bar.x, bar.st)
#else
    XcdBarrier bar; bar.bar = ctl; bar.x = 0; bar.st = nullptr;
#define GRID_BAR() do {} while (0)
#endif
#define IN(k) (lo <= (k) && (k) < hi)
#define SEAM(k) do { if (IN(k) && IN((k) + 1)) GRID_BAR(); } while (0)

    if (PHK(0) && IN(0)) {
        LAS float* tile = (LAS float*)lds;
        for (int l = 0; l < 2; ++l) {
            convert_job(tile, p.a_w_in + (size_t)l * D * 2048, (bf16_t*)(ws + WS_AWIN) + (size_t)l * 2048 * D, D, 2048, 1);
            convert_job(tile, p.a_w_out + (size_t)l * D * D, (bf16_t*)(ws + WS_AWOUT) + (size_t)l * D * D, D, D, 1);
        }
        convert_job(tile, p.a_w_rgate, (bf16_t*)(ws + WS_AGT), 128, 128, 8);
        convert_job(tile, p.a_w_igate, (bf16_t*)(ws + WS_AGT) + (size_t)8 * 128 * 128, 128, 128, 8);
        convert_job(tile, p.a_w_rgate + (size_t)8 * 128 * 128, (bf16_t*)(ws + WS_AGT) + (size_t)16 * 128 * 128, 128, 128, 8);
        convert_job(tile, p.a_w_igate + (size_t)8 * 128 * 128, (bf16_t*)(ws + WS_AGT) + (size_t)24 * 128 * 128, 128, 128, 8);
        convert_job(tile, p.b_w_in, (bf16_t*)(ws + WS_BWIN), D, 6144, 1);
        convert_job(tile, p.b_w_out, (bf16_t*)(ws + WS_BWOUT), 2048, D, 1);
        convert_job(tile, p.c_w_in, (bf16_t*)(ws + WS_CWIN), D, 9216, 1);
        convert_job(tile, p.c_w_out, (bf16_t*)(ws + WS_CWOUT), D, D, 1);
        convert_job(tile, p.moe_w_gu, (bf16_t*)(ws + WS_GU), D, 2048, DEPTH * NEXP);
        convert_job(tile, p.moe_w_down, (bf16_t*)(ws + WS_DN), D, D, DEPTH * NEXP);
        float* xf = (float*)(ws + WS_XF); bf16_t* xb = (bf16_t*)(ws + WS_XB);
        for (size_t i = (size_t)blockIdx.x * NTHREADS + threadIdx.x; i < (size_t)T * D / 4; i += (size_t)gridDim.x * NTHREADS) {
            const f32x4 v = *(const f32x4*)(p.x + i * 4);
            *(f32x4*)(xf + i * 4) = v;
            u32x2 w; w.x = pack2(v[0], v[1]); w.y = pack2(v[2], v[3]); *(u32x2*)(xb + i * 4) = w;
        }
    }
    SEAM(0);

    run_layer<0>(p, lds, bar); run_layer<1>(p, lds, bar); run_layer<2>(p, lds, bar); run_layer<3>(p, lds, bar);
#undef IN
#undef SEAM
}

extern "C" void kernel_launch(void* const* d_in, const int* in_sizes, int n_in, void* d_out, int out_size, void* d_ws, size_t ws_size, hipStream_t stream) {
    static int grid = 0;
    if (grid == 0) {
        if (n_in != 22 || out_size != T * D || ws_size < WS_END) { fprintf(stderr, "kernel_launch: unexpected shapes (n_in %d out %d ws %zu need %zu)\n", n_in, out_size, ws_size, (size_t)WS_END); grid = -1; return; }
        if (hipFuncSetAttribute((const void*)fwd_kernel, hipFuncAttributeMaxDynamicSharedMemorySize, LDS_BYTES) != hipSuccess) { fprintf(stderr, "kernel_launch: hipFuncSetAttribute failed\n"); grid = -1; return; }
        int dev = 0, cus = 0;
        if (hipGetDevice(&dev) != hipSuccess || hipDeviceGetAttribute(&cus, hipDeviceAttributeMultiprocessorCount, dev) != hipSuccess) { grid = -1; return; }
        grid = cus;
    }
    if (grid < 0) return;
    (void)hipMemsetAsync((char*)d_ws + WS_CTL, 0, CTL_BYTES, stream);
    Params p{};
    const float** pp = (const float**)&p;
    for (int i = 0; i < 22; ++i) pp[i] = (const float*)d_in[i];
    p.out = (float*)d_out; p.ws = (unsigned char*)d_ws;
#if MK_ONE_LAUNCH
    p.ph_lo = 0; p.ph_hi = NPHASES;
    hipLaunchKernelGGL(fwd_kernel, dim3(grid), dim3(NTHREADS), LDS_BYTES, stream, p);
#else
    for (int ph = 0; ph < NPHASES; ++ph) {
        if (ph > 0) { const int k = (ph - 1) % PH_PER_LAYER, layer = (ph - 1) / PH_PER_LAYER; if (k == 2 && layer % 3 == 2) continue; }
        p.ph_lo = ph; p.ph_hi = ph + 1;
        hipLaunchKernelGGL(fwd_kernel, dim3(grid), dim3(NTHREADS), LDS_BYTES, stream, p);
    }
#endif
}
```

```cpp
#include <hip/hip_runtime.h>
#include <stdint.h>
#include <stdio.h>

#ifndef MK_ONE_LAUNCH
#define MK_ONE_LAUNCH 1
#endif

#define LAS __attribute__((address_space(3)))
typedef unsigned short bf16_t;
typedef short bf16x8 __attribute__((ext_vector_type(8)));
typedef float f32x4 __attribute__((ext_vector_type(4)));
typedef unsigned u32x4 __attribute__((ext_vector_type(4)));
typedef unsigned u32x2 __attribute__((ext_vector_type(2)));

constexpr int T = 16384, D = 1024, SEQ = 2048, NBATCH = 8, DEPTH = 4;
constexpr int NEXP = 32, TOPK = 4;
constexpr int MAXROWS = 73728;
constexpr float DN_ALPHA = 1.681792830507429f;
constexpr float LN_EPS = 1e-5f;
constexpr int NTHREADS = 512;

constexpr size_t MB = 1ull << 20;
constexpr size_t WS_CTL = 0;
constexpr size_t CTL_BYTES = 65536;
constexpr size_t WS_AWIN = 1 * MB;
constexpr size_t WS_AWOUT = WS_AWIN + 8 * MB;
constexpr size_t WS_BWIN = WS_AWOUT + 4 * MB;
constexpr size_t WS_BWOUT = WS_BWIN + 12 * MB;
constexpr size_t WS_CWIN = WS_BWOUT + 4 * MB;
constexpr size_t WS_CWOUT = WS_CWIN + 18 * MB;
constexpr size_t WS_GU = WS_CWOUT + 2 * MB;
constexpr size_t WS_DN = WS_GU + 512 * MB;
constexpr size_t WS_XF = WS_DN + 256 * MB;
constexpr size_t WS_XB = WS_XF + 64 * MB;
constexpr size_t WS_U = WS_XB + 32 * MB;
constexpr size_t WS_YIN = WS_U + 288 * MB;
constexpr size_t WS_YMIX = WS_YIN + 64 * MB;
constexpr size_t WS_SCR = WS_YMIX + 64 * MB;
constexpr size_t WS_TOPE = WS_SCR + 128 * MB;
constexpr size_t WS_GATES = WS_TOPE + 256 * 1024;
constexpr size_t WS_POS = WS_GATES + 256 * 1024;
constexpr size_t WS_DEST = WS_POS + 256 * 1024;
constexpr size_t WS_ROWTOK = WS_DEST + 256 * 1024;
constexpr size_t WS_HID = WS_ROWTOK + 1 * MB;
constexpr size_t WS_YROWS = WS_HID + 144 * MB;
constexpr size_t WS_LSUM = WS_YROWS + 288 * MB;
constexpr size_t WS_AGT = WS_LSUM + 2 * MB;
constexpr size_t WS_END = WS_AGT + 1 * MB;

constexpr int CW_CNT = 4096;
constexpr int CW_MDYN = 8192;
constexpr int CW_TEXP = 12288;

#define XB_TMO      128
#define XB_XCNT(j)  (256  + 64 * (j))
#define XB_XSUB(j)  (1280 + 64 * (j))
#define XB_XGEN(j)  (2304 + 64 * (j))
#define XB_TOP      3328
#define XB_TOPGEN   3392
#define XCD_BAR_WORDS 3456
#define XB_SPIN_CAP (1u << 22)

__device__ __forceinline__ unsigned xb_ld(unsigned* p)              { return __hip_atomic_load(p, __ATOMIC_RELAXED, __HIP_MEMORY_SCOPE_AGENT); }
__device__ __forceinline__ unsigned xb_add(unsigned* p, unsigned v) { return __hip_atomic_fetch_add(p, v, __ATOMIC_RELAXED, __HIP_MEMORY_SCOPE_AGENT); }
__device__ __forceinline__ unsigned xb_xcc_id() { return (unsigned)__builtin_amdgcn_s_getreg((3 << 11) | 20) & 0xFu; }
#define XB_SPIN(cond, bar) do { unsigned _sp = 0; while (cond) { __builtin_amdgcn_s_sleep(1); \
    if ((++_sp & 255u) == 0u) { if (xb_ld(&(bar)[XB_TMO])) break; if (_sp > XB_SPIN_CAP) { atomicAdd(&(bar)[XB_TMO], 1u); break; } } } } while (0)

struct XcdBarrier { unsigned* bar; unsigned x; volatile LAS unsigned* st; };

__device__ __forceinline__ XcdBarrier xcd_barrier_post(unsigned* bar, volatile LAS unsigned* st) {
    XcdBarrier b; b.bar = bar; b.x = xb_xcc_id(); b.st = st;
    if (threadIdx.x == 0) (void)xb_add(&bar[XB_XCNT(b.x)], 1u);
    return b;
}
__device__ __forceinline__ void xcd_barrier_complete(unsigned* bar, unsigned x, unsigned& nloc, unsigned& nx) {
    const unsigned G = gridDim.x * gridDim.y * gridDim.z;
    unsigned sum, cnt, mine, sp = 0u;
    for (;;) {
        sum = 0u; cnt = 0u; mine = 0u;
#pragma unroll
        for (unsigned j = 0; j < 16; ++j) { const unsigned c = xb_ld(&bar[XB_XCNT(j)]); sum += c; cnt += (c > 0u) ? 1u : 0u; mine = (j == x) ? c : mine; }
        if (sum == G) break;
        __builtin_amdgcn_s_sleep(1);
        if ((++sp & 255u) == 0u) { if (xb_ld(&bar[XB_TMO])) break; if (sp > XB_SPIN_CAP) { atomicAdd(&bar[XB_TMO], 1u); break; } }
    }
    nloc = mine > 0u ? mine : 1u; nx = cnt > 0u ? cnt : 1u;
}
__device__ __noinline__ void xcd_barrier_nv(unsigned* bbar, unsigned bx, volatile LAS unsigned* bst) {
    XcdBarrier b; b.bar = bbar; b.x = bx; b.st = bst;
    asm volatile("s_waitcnt vmcnt(0)" ::: "memory");
    __syncthreads();
    if (threadIdx.x == 0) {
        unsigned* bar = b.bar;
        __builtin_amdgcn_s_waitcnt(0);
        unsigned nloc = b.st[0], nx = b.st[1];
        if (nloc == 0u) { xcd_barrier_complete(bar, b.x, nloc, nx); b.st[0] = nloc; b.st[1] = nx; }
        const unsigned old = xb_add(&bar[XB_XSUB(b.x)], 1u);
        const unsigned gen = old / nloc;
        if (old + 1u == (gen + 1u) * nloc) {
            __builtin_amdgcn_fence(__ATOMIC_RELEASE, "agent");
            asm volatile("s_waitcnt vmcnt(0)" ::: "memory");
            const unsigned og = xb_add(&bar[XB_TOP], 1u);
            const unsigned tg = og / nx;
            if (og + 1u == (tg + 1u) * nx) xb_add(&bar[XB_TOPGEN], 1u);
            else XB_SPIN(xb_ld(&bar[XB_TOPGEN]) == tg, bar);
            __builtin_amdgcn_fence(__ATOMIC_ACQUIRE, "agent");
            xb_add(&bar[XB_XGEN(b.x)], 1u);
            asm volatile("s_waitcnt vmcnt(0)" ::: "memory");
        } else {
            XB_SPIN(xb_ld(&bar[XB_XGEN(b.x)]) == gen, bar);
            __builtin_amdgcn_fence(__ATOMIC_ACQUIRE, "agent");
            asm volatile("s_waitcnt vmcnt(0)" ::: "memory");
        }
    }
    __syncthreads();
}

__device__ __forceinline__ int tid_() { int t = threadIdx.x; asm volatile("" : "+v"(t)); return t; }
__device__ __forceinline__ float bf2f(bf16_t v) { return __uint_as_float(((unsigned)v) << 16); }
__device__ __forceinline__ bf16_t f2bf(float f) { unsigned u = __float_as_uint(f); u += 0x7FFFu + ((u >> 16) & 1u); return (bf16_t)(u >> 16); }
__device__ __forceinline__ unsigned pack2(float lo, float hi) { return (unsigned)f2bf(lo) | ((unsigned)f2bf(hi) << 16); }
__device__ __forceinline__ float wave_sum(float v) {
#pragma unroll
    for (int o = 32; o >= 1; o >>= 1) v += __shfl_xor(v, o);
    return v;
}
__device__ __forceinline__ float wave_max(float v) {
#pragma unroll
    for (int o = 32; o >= 1; o >>= 1) v = fmaxf(v, __shfl_xor(v, o));
    return v;
}
__device__ __forceinline__ float sigmoidf_(float x) { return 1.0f / (1.0f + __expf(-x)); }
__device__ __forceinline__ float gelu_tanh(float x) { const float u = 0.7978845608028654f * (x + 0.044715f * x * x * x); return 0.5f * x * (1.0f + tanhf(u)); }
__device__ __forceinline__ float swiglu(float gate, float up) {
    const float g = fminf(gate, 7.0f), u = fminf(fmaxf(up, -7.0f), 7.0f);
    return (u + 1.0f) * g * sigmoidf_(1.702f * g);
}

struct Params {
    const float* x; const float* a_w_in; const float* a_conv_w; const float* a_conv_b; const float* a_w_rgate; const float* a_b_rgate;
    const float* a_w_igate; const float* a_b_igate; const float* a_lambda; const float* a_w_out; const float* b_w_in; const float* b_w_out;
    const float* c_w_in; const float* c_w_out; const float* ln_gain; const float* ln_bias; const float* moe_w_router; const float* moe_b_router;
    const float* moe_w_gu; const float* moe_b_gu; const float* moe_w_down; const float* moe_b_down;
    float* out; unsigned char* ws;
    int ph_lo, ph_hi;
};

__device__ void convert_job(LAS float* tile, const float* src, bf16_t* dst, int K, int N, int batch) {
    const int tid = tid_();
    const int tk = K / 64, tn = N / 64, per = tk * tn; const long total = (long)per * batch;
    for (long u = blockIdx.x; u < total; u += gridDim.x) {
        const int bidx = (int)(u / per), r = (int)(u % per), kt = r / tn, nt = r % tn;
        const float* s = src + (size_t)bidx * K * N + (size_t)(kt * 64) * N + nt * 64;
#pragma unroll
        for (int pass = 0; pass < 2; ++pass) {
            const int row = (tid >> 4) + 32 * pass, c4 = tid & 15;
            const f32x4 v = *(const f32x4*)(s + (size_t)row * N + c4 * 4);
            tile[row * 65 + c4 * 4 + 0] = v[0]; tile[row * 65 + c4 * 4 + 1] = v[1]; tile[row * 65 + c4 * 4 + 2] = v[2]; tile[row * 65 + c4 * 4 + 3] = v[3];
        }
        __syncthreads();
        {
            const int n = tid >> 3, k8 = tid & 7;
            float v[8];
#pragma unroll
            for (int j = 0; j < 8; ++j) v[j] = tile[(k8 * 8 + j) * 65 + n];
            u32x4 w; w.x = pack2(v[0], v[1]); w.y = pack2(v[2], v[3]); w.z = pack2(v[4], v[5]); w.w = pack2(v[6], v[7]);
            *(u32x4*)(dst + (size_t)bidx * N * K + (size_t)(nt * 64 + n) * K + kt * 64 + k8 * 8) = w;
        }
        __syncthreads();
    }
}

struct GemmS {
    const bf16_t* A; int lda;
    const bf16_t* Bt; int ldb;
    int M, N, K;
    const unsigned* Mdyn;
    const int* row_idx;
    const unsigned* tile_exp;
    size_t b_exp_stride;
    const float* bias; int bias_es;
    float* Cf; bf16_t* Cb; int ldc;
};
template <int MODE>
__device__ void gemm_simple(LAS unsigned char* lds, const GemmS& g) {
    const int tid = tid_(), lane = tid & 63, wid = tid >> 6, wr = wid >> 1, wc = wid & 1, fr = lane & 15, fq = lane >> 4;
    const int M = g.Mdyn ? (int)*g.Mdyn : g.M;
    const int tiles_n = (MODE == 1) ? (g.N / 256) * 2 : g.N / 128;
    const int tiles_m = M / 128, nunits = tiles_m * tiles_n, nk = g.K / 32;
    LAS bf16_t* As = (LAS bf16_t*)lds;
    LAS bf16_t* Bs = As + 2 * 128 * 40;
    const int lrow = tid >> 2, lch = tid & 3;
    for (int u = blockIdx.x; u < nunits; u += gridDim.x) {
        const int tm = u / tiles_n, tn = u % tiles_n, m0 = tm * 128;
        const int e = (MODE != 0) ? (int)g.tile_exp[m0 >> 8] : 0;
        const bf16_t* Bbase = g.Bt + (size_t)e * g.b_exp_stride;
        int arow = m0 + lrow; if (MODE == 1) arow = g.row_idx[arow];
        int brow;
        if (MODE == 1) { const int bwc = lrow >> 6, ni = (lrow & 63) >> 4, r = lrow & 15; brow = ((ni & 1) ? 1024 : 0) + tn * 64 + bwc * 32 + (ni >> 1) * 16 + r; }
        else brow = tn * 128 + lrow;
        const bf16_t* ap = g.A + (size_t)arow * g.lda + lch * 8;
        const bf16_t* bp = Bbase + (size_t)brow * g.ldb + lch * 8;
        f32x4 acc[2][4];
#pragma unroll
        for (int mi = 0; mi < 2; ++mi)
#pragma unroll
            for (int ni = 0; ni < 4; ++ni) acc[mi][ni] = (f32x4){0.f, 0.f, 0.f, 0.f};
        u32x4 ra = *(const u32x4*)ap, rb = *(const u32x4*)bp;
        *(LAS u32x4*)(As + lrow * 40 + lch * 8) = ra; *(LAS u32x4*)(Bs + lrow * 40 + lch * 8) = rb;
        __syncthreads();
        for (int kt = 0; kt < nk; ++kt) {
            const int cur = kt & 1;
            if (kt + 1 < nk) { ra = *(const u32x4*)(ap + (kt + 1) * 32); rb = *(const u32x4*)(bp + (kt + 1) * 32); }
            bf16x8 af[2], bfr[4];
#pragma unroll
            for (int mi = 0; mi < 2; ++mi) af[mi] = *(const LAS bf16x8*)(As + cur * 5120 + (wr * 32 + mi * 16 + fr) * 40 + fq * 8);
#pragma unroll
            for (int ni = 0; ni < 4; ++ni) bfr[ni] = *(const LAS bf16x8*)(Bs + cur * 5120 + (wc * 64 + ni * 16 + fr) * 40 + fq * 8);
#pragma unroll
            for (int mi = 0; mi < 2; ++mi)
#pragma unroll
                for (int ni = 0; ni < 4; ++ni) acc[mi][ni] = __builtin_amdgcn_mfma_f32_16x16x32_bf16(bfr[ni], af[mi], acc[mi][ni], 0, 0, 0);
            if (kt + 1 < nk) { *(LAS u32x4*)(As + (cur ^ 1) * 5120 + lrow * 40 + lch * 8) = ra; *(LAS u32x4*)(Bs + (cur ^ 1) * 5120 + lrow * 40 + lch * 8) = rb; }
            __syncthreads();
        }
#pragma unroll
        for (int mi = 0; mi < 2; ++mi) {
            const int m = m0 + wr * 32 + mi * 16 + fr;
            if (MODE == 1) {
#pragma unroll
                for (int q = 0; q < 2; ++q) {
                    const int hc = tn * 64 + wc * 32 + q * 16 + 4 * fq;
                    const f32x4 bg = *(const f32x4*)(g.bias + (size_t)e * g.bias_es + hc), bu = *(const f32x4*)(g.bias + (size_t)e * g.bias_es + 1024 + hc);
                    const f32x4 gt = acc[mi][2 * q] + bg, up = acc[mi][2 * q + 1] + bu;
                    u32x2 w; w.x = pack2(swiglu(gt[0], up[0]), swiglu(gt[1], up[1])); w.y = pack2(swiglu(gt[2], up[2]), swiglu(gt[3], up[3]));
                    *(u32x2*)(g.Cb + (size_t)m * g.ldc + hc) = w;
                }
            } else {
#pragma unroll
                for (int ni = 0; ni < 4; ++ni) {
                    const int n = tn * 128 + wc * 64 + ni * 16 + 4 * fq;
                    f32x4 v = acc[mi][ni];
                    if (g.bias) v += *(const f32x4*)(g.bias + (size_t)e * g.bias_es + n);
                    if (g.Cf) *(f32x4*)(g.Cf + (size_t)m * g.ldc + n) = v;
                    else { u32x2 w; w.x = pack2(v[0], v[1]); w.y = pack2(v[2], v[3]); *(u32x2*)(g.Cb + (size_t)m * g.ldc + n) = w; }
                }
            }
        }
    }
}


namespace g8 {
constexpr int BM = 256, BK = 64, HALF = 128, HTB = HALF * BK * 2, STAGE_BYTES = 8 * HTB, NXCD = 8, WGM = 8;
__device__ __forceinline__ int lds_byte(int r, int c) { const int st = (r >> 4) * 2 + (c >> 5), rr = r & 15, cc = c & 31, ob = rr * 64 + cc * 2; return st * 1024 + (ob ^ (((ob >> 9) & 1) << 5)); }
__device__ __forceinline__ void stage_rc(int b, int& R, int& C) { const int st = b / 1024, sb = b % 1024, swz = sb ^ (((sb >> 9) & 1) << 5); R = (st >> 1) * 16 + swz / 64; C = (st & 1) * 32 + (swz % 64) / 2; }
__device__ __forceinline__ int perm32(int rho) { const int n = rho >> 4, i = rho & 15; return 8 * (i >> 2) + 4 * n + (i & 3); }
__device__ __forceinline__ unsigned cvt_pk_bf16(float lo, float hi) { unsigned r; asm volatile("v_cvt_pk_bf16_f32 %0, %1, %2" : "=v"(r) : "v"(lo), "v"(hi)); return r; }

struct Unit { const char* a0; const char* a1; const char* b0; const char* b1; const int* rows; int row0, col0, e; };

struct SchedPlain {
    const char* A; const char* Bt; size_t hstepA, hstepB; int nM, nN, nwg, G, c;
    __device__ __forceinline__ void init(const void* A_, const void* Bt_, int M, int N, int K, int G_, int c_) { A = (const char*)A_; Bt = (const char*)Bt_; hstepA = (size_t)HALF * K * 2; hstepB = hstepA; nM = M / BM; nN = N / BM; nwg = nM * nN; G = G_; c = c_; }
    __device__ __forceinline__ bool next(int i, Unit& u) const {
        const long L = (long)i * G + c; if (L >= nwg) return false;
        int wgid = (int)L; { const int q = nwg / NXCD, r = nwg % NXCD, xcd = wgid % NXCD, off = wgid / NXCD; wgid = (xcd < r ? xcd * (q + 1) : r * (q + 1) + (xcd - r) * q) + off; }
        const int nig = WGM * nN, gid = wgid / nig, fm = gid * WGM, gsz = (nM - fm) < WGM ? (nM - fm) : WGM;
        const int pm = fm + ((wgid % nig) % gsz), pn = (wgid % nig) / gsz;
        u.a0 = A + (size_t)pm * 2 * hstepA; u.a1 = u.a0 + hstepA; u.b0 = Bt + (size_t)pn * 2 * hstepB; u.b1 = u.b0 + hstepB; u.rows = nullptr; u.row0 = pm * BM; u.col0 = pn * BM; u.e = 0;
        return true;
    }
};
struct SchedGU {
    const char* A; const char* W; const int* rowtok; const unsigned* texp; int ntiles, G, c;
    __device__ __forceinline__ bool next(int i, Unit& u) const {
        const int L = i * G + c, rt = L >> 3, pn = L & 7; if (rt >= ntiles) return false;
        const int e = (int)texp[rt];
        u.a0 = A; u.a1 = A; u.rows = rowtok + rt * BM; u.b0 = W + ((size_t)e * 2048 + pn * 128) * (D * 2); u.b1 = u.b0 + (size_t)1024 * D * 2; u.row0 = rt * BM; u.col0 = pn * 128; u.e = e;
        return true;
    }
};
struct SchedDown {
    const char* A; const char* W; const unsigned* texp; int ntiles, G, c;
    __device__ __forceinline__ bool next(int i, Unit& u) const {
        const int L = i * G + c, rt = L >> 2, pn = L & 3; if (rt >= ntiles) return false;
        const int e = (int)texp[rt];
        u.a0 = A + (size_t)rt * BM * D * 2; u.a1 = u.a0 + (size_t)HALF * D * 2; u.rows = nullptr; u.b0 = W + ((size_t)e * 1024 + pn * BM) * (D * 2); u.b1 = u.b0 + (size_t)HALF * D * 2; u.row0 = rt * BM; u.col0 = pn * BM; u.e = e;
        return true;
    }
};

struct EpiF32 {
    static constexpr bool PERM = false;
    float* C; int ldc; const float* bias; int bias_es;
    __device__ __forceinline__ void operator()(const f32x4 (&acc)[2][2][4][2], const Unit& u, int wr, int wc, int fr, int fq) const {
        const int row0 = u.row0 + wr * 64 + fr, col0 = u.col0 + wc * 32 + 4 * fq;
        f32x4 bv[2][2];
#pragma unroll
        for (int bj = 0; bj < 2; ++bj)
#pragma unroll
            for (int n = 0; n < 2; ++n) bv[bj][n] = bias ? *(const f32x4*)(bias + (size_t)u.e * bias_es + col0 + bj * HALF + n * 16) : (f32x4){0.f, 0.f, 0.f, 0.f};
#pragma unroll
        for (int ai = 0; ai < 2; ++ai)
#pragma unroll
            for (int m = 0; m < 4; ++m) { float* rowp = C + (size_t)(row0 + ai * HALF + m * 16) * ldc + col0;
#pragma unroll
                for (int bj = 0; bj < 2; ++bj)
#pragma unroll
                    for (int n = 0; n < 2; ++n) *(f32x4*)(rowp + bj * HALF + n * 16) = acc[ai][bj][m][n] + bv[bj][n]; }
    }
};
struct EpiBf16 {
    static constexpr bool PERM = true;
    bf16_t* O; int ldc;
    __device__ __forceinline__ void operator()(const f32x4 (&acc)[2][2][4][2], const Unit& u, int wr, int wc, int fr, int fq) const {
        const int row0 = u.row0 + wr * 64 + fr, col0 = u.col0 + wc * 32 + 8 * fq;
#pragma unroll
        for (int ai = 0; ai < 2; ++ai)
#pragma unroll
            for (int m = 0; m < 4; ++m) { bf16_t* rowp = O + (size_t)(row0 + ai * HALF + m * 16) * ldc + col0;
#pragma unroll
                for (int bj = 0; bj < 2; ++bj) { const f32x4 v0 = acc[ai][bj][m][0], v1 = acc[ai][bj][m][1];
                    u32x4 w; w.x = cvt_pk_bf16(v0[0], v0[1]); w.y = cvt_pk_bf16(v0[2], v0[3]); w.z = cvt_pk_bf16(v1[0], v1[1]); w.w = cvt_pk_bf16(v1[2], v1[3]);
                    *(u32x4*)(rowp + bj * HALF) = w; } }
    }
};
struct EpiSwiglu {
    static constexpr bool PERM = true;
    bf16_t* O; const float* bias;
    __device__ __forceinline__ void operator()(const f32x4 (&acc)[2][2][4][2], const Unit& u, int wr, int wc, int fr, int fq) const {
        const int row0 = u.row0 + wr * 64 + fr, hc = u.col0 + wc * 32 + 8 * fq;
        const float* bp = bias + (size_t)u.e * 2048 + hc;
        const f32x4 bg0 = *(const f32x4*)(bp), bg1 = *(const f32x4*)(bp + 4), bu0 = *(const f32x4*)(bp + 1024), bu1 = *(const f32x4*)(bp + 1028);
#pragma unroll
        for (int ai = 0; ai < 2; ++ai)
#pragma unroll
            for (int m = 0; m < 4; ++m) {
                const f32x4 g0 = acc[ai][0][m][0] + bg0, g1 = acc[ai][0][m][1] + bg1, u0 = acc[ai][1][m][0] + bu0, u1 = acc[ai][1][m][1] + bu1;
                u32x4 w; w.x = cvt_pk_bf16(swiglu(g0[0], u0[0]), swiglu(g0[1], u0[1])); w.y = cvt_pk_bf16(swiglu(g0[2], u0[2]), swiglu(g0[3], u0[3]));
                w.z = cvt_pk_bf16(swiglu(g1[0], u1[0]), swiglu(g1[1], u1[1])); w.w = cvt_pk_bf16(swiglu(g1[2], u1[2]), swiglu(g1[3], u1[3]));
                *(u32x4*)(O + (size_t)(row0 + ai * HALF + m * 16) * D + hc) = w;
            }
    }
};

template <class Epi, class Sched, bool GATHER>
__device__ __forceinline__ void gemm_phase(LAS unsigned char* lds, const int K, const Sched& S, const Epi& E) {
    const int tid = tid_(), wid = __builtin_amdgcn_readfirstlane(tid >> 6), lane = tid & 63, wr = wid >> 2, wc = wid & 3, fr = lane & 15, fq = lane >> 4;
    const int nt = K / BK;
    int sR[2], sC[2];
    unsigned voffB[2];
#pragma unroll
    for (int i = 0; i < 2; ++i) { stage_rc(tid * 16 + i * 8192, sR[i], sC[i]); const int Rb = Epi::PERM ? ((sR[i] & ~31) + perm32(sR[i] & 31)) : sR[i]; voffB[i] = (unsigned)(Rb * K + sC[i]) * 2u; }
    unsigned cvA0[2], cvA1[2], nvA0[2], nvA1[2];
#define G8_VOFF(u, v0, v1) do { _Pragma("unroll") for (int _i = 0; _i < 2; ++_i) { \
        if (GATHER) { v0[_i] = (unsigned)((u).rows[sR[_i]] * K + sC[_i]) * 2u; v1[_i] = (unsigned)((u).rows[HALF + sR[_i]] * K + sC[_i]) * 2u; } \
        else { v0[_i] = (unsigned)(sR[_i] * K + sC[_i]) * 2u; v1[_i] = v0[_i]; } } } while (0)
    const size_t kstep = (size_t)(BK * 2);
    const unsigned ldsw = (unsigned)wid * 1024u;
    const int aoff = lds_byte(wr * 64 + fr, fq * 8), boff = lds_byte(wc * 32 + fr, fq * 8);
#define PG8_SA(b, h) (((b) * 2 + (h)) * HTB)
#define PG8_SB(b, h) ((4 + (b) * 2 + (h)) * HTB)
#define PG8_STAGE(bufoff, gbase, voff) do { _Pragma("unroll") for (int _i = 0; _i < 2; ++_i) \
        __builtin_amdgcn_global_load_lds((const unsigned*)((const char*)(gbase) + (voff)[_i]), (LAS unsigned*)(lds + (bufoff) + ldsw + _i * 8192), 16, 0, 0); } while (0)
#define PG8_LDA(dst, b, h) do { _Pragma("unroll") for (int m = 0; m < 4; ++m) _Pragma("unroll") for (int k = 0; k < 2; ++k) dst[m][k] = *(const LAS bf16x8*)(lds + PG8_SA(b, h) + aoff + m * 2048 + k * 1024); } while (0)
#define PG8_LDB(dst, b, h) do { _Pragma("unroll") for (int n = 0; n < 2; ++n) _Pragma("unroll") for (int k = 0; k < 2; ++k) dst[n][k] = *(const LAS bf16x8*)(lds + PG8_SB(b, h) + boff + n * 2048 + k * 1024); } while (0)
#define PG8_MMA(ai, bj, At, Bt) do { __builtin_amdgcn_s_setprio(1); _Pragma("unroll") for (int m = 0; m < 4; ++m) _Pragma("unroll") for (int n = 0; n < 2; ++n) _Pragma("unroll") for (int k = 0; k < 2; ++k) \
        acc[ai][bj][m][n] = __builtin_amdgcn_mfma_f32_16x16x32_bf16(Bt[n][k], At[m][k], acc[ai][bj][m][n], 0, 0, 0); __builtin_amdgcn_s_setprio(0); } while (0)
#define PG8_WAIT_V(n) asm volatile("s_waitcnt vmcnt(" #n ")" ::: "memory")
#define PG8_WAIT_L(n) asm volatile("s_waitcnt lgkmcnt(" #n ")" ::: "memory")
#define PG8_BAR __builtin_amdgcn_s_barrier()
#define PG8_SCHED __builtin_amdgcn_sched_barrier(0)
    Unit cur, nxt; int ui = 0;
    if (!S.next(0, cur)) return;
    f32x4 acc[2][2][4][2];
#pragma unroll
    for (int a = 0; a < 2; ++a)
#pragma unroll
        for (int b = 0; b < 2; ++b)
#pragma unroll
            for (int m = 0; m < 4; ++m)
#pragma unroll
                for (int n = 0; n < 2; ++n) acc[a][b][m][n] = (f32x4){0.f, 0.f, 0.f, 0.f};
    bf16x8 At[4][2], B0[2][2], B1[2][2];
    const char* cA0 = cur.a0; const char* cA1 = cur.a1; const char* cB0 = cur.b0; const char* cB1 = cur.b1;
    G8_VOFF(cur, cvA0, cvA1);
    PG8_STAGE(PG8_SB(0, 0), cB0, voffB); PG8_STAGE(PG8_SB(0, 1), cB1, voffB); PG8_STAGE(PG8_SA(0, 0), cA0, cvA0); PG8_STAGE(PG8_SA(0, 1), cA1, cvA1);
    if (wr == 1) PG8_BAR;
    PG8_WAIT_V(2); PG8_BAR;
    PG8_STAGE(PG8_SB(1, 0), cB0 + kstep, voffB); PG8_STAGE(PG8_SA(1, 0), cA0 + kstep, cvA0); PG8_STAGE(PG8_SB(1, 1), cB1 + kstep, voffB);
    PG8_WAIT_V(6); PG8_BAR;
    for (;;) {
        const bool has_next = S.next(ui + 1, nxt);
        const char* nA0 = has_next ? nxt.a0 : cA0; const char* nA1 = has_next ? nxt.a1 : cA1; const char* nB0 = has_next ? nxt.b0 : cB0; const char* nB1 = has_next ? nxt.b1 : cB1;
        if (GATHER) { if (has_next) { G8_VOFF(nxt, nvA0, nvA1); } else { nvA0[0] = cvA0[0]; nvA0[1] = cvA0[1]; nvA1[0] = cvA1[0]; nvA1[1] = cvA1[1]; } }
        for (int t = 0; t < nt; t += 2) {
            const bool last = (t == nt - 2);
            const char* a1_1 = cA1 + (size_t)(t + 1) * kstep;
            const char* a2_0 = last ? nA0 : cA0 + (size_t)(t + 2) * kstep; const char* a2_1 = last ? nA1 : cA1 + (size_t)(t + 2) * kstep;
            const char* b2_0 = last ? nB0 : cB0 + (size_t)(t + 2) * kstep; const char* b2_1 = last ? nB1 : cB1 + (size_t)(t + 2) * kstep;
            const char* a3_0 = a2_0 + kstep; const char* b3_0 = b2_0 + kstep; const char* b3_1 = b2_1 + kstep;
            unsigned vA0[2], vA1[2];
            if (GATHER) { vA0[0] = last ? nvA0[0] : cvA0[0]; vA0[1] = last ? nvA0[1] : cvA0[1]; vA1[0] = last ? nvA1[0] : cvA1[0]; vA1[1] = last ? nvA1[1] : cvA1[1]; }
            else { vA0[0] = cvA0[0]; vA0[1] = cvA0[1]; vA1[0] = cvA0[0]; vA1[1] = cvA0[1]; }
            PG8_LDB(B0, 0, 0); PG8_LDB(B1, 0, 1); PG8_SCHED; PG8_LDA(At, 0, 0); PG8_STAGE(PG8_SA(1, 1), a1_1, cvA1);
            PG8_WAIT_V(8); PG8_WAIT_L(0); PG8_BAR; PG8_MMA(0, 0, At, B0); PG8_MMA(0, 1, At, B1); PG8_BAR; PG8_SCHED;
            PG8_LDA(At, 0, 1); PG8_STAGE(PG8_SB(0, 0), b2_0, voffB); PG8_STAGE(PG8_SB(0, 1), b2_1, voffB); PG8_STAGE(PG8_SA(0, 0), a2_0, vA0);
            PG8_WAIT_V(8); PG8_WAIT_L(0); PG8_BAR; PG8_MMA(1, 0, At, B0); PG8_MMA(1, 1, At, B1); PG8_BAR; PG8_SCHED;
            PG8_LDB(B0, 1, 0); PG8_LDB(B1, 1, 1); PG8_SCHED; PG8_LDA(At, 1, 0); PG8_STAGE(PG8_SA(0, 1), a2_1, vA1);
            PG8_WAIT_V(8); PG8_WAIT_L(0); PG8_BAR; PG8_MMA(0, 0, At, B0); PG8_MMA(0, 1, At, B1); PG8_BAR; PG8_SCHED;
            PG8_LDA(At, 1, 1); PG8_STAGE(PG8_SB(1, 0), b3_0, voffB); PG8_STAGE(PG8_SB(1, 1), b3_1, voffB); PG8_STAGE(PG8_SA(1, 0), a3_0, vA0);
            PG8_WAIT_V(8); PG8_WAIT_L(0); PG8_BAR; PG8_MMA(1, 0, At, B0); PG8_MMA(1, 1, At, B1); PG8_BAR; PG8_SCHED;
        }
        if (wr == 0) PG8_BAR;
        E(acc, cur, wr, wc, fr, fq);
        if (!has_next) break;
#pragma unroll
        for (int a = 0; a < 2; ++a)
#pragma unroll
            for (int b = 0; b < 2; ++b)
#pragma unroll
                for (int m = 0; m < 4; ++m)
#pragma unroll
                    for (int n = 0; n < 2; ++n) acc[a][b][m][n] = (f32x4){0.f, 0.f, 0.f, 0.f};
        cur = nxt; cA0 = nA0; cA1 = nA1; cB0 = nB0; cB1 = nB1; ++ui;
        if (GATHER) { cvA0[0] = nvA0[0]; cvA0[1] = nvA0[1]; cvA1[0] = nvA1[0]; cvA1[1] = nvA1[1]; }
        if (wr == 1) PG8_BAR;
    }
    PG8_WAIT_V(0);
    PG8_BAR;
#undef G8_VOFF
#undef PG8_SA
#undef PG8_SB
#undef PG8_STAGE
#undef PG8_LDA
#undef PG8_LDB
#undef PG8_MMA
#undef PG8_WAIT_V
#undef PG8_WAIT_L
#undef PG8_BAR
#undef PG8_SCHED
}
}

__device__ __forceinline__ float gelu_fast(float x) { const float u2 = 1.5957691216057308f * (x + 0.044715f * x * x * x); return x / (1.0f + __expf(-u2)); }
__device__ void lru_gates_phase(LAS unsigned char* lds, const Params& p, int idx) {
    const int tid = tid_(), lane = tid & 63, wid = tid >> 6, fr = lane & 15, fq = lane >> 4;
    LAS bf16_t* xcb = (LAS bf16_t*)lds;
    LAS float* xcf = (LAS float*)(lds + 17408);
    LAS float* sa = (LAS float*)(lds + 17408 + 33792);
    LAS float* sb = sa + 64 * 132;
    LAS float* comb = sb + 64 * 132;
    const bf16_t* u = (const bf16_t*)(p.ws + WS_U);
    float* Aarr = (float*)(p.ws + WS_SCR); float* Barr = Aarr + (size_t)T * D;
    float* SP = (float*)(p.ws + WS_LSUM); float* SH = SP + NBATCH * 32 * D;
    const int hd = blockIdx.x & 7, slot = blockIdx.x >> 3, nslots = gridDim.x >> 3;
    const float* conv_w = p.a_conv_w + (size_t)idx * 4 * D; const float* conv_b = p.a_conv_b + (size_t)idx * D;
    const bf16_t* wrt = (const bf16_t*)(p.ws + WS_AGT) + ((size_t)(idx * 2 + 0) * 8 + hd) * 128 * 128;
    const bf16_t* wit = (const bf16_t*)(p.ws + WS_AGT) + ((size_t)(idx * 2 + 1) * 8 + hd) * 128 * 128;
    bf16x8 Br[4], Bi[4];
#pragma unroll
    for (int ks = 0; ks < 4; ++ks) { Br[ks] = *(const bf16x8*)(wrt + (size_t)(16 * wid + fr) * 128 + 32 * ks + 8 * fq); Bi[ks] = *(const bf16x8*)(wit + (size_t)(16 * wid + fr) * 128 + 32 * ks + 8 * fq); }
    const int cg = hd * 128 + 16 * wid + 4 * fq;
    const f32x4 brv = *(const f32x4*)(p.a_b_rgate + (size_t)idx * D + cg), biv = *(const f32x4*)(p.a_b_igate + (size_t)idx * D + cg), lmv = *(const f32x4*)(p.a_lambda + (size_t)idx * D + cg);
    f32x4 spv;
#pragma unroll
    for (int r = 0; r < 4; ++r) spv[r] = (lmv[r] > 15.f) ? __expf(-lmv[r]) : log1pf(__expf(-lmv[r]));
    const int cc = (tid & 31) * 4, cch = hd * 128 + cc;
    f32x4 cw[4];
#pragma unroll
    for (int j = 0; j < 4; ++j) cw[j] = *(const f32x4*)(conv_w + j * D + cch);
    const f32x4 cb = *(const f32x4*)(conv_b + cch);
    for (int tile = slot; tile < T / 64; tile += nslots) {
        const int t0 = tile * 64;
#pragma unroll
        for (int k = 0; k < 4; ++k) {
            const int tl = (tid >> 5) + 16 * k, t = t0 + tl, s_ = t & (SEQ - 1);
            f32x4 acc = cb;
#pragma unroll
            for (int j = 0; j < 4; ++j) {
                if (s_ - 3 + j >= 0) {
                    const u32x2 rv = *(const u32x2*)(u + (size_t)(t - 3 + j) * 2048 + 1024 + cch);
                    acc[0] += cw[j][0] * __uint_as_float(rv.x << 16); acc[1] += cw[j][1] * __uint_as_float(rv.x & 0xffff0000u);
                    acc[2] += cw[j][2] * __uint_as_float(rv.y << 16); acc[3] += cw[j][3] * __uint_as_float(rv.y & 0xffff0000u);
                }
            }
            *(LAS f32x4*)(xcf + tl * 132 + cc) = acc;
            u32x2 w; w.x = pack2(acc[0], acc[1]); w.y = pack2(acc[2], acc[3]);
            *(LAS u32x2*)(xcb + tl * 136 + cc) = w;
        }
        __syncthreads();
        f32x4 ar[4], ai[4];
#pragma unroll
        for (int mt = 0; mt < 4; ++mt) { ar[mt] = (f32x4){0.f, 0.f, 0.f, 0.f}; ai[mt] = (f32x4){0.f, 0.f, 0.f, 0.f}; }
#pragma unroll
        for (int ks = 0; ks < 4; ++ks)
#pragma unroll
            for (int mt = 0; mt < 4; ++mt) {
                const bf16x8 af = *(const LAS bf16x8*)(xcb + (mt * 16 + fr) * 136 + 32 * ks + 8 * fq);
                ar[mt] = __builtin_amdgcn_mfma_f32_16x16x32_bf16(Br[ks], af, ar[mt], 0, 0, 0);
                ai[mt] = __builtin_amdgcn_mfma_f32_16x16x32_bf16(Bi[ks], af, ai[mt], 0, 0, 0);
            }
#pragma unroll
        for (int mt = 0; mt < 4; ++mt) {
            const int tl = mt * 16 + fr, cl = 16 * wid + 4 * fq;
            const f32x4 rec = *(const LAS f32x4*)(xcf + tl * 132 + cl);
            f32x4 av, bv;
#pragma unroll
            for (int r = 0; r < 4; ++r) {
                const float rg = sigmoidf_(ar[mt][r] + brv[r]), ig = sigmoidf_(ai[mt][r] + biv[r]);
                const float log_a = -8.0f * rg * spv[r];
                av[r] = __expf(log_a);
                bv[r] = sqrtf(fmaxf(-expm1f(2.0f * log_a), 0.f)) * ig * rec[r];
            }
            *(f32x4*)(Aarr + (size_t)(t0 + tl) * D + cg) = av; *(f32x4*)(Barr + (size_t)(t0 + tl) * D + cg) = bv;
            *(LAS f32x4*)(sa + tl * 132 + cl) = av; *(LAS f32x4*)(sb + tl * 132 + cl) = bv;
        }
        __syncthreads();
        {
            const int j = tid & 127, q = tid >> 7;
            float P = 1.f, H = 0.f;
#pragma unroll
            for (int s_ = 0; s_ < 16; ++s_) { const float a = sa[(q * 16 + s_) * 132 + j], bb = sb[(q * 16 + s_) * 132 + j]; H = a * H + bb; P *= a; }
            comb[(q * 128 + j) * 2 + 0] = P; comb[(q * 128 + j) * 2 + 1] = H;
        }
        __syncthreads();
        if (tid < 128) {
            float P = comb[tid * 2], H = comb[tid * 2 + 1];
#pragma unroll
            for (int q = 1; q < 4; ++q) { const float Pq = comb[(q * 128 + tid) * 2], Hq = comb[(q * 128 + tid) * 2 + 1]; H = Pq * H + Hq; P *= Pq; }
            SP[(size_t)tile * D + hd * 128 + tid] = P; SH[(size_t)tile * D + hd * 128 + tid] = H;
        }
    }
}
__device__ void lru_scan_phase(const Params& p) {
    const int tid = tid_();
    const bf16_t* u = (const bf16_t*)(p.ws + WS_U);
    const float* Aarr = (const float*)(p.ws + WS_SCR); const float* Barr = Aarr + (size_t)T * D;
    const float* SP = (const float*)(p.ws + WS_LSUM); const float* SH = SP + NBATCH * 32 * D;
    bf16_t* yin = (bf16_t*)(p.ws + WS_YIN);
    const int nunits = NBATCH * 32 * 2;
    for (int un = blockIdx.x; un < nunits; un += gridDim.x) {
        const int tile = un >> 1, c = (un & 1) * 512 + tid, b = tile >> 5, chunk = tile & 31;
        float h = 0.f;
        for (int k = 0; k < chunk; ++k) h = SP[(size_t)(b * 32 + k) * D + c] * h + SH[(size_t)(b * 32 + k) * D + c];
        const size_t tb = (size_t)tile * 64;
#pragma unroll 16
        for (int s_ = 0; s_ < 64; ++s_) {
            const size_t t = tb + s_;
            h = Aarr[t * D + c] * h + Barr[t * D + c];
            yin[t * D + c] = f2bf(gelu_fast(bf2f(u[t * 2048 + c])) * h);
        }
    }
}

typedef short s16x4 __attribute__((ext_vector_type(4)));
__device__ __forceinline__ s16x4 tr4(LAS const unsigned char* base, int row0, int col0, int stride, int lane) {
    const int q = (lane & 15) >> 2, pp = lane & 3;
    return __builtin_amdgcn_ds_read_tr16_b64_v4i16((LAS s16x4*)(base + (row0 + q) * stride + (col0 + 4 * pp) * 2));
}
__device__ __forceinline__ bf16x8 cat8(s16x4 a, s16x4 b) { return (bf16x8){a[0], a[1], a[2], a[3], b[0], b[1], b[2], b[3]}; }
__device__ void ret_core_phase(LAS unsigned char* lds, const Params& p) {
    const int tid = tid_(), lane = tid & 63, wid = tid >> 6, fr = lane & 15, fq = lane >> 4;
    constexpr int KS = 544, VS = 160, SS = 528;
    LAS unsigned char* Kl = lds;
    LAS unsigned char* Vl = lds + 128 * KS;
    LAS unsigned char* Sl = Vl + 128 * VS;
    const bf16_t* u = (const bf16_t*)(p.ws + WS_U);
    float* RO = (float*)(p.ws + WS_SCR);
    for (int un = blockIdx.x; un < NBATCH * 4 * 8; un += gridDim.x) {
        const int b = un >> 5, h = (un >> 3) & 3, vs = un & 7;
        const float lg2 = log2f(1.0f - exp2f(-5.0f - (float)h));
        f32x4 Sacc[2][4];
#pragma unroll
        for (int dt = 0; dt < 2; ++dt)
#pragma unroll
            for (int vt = 0; vt < 4; ++vt) Sacc[dt][vt] = (f32x4){0.f, 0.f, 0.f, 0.f};
        for (int i = tid; i < 64 * SS / 16; i += NTHREADS) ((LAS u32x4*)Sl)[i] = (u32x4){0u, 0u, 0u, 0u};
        for (int chunk = 0; chunk < 16; ++chunk) {
            const size_t t0 = (size_t)b * SEQ + chunk * 128;
#pragma unroll
            for (int i = 0; i < 8; ++i) {
                const int piece = tid + NTHREADS * i, m = piece >> 5, ch = piece & 31;
                const u32x4 kv = *(const u32x4*)(u + (t0 + m) * 6144 + 1024 + h * 256 + ch * 8);
                const float sc = exp2f(-(float)(m + 1) * lg2) * 0.0625f;
                u32x4 w;
                w.x = pack2(__uint_as_float(kv.x << 16) * sc, __uint_as_float(kv.x & 0xffff0000u) * sc); w.y = pack2(__uint_as_float(kv.y << 16) * sc, __uint_as_float(kv.y & 0xffff0000u) * sc);
                w.z = pack2(__uint_as_float(kv.z << 16) * sc, __uint_as_float(kv.z & 0xffff0000u) * sc); w.w = pack2(__uint_as_float(kv.w << 16) * sc, __uint_as_float(kv.w & 0xffff0000u) * sc);
                *(LAS u32x4*)(Kl + m * KS + ch * 16) = w;
            }
#pragma unroll
            for (int i = 0; i < 2; ++i) {
                const int piece = tid + NTHREADS * i, m = piece >> 3, ch = piece & 7;
                *(LAS u32x4*)(Vl + m * VS + ch * 16) = *(const u32x4*)(u + (t0 + m) * 6144 + 2048 + h * 512 + vs * 64 + ch * 8);
            }
            bf16x8 Qf[8];
#pragma unroll
            for (int ks = 0; ks < 8; ++ks) Qf[ks] = *(const bf16x8*)(u + (t0 + 16 * wid + fr) * 6144 + h * 256 + 32 * ks + 8 * fq);
            __syncthreads();
            f32x4 sc[8];
#pragma unroll
            for (int mt = 0; mt < 8; ++mt) {
                sc[mt] = (f32x4){0.f, 0.f, 0.f, 0.f};
#pragma unroll
                for (int ks = 0; ks < 8; ++ks) {
                    const bf16x8 kf = *(const LAS bf16x8*)(Kl + (16 * mt + fr) * KS + (32 * ks + 8 * fq) * 2);
                    sc[mt] = __builtin_amdgcn_mfma_f32_16x16x32_bf16(kf, Qf[ks], sc[mt], 0, 0, 0);
                }
            }
            bf16x8 pf[4];
            const int nloc = 16 * wid + fr;
#pragma unroll
            for (int ks2 = 0; ks2 < 4; ++ks2) {
                float v[8];
#pragma unroll
                for (int t = 0; t < 2; ++t)
#pragma unroll
                    for (int r = 0; r < 4; ++r) { const int m = 32 * ks2 + 16 * t + 4 * fq + r; v[4 * t + r] = (m <= nloc) ? sc[2 * ks2 + t][r] : 0.f; }
                u32x4 w; w.x = pack2(v[0], v[1]); w.y = pack2(v[2], v[3]); w.z = pack2(v[4], v[5]); w.w = pack2(v[6], v[7]);
                pf[ks2] = __builtin_bit_cast(bf16x8, w);
            }
            f32x4 O[4];
#pragma unroll
            for (int vt = 0; vt < 4; ++vt) {
                O[vt] = (f32x4){0.f, 0.f, 0.f, 0.f};
#pragma unroll
                for (int ks2 = 0; ks2 < 4; ++ks2) {
                    const bf16x8 vf = cat8(tr4(Vl, 32 * ks2 + 4 * fq, 16 * vt, VS, lane), tr4(Vl, 32 * ks2 + 16 + 4 * fq, 16 * vt, VS, lane));
                    O[vt] = __builtin_amdgcn_mfma_f32_16x16x32_bf16(pf[ks2], vf, O[vt], 0, 0, 0);
                }
#pragma unroll
                for (int ks = 0; ks < 8; ++ks) {
                    const bf16x8 sf = *(const LAS bf16x8*)(Sl + (16 * vt + fr) * SS + (32 * ks + 8 * fq) * 2);
                    O[vt] = __builtin_amdgcn_mfma_f32_16x16x32_bf16(Qf[ks], sf, O[vt], 0, 0, 0);
                }
            }
#pragma unroll
            for (int r = 0; r < 4; ++r) {
                const int n = 16 * wid + 4 * fq + r;
                const float qd = exp2f((float)(n + 1) * lg2);
                float* op = RO + (t0 + n) * 2048 + h * 512 + vs * 64 + fr;
#pragma unroll
                for (int vt = 0; vt < 4; ++vt) op[16 * vt] = O[vt][r] * qd;
            }
#pragma unroll
            for (int ks3 = 0; ks3 < 4; ++ks3) {
                bf16x8 kt[2], vf[4];
#pragma unroll
                for (int dt = 0; dt < 2; ++dt) kt[dt] = cat8(tr4(Kl, 32 * ks3 + 8 * fq, 32 * wid + 16 * dt, KS, lane), tr4(Kl, 32 * ks3 + 8 * fq + 4, 32 * wid + 16 * dt, KS, lane));
#pragma unroll
                for (int vt = 0; vt < 4; ++vt) vf[vt] = cat8(tr4(Vl, 32 * ks3 + 8 * fq, 16 * vt, VS, lane), tr4(Vl, 32 * ks3 + 8 * fq + 4, 16 * vt, VS, lane));
#pragma unroll
                for (int dt = 0; dt < 2; ++dt)
#pragma unroll
                    for (int vt = 0; vt < 4; ++vt) Sacc[dt][vt] = __builtin_amdgcn_mfma_f32_16x16x32_bf16(kt[dt], vf[vt], Sacc[dt][vt], 0, 0, 0);
            }
            __syncthreads();
            const float cd = exp2f(128.0f * lg2);
#pragma unroll
            for (int dt = 0; dt < 2; ++dt)
#pragma unroll
                for (int vt = 0; vt < 4; ++vt) {
                    Sacc[dt][vt] *= cd;
                    u32x2 w; w.x = pack2(Sacc[dt][vt][0], Sacc[dt][vt][1]); w.y = pack2(Sacc[dt][vt][2], Sacc[dt][vt][3]);
                    *(LAS u32x2*)(Sl + (16 * vt + fr) * SS + (32 * wid + 16 * dt + 4 * fq) * 2) = w;
                }
        }
        __syncthreads();
    }
}
__device__ void ret_norm_phase(LAS unsigned char* lds, const Params& p) {
    const int tid = tid_(), lane = tid & 63, wid = tid >> 6;
    LAS float* red = (LAS float*)lds;
    const bf16_t* u = (const bf16_t*)(p.ws + WS_U);
    const float* RO = (const float*)(p.ws + WS_SCR);
    bf16_t* yin = (bf16_t*)(p.ws + WS_YIN);
    for (int t = blockIdx.x; t < T; t += gridDim.x) {
        const f32x4 o = *(const f32x4*)(RO + (size_t)t * 2048 + tid * 4);
        const float ss = wave_sum(o[0] * o[0] + o[1] * o[1] + o[2] * o[2] + o[3] * o[3]);
        if (lane == 0) red[wid] = ss;
        __syncthreads();
        const float tot = red[(wid & ~1)] + red[(wid | 1)];
        const float rstd = rsqrtf(tot * (1.0f / 512.0f) + 1e-6f);
        const u32x2 gv = *(const u32x2*)(u + (size_t)t * 6144 + 4096 + tid * 4);
        const float g0 = __uint_as_float(gv.x << 16), g1 = __uint_as_float(gv.x & 0xffff0000u), g2 = __uint_as_float(gv.y << 16), g3 = __uint_as_float(gv.y & 0xffff0000u);
        u32x2 w; w.x = pack2(g0 * sigmoidf_(g0) * o[0] * rstd, g1 * sigmoidf_(g1) * o[1] * rstd); w.y = pack2(g2 * sigmoidf_(g2) * o[2] * rstd, g3 * sigmoidf_(g3) * o[3] * rstd);
        *(u32x2*)(yin + (size_t)t * 2048 + tid * 4) = w;
        __syncthreads();
    }
}

__device__ void attn_core_phase(LAS unsigned char* lds, const Params& p) {
    const int tid = tid_(), lane = tid & 63, wid = tid >> 6, fr = lane & 15, fq = lane >> 4;
    constexpr int RS = 144, TILE = 272 * RS;
    LAS unsigned char* Kl = lds;
    LAS unsigned char* Vl = lds + TILE;
    const bf16_t* u = (const bf16_t*)(p.ws + WS_U);
    bf16_t* OP = (bf16_t*)(p.ws + WS_SCR);
    float* LSE = (float*)(p.ws + WS_SCR + 96 * MB);
    for (int i = tid; i < 16 * RS / 16; i += NTHREADS) { ((LAS u32x4*)(Kl + 256 * RS))[i] = (u32x4){0u, 0u, 0u, 0u}; ((LAS u32x4*)(Vl + 256 * RS))[i] = (u32x4){0u, 0u, 0u, 0u}; }
    for (int un = blockIdx.x; un < 3 * 2048; un += gridDim.x) {
        const int g = un >> 11, rem = un & 2047, b = rem >> 8, h = (rem >> 4) & 15, x = rem & 15;
        const int dl = (g == 0) ? 1 : (g == 1 ? 4 : 16), r_ = x & (dl - 1), n = x / dl;
        const float slope = exp2f(-0.5f * (float)(h + 1)) * (float)dl;
        const bf16_t* ub = u + (size_t)b * SEQ * 9216;
#pragma unroll
        for (int i = 0; i < 4; ++i) {
            const int piece = tid + NTHREADS * i, row = piece >> 3, ch = piece & 7;
            const int sk = ((n - 1) * 128 + row) * dl + r_;
            u32x4 kv = (u32x4){0u, 0u, 0u, 0u}, vv = (u32x4){0u, 0u, 0u, 0u};
            if (sk >= 0) { const bf16_t* src = ub + (size_t)sk * 9216 + h * 64 + ch * 8; kv = *(const u32x4*)(src + (3 + g) * 1024); vv = *(const u32x4*)(src + (6 + g) * 1024); }
            *(LAS u32x4*)(Kl + row * RS + ch * 16) = kv; *(LAS u32x4*)(Vl + row * RS + ch * 16) = vv;
        }
        const int qi = 16 * wid + fr, sq = (n * 128 + qi) * dl + r_;
        bf16x8 Qf[2];
#pragma unroll
        for (int ks = 0; ks < 2; ++ks) Qf[ks] = *(const bf16x8*)(ub + (size_t)sq * 9216 + g * 1024 + h * 64 + 32 * ks + 8 * fq);
        __syncthreads();
        f32x4 sc[9];
        float mx = -INFINITY;
#pragma unroll
        for (int kt = 0; kt < 9; ++kt) {
            sc[kt] = (f32x4){0.f, 0.f, 0.f, 0.f};
#pragma unroll
            for (int ks = 0; ks < 2; ++ks) {
                const bf16x8 kf = *(const LAS bf16x8*)(Kl + (16 * (wid + kt) + fr) * RS + (32 * ks + 8 * fq) * 2);
                sc[kt] = __builtin_amdgcn_mfma_f32_16x16x32_bf16(kf, Qf[ks], sc[kt], 0, 0, 0);
            }
#pragma unroll
            for (int r = 0; r < 4; ++r) {
                const int ki = 16 * (wid + kt) + 4 * fq + r, steps = qi + 128 - ki;
                const bool ok = (steps >= 0) && (steps <= 128) && (n > 0 || ki >= 128);
                const float v = ok ? sc[kt][r] * 0.125f - slope * (float)steps : -INFINITY;
                sc[kt][r] = v; mx = fmaxf(mx, v);
            }
        }
        mx = fmaxf(mx, __shfl_xor(mx, 16)); mx = fmaxf(mx, __shfl_xor(mx, 32));
        float l = 0.f;
#pragma unroll
        for (int kt = 0; kt < 9; ++kt)
#pragma unroll
            for (int r = 0; r < 4; ++r) { const float pv = __expf(sc[kt][r] - mx); sc[kt][r] = pv; l += pv; }
        l += __shfl_xor(l, 16); l += __shfl_xor(l, 32);
        f32x4 O[4];
#pragma unroll
        for (int dt = 0; dt < 4; ++dt) O[dt] = (f32x4){0.f, 0.f, 0.f, 0.f};
#pragma unroll
        for (int ks5 = 0; ks5 < 5; ++ks5) {
            const f32x4 p0 = sc[2 * ks5], p1 = (ks5 < 4) ? sc[(ks5 < 4) ? 2 * ks5 + 1 : 0] : (f32x4){0.f, 0.f, 0.f, 0.f};
            u32x4 w; w.x = pack2(p0[0], p0[1]); w.y = pack2(p0[2], p0[3]); w.z = pack2(p1[0], p1[1]); w.w = pack2(p1[2], p1[3]);
            const bf16x8 pf = __builtin_bit_cast(bf16x8, w);
#pragma unroll
            for (int dt = 0; dt < 4; ++dt) {
                const bf16x8 vf = cat8(tr4(Vl, 16 * (wid + 2 * ks5) + 4 * fq, 16 * dt, RS, lane), tr4(Vl, 16 * (wid + 2 * ks5 + 1) + 4 * fq, 16 * dt, RS, lane));
                O[dt] = __builtin_amdgcn_mfma_f32_16x16x32_bf16(vf, pf, O[dt], 0, 0, 0);
            }
        }
        const float inv = 1.0f / l;
        const size_t tq = (size_t)b * SEQ + sq;
#pragma unroll
        for (int dt = 0; dt < 4; ++dt) {
            u32x2 w; w.x = pack2(O[dt][0] * inv, O[dt][1] * inv); w.y = pack2(O[dt][2] * inv, O[dt][3] * inv);
            *(u32x2*)(OP + ((size_t)g * T + tq) * D + h * 64 + 16 * dt + 4 * fq) = w;
        }
        if (fq == 0) LSE[((size_t)g * T + tq) * 16 + h] = mx + __logf(l);
        __syncthreads();
    }
}
__device__ void attn_merge_phase(const Params& p) {
    const int tid = tid_();
    const bf16_t* OP = (const bf16_t*)(p.ws + WS_SCR);
    const float* LSE = (const float*)(p.ws + WS_SCR + 96 * MB);
    bf16_t* yin = (bf16_t*)(p.ws + WS_YIN);
    for (size_t i = (size_t)blockIdx.x * NTHREADS + tid; i < (size_t)T * D / 8; i += (size_t)gridDim.x * NTHREADS) {
        const size_t t = i >> 7; const int c8 = (int)(i & 127), h = c8 >> 3;
        const float l0 = LSE[t * 16 + h], l1 = LSE[((size_t)T + t) * 16 + h], l2 = LSE[((size_t)2 * T + t) * 16 + h];
        const float m = fmaxf(l0, fmaxf(l1, l2));
        float w0 = __expf(l0 - m), w1 = __expf(l1 - m), w2 = __expf(l2 - m);
        const float inv = 1.0f / (w0 + w1 + w2); w0 *= inv; w1 *= inv; w2 *= inv;
        const u32x4 a = *(const u32x4*)(OP + t * D + c8 * 8), bq = *(const u32x4*)(OP + ((size_t)T + t) * D + c8 * 8), c = *(const u32x4*)(OP + ((size_t)2 * T + t) * D + c8 * 8);
        u32x4 o;
#define MRG(f) o.f = pack2(w0 * __uint_as_float(a.f << 16) + w1 * __uint_as_float(bq.f << 16) + w2 * __uint_as_float(c.f << 16), \
                           w0 * __uint_as_float(a.f & 0xffff0000u) + w1 * __uint_as_float(bq.f & 0xffff0000u) + w2 * __uint_as_float(c.f & 0xffff0000u))
        MRG(x); MRG(y); MRG(z); MRG(w);
#undef MRG
        *(u32x4*)(yin + t * D + c8 * 8) = o;
    }
}

__device__ void ln_phase(const Params& p, int layer, int which) {
    const int tid = tid_(), lane = tid & 63, wid = tid >> 6;
    float* xf = (float*)(p.ws + WS_XF); bf16_t* xb = (bf16_t*)(p.ws + WS_XB);
    const float* ymix = (const float*)(p.ws + WS_YMIX);
    const float* yrows = (const float*)(p.ws + WS_YROWS);
    int* tope = (int*)(p.ws + WS_TOPE); float* gates = (float*)(p.ws + WS_GATES); int* pos = (int*)(p.ws + WS_POS); const int* dest = (const int*)(p.ws + WS_DEST);
    unsigned* ctl = (unsigned*)(p.ws + WS_CTL);
    const float* gain = p.ln_gain + (size_t)(layer * 2 + which) * D; const float* bias = p.ln_bias + (size_t)(layer * 2 + which) * D;
    const float* wrt = p.moe_w_router + (size_t)layer * D * NEXP; const float* brt = p.moe_b_router + (size_t)layer * NEXP;
    for (int t = blockIdx.x * 8 + wid; t < T; t += gridDim.x * 8) {
        f32x4 z[4];
        if (which == 0) {
#pragma unroll
            for (int i = 0; i < 4; ++i) { const int c = 256 * i + 4 * lane; z[i] = DN_ALPHA * *(const f32x4*)(xf + (size_t)t * D + c) + *(const f32x4*)(ymix + (size_t)t * D + c); }
        } else {
            int dk[4]; float gk[4];
#pragma unroll
            for (int k = 0; k < 4; ++k) { dk[k] = dest[t * 4 + k]; gk[k] = gates[t * 4 + k]; }
#pragma unroll
            for (int i = 0; i < 4; ++i) {
                const int c = 256 * i + 4 * lane;
                f32x4 f = (f32x4){0.f, 0.f, 0.f, 0.f};
#pragma unroll
                for (int k = 0; k < 4; ++k) f += gk[k] * *(const f32x4*)(yrows + (size_t)dk[k] * D + c);
                z[i] = DN_ALPHA * *(const f32x4*)(xf + (size_t)t * D + c) + f;
            }
        }
        float sm = 0.f;
#pragma unroll
        for (int i = 0; i < 4; ++i) sm += (z[i][0] + z[i][1]) + (z[i][2] + z[i][3]);
        const float mean = wave_sum(sm) * (1.0f / D);
        float sq = 0.f;
#pragma unroll
        for (int i = 0; i < 4; ++i) { const f32x4 dd = z[i] - mean; sq += (dd[0] * dd[0] + dd[1] * dd[1]) + (dd[2] * dd[2] + dd[3] * dd[3]); }
        const float rstd = rsqrtf(wave_sum(sq) * (1.0f / D) + LN_EPS);
#pragma unroll
        for (int i = 0; i < 4; ++i) {
            const int c = 256 * i + 4 * lane;
            z[i] = (z[i] - mean) * rstd * *(const f32x4*)(gain + c) + *(const f32x4*)(bias + c);
            *(f32x4*)(xf + (size_t)t * D + c) = z[i];
            u32x2 w; w.x = pack2(z[i][0], z[i][1]); w.y = pack2(z[i][2], z[i][3]);
            *(u32x2*)(xb + (size_t)t * D + c) = w;
            if (which == 1 && layer == DEPTH - 1) *(f32x4*)(p.out + (size_t)t * D + c) = z[i];
        }
        if (which == 0) {
            const float* wrt_l = wrt; asm volatile("" : "+s"(wrt_l));
            float lg[NEXP];
#pragma unroll
            for (int e = 0; e < NEXP; ++e) lg[e] = 0.f;
#pragma unroll
            for (int i = 0; i < 4; ++i)
#pragma unroll
                for (int j = 0; j < 4; ++j) {
                    const int c = 256 * i + 4 * lane + j; const float xv = z[i][j];
#pragma unroll
                    for (int e4 = 0; e4 < NEXP / 4; ++e4) { const f32x4 w = *(const f32x4*)(wrt_l + (unsigned)(c * NEXP + e4 * 4)); lg[e4 * 4 + 0] += xv * w[0]; lg[e4 * 4 + 1] += xv * w[1]; lg[e4 * 4 + 2] += xv * w[2]; lg[e4 * 4 + 3] += xv * w[3]; }
                    if (j & 1) __builtin_amdgcn_sched_barrier(0);
                }
#pragma unroll
            for (int e = 0; e < NEXP; ++e) lg[e] = wave_sum(lg[e]) + brt[e];
            int te[4]; float tv[4]; unsigned used = 0u;
#pragma unroll
            for (int k = 0; k < 4; ++k) {
                float best = -INFINITY; int bi = 0;
#pragma unroll
                for (int e = 0; e < NEXP; ++e) { const bool ok = !((used >> e) & 1u) && lg[e] > best; best = ok ? lg[e] : best; bi = ok ? e : bi; }
                te[k] = bi; tv[k] = best; used |= 1u << bi;
            }
            const float e1 = __expf(tv[1] - tv[0]), e2 = __expf(tv[2] - tv[0]), e3 = __expf(tv[3] - tv[0]);
            const float inv = 1.0f / (1.0f + e1 + e2 + e3);
            if (lane < 4) {
                const int k = lane;
                const int ee = (k == 0) ? te[0] : (k == 1 ? te[1] : (k == 2 ? te[2] : te[3]));
                const float gg = ((k == 0) ? 1.0f : (k == 1 ? e1 : (k == 2 ? e2 : e3))) * inv;
                tope[t * 4 + k] = ee; gates[t * 4 + k] = gg;
                pos[t * 4 + k] = (int)atomicAdd(ctl + CW_CNT + layer * 64 + ee, 1u);
            }
        }
    }
}

__device__ void moe_scatter_phase(LAS unsigned char* lds, const Params& p, int layer) {
    const int tid = tid_();
    LAS int* pstart = (LAS int*)lds;
    unsigned* ctl = (unsigned*)(p.ws + WS_CTL);
    const int* tope = (const int*)(p.ws + WS_TOPE); const int* pos = (const int*)(p.ws + WS_POS);
    int* dest = (int*)(p.ws + WS_DEST); int* rowtok = (int*)(p.ws + WS_ROWTOK);
    if (tid == 0) {
        int acc = 0;
        for (int e = 0; e < NEXP; ++e) { const int c = (int)ctl[CW_CNT + layer * 64 + e]; pstart[e] = acc; pstart[32 + e] = c; acc += ((c + 255) >> 8) << 8; }
        pstart[64] = acc;
        if (blockIdx.x == 0) {
            ctl[CW_MDYN + layer * 64] = (unsigned)acc;
            for (int e = 0; e < NEXP; ++e) { const int nb = (pstart[32 + e] + 255) >> 8; for (int b = 0; b < nb; ++b) ctl[CW_TEXP + layer * 512 + (pstart[e] >> 8) + b] = (unsigned)e; }
        }
    }
    __syncthreads();
    for (int i = blockIdx.x * NTHREADS + tid; i < T * TOPK; i += gridDim.x * NTHREADS) {
        const int e = tope[i], row = pstart[e] + pos[i];
        dest[i] = row; rowtok[row] = i >> 2;
    }
    for (int i = blockIdx.x * NTHREADS + tid; i < NEXP * 256; i += gridDim.x * NTHREADS) {
        const int e = i >> 8, r = i & 255, c = pstart[32 + e], padded = ((c + 255) >> 8) << 8;
        if (c + r < padded) rowtok[pstart[e] + c + r] = 0;
    }
    __syncthreads();
}

constexpr int PH_PER_LAYER = 9;
constexpr int NPHASES = 1 + DEPTH * PH_PER_LAYER;
constexpr int LDS_BYTES = 132 * 1024;


#ifndef PHMASK
#define PHMASK 0x3FF
#endif
#define PHK(j) ((PHMASK >> (j)) & 1)
#define IN(k) (lo <= (k) && (k) < hi)
#if MK_ONE_LAUNCH
#define SEAM(k) do { if (IN(k) && IN((k) + 1)) xcd_barrier_nv(bar.bar, bar.x, bar.st); } while (0)
#else
#define SEAM(k) do {} while (0)
#endif
template <int layer>
__device__ __forceinline__ void run_layer(const Params& p, LAS unsigned char* lds, const XcdBarrier& bar) {
    const int lo = p.ph_lo, hi = p.ph_hi;
    unsigned char* ws = p.ws;
    unsigned* ctl = (unsigned*)(ws + WS_CTL);
        constexpr int base = 1 + layer * PH_PER_LAYER, kind = layer % 3, idx = layer / 3;
        if (PHK(1) && IN(base + 0)) {
            constexpr int N = (kind == 0) ? 2048 : (kind == 1 ? 6144 : 9216);
            const bf16_t* Bt = (kind == 0) ? (const bf16_t*)(ws + WS_AWIN) + (size_t)idx * 2048 * D : (kind == 1 ? (const bf16_t*)(ws + WS_BWIN) : (const bf16_t*)(ws + WS_CWIN));
            g8::SchedPlain S; S.init(ws + WS_XB, Bt, T, N, D, (int)gridDim.x, (int)blockIdx.x);
            g8::EpiBf16 E{(bf16_t*)(ws + WS_U), N};
            g8::gemm_phase<g8::EpiBf16, g8::SchedPlain, false>(lds, D, S, E);
        }
        SEAM(base + 0);
        if (PHK(2) && IN(base + 1)) {
            if (kind == 0) lru_gates_phase(lds, p, idx);
            else if (kind == 1) ret_core_phase(lds, p);
            else attn_core_phase(lds, p);
        }
        SEAM(base + 1);
        if (PHK(3) && IN(base + 2)) {
            if (kind == 0) lru_scan_phase(p);
            else if (kind == 1) ret_norm_phase(lds, p);
            else attn_merge_phase(p);
        }
        SEAM(base + 2);
        if (PHK(4) && IN(base + 3)) {
            constexpr int K = (kind == 1) ? 2048 : D;
            const bf16_t* Bt = (kind == 0) ? (const bf16_t*)(ws + WS_AWOUT) + (size_t)idx * D * D : (kind == 1 ? (const bf16_t*)(ws + WS_BWOUT) : (const bf16_t*)(ws + WS_CWOUT));
            g8::SchedPlain S; S.init(ws + WS_YIN, Bt, T, D, K, (int)gridDim.x, (int)blockIdx.x);
            g8::EpiF32 E{(float*)(ws + WS_YMIX), D, nullptr, 0};
            g8::gemm_phase<g8::EpiF32, g8::SchedPlain, false>(lds, K, S, E);
        }
        SEAM(base + 3);
        if (PHK(5) && IN(base + 4)) ln_phase(p, layer, 0);
        SEAM(base + 4);
        if (PHK(6) && IN(base + 5)) moe_scatter_phase(lds, p, layer);
        SEAM(base + 5);
        if (PHK(7) && IN(base + 6)) {
            g8::SchedGU S{(const char*)(ws + WS_XB), (const char*)((const bf16_t*)(ws + WS_GU) + (size_t)layer * NEXP * 2048 * D), (const int*)(ws + WS_ROWTOK), ctl + CW_TEXP + layer * 512,
                          (int)(ctl[CW_MDYN + layer * 64] >> 8), (int)gridDim.x, (int)blockIdx.x};
            g8::EpiSwiglu E{(bf16_t*)(ws + WS_HID), p.moe_b_gu + (size_t)layer * NEXP * 2048};
            g8::gemm_phase<g8::EpiSwiglu, g8::SchedGU, true>(lds, D, S, E);
        }
        SEAM(base + 6);
        if (PHK(8) && IN(base + 7)) {
            g8::SchedDown S{(const char*)(ws + WS_HID), (const char*)((const bf16_t*)(ws + WS_DN) + (size_t)layer * NEXP * D * D), ctl + CW_TEXP + layer * 512,
                            (int)(ctl[CW_MDYN + layer * 64] >> 8), (int)gridDim.x, (int)blockIdx.x};
            g8::EpiF32 E{(float*)(ws + WS_YROWS), D, p.moe_b_down + (size_t)layer * NEXP * D, D};
            g8::gemm_phase<g8::EpiF32, g8::SchedDown, false>(lds, D, S, E);
        }
        SEAM(base + 7);
        if (PHK(9) && IN(base + 8)) ln_phase(p, layer, 1);
        SEAM(base + 8);
    }
#undef IN
#undef SEAM
__global__ void __launch_bounds__(NTHREADS, 2) fwd_kernel(Params p) {
    extern __shared__ __attribute__((aligned(16))) unsigned char lds_raw[];
    LAS unsigned char* lds = (LAS unsigned char*)lds_raw;
    const int lo = p.ph_lo, hi = p.ph_hi;
    unsigned char* ws = p.ws;
    unsigned* ctl = (unsigned*)(ws + WS_CTL);
#if MK_ONE_LAUNCH
    volatile LAS unsigned* bst = (volatile LAS unsigned*)(lds + LDS_BYTES - 16);
    if (threadIdx.x == 0) { bst[0] = 0u; bst[1] = 0u; bst[2] = 0u; bst[3] = 0u; }
    __syncthreads();
    XcdBarrier bar = xcd_barrier_post(ctl, bst);
#define GRID_BAR() xcd_barrier_nv(bar.bar, bar.x, bar.st)
#else
    XcdBarrier bar; bar.bar = ctl; bar.x = 0; bar.st = nullptr;
#define GRID_BAR() do {} while (0)
#endif
#define IN(k) (lo <= (k) && (k) < hi)
#define SEAM(k) do { if (IN(k) && IN((k) + 1)) GRID_BAR(); } while (0)

    if (PHK(0) && IN(0)) {
        LAS float* tile = (LAS float*)lds;
        for (int l = 0; l < 2; ++l) {
            convert_job(tile, p.a_w_in + (size_t)l * D * 2048, (bf16_t*)(ws + WS_AWIN) + (size_t)l * 2048 * D, D, 2048, 1);
            convert_job(tile, p.a_w_out + (size_t)l * D * D, (bf16_t*)(ws + WS_AWOUT) + (size_t)l * D * D, D, D, 1);
        }
        convert_job(tile, p.a_w_rgate, (bf16_t*)(ws + WS_AGT), 128, 128, 8);
        convert_job(tile, p.a_w_igate, (bf16_t*)(ws + WS_AGT) + (size_t)8 * 128 * 128, 128, 128, 8);
        convert_job(tile, p.a_w_rgate + (size_t)8 * 128 * 128, (bf16_t*)(ws + WS_AGT) + (size_t)16 * 128 * 128, 128, 128, 8);
        convert_job(tile, p.a_w_igate + (size_t)8 * 128 * 128, (bf16_t*)(ws + WS_AGT) + (size_t)24 * 128 * 128, 128, 128, 8);
        convert_job(tile, p.b_w_in, (bf16_t*)(ws + WS_BWIN), D, 6144, 1);
        convert_job(tile, p.b_w_out, (bf16_t*)(ws + WS_BWOUT), 2048, D, 1);
        convert_job(tile, p.c_w_in, (bf16_t*)(ws + WS_CWIN), D, 9216, 1);
        convert_job(tile, p.c_w_out, (bf16_t*)(ws + WS_CWOUT), D, D, 1);
        convert_job(tile, p.moe_w_gu, (bf16_t*)(ws + WS_GU), D, 2048, DEPTH * NEXP);
        convert_job(tile, p.moe_w_down, (bf16_t*)(ws + WS_DN), D, D, DEPTH * NEXP);
        float* xf = (float*)(ws + WS_XF); bf16_t* xb = (bf16_t*)(ws + WS_XB);
        for (size_t i = (size_t)blockIdx.x * NTHREADS + threadIdx.x; i < (size_t)T * D / 4; i += (size_t)gridDim.x * NTHREADS) {
            const f32x4 v = *(const f32x4*)(p.x + i * 4);
            *(f32x4*)(xf + i * 4) = v;
            u32x2 w; w.x = pack2(v[0], v[1]); w.y = pack2(v[2], v[3]); *(u32x2*)(xb + i * 4) = w;
        }
    }
    SEAM(0);

    run_layer<0>(p, lds, bar); run_layer<1>(p, lds, bar); run_layer<2>(p, lds, bar); run_layer<3>(p, lds, bar);
#undef IN
#undef SEAM
}

extern "C" void kernel_launch(void* const* d_in, const int* in_sizes, int n_in, void* d_out, int out_size, void* d_ws, size_t ws_size, hipStream_t stream) {
    static int grid = 0;
    if (grid == 0) {
        if (n_in != 22 || out_size != T * D || ws_size < WS_END) { fprintf(stderr, "kernel_launch: unexpected shapes (n_in %d out %d ws %zu need %zu)\n", n_in, out_size, ws_size, (size_t)WS_END); grid = -1; return; }
        if (hipFuncSetAttribute((const void*)fwd_kernel, hipFuncAttributeMaxDynamicSharedMemorySize, LDS_BYTES) != hipSuccess) { fprintf(stderr, "kernel_launch: hipFuncSetAttribute failed\n"); grid = -1; return; }
        int dev = 0, cus = 0;
        if (hipGetDevice(&dev) != hipSuccess || hipDeviceGetAttribute(&cus, hipDeviceAttributeMultiprocessorCount, dev) != hipSuccess) { grid = -1; return; }
        grid = cus;
    }
    if (grid < 0) return;
    (void)hipMemsetAsync((char*)d_ws + WS_CTL, 0, CTL_BYTES, stream);
    Params p{};
    const float** pp = (const float**)&p;
    for (int i = 0; i < 22; ++i) pp[i] = (const float*)d_in[i];
    p.out = (float*)d_out; p.ws = (unsigned char*)d_ws;
#if MK_ONE_LAUNCH
    p.ph_lo = 0; p.ph_hi = NPHASES;
    hipLaunchKernelGGL(fwd_kernel, dim3(grid), dim3(NTHREADS), LDS_BYTES, stream, p);
#else
    for (int ph = 0; ph < NPHASES; ++ph) {
        p.ph_lo = ph; p.ph_hi = ph + 1;
        hipLaunchKernelGGL(fwd_kernel, dim3(grid), dim3(NTHREADS), LDS_BYTES, stream, p);
    }
#endif
}
```

```cpp
#include <hip/hip_runtime.h>
#include <stdint.h>
#include <stdio.h>

#ifndef MK_ONE_LAUNCH
#define MK_ONE_LAUNCH 1
#endif

#define LAS __attribute__((address_space(3)))
typedef unsigned short bf16_t;
typedef short bf16x8 __attribute__((ext_vector_type(8)));
typedef float f32x4 __attribute__((ext_vector_type(4)));
typedef unsigned u32x4 __attribute__((ext_vector_type(4)));
typedef unsigned u32x2 __attribute__((ext_vector_type(2)));

constexpr int T = 16384, D = 1024, SEQ = 2048, NBATCH = 8, DEPTH = 4;
constexpr int NEXP = 32, TOPK = 4;
constexpr int MAXROWS = 73728;
constexpr float DN_ALPHA = 1.681792830507429f;
constexpr float LN_EPS = 1e-5f;
constexpr int NTHREADS = 512;

constexpr size_t MB = 1ull << 20;
constexpr size_t WS_CTL = 0;
constexpr size_t CTL_BYTES = 65536;
constexpr size_t WS_AWIN = 1 * MB;
constexpr size_t WS_AWOUT = WS_AWIN + 8 * MB;
constexpr size_t WS_BWIN = WS_AWOUT + 4 * MB;
constexpr size_t WS_BWOUT = WS_BWIN + 12 * MB;
constexpr size_t WS_CWIN = WS_BWOUT + 4 * MB;
constexpr size_t WS_CWOUT = WS_CWIN + 18 * MB;
constexpr size_t WS_GU = WS_CWOUT + 2 * MB;
constexpr size_t WS_DN = WS_GU + 512 * MB;
constexpr size_t WS_XF = WS_DN + 256 * MB;
constexpr size_t WS_XB = WS_XF + 64 * MB;
constexpr size_t WS_U = WS_XB + 32 * MB;
constexpr size_t WS_YIN = WS_U + 288 * MB;
constexpr size_t WS_YMIX = WS_YIN + 64 * MB;
constexpr size_t WS_SCR = WS_YMIX + 64 * MB;
constexpr size_t WS_TOPE = WS_SCR + 128 * MB;
constexpr size_t WS_GATES = WS_TOPE + 256 * 1024;
constexpr size_t WS_POS = WS_GATES + 256 * 1024;
constexpr size_t WS_DEST = WS_POS + 256 * 1024;
constexpr size_t WS_ROWTOK = WS_DEST + 256 * 1024;
constexpr size_t WS_HID = WS_ROWTOK + 1 * MB;
constexpr size_t WS_YROWS = WS_HID + 144 * MB;
constexpr size_t WS_LSUM = WS_YROWS + 288 * MB;
constexpr size_t WS_AGT = WS_LSUM + 2 * MB;
constexpr size_t WS_RT = WS_AGT + 1 * MB;
constexpr size_t WS_END = WS_RT + 1 * MB;

constexpr int CW_CNT = 4096;
constexpr int CW_MDYN = 8192;
constexpr int CW_TEXP = 12288;

#define XB_TMO      128
#define XB_XCNT(j)  (256  + 64 * (j))
#define XB_XSUB(j)  (1280 + 64 * (j))
#define XB_XGEN(j)  (2304 + 64 * (j))
#define XB_TOP      3328
#define XB_TOPGEN   3392
#define XCD_BAR_WORDS 3456
#define XB_SPIN_CAP (1u << 22)

__device__ __forceinline__ unsigned xb_ld(unsigned* p)              { return __hip_atomic_load(p, __ATOMIC_RELAXED, __HIP_MEMORY_SCOPE_AGENT); }
__device__ __forceinline__ unsigned xb_add(unsigned* p, unsigned v) { return __hip_atomic_fetch_add(p, v, __ATOMIC_RELAXED, __HIP_MEMORY_SCOPE_AGENT); }
__device__ __forceinline__ unsigned xb_xcc_id() { return (unsigned)__builtin_amdgcn_s_getreg((3 << 11) | 20) & 0xFu; }
#define XB_SPIN(cond, bar) do { unsigned _sp = 0; while (cond) { __builtin_amdgcn_s_sleep(1); \
    if ((++_sp & 255u) == 0u) { if (xb_ld(&(bar)[XB_TMO])) break; if (_sp > XB_SPIN_CAP) { atomicAdd(&(bar)[XB_TMO], 1u); break; } } } } while (0)

struct XcdBarrier { unsigned* bar; unsigned x; volatile LAS unsigned* st; };

__device__ __forceinline__ XcdBarrier xcd_barrier_post(unsigned* bar, volatile LAS unsigned* st) {
    XcdBarrier b; b.bar = bar; b.x = xb_xcc_id(); b.st = st;
    if (threadIdx.x == 0) (void)xb_add(&bar[XB_XCNT(b.x)], 1u);
    return b;
}
__device__ __forceinline__ void xcd_barrier_complete(unsigned* bar, unsigned x, unsigned& nloc, unsigned& nx) {
    const unsigned G = gridDim.x * gridDim.y * gridDim.z;
    unsigned sum, cnt, mine, sp = 0u;
    for (;;) {
        sum = 0u; cnt = 0u; mine = 0u;
#pragma unroll
        for (unsigned j = 0; j < 16; ++j) { const unsigned c = xb_ld(&bar[XB_XCNT(j)]); sum += c; cnt += (c > 0u) ? 1u : 0u; mine = (j == x) ? c : mine; }
        if (sum == G) break;
        __builtin_amdgcn_s_sleep(1);
        if ((++sp & 255u) == 0u) { if (xb_ld(&bar[XB_TMO])) break; if (sp > XB_SPIN_CAP) { atomicAdd(&bar[XB_TMO], 1u); break; } }
    }
    nloc = mine > 0u ? mine : 1u; nx = cnt > 0u ? cnt : 1u;
}
__device__ __noinline__ void xcd_barrier_nv(unsigned* bbar, unsigned bx, volatile LAS unsigned* bst) {
    XcdBarrier b; b.bar = bbar; b.x = bx; b.st = bst;
    asm volatile("s_waitcnt vmcnt(0)" ::: "memory");
    __syncthreads();
    if (threadIdx.x == 0) {
        unsigned* bar = b.bar;
        __builtin_amdgcn_s_waitcnt(0);
        unsigned nloc = b.st[0], nx = b.st[1];
        if (nloc == 0u) { xcd_barrier_complete(bar, b.x, nloc, nx); b.st[0] = nloc; b.st[1] = nx; }
        const unsigned old = xb_add(&bar[XB_XSUB(b.x)], 1u);
        const unsigned gen = old / nloc;
        if (old + 1u == (gen + 1u) * nloc) {
            __builtin_amdgcn_fence(__ATOMIC_RELEASE, "agent");
            asm volatile("s_waitcnt vmcnt(0)" ::: "memory");
            const unsigned og = xb_add(&bar[XB_TOP], 1u);
            const unsigned tg = og / nx;
            if (og + 1u == (tg + 1u) * nx) xb_add(&bar[XB_TOPGEN], 1u);
            else XB_SPIN(xb_ld(&bar[XB_TOPGEN]) == tg, bar);
            __builtin_amdgcn_fence(__ATOMIC_ACQUIRE, "agent");
            xb_add(&bar[XB_XGEN(b.x)], 1u);
            asm volatile("s_waitcnt vmcnt(0)" ::: "memory");
        } else {
            XB_SPIN(xb_ld(&bar[XB_XGEN(b.x)]) == gen, bar);
            __builtin_amdgcn_fence(__ATOMIC_ACQUIRE, "agent");
            asm volatile("s_waitcnt vmcnt(0)" ::: "memory");
        }
    }
    __syncthreads();
}

__device__ __forceinline__ int tid_() { int t = threadIdx.x; asm volatile("" : "+v"(t)); return t; }
__device__ __forceinline__ float bf2f(bf16_t v) { return __uint_as_float(((unsigned)v) << 16); }
__device__ __forceinline__ bf16_t f2bf(float f) { unsigned u = __float_as_uint(f); u += 0x7FFFu + ((u >> 16) & 1u); return (bf16_t)(u >> 16); }
__device__ __forceinline__ unsigned pack2(float lo, float hi) { return (unsigned)f2bf(lo) | ((unsigned)f2bf(hi) << 16); }
__device__ __forceinline__ float wave_sum(float v) {
#pragma unroll
    for (int o = 32; o >= 1; o >>= 1) v += __shfl_xor(v, o);
    return v;
}
__device__ __forceinline__ float wave_max(float v) {
#pragma unroll
    for (int o = 32; o >= 1; o >>= 1) v = fmaxf(v, __shfl_xor(v, o));
    return v;
}
__device__ __forceinline__ float sigmoidf_(float x) { return 1.0f / (1.0f + __expf(-x)); }
__device__ __forceinline__ float gelu_tanh(float x) { const float u = 0.7978845608028654f * (x + 0.044715f * x * x * x); return 0.5f * x * (1.0f + tanhf(u)); }
__device__ __forceinline__ float swiglu(float gate, float up) {
    const float g = fminf(gate, 7.0f), u = fminf(fmaxf(up, -7.0f), 7.0f);
    return (u + 1.0f) * g * sigmoidf_(1.702f * g);
}

struct Params {
    const float* x; const float* a_w_in; const float* a_conv_w; const float* a_conv_b; const float* a_w_rgate; const float* a_b_rgate;
    const float* a_w_igate; const float* a_b_igate; const float* a_lambda; const float* a_w_out; const float* b_w_in; const float* b_w_out;
    const float* c_w_in; const float* c_w_out; const float* ln_gain; const float* ln_bias; const float* moe_w_router; const float* moe_b_router;
    const float* moe_w_gu; const float* moe_b_gu; const float* moe_w_down; const float* moe_b_down;
    float* out; unsigned char* ws;
    int ph_lo, ph_hi;
};

__device__ __forceinline__ void convert_job(LAS float* tile, const float* src, bf16_t* dst, int K, int N, int batch) {
    const int tid = tid_();
    const int tk = K / 64, tn = N / 64, per = tk * tn; const long total = (long)per * batch;
    for (long u = blockIdx.x; u < total; u += gridDim.x) {
        const int bidx = (int)(u / per), r = (int)(u % per), kt = r / tn, nt = r % tn;
        const float* s = src + (size_t)bidx * K * N + (size_t)(kt * 64) * N + nt * 64;
#pragma unroll
        for (int pass = 0; pass < 2; ++pass) {
            const int row = (tid >> 4) + 32 * pass, c4 = tid & 15;
            const f32x4 v = *(const f32x4*)(s + (size_t)row * N + c4 * 4);
            tile[row * 65 + c4 * 4 + 0] = v[0]; tile[row * 65 + c4 * 4 + 1] = v[1]; tile[row * 65 + c4 * 4 + 2] = v[2]; tile[row * 65 + c4 * 4 + 3] = v[3];
        }
        __syncthreads();
        {
            const int n = tid >> 3, k8 = tid & 7;
            float v[8];
#pragma unroll
            for (int j = 0; j < 8; ++j) v[j] = tile[(k8 * 8 + j) * 65 + n];
            u32x4 w; w.x = pack2(v[0], v[1]); w.y = pack2(v[2], v[3]); w.z = pack2(v[4], v[5]); w.w = pack2(v[6], v[7]);
            *(u32x4*)(dst + (size_t)bidx * N * K + (size_t)(nt * 64 + n) * K + kt * 64 + k8 * 8) = w;
        }
        __syncthreads();
    }
}

struct GemmS {
    const bf16_t* A; int lda;
    const bf16_t* Bt; int ldb;
    int M, N, K;
    const unsigned* Mdyn;
    const int* row_idx;
    const unsigned* tile_exp;
    size_t b_exp_stride;
    const float* bias; int bias_es;
    float* Cf; bf16_t* Cb; int ldc;
};
template <int MODE>
__device__ __forceinline__ void gemm_simple(LAS unsigned char* lds, const GemmS& g) {
    const int tid = tid_(), lane = tid & 63, wid = tid >> 6, wr = wid >> 1, wc = wid & 1, fr = lane & 15, fq = lane >> 4;
    const int M = g.Mdyn ? (int)*g.Mdyn : g.M;
    const int tiles_n = (MODE == 1) ? (g.N / 256) * 2 : g.N / 128;
    const int tiles_m = M / 128, nunits = tiles_m * tiles_n, nk = g.K / 32;
    LAS bf16_t* As = (LAS bf16_t*)lds;
    LAS bf16_t* Bs = As + 2 * 128 * 40;
    const int lrow = tid >> 2, lch = tid & 3;
    for (int u = blockIdx.x; u < nunits; u += gridDim.x) {
        const int tm = u / tiles_n, tn = u % tiles_n, m0 = tm * 128;
        const int e = (MODE != 0) ? (int)g.tile_exp[m0 >> 8] : 0;
        const bf16_t* Bbase = g.Bt + (size_t)e * g.b_exp_stride;
        int arow = m0 + lrow; if (MODE == 1) arow = g.row_idx[arow];
        int brow;
        if (MODE == 1) { const int bwc = lrow >> 6, ni = (lrow & 63) >> 4, r = lrow & 15; brow = ((ni & 1) ? 1024 : 0) + tn * 64 + bwc * 32 + (ni >> 1) * 16 + r; }
        else brow = tn * 128 + lrow;
        const bf16_t* ap = g.A + (size_t)arow * g.lda + lch * 8;
        const bf16_t* bp = Bbase + (size_t)brow * g.ldb + lch * 8;
        f32x4 acc[2][4];
#pragma unroll
        for (int mi = 0; mi < 2; ++mi)
#pragma unroll
            for (int ni = 0; ni < 4; ++ni) acc[mi][ni] = (f32x4){0.f, 0.f, 0.f, 0.f};
        u32x4 ra = *(const u32x4*)ap, rb = *(const u32x4*)bp;
        *(LAS u32x4*)(As + lrow * 40 + lch * 8) = ra; *(LAS u32x4*)(Bs + lrow * 40 + lch * 8) = rb;
        __syncthreads();
        for (int kt = 0; kt < nk; ++kt) {
            const int cur = kt & 1;
            if (kt + 1 < nk) { ra = *(const u32x4*)(ap + (kt + 1) * 32); rb = *(const u32x4*)(bp + (kt + 1) * 32); }
            bf16x8 af[2], bfr[4];
#pragma unroll
            for (int mi = 0; mi < 2; ++mi) af[mi] = *(const LAS bf16x8*)(As + cur * 5120 + (wr * 32 + mi * 16 + fr) * 40 + fq * 8);
#pragma unroll
            for (int ni = 0; ni < 4; ++ni) bfr[ni] = *(const LAS bf16x8*)(Bs + cur * 5120 + (wc * 64 + ni * 16 + fr) * 40 + fq * 8);
#pragma unroll
            for (int mi = 0; mi < 2; ++mi)
#pragma unroll
                for (int ni = 0; ni < 4; ++ni) acc[mi][ni] = __builtin_amdgcn_mfma_f32_16x16x32_bf16(bfr[ni], af[mi], acc[mi][ni], 0, 0, 0);
            if (kt + 1 < nk) { *(LAS u32x4*)(As + (cur ^ 1) * 5120 + lrow * 40 + lch * 8) = ra; *(LAS u32x4*)(Bs + (cur ^ 1) * 5120 + lrow * 40 + lch * 8) = rb; }
            __syncthreads();
        }
#pragma unroll
        for (int mi = 0; mi < 2; ++mi) {
            const int m = m0 + wr * 32 + mi * 16 + fr;
            if (MODE == 1) {
#pragma unroll
                for (int q = 0; q < 2; ++q) {
                    const int hc = tn * 64 + wc * 32 + q * 16 + 4 * fq;
                    const f32x4 bg = *(const f32x4*)(g.bias + (size_t)e * g.bias_es + hc), bu = *(const f32x4*)(g.bias + (size_t)e * g.bias_es + 1024 + hc);
                    const f32x4 gt = acc[mi][2 * q] + bg, up = acc[mi][2 * q + 1] + bu;
                    u32x2 w; w.x = pack2(swiglu(gt[0], up[0]), swiglu(gt[1], up[1])); w.y = pack2(swiglu(gt[2], up[2]), swiglu(gt[3], up[3]));
                    *(u32x2*)(g.Cb + (size_t)m * g.ldc + hc) = w;
                }
            } else {
#pragma unroll
                for (int ni = 0; ni < 4; ++ni) {
                    const int n = tn * 128 + wc * 64 + ni * 16 + 4 * fq;
                    f32x4 v = acc[mi][ni];
                    if (g.bias) v += *(const f32x4*)(g.bias + (size_t)e * g.bias_es + n);
                    if (g.Cf) *(f32x4*)(g.Cf + (size_t)m * g.ldc + n) = v;
                    else { u32x2 w; w.x = pack2(v[0], v[1]); w.y = pack2(v[2], v[3]); *(u32x2*)(g.Cb + (size_t)m * g.ldc + n) = w; }
                }
            }
        }
    }
}


namespace g8 {
constexpr int BM = 256, BK = 64, HALF = 128, HTB = HALF * BK * 2, STAGE_BYTES = 8 * HTB, NXCD = 8, WGM = 8;
__device__ __forceinline__ int lds_byte(int r, int c) { const int st = (r >> 4) * 2 + (c >> 5), rr = r & 15, cc = c & 31, ob = rr * 64 + cc * 2; return st * 1024 + (ob ^ (((ob >> 9) & 1) << 5)); }
__device__ __forceinline__ void stage_rc(int b, int& R, int& C) { const int st = b / 1024, sb = b % 1024, swz = sb ^ (((sb >> 9) & 1) << 5); R = (st >> 1) * 16 + swz / 64; C = (st & 1) * 32 + (swz % 64) / 2; }
__device__ __forceinline__ int perm32(int rho) { const int n = rho >> 4, i = rho & 15; return 8 * (i >> 2) + 4 * n + (i & 3); }
__device__ __forceinline__ unsigned cvt_pk_bf16(float lo, float hi) { unsigned r; asm volatile("v_cvt_pk_bf16_f32 %0, %1, %2" : "=v"(r) : "v"(lo), "v"(hi)); return r; }

struct Unit { const char* a0; const char* a1; const char* b0; const char* b1; const int* rows; int row0, col0, e; };

struct SchedPlain {
    const char* A; const char* Bt; size_t hstepA, hstepB; int nM, nN, nwg, G, c;
    __device__ __forceinline__ void init(const void* A_, const void* Bt_, int M, int N, int K, int G_, int c_) { A = (const char*)A_; Bt = (const char*)Bt_; hstepA = (size_t)HALF * K * 2; hstepB = hstepA; nM = M / BM; nN = N / BM; nwg = nM * nN; G = G_; c = c_; }
    __device__ __forceinline__ bool next(int i, Unit& u) const {
        const long L = (long)i * G + c; if (L >= nwg) return false;
        int wgid = (int)L; { const int q = nwg / NXCD, r = nwg % NXCD, xcd = wgid % NXCD, off = wgid / NXCD; wgid = (xcd < r ? xcd * (q + 1) : r * (q + 1) + (xcd - r) * q) + off; }
        const int nig = WGM * nN, gid = wgid / nig, fm = gid * WGM, gsz = (nM - fm) < WGM ? (nM - fm) : WGM;
        const int pm = fm + ((wgid % nig) % gsz), pn = (wgid % nig) / gsz;
        u.a0 = A + (size_t)pm * 2 * hstepA; u.a1 = u.a0 + hstepA; u.b0 = Bt + (size_t)pn * 2 * hstepB; u.b1 = u.b0 + hstepB; u.rows = nullptr; u.row0 = pm * BM; u.col0 = pn * BM; u.e = 0;
        return true;
    }
};
struct SchedGU {
    const char* A; const char* W; const int* rowtok; const unsigned* texp; int ntiles, G, c;
    __device__ __forceinline__ bool next(int i, Unit& u) const {
        const int L = i * G + c, rt = L >> 3, pn = L & 7; if (rt >= ntiles) return false;
        const int e = (int)texp[rt];
        u.a0 = A; u.a1 = A; u.rows = rowtok + rt * BM; u.b0 = W + ((size_t)e * 2048 + pn * 128) * (D * 2); u.b1 = u.b0 + (size_t)1024 * D * 2; u.row0 = rt * BM; u.col0 = pn * 128; u.e = e;
        return true;
    }
};
struct SchedDown {
    const char* A; const char* W; const unsigned* texp; int ntiles, G, c;
    __device__ __forceinline__ bool next(int i, Unit& u) const {
        const int L = i * G + c, rt = L >> 2, pn = L & 3; if (rt >= ntiles) return false;
        const int e = (int)texp[rt];
        u.a0 = A + (size_t)rt * BM * D * 2; u.a1 = u.a0 + (size_t)HALF * D * 2; u.rows = nullptr; u.b0 = W + ((size_t)e * 1024 + pn * BM) * (D * 2); u.b1 = u.b0 + (size_t)HALF * D * 2; u.row0 = rt * BM; u.col0 = pn * BM; u.e = e;
        return true;
    }
};

struct EpiF32 {
    static constexpr bool PERM = false;
    float* C; int ldc; const float* bias; int bias_es;
    __device__ __forceinline__ void operator()(const f32x4 (&acc)[2][2][4][2], const Unit& u, int wr, int wc, int fr, int fq) const {
        const int row0 = u.row0 + wr * 64 + fr, col0 = u.col0 + wc * 32 + 4 * fq;
        f32x4 bv[2][2];
#pragma unroll
        for (int bj = 0; bj < 2; ++bj)
#pragma unroll
            for (int n = 0; n < 2; ++n) bv[bj][n] = bias ? *(const f32x4*)(bias + (size_t)u.e * bias_es + col0 + bj * HALF + n * 16) : (f32x4){0.f, 0.f, 0.f, 0.f};
#pragma unroll
        for (int ai = 0; ai < 2; ++ai)
#pragma unroll
            for (int m = 0; m < 4; ++m) { float* rowp = C + (size_t)(row0 + ai * HALF + m * 16) * ldc + col0;
#pragma unroll
                for (int bj = 0; bj < 2; ++bj)
#pragma unroll
                    for (int n = 0; n < 2; ++n) *(f32x4*)(rowp + bj * HALF + n * 16) = acc[ai][bj][m][n] + bv[bj][n]; }
    }
};
struct EpiBf16 {
    static constexpr bool PERM = true;
    bf16_t* O; int ldc; const float* bias; int bias_es;
    __device__ __forceinline__ void operator()(const f32x4 (&acc)[2][2][4][2], const Unit& u, int wr, int wc, int fr, int fq) const {
        const int row0 = u.row0 + wr * 64 + fr, col0 = u.col0 + wc * 32 + 8 * fq;
        f32x4 bv[2][2];
#pragma unroll
        for (int bj = 0; bj < 2; ++bj)
#pragma unroll
            for (int n = 0; n < 2; ++n) bv[bj][n] = bias ? *(const f32x4*)(bias + (size_t)u.e * bias_es + col0 + bj * HALF + 4 * n) : (f32x4){0.f, 0.f, 0.f, 0.f};
#pragma unroll
        for (int ai = 0; ai < 2; ++ai)
#pragma unroll
            for (int m = 0; m < 4; ++m) { bf16_t* rowp = O + (size_t)(row0 + ai * HALF + m * 16) * ldc + col0;
#pragma unroll
                for (int bj = 0; bj < 2; ++bj) { const f32x4 v0 = acc[ai][bj][m][0] + bv[bj][0], v1 = acc[ai][bj][m][1] + bv[bj][1];
                    u32x4 w; w.x = cvt_pk_bf16(v0[0], v0[1]); w.y = cvt_pk_bf16(v0[2], v0[3]); w.z = cvt_pk_bf16(v1[0], v1[1]); w.w = cvt_pk_bf16(v1[2], v1[3]);
                    *(u32x4*)(rowp + bj * HALF) = w; } }
    }
};
struct EpiSwiglu {
    static constexpr bool PERM = true;
    bf16_t* O; const float* bias;
    __device__ __forceinline__ void operator()(const f32x4 (&acc)[2][2][4][2], const Unit& u, int wr, int wc, int fr, int fq) const {
        const int row0 = u.row0 + wr * 64 + fr, hc = u.col0 + wc * 32 + 8 * fq;
        const float* bp = bias + (size_t)u.e * 2048 + hc;
        const f32x4 bg0 = *(const f32x4*)(bp), bg1 = *(const f32x4*)(bp + 4), bu0 = *(const f32x4*)(bp + 1024), bu1 = *(const f32x4*)(bp + 1028);
#pragma unroll
        for (int ai = 0; ai < 2; ++ai)
#pragma unroll
            for (int m = 0; m < 4; ++m) {
                const f32x4 g0 = acc[ai][0][m][0] + bg0, g1 = acc[ai][0][m][1] + bg1, u0 = acc[ai][1][m][0] + bu0, u1 = acc[ai][1][m][1] + bu1;
                u32x4 w; w.x = cvt_pk_bf16(swiglu(g0[0], u0[0]), swiglu(g0[1], u0[1])); w.y = cvt_pk_bf16(swiglu(g0[2], u0[2]), swiglu(g0[3], u0[3]));
                w.z = cvt_pk_bf16(swiglu(g1[0], u1[0]), swiglu(g1[1], u1[1])); w.w = cvt_pk_bf16(swiglu(g1[2], u1[2]), swiglu(g1[3], u1[3]));
                *(u32x4*)(O + (size_t)(row0 + ai * HALF + m * 16) * D + hc) = w;
            }
    }
};

template <class Epi, class Sched, bool GATHER>
__device__ __forceinline__ void gemm_phase(LAS unsigned char* lds, const int K, const Sched& S, const Epi& E) {
    const int tid = tid_(), wid = __builtin_amdgcn_readfirstlane(tid >> 6), lane = tid & 63, wr = wid >> 2, wc = wid & 3, fr = lane & 15, fq = lane >> 4;
    const int nt = K / BK;
    int sR[2], sC[2];
    unsigned voffB[2];
#pragma unroll
    for (int i = 0; i < 2; ++i) { stage_rc(tid * 16 + i * 8192, sR[i], sC[i]); const int Rb = Epi::PERM ? ((sR[i] & ~31) + perm32(sR[i] & 31)) : sR[i]; voffB[i] = (unsigned)(Rb * K + sC[i]) * 2u; }
    unsigned cvA0[2], cvA1[2], nvA0[2], nvA1[2];
#define G8_VOFF(u, v0, v1) do { _Pragma("unroll") for (int _i = 0; _i < 2; ++_i) { \
        if (GATHER) { v0[_i] = (unsigned)((u).rows[sR[_i]] * K + sC[_i]) * 2u; v1[_i] = (unsigned)((u).rows[HALF + sR[_i]] * K + sC[_i]) * 2u; } \
        else { v0[_i] = (unsigned)(sR[_i] * K + sC[_i]) * 2u; v1[_i] = v0[_i]; } } } while (0)
    const size_t kstep = (size_t)(BK * 2);
    const unsigned ldsw = (unsigned)wid * 1024u;
    const int aoff = lds_byte(wr * 64 + fr, fq * 8), boff = lds_byte(wc * 32 + fr, fq * 8);
#define PG8_SA(b, h) (((b) * 2 + (h)) * HTB)
#define PG8_SB(b, h) ((4 + (b) * 2 + (h)) * HTB)
#define PG8_STAGE(bufoff, gbase, voff) do { _Pragma("unroll") for (int _i = 0; _i < 2; ++_i) \
        __builtin_amdgcn_global_load_lds((const unsigned*)((const char*)(gbase) + (voff)[_i]), (LAS unsigned*)(lds + (bufoff) + ldsw + _i * 8192), 16, 0, 0); } while (0)
#define PG8_LDA(dst, b, h) do { _Pragma("unroll") for (int m = 0; m < 4; ++m) _Pragma("unroll") for (int k = 0; k < 2; ++k) dst[m][k] = *(const LAS bf16x8*)(lds + PG8_SA(b, h) + aoff + m * 2048 + k * 1024); } while (0)
#define PG8_LDB(dst, b, h) do { _Pragma("unroll") for (int n = 0; n < 2; ++n) _Pragma("unroll") for (int k = 0; k < 2; ++k) dst[n][k] = *(const LAS bf16x8*)(lds + PG8_SB(b, h) + boff + n * 2048 + k * 1024); } while (0)
#define PG8_MMA(ai, bj, At, Bt) do { __builtin_amdgcn_s_setprio(1); _Pragma("unroll") for (int m = 0; m < 4; ++m) _Pragma("unroll") for (int n = 0; n < 2; ++n) _Pragma("unroll") for (int k = 0; k < 2; ++k) \
        acc[ai][bj][m][n] = __builtin_amdgcn_mfma_f32_16x16x32_bf16(Bt[n][k], At[m][k], acc[ai][bj][m][n], 0, 0, 0); __builtin_amdgcn_s_setprio(0); } while (0)
#define PG8_WAIT_V(n) asm volatile("s_waitcnt vmcnt(" #n ")" ::: "memory")
#define PG8_WAIT_L(n) asm volatile("s_waitcnt lgkmcnt(" #n ")" ::: "memory")
#define PG8_BAR __builtin_amdgcn_s_barrier()
#define PG8_SCHED __builtin_amdgcn_sched_barrier(0)
    Unit cur, nxt; int ui = 0;
    if (!S.next(0, cur)) return;
    f32x4 acc[2][2][4][2];
#pragma unroll
    for (int a = 0; a < 2; ++a)
#pragma unroll
        for (int b = 0; b < 2; ++b)
#pragma unroll
            for (int m = 0; m < 4; ++m)
#pragma unroll
                for (int n = 0; n < 2; ++n) acc[a][b][m][n] = (f32x4){0.f, 0.f, 0.f, 0.f};
    bf16x8 At[4][2], B0[2][2], B1[2][2];
    const char* cA0 = cur.a0; const char* cA1 = cur.a1; const char* cB0 = cur.b0; const char* cB1 = cur.b1;
    G8_VOFF(cur, cvA0, cvA1);
    PG8_STAGE(PG8_SB(0, 0), cB0, voffB); PG8_STAGE(PG8_SB(0, 1), cB1, voffB); PG8_STAGE(PG8_SA(0, 0), cA0, cvA0); PG8_STAGE(PG8_SA(0, 1), cA1, cvA1);
    if (wr == 1) PG8_BAR;
    PG8_WAIT_V(2); PG8_BAR;
    PG8_STAGE(PG8_SB(1, 0), cB0 + kstep, voffB); PG8_STAGE(PG8_SA(1, 0), cA0 + kstep, cvA0); PG8_STAGE(PG8_SB(1, 1), cB1 + kstep, voffB);
    PG8_WAIT_V(6); PG8_BAR;
    for (;;) {
        const bool has_next = S.next(ui + 1, nxt);
        const char* nA0 = has_next ? nxt.a0 : cA0; const char* nA1 = has_next ? nxt.a1 : cA1; const char* nB0 = has_next ? nxt.b0 : cB0; const char* nB1 = has_next ? nxt.b1 : cB1;
        if (GATHER) { if (has_next) { G8_VOFF(nxt, nvA0, nvA1); } else { nvA0[0] = cvA0[0]; nvA0[1] = cvA0[1]; nvA1[0] = cvA1[0]; nvA1[1] = cvA1[1]; } }
        for (int t = 0; t < nt; t += 2) {
            const bool last = (t == nt - 2);
            const char* a1_1 = cA1 + (size_t)(t + 1) * kstep;
            const char* a2_0 = last ? nA0 : cA0 + (size_t)(t + 2) * kstep; const char* a2_1 = last ? nA1 : cA1 + (size_t)(t + 2) * kstep;
            const char* b2_0 = last ? nB0 : cB0 + (size_t)(t + 2) * kstep; const char* b2_1 = last ? nB1 : cB1 + (size_t)(t + 2) * kstep;
            const char* a3_0 = a2_0 + kstep; const char* b3_0 = b2_0 + kstep; const char* b3_1 = b2_1 + kstep;
            unsigned vA0[2], vA1[2];
            if (GATHER) { vA0[0] = last ? nvA0[0] : cvA0[0]; vA0[1] = last ? nvA0[1] : cvA0[1]; vA1[0] = last ? nvA1[0] : cvA1[0]; vA1[1] = last ? nvA1[1] : cvA1[1]; }
            else { vA0[0] = cvA0[0]; vA0[1] = cvA0[1]; vA1[0] = cvA0[0]; vA1[1] = cvA0[1]; }
            PG8_LDB(B0, 0, 0); PG8_LDB(B1, 0, 1); PG8_SCHED; PG8_LDA(At, 0, 0); PG8_STAGE(PG8_SA(1, 1), a1_1, cvA1);
            PG8_WAIT_V(8); PG8_WAIT_L(0); PG8_BAR; PG8_MMA(0, 0, At, B0); PG8_MMA(0, 1, At, B1); PG8_BAR; PG8_SCHED;
            PG8_LDA(At, 0, 1); PG8_STAGE(PG8_SB(0, 0), b2_0, voffB); PG8_STAGE(PG8_SB(0, 1), b2_1, voffB); PG8_STAGE(PG8_SA(0, 0), a2_0, vA0);
            PG8_WAIT_V(8); PG8_WAIT_L(0); PG8_BAR; PG8_MMA(1, 0, At, B0); PG8_MMA(1, 1, At, B1); PG8_BAR; PG8_SCHED;
            PG8_LDB(B0, 1, 0); PG8_LDB(B1, 1, 1); PG8_SCHED; PG8_LDA(At, 1, 0); PG8_STAGE(PG8_SA(0, 1), a2_1, vA1);
            PG8_WAIT_V(8); PG8_WAIT_L(0); PG8_BAR; PG8_MMA(0, 0, At, B0); PG8_MMA(0, 1, At, B1); PG8_BAR; PG8_SCHED;
            PG8_LDA(At, 1, 1); PG8_STAGE(PG8_SB(1, 0), b3_0, voffB); PG8_STAGE(PG8_SB(1, 1), b3_1, voffB); PG8_STAGE(PG8_SA(1, 0), a3_0, vA0);
            PG8_WAIT_V(8); PG8_WAIT_L(0); PG8_BAR; PG8_MMA(1, 0, At, B0); PG8_MMA(1, 1, At, B1); PG8_BAR; PG8_SCHED;
        }
        if (wr == 0) PG8_BAR;
        E(acc, cur, wr, wc, fr, fq);
        if (!has_next) break;
#pragma unroll
        for (int a = 0; a < 2; ++a)
#pragma unroll
            for (int b = 0; b < 2; ++b)
#pragma unroll
                for (int m = 0; m < 4; ++m)
#pragma unroll
                    for (int n = 0; n < 2; ++n) acc[a][b][m][n] = (f32x4){0.f, 0.f, 0.f, 0.f};
        cur = nxt; cA0 = nA0; cA1 = nA1; cB0 = nB0; cB1 = nB1; ++ui;
        if (GATHER) { cvA0[0] = nvA0[0]; cvA0[1] = nvA0[1]; cvA1[0] = nvA1[0]; cvA1[1] = nvA1[1]; }
        if (wr == 1) PG8_BAR;
    }
    PG8_WAIT_V(0);
    PG8_BAR;
#undef G8_VOFF
#undef PG8_SA
#undef PG8_SB
#undef PG8_STAGE
#undef PG8_LDA
#undef PG8_LDB
#undef PG8_MMA
#undef PG8_WAIT_V
#undef PG8_WAIT_L
#undef PG8_BAR
#undef PG8_SCHED
}
}


__device__ __forceinline__ void convert_big(const float* src, bf16_t* dst, int K, int N, int batch) {
    const int tid = tid_(), lane = tid & 63, wid = tid >> 6;
    const int nbn = N / 256, per = (K / 128) * nbn; const long total = (long)per * batch;
    f32x4 cur[16], nxt[16];
#define CV_LOAD(uu, reg) do { const int bidx = (int)((uu) / per), r_ = (int)((uu) % per), kb = r_ / nbn, nb = r_ % nbn; \
        const float* sp = src + (size_t)bidx * K * N + (size_t)(kb * 128 + 16 * wid) * N + nb * 256 + 4 * lane; \
        _Pragma("unroll") for (int i = 0; i < 16; ++i) reg[i] = *(const f32x4*)(sp + (size_t)i * N); } while (0)
    long u = blockIdx.x;
    if (u < total) CV_LOAD(u, cur);
    for (; u < total; u += gridDim.x) {
        const long un = u + gridDim.x;
        if (un < total) CV_LOAD(un, nxt);
        const int bidx = (int)(u / per), r_ = (int)(u % per), kb = r_ / nbn, nb = r_ % nbn;
        bf16_t* dp = dst + (size_t)bidx * N * K + (size_t)(nb * 256 + 4 * lane) * K + kb * 128 + 16 * wid;
#pragma unroll
        for (int j = 0; j < 4; ++j) {
            u32x4 w0, w1;
            w0.x = g8::cvt_pk_bf16(cur[0][j], cur[1][j]); w0.y = g8::cvt_pk_bf16(cur[2][j], cur[3][j]); w0.z = g8::cvt_pk_bf16(cur[4][j], cur[5][j]); w0.w = g8::cvt_pk_bf16(cur[6][j], cur[7][j]);
            w1.x = g8::cvt_pk_bf16(cur[8][j], cur[9][j]); w1.y = g8::cvt_pk_bf16(cur[10][j], cur[11][j]); w1.z = g8::cvt_pk_bf16(cur[12][j], cur[13][j]); w1.w = g8::cvt_pk_bf16(cur[14][j], cur[15][j]);
            *(u32x4*)(dp + (size_t)j * K) = w0; *(u32x4*)(dp + (size_t)j * K + 8) = w1;
        }
        if (un < total) {
#pragma unroll
            for (int i = 0; i < 16; ++i) cur[i] = nxt[i];
        }
    }
#undef CV_LOAD
}

__device__ __forceinline__ float gelu_fast(float x) { const float u2 = 1.5957691216057308f * (x + 0.044715f * x * x * x); return x / (1.0f + __expf(-u2)); }
__device__ __forceinline__ void lru_gates_phase(LAS unsigned char* lds, const Params& p, int idx) {
    const int tid = tid_(), lane = tid & 63, wid = tid >> 6, fr = lane & 15, fq = lane >> 4;
    LAS bf16_t* xcb = (LAS bf16_t*)lds;
    LAS float* xcf = (LAS float*)(lds + 17408);
    LAS float* sa = (LAS float*)(lds + 17408 + 33792);
    LAS float* sb = sa + 64 * 132;
    LAS float* comb = sb + 64 * 132;
    const bf16_t* u = (const bf16_t*)(p.ws + WS_U);
    float* Aarr = (float*)(p.ws + WS_SCR); float* Barr = Aarr + (size_t)T * D;
    float* SP = (float*)(p.ws + WS_LSUM); float* SH = SP + NBATCH * 32 * D;
    const int hd = blockIdx.x & 7, slot = blockIdx.x >> 3, nslots = gridDim.x >> 3;
    const float* conv_w = p.a_conv_w + (size_t)idx * 4 * D; const float* conv_b = p.a_conv_b + (size_t)idx * D;
    const bf16_t* wrt = (const bf16_t*)(p.ws + WS_AGT) + ((size_t)(idx * 2 + 0) * 8 + hd) * 128 * 128;
    const bf16_t* wit = (const bf16_t*)(p.ws + WS_AGT) + ((size_t)(idx * 2 + 1) * 8 + hd) * 128 * 128;
    bf16x8 Br[4], Bi[4];
#pragma unroll
    for (int ks = 0; ks < 4; ++ks) { Br[ks] = *(const bf16x8*)(wrt + (size_t)(16 * wid + fr) * 128 + 32 * ks + 8 * fq); Bi[ks] = *(const bf16x8*)(wit + (size_t)(16 * wid + fr) * 128 + 32 * ks + 8 * fq); }
    const int cg = hd * 128 + 16 * wid + 4 * fq;
    const f32x4 brv = *(const f32x4*)(p.a_b_rgate + (size_t)idx * D + cg), biv = *(const f32x4*)(p.a_b_igate + (size_t)idx * D + cg), lmv = *(const f32x4*)(p.a_lambda + (size_t)idx * D + cg);
    f32x4 spv;
#pragma unroll
    for (int r = 0; r < 4; ++r) spv[r] = (lmv[r] > 15.f) ? __expf(-lmv[r]) : log1pf(__expf(-lmv[r]));
    const int cc = (tid & 31) * 4, cch = hd * 128 + cc;
    f32x4 cw[4];
#pragma unroll
    for (int j = 0; j < 4; ++j) cw[j] = *(const f32x4*)(conv_w + j * D + cch);
    const f32x4 cb = *(const f32x4*)(conv_b + cch);
    for (int tile = slot; tile < T / 64; tile += nslots) {
        const int t0 = tile * 64;
#pragma unroll
        for (int k = 0; k < 4; ++k) {
            const int tl = (tid >> 5) + 16 * k, t = t0 + tl, s_ = t & (SEQ - 1);
            f32x4 acc = cb;
#pragma unroll
            for (int j = 0; j < 4; ++j) {
                if (s_ - 3 + j >= 0) {
                    const u32x2 rv = *(const u32x2*)(u + (size_t)(t - 3 + j) * 2048 + 1024 + cch);
                    acc[0] += cw[j][0] * __uint_as_float(rv.x << 16); acc[1] += cw[j][1] * __uint_as_float(rv.x & 0xffff0000u);
                    acc[2] += cw[j][2] * __uint_as_float(rv.y << 16); acc[3] += cw[j][3] * __uint_as_float(rv.y & 0xffff0000u);
                }
            }
            *(LAS f32x4*)(xcf + tl * 132 + cc) = acc;
            u32x2 w; w.x = pack2(acc[0], acc[1]); w.y = pack2(acc[2], acc[3]);
            *(LAS u32x2*)(xcb + tl * 136 + cc) = w;
        }
        __syncthreads();
        f32x4 ar[4], ai[4];
#pragma unroll
        for (int mt = 0; mt < 4; ++mt) { ar[mt] = (f32x4){0.f, 0.f, 0.f, 0.f}; ai[mt] = (f32x4){0.f, 0.f, 0.f, 0.f}; }
#pragma unroll
        for (int ks = 0; ks < 4; ++ks)
#pragma unroll
            for (int mt = 0; mt < 4; ++mt) {
                const bf16x8 af = *(const LAS bf16x8*)(xcb + (mt * 16 + fr) * 136 + 32 * ks + 8 * fq);
                ar[mt] = __builtin_amdgcn_mfma_f32_16x16x32_bf16(Br[ks], af, ar[mt], 0, 0, 0);
                ai[mt] = __builtin_amdgcn_mfma_f32_16x16x32_bf16(Bi[ks], af, ai[mt], 0, 0, 0);
            }
#pragma unroll
        for (int mt = 0; mt < 4; ++mt) {
            const int tl = mt * 16 + fr, cl = 16 * wid + 4 * fq;
            const f32x4 rec = *(const LAS f32x4*)(xcf + tl * 132 + cl);
            f32x4 av, bv;
#pragma unroll
            for (int r = 0; r < 4; ++r) {
                const float rg = sigmoidf_(ar[mt][r] + brv[r]), ig = sigmoidf_(ai[mt][r] + biv[r]);
                const float log_a = -8.0f * rg * spv[r];
                av[r] = __expf(log_a);
                bv[r] = sqrtf(fmaxf(-expm1f(2.0f * log_a), 0.f)) * ig * rec[r];
            }
            *(f32x4*)(Aarr + (size_t)(t0 + tl) * D + cg) = av; *(f32x4*)(Barr + (size_t)(t0 + tl) * D + cg) = bv;
            *(LAS f32x4*)(sa + tl * 132 + cl) = av; *(LAS f32x4*)(sb + tl * 132 + cl) = bv;
        }
        __syncthreads();
        {
            const int j = tid & 127, q = tid >> 7;
            float P = 1.f, H = 0.f;
#pragma unroll
            for (int s_ = 0; s_ < 16; ++s_) { const float a = sa[(q * 16 + s_) * 132 + j], bb = sb[(q * 16 + s_) * 132 + j]; H = a * H + bb; P *= a; }
            comb[(q * 128 + j) * 2 + 0] = P; comb[(q * 128 + j) * 2 + 1] = H;
        }
        __syncthreads();
        if (tid < 128) {
            float P = comb[tid * 2], H = comb[tid * 2 + 1];
#pragma unroll
            for (int q = 1; q < 4; ++q) { const float Pq = comb[(q * 128 + tid) * 2], Hq = comb[(q * 128 + tid) * 2 + 1]; H = Pq * H + Hq; P *= Pq; }
            SP[(size_t)tile * D + hd * 128 + tid] = P; SH[(size_t)tile * D + hd * 128 + tid] = H;
        }
    }
}
__device__ __forceinline__ void lru_scan_phase(const Params& p) {
    const int tid = tid_();
    const bf16_t* u = (const bf16_t*)(p.ws + WS_U);
    const float* Aarr = (const float*)(p.ws + WS_SCR); const float* Barr = Aarr + (size_t)T * D;
    const float* SP = (const float*)(p.ws + WS_LSUM); const float* SH = SP + NBATCH * 32 * D;
    bf16_t* yin = (bf16_t*)(p.ws + WS_YIN);
    const int nunits = NBATCH * 32 * 2;
    for (int un = blockIdx.x; un < nunits; un += gridDim.x) {
        const int tile = un >> 1, c = (un & 1) * 512 + tid, b = tile >> 5, chunk = tile & 31;
        float h = 0.f;
        for (int k = 0; k < chunk; ++k) h = SP[(size_t)(b * 32 + k) * D + c] * h + SH[(size_t)(b * 32 + k) * D + c];
        const size_t tb = (size_t)tile * 64;
#pragma unroll 16
        for (int s_ = 0; s_ < 64; ++s_) {
            const size_t t = tb + s_;
            h = Aarr[t * D + c] * h + Barr[t * D + c];
            yin[t * D + c] = f2bf(gelu_fast(bf2f(u[t * 2048 + c])) * h);
        }
    }
}

typedef short s16x4 __attribute__((ext_vector_type(4)));
__device__ __forceinline__ s16x4 tr4(LAS const unsigned char* base, int row0, int col0, int stride, int lane) {
    const int q = (lane & 15) >> 2, pp = lane & 3;
    return __builtin_amdgcn_ds_read_tr16_b64_v4i16((LAS s16x4*)(base + (row0 + q) * stride + (col0 + 4 * pp) * 2));
}
__device__ __forceinline__ bf16x8 cat8(s16x4 a, s16x4 b) { return (bf16x8){a[0], a[1], a[2], a[3], b[0], b[1], b[2], b[3]}; }
__device__ __forceinline__ void ret_core_phase(LAS unsigned char* lds, const Params& p) {
    const int tid = tid_(), lane = tid & 63, wid = tid >> 6, fr = lane & 15, fq = lane >> 4;
    constexpr int KS = 544, VS = 160, SS = 528;
    LAS unsigned char* Kl = lds;
    LAS unsigned char* Vl = lds + 128 * KS;
    LAS unsigned char* Sl = Vl + 128 * VS;
    const bf16_t* u = (const bf16_t*)(p.ws + WS_U);
    float* RO = (float*)(p.ws + WS_SCR);
    for (int un = blockIdx.x; un < NBATCH * 4 * 8; un += gridDim.x) {
        const int b = un >> 5, h = (un >> 3) & 3, vs = un & 7;
        const float lg2 = log2f(1.0f - exp2f(-5.0f - (float)h));
        f32x4 Sacc[2][4];
#pragma unroll
        for (int dt = 0; dt < 2; ++dt)
#pragma unroll
            for (int vt = 0; vt < 4; ++vt) Sacc[dt][vt] = (f32x4){0.f, 0.f, 0.f, 0.f};
        for (int i = tid; i < 64 * SS / 16; i += NTHREADS) ((LAS u32x4*)Sl)[i] = (u32x4){0u, 0u, 0u, 0u};
        for (int chunk = 0; chunk < 16; ++chunk) {
            const size_t t0 = (size_t)b * SEQ + chunk * 128;
#pragma unroll
            for (int i = 0; i < 8; ++i) {
                const int piece = tid + NTHREADS * i, m = piece >> 5, ch = piece & 31;
                const u32x4 kv = *(const u32x4*)(u + (t0 + m) * 6144 + 1024 + h * 256 + ch * 8);
                const float sc = exp2f(-(float)(m + 1) * lg2) * 0.0625f;
                u32x4 w;
                w.x = pack2(__uint_as_float(kv.x << 16) * sc, __uint_as_float(kv.x & 0xffff0000u) * sc); w.y = pack2(__uint_as_float(kv.y << 16) * sc, __uint_as_float(kv.y & 0xffff0000u) * sc);
                w.z = pack2(__uint_as_float(kv.z << 16) * sc, __uint_as_float(kv.z & 0xffff0000u) * sc); w.w = pack2(__uint_as_float(kv.w << 16) * sc, __uint_as_float(kv.w & 0xffff0000u) * sc);
                *(LAS u32x4*)(Kl + m * KS + ch * 16) = w;
            }
#pragma unroll
            for (int i = 0; i < 2; ++i) {
                const int piece = tid + NTHREADS * i, m = piece >> 3, ch = piece & 7;
                *(LAS u32x4*)(Vl + m * VS + ch * 16) = *(const u32x4*)(u + (t0 + m) * 6144 + 2048 + h * 512 + vs * 64 + ch * 8);
            }
            bf16x8 Qf[8];
#pragma unroll
            for (int ks = 0; ks < 8; ++ks) Qf[ks] = *(const bf16x8*)(u + (t0 + 16 * wid + fr) * 6144 + h * 256 + 32 * ks + 8 * fq);
            __syncthreads();
            f32x4 sc[8];
#pragma unroll
            for (int mt = 0; mt < 8; ++mt) {
                sc[mt] = (f32x4){0.f, 0.f, 0.f, 0.f};
#pragma unroll
                for (int ks = 0; ks < 8; ++ks) {
                    const bf16x8 kf = *(const LAS bf16x8*)(Kl + (16 * mt + fr) * KS + (32 * ks + 8 * fq) * 2);
                    sc[mt] = __builtin_amdgcn_mfma_f32_16x16x32_bf16(kf, Qf[ks], sc[mt], 0, 0, 0);
                }
            }
            bf16x8 pf[4];
            const int nloc = 16 * wid + fr;
#pragma unroll
            for (int ks2 = 0; ks2 < 4; ++ks2) {
                float v[8];
#pragma unroll
                for (int t = 0; t < 2; ++t)
#pragma unroll
                    for (int r = 0; r < 4; ++r) { const int m = 32 * ks2 + 16 * t + 4 * fq + r; v[4 * t + r] = (m <= nloc) ? sc[2 * ks2 + t][r] : 0.f; }
                u32x4 w; w.x = pack2(v[0], v[1]); w.y = pack2(v[2], v[3]); w.z = pack2(v[4], v[5]); w.w = pack2(v[6], v[7]);
                pf[ks2] = __builtin_bit_cast(bf16x8, w);
            }
            f32x4 O[4];
#pragma unroll
            for (int vt = 0; vt < 4; ++vt) {
                O[vt] = (f32x4){0.f, 0.f, 0.f, 0.f};
#pragma unroll
                for (int ks2 = 0; ks2 < 4; ++ks2) {
                    const bf16x8 vf = cat8(tr4(Vl, 32 * ks2 + 4 * fq, 16 * vt, VS, lane), tr4(Vl, 32 * ks2 + 16 + 4 * fq, 16 * vt, VS, lane));
                    O[vt] = __builtin_amdgcn_mfma_f32_16x16x32_bf16(pf[ks2], vf, O[vt], 0, 0, 0);
                }
#pragma unroll
                for (int ks = 0; ks < 8; ++ks) {
                    const bf16x8 sf = *(const LAS bf16x8*)(Sl + (16 * vt + fr) * SS + (32 * ks + 8 * fq) * 2);
                    O[vt] = __builtin_amdgcn_mfma_f32_16x16x32_bf16(Qf[ks], sf, O[vt], 0, 0, 0);
                }
            }
#pragma unroll
            for (int r = 0; r < 4; ++r) {
                const int n = 16 * wid + 4 * fq + r;
                const float qd = exp2f((float)(n + 1) * lg2);
                float* op = RO + (t0 + n) * 2048 + h * 512 + vs * 64 + fr;
#pragma unroll
                for (int vt = 0; vt < 4; ++vt) op[16 * vt] = O[vt][r] * qd;
            }
#pragma unroll
            for (int ks3 = 0; ks3 < 4; ++ks3) {
                bf16x8 kt[2], vf[4];
#pragma unroll
                for (int dt = 0; dt < 2; ++dt) kt[dt] = cat8(tr4(Kl, 32 * ks3 + 8 * fq, 32 * wid + 16 * dt, KS, lane), tr4(Kl, 32 * ks3 + 8 * fq + 4, 32 * wid + 16 * dt, KS, lane));
#pragma unroll
                for (int vt = 0; vt < 4; ++vt) vf[vt] = cat8(tr4(Vl, 32 * ks3 + 8 * fq, 16 * vt, VS, lane), tr4(Vl, 32 * ks3 + 8 * fq + 4, 16 * vt, VS, lane));
#pragma unroll
                for (int dt = 0; dt < 2; ++dt)
#pragma unroll
                    for (int vt = 0; vt < 4; ++vt) Sacc[dt][vt] = __builtin_amdgcn_mfma_f32_16x16x32_bf16(kt[dt], vf[vt], Sacc[dt][vt], 0, 0, 0);
            }
            __syncthreads();
            const float cd = exp2f(128.0f * lg2);
#pragma unroll
            for (int dt = 0; dt < 2; ++dt)
#pragma unroll
                for (int vt = 0; vt < 4; ++vt) {
                    Sacc[dt][vt] *= cd;
                    u32x2 w; w.x = pack2(Sacc[dt][vt][0], Sacc[dt][vt][1]); w.y = pack2(Sacc[dt][vt][2], Sacc[dt][vt][3]);
                    *(LAS u32x2*)(Sl + (16 * vt + fr) * SS + (32 * wid + 16 * dt + 4 * fq) * 2) = w;
                }
        }
        __syncthreads();
    }
}
__device__ __forceinline__ void ret_norm_phase(LAS unsigned char* lds, const Params& p) {
    const int tid = tid_(), lane = tid & 63, wid = tid >> 6;
    LAS float* red = (LAS float*)lds;
    const bf16_t* u = (const bf16_t*)(p.ws + WS_U);
    const float* RO = (const float*)(p.ws + WS_SCR);
    bf16_t* yin = (bf16_t*)(p.ws + WS_YIN);
    for (int t = blockIdx.x; t < T; t += gridDim.x) {
        const f32x4 o = *(const f32x4*)(RO + (size_t)t * 2048 + tid * 4);
        const float ss = wave_sum(o[0] * o[0] + o[1] * o[1] + o[2] * o[2] + o[3] * o[3]);
        if (lane == 0) red[wid] = ss;
        __syncthreads();
        const float tot = red[(wid & ~1)] + red[(wid | 1)];
        const float rstd = rsqrtf(tot * (1.0f / 512.0f) + 1e-6f);
        const u32x2 gv = *(const u32x2*)(u + (size_t)t * 6144 + 4096 + tid * 4);
        const float g0 = __uint_as_float(gv.x << 16), g1 = __uint_as_float(gv.x & 0xffff0000u), g2 = __uint_as_float(gv.y << 16), g3 = __uint_as_float(gv.y & 0xffff0000u);
        u32x2 w; w.x = pack2(g0 * sigmoidf_(g0) * o[0] * rstd, g1 * sigmoidf_(g1) * o[1] * rstd); w.y = pack2(g2 * sigmoidf_(g2) * o[2] * rstd, g3 * sigmoidf_(g3) * o[3] * rstd);
        *(u32x2*)(yin + (size_t)t * 2048 + tid * 4) = w;
        __syncthreads();
    }
}

__device__ __forceinline__ void attn_core_phase(LAS unsigned char* lds, const Params& p) {
    const int tid = tid_(), lane = tid & 63, wid = tid >> 6, fr = lane & 15, fq = lane >> 4;
    constexpr int RS = 144, TILE = 272 * RS;
    LAS unsigned char* Kl = lds;
    LAS unsigned char* Vl = lds + TILE;
    const bf16_t* u = (const bf16_t*)(p.ws + WS_U);
    bf16_t* OP = (bf16_t*)(p.ws + WS_SCR);
    float* LSE = (float*)(p.ws + WS_SCR + 96 * MB);
    for (int i = tid; i < 16 * RS / 16; i += NTHREADS) { ((LAS u32x4*)(Kl + 256 * RS))[i] = (u32x4){0u, 0u, 0u, 0u}; ((LAS u32x4*)(Vl + 256 * RS))[i] = (u32x4){0u, 0u, 0u, 0u}; }
    for (int un = blockIdx.x; un < 3 * 2048; un += gridDim.x) {
        const int g = un >> 11, rem = un & 2047, b = rem >> 8, h = (rem >> 4) & 15, x = rem & 15;
        const int dl = (g == 0) ? 1 : (g == 1 ? 4 : 16), r_ = x & (dl - 1), n = x / dl;
        const float slope = exp2f(-0.5f * (float)(h + 1)) * (float)dl;
        const bf16_t* ub = u + (size_t)b * SEQ * 9216;
#pragma unroll
        for (int i = 0; i < 4; ++i) {
            const int piece = tid + NTHREADS * i, row = piece >> 3, ch = piece & 7;
            const int sk = ((n - 1) * 128 + row) * dl + r_;
            u32x4 kv = (u32x4){0u, 0u, 0u, 0u}, vv = (u32x4){0u, 0u, 0u, 0u};
            if (sk >= 0) { const bf16_t* src = ub + (size_t)sk * 9216 + h * 64 + ch * 8; kv = *(const u32x4*)(src + (3 + g) * 1024); vv = *(const u32x4*)(src + (6 + g) * 1024); }
            *(LAS u32x4*)(Kl + row * RS + ch * 16) = kv; *(LAS u32x4*)(Vl + row * RS + ch * 16) = vv;
        }
        const int qi = 16 * wid + fr, sq = (n * 128 + qi) * dl + r_;
        bf16x8 Qf[2];
#pragma unroll
        for (int ks = 0; ks < 2; ++ks) Qf[ks] = *(const bf16x8*)(ub + (size_t)sq * 9216 + g * 1024 + h * 64 + 32 * ks + 8 * fq);
        __syncthreads();
        f32x4 sc[9];
        float mx = -INFINITY;
#pragma unroll
        for (int kt = 0; kt < 9; ++kt) {
            sc[kt] = (f32x4){0.f, 0.f, 0.f, 0.f};
#pragma unroll
            for (int ks = 0; ks < 2; ++ks) {
                const bf16x8 kf = *(const LAS bf16x8*)(Kl + (16 * (wid + kt) + fr) * RS + (32 * ks + 8 * fq) * 2);
                sc[kt] = __builtin_amdgcn_mfma_f32_16x16x32_bf16(kf, Qf[ks], sc[kt], 0, 0, 0);
            }
#pragma unroll
            for (int r = 0; r < 4; ++r) {
                const int ki = 16 * (wid + kt) + 4 * fq + r, steps = qi + 128 - ki;
                const bool ok = (steps >= 0) && (steps <= 128) && (n > 0 || ki >= 128);
                const float v = ok ? sc[kt][r] * 0.125f - slope * (float)steps : -INFINITY;
                sc[kt][r] = v; mx = fmaxf(mx, v);
            }
        }
        mx = fmaxf(mx, __shfl_xor(mx, 16)); mx = fmaxf(mx, __shfl_xor(mx, 32));
        float l = 0.f;
#pragma unroll
        for (int kt = 0; kt < 9; ++kt)
#pragma unroll
            for (int r = 0; r < 4; ++r) { const float pv = __expf(sc[kt][r] - mx); sc[kt][r] = pv; l += pv; }
        l += __shfl_xor(l, 16); l += __shfl_xor(l, 32);
        f32x4 O[4];
#pragma unroll
        for (int dt = 0; dt < 4; ++dt) O[dt] = (f32x4){0.f, 0.f, 0.f, 0.f};
#pragma unroll
        for (int ks5 = 0; ks5 < 5; ++ks5) {
            const f32x4 p0 = sc[2 * ks5], p1 = (ks5 < 4) ? sc[(ks5 < 4) ? 2 * ks5 + 1 : 0] : (f32x4){0.f, 0.f, 0.f, 0.f};
            u32x4 w; w.x = pack2(p0[0], p0[1]); w.y = pack2(p0[2], p0[3]); w.z = pack2(p1[0], p1[1]); w.w = pack2(p1[2], p1[3]);
            const bf16x8 pf = __builtin_bit_cast(bf16x8, w);
#pragma unroll
            for (int dt = 0; dt < 4; ++dt) {
                const bf16x8 vf = cat8(tr4(Vl, 16 * (wid + 2 * ks5) + 4 * fq, 16 * dt, RS, lane), tr4(Vl, 16 * (wid + 2 * ks5 + 1) + 4 * fq, 16 * dt, RS, lane));
                O[dt] = __builtin_amdgcn_mfma_f32_16x16x32_bf16(vf, pf, O[dt], 0, 0, 0);
            }
        }
        const float inv = 1.0f / l;
        const size_t tq = (size_t)b * SEQ + sq;
#pragma unroll
        for (int dt = 0; dt < 4; ++dt) {
            u32x2 w; w.x = pack2(O[dt][0] * inv, O[dt][1] * inv); w.y = pack2(O[dt][2] * inv, O[dt][3] * inv);
            *(u32x2*)(OP + ((size_t)g * T + tq) * D + h * 64 + 16 * dt + 4 * fq) = w;
        }
        if (fq == 0) LSE[((size_t)g * T + tq) * 16 + h] = mx + __logf(l);
        __syncthreads();
    }
}
__device__ __forceinline__ void attn_merge_phase(const Params& p) {
    const int tid = tid_();
    const bf16_t* OP = (const bf16_t*)(p.ws + WS_SCR);
    const float* LSE = (const float*)(p.ws + WS_SCR + 96 * MB);
    bf16_t* yin = (bf16_t*)(p.ws + WS_YIN);
    for (size_t i = (size_t)blockIdx.x * NTHREADS + tid; i < (size_t)T * D / 8; i += (size_t)gridDim.x * NTHREADS) {
        const size_t t = i >> 7; const int c8 = (int)(i & 127), h = c8 >> 3;
        const float l0 = LSE[t * 16 + h], l1 = LSE[((size_t)T + t) * 16 + h], l2 = LSE[((size_t)2 * T + t) * 16 + h];
        const float m = fmaxf(l0, fmaxf(l1, l2));
        float w0 = __expf(l0 - m), w1 = __expf(l1 - m), w2 = __expf(l2 - m);
        const float inv = 1.0f / (w0 + w1 + w2); w0 *= inv; w1 *= inv; w2 *= inv;
        const u32x4 a = *(const u32x4*)(OP + t * D + c8 * 8), bq = *(const u32x4*)(OP + ((size_t)T + t) * D + c8 * 8), c = *(const u32x4*)(OP + ((size_t)2 * T + t) * D + c8 * 8);
        u32x4 o;
#define MRG(f) o.f = pack2(w0 * __uint_as_float(a.f << 16) + w1 * __uint_as_float(bq.f << 16) + w2 * __uint_as_float(c.f << 16), \
                           w0 * __uint_as_float(a.f & 0xffff0000u) + w1 * __uint_as_float(bq.f & 0xffff0000u) + w2 * __uint_as_float(c.f & 0xffff0000u))
        MRG(x); MRG(y); MRG(z); MRG(w);
#undef MRG
        *(u32x4*)(yin + t * D + c8 * 8) = o;
    }
}

__device__ __forceinline__ void ln1_router_phase(LAS unsigned char* lds, const Params& p, int layer) {
    const int tid = tid_(), lane = tid & 63, wid = tid >> 6, fr = lane & 15, fq = lane >> 4;
    constexpr int XS = 2064;
    LAS unsigned char* xh = lds;
    LAS unsigned char* xl = lds + 16 * XS;
    LAS float* part = (LAS float*)(lds + 32 * XS);
    LAS float* logit = part + 8 * 16 * 32;
    float* xf = (float*)(p.ws + WS_XF); bf16_t* xb = (bf16_t*)(p.ws + WS_XB);
    const float* ymix = (const float*)(p.ws + WS_YMIX);
    int* tope = (int*)(p.ws + WS_TOPE); float* gates = (float*)(p.ws + WS_GATES); int* pos = (int*)(p.ws + WS_POS);
    unsigned* ctl = (unsigned*)(p.ws + WS_CTL);
    const float* gain = p.ln_gain + (size_t)(layer * 2) * D; const float* bias = p.ln_bias + (size_t)(layer * 2) * D;
    const float* brt = p.moe_b_router + (size_t)layer * NEXP;
    const bf16_t* rth = (const bf16_t*)(p.ws + WS_RT) + (size_t)layer * 2 * NEXP * D; const bf16_t* rtl = rth + NEXP * D;
    bf16x8 Wh[2][4], Wl[2][4];
#pragma unroll
    for (int nt = 0; nt < 2; ++nt)
#pragma unroll
        for (int ks = 0; ks < 4; ++ks) { const size_t o = (size_t)(16 * nt + fr) * D + 128 * wid + 32 * ks + 8 * fq; Wh[nt][ks] = *(const bf16x8*)(rth + o); Wl[nt][ks] = *(const bf16x8*)(rtl + o); }
    for (int tile = blockIdx.x; tile < T / 16; tile += gridDim.x) {
#pragma unroll
        for (int tt = 0; tt < 2; ++tt) {
            const int trow = 2 * wid + tt; const size_t t = (size_t)tile * 16 + trow;
            f32x4 z[4];
#pragma unroll
            for (int i = 0; i < 4; ++i) { const int c = 256 * i + 4 * lane; z[i] = DN_ALPHA * *(const f32x4*)(xf + t * D + c) + *(const f32x4*)(ymix + t * D + c); }
            float sm = 0.f;
#pragma unroll
            for (int i = 0; i < 4; ++i) sm += (z[i][0] + z[i][1]) + (z[i][2] + z[i][3]);
            const float mean = wave_sum(sm) * (1.0f / D);
            float sq = 0.f;
#pragma unroll
            for (int i = 0; i < 4; ++i) { const f32x4 dd = z[i] - mean; sq += (dd[0] * dd[0] + dd[1] * dd[1]) + (dd[2] * dd[2] + dd[3] * dd[3]); }
            const float rstd = rsqrtf(wave_sum(sq) * (1.0f / D) + LN_EPS);
#pragma unroll
            for (int i = 0; i < 4; ++i) {
                const int c = 256 * i + 4 * lane;
                const f32x4 v = (z[i] - mean) * rstd * *(const f32x4*)(gain + c) + *(const f32x4*)(bias + c);
                *(f32x4*)(xf + t * D + c) = v;
                u32x2 wh; wh.x = pack2(v[0], v[1]); wh.y = pack2(v[2], v[3]);
                *(u32x2*)(xb + t * D + c) = wh;
                const float r0 = v[0] - __uint_as_float(wh.x << 16), r1 = v[1] - __uint_as_float(wh.x & 0xffff0000u), r2 = v[2] - __uint_as_float(wh.y << 16), r3 = v[3] - __uint_as_float(wh.y & 0xffff0000u);
                u32x2 wl; wl.x = pack2(r0, r1); wl.y = pack2(r2, r3);
                *(LAS u32x2*)(xh + trow * XS + c * 2) = wh; *(LAS u32x2*)(xl + trow * XS + c * 2) = wl;
            }
        }
        __syncthreads();
        {
            f32x4 acc[2] = {(f32x4){0.f, 0.f, 0.f, 0.f}, (f32x4){0.f, 0.f, 0.f, 0.f}};
#pragma unroll
            for (int ks = 0; ks < 4; ++ks) {
                const bf16x8 ah = *(const LAS bf16x8*)(xh + fr * XS + (128 * wid + 32 * ks + 8 * fq) * 2), al = *(const LAS bf16x8*)(xl + fr * XS + (128 * wid + 32 * ks + 8 * fq) * 2);
#pragma unroll
                for (int nt = 0; nt < 2; ++nt) {
                    acc[nt] = __builtin_amdgcn_mfma_f32_16x16x32_bf16(Wh[nt][ks], ah, acc[nt], 0, 0, 0);
                    acc[nt] = __builtin_amdgcn_mfma_f32_16x16x32_bf16(Wh[nt][ks], al, acc[nt], 0, 0, 0);
                    acc[nt] = __builtin_amdgcn_mfma_f32_16x16x32_bf16(Wl[nt][ks], ah, acc[nt], 0, 0, 0);
                }
            }
#pragma unroll
            for (int nt = 0; nt < 2; ++nt) *(LAS f32x4*)(part + (wid * 16 + fr) * 32 + 16 * nt + 4 * fq) = acc[nt];
        }
        __syncthreads();
        {
            const int tk = tid >> 5, e = tid & 31;
            float sacc = brt[e];
#pragma unroll
            for (int w = 0; w < 8; ++w) sacc += part[(w * 16 + tk) * 32 + e];
            logit[tk * 32 + e] = sacc;
        }
        __syncthreads();
        if (tid < 16) {
            const size_t t = (size_t)tile * 16 + tid;
            float v0 = -INFINITY, v1 = -INFINITY, v2 = -INFINITY, v3 = -INFINITY; int i0 = 0, i1 = 0, i2 = 0, i3 = 0;
#pragma unroll
            for (int e = 0; e < NEXP; ++e) {
                const float v = logit[tid * 32 + e];
                if (v > v3) {
                    if (v > v0) { v3 = v2; i3 = i2; v2 = v1; i2 = i1; v1 = v0; i1 = i0; v0 = v; i0 = e; }
                    else if (v > v1) { v3 = v2; i3 = i2; v2 = v1; i2 = i1; v1 = v; i1 = e; }
                    else if (v > v2) { v3 = v2; i3 = i2; v2 = v; i2 = e; }
                    else { v3 = v; i3 = e; }
                }
            }
            const float e1 = __expf(v1 - v0), e2 = __expf(v2 - v0), e3 = __expf(v3 - v0), inv = 1.0f / (1.0f + e1 + e2 + e3);
            tope[t * 4 + 0] = i0; tope[t * 4 + 1] = i1; tope[t * 4 + 2] = i2; tope[t * 4 + 3] = i3;
            gates[t * 4 + 0] = inv; gates[t * 4 + 1] = e1 * inv; gates[t * 4 + 2] = e2 * inv; gates[t * 4 + 3] = e3 * inv;
            pos[t * 4 + 0] = (int)atomicAdd(ctl + CW_CNT + layer * 64 + i0, 1u); pos[t * 4 + 1] = (int)atomicAdd(ctl + CW_CNT + layer * 64 + i1, 1u);
            pos[t * 4 + 2] = (int)atomicAdd(ctl + CW_CNT + layer * 64 + i2, 1u); pos[t * 4 + 3] = (int)atomicAdd(ctl + CW_CNT + layer * 64 + i3, 1u);
        }
    }
    __syncthreads();
}
__device__ __forceinline__ void ln2_phase(const Params& p, int layer) {
    const int tid = tid_(), lane = tid & 63, wid = tid >> 6;
    float* xf = (float*)(p.ws + WS_XF); bf16_t* xb = (bf16_t*)(p.ws + WS_XB);
    const bf16_t* yrows = (const bf16_t*)(p.ws + WS_YROWS);
    const float* gates = (const float*)(p.ws + WS_GATES); const int* dest = (const int*)(p.ws + WS_DEST);
    const float* gain = p.ln_gain + (size_t)(layer * 2 + 1) * D; const float* bias = p.ln_bias + (size_t)(layer * 2 + 1) * D;
    for (int t = blockIdx.x * 8 + wid; t < T; t += gridDim.x * 8) {
        f32x4 z[4];
        int dk[4]; float gk[4];
#pragma unroll
        for (int k = 0; k < 4; ++k) { dk[k] = dest[t * 4 + k]; gk[k] = gates[t * 4 + k]; }
#pragma unroll
        for (int i = 0; i < 4; ++i) {
            const int c = 256 * i + 4 * lane;
            f32x4 f = (f32x4){0.f, 0.f, 0.f, 0.f};
#pragma unroll
            for (int k = 0; k < 4; ++k) { const u32x2 yv = *(const u32x2*)(yrows + (size_t)dk[k] * D + c);
                f[0] += gk[k] * __uint_as_float(yv.x << 16); f[1] += gk[k] * __uint_as_float(yv.x & 0xffff0000u); f[2] += gk[k] * __uint_as_float(yv.y << 16); f[3] += gk[k] * __uint_as_float(yv.y & 0xffff0000u); }
            z[i] = DN_ALPHA * *(const f32x4*)(xf + (size_t)t * D + c) + f;
        }
        float sm = 0.f;
#pragma unroll
        for (int i = 0; i < 4; ++i) sm += (z[i][0] + z[i][1]) + (z[i][2] + z[i][3]);
        const float mean = wave_sum(sm) * (1.0f / D);
        float sq = 0.f;
#pragma unroll
        for (int i = 0; i < 4; ++i) { const f32x4 dd = z[i] - mean; sq += (dd[0] * dd[0] + dd[1] * dd[1]) + (dd[2] * dd[2] + dd[3] * dd[3]); }
        const float rstd = rsqrtf(wave_sum(sq) * (1.0f / D) + LN_EPS);
#pragma unroll
        for (int i = 0; i < 4; ++i) {
            const int c = 256 * i + 4 * lane;
            z[i] = (z[i] - mean) * rstd * *(const f32x4*)(gain + c) + *(const f32x4*)(bias + c);
            if (layer == DEPTH - 1) *(f32x4*)(p.out + (size_t)t * D + c) = z[i];
            else { *(f32x4*)(xf + (size_t)t * D + c) = z[i]; u32x2 w; w.x = pack2(z[i][0], z[i][1]); w.y = pack2(z[i][2], z[i][3]); *(u32x2*)(xb + (size_t)t * D + c) = w; }
        }
    }
}

__device__ __forceinline__ void moe_scatter_phase(LAS unsigned char* lds, const Params& p, int layer) {
    const int tid = tid_();
    LAS int* pstart = (LAS int*)lds;
    unsigned* ctl = (unsigned*)(p.ws + WS_CTL);
    const int* tope = (const int*)(p.ws + WS_TOPE); const int* pos = (const int*)(p.ws + WS_POS);
    int* dest = (int*)(p.ws + WS_DEST); int* rowtok = (int*)(p.ws + WS_ROWTOK);
    if (tid == 0) {
        int acc = 0;
        for (int e = 0; e < NEXP; ++e) { const int c = (int)ctl[CW_CNT + layer * 64 + e]; pstart[e] = acc; pstart[32 + e] = c; acc += ((c + 255) >> 8) << 8; }
        pstart[64] = acc;
        if (blockIdx.x == 0) {
            ctl[CW_MDYN + layer * 64] = (unsigned)acc;
            for (int e = 0; e < NEXP; ++e) { const int nb = (pstart[32 + e] + 255) >> 8; for (int b = 0; b < nb; ++b) ctl[CW_TEXP + layer * 512 + (pstart[e] >> 8) + b] = (unsigned)e; }
        }
    }
    __syncthreads();
    for (int i = blockIdx.x * NTHREADS + tid; i < T * TOPK; i += gridDim.x * NTHREADS) {
        const int e = tope[i], row = pstart[e] + pos[i];
        dest[i] = row; rowtok[row] = i >> 2;
    }
    for (int i = blockIdx.x * NTHREADS + tid; i < NEXP * 256; i += gridDim.x * NTHREADS) {
        const int e = i >> 8, r = i & 255, c = pstart[32 + e], padded = ((c + 255) >> 8) << 8;
        if (c + r < padded) rowtok[pstart[e] + c + r] = 0;
    }
    __syncthreads();
}

constexpr int PH_PER_LAYER = 9;
constexpr int NPHASES = 1 + DEPTH * PH_PER_LAYER;
constexpr int LDS_BYTES = 132 * 1024;


#ifndef PHMASK
#define PHMASK 0x3FF
#endif
#define PHK(j) ((PHMASK >> (j)) & 1)
#define IN(k) (lo <= (k) && (k) < hi)
#if MK_ONE_LAUNCH
#define SEAM(k) do { if (IN(k) && IN((k) + 1)) xcd_barrier_nv(bar.bar, bar.x, bar.st); } while (0)
#else
#define SEAM(k) do {} while (0)
#endif
template <int layer>
__device__ __forceinline__ void run_layer(const Params& p, LAS unsigned char* lds, const XcdBarrier& bar) {
    const int lo = p.ph_lo, hi = p.ph_hi;
    unsigned char* ws = p.ws;
    unsigned* ctl = (unsigned*)(ws + WS_CTL);
        constexpr int base = 1 + layer * PH_PER_LAYER, kind = layer % 3, idx = layer / 3;
        if (PHK(1) && IN(base + 0)) {
            constexpr int N = (kind == 0) ? 2048 : (kind == 1 ? 6144 : 9216);
            const bf16_t* Bt = (kind == 0) ? (const bf16_t*)(ws + WS_AWIN) + (size_t)idx * 2048 * D : (kind == 1 ? (const bf16_t*)(ws + WS_BWIN) : (const bf16_t*)(ws + WS_CWIN));
            g8::SchedPlain S; S.init(ws + WS_XB, Bt, T, N, D, (int)gridDim.x, (int)blockIdx.x);
            g8::EpiBf16 E{(bf16_t*)(ws + WS_U), N, nullptr, 0};
            g8::gemm_phase<g8::EpiBf16, g8::SchedPlain, false>(lds, D, S, E);
        }
        SEAM(base + 0);
        if (PHK(2) && IN(base + 1)) {
            if (kind == 0) lru_gates_phase(lds, p, idx);
            else if (kind == 1) ret_core_phase(lds, p);
            else attn_core_phase(lds, p);
        }
        SEAM(base + 1);
        if (PHK(3) && IN(base + 2)) {
            if (kind == 0) lru_scan_phase(p);
            else if (kind == 1) ret_norm_phase(lds, p);
            else attn_merge_phase(p);
        }
        SEAM(base + 2);
        if (PHK(4) && IN(base + 3)) {
            constexpr int K = (kind == 1) ? 2048 : D;
            const bf16_t* Bt = (kind == 0) ? (const bf16_t*)(ws + WS_AWOUT) + (size_t)idx * D * D : (kind == 1 ? (const bf16_t*)(ws + WS_BWOUT) : (const bf16_t*)(ws + WS_CWOUT));
            g8::SchedPlain S; S.init(ws + WS_YIN, Bt, T, D, K, (int)gridDim.x, (int)blockIdx.x);
            g8::EpiF32 E{(float*)(ws + WS_YMIX), D, nullptr, 0};
            g8::gemm_phase<g8::EpiF32, g8::SchedPlain, false>(lds, K, S, E);
        }
        SEAM(base + 3);
        if (PHK(5) && IN(base + 4)) ln1_router_phase(lds, p, layer);
        SEAM(base + 4);
        if (PHK(6) && IN(base + 5)) moe_scatter_phase(lds, p, layer);
        SEAM(base + 5);
        if (PHK(7) && IN(base + 6)) {
            g8::SchedGU S{(const char*)(ws + WS_XB), (const char*)((const bf16_t*)(ws + WS_GU) + (size_t)layer * NEXP * 2048 * D), (const int*)(ws + WS_ROWTOK), ctl + CW_TEXP + layer * 512,
                          (int)(ctl[CW_MDYN + layer * 64] >> 8), (int)gridDim.x, (int)blockIdx.x};
            g8::EpiSwiglu E{(bf16_t*)(ws + WS_HID), p.moe_b_gu + (size_t)layer * NEXP * 2048};
            g8::gemm_phase<g8::EpiSwiglu, g8::SchedGU, true>(lds, D, S, E);
        }
        SEAM(base + 6);
        if (PHK(8) && IN(base + 7)) {
            g8::SchedDown S{(const char*)(ws + WS_HID), (const char*)((const bf16_t*)(ws + WS_DN) + (size_t)layer * NEXP * D * D), ctl + CW_TEXP + layer * 512,
                            (int)(ctl[CW_MDYN + layer * 64] >> 8), (int)gridDim.x, (int)blockIdx.x};
            g8::EpiBf16 E{(bf16_t*)(ws + WS_YROWS), D, p.moe_b_down + (size_t)layer * NEXP * D, D};
            g8::gemm_phase<g8::EpiBf16, g8::SchedDown, false>(lds, D, S, E);
        }
        SEAM(base + 7);
        if (PHK(9) && IN(base + 8)) ln2_phase(p, layer);
        SEAM(base + 8);
    }
#undef IN
#undef SEAM
__global__ void __launch_bounds__(NTHREADS, 2) fwd_kernel(Params p) {
    extern __shared__ __attribute__((aligned(16))) unsigned char lds_raw[];
    LAS unsigned char* lds = (LAS unsigned char*)lds_raw;
    const int lo = p.ph_lo, hi = p.ph_hi;
    unsigned char* ws = p.ws;
    unsigned* ctl = (unsigned*)(ws + WS_CTL);
#if MK_ONE_LAUNCH
    volatile LAS unsigned* bst = (volatile LAS unsigned*)(lds + LDS_BYTES - 16);
    if (threadIdx.x == 0) { bst[0] = 0u; bst[1] = 0u; bst[2] = 0u; bst[3] = 0u; }
    __syncthreads();
    XcdBarrier bar = xcd_barrier_post(ctl, bst);
#define GRID_BAR() xcd_barrier_nv(bar.bar, bar.x, bar.st)
#else
    XcdBarrier bar; bar.bar = ctl; bar.x = 0; bar.st = nullptr;
#define GRID_BAR() do {} while (0)
#endif
#define IN(k) (lo <= (k) && (k) < hi)
#define SEAM(k) do { if (IN(k) && IN((k) + 1)) GRID_BAR(); } while (0)

    if (PHK(0) && IN(0)) {
        LAS float* tile = (LAS float*)lds;
        convert_big(p.moe_w_gu, (bf16_t*)(ws + WS_GU), D, 2048, DEPTH * NEXP);
        convert_big(p.moe_w_down, (bf16_t*)(ws + WS_DN), D, D, DEPTH * NEXP);
        convert_big(p.a_w_in, (bf16_t*)(ws + WS_AWIN), D, 2048, 2);
        convert_big(p.a_w_out, (bf16_t*)(ws + WS_AWOUT), D, D, 2);
        convert_big(p.b_w_in, (bf16_t*)(ws + WS_BWIN), D, 6144, 1);
        convert_big(p.b_w_out, (bf16_t*)(ws + WS_BWOUT), 2048, D, 1);
        convert_big(p.c_w_in, (bf16_t*)(ws + WS_CWIN), D, 9216, 1);
        convert_big(p.c_w_out, (bf16_t*)(ws + WS_CWOUT), D, D, 1);
        convert_job(tile, p.a_w_rgate, (bf16_t*)(ws + WS_AGT), 128, 128, 8);
        convert_job(tile, p.a_w_igate, (bf16_t*)(ws + WS_AGT) + (size_t)8 * 128 * 128, 128, 128, 8);
        convert_job(tile, p.a_w_rgate + (size_t)8 * 128 * 128, (bf16_t*)(ws + WS_AGT) + (size_t)16 * 128 * 128, 128, 128, 8);
        convert_job(tile, p.a_w_igate + (size_t)8 * 128 * 128, (bf16_t*)(ws + WS_AGT) + (size_t)24 * 128 * 128, 128, 128, 8);
        {
            bf16_t* rt = (bf16_t*)(ws + WS_RT);
            for (int i = blockIdx.x * NTHREADS + threadIdx.x; i < DEPTH * NEXP * D; i += gridDim.x * NTHREADS) {
                const int l = i / (NEXP * D), r_ = i % (NEXP * D), e = r_ / D, k = r_ % D;
                const float w = p.moe_w_router[((size_t)l * D + k) * NEXP + e];
                const bf16_t hi = f2bf(w); const bf16_t lo = f2bf(w - bf2f(hi));
                rt[((size_t)l * 2 + 0) * NEXP * D + (size_t)e * D + k] = hi; rt[((size_t)l * 2 + 1) * NEXP * D + (size_t)e * D + k] = lo;
            }
        }
        float* xf = (float*)(ws + WS_XF); bf16_t* xb = (bf16_t*)(ws + WS_XB);
        for (size_t i = (size_t)blockIdx.x * NTHREADS + threadIdx.x; i < (size_t)T * D / 4; i += (size_t)gridDim.x * NTHREADS) {
            const f32x4 v = *(const f32x4*)(p.x + i * 4);
            *(f32x4*)(xf + i * 4) = v;
            u32x2 w; w.x = pack2(v[0], v[1]); w.y = pack2(v[2], v[3]); *(u32x2*)(xb + i * 4) = w;
        }
    }
    SEAM(0);

    run_layer<0>(p, lds, bar); run_layer<1>(p, lds, bar); run_layer<2>(p, lds, bar); run_layer<3>(p, lds, bar);
#undef IN
#undef SEAM
}

extern "C" void kernel_launch(void* const* d_in, const int* in_sizes, int n_in, void* d_out, int out_size, void* d_ws, size_t ws_size, hipStream_t stream) {
    static int grid = 0;
    if (grid == 0) {
        if (n_in != 22 || out_size != T * D || ws_size < WS_END) { fprintf(stderr, "kernel_launch: unexpected shapes (n_in %d out %d ws %zu need %zu)\n", n_in, out_size, ws_size, (size_t)WS_END); grid = -1; return; }
        if (hipFuncSetAttribute((const void*)fwd_kernel, hipFuncAttributeMaxDynamicSharedMemorySize, LDS_BYTES) != hipSuccess) { fprintf(stderr, "kernel_launch: hipFuncSetAttribute failed\n"); grid = -1; return; }
        int dev = 0, cus = 0;
        if (hipGetDevice(&dev) != hipSuccess || hipDeviceGetAttribute(&cus, hipDeviceAttributeMultiprocessorCount, dev) != hipSuccess) { grid = -1; return; }
        grid = cus;
    }
    if (grid < 0) return;
    (void)hipMemsetAsync((char*)d_ws + WS_CTL, 0, CTL_BYTES, stream);
    Params p{};
    const float** pp = (const float**)&p;
    for (int i = 0; i < 22; ++i) pp[i] = (const float*)d_in[i];
    p.out = (float*)d_out; p.ws = (unsigned char*)d_ws;
#if MK_ONE_LAUNCH
    p.ph_lo = 0; p.ph_hi = NPHASES;
    hipLaunchKernelGGL(fwd_kernel, dim3(grid), dim3(NTHREADS), LDS_BYTES, stream, p);
#else
    for (int ph = 0; ph < NPHASES; ++ph) {
        p.ph_lo = ph; p.ph_hi = ph + 1;
        hipLaunchKernelGGL(fwd_kernel, dim3(grid), dim3(NTHREADS), LDS_BYTES, stream, p);
    }
#endif
}
```

```cpp
#include <hip/hip_runtime.h>
#include <stdint.h>
#include <stdio.h>

#ifndef MK_ONE_LAUNCH
#define MK_ONE_LAUNCH 1
#endif

#define LAS __attribute__((address_space(3)))
typedef unsigned short bf16_t;
typedef short bf16x8 __attribute__((ext_vector_type(8)));
typedef float f32x4 __attribute__((ext_vector_type(4)));
typedef unsigned u32x4 __attribute__((ext_vector_type(4)));
typedef unsigned u32x2 __attribute__((ext_vector_type(2)));

constexpr int T = 16384, D = 1024, SEQ = 2048, NBATCH = 8, DEPTH = 4;
constexpr int NEXP = 32, TOPK = 4;
constexpr int MAXROWS = 73728;
constexpr float DN_ALPHA = 1.681792830507429f;
constexpr float LN_EPS = 1e-5f;
constexpr float GU_WSCALE = 64.0f, DN_WSCALE = 128.0f;
constexpr int NTHREADS = 512;

constexpr size_t MB = 1ull << 20;
constexpr size_t WS_CTL = 0;
constexpr size_t CTL_BYTES = 65536;
constexpr size_t WS_AWIN = 1 * MB;
constexpr size_t WS_AWOUT = WS_AWIN + 8 * MB;
constexpr size_t WS_BWIN = WS_AWOUT + 4 * MB;
constexpr size_t WS_BWOUT = WS_BWIN + 12 * MB;
constexpr size_t WS_CWIN = WS_BWOUT + 4 * MB;
constexpr size_t WS_CWOUT = WS_CWIN + 18 * MB;
constexpr size_t WS_GU = WS_CWOUT + 2 * MB;
constexpr size_t WS_DN = WS_GU + 512 * MB;
constexpr size_t WS_XF = WS_DN + 256 * MB;
constexpr size_t WS_XB = WS_XF + 64 * MB;
constexpr size_t WS_U = WS_XB + 32 * MB;
constexpr size_t WS_YIN = WS_U + 288 * MB;
constexpr size_t WS_YMIX = WS_YIN + 64 * MB;
constexpr size_t WS_SCR = WS_YMIX + 64 * MB;
constexpr size_t WS_TOPE = WS_SCR + 128 * MB;
constexpr size_t WS_GATES = WS_TOPE + 256 * 1024;
constexpr size_t WS_POS = WS_GATES + 256 * 1024;
constexpr size_t WS_DEST = WS_POS + 256 * 1024;
constexpr size_t WS_ROWTOK = WS_DEST + 256 * 1024;
constexpr size_t WS_HID = WS_ROWTOK + 1 * MB;
constexpr size_t WS_YROWS = WS_HID + 144 * MB;
constexpr size_t WS_LSUM = WS_YROWS + 288 * MB;
constexpr size_t WS_AGT = WS_LSUM + 2 * MB;
constexpr size_t WS_RT = WS_AGT + 1 * MB;
constexpr size_t WS_XQ = WS_RT + 1 * MB;
constexpr size_t WS_END = WS_XQ + 16 * MB;

constexpr int CW_CNT = 4096;
constexpr int CW_MDYN = 8192;
constexpr int CW_TEXP = 12288;

#define XB_TMO      128
#define XB_XCNT(j)  (256  + 64 * (j))
#define XB_XSUB(j)  (1280 + 64 * (j))
#define XB_XGEN(j)  (2304 + 64 * (j))
#define XB_TOP      3328
#define XB_TOPGEN   3392
#define XCD_BAR_WORDS 3456
#define XB_SPIN_CAP (1u << 22)

__device__ __forceinline__ unsigned xb_ld(unsigned* p)              { return __hip_atomic_load(p, __ATOMIC_RELAXED, __HIP_MEMORY_SCOPE_AGENT); }
__device__ __forceinline__ unsigned xb_add(unsigned* p, unsigned v) { return __hip_atomic_fetch_add(p, v, __ATOMIC_RELAXED, __HIP_MEMORY_SCOPE_AGENT); }
__device__ __forceinline__ unsigned xb_xcc_id() { return (unsigned)__builtin_amdgcn_s_getreg((3 << 11) | 20) & 0xFu; }
#define XB_SPIN(cond, bar) do { unsigned _sp = 0; while (cond) { __builtin_amdgcn_s_sleep(1); \
    if ((++_sp & 255u) == 0u) { if (xb_ld(&(bar)[XB_TMO])) break; if (_sp > XB_SPIN_CAP) { atomicAdd(&(bar)[XB_TMO], 1u); break; } } } } while (0)

struct XcdBarrier { unsigned* bar; unsigned x; volatile LAS unsigned* st; };

__device__ __forceinline__ XcdBarrier xcd_barrier_post(unsigned* bar, volatile LAS unsigned* st) {
    XcdBarrier b; b.bar = bar; b.x = xb_xcc_id(); b.st = st;
    if (threadIdx.x == 0) (void)xb_add(&bar[XB_XCNT(b.x)], 1u);
    return b;
}
__device__ __forceinline__ void xcd_barrier_complete(unsigned* bar, unsigned x, unsigned& nloc, unsigned& nx) {
    const unsigned G = gridDim.x * gridDim.y * gridDim.z;
    unsigned sum, cnt, mine, sp = 0u;
    for (;;) {
        sum = 0u; cnt = 0u; mine = 0u;
#pragma unroll
        for (unsigned j = 0; j < 16; ++j) { const unsigned c = xb_ld(&bar[XB_XCNT(j)]); sum += c; cnt += (c > 0u) ? 1u : 0u; mine = (j == x) ? c : mine; }
        if (sum == G) break;
        __builtin_amdgcn_s_sleep(1);
        if ((++sp & 255u) == 0u) { if (xb_ld(&bar[XB_TMO])) break; if (sp > XB_SPIN_CAP) { atomicAdd(&bar[XB_TMO], 1u); break; } }
    }
    nloc = mine > 0u ? mine : 1u; nx = cnt > 0u ? cnt : 1u;
}
__device__ __noinline__ void xcd_barrier_nv(unsigned* bbar, unsigned bx, volatile LAS unsigned* bst) {
    XcdBarrier b; b.bar = bbar; b.x = bx; b.st = bst;
    asm volatile("s_waitcnt vmcnt(0)" ::: "memory");
    __syncthreads();
    if (threadIdx.x == 0) {
        unsigned* bar = b.bar;
        __builtin_amdgcn_s_waitcnt(0);
        unsigned nloc = b.st[0], nx = b.st[1];
        if (nloc == 0u) { xcd_barrier_complete(bar, b.x, nloc, nx); b.st[0] = nloc; b.st[1] = nx; }
        const unsigned old = xb_add(&bar[XB_XSUB(b.x)], 1u);
        const unsigned gen = old / nloc;
        if (old + 1u == (gen + 1u) * nloc) {
            __builtin_amdgcn_fence(__ATOMIC_RELEASE, "agent");
            asm volatile("s_waitcnt vmcnt(0)" ::: "memory");
            const unsigned og = xb_add(&bar[XB_TOP], 1u);
            const unsigned tg = og / nx;
            if (og + 1u == (tg + 1u) * nx) xb_add(&bar[XB_TOPGEN], 1u);
            else XB_SPIN(xb_ld(&bar[XB_TOPGEN]) == tg, bar);
            __builtin_amdgcn_fence(__ATOMIC_ACQUIRE, "agent");
            xb_add(&bar[XB_XGEN(b.x)], 1u);
            asm volatile("s_waitcnt vmcnt(0)" ::: "memory");
        } else {
            XB_SPIN(xb_ld(&bar[XB_XGEN(b.x)]) == gen, bar);
            __builtin_amdgcn_fence(__ATOMIC_ACQUIRE, "agent");
            asm volatile("s_waitcnt vmcnt(0)" ::: "memory");
        }
    }
    __syncthreads();
}

__device__ __forceinline__ int tid_() { int t = threadIdx.x; asm volatile("" : "+v"(t)); return t; }
__device__ __forceinline__ float bf2f(bf16_t v) { return __uint_as_float(((unsigned)v) << 16); }
__device__ __forceinline__ bf16_t f2bf(float f) { unsigned u = __float_as_uint(f); u += 0x7FFFu + ((u >> 16) & 1u); return (bf16_t)(u >> 16); }
__device__ __forceinline__ unsigned pack2(float lo, float hi) { return (unsigned)f2bf(lo) | ((unsigned)f2bf(hi) << 16); }
__device__ __forceinline__ float wave_sum(float v) {
#pragma unroll
    for (int o = 32; o >= 1; o >>= 1) v += __shfl_xor(v, o);
    return v;
}
__device__ __forceinline__ float wave_max(float v) {
#pragma unroll
    for (int o = 32; o >= 1; o >>= 1) v = fmaxf(v, __shfl_xor(v, o));
    return v;
}
__device__ __forceinline__ float sigmoidf_(float x) { return 1.0f / (1.0f + __expf(-x)); }
__device__ __forceinline__ float gelu_tanh(float x) { const float u = 0.7978845608028654f * (x + 0.044715f * x * x * x); return 0.5f * x * (1.0f + tanhf(u)); }
__device__ __forceinline__ unsigned pk_fp8x4(float a, float b, float c, float d) { int w = 0; w = __builtin_amdgcn_cvt_pk_fp8_f32(a, b, w, false); w = __builtin_amdgcn_cvt_pk_fp8_f32(c, d, w, true); return (unsigned)w; }
__device__ __forceinline__ float swiglu(float gate, float up) {
    const float g = fminf(gate, 7.0f), u = fminf(fmaxf(up, -7.0f), 7.0f);
    return (u + 1.0f) * g * sigmoidf_(1.702f * g);
}

struct Params {
    const float* x; const float* a_w_in; const float* a_conv_w; const float* a_conv_b; const float* a_w_rgate; const float* a_b_rgate;
    const float* a_w_igate; const float* a_b_igate; const float* a_lambda; const float* a_w_out; const float* b_w_in; const float* b_w_out;
    const float* c_w_in; const float* c_w_out; const float* ln_gain; const float* ln_bias; const float* moe_w_router; const float* moe_b_router;
    const float* moe_w_gu; const float* moe_b_gu; const float* moe_w_down; const float* moe_b_down;
    float* out; unsigned char* ws;
    int ph_lo, ph_hi;
};

__device__ __forceinline__ void convert_job(LAS float* tile, const float* src, bf16_t* dst, int K, int N, int batch) {
    const int tid = tid_();
    const int tk = K / 64, tn = N / 64, per = tk * tn; const long total = (long)per * batch;
    for (long u = blockIdx.x; u < total; u += gridDim.x) {
        const int bidx = (int)(u / per), r = (int)(u % per), kt = r / tn, nt = r % tn;
        const float* s = src + (size_t)bidx * K * N + (size_t)(kt * 64) * N + nt * 64;
#pragma unroll
        for (int pass = 0; pass < 2; ++pass) {
            const int row = (tid >> 4) + 32 * pass, c4 = tid & 15;
            const f32x4 v = *(const f32x4*)(s + (size_t)row * N + c4 * 4);
            tile[row * 65 + c4 * 4 + 0] = v[0]; tile[row * 65 + c4 * 4 + 1] = v[1]; tile[row * 65 + c4 * 4 + 2] = v[2]; tile[row * 65 + c4 * 4 + 3] = v[3];
        }
        __syncthreads();
        {
            const int n = tid >> 3, k8 = tid & 7;
            float v[8];
#pragma unroll
            for (int j = 0; j < 8; ++j) v[j] = tile[(k8 * 8 + j) * 65 + n];
            u32x4 w; w.x = pack2(v[0], v[1]); w.y = pack2(v[2], v[3]); w.z = pack2(v[4], v[5]); w.w = pack2(v[6], v[7]);
            *(u32x4*)(dst + (size_t)bidx * N * K + (size_t)(nt * 64 + n) * K + kt * 64 + k8 * 8) = w;
        }
        __syncthreads();
    }
}

struct GemmS {
    const bf16_t* A; int lda;
    const bf16_t* Bt; int ldb;
    int M, N, K;
    const unsigned* Mdyn;
    const int* row_idx;
    const unsigned* tile_exp;
    size_t b_exp_stride;
    const float* bias; int bias_es;
    float* Cf; bf16_t* Cb; int ldc;
};
template <int MODE>
__device__ __forceinline__ void gemm_simple(LAS unsigned char* lds, const GemmS& g) {
    const int tid = tid_(), lane = tid & 63, wid = tid >> 6, wr = wid >> 1, wc = wid & 1, fr = lane & 15, fq = lane >> 4;
    const int M = g.Mdyn ? (int)*g.Mdyn : g.M;
    const int tiles_n = (MODE == 1) ? (g.N / 256) * 2 : g.N / 128;
    const int tiles_m = M / 128, nunits = tiles_m * tiles_n, nk = g.K / 32;
    LAS bf16_t* As = (LAS bf16_t*)lds;
    LAS bf16_t* Bs = As + 2 * 128 * 40;
    const int lrow = tid >> 2, lch = tid & 3;
    for (int u = blockIdx.x; u < nunits; u += gridDim.x) {
        const int tm = u / tiles_n, tn = u % tiles_n, m0 = tm * 128;
        const int e = (MODE != 0) ? (int)g.tile_exp[m0 >> 8] : 0;
        const bf16_t* Bbase = g.Bt + (size_t)e * g.b_exp_stride;
        int arow = m0 + lrow; if (MODE == 1) arow = g.row_idx[arow];
        int brow;
        if (MODE == 1) { const int bwc = lrow >> 6, ni = (lrow & 63) >> 4, r = lrow & 15; brow = ((ni & 1) ? 1024 : 0) + tn * 64 + bwc * 32 + (ni >> 1) * 16 + r; }
        else brow = tn * 128 + lrow;
        const bf16_t* ap = g.A + (size_t)arow * g.lda + lch * 8;
        const bf16_t* bp = Bbase + (size_t)brow * g.ldb + lch * 8;
        f32x4 acc[2][4];
#pragma unroll
        for (int mi = 0; mi < 2; ++mi)
#pragma unroll
            for (int ni = 0; ni < 4; ++ni) acc[mi][ni] = (f32x4){0.f, 0.f, 0.f, 0.f};
        u32x4 ra = *(const u32x4*)ap, rb = *(const u32x4*)bp;
        *(LAS u32x4*)(As + lrow * 40 + lch * 8) = ra; *(LAS u32x4*)(Bs + lrow * 40 + lch * 8) = rb;
        __syncthreads();
        for (int kt = 0; kt < nk; ++kt) {
            const int cur = kt & 1;
            if (kt + 1 < nk) { ra = *(const u32x4*)(ap + (kt + 1) * 32); rb = *(const u32x4*)(bp + (kt + 1) * 32); }
            bf16x8 af[2], bfr[4];
#pragma unroll
            for (int mi = 0; mi < 2; ++mi) af[mi] = *(const LAS bf16x8*)(As + cur * 5120 + (wr * 32 + mi * 16 + fr) * 40 + fq * 8);
#pragma unroll
            for (int ni = 0; ni < 4; ++ni) bfr[ni] = *(const LAS bf16x8*)(Bs + cur * 5120 + (wc * 64 + ni * 16 + fr) * 40 + fq * 8);
#pragma unroll
            for (int mi = 0; mi < 2; ++mi)
#pragma unroll
                for (int ni = 0; ni < 4; ++ni) acc[mi][ni] = __builtin_amdgcn_mfma_f32_16x16x32_bf16(bfr[ni], af[mi], acc[mi][ni], 0, 0, 0);
            if (kt + 1 < nk) { *(LAS u32x4*)(As + (cur ^ 1) * 5120 + lrow * 40 + lch * 8) = ra; *(LAS u32x4*)(Bs + (cur ^ 1) * 5120 + lrow * 40 + lch * 8) = rb; }
            __syncthreads();
        }
#pragma unroll
        for (int mi = 0; mi < 2; ++mi) {
            const int m = m0 + wr * 32 + mi * 16 + fr;
            if (MODE == 1) {
#pragma unroll
                for (int q = 0; q < 2; ++q) {
                    const int hc = tn * 64 + wc * 32 + q * 16 + 4 * fq;
                    const f32x4 bg = *(const f32x4*)(g.bias + (size_t)e * g.bias_es + hc), bu = *(const f32x4*)(g.bias + (size_t)e * g.bias_es + 1024 + hc);
                    const f32x4 gt = acc[mi][2 * q] + bg, up = acc[mi][2 * q + 1] + bu;
                    u32x2 w; w.x = pack2(swiglu(gt[0], up[0]), swiglu(gt[1], up[1])); w.y = pack2(swiglu(gt[2], up[2]), swiglu(gt[3], up[3]));
                    *(u32x2*)(g.Cb + (size_t)m * g.ldc + hc) = w;
                }
            } else {
#pragma unroll
                for (int ni = 0; ni < 4; ++ni) {
                    const int n = tn * 128 + wc * 64 + ni * 16 + 4 * fq;
                    f32x4 v = acc[mi][ni];
                    if (g.bias) v += *(const f32x4*)(g.bias + (size_t)e * g.bias_es + n);
                    if (g.Cf) *(f32x4*)(g.Cf + (size_t)m * g.ldc + n) = v;
                    else { u32x2 w; w.x = pack2(v[0], v[1]); w.y = pack2(v[2], v[3]); *(u32x2*)(g.Cb + (size_t)m * g.ldc + n) = w; }
                }
            }
        }
    }
}


namespace g8 {
constexpr int BM = 256, BK = 64, HALF = 128, HTB = HALF * BK * 2, STAGE_BYTES = 8 * HTB, NXCD = 8, WGM = 8;
__device__ __forceinline__ int lds_byte(int r, int c) { const int st = (r >> 4) * 2 + (c >> 5), rr = r & 15, cc = c & 31, ob = rr * 64 + cc * 2; return st * 1024 + (ob ^ (((ob >> 9) & 1) << 5)); }
__device__ __forceinline__ void stage_rc(int b, int& R, int& C) { const int st = b / 1024, sb = b % 1024, swz = sb ^ (((sb >> 9) & 1) << 5); R = (st >> 1) * 16 + swz / 64; C = (st & 1) * 32 + (swz % 64) / 2; }
__device__ __forceinline__ int perm32(int rho) { const int n = rho >> 4, i = rho & 15; return 8 * (i >> 2) + 4 * n + (i & 3); }
__device__ __forceinline__ unsigned cvt_pk_bf16(float lo, float hi) { unsigned r; asm volatile("v_cvt_pk_bf16_f32 %0, %1, %2" : "=v"(r) : "v"(lo), "v"(hi)); return r; }

struct Unit { const char* a0; const char* a1; const char* b0; const char* b1; const int* rows; int row0, col0, e; };

struct SchedPlain {
    const char* A; const char* Bt; size_t hstepA, hstepB; int nM, nN, nwg, G, c;
    __device__ __forceinline__ void init(const void* A_, const void* Bt_, int M, int N, int K, int G_, int c_) { A = (const char*)A_; Bt = (const char*)Bt_; hstepA = (size_t)HALF * K * 2; hstepB = hstepA; nM = M / BM; nN = N / BM; nwg = nM * nN; G = G_; c = c_; }
    __device__ __forceinline__ bool next(int i, Unit& u) const {
        const long L = (long)i * G + c; if (L >= nwg) return false;
        int wgid = (int)L; { const int q = nwg / NXCD, r = nwg % NXCD, xcd = wgid % NXCD, off = wgid / NXCD; wgid = (xcd < r ? xcd * (q + 1) : r * (q + 1) + (xcd - r) * q) + off; }
        const int nig = WGM * nN, gid = wgid / nig, fm = gid * WGM, gsz = (nM - fm) < WGM ? (nM - fm) : WGM;
        const int pm = fm + ((wgid % nig) % gsz), pn = (wgid % nig) / gsz;
        u.a0 = A + (size_t)pm * 2 * hstepA; u.a1 = u.a0 + hstepA; u.b0 = Bt + (size_t)pn * 2 * hstepB; u.b1 = u.b0 + hstepB; u.rows = nullptr; u.row0 = pm * BM; u.col0 = pn * BM; u.e = 0;
        return true;
    }
};
struct SchedGU {
    const char* A; const char* W; const int* rowtok; const unsigned* texp; int ntiles, G, c;
    __device__ __forceinline__ bool next(int i, Unit& u) const {
        const int L = i * G + c, rt = L >> 3, pn = L & 7; if (rt >= ntiles) return false;
        const int e = (int)texp[rt];
        u.a0 = A; u.a1 = A; u.rows = rowtok + rt * BM; u.b0 = W + ((size_t)e * 2048 + pn * 128) * D; u.b1 = u.b0 + (size_t)1024 * D; u.row0 = rt * BM; u.col0 = pn * 128; u.e = e;
        return true;
    }
};
struct SchedDown {
    const char* A; const char* W; const unsigned* texp; int ntiles, G, c;
    __device__ __forceinline__ bool next(int i, Unit& u) const {
        const int L = i * G + c, rt = L >> 2, pn = L & 3; if (rt >= ntiles) return false;
        const int e = (int)texp[rt];
        u.a0 = A + (size_t)rt * BM * D; u.a1 = u.a0 + (size_t)HALF * D; u.rows = nullptr; u.b0 = W + ((size_t)e * 1024 + pn * BM) * D; u.b1 = u.b0 + (size_t)HALF * D; u.row0 = rt * BM; u.col0 = pn * BM; u.e = e;
        return true;
    }
};

struct EpiF32 {
    static constexpr bool PERM = false;
    float* C; int ldc; const float* bias; int bias_es;
    __device__ __forceinline__ void operator()(const f32x4 (&acc)[2][2][4][2], const Unit& u, int wr, int wc, int fr, int fq) const {
        const int row0 = u.row0 + wr * 64 + fr, col0 = u.col0 + wc * 32 + 4 * fq;
        f32x4 bv[2][2];
#pragma unroll
        for (int bj = 0; bj < 2; ++bj)
#pragma unroll
            for (int n = 0; n < 2; ++n) bv[bj][n] = bias ? *(const f32x4*)(bias + (size_t)u.e * bias_es + col0 + bj * HALF + n * 16) : (f32x4){0.f, 0.f, 0.f, 0.f};
#pragma unroll
        for (int ai = 0; ai < 2; ++ai)
#pragma unroll
            for (int m = 0; m < 4; ++m) { float* rowp = C + (size_t)(row0 + ai * HALF + m * 16) * ldc + col0;
#pragma unroll
                for (int bj = 0; bj < 2; ++bj)
#pragma unroll
                    for (int n = 0; n < 2; ++n) *(f32x4*)(rowp + bj * HALF + n * 16) = acc[ai][bj][m][n] + bv[bj][n]; }
    }
};
struct EpiBf16 {
    static constexpr bool PERM = true;
    bf16_t* O; int ldc; const float* bias; int bias_es; float scale;
    __device__ __forceinline__ void operator()(const f32x4 (&acc)[2][2][4][2], const Unit& u, int wr, int wc, int fr, int fq) const {
        const int row0 = u.row0 + wr * 64 + fr, col0 = u.col0 + wc * 32 + 8 * fq;
        f32x4 bv[2][2];
#pragma unroll
        for (int bj = 0; bj < 2; ++bj)
#pragma unroll
            for (int n = 0; n < 2; ++n) bv[bj][n] = bias ? *(const f32x4*)(bias + (size_t)u.e * bias_es + col0 + bj * HALF + 4 * n) : (f32x4){0.f, 0.f, 0.f, 0.f};
#pragma unroll
        for (int ai = 0; ai < 2; ++ai)
#pragma unroll
            for (int m = 0; m < 4; ++m) { bf16_t* rowp = O + (size_t)(row0 + ai * HALF + m * 16) * ldc + col0;
#pragma unroll
                for (int bj = 0; bj < 2; ++bj) { const f32x4 v0 = acc[ai][bj][m][0] * scale + bv[bj][0], v1 = acc[ai][bj][m][1] * scale + bv[bj][1];
                    u32x4 w; w.x = cvt_pk_bf16(v0[0], v0[1]); w.y = cvt_pk_bf16(v0[2], v0[3]); w.z = cvt_pk_bf16(v1[0], v1[1]); w.w = cvt_pk_bf16(v1[2], v1[3]);
                    *(u32x4*)(rowp + bj * HALF) = w; } }
    }
};
struct EpiSwiglu {
    static constexpr bool PERM = true;
    unsigned char* O; const float* bias; float scale;
    __device__ __forceinline__ void operator()(const f32x4 (&acc)[2][2][4][2], const Unit& u, int wr, int wc, int fr, int fq) const {
        const int row0 = u.row0 + wr * 64 + fr, hc = u.col0 + wc * 32 + 8 * fq;
        const float* bp = bias + (size_t)u.e * 2048 + hc;
        const f32x4 bg0 = *(const f32x4*)(bp), bg1 = *(const f32x4*)(bp + 4), bu0 = *(const f32x4*)(bp + 1024), bu1 = *(const f32x4*)(bp + 1028);
#pragma unroll
        for (int ai = 0; ai < 2; ++ai)
#pragma unroll
            for (int m = 0; m < 4; ++m) {
                const f32x4 g0 = acc[ai][0][m][0] * scale + bg0, g1 = acc[ai][0][m][1] * scale + bg1, u0 = acc[ai][1][m][0] * scale + bu0, u1 = acc[ai][1][m][1] * scale + bu1;
                u32x2 w; w.x = pk_fp8x4(swiglu(g0[0], u0[0]), swiglu(g0[1], u0[1]), swiglu(g0[2], u0[2]), swiglu(g0[3], u0[3]));
                w.y = pk_fp8x4(swiglu(g1[0], u1[0]), swiglu(g1[1], u1[1]), swiglu(g1[2], u1[2]), swiglu(g1[3], u1[3]));
                *(u32x2*)(O + (size_t)(row0 + ai * HALF + m * 16) * D + hc) = w;
            }
    }
};

typedef int i32x8 __attribute__((ext_vector_type(8)));
typedef int i32x4 __attribute__((ext_vector_type(4)));
template <class Epi, class Sched, bool GATHER, int ESZ = 2>
__device__ __forceinline__ void gemm_phase(LAS unsigned char* lds, const int K, const Sched& S, const Epi& E) {
    const int tid = tid_(), wid = __builtin_amdgcn_readfirstlane(tid >> 6), lane = tid & 63, wr = wid >> 2, wc = wid & 3, fr = lane & 15, fq = lane >> 4;
    const int nt = K * ESZ / 128, KP = K * ESZ;
    int sR[2], sC[2];
    unsigned voffB[2];
#pragma unroll
    for (int i = 0; i < 2; ++i) { stage_rc(tid * 16 + i * 8192, sR[i], sC[i]); const int Rb = Epi::PERM ? ((sR[i] & ~31) + perm32(sR[i] & 31)) : sR[i]; voffB[i] = (unsigned)(Rb * KP + sC[i] * 2); }
    unsigned cvA0[2], cvA1[2], nvA0[2], nvA1[2];
#define G8_VOFF(u, v0, v1) do { _Pragma("unroll") for (int _i = 0; _i < 2; ++_i) { \
        if (GATHER) { v0[_i] = (unsigned)((u).rows[sR[_i]] * KP + sC[_i] * 2); v1[_i] = (unsigned)((u).rows[HALF + sR[_i]] * KP + sC[_i] * 2); } \
        else { v0[_i] = (unsigned)(sR[_i] * KP + sC[_i] * 2); v1[_i] = v0[_i]; } } } while (0)
    const size_t kstep = (size_t)(BK * 2);
    const unsigned ldsw = (unsigned)wid * 1024u;
    const int aoff = lds_byte(wr * 64 + fr, fq * 8), boff = lds_byte(wc * 32 + fr, fq * 8);
#define PG8_SA(b, h) (((b) * 2 + (h)) * HTB)
#define PG8_SB(b, h) ((4 + (b) * 2 + (h)) * HTB)
#define PG8_STAGE(bufoff, gbase, voff) do { _Pragma("unroll") for (int _i = 0; _i < 2; ++_i) \
        __builtin_amdgcn_global_load_lds((const unsigned*)((const char*)(gbase) + (voff)[_i]), (LAS unsigned*)(lds + (bufoff) + ldsw + _i * 8192), 16, 0, 0); } while (0)
#define PG8_LDA(dst, b, h) do { _Pragma("unroll") for (int m = 0; m < 4; ++m) { dst[m].lo = *(const LAS i32x4*)(lds + PG8_SA(b, h) + aoff + m * 2048); dst[m].hi = *(const LAS i32x4*)(lds + PG8_SA(b, h) + aoff + m * 2048 + 1024); } } while (0)
#define PG8_LDB(dst, b, h) do { _Pragma("unroll") for (int n = 0; n < 2; ++n) { dst[n].lo = *(const LAS i32x4*)(lds + PG8_SB(b, h) + boff + n * 2048); dst[n].hi = *(const LAS i32x4*)(lds + PG8_SB(b, h) + boff + n * 2048 + 1024); } } while (0)
#define PG8_MMA(ai, bj, At, Bt) do { __builtin_amdgcn_s_setprio(1); _Pragma("unroll") for (int m = 0; m < 4; ++m) _Pragma("unroll") for (int n = 0; n < 2; ++n) { \
        if (ESZ == 2) { acc[ai][bj][m][n] = __builtin_amdgcn_mfma_f32_16x16x32_bf16(__builtin_bit_cast(bf16x8, (i32x4)__builtin_shufflevector(Bt[n], Bt[n], 0, 1, 2, 3)), __builtin_bit_cast(bf16x8, (i32x4)__builtin_shufflevector(At[m], At[m], 0, 1, 2, 3)), acc[ai][bj][m][n], 0, 0, 0); \
                        acc[ai][bj][m][n] = __builtin_amdgcn_mfma_f32_16x16x32_bf16(__builtin_bit_cast(bf16x8, (i32x4)__builtin_shufflevector(Bt[n], Bt[n], 4, 5, 6, 7)), __builtin_bit_cast(bf16x8, (i32x4)__builtin_shufflevector(At[m], At[m], 4, 5, 6, 7)), acc[ai][bj][m][n], 0, 0, 0); } \
        else asm volatile("v_mfma_f32_16x16x128_f8f6f4 %0, %1, %2, %0" : "+v"(acc[ai][bj][m][n]) : "v"(Bt[n]), "v"(At[m])); } __builtin_amdgcn_s_setprio(0); } while (0)
#define PG8_WAIT_V(n) asm volatile("s_waitcnt vmcnt(" #n ")" ::: "memory")
#define PG8_WAIT_L(n) asm volatile("s_waitcnt lgkmcnt(" #n ")" ::: "memory")
#define PG8_BAR __builtin_amdgcn_s_barrier()
#define PG8_SCHED __builtin_amdgcn_sched_barrier(0)
    Unit cur, nxt; int ui = 0;
    if (!S.next(0, cur)) return;
    f32x4 acc[2][2][4][2];
#pragma unroll
    for (int a = 0; a < 2; ++a)
#pragma unroll
        for (int b = 0; b < 2; ++b)
#pragma unroll
            for (int m = 0; m < 4; ++m)
#pragma unroll
                for (int n = 0; n < 2; ++n) acc[a][b][m][n] = (f32x4){0.f, 0.f, 0.f, 0.f};
    i32x8 At[4], B0[2], B1[2];
    const char* cA0 = cur.a0; const char* cA1 = cur.a1; const char* cB0 = cur.b0; const char* cB1 = cur.b1;
    G8_VOFF(cur, cvA0, cvA1);
    PG8_STAGE(PG8_SB(0, 0), cB0, voffB); PG8_STAGE(PG8_SB(0, 1), cB1, voffB); PG8_STAGE(PG8_SA(0, 0), cA0, cvA0); PG8_STAGE(PG8_SA(0, 1), cA1, cvA1);
    if (wr == 1) PG8_BAR;
    PG8_WAIT_V(2); PG8_BAR;
    PG8_STAGE(PG8_SB(1, 0), cB0 + kstep, voffB); PG8_STAGE(PG8_SA(1, 0), cA0 + kstep, cvA0); PG8_STAGE(PG8_SB(1, 1), cB1 + kstep, voffB);
    PG8_WAIT_V(6); PG8_BAR;
    for (;;) {
        const bool has_next = S.next(ui + 1, nxt);
        const char* nA0 = has_next ? nxt.a0 : cA0; const char* nA1 = has_next ? nxt.a1 : cA1; const char* nB0 = has_next ? nxt.b0 : cB0; const char* nB1 = has_next ? nxt.b1 : cB1;
        if (GATHER) { if (has_next) { G8_VOFF(nxt, nvA0, nvA1); } else { nvA0[0] = cvA0[0]; nvA0[1] = cvA0[1]; nvA1[0] = cvA1[0]; nvA1[1] = cvA1[1]; } }
#pragma unroll 1
        for (int t = 0; t < nt; t += 2) {
            const bool last = (t == nt - 2);
            const char* a1_1 = cA1 + (size_t)(t + 1) * kstep;
            const char* a2_0 = last ? nA0 : cA0 + (size_t)(t + 2) * kstep; const char* a2_1 = last ? nA1 : cA1 + (size_t)(t + 2) * kstep;
            const char* b2_0 = last ? nB0 : cB0 + (size_t)(t + 2) * kstep; const char* b2_1 = last ? nB1 : cB1 + (size_t)(t + 2) * kstep;
            const char* a3_0 = a2_0 + kstep; const char* b3_0 = b2_0 + kstep; const char* b3_1 = b2_1 + kstep;
            unsigned vA0[2], vA1[2];
            if (GATHER) { vA0[0] = last ? nvA0[0] : cvA0[0]; vA0[1] = last ? nvA0[1] : cvA0[1]; vA1[0] = last ? nvA1[0] : cvA1[0]; vA1[1] = last ? nvA1[1] : cvA1[1]; }
            else { vA0[0] = cvA0[0]; vA0[1] = cvA0[1]; vA1[0] = cvA0[0]; vA1[1] = cvA0[1]; }
            PG8_LDB(B0, 0, 0); PG8_LDB(B1, 0, 1); PG8_SCHED; PG8_LDA(At, 0, 0); PG8_STAGE(PG8_SA(1, 1), a1_1, cvA1);
            PG8_WAIT_V(8); PG8_WAIT_L(0); PG8_BAR; PG8_MMA(0, 0, At, B0); PG8_MMA(0, 1, At, B1); PG8_BAR; PG8_SCHED;
            PG8_LDA(At, 0, 1); PG8_STAGE(PG8_SB(0, 0), b2_0, voffB); PG8_STAGE(PG8_SB(0, 1), b2_1, voffB); PG8_STAGE(PG8_SA(0, 0), a2_0, vA0);
            PG8_WAIT_V(8); PG8_WAIT_L(0); PG8_BAR; PG8_MMA(1, 0, At, B0); PG8_MMA(1, 1, At, B1); PG8_BAR; PG8_SCHED;
            PG8_LDB(B0, 1, 0); PG8_LDB(B1, 1, 1); PG8_SCHED; PG8_LDA(At, 1, 0); PG8_STAGE(PG8_SA(0, 1), a2_1, vA1);
            PG8_WAIT_V(8); PG8_WAIT_L(0); PG8_BAR; PG8_MMA(0, 0, At, B0); PG8_MMA(0, 1, At, B1); PG8_BAR; PG8_SCHED;
            PG8_LDA(At, 1, 1); PG8_STAGE(PG8_SB(1, 0), b3_0, voffB); PG8_STAGE(PG8_SB(1, 1), b3_1, voffB); PG8_STAGE(PG8_SA(1, 0), a3_0, vA0);
            PG8_WAIT_V(8); PG8_WAIT_L(0); PG8_BAR; PG8_MMA(1, 0, At, B0); PG8_MMA(1, 1, At, B1); PG8_BAR; PG8_SCHED;
        }
        if (wr == 0) PG8_BAR;
        if (ESZ == 1) asm volatile("s_nop 15\n\ts_nop 15" ::: "memory");
        E(acc, cur, wr, wc, fr, fq);
        if (!has_next) break;
#pragma unroll
        for (int a = 0; a < 2; ++a)
#pragma unroll
            for (int b = 0; b < 2; ++b)
#pragma unroll
                for (int m = 0; m < 4; ++m)
#pragma unroll
                    for (int n = 0; n < 2; ++n) acc[a][b][m][n] = (f32x4){0.f, 0.f, 0.f, 0.f};
        cur = nxt; cA0 = nA0; cA1 = nA1; cB0 = nB0; cB1 = nB1; ++ui;
        if (GATHER) { cvA0[0] = nvA0[0]; cvA0[1] = nvA0[1]; cvA1[0] = nvA1[0]; cvA1[1] = nvA1[1]; }
        if (wr == 1) PG8_BAR;
    }
    PG8_WAIT_V(0);
    PG8_BAR;
#undef G8_VOFF
#undef PG8_SA
#undef PG8_SB
#undef PG8_STAGE
#undef PG8_LDA
#undef PG8_LDB
#undef PG8_MMA
#undef PG8_WAIT_V
#undef PG8_WAIT_L
#undef PG8_BAR
#undef PG8_SCHED
}
}


template <bool F8>
__device__ __forceinline__ void convert_big(LAS unsigned char* lds, const float* src, void* dstv, int K, int N, int batch, float scale) {
    const int tid = tid_(), lane = tid & 63, wid = tid >> 6;
    const int nbn = N / 256, per = (K / 128) * nbn, total = per * batch, G = (int)gridDim.x;
    constexpr int ESZ = F8 ? 1 : 2, ROWB = 128 * ESZ, TILEB = 256 * ROWB;
    f32x4 ra[16], rb[16];
#define CV_LOAD(uu, reg) do { const int bidx = (uu) / per, r_ = (uu) % per, kb = r_ / nbn, nb = r_ % nbn; \
        const float* sp = src + (size_t)bidx * K * N + (size_t)(kb * 128 + 16 * wid) * N + nb * 256 + 4 * lane; \
        _Pragma("unroll") for (int i = 0; i < 16; ++i) reg[i] = *(const f32x4*)(sp + (size_t)i * N); } while (0)
#define CV_PACK(reg, tl) do { _Pragma("unroll") for (int j = 0; j < 4; ++j) { \
        if (F8) { u32x4 w0; w0.x = pk_fp8x4(reg[0][j] * scale, reg[1][j] * scale, reg[2][j] * scale, reg[3][j] * scale); w0.y = pk_fp8x4(reg[4][j] * scale, reg[5][j] * scale, reg[6][j] * scale, reg[7][j] * scale); \
            w0.z = pk_fp8x4(reg[8][j] * scale, reg[9][j] * scale, reg[10][j] * scale, reg[11][j] * scale); w0.w = pk_fp8x4(reg[12][j] * scale, reg[13][j] * scale, reg[14][j] * scale, reg[15][j] * scale); \
            *(LAS u32x4*)((tl) + (4 * lane + j) * ROWB + ((wid ^ (lane & 7)) * 16)) = w0; } \
        else { u32x4 w0, w1; \
            w0.x = g8::cvt_pk_bf16(reg[0][j], reg[1][j]); w0.y = g8::cvt_pk_bf16(reg[2][j], reg[3][j]); w0.z = g8::cvt_pk_bf16(reg[4][j], reg[5][j]); w0.w = g8::cvt_pk_bf16(reg[6][j], reg[7][j]); \
            w1.x = g8::cvt_pk_bf16(reg[8][j], reg[9][j]); w1.y = g8::cvt_pk_bf16(reg[10][j], reg[11][j]); w1.z = g8::cvt_pk_bf16(reg[12][j], reg[13][j]); w1.w = g8::cvt_pk_bf16(reg[14][j], reg[15][j]); \
            *(LAS u32x4*)((tl) + (4 * lane + j) * ROWB + (((2 * wid) ^ (lane & 15)) * 16)) = w0; *(LAS u32x4*)((tl) + (4 * lane + j) * ROWB + (((2 * wid + 1) ^ (lane & 15)) * 16)) = w1; } } } while (0)
#define CV_STORE(uu, tl) do { const int bidx = (uu) / per, r_ = (uu) % per, kb = r_ / nbn, nb = r_ % nbn; \
        unsigned char* dp = (unsigned char*)dstv + ((size_t)bidx * N * K + (size_t)(nb * 256) * K + kb * 128) * ESZ; \
        _Pragma("unroll") for (int i = 0; i < 4 * ESZ; ++i) { const int pc = tid + NTHREADS * i, n = pc / (8 * ESZ), c = pc % (8 * ESZ); \
            *(u32x4*)(dp + (size_t)n * K * ESZ + c * 16) = *(const LAS u32x4*)((tl) + n * ROWB + ((c ^ ((n >> 2) & (8 * ESZ - 1))) * 16)); } } while (0)
    const int u0 = blockIdx.x;
    if (u0 < total) CV_LOAD(u0, ra);
    if (u0 + G < total) CV_LOAD(u0 + G, rb);
    for (int u = u0; u < total; u += 2 * G) {
        CV_PACK(ra, lds);
        if (u + 2 * G < total) CV_LOAD(u + 2 * G, ra);
        __syncthreads();
        CV_STORE(u, lds);
        const bool has_b = (u + G < total);
        if (has_b) { CV_PACK(rb, lds + TILEB); if (u + 3 * G < total) CV_LOAD(u + 3 * G, rb); }
        __syncthreads();
        if (has_b) CV_STORE(u + G, lds + TILEB);
    }
    __syncthreads();
#undef CV_LOAD
#undef CV_PACK
#undef CV_STORE
}

__device__ __forceinline__ float gelu_fast(float x) { const float u2 = 1.5957691216057308f * (x + 0.044715f * x * x * x); return x / (1.0f + __expf(-u2)); }
__device__ __forceinline__ void lru_gates_phase(LAS unsigned char* lds, const Params& p, int idx) {
    const int tid = tid_(), lane = tid & 63, wid = tid >> 6, fr = lane & 15, fq = lane >> 4;
    LAS bf16_t* xcb = (LAS bf16_t*)lds;
    LAS float* xcf = (LAS float*)(lds + 17408);
    LAS float* sa = (LAS float*)(lds + 17408 + 33792);
    LAS float* sb = sa + 64 * 132;
    LAS float* comb = sb + 64 * 132;
    const bf16_t* u = (const bf16_t*)(p.ws + WS_U);
    float* Aarr = (float*)(p.ws + WS_SCR); float* Barr = Aarr + (size_t)T * D;
    float* SP = (float*)(p.ws + WS_LSUM); float* SH = SP + NBATCH * 32 * D;
    const int hd = blockIdx.x & 7, slot = blockIdx.x >> 3, nslots = gridDim.x >> 3;
    const float* conv_w = p.a_conv_w + (size_t)idx * 4 * D; const float* conv_b = p.a_conv_b + (size_t)idx * D;
    const bf16_t* wrt = (const bf16_t*)(p.ws + WS_AGT) + ((size_t)(idx * 2 + 0) * 8 + hd) * 128 * 128;
    const bf16_t* wit = (const bf16_t*)(p.ws + WS_AGT) + ((size_t)(idx * 2 + 1) * 8 + hd) * 128 * 128;
    bf16x8 Br[4], Bi[4];
#pragma unroll
    for (int ks = 0; ks < 4; ++ks) { Br[ks] = *(const bf16x8*)(wrt + (size_t)(16 * wid + fr) * 128 + 32 * ks + 8 * fq); Bi[ks] = *(const bf16x8*)(wit + (size_t)(16 * wid + fr) * 128 + 32 * ks + 8 * fq); }
    const int cg = hd * 128 + 16 * wid + 4 * fq;
    const f32x4 brv = *(const f32x4*)(p.a_b_rgate + (size_t)idx * D + cg), biv = *(const f32x4*)(p.a_b_igate + (size_t)idx * D + cg), lmv = *(const f32x4*)(p.a_lambda + (size_t)idx * D + cg);
    f32x4 spv;
#pragma unroll
    for (int r = 0; r < 4; ++r) spv[r] = (lmv[r] > 15.f) ? __expf(-lmv[r]) : log1pf(__expf(-lmv[r]));
    const int cc = (tid & 31) * 4, cch = hd * 128 + cc;
    f32x4 cw[4];
#pragma unroll
    for (int j = 0; j < 4; ++j) cw[j] = *(const f32x4*)(conv_w + j * D + cch);
    const f32x4 cb = *(const f32x4*)(conv_b + cch);
    for (int tile = slot; tile < T / 64; tile += nslots) {
        const int t0 = tile * 64;
#pragma unroll
        for (int k = 0; k < 4; ++k) {
            const int tl = (tid >> 5) + 16 * k, t = t0 + tl, s_ = t & (SEQ - 1);
            f32x4 acc = cb;
#pragma unroll
            for (int j = 0; j < 4; ++j) {
                if (s_ - 3 + j >= 0) {
                    const u32x2 rv = *(const u32x2*)(u + (size_t)(t - 3 + j) * 2048 + 1024 + cch);
                    acc[0] += cw[j][0] * __uint_as_float(rv.x << 16); acc[1] += cw[j][1] * __uint_as_float(rv.x & 0xffff0000u);
                    acc[2] += cw[j][2] * __uint_as_float(rv.y << 16); acc[3] += cw[j][3] * __uint_as_float(rv.y & 0xffff0000u);
                }
            }
            *(LAS f32x4*)(xcf + tl * 132 + cc) = acc;
            u32x2 w; w.x = pack2(acc[0], acc[1]); w.y = pack2(acc[2], acc[3]);
            *(LAS u32x2*)(xcb + tl * 136 + cc) = w;
        }
        __syncthreads();
        f32x4 ar[4], ai[4];
#pragma unroll
        for (int mt = 0; mt < 4; ++mt) { ar[mt] = (f32x4){0.f, 0.f, 0.f, 0.f}; ai[mt] = (f32x4){0.f, 0.f, 0.f, 0.f}; }
#pragma unroll
        for (int ks = 0; ks < 4; ++ks)
#pragma unroll
            for (int mt = 0; mt < 4; ++mt) {
                const bf16x8 af = *(const LAS bf16x8*)(xcb + (mt * 16 + fr) * 136 + 32 * ks + 8 * fq);
                ar[mt] = __builtin_amdgcn_mfma_f32_16x16x32_bf16(Br[ks], af, ar[mt], 0, 0, 0);
                ai[mt] = __builtin_amdgcn_mfma_f32_16x16x32_bf16(Bi[ks], af, ai[mt], 0, 0, 0);
            }
#pragma unroll
        for (int mt = 0; mt < 4; ++mt) {
            const int tl = mt * 16 + fr, cl = 16 * wid + 4 * fq;
            const f32x4 rec = *(const LAS f32x4*)(xcf + tl * 132 + cl);
            f32x4 av, bv;
#pragma unroll
            for (int r = 0; r < 4; ++r) {
                const float rg = sigmoidf_(ar[mt][r] + brv[r]), ig = sigmoidf_(ai[mt][r] + biv[r]);
                const float log_a = -8.0f * rg * spv[r];
                av[r] = __expf(log_a);
                bv[r] = sqrtf(fmaxf(-expm1f(2.0f * log_a), 0.f)) * ig * rec[r];
            }
            *(f32x4*)(Aarr + (size_t)(t0 + tl) * D + cg) = av; *(f32x4*)(Barr + (size_t)(t0 + tl) * D + cg) = bv;
            *(LAS f32x4*)(sa + tl * 132 + cl) = av; *(LAS f32x4*)(sb + tl * 132 + cl) = bv;
        }
        __syncthreads();
        {
            const int j = tid & 127, q = tid >> 7;
            float P = 1.f, H = 0.f;
#pragma unroll
            for (int s_ = 0; s_ < 16; ++s_) { const float a = sa[(q * 16 + s_) * 132 + j], bb = sb[(q * 16 + s_) * 132 + j]; H = a * H + bb; P *= a; }
            comb[(q * 128 + j) * 2 + 0] = P; comb[(q * 128 + j) * 2 + 1] = H;
        }
        __syncthreads();
        if (tid < 128) {
            float P = comb[tid * 2], H = comb[tid * 2 + 1];
#pragma unroll
            for (int q = 1; q < 4; ++q) { const float Pq = comb[(q * 128 + tid) * 2], Hq = comb[(q * 128 + tid) * 2 + 1]; H = Pq * H + Hq; P *= Pq; }
            SP[(size_t)tile * D + hd * 128 + tid] = P; SH[(size_t)tile * D + hd * 128 + tid] = H;
        }
    }
}
__device__ __forceinline__ void lru_scan_phase(const Params& p) {
    const int tid = tid_();
    const bf16_t* u = (const bf16_t*)(p.ws + WS_U);
    const float* Aarr = (const float*)(p.ws + WS_SCR); const float* Barr = Aarr + (size_t)T * D;
    const float* SP = (const float*)(p.ws + WS_LSUM); const float* SH = SP + NBATCH * 32 * D;
    bf16_t* yin = (bf16_t*)(p.ws + WS_YIN);
    const int nunits = NBATCH * 32 * 2;
    for (int un = blockIdx.x; un < nunits; un += gridDim.x) {
        const int tile = un >> 1, c = (un & 1) * 512 + tid, b = tile >> 5, chunk = tile & 31;
        float h = 0.f;
        for (int k = 0; k < chunk; ++k) h = SP[(size_t)(b * 32 + k) * D + c] * h + SH[(size_t)(b * 32 + k) * D + c];
        const size_t tb = (size_t)tile * 64;
#pragma unroll 16
        for (int s_ = 0; s_ < 64; ++s_) {
            const size_t t = tb + s_;
            h = Aarr[t * D + c] * h + Barr[t * D + c];
            yin[t * D + c] = f2bf(gelu_fast(bf2f(u[t * 2048 + c])) * h);
        }
    }
}

typedef short s16x4 __attribute__((ext_vector_type(4)));
__device__ __forceinline__ s16x4 tr4(LAS const unsigned char* base, int row0, int col0, int stride, int lane) {
    const int q = (lane & 15) >> 2, pp = lane & 3;
    return __builtin_amdgcn_ds_read_tr16_b64_v4i16((LAS s16x4*)(base + (row0 + q) * stride + (col0 + 4 * pp) * 2));
}
__device__ __forceinline__ bf16x8 cat8(s16x4 a, s16x4 b) { return (bf16x8){a[0], a[1], a[2], a[3], b[0], b[1], b[2], b[3]}; }
__device__ __forceinline__ void ret_core_phase(LAS unsigned char* lds, const Params& p) {
    const int tid = tid_(), lane = tid & 63, wid = tid >> 6, fr = lane & 15, fq = lane >> 4;
    constexpr int KS = 544, VS = 160, SS = 528;
    LAS unsigned char* Kl = lds;
    LAS unsigned char* Vl = lds + 128 * KS;
    LAS unsigned char* Sl = Vl + 128 * VS;
    const bf16_t* u = (const bf16_t*)(p.ws + WS_U);
    float* RO = (float*)(p.ws + WS_SCR);
    for (int un = blockIdx.x; un < NBATCH * 4 * 8; un += gridDim.x) {
        const int b = un >> 5, h = (un >> 3) & 3, vs = un & 7;
        const float lg2 = log2f(1.0f - exp2f(-5.0f - (float)h));
        f32x4 Sacc[2][4];
#pragma unroll
        for (int dt = 0; dt < 2; ++dt)
#pragma unroll
            for (int vt = 0; vt < 4; ++vt) Sacc[dt][vt] = (f32x4){0.f, 0.f, 0.f, 0.f};
        for (int i = tid; i < 64 * SS / 16; i += NTHREADS) ((LAS u32x4*)Sl)[i] = (u32x4){0u, 0u, 0u, 0u};
        for (int chunk = 0; chunk < 16; ++chunk) {
            const size_t t0 = (size_t)b * SEQ + chunk * 128;
#pragma unroll
            for (int i = 0; i < 8; ++i) {
                const int piece = tid + NTHREADS * i, m = piece >> 5, ch = piece & 31;
                const u32x4 kv = *(const u32x4*)(u + (t0 + m) * 6144 + 1024 + h * 256 + ch * 8);
                const float sc = exp2f(-(float)(m + 1) * lg2) * 0.0625f;
                u32x4 w;
                w.x = pack2(__uint_as_float(kv.x << 16) * sc, __uint_as_float(kv.x & 0xffff0000u) * sc); w.y = pack2(__uint_as_float(kv.y << 16) * sc, __uint_as_float(kv.y & 0xffff0000u) * sc);
                w.z = pack2(__uint_as_float(kv.z << 16) * sc, __uint_as_float(kv.z & 0xffff0000u) * sc); w.w = pack2(__uint_as_float(kv.w << 16) * sc, __uint_as_float(kv.w & 0xffff0000u) * sc);
                *(LAS u32x4*)(Kl + m * KS + ch * 16) = w;
            }
#pragma unroll
            for (int i = 0; i < 2; ++i) {
                const int piece = tid + NTHREADS * i, m = piece >> 3, ch = piece & 7;
                *(LAS u32x4*)(Vl + m * VS + ch * 16) = *(const u32x4*)(u + (t0 + m) * 6144 + 2048 + h * 512 + vs * 64 + ch * 8);
            }
            bf16x8 Qf[8];
#pragma unroll
            for (int ks = 0; ks < 8; ++ks) Qf[ks] = *(const bf16x8*)(u + (t0 + 16 * wid + fr) * 6144 + h * 256 + 32 * ks + 8 * fq);
            __syncthreads();
            f32x4 sc[8];
#pragma unroll
            for (int mt = 0; mt < 8; ++mt) {
                sc[mt] = (f32x4){0.f, 0.f, 0.f, 0.f};
#pragma unroll
                for (int ks = 0; ks < 8; ++ks) {
                    const bf16x8 kf = *(const LAS bf16x8*)(Kl + (16 * mt + fr) * KS + (32 * ks + 8 * fq) * 2);
                    sc[mt] = __builtin_amdgcn_mfma_f32_16x16x32_bf16(kf, Qf[ks], sc[mt], 0, 0, 0);
                }
            }
            bf16x8 pf[4];
            const int nloc = 16 * wid + fr;
#pragma unroll
            for (int ks2 = 0; ks2 < 4; ++ks2) {
                float v[8];
#pragma unroll
                for (int t = 0; t < 2; ++t)
#pragma unroll
                    for (int r = 0; r < 4; ++r) { const int m = 32 * ks2 + 16 * t + 4 * fq + r; v[4 * t + r] = (m <= nloc) ? sc[2 * ks2 + t][r] : 0.f; }
                u32x4 w; w.x = pack2(v[0], v[1]); w.y = pack2(v[2], v[3]); w.z = pack2(v[4], v[5]); w.w = pack2(v[6], v[7]);
                pf[ks2] = __builtin_bit_cast(bf16x8, w);
            }
            f32x4 O[4];
#pragma unroll
            for (int vt = 0; vt < 4; ++vt) {
                O[vt] = (f32x4){0.f, 0.f, 0.f, 0.f};
#pragma unroll
                for (int ks2 = 0; ks2 < 4; ++ks2) {
                    const bf16x8 vf = cat8(tr4(Vl, 32 * ks2 + 4 * fq, 16 * vt, VS, lane), tr4(Vl, 32 * ks2 + 16 + 4 * fq, 16 * vt, VS, lane));
                    O[vt] = __builtin_amdgcn_mfma_f32_16x16x32_bf16(pf[ks2], vf, O[vt], 0, 0, 0);
                }
#pragma unroll
                for (int ks = 0; ks < 8; ++ks) {
                    const bf16x8 sf = *(const LAS bf16x8*)(Sl + (16 * vt + fr) * SS + (32 * ks + 8 * fq) * 2);
                    O[vt] = __builtin_amdgcn_mfma_f32_16x16x32_bf16(Qf[ks], sf, O[vt], 0, 0, 0);
                }
            }
#pragma unroll
            for (int r = 0; r < 4; ++r) {
                const int n = 16 * wid + 4 * fq + r;
                const float qd = exp2f((float)(n + 1) * lg2);
                float* op = RO + (t0 + n) * 2048 + h * 512 + vs * 64 + fr;
#pragma unroll
                for (int vt = 0; vt < 4; ++vt) op[16 * vt] = O[vt][r] * qd;
            }
#pragma unroll
            for (int ks3 = 0; ks3 < 4; ++ks3) {
                bf16x8 kt[2], vf[4];
#pragma unroll
                for (int dt = 0; dt < 2; ++dt) kt[dt] = cat8(tr4(Kl, 32 * ks3 + 8 * fq, 32 * wid + 16 * dt, KS, lane), tr4(Kl, 32 * ks3 + 8 * fq + 4, 32 * wid + 16 * dt, KS, lane));
#pragma unroll
                for (int vt = 0; vt < 4; ++vt) vf[vt] = cat8(tr4(Vl, 32 * ks3 + 8 * fq, 16 * vt, VS, lane), tr4(Vl, 32 * ks3 + 8 * fq + 4, 16 * vt, VS, lane));
#pragma unroll
                for (int dt = 0; dt < 2; ++dt)
#pragma unroll
                    for (int vt = 0; vt < 4; ++vt) Sacc[dt][vt] = __builtin_amdgcn_mfma_f32_16x16x32_bf16(kt[dt], vf[vt], Sacc[dt][vt], 0, 0, 0);
            }
            __syncthreads();
            const float cd = exp2f(128.0f * lg2);
#pragma unroll
            for (int dt = 0; dt < 2; ++dt)
#pragma unroll
                for (int vt = 0; vt < 4; ++vt) {
                    Sacc[dt][vt] *= cd;
                    u32x2 w; w.x = pack2(Sacc[dt][vt][0], Sacc[dt][vt][1]); w.y = pack2(Sacc[dt][vt][2], Sacc[dt][vt][3]);
                    *(LAS u32x2*)(Sl + (16 * vt + fr) * SS + (32 * wid + 16 * dt + 4 * fq) * 2) = w;
                }
        }
        __syncthreads();
    }
}
__device__ __forceinline__ void ret_norm_phase(LAS unsigned char* lds, const Params& p) {
    const int tid = tid_(), lane = tid & 63, wid = tid >> 6;
    LAS float* red = (LAS float*)lds;
    const bf16_t* u = (const bf16_t*)(p.ws + WS_U);
    const float* RO = (const float*)(p.ws + WS_SCR);
    bf16_t* yin = (bf16_t*)(p.ws + WS_YIN);
    for (int t = blockIdx.x; t < T; t += gridDim.x) {
        const f32x4 o = *(const f32x4*)(RO + (size_t)t * 2048 + tid * 4);
        const float ss = wave_sum(o[0] * o[0] + o[1] * o[1] + o[2] * o[2] + o[3] * o[3]);
        if (lane == 0) red[wid] = ss;
        __syncthreads();
        const float tot = red[(wid & ~1)] + red[(wid | 1)];
        const float rstd = rsqrtf(tot * (1.0f / 512.0f) + 1e-6f);
        const u32x2 gv = *(const u32x2*)(u + (size_t)t * 6144 + 4096 + tid * 4);
        const float g0 = __uint_as_float(gv.x << 16), g1 = __uint_as_float(gv.x & 0xffff0000u), g2 = __uint_as_float(gv.y << 16), g3 = __uint_as_float(gv.y & 0xffff0000u);
        u32x2 w; w.x = pack2(g0 * sigmoidf_(g0) * o[0] * rstd, g1 * sigmoidf_(g1) * o[1] * rstd); w.y = pack2(g2 * sigmoidf_(g2) * o[2] * rstd, g3 * sigmoidf_(g3) * o[3] * rstd);
        *(u32x2*)(yin + (size_t)t * 2048 + tid * 4) = w;
        __syncthreads();
    }
}

__device__ __forceinline__ void attn_core_phase(LAS unsigned char* lds, const Params& p) {
    const int tid = tid_(), lane = tid & 63, wid = tid >> 6, fr = lane & 15, fq = lane >> 4;
    constexpr int RS = 144, TILE = 272 * RS;
    LAS unsigned char* Kl = lds;
    LAS unsigned char* Vl = lds + TILE;
    const bf16_t* u = (const bf16_t*)(p.ws + WS_U);
    bf16_t* OP = (bf16_t*)(p.ws + WS_SCR);
    float* LSE = (float*)(p.ws + WS_SCR + 96 * MB);
    for (int i = tid; i < 16 * RS / 16; i += NTHREADS) { ((LAS u32x4*)(Kl + 256 * RS))[i] = (u32x4){0u, 0u, 0u, 0u}; ((LAS u32x4*)(Vl + 256 * RS))[i] = (u32x4){0u, 0u, 0u, 0u}; }
    for (int un = blockIdx.x; un < 3 * 2048; un += gridDim.x) {
        const int g = un >> 11, rem = un & 2047, b = rem >> 8, h = (rem >> 4) & 15, x = rem & 15;
        const int dl = (g == 0) ? 1 : (g == 1 ? 4 : 16), r_ = x & (dl - 1), n = x / dl;
        const float slope = exp2f(-0.5f * (float)(h + 1)) * (float)dl;
        const bf16_t* ub = u + (size_t)b * SEQ * 9216;
#pragma unroll
        for (int i = 0; i < 4; ++i) {
            const int piece = tid + NTHREADS * i, row = piece >> 3, ch = piece & 7;
            const int sk = ((n - 1) * 128 + row) * dl + r_;
            u32x4 kv = (u32x4){0u, 0u, 0u, 0u}, vv = (u32x4){0u, 0u, 0u, 0u};
            if (sk >= 0) { const bf16_t* src = ub + (size_t)sk * 9216 + h * 64 + ch * 8; kv = *(const u32x4*)(src + (3 + g) * 1024); vv = *(const u32x4*)(src + (6 + g) * 1024); }
            *(LAS u32x4*)(Kl + row * RS + ch * 16) = kv; *(LAS u32x4*)(Vl + row * RS + ch * 16) = vv;
        }
        const int qi = 16 * wid + fr, sq = (n * 128 + qi) * dl + r_;
        bf16x8 Qf[2];
#pragma unroll
        for (int ks = 0; ks < 2; ++ks) Qf[ks] = *(const bf16x8*)(ub + (size_t)sq * 9216 + g * 1024 + h * 64 + 32 * ks + 8 * fq);
        __syncthreads();
        f32x4 sc[9];
        float mx = -INFINITY;
#pragma unroll
        for (int kt = 0; kt < 9; ++kt) {
            sc[kt] = (f32x4){0.f, 0.f, 0.f, 0.f};
#pragma unroll
            for (int ks = 0; ks < 2; ++ks) {
                const bf16x8 kf = *(const LAS bf16x8*)(Kl + (16 * (wid + kt) + fr) * RS + (32 * ks + 8 * fq) * 2);
                sc[kt] = __builtin_amdgcn_mfma_f32_16x16x32_bf16(kf, Qf[ks], sc[kt], 0, 0, 0);
            }
#pragma unroll
            for (int r = 0; r < 4; ++r) {
                const int ki = 16 * (wid + kt) + 4 * fq + r, steps = qi + 128 - ki;
                const bool ok = (steps >= 0) && (steps <= 128) && (n > 0 || ki >= 128);
                const float v = ok ? sc[kt][r] * 0.125f - slope * (float)steps : -INFINITY;
                sc[kt][r] = v; mx = fmaxf(mx, v);
            }
        }
        mx = fmaxf(mx, __shfl_xor(mx, 16)); mx = fmaxf(mx, __shfl_xor(mx, 32));
        float l = 0.f;
#pragma unroll
        for (int kt = 0; kt < 9; ++kt)
#pragma unroll
            for (int r = 0; r < 4; ++r) { const float pv = __expf(sc[kt][r] - mx); sc[kt][r] = pv; l += pv; }
        l += __shfl_xor(l, 16); l += __shfl_xor(l, 32);
        f32x4 O[4];
#pragma unroll
        for (int dt = 0; dt < 4; ++dt) O[dt] = (f32x4){0.f, 0.f, 0.f, 0.f};
#pragma unroll
        for (int ks5 = 0; ks5 < 5; ++ks5) {
            const f32x4 p0 = sc[2 * ks5], p1 = (ks5 < 4) ? sc[(ks5 < 4) ? 2 * ks5 + 1 : 0] : (f32x4){0.f, 0.f, 0.f, 0.f};
            u32x4 w; w.x = pack2(p0[0], p0[1]); w.y = pack2(p0[2], p0[3]); w.z = pack2(p1[0], p1[1]); w.w = pack2(p1[2], p1[3]);
            const bf16x8 pf = __builtin_bit_cast(bf16x8, w);
#pragma unroll
            for (int dt = 0; dt < 4; ++dt) {
                const bf16x8 vf = cat8(tr4(Vl, 16 * (wid + 2 * ks5) + 4 * fq, 16 * dt, RS, lane), tr4(Vl, 16 * (wid + 2 * ks5 + 1) + 4 * fq, 16 * dt, RS, lane));
                O[dt] = __builtin_amdgcn_mfma_f32_16x16x32_bf16(vf, pf, O[dt], 0, 0, 0);
            }
        }
        const float inv = 1.0f / l;
        const size_t tq = (size_t)b * SEQ + sq;
#pragma unroll
        for (int dt = 0; dt < 4; ++dt) {
            u32x2 w; w.x = pack2(O[dt][0] * inv, O[dt][1] * inv); w.y = pack2(O[dt][2] * inv, O[dt][3] * inv);
            *(u32x2*)(OP + ((size_t)g * T + tq) * D + h * 64 + 16 * dt + 4 * fq) = w;
        }
        if (fq == 0) LSE[((size_t)g * T + tq) * 16 + h] = mx + __logf(l);
        __syncthreads();
    }
}
__device__ __forceinline__ void attn_merge_phase(const Params& p) {
    const int tid = tid_();
    const bf16_t* OP = (const bf16_t*)(p.ws + WS_SCR);
    const float* LSE = (const float*)(p.ws + WS_SCR + 96 * MB);
    bf16_t* yin = (bf16_t*)(p.ws + WS_YIN);
    for (size_t i = (size_t)blockIdx.x * NTHREADS + tid; i < (size_t)T * D / 8; i += (size_t)gridDim.x * NTHREADS) {
        const size_t t = i >> 7; const int c8 = (int)(i & 127), h = c8 >> 3;
        const float l0 = LSE[t * 16 + h], l1 = LSE[((size_t)T + t) * 16 + h], l2 = LSE[((size_t)2 * T + t) * 16 + h];
        const float m = fmaxf(l0, fmaxf(l1, l2));
        float w0 = __expf(l0 - m), w1 = __expf(l1 - m), w2 = __expf(l2 - m);
        const float inv = 1.0f / (w0 + w1 + w2); w0 *= inv; w1 *= inv; w2 *= inv;
        const u32x4 a = *(const u32x4*)(OP + t * D + c8 * 8), bq = *(const u32x4*)(OP + ((size_t)T + t) * D + c8 * 8), c = *(const u32x4*)(OP + ((size_t)2 * T + t) * D + c8 * 8);
        u32x4 o;
#define MRG(f) o.f = pack2(w0 * __uint_as_float(a.f << 16) + w1 * __uint_as_float(bq.f << 16) + w2 * __uint_as_float(c.f << 16), \
                           w0 * __uint_as_float(a.f & 0xffff0000u) + w1 * __uint_as_float(bq.f & 0xffff0000u) + w2 * __uint_as_float(c.f & 0xffff0000u))
        MRG(x); MRG(y); MRG(z); MRG(w);
#undef MRG
        *(u32x4*)(yin + t * D + c8 * 8) = o;
    }
}

__device__ __forceinline__ void ln1_router_phase(LAS unsigned char* lds, const Params& p, int layer) {
    const int tid = tid_(), lane = tid & 63, wid = tid >> 6, fr = lane & 15, fq = lane >> 4;
    constexpr int XS = 2064;
    LAS unsigned char* xh = lds;
    LAS unsigned char* xl = lds + 16 * XS;
    LAS float* part = (LAS float*)(lds + 32 * XS);
    LAS float* logit = part + 8 * 16 * 32;
    float* xf = (float*)(p.ws + WS_XF); bf16_t* xb = (bf16_t*)(p.ws + WS_XB);
    const float* ymix = (const float*)(p.ws + WS_YMIX);
    int* tope = (int*)(p.ws + WS_TOPE); float* gates = (float*)(p.ws + WS_GATES); int* pos = (int*)(p.ws + WS_POS);
    unsigned char* xq = p.ws + WS_XQ;
    unsigned* ctl = (unsigned*)(p.ws + WS_CTL);
    const float* gain = p.ln_gain + (size_t)(layer * 2) * D; const float* bias = p.ln_bias + (size_t)(layer * 2) * D;
    const float* brt = p.moe_b_router + (size_t)layer * NEXP;
    const bf16_t* rth = (const bf16_t*)(p.ws + WS_RT) + (size_t)layer * 2 * NEXP * D; const bf16_t* rtl = rth + NEXP * D;
    bf16x8 Wh[2][4], Wl[2][4];
#pragma unroll
    for (int nt = 0; nt < 2; ++nt)
#pragma unroll
        for (int ks = 0; ks < 4; ++ks) { const size_t o = (size_t)(16 * nt + fr) * D + 128 * wid + 32 * ks + 8 * fq; Wh[nt][ks] = *(const bf16x8*)(rth + o); Wl[nt][ks] = *(const bf16x8*)(rtl + o); }
    for (int tile = blockIdx.x; tile < T / 16; tile += gridDim.x) {
#pragma unroll
        for (int tt = 0; tt < 2; ++tt) {
            const int trow = 2 * wid + tt; const size_t t = (size_t)tile * 16 + trow;
            f32x4 z[4];
#pragma unroll
            for (int i = 0; i < 4; ++i) { const int c = 256 * i + 4 * lane; z[i] = DN_ALPHA * *(const f32x4*)(xf + t * D + c) + *(const f32x4*)(ymix + t * D + c); }
            float sm = 0.f;
#pragma unroll
            for (int i = 0; i < 4; ++i) sm += (z[i][0] + z[i][1]) + (z[i][2] + z[i][3]);
            const float mean = wave_sum(sm) * (1.0f / D);
            float sq = 0.f;
#pragma unroll
            for (int i = 0; i < 4; ++i) { const f32x4 dd = z[i] - mean; sq += (dd[0] * dd[0] + dd[1] * dd[1]) + (dd[2] * dd[2] + dd[3] * dd[3]); }
            const float rstd = rsqrtf(wave_sum(sq) * (1.0f / D) + LN_EPS);
#pragma unroll
            for (int i = 0; i < 4; ++i) {
                const int c = 256 * i + 4 * lane;
                const f32x4 v = (z[i] - mean) * rstd * *(const f32x4*)(gain + c) + *(const f32x4*)(bias + c);
                *(f32x4*)(xf + t * D + c) = v;
                u32x2 wh; wh.x = pack2(v[0], v[1]); wh.y = pack2(v[2], v[3]);
                *(u32x2*)(xb + t * D + c) = wh;
                *(unsigned*)(xq + t * D + c) = pk_fp8x4(v[0], v[1], v[2], v[3]);
                const float r0 = v[0] - __uint_as_float(wh.x << 16), r1 = v[1] - __uint_as_float(wh.x & 0xffff0000u), r2 = v[2] - __uint_as_float(wh.y << 16), r3 = v[3] - __uint_as_float(wh.y & 0xffff0000u);
                u32x2 wl; wl.x = pack2(r0, r1); wl.y = pack2(r2, r3);
                *(LAS u32x2*)(xh + trow * XS + c * 2) = wh; *(LAS u32x2*)(xl + trow * XS + c * 2) = wl;
            }
        }
        __syncthreads();
        {
            f32x4 acc[2] = {(f32x4){0.f, 0.f, 0.f, 0.f}, (f32x4){0.f, 0.f, 0.f, 0.f}};
#pragma unroll
            for (int ks = 0; ks < 4; ++ks) {
                const bf16x8 ah = *(const LAS bf16x8*)(xh + fr * XS + (128 * wid + 32 * ks + 8 * fq) * 2), al = *(const LAS bf16x8*)(xl + fr * XS + (128 * wid + 32 * ks + 8 * fq) * 2);
#pragma unroll
                for (int nt = 0; nt < 2; ++nt) {
                    acc[nt] = __builtin_amdgcn_mfma_f32_16x16x32_bf16(Wh[nt][ks], ah, acc[nt], 0, 0, 0);
                    acc[nt] = __builtin_amdgcn_mfma_f32_16x16x32_bf16(Wh[nt][ks], al, acc[nt], 0, 0, 0);
                    acc[nt] = __builtin_amdgcn_mfma_f32_16x16x32_bf16(Wl[nt][ks], ah, acc[nt], 0, 0, 0);
                }
            }
#pragma unroll
            for (int nt = 0; nt < 2; ++nt) *(LAS f32x4*)(part + (wid * 16 + fr) * 32 + 16 * nt + 4 * fq) = acc[nt];
        }
        __syncthreads();
        {
            const int tk = tid >> 5, e = tid & 31;
            float sacc = brt[e];
#pragma unroll
            for (int w = 0; w < 8; ++w) sacc += part[(w * 16 + tk) * 32 + e];
            logit[tk * 32 + e] = sacc;
        }
        __syncthreads();
        if (tid < 16) {
            const size_t t = (size_t)tile * 16 + tid;
            float v0 = -INFINITY, v1 = -INFINITY, v2 = -INFINITY, v3 = -INFINITY; int i0 = 0, i1 = 0, i2 = 0, i3 = 0;
#pragma unroll
            for (int e = 0; e < NEXP; ++e) {
                const float v = logit[tid * 32 + e];
                if (v > v3) {
                    if (v > v0) { v3 = v2; i3 = i2; v2 = v1; i2 = i1; v1 = v0; i1 = i0; v0 = v; i0 = e; }
                    else if (v > v1) { v3 = v2; i3 = i2; v2 = v1; i2 = i1; v1 = v; i1 = e; }
                    else if (v > v2) { v3 = v2; i3 = i2; v2 = v; i2 = e; }
                    else { v3 = v; i3 = e; }
                }
            }
            const float e1 = __expf(v1 - v0), e2 = __expf(v2 - v0), e3 = __expf(v3 - v0), inv = 1.0f / (1.0f + e1 + e2 + e3);
            tope[t * 4 + 0] = i0; tope[t * 4 + 1] = i1; tope[t * 4 + 2] = i2; tope[t * 4 + 3] = i3;
            gates[t * 4 + 0] = inv; gates[t * 4 + 1] = e1 * inv; gates[t * 4 + 2] = e2 * inv; gates[t * 4 + 3] = e3 * inv;
            pos[t * 4 + 0] = (int)atomicAdd(ctl + CW_CNT + layer * 64 + i0, 1u); pos[t * 4 + 1] = (int)atomicAdd(ctl + CW_CNT + layer * 64 + i1, 1u);
            pos[t * 4 + 2] = (int)atomicAdd(ctl + CW_CNT + layer * 64 + i2, 1u); pos[t * 4 + 3] = (int)atomicAdd(ctl + CW_CNT + layer * 64 + i3, 1u);
        }
    }
    __syncthreads();
}
__device__ __forceinline__ void ln2_phase(const Params& p, int layer) {
    const int tid = tid_(), lane = tid & 63, wid = tid >> 6;
    float* xf = (float*)(p.ws + WS_XF); bf16_t* xb = (bf16_t*)(p.ws + WS_XB);
    const bf16_t* yrows = (const bf16_t*)(p.ws + WS_YROWS);
    const float* gates = (const float*)(p.ws + WS_GATES); const int* dest = (const int*)(p.ws + WS_DEST);
    const float* gain = p.ln_gain + (size_t)(layer * 2 + 1) * D; const float* bias = p.ln_bias + (size_t)(layer * 2 + 1) * D;
    for (int t = blockIdx.x * 8 + wid; t < T; t += gridDim.x * 8) {
        f32x4 z[4];
        int dk[4]; float gk[4];
#pragma unroll
        for (int k = 0; k < 4; ++k) { dk[k] = dest[t * 4 + k]; gk[k] = gates[t * 4 + k]; }
#pragma unroll
        for (int i = 0; i < 4; ++i) {
            const int c = 256 * i + 4 * lane;
            f32x4 f = (f32x4){0.f, 0.f, 0.f, 0.f};
#pragma unroll
            for (int k = 0; k < 4; ++k) { const u32x2 yv = *(const u32x2*)(yrows + (size_t)dk[k] * D + c);
                f[0] += gk[k] * __uint_as_float(yv.x << 16); f[1] += gk[k] * __uint_as_float(yv.x & 0xffff0000u); f[2] += gk[k] * __uint_as_float(yv.y << 16); f[3] += gk[k] * __uint_as_float(yv.y & 0xffff0000u); }
            z[i] = DN_ALPHA * *(const f32x4*)(xf + (size_t)t * D + c) + f;
        }
        float sm = 0.f;
#pragma unroll
        for (int i = 0; i < 4; ++i) sm += (z[i][0] + z[i][1]) + (z[i][2] + z[i][3]);
        const float mean = wave_sum(sm) * (1.0f / D);
        float sq = 0.f;
#pragma unroll
        for (int i = 0; i < 4; ++i) { const f32x4 dd = z[i] - mean; sq += (dd[0] * dd[0] + dd[1] * dd[1]) + (dd[2] * dd[2] + dd[3] * dd[3]); }
        const float rstd = rsqrtf(wave_sum(sq) * (1.0f / D) + LN_EPS);
#pragma unroll
        for (int i = 0; i < 4; ++i) {
            const int c = 256 * i + 4 * lane;
            z[i] = (z[i] - mean) * rstd * *(const f32x4*)(gain + c) + *(const f32x4*)(bias + c);
            if (layer == DEPTH - 1) *(f32x4*)(p.out + (size_t)t * D + c) = z[i];
            else { *(f32x4*)(xf + (size_t)t * D + c) = z[i]; u32x2 w; w.x = pack2(z[i][0], z[i][1]); w.y = pack2(z[i][2], z[i][3]); *(u32x2*)(xb + (size_t)t * D + c) = w; }
        }
    }
}

__device__ __forceinline__ void moe_scatter_phase(LAS unsigned char* lds, const Params& p, int layer) {
    const int tid = tid_();
    LAS int* pstart = (LAS int*)lds;
    unsigned* ctl = (unsigned*)(p.ws + WS_CTL);
    const int* tope = (const int*)(p.ws + WS_TOPE); const int* pos = (const int*)(p.ws + WS_POS);
    int* dest = (int*)(p.ws + WS_DEST); int* rowtok = (int*)(p.ws + WS_ROWTOK);
    if (tid == 0) {
        int acc = 0;
        for (int e = 0; e < NEXP; ++e) { const int c = (int)ctl[CW_CNT + layer * 64 + e]; pstart[e] = acc; pstart[32 + e] = c; acc += ((c + 255) >> 8) << 8; }
        pstart[64] = acc;
        if (blockIdx.x == 0) {
            ctl[CW_MDYN + layer * 64] = (unsigned)acc;
            for (int e = 0; e < NEXP; ++e) { const int nb = (pstart[32 + e] + 255) >> 8; for (int b = 0; b < nb; ++b) ctl[CW_TEXP + layer * 512 + (pstart[e] >> 8) + b] = (unsigned)e; }
        }
    }
    __syncthreads();
    for (int i = blockIdx.x * NTHREADS + tid; i < T * TOPK; i += gridDim.x * NTHREADS) {
        const int e = tope[i], row = pstart[e] + pos[i];
        dest[i] = row; rowtok[row] = i >> 2;
    }
    for (int i = blockIdx.x * NTHREADS + tid; i < NEXP * 256; i += gridDim.x * NTHREADS) {
        const int e = i >> 8, r = i & 255, c = pstart[32 + e], padded = ((c + 255) >> 8) << 8;
        if (c + r < padded) rowtok[pstart[e] + c + r] = 0;
    }
    __syncthreads();
}

constexpr int PH_PER_LAYER = 9;
constexpr int NPHASES = 1 + DEPTH * PH_PER_LAYER;
constexpr int LDS_BYTES = 132 * 1024;


#ifndef PHMASK
#define PHMASK 0x3FF
#endif
#define PHK(j) ((PHMASK >> (j)) & 1)
#ifndef PROBE_MASK
#define PROBE_MASK 0
#endif
#define REPS(j) ((((PROBE_MASK) >> (j)) & 1) ? 2 : 1)
#define IN(k) (lo <= (k) && (k) < hi)
#if MK_ONE_LAUNCH
#define SEAM(k) do { if (IN(k) && IN((k) + 1)) xcd_barrier_nv(bar.bar, bar.x, bar.st); } while (0)
#else
#define SEAM(k) do {} while (0)
#endif
template <int layer>
__device__ __forceinline__ void run_layer(const Params& p, LAS unsigned char* lds, const XcdBarrier& bar) {
    const int lo = p.ph_lo, hi = p.ph_hi;
    unsigned char* ws = p.ws;
    unsigned* ctl = (unsigned*)(ws + WS_CTL);
        constexpr int base = 1 + layer * PH_PER_LAYER, kind = layer % 3, idx = layer / 3;
        for (int rep_ = 0; rep_ < REPS(1); ++rep_) if (PHK(1) && IN(base + 0)) {
            constexpr int N = (kind == 0) ? 2048 : (kind == 1 ? 6144 : 9216);
            const bf16_t* Bt = (kind == 0) ? (const bf16_t*)(ws + WS_AWIN) + (size_t)idx * 2048 * D : (kind == 1 ? (const bf16_t*)(ws + WS_BWIN) : (const bf16_t*)(ws + WS_CWIN));
            g8::SchedPlain S; S.init(ws + WS_XB, Bt, T, N, D, (int)gridDim.x, (int)blockIdx.x);
            g8::EpiBf16 E{(bf16_t*)(ws + WS_U), N, nullptr, 0, 1.0f};
            g8::gemm_phase<g8::EpiBf16, g8::SchedPlain, false>(lds, D, S, E);
        }
        SEAM(base + 0);
        for (int rep_ = 0; rep_ < REPS(2); ++rep_) if (PHK(2) && IN(base + 1)) {
            if (kind == 0) lru_gates_phase(lds, p, idx);
            else if (kind == 1) ret_core_phase(lds, p);
            else attn_core_phase(lds, p);
        }
        SEAM(base + 1);
        for (int rep_ = 0; rep_ < REPS(3); ++rep_) if (PHK(3) && IN(base + 2)) {
            if (kind == 0) lru_scan_phase(p);
            else if (kind == 1) ret_norm_phase(lds, p);
            else attn_merge_phase(p);
        }
        SEAM(base + 2);
        for (int rep_ = 0; rep_ < REPS(4); ++rep_) if (PHK(4) && IN(base + 3)) {
            constexpr int K = (kind == 1) ? 2048 : D;
            const bf16_t* Bt = (kind == 0) ? (const bf16_t*)(ws + WS_AWOUT) + (size_t)idx * D * D : (kind == 1 ? (const bf16_t*)(ws + WS_BWOUT) : (const bf16_t*)(ws + WS_CWOUT));
            g8::SchedPlain S; S.init(ws + WS_YIN, Bt, T, D, K, (int)gridDim.x, (int)blockIdx.x);
            g8::EpiF32 E{(float*)(ws + WS_YMIX), D, nullptr, 0};
            g8::gemm_phase<g8::EpiF32, g8::SchedPlain, false>(lds, K, S, E);
        }
        SEAM(base + 3);
        for (int rep_ = 0; rep_ < REPS(5); ++rep_) if (PHK(5) && IN(base + 4)) ln1_router_phase(lds, p, layer);
        SEAM(base + 4);
        for (int rep_ = 0; rep_ < REPS(6); ++rep_) if (PHK(6) && IN(base + 5)) moe_scatter_phase(lds, p, layer);
        SEAM(base + 5);
        for (int rep_ = 0; rep_ < REPS(7); ++rep_) if (PHK(7) && IN(base + 6)) {
            g8::SchedGU S{(const char*)(ws + WS_XQ), (const char*)(ws + WS_GU) + (size_t)layer * NEXP * 2048 * D, (const int*)(ws + WS_ROWTOK), ctl + CW_TEXP + layer * 512,
                          (int)(ctl[CW_MDYN + layer * 64] >> 8), (int)gridDim.x, (int)blockIdx.x};
            g8::EpiSwiglu E{ws + WS_HID, p.moe_b_gu + (size_t)layer * NEXP * 2048, 1.0f / GU_WSCALE};
            g8::gemm_phase<g8::EpiSwiglu, g8::SchedGU, true, 1>(lds, D, S, E);
        }
        SEAM(base + 6);
        for (int rep_ = 0; rep_ < REPS(8); ++rep_) if (PHK(8) && IN(base + 7)) {
            g8::SchedDown S{(const char*)(ws + WS_HID), (const char*)(ws + WS_DN) + (size_t)layer * NEXP * D * D, ctl + CW_TEXP + layer * 512,
                            (int)(ctl[CW_MDYN + layer * 64] >> 8), (int)gridDim.x, (int)blockIdx.x};
            g8::EpiBf16 E{(bf16_t*)(ws + WS_YROWS), D, p.moe_b_down + (size_t)layer * NEXP * D, D, 1.0f / DN_WSCALE};
            g8::gemm_phase<g8::EpiBf16, g8::SchedDown, false, 1>(lds, D, S, E);
        }
        SEAM(base + 7);
        for (int rep_ = 0; rep_ < REPS(9); ++rep_) if (PHK(9) && IN(base + 8)) ln2_phase(p, layer);
        SEAM(base + 8);
    }
#undef IN
#undef SEAM
__global__ void __launch_bounds__(NTHREADS, 2) fwd_kernel(Params p) {
    extern __shared__ __attribute__((aligned(16))) unsigned char lds_raw[];
    LAS unsigned char* lds = (LAS unsigned char*)lds_raw;
    const int lo = p.ph_lo, hi = p.ph_hi;
    unsigned char* ws = p.ws;
    unsigned* ctl = (unsigned*)(ws + WS_CTL);
#if MK_ONE_LAUNCH
    volatile LAS unsigned* bst = (volatile LAS unsigned*)(lds + LDS_BYTES - 16);
    if (threadIdx.x == 0) { bst[0] = 0u; bst[1] = 0u; bst[2] = 0u; bst[3] = 0u; }
    __syncthreads();
    XcdBarrier bar = xcd_barrier_post(ctl, bst);
#define GRID_BAR() xcd_barrier_nv(bar.bar, bar.x, bar.st)
#else
    XcdBarrier bar; bar.bar = ctl; bar.x = 0; bar.st = nullptr;
#define GRID_BAR() do {} while (0)
#endif
#define IN(k) (lo <= (k) && (k) < hi)
#define SEAM(k) do { if (IN(k) && IN((k) + 1)) GRID_BAR(); } while (0)

    for (int rep_ = 0; rep_ < REPS(0); ++rep_) if (PHK(0) && IN(0)) {
        LAS float* tile = (LAS float*)lds;
        convert_big<true>(lds, p.moe_w_gu, ws + WS_GU, D, 2048, DEPTH * NEXP, GU_WSCALE);
        convert_big<true>(lds, p.moe_w_down, ws + WS_DN, D, D, DEPTH * NEXP, DN_WSCALE);
        convert_big<false>(lds, p.a_w_in, (bf16_t*)(ws + WS_AWIN), D, 2048, 2, 1.0f);
        convert_big<false>(lds, p.a_w_out, (bf16_t*)(ws + WS_AWOUT), D, D, 2, 1.0f);
        convert_big<false>(lds, p.b_w_in, (bf16_t*)(ws + WS_BWIN), D, 6144, 1, 1.0f);
        convert_big<false>(lds, p.b_w_out, (bf16_t*)(ws + WS_BWOUT), 2048, D, 1, 1.0f);
        convert_big<false>(lds, p.c_w_in, (bf16_t*)(ws + WS_CWIN), D, 9216, 1, 1.0f);
        convert_big<false>(lds, p.c_w_out, (bf16_t*)(ws + WS_CWOUT), D, D, 1, 1.0f);
        convert_job(tile, p.a_w_rgate, (bf16_t*)(ws + WS_AGT), 128, 128, 8);
        convert_job(tile, p.a_w_igate, (bf16_t*)(ws + WS_AGT) + (size_t)8 * 128 * 128, 128, 128, 8);
        convert_job(tile, p.a_w_rgate + (size_t)8 * 128 * 128, (bf16_t*)(ws + WS_AGT) + (size_t)16 * 128 * 128, 128, 128, 8);
        convert_job(tile, p.a_w_igate + (size_t)8 * 128 * 128, (bf16_t*)(ws + WS_AGT) + (size_t)24 * 128 * 128, 128, 128, 8);
        {
            bf16_t* rt = (bf16_t*)(ws + WS_RT);
            for (int i = blockIdx.x * NTHREADS + threadIdx.x; i < DEPTH * NEXP * D; i += gridDim.x * NTHREADS) {
                const int l = i / (NEXP * D), r_ = i % (NEXP * D), e = r_ / D, k = r_ % D;
                const float w = p.moe_w_router[((size_t)l * D + k) * NEXP + e];
                const bf16_t hi = f2bf(w); const bf16_t lo = f2bf(w - bf2f(hi));
                rt[((size_t)l * 2 + 0) * NEXP * D + (size_t)e * D + k] = hi; rt[((size_t)l * 2 + 1) * NEXP * D + (size_t)e * D + k] = lo;
            }
        }
        float* xf = (float*)(ws + WS_XF); bf16_t* xb = (bf16_t*)(ws + WS_XB);
        {
            const size_t stride = (size_t)gridDim.x * NTHREADS;
            for (size_t i = (size_t)blockIdx.x * NTHREADS + threadIdx.x; i < (size_t)T * D / 4; i += 4 * stride) {
                f32x4 v[4];
#pragma unroll
                for (int q = 0; q < 4; ++q) v[q] = *(const f32x4*)(p.x + (i + q * stride) * 4);
#pragma unroll
                for (int q = 0; q < 4; ++q) { *(f32x4*)(xf + (i + q * stride) * 4) = v[q]; u32x2 w; w.x = pack2(v[q][0], v[q][1]); w.y = pack2(v[q][2], v[q][3]); *(u32x2*)(xb + (i + q * stride) * 4) = w; }
            }
        }
    }
    SEAM(0);

    run_layer<0>(p, lds, bar); run_layer<1>(p, lds, bar); run_layer<2>(p, lds, bar); run_layer<3>(p, lds, bar);
#undef IN
#undef SEAM
}

extern "C" void kernel_launch(void* const* d_in, const int* in_sizes, int n_in, void* d_out, int out_size, void* d_ws, size_t ws_size, hipStream_t stream) {
    static int grid = 0;
    if (grid == 0) {
        if (n_in != 22 || out_size != T * D || ws_size < WS_END) { fprintf(stderr, "kernel_launch: unexpected shapes (n_in %d out %d ws %zu need %zu)\n", n_in, out_size, ws_size, (size_t)WS_END); grid = -1; return; }
        if (hipFuncSetAttribute((const void*)fwd_kernel, hipFuncAttributeMaxDynamicSharedMemorySize, LDS_BYTES) != hipSuccess) { fprintf(stderr, "kernel_launch: hipFuncSetAttribute failed\n"); grid = -1; return; }
        int dev = 0, cus = 0;
        if (hipGetDevice(&dev) != hipSuccess || hipDeviceGetAttribute(&cus, hipDeviceAttributeMultiprocessorCount, dev) != hipSuccess) { grid = -1; return; }
        grid = cus;
    }
    if (grid < 0) return;
    (void)hipMemsetAsync((char*)d_ws + WS_CTL, 0, CTL_BYTES, stream);
    Params p{};
    const float** pp = (const float**)&p;
    for (int i = 0; i < 22; ++i) pp[i] = (const float*)d_in[i];
    p.out = (float*)d_out; p.ws = (unsigned char*)d_ws;
#if MK_ONE_LAUNCH
    p.ph_lo = 0; p.ph_hi = NPHASES;
    hipLaunchKernelGGL(fwd_kernel, dim3(grid), dim3(NTHREADS), LDS_BYTES, stream, p);
#else
    for (int ph = 0; ph < NPHASES; ++ph) {
        p.ph_lo = ph; p.ph_hi = ph + 1;
        hipLaunchKernelGGL(fwd_kernel, dim3(grid), dim3(NTHREADS), LDS_BYTES, stream, p);
    }
#endif
}
```

```cpp
#include <hip/hip_runtime.h>
#include <stdint.h>
#include <stdio.h>

#ifndef MK_ONE_LAUNCH
#define MK_ONE_LAUNCH 1
#endif

#define LAS __attribute__((address_space(3)))
typedef unsigned short bf16_t;
typedef short bf16x8 __attribute__((ext_vector_type(8)));
typedef float f32x4 __attribute__((ext_vector_type(4)));
typedef unsigned u32x4 __attribute__((ext_vector_type(4)));
typedef unsigned u32x2 __attribute__((ext_vector_type(2)));

constexpr int T = 16384, D = 1024, SEQ = 2048, NBATCH = 8, DEPTH = 4;
constexpr int NEXP = 32, TOPK = 4;
constexpr int MAXROWS = 73728;
constexpr float DN_ALPHA = 1.681792830507429f;
constexpr float LN_EPS = 1e-5f;
constexpr float GU_WSCALE = 64.0f, DN_WSCALE = 128.0f;
constexpr int NTHREADS = 512;

constexpr size_t MB = 1ull << 20;
constexpr size_t WS_CTL = 0;
constexpr size_t CTL_BYTES = 65536;
constexpr size_t WS_AWIN = 1 * MB;
constexpr size_t WS_AWOUT = WS_AWIN + 8 * MB;
constexpr size_t WS_BWIN = WS_AWOUT + 4 * MB;
constexpr size_t WS_BWOUT = WS_BWIN + 12 * MB;
constexpr size_t WS_CWIN = WS_BWOUT + 4 * MB;
constexpr size_t WS_CWOUT = WS_CWIN + 18 * MB;
constexpr size_t WS_GU = WS_CWOUT + 2 * MB;
constexpr size_t WS_DN = WS_GU + 512 * MB;
constexpr size_t WS_XF = WS_DN + 256 * MB;
constexpr size_t WS_XB = WS_XF + 64 * MB;
constexpr size_t WS_U = WS_XB + 32 * MB;
constexpr size_t WS_YIN = WS_U + 288 * MB;
constexpr size_t WS_YMIX = WS_YIN + 64 * MB;
constexpr size_t WS_SCR = WS_YMIX + 64 * MB;
constexpr size_t WS_TOPE = WS_SCR + 128 * MB;
constexpr size_t WS_GATES = WS_TOPE + 256 * 1024;
constexpr size_t WS_POS = WS_GATES + 256 * 1024;
constexpr size_t WS_DEST = WS_POS + 256 * 1024;
constexpr size_t WS_ROWTOK = WS_DEST + 256 * 1024;
constexpr size_t WS_HID = WS_ROWTOK + 1 * MB;
constexpr size_t WS_YROWS = WS_HID + 144 * MB;
constexpr size_t WS_LSUM = WS_YROWS + 288 * MB;
constexpr size_t WS_AGT = WS_LSUM + 2 * MB;
constexpr size_t WS_RT = WS_AGT + 1 * MB;
constexpr size_t WS_XQ = WS_RT + 1 * MB;
constexpr size_t WS_LIST = WS_XQ + 16 * MB;
constexpr size_t WS_END = WS_LIST + 2 * MB;

constexpr int CW_CNT = 4096;
constexpr int CW_MDYN = 8192;
constexpr int CW_TEXP = 12288;

#define XB_TMO      128
#define XB_XCNT(j)  (256  + 64 * (j))
#define XB_XSUB(j)  (1280 + 64 * (j))
#define XB_XGEN(j)  (2304 + 64 * (j))
#define XB_TOP      3328
#define XB_TOPGEN   3392
#define XCD_BAR_WORDS 3456
#define XB_SPIN_CAP (1u << 22)

__device__ __forceinline__ unsigned xb_ld(unsigned* p)              { return __hip_atomic_load(p, __ATOMIC_RELAXED, __HIP_MEMORY_SCOPE_AGENT); }
__device__ __forceinline__ unsigned xb_add(unsigned* p, unsigned v) { return __hip_atomic_fetch_add(p, v, __ATOMIC_RELAXED, __HIP_MEMORY_SCOPE_AGENT); }
__device__ __forceinline__ unsigned xb_xcc_id() { return (unsigned)__builtin_amdgcn_s_getreg((3 << 11) | 20) & 0xFu; }
#define XB_SPIN(cond, bar) do { unsigned _sp = 0; while (cond) { __builtin_amdgcn_s_sleep(1); \
    if ((++_sp & 255u) == 0u) { if (xb_ld(&(bar)[XB_TMO])) break; if (_sp > XB_SPIN_CAP) { atomicAdd(&(bar)[XB_TMO], 1u); break; } } } } while (0)

struct XcdBarrier { unsigned* bar; unsigned x; volatile LAS unsigned* st; };

__device__ __forceinline__ XcdBarrier xcd_barrier_post(unsigned* bar, volatile LAS unsigned* st) {
    XcdBarrier b; b.bar = bar; b.x = xb_xcc_id(); b.st = st;
    if (threadIdx.x == 0) (void)xb_add(&bar[XB_XCNT(b.x)], 1u);
    return b;
}
__device__ __forceinline__ void xcd_barrier_complete(unsigned* bar, unsigned x, unsigned& nloc, unsigned& nx) {
    const unsigned G = gridDim.x * gridDim.y * gridDim.z;
    unsigned sum, cnt, mine, sp = 0u;
    for (;;) {
        sum = 0u; cnt = 0u; mine = 0u;
#pragma unroll
        for (unsigned j = 0; j < 16; ++j) { const unsigned c = xb_ld(&bar[XB_XCNT(j)]); sum += c; cnt += (c > 0u) ? 1u : 0u; mine = (j == x) ? c : mine; }
        if (sum == G) break;
        __builtin_amdgcn_s_sleep(1);
        if ((++sp & 255u) == 0u) { if (xb_ld(&bar[XB_TMO])) break; if (sp > XB_SPIN_CAP) { atomicAdd(&bar[XB_TMO], 1u); break; } }
    }
    nloc = mine > 0u ? mine : 1u; nx = cnt > 0u ? cnt : 1u;
}
__device__ __noinline__ void xcd_barrier_nv(unsigned* bbar, unsigned bx, volatile LAS unsigned* bst) {
    XcdBarrier b; b.bar = bbar; b.x = bx; b.st = bst;
    asm volatile("s_waitcnt vmcnt(0)" ::: "memory");
    __syncthreads();
    if (threadIdx.x == 0) {
        unsigned* bar = b.bar;
        __builtin_amdgcn_s_waitcnt(0);
        unsigned nloc = b.st[0], nx = b.st[1];
        if (nloc == 0u) { xcd_barrier_complete(bar, b.x, nloc, nx); b.st[0] = nloc; b.st[1] = nx; }
        const unsigned old = xb_add(&bar[XB_XSUB(b.x)], 1u);
        const unsigned gen = old / nloc;
        if (old + 1u == (gen + 1u) * nloc) {
            __builtin_amdgcn_fence(__ATOMIC_RELEASE, "agent");
            asm volatile("s_waitcnt vmcnt(0)" ::: "memory");
            const unsigned og = xb_add(&bar[XB_TOP], 1u);
            const unsigned tg = og / nx;
            if (og + 1u == (tg + 1u) * nx) xb_add(&bar[XB_TOPGEN], 1u);
            else XB_SPIN(xb_ld(&bar[XB_TOPGEN]) == tg, bar);
            __builtin_amdgcn_fence(__ATOMIC_ACQUIRE, "agent");
            xb_add(&bar[XB_XGEN(b.x)], 1u);
            asm volatile("s_waitcnt vmcnt(0)" ::: "memory");
        } else {
            XB_SPIN(xb_ld(&bar[XB_XGEN(b.x)]) == gen, bar);
            __builtin_amdgcn_fence(__ATOMIC_ACQUIRE, "agent");
            asm volatile("s_waitcnt vmcnt(0)" ::: "memory");
        }
    }
    __syncthreads();
}

__device__ __forceinline__ int tid_() { int t = threadIdx.x; asm volatile("" : "+v"(t)); return t; }
__device__ __forceinline__ float bf2f(bf16_t v) { return __uint_as_float(((unsigned)v) << 16); }
__device__ __forceinline__ bf16_t f2bf(float f) { unsigned u = __float_as_uint(f); u += 0x7FFFu + ((u >> 16) & 1u); return (bf16_t)(u >> 16); }
__device__ __forceinline__ unsigned pack2(float lo, float hi) { return (unsigned)f2bf(lo) | ((unsigned)f2bf(hi) << 16); }
__device__ __forceinline__ float wave_sum(float v) {
#pragma unroll
    for (int o = 32; o >= 1; o >>= 1) v += __shfl_xor(v, o);
    return v;
}
__device__ __forceinline__ float wave_max(float v) {
#pragma unroll
    for (int o = 32; o >= 1; o >>= 1) v = fmaxf(v, __shfl_xor(v, o));
    return v;
}
__device__ __forceinline__ float sigmoidf_(float x) { return 1.0f / (1.0f + __expf(-x)); }
__device__ __forceinline__ float gelu_tanh(float x) { const float u = 0.7978845608028654f * (x + 0.044715f * x * x * x); return 0.5f * x * (1.0f + tanhf(u)); }
__device__ __forceinline__ unsigned pk_fp8x4(float a, float b, float c, float d) { int w = 0; w = __builtin_amdgcn_cvt_pk_fp8_f32(a, b, w, false); w = __builtin_amdgcn_cvt_pk_fp8_f32(c, d, w, true); return (unsigned)w; }
__device__ __forceinline__ float swiglu(float gate, float up) {
    const float g = fminf(gate, 7.0f), u = fminf(fmaxf(up, -7.0f), 7.0f);
    return (u + 1.0f) * g * sigmoidf_(1.702f * g);
}

struct Params {
    const float* x; const float* a_w_in; const float* a_conv_w; const float* a_conv_b; const float* a_w_rgate; const float* a_b_rgate;
    const float* a_w_igate; const float* a_b_igate; const float* a_lambda; const float* a_w_out; const float* b_w_in; const float* b_w_out;
    const float* c_w_in; const float* c_w_out; const float* ln_gain; const float* ln_bias; const float* moe_w_router; const float* moe_b_router;
    const float* moe_w_gu; const float* moe_b_gu; const float* moe_w_down; const float* moe_b_down;
    float* out; unsigned char* ws;
    int ph_lo, ph_hi;
};

__device__ __forceinline__ void convert_job(LAS float* tile, const float* src, bf16_t* dst, int K, int N, int batch) {
    const int tid = tid_();
    const int tk = K / 64, tn = N / 64, per = tk * tn; const long total = (long)per * batch;
    for (long u = blockIdx.x; u < total; u += gridDim.x) {
        const int bidx = (int)(u / per), r = (int)(u % per), kt = r / tn, nt = r % tn;
        const float* s = src + (size_t)bidx * K * N + (size_t)(kt * 64) * N + nt * 64;
#pragma unroll
        for (int pass = 0; pass < 2; ++pass) {
            const int row = (tid >> 4) + 32 * pass, c4 = tid & 15;
            const f32x4 v = *(const f32x4*)(s + (size_t)row * N + c4 * 4);
            tile[row * 65 + c4 * 4 + 0] = v[0]; tile[row * 65 + c4 * 4 + 1] = v[1]; tile[row * 65 + c4 * 4 + 2] = v[2]; tile[row * 65 + c4 * 4 + 3] = v[3];
        }
        __syncthreads();
        {
            const int n = tid >> 3, k8 = tid & 7;
            float v[8];
#pragma unroll
            for (int j = 0; j < 8; ++j) v[j] = tile[(k8 * 8 + j) * 65 + n];
            u32x4 w; w.x = pack2(v[0], v[1]); w.y = pack2(v[2], v[3]); w.z = pack2(v[4], v[5]); w.w = pack2(v[6], v[7]);
            *(u32x4*)(dst + (size_t)bidx * N * K + (size_t)(nt * 64 + n) * K + kt * 64 + k8 * 8) = w;
        }
        __syncthreads();
    }
}

struct GemmS {
    const bf16_t* A; int lda;
    const bf16_t* Bt; int ldb;
    int M, N, K;
    const unsigned* Mdyn;
    const int* row_idx;
    const unsigned* tile_exp;
    size_t b_exp_stride;
    const float* bias; int bias_es;
    float* Cf; bf16_t* Cb; int ldc;
};
template <int MODE>
__device__ __forceinline__ void gemm_simple(LAS unsigned char* lds, const GemmS& g) {
    const int tid = tid_(), lane = tid & 63, wid = tid >> 6, wr = wid >> 1, wc = wid & 1, fr = lane & 15, fq = lane >> 4;
    const int M = g.Mdyn ? (int)*g.Mdyn : g.M;
    const int tiles_n = (MODE == 1) ? (g.N / 256) * 2 : g.N / 128;
    const int tiles_m = M / 128, nunits = tiles_m * tiles_n, nk = g.K / 32;
    LAS bf16_t* As = (LAS bf16_t*)lds;
    LAS bf16_t* Bs = As + 2 * 128 * 40;
    const int lrow = tid >> 2, lch = tid & 3;
    for (int u = blockIdx.x; u < nunits; u += gridDim.x) {
        const int tm = u / tiles_n, tn = u % tiles_n, m0 = tm * 128;
        const int e = (MODE != 0) ? (int)g.tile_exp[m0 >> 8] : 0;
        const bf16_t* Bbase = g.Bt + (size_t)e * g.b_exp_stride;
        int arow = m0 + lrow; if (MODE == 1) arow = g.row_idx[arow];
        int brow;
        if (MODE == 1) { const int bwc = lrow >> 6, ni = (lrow & 63) >> 4, r = lrow & 15; brow = ((ni & 1) ? 1024 : 0) + tn * 64 + bwc * 32 + (ni >> 1) * 16 + r; }
        else brow = tn * 128 + lrow;
        const bf16_t* ap = g.A + (size_t)arow * g.lda + lch * 8;
        const bf16_t* bp = Bbase + (size_t)brow * g.ldb + lch * 8;
        f32x4 acc[2][4];
#pragma unroll
        for (int mi = 0; mi < 2; ++mi)
#pragma unroll
            for (int ni = 0; ni < 4; ++ni) acc[mi][ni] = (f32x4){0.f, 0.f, 0.f, 0.f};
        u32x4 ra = *(const u32x4*)ap, rb = *(const u32x4*)bp;
        *(LAS u32x4*)(As + lrow * 40 + lch * 8) = ra; *(LAS u32x4*)(Bs + lrow * 40 + lch * 8) = rb;
        __syncthreads();
        for (int kt = 0; kt < nk; ++kt) {
            const int cur = kt & 1;
            if (kt + 1 < nk) { ra = *(const u32x4*)(ap + (kt + 1) * 32); rb = *(const u32x4*)(bp + (kt + 1) * 32); }
            bf16x8 af[2], bfr[4];
#pragma unroll
            for (int mi = 0; mi < 2; ++mi) af[mi] = *(const LAS bf16x8*)(As + cur * 5120 + (wr * 32 + mi * 16 + fr) * 40 + fq * 8);
#pragma unroll
            for (int ni = 0; ni < 4; ++ni) bfr[ni] = *(const LAS bf16x8*)(Bs + cur * 5120 + (wc * 64 + ni * 16 + fr) * 40 + fq * 8);
#pragma unroll
            for (int mi = 0; mi < 2; ++mi)
#pragma unroll
                for (int ni = 0; ni < 4; ++ni) acc[mi][ni] = __builtin_amdgcn_mfma_f32_16x16x32_bf16(bfr[ni], af[mi], acc[mi][ni], 0, 0, 0);
            if (kt + 1 < nk) { *(LAS u32x4*)(As + (cur ^ 1) * 5120 + lrow * 40 + lch * 8) = ra; *(LAS u32x4*)(Bs + (cur ^ 1) * 5120 + lrow * 40 + lch * 8) = rb; }
            __syncthreads();
        }
#pragma unroll
        for (int mi = 0; mi < 2; ++mi) {
            const int m = m0 + wr * 32 + mi * 16 + fr;
            if (MODE == 1) {
#pragma unroll
                for (int q = 0; q < 2; ++q) {
                    const int hc = tn * 64 + wc * 32 + q * 16 + 4 * fq;
                    const f32x4 bg = *(const f32x4*)(g.bias + (size_t)e * g.bias_es + hc), bu = *(const f32x4*)(g.bias + (size_t)e * g.bias_es + 1024 + hc);
                    const f32x4 gt = acc[mi][2 * q] + bg, up = acc[mi][2 * q + 1] + bu;
                    u32x2 w; w.x = pack2(swiglu(gt[0], up[0]), swiglu(gt[1], up[1])); w.y = pack2(swiglu(gt[2], up[2]), swiglu(gt[3], up[3]));
                    *(u32x2*)(g.Cb + (size_t)m * g.ldc + hc) = w;
                }
            } else {
#pragma unroll
                for (int ni = 0; ni < 4; ++ni) {
                    const int n = tn * 128 + wc * 64 + ni * 16 + 4 * fq;
                    f32x4 v = acc[mi][ni];
                    if (g.bias) v += *(const f32x4*)(g.bias + (size_t)e * g.bias_es + n);
                    if (g.Cf) *(f32x4*)(g.Cf + (size_t)m * g.ldc + n) = v;
                    else { u32x2 w; w.x = pack2(v[0], v[1]); w.y = pack2(v[2], v[3]); *(u32x2*)(g.Cb + (size_t)m * g.ldc + n) = w; }
                }
            }
        }
    }
}


constexpr int TAB_OFF = 131072;
__device__ __forceinline__ void moe_tables(LAS unsigned char* lds, const unsigned* ctl, int layer) {
    LAS int* tab = (LAS int*)(lds + TAB_OFF);
    const int tid = tid_();
    __syncthreads();
    if (tid == 0) { int acc = 0; for (int e = 0; e < NEXP; ++e) { tab[e] = acc; acc += ((int)ctl[CW_CNT + layer * 64 + e] + 255) >> 8; } tab[32] = acc; }
    __syncthreads();
    if (tid < 288) { int e = 0; for (int q = 1; q < NEXP; ++q) e += (tab[q] <= tid) ? 1 : 0; tab[64 + tid] = e; }
    __syncthreads();
}

namespace g8 {
constexpr int BM = 256, BK = 64, HALF = 128, HTB = HALF * BK * 2, STAGE_BYTES = 8 * HTB, NXCD = 8, WGM = 8;
__device__ __forceinline__ int lds_byte(int r, int c) { const int st = (r >> 4) * 2 + (c >> 5), rr = r & 15, cc = c & 31, ob = rr * 64 + cc * 2; return st * 1024 + (ob ^ (((ob >> 9) & 1) << 5)); }
__device__ __forceinline__ void stage_rc(int b, int& R, int& C) { const int st = b / 1024, sb = b % 1024, swz = sb ^ (((sb >> 9) & 1) << 5); R = (st >> 1) * 16 + swz / 64; C = (st & 1) * 32 + (swz % 64) / 2; }
__device__ __forceinline__ int perm32(int rho) { const int n = rho >> 4, i = rho & 15; return 8 * (i >> 2) + 4 * n + (i & 3); }
__device__ __forceinline__ unsigned cvt_pk_bf16(float lo, float hi) { unsigned r; asm volatile("v_cvt_pk_bf16_f32 %0, %1, %2" : "=v"(r) : "v"(lo), "v"(hi)); return r; }

struct Unit { const char* a0; const char* a1; const char* b0; const char* b1; const int* rows; int row0, col0, e; };

struct SchedPlain {
    const char* A; const char* Bt; size_t hstepA, hstepB; int nM, nN, nwg, G, c;
    __device__ __forceinline__ void init(const void* A_, const void* Bt_, int M, int N, int K, int G_, int c_) { A = (const char*)A_; Bt = (const char*)Bt_; hstepA = (size_t)HALF * K * 2; hstepB = hstepA; nM = M / BM; nN = N / BM; nwg = nM * nN; G = G_; c = c_; }
    __device__ __forceinline__ bool next(int i, Unit& u) const {
        const long L = (long)i * G + c; if (L >= nwg) return false;
        int wgid = (int)L; { const int q = nwg / NXCD, r = nwg % NXCD, xcd = wgid % NXCD, off = wgid / NXCD; wgid = (xcd < r ? xcd * (q + 1) : r * (q + 1) + (xcd - r) * q) + off; }
        const int nig = WGM * nN, gid = wgid / nig, fm = gid * WGM, gsz = (nM - fm) < WGM ? (nM - fm) : WGM;
        const int pm = fm + ((wgid % nig) % gsz), pn = (wgid % nig) / gsz;
        u.a0 = A + (size_t)pm * 2 * hstepA; u.a1 = u.a0 + hstepA; u.b0 = Bt + (size_t)pn * 2 * hstepB; u.b1 = u.b0 + hstepB; u.rows = nullptr; u.row0 = pm * BM; u.col0 = pn * BM; u.e = 0;
        return true;
    }
};
struct SchedGU {
    const char* A; const char* W; const int* elist; LAS const int* tab; int G, c;
    __device__ __forceinline__ bool next(int i, Unit& u) const {
        const int L = i * G + c, rt = L >> 3, pn = L & 7; if (rt >= __builtin_amdgcn_readfirstlane(tab[32])) return false;
        const int e = __builtin_amdgcn_readfirstlane(tab[64 + rt]), j = rt - __builtin_amdgcn_readfirstlane(tab[e]);
        u.a0 = A; u.a1 = A; u.rows = elist + (size_t)e * T + j * BM; u.b0 = W + ((size_t)e * 2048 + pn * 128) * D; u.b1 = u.b0 + (size_t)1024 * D; u.row0 = rt * BM; u.col0 = pn * 128; u.e = e;
        return true;
    }
};
struct SchedDown {
    const char* A; const char* W; LAS const int* tab; int G, c;
    __device__ __forceinline__ bool next(int i, Unit& u) const {
        const int L = i * G + c, rt = L >> 2, pn = L & 3; if (rt >= __builtin_amdgcn_readfirstlane(tab[32])) return false;
        const int e = __builtin_amdgcn_readfirstlane(tab[64 + rt]);
        u.a0 = A + (size_t)rt * BM * D; u.a1 = u.a0 + (size_t)HALF * D; u.rows = nullptr; u.b0 = W + ((size_t)e * 1024 + pn * BM) * D; u.b1 = u.b0 + (size_t)HALF * D; u.row0 = rt * BM; u.col0 = pn * BM; u.e = e;
        return true;
    }
};

struct EpiF32 {
    static constexpr bool PERM = false;
    float* C; int ldc; const float* bias; int bias_es;
    __device__ __forceinline__ void operator()(const f32x4 (&acc)[2][2][4][2], const Unit& u, int wr, int wc, int fr, int fq) const {
        const int row0 = u.row0 + wr * 64 + fr, col0 = u.col0 + wc * 32 + 4 * fq;
        f32x4 bv[2][2];
#pragma unroll
        for (int bj = 0; bj < 2; ++bj)
#pragma unroll
            for (int n = 0; n < 2; ++n) bv[bj][n] = bias ? *(const f32x4*)(bias + (size_t)u.e * bias_es + col0 + bj * HALF + n * 16) : (f32x4){0.f, 0.f, 0.f, 0.f};
#pragma unroll
        for (int ai = 0; ai < 2; ++ai)
#pragma unroll
            for (int m = 0; m < 4; ++m) { float* rowp = C + (size_t)(row0 + ai * HALF + m * 16) * ldc + col0;
#pragma unroll
                for (int bj = 0; bj < 2; ++bj)
#pragma unroll
                    for (int n = 0; n < 2; ++n) *(f32x4*)(rowp + bj * HALF + n * 16) = acc[ai][bj][m][n] + bv[bj][n]; }
    }
};
struct EpiBf16 {
    static constexpr bool PERM = true;
    bf16_t* O; int ldc; const float* bias; int bias_es; float scale;
    __device__ __forceinline__ void operator()(const f32x4 (&acc)[2][2][4][2], const Unit& u, int wr, int wc, int fr, int fq) const {
        const int row0 = u.row0 + wr * 64 + fr, col0 = u.col0 + wc * 32 + 8 * fq;
        f32x4 bv[2][2];
#pragma unroll
        for (int bj = 0; bj < 2; ++bj)
#pragma unroll
            for (int n = 0; n < 2; ++n) bv[bj][n] = bias ? *(const f32x4*)(bias + (size_t)u.e * bias_es + col0 + bj * HALF + 4 * n) : (f32x4){0.f, 0.f, 0.f, 0.f};
#pragma unroll
        for (int ai = 0; ai < 2; ++ai)
#pragma unroll
            for (int m = 0; m < 4; ++m) { bf16_t* rowp = O + (size_t)(row0 + ai * HALF + m * 16) * ldc + col0;
#pragma unroll
                for (int bj = 0; bj < 2; ++bj) { const f32x4 v0 = acc[ai][bj][m][0] * scale + bv[bj][0], v1 = acc[ai][bj][m][1] * scale + bv[bj][1];
                    u32x4 w; w.x = cvt_pk_bf16(v0[0], v0[1]); w.y = cvt_pk_bf16(v0[2], v0[3]); w.z = cvt_pk_bf16(v1[0], v1[1]); w.w = cvt_pk_bf16(v1[2], v1[3]);
                    *(u32x4*)(rowp + bj * HALF) = w; } }
    }
};
struct EpiSwiglu {
    static constexpr bool PERM = true;
    unsigned char* O; const float* bias; float scale;
    __device__ __forceinline__ void operator()(const f32x4 (&acc)[2][2][4][2], const Unit& u, int wr, int wc, int fr, int fq) const {
        const int row0 = u.row0 + wr * 64 + fr, hc = u.col0 + wc * 32 + 8 * fq;
        const float* bp = bias + (size_t)u.e * 2048 + hc;
        const f32x4 bg0 = *(const f32x4*)(bp), bg1 = *(const f32x4*)(bp + 4), bu0 = *(const f32x4*)(bp + 1024), bu1 = *(const f32x4*)(bp + 1028);
#pragma unroll
        for (int ai = 0; ai < 2; ++ai)
#pragma unroll
            for (int m = 0; m < 4; ++m) {
                const f32x4 g0 = acc[ai][0][m][0] * scale + bg0, g1 = acc[ai][0][m][1] * scale + bg1, u0 = acc[ai][1][m][0] * scale + bu0, u1 = acc[ai][1][m][1] * scale + bu1;
                u32x2 w; w.x = pk_fp8x4(swiglu(g0[0], u0[0]), swiglu(g0[1], u0[1]), swiglu(g0[2], u0[2]), swiglu(g0[3], u0[3]));
                w.y = pk_fp8x4(swiglu(g1[0], u1[0]), swiglu(g1[1], u1[1]), swiglu(g1[2], u1[2]), swiglu(g1[3], u1[3]));
                *(u32x2*)(O + (size_t)(row0 + ai * HALF + m * 16) * D + hc) = w;
            }
    }
};

typedef int i32x8 __attribute__((ext_vector_type(8)));
typedef int i32x4 __attribute__((ext_vector_type(4)));
template <class Epi, class Sched, bool GATHER, int ESZ = 2>
__device__ __forceinline__ void gemm_phase(LAS unsigned char* lds, const int K, const Sched& S, const Epi& E) {
    const int tid = tid_(), wid = __builtin_amdgcn_readfirstlane(tid >> 6), lane = tid & 63, wr = wid >> 2, wc = wid & 3, fr = lane & 15, fq = lane >> 4;
    const int nt = K * ESZ / 128, KP = K * ESZ;
    int sR[2], sC[2];
    unsigned voffB[2];
#pragma unroll
    for (int i = 0; i < 2; ++i) { stage_rc(tid * 16 + i * 8192, sR[i], sC[i]); const int Rb = Epi::PERM ? ((sR[i] & ~31) + perm32(sR[i] & 31)) : sR[i]; voffB[i] = (unsigned)(Rb * KP + sC[i] * 2); }
    unsigned cvA0[2], cvA1[2], nvA0[2], nvA1[2];
#define G8_VOFF(u, v0, v1) do { _Pragma("unroll") for (int _i = 0; _i < 2; ++_i) { \
        if (GATHER) { unsigned t0_ = (unsigned)(u).rows[sR[_i]], t1_ = (unsigned)(u).rows[HALF + sR[_i]]; t0_ = t0_ < (unsigned)T ? t0_ : 0u; t1_ = t1_ < (unsigned)T ? t1_ : 0u;     \
            v0[_i] = t0_ * (unsigned)KP + (unsigned)(sC[_i] * 2); v1[_i] = t1_ * (unsigned)KP + (unsigned)(sC[_i] * 2); } \
        else { v0[_i] = (unsigned)(sR[_i] * KP + sC[_i] * 2); v1[_i] = v0[_i]; } } } while (0)
    const size_t kstep = (size_t)(BK * 2);
    const unsigned ldsw = (unsigned)wid * 1024u;
    const int aoff = lds_byte(wr * 64 + fr, fq * 8), boff = lds_byte(wc * 32 + fr, fq * 8);
#define PG8_SA(b, h) (((b) * 2 + (h)) * HTB)
#define PG8_SB(b, h) ((4 + (b) * 2 + (h)) * HTB)
#define PG8_STAGE(bufoff, gbase, voff) do { _Pragma("unroll") for (int _i = 0; _i < 2; ++_i) \
        __builtin_amdgcn_global_load_lds((const unsigned*)((const char*)(gbase) + (voff)[_i]), (LAS unsigned*)(lds + (bufoff) + ldsw + _i * 8192), 16, 0, 0); } while (0)
#define PG8_LDA(dst, b, h) do { _Pragma("unroll") for (int m = 0; m < 4; ++m) { dst[m].lo = *(const LAS i32x4*)(lds + PG8_SA(b, h) + aoff + m * 2048); dst[m].hi = *(const LAS i32x4*)(lds + PG8_SA(b, h) + aoff + m * 2048 + 1024); } } while (0)
#define PG8_LDB(dst, b, h) do { _Pragma("unroll") for (int n = 0; n < 2; ++n) { dst[n].lo = *(const LAS i32x4*)(lds + PG8_SB(b, h) + boff + n * 2048); dst[n].hi = *(const LAS i32x4*)(lds + PG8_SB(b, h) + boff + n * 2048 + 1024); } } while (0)
#define PG8_MMA(ai, bj, At, Bt) do { __builtin_amdgcn_s_setprio(1); _Pragma("unroll") for (int m = 0; m < 4; ++m) _Pragma("unroll") for (int n = 0; n < 2; ++n) { \
        if (ESZ == 2) { acc[ai][bj][m][n] = __builtin_amdgcn_mfma_f32_16x16x32_bf16(__builtin_bit_cast(bf16x8, (i32x4)__builtin_shufflevector(Bt[n], Bt[n], 0, 1, 2, 3)), __builtin_bit_cast(bf16x8, (i32x4)__builtin_shufflevector(At[m], At[m], 0, 1, 2, 3)), acc[ai][bj][m][n], 0, 0, 0); \
                        acc[ai][bj][m][n] = __builtin_amdgcn_mfma_f32_16x16x32_bf16(__builtin_bit_cast(bf16x8, (i32x4)__builtin_shufflevector(Bt[n], Bt[n], 4, 5, 6, 7)), __builtin_bit_cast(bf16x8, (i32x4)__builtin_shufflevector(At[m], At[m], 4, 5, 6, 7)), acc[ai][bj][m][n], 0, 0, 0); } \
        else asm volatile("v_mfma_f32_16x16x128_f8f6f4 %0, %1, %2, %0" : "+v"(acc[ai][bj][m][n]) : "v"(Bt[n]), "v"(At[m])); } __builtin_amdgcn_s_setprio(0); } while (0)
#define PG8_WAIT_V(n) asm volatile("s_waitcnt vmcnt(" #n ")" ::: "memory")
#define PG8_WAIT_L(n) asm volatile("s_waitcnt lgkmcnt(" #n ")" ::: "memory")
#define PG8_BAR __builtin_amdgcn_s_barrier()
#define PG8_SCHED __builtin_amdgcn_sched_barrier(0)
    Unit cur, nxt; int ui = 0;
    if (!S.next(0, cur)) return;
    f32x4 acc[2][2][4][2];
#pragma unroll
    for (int a = 0; a < 2; ++a)
#pragma unroll
        for (int b = 0; b < 2; ++b)
#pragma unroll
            for (int m = 0; m < 4; ++m)
#pragma unroll
                for (int n = 0; n < 2; ++n) acc[a][b][m][n] = (f32x4){0.f, 0.f, 0.f, 0.f};
    i32x8 At[4], B0[2], B1[2];
    const char* cA0 = cur.a0; const char* cA1 = cur.a1; const char* cB0 = cur.b0; const char* cB1 = cur.b1;
    G8_VOFF(cur, cvA0, cvA1);
    PG8_STAGE(PG8_SB(0, 0), cB0, voffB); PG8_STAGE(PG8_SB(0, 1), cB1, voffB); PG8_STAGE(PG8_SA(0, 0), cA0, cvA0); PG8_STAGE(PG8_SA(0, 1), cA1, cvA1);
    if (wr == 1) PG8_BAR;
    PG8_WAIT_V(2); PG8_BAR;
    PG8_STAGE(PG8_SB(1, 0), cB0 + kstep, voffB); PG8_STAGE(PG8_SA(1, 0), cA0 + kstep, cvA0); PG8_STAGE(PG8_SB(1, 1), cB1 + kstep, voffB);
    PG8_WAIT_V(6); PG8_BAR;
    for (;;) {
        const bool has_next = S.next(ui + 1, nxt);
        const char* nA0 = has_next ? nxt.a0 : cA0; const char* nA1 = has_next ? nxt.a1 : cA1; const char* nB0 = has_next ? nxt.b0 : cB0; const char* nB1 = has_next ? nxt.b1 : cB1;
        if (GATHER) { if (has_next) { G8_VOFF(nxt, nvA0, nvA1); } else { nvA0[0] = cvA0[0]; nvA0[1] = cvA0[1]; nvA1[0] = cvA1[0]; nvA1[1] = cvA1[1]; } }
#pragma unroll 1
        for (int t = 0; t < nt; t += 2) {
            const bool last = (t == nt - 2);
            const char* a1_1 = cA1 + (size_t)(t + 1) * kstep;
            const char* a2_0 = last ? nA0 : cA0 + (size_t)(t + 2) * kstep; const char* a2_1 = last ? nA1 : cA1 + (size_t)(t + 2) * kstep;
            const char* b2_0 = last ? nB0 : cB0 + (size_t)(t + 2) * kstep; const char* b2_1 = last ? nB1 : cB1 + (size_t)(t + 2) * kstep;
            const char* a3_0 = a2_0 + kstep; const char* b3_0 = b2_0 + kstep; const char* b3_1 = b2_1 + kstep;
            unsigned vA0[2], vA1[2];
            if (GATHER) { vA0[0] = last ? nvA0[0] : cvA0[0]; vA0[1] = last ? nvA0[1] : cvA0[1]; vA1[0] = last ? nvA1[0] : cvA1[0]; vA1[1] = last ? nvA1[1] : cvA1[1]; }
            else { vA0[0] = cvA0[0]; vA0[1] = cvA0[1]; vA1[0] = cvA0[0]; vA1[1] = cvA0[1]; }
            PG8_LDB(B0, 0, 0); PG8_LDB(B1, 0, 1); PG8_SCHED; PG8_LDA(At, 0, 0); PG8_STAGE(PG8_SA(1, 1), a1_1, cvA1);
            PG8_WAIT_V(8); PG8_WAIT_L(0); PG8_BAR; PG8_MMA(0, 0, At, B0); PG8_MMA(0, 1, At, B1); PG8_BAR; PG8_SCHED;
            PG8_LDA(At, 0, 1); PG8_STAGE(PG8_SB(0, 0), b2_0, voffB); PG8_STAGE(PG8_SB(0, 1), b2_1, voffB); PG8_STAGE(PG8_SA(0, 0), a2_0, vA0);
            PG8_WAIT_V(8); PG8_WAIT_L(0); PG8_BAR; PG8_MMA(1, 0, At, B0); PG8_MMA(1, 1, At, B1); PG8_BAR; PG8_SCHED;
            PG8_LDB(B0, 1, 0); PG8_LDB(B1, 1, 1); PG8_SCHED; PG8_LDA(At, 1, 0); PG8_STAGE(PG8_SA(0, 1), a2_1, vA1);
            PG8_WAIT_V(8); PG8_WAIT_L(0); PG8_BAR; PG8_MMA(0, 0, At, B0); PG8_MMA(0, 1, At, B1); PG8_BAR; PG8_SCHED;
            PG8_LDA(At, 1, 1); PG8_STAGE(PG8_SB(1, 0), b3_0, voffB); PG8_STAGE(PG8_SB(1, 1), b3_1, voffB); PG8_STAGE(PG8_SA(1, 0), a3_0, vA0);
            PG8_WAIT_V(8); PG8_WAIT_L(0); PG8_BAR; PG8_MMA(1, 0, At, B0); PG8_MMA(1, 1, At, B1); PG8_BAR; PG8_SCHED;
        }
        if (wr == 0) PG8_BAR;
        if (ESZ == 1) asm volatile("s_nop 15\n\ts_nop 15" ::: "memory");
        E(acc, cur, wr, wc, fr, fq);
        if (!has_next) break;
#pragma unroll
        for (int a = 0; a < 2; ++a)
#pragma unroll
            for (int b = 0; b < 2; ++b)
#pragma unroll
                for (int m = 0; m < 4; ++m)
#pragma unroll
                    for (int n = 0; n < 2; ++n) acc[a][b][m][n] = (f32x4){0.f, 0.f, 0.f, 0.f};
        cur = nxt; cA0 = nA0; cA1 = nA1; cB0 = nB0; cB1 = nB1; ++ui;
        if (GATHER) { cvA0[0] = nvA0[0]; cvA0[1] = nvA0[1]; cvA1[0] = nvA1[0]; cvA1[1] = nvA1[1]; }
        if (wr == 1) PG8_BAR;
    }
    PG8_WAIT_V(0);
    PG8_BAR;
#undef G8_VOFF
#undef PG8_SA
#undef PG8_SB
#undef PG8_STAGE
#undef PG8_LDA
#undef PG8_LDB
#undef PG8_MMA
#undef PG8_WAIT_V
#undef PG8_WAIT_L
#undef PG8_BAR
#undef PG8_SCHED
}
}


template <bool F8>
__device__ __forceinline__ void convert_big(LAS unsigned char* lds, const float* src, void* dstv, int K, int N, int batch, float scale) {
    const int tid = tid_(), lane = tid & 63, wid = tid >> 6;
    const int nbn = N / 256, per = (K / 128) * nbn, total = per * batch, G = (int)gridDim.x;
    constexpr int ESZ = F8 ? 1 : 2, ROWB = 128 * ESZ, TILEB = 256 * ROWB;
    f32x4 ra[16], rb[16];
#define CV_LOAD(uu, reg) do { const int bidx = (uu) / per, r_ = (uu) % per, kb = r_ / nbn, nb = r_ % nbn; \
        const float* sp = src + (size_t)bidx * K * N + (size_t)(kb * 128 + 16 * wid) * N + nb * 256 + 4 * lane; \
        _Pragma("unroll") for (int i = 0; i < 16; ++i) reg[i] = *(const f32x4*)(sp + (size_t)i * N); } while (0)
#define CV_PACK(reg, tl) do { _Pragma("unroll") for (int j = 0; j < 4; ++j) { \
        if (F8) { u32x4 w0; w0.x = pk_fp8x4(reg[0][j] * scale, reg[1][j] * scale, reg[2][j] * scale, reg[3][j] * scale); w0.y = pk_fp8x4(reg[4][j] * scale, reg[5][j] * scale, reg[6][j] * scale, reg[7][j] * scale); \
            w0.z = pk_fp8x4(reg[8][j] * scale, reg[9][j] * scale, reg[10][j] * scale, reg[11][j] * scale); w0.w = pk_fp8x4(reg[12][j] * scale, reg[13][j] * scale, reg[14][j] * scale, reg[15][j] * scale); \
            *(LAS u32x4*)((tl) + (4 * lane + j) * ROWB + ((wid ^ (lane & 7)) * 16)) = w0; } \
        else { u32x4 w0, w1; \
            w0.x = g8::cvt_pk_bf16(reg[0][j], reg[1][j]); w0.y = g8::cvt_pk_bf16(reg[2][j], reg[3][j]); w0.z = g8::cvt_pk_bf16(reg[4][j], reg[5][j]); w0.w = g8::cvt_pk_bf16(reg[6][j], reg[7][j]); \
            w1.x = g8::cvt_pk_bf16(reg[8][j], reg[9][j]); w1.y = g8::cvt_pk_bf16(reg[10][j], reg[11][j]); w1.z = g8::cvt_pk_bf16(reg[12][j], reg[13][j]); w1.w = g8::cvt_pk_bf16(reg[14][j], reg[15][j]); \
            *(LAS u32x4*)((tl) + (4 * lane + j) * ROWB + (((2 * wid) ^ (lane & 15)) * 16)) = w0; *(LAS u32x4*)((tl) + (4 * lane + j) * ROWB + (((2 * wid + 1) ^ (lane & 15)) * 16)) = w1; } } } while (0)
#define CV_STORE(uu, tl) do { const int bidx = (uu) / per, r_ = (uu) % per, kb = r_ / nbn, nb = r_ % nbn; \
        unsigned char* dp = (unsigned char*)dstv + ((size_t)bidx * N * K + (size_t)(nb * 256) * K + kb * 128) * ESZ; \
        _Pragma("unroll") for (int i = 0; i < 4 * ESZ; ++i) { const int pc = tid + NTHREADS * i, n = pc / (8 * ESZ), c = pc % (8 * ESZ); \
            *(u32x4*)(dp + (size_t)n * K * ESZ + c * 16) = *(const LAS u32x4*)((tl) + n * ROWB + ((c ^ ((n >> 2) & (8 * ESZ - 1))) * 16)); } } while (0)
    const int u0 = blockIdx.x;
    if (u0 < total) CV_LOAD(u0, ra);
    if (u0 + G < total) CV_LOAD(u0 + G, rb);
    for (int u = u0; u < total; u += 2 * G) {
        CV_PACK(ra, lds);
        if (u + 2 * G < total) CV_LOAD(u + 2 * G, ra);
        __syncthreads();
        CV_STORE(u, lds);
        const bool has_b = (u + G < total);
        if (has_b) { CV_PACK(rb, lds + TILEB); if (u + 3 * G < total) CV_LOAD(u + 3 * G, rb); }
        __syncthreads();
        if (has_b) CV_STORE(u + G, lds + TILEB);
    }
    __syncthreads();
#undef CV_LOAD
#undef CV_PACK
#undef CV_STORE
}

__device__ __forceinline__ float gelu_fast(float x) { const float u2 = 1.5957691216057308f * (x + 0.044715f * x * x * x); return x / (1.0f + __expf(-u2)); }
__device__ __forceinline__ void lru_gates_phase(LAS unsigned char* lds, const Params& p, int idx) {
    const int tid = tid_(), lane = tid & 63, wid = tid >> 6, fr = lane & 15, fq = lane >> 4;
    LAS bf16_t* xcb = (LAS bf16_t*)lds;
    LAS float* xcf = (LAS float*)(lds + 17408);
    LAS float* sa = (LAS float*)(lds + 17408 + 33792);
    LAS float* sb = sa + 64 * 132;
    LAS float* comb = sb + 64 * 132;
    const bf16_t* u = (const bf16_t*)(p.ws + WS_U);
    float* Aarr = (float*)(p.ws + WS_SCR); float* Barr = Aarr + (size_t)T * D;
    float* SP = (float*)(p.ws + WS_LSUM); float* SH = SP + NBATCH * 32 * D;
    const int hd = blockIdx.x & 7, slot = blockIdx.x >> 3, nslots = gridDim.x >> 3;
    const float* conv_w = p.a_conv_w + (size_t)idx * 4 * D; const float* conv_b = p.a_conv_b + (size_t)idx * D;
    const bf16_t* wrt = (const bf16_t*)(p.ws + WS_AGT) + ((size_t)(idx * 2 + 0) * 8 + hd) * 128 * 128;
    const bf16_t* wit = (const bf16_t*)(p.ws + WS_AGT) + ((size_t)(idx * 2 + 1) * 8 + hd) * 128 * 128;
    bf16x8 Br[4], Bi[4];
#pragma unroll
    for (int ks = 0; ks < 4; ++ks) { Br[ks] = *(const bf16x8*)(wrt + (size_t)(16 * wid + fr) * 128 + 32 * ks + 8 * fq); Bi[ks] = *(const bf16x8*)(wit + (size_t)(16 * wid + fr) * 128 + 32 * ks + 8 * fq); }
    const int cg = hd * 128 + 16 * wid + 4 * fq;
    const f32x4 brv = *(const f32x4*)(p.a_b_rgate + (size_t)idx * D + cg), biv = *(const f32x4*)(p.a_b_igate + (size_t)idx * D + cg), lmv = *(const f32x4*)(p.a_lambda + (size_t)idx * D + cg);
    f32x4 spv;
#pragma unroll
    for (int r = 0; r < 4; ++r) spv[r] = (lmv[r] > 15.f) ? __expf(-lmv[r]) : log1pf(__expf(-lmv[r]));
    const int cc = (tid & 31) * 4, cch = hd * 128 + cc;
    f32x4 cw[4];
#pragma unroll
    for (int j = 0; j < 4; ++j) cw[j] = *(const f32x4*)(conv_w + j * D + cch);
    const f32x4 cb = *(const f32x4*)(conv_b + cch);
    for (int tile = slot; tile < T / 64; tile += nslots) {
        const int t0 = tile * 64;
#pragma unroll
        for (int k = 0; k < 4; ++k) {
            const int tl = (tid >> 5) + 16 * k, t = t0 + tl, s_ = t & (SEQ - 1);
            f32x4 acc = cb;
#pragma unroll
            for (int j = 0; j < 4; ++j) {
                if (s_ - 3 + j >= 0) {
                    const u32x2 rv = *(const u32x2*)(u + (size_t)(t - 3 + j) * 2048 + 1024 + cch);
                    acc[0] += cw[j][0] * __uint_as_float(rv.x << 16); acc[1] += cw[j][1] * __uint_as_float(rv.x & 0xffff0000u);
                    acc[2] += cw[j][2] * __uint_as_float(rv.y << 16); acc[3] += cw[j][3] * __uint_as_float(rv.y & 0xffff0000u);
                }
            }
            *(LAS f32x4*)(xcf + tl * 132 + cc) = acc;
            u32x2 w; w.x = pack2(acc[0], acc[1]); w.y = pack2(acc[2], acc[3]);
            *(LAS u32x2*)(xcb + tl * 136 + cc) = w;
        }
        __syncthreads();
        f32x4 ar[4], ai[4];
#pragma unroll
        for (int mt = 0; mt < 4; ++mt) { ar[mt] = (f32x4){0.f, 0.f, 0.f, 0.f}; ai[mt] = (f32x4){0.f, 0.f, 0.f, 0.f}; }
#pragma unroll
        for (int ks = 0; ks < 4; ++ks)
#pragma unroll
            for (int mt = 0; mt < 4; ++mt) {
                const bf16x8 af = *(const LAS bf16x8*)(xcb + (mt * 16 + fr) * 136 + 32 * ks + 8 * fq);
                ar[mt] = __builtin_amdgcn_mfma_f32_16x16x32_bf16(Br[ks], af, ar[mt], 0, 0, 0);
                ai[mt] = __builtin_amdgcn_mfma_f32_16x16x32_bf16(Bi[ks], af, ai[mt], 0, 0, 0);
            }
#pragma unroll
        for (int mt = 0; mt < 4; ++mt) {
            const int tl = mt * 16 + fr, cl = 16 * wid + 4 * fq;
            const f32x4 rec = *(const LAS f32x4*)(xcf + tl * 132 + cl);
            f32x4 av, bv;
#pragma unroll
            for (int r = 0; r < 4; ++r) {
                const float rg = sigmoidf_(ar[mt][r] + brv[r]), ig = sigmoidf_(ai[mt][r] + biv[r]);
                const float log_a = -8.0f * rg * spv[r];
                av[r] = __expf(log_a);
                bv[r] = sqrtf(fmaxf(-expm1f(2.0f * log_a), 0.f)) * ig * rec[r];
            }
            *(f32x4*)(Aarr + (size_t)(t0 + tl) * D + cg) = av; *(f32x4*)(Barr + (size_t)(t0 + tl) * D + cg) = bv;
            *(LAS f32x4*)(sa + tl * 132 + cl) = av; *(LAS f32x4*)(sb + tl * 132 + cl) = bv;
        }
        __syncthreads();
        {
            const int j = tid & 127, q = tid >> 7;
            float P = 1.f, H = 0.f;
#pragma unroll
            for (int s_ = 0; s_ < 16; ++s_) { const float a = sa[(q * 16 + s_) * 132 + j], bb = sb[(q * 16 + s_) * 132 + j]; H = a * H + bb; P *= a; }
            comb[(q * 128 + j) * 2 + 0] = P; comb[(q * 128 + j) * 2 + 1] = H;
        }
        __syncthreads();
        if (tid < 128) {
            float P = comb[tid * 2], H = comb[tid * 2 + 1];
#pragma unroll
            for (int q = 1; q < 4; ++q) { const float Pq = comb[(q * 128 + tid) * 2], Hq = comb[(q * 128 + tid) * 2 + 1]; H = Pq * H + Hq; P *= Pq; }
            SP[(size_t)tile * D + hd * 128 + tid] = P; SH[(size_t)tile * D + hd * 128 + tid] = H;
        }
    }
}
__device__ __forceinline__ void lru_scan_phase(const Params& p) {
    const int tid = tid_();
    const bf16_t* u = (const bf16_t*)(p.ws + WS_U);
    const float* Aarr = (const float*)(p.ws + WS_SCR); const float* Barr = Aarr + (size_t)T * D;
    const float* SP = (const float*)(p.ws + WS_LSUM); const float* SH = SP + NBATCH * 32 * D;
    bf16_t* yin = (bf16_t*)(p.ws + WS_YIN);
    const int nunits = NBATCH * 32 * 2;
    for (int un = blockIdx.x; un < nunits; un += gridDim.x) {
        const int tile = un >> 1, c = (un & 1) * 512 + tid, b = tile >> 5, chunk = tile & 31;
        float h = 0.f;
        for (int k = 0; k < chunk; ++k) h = SP[(size_t)(b * 32 + k) * D + c] * h + SH[(size_t)(b * 32 + k) * D + c];
        const size_t tb = (size_t)tile * 64;
#pragma unroll 16
        for (int s_ = 0; s_ < 64; ++s_) {
            const size_t t = tb + s_;
            h = Aarr[t * D + c] * h + Barr[t * D + c];
            yin[t * D + c] = f2bf(gelu_fast(bf2f(u[t * 2048 + c])) * h);
        }
    }
}

typedef short s16x4 __attribute__((ext_vector_type(4)));
__device__ __forceinline__ s16x4 tr4(LAS const unsigned char* base, int row0, int col0, int stride, int lane) {
    const int q = (lane & 15) >> 2, pp = lane & 3;
    return __builtin_amdgcn_ds_read_tr16_b64_v4i16((LAS s16x4*)(base + (row0 + q) * stride + (col0 + 4 * pp) * 2));
}
__device__ __forceinline__ bf16x8 cat8(s16x4 a, s16x4 b) { return (bf16x8){a[0], a[1], a[2], a[3], b[0], b[1], b[2], b[3]}; }
__device__ __forceinline__ void ret_core_phase(LAS unsigned char* lds, const Params& p) {
    const int tid = tid_(), lane = tid & 63, wid = tid >> 6, fr = lane & 15, fq = lane >> 4;
    constexpr int KS = 544, VS = 160, SS = 528;
    LAS unsigned char* Kl = lds;
    LAS unsigned char* Vl = lds + 128 * KS;
    LAS unsigned char* Sl = Vl + 128 * VS;
    const bf16_t* u = (const bf16_t*)(p.ws + WS_U);
    float* RO = (float*)(p.ws + WS_SCR);
    for (int un = blockIdx.x; un < NBATCH * 4 * 8; un += gridDim.x) {
        const int b = un >> 5, h = (un >> 3) & 3, vs = un & 7;
        const float lg2 = log2f(1.0f - exp2f(-5.0f - (float)h));
        f32x4 Sacc[2][4];
#pragma unroll
        for (int dt = 0; dt < 2; ++dt)
#pragma unroll
            for (int vt = 0; vt < 4; ++vt) Sacc[dt][vt] = (f32x4){0.f, 0.f, 0.f, 0.f};
        for (int i = tid; i < 64 * SS / 16; i += NTHREADS) ((LAS u32x4*)Sl)[i] = (u32x4){0u, 0u, 0u, 0u};
        for (int chunk = 0; chunk < 16; ++chunk) {
            const size_t t0 = (size_t)b * SEQ + chunk * 128;
#pragma unroll
            for (int i = 0; i < 8; ++i) {
                const int piece = tid + NTHREADS * i, m = piece >> 5, ch = piece & 31;
                const u32x4 kv = *(const u32x4*)(u + (t0 + m) * 6144 + 1024 + h * 256 + ch * 8);
                const float sc = exp2f(-(float)(m + 1) * lg2) * 0.0625f;
                u32x4 w;
                w.x = pack2(__uint_as_float(kv.x << 16) * sc, __uint_as_float(kv.x & 0xffff0000u) * sc); w.y = pack2(__uint_as_float(kv.y << 16) * sc, __uint_as_float(kv.y & 0xffff0000u) * sc);
                w.z = pack2(__uint_as_float(kv.z << 16) * sc, __uint_as_float(kv.z & 0xffff0000u) * sc); w.w = pack2(__uint_as_float(kv.w << 16) * sc, __uint_as_float(kv.w & 0xffff0000u) * sc);
                *(LAS u32x4*)(Kl + m * KS + ch * 16) = w;
            }
#pragma unroll
            for (int i = 0; i < 2; ++i) {
                const int piece = tid + NTHREADS * i, m = piece >> 3, ch = piece & 7;
                *(LAS u32x4*)(Vl + m * VS + ch * 16) = *(const u32x4*)(u + (t0 + m) * 6144 + 2048 + h * 512 + vs * 64 + ch * 8);
            }
            bf16x8 Qf[8];
#pragma unroll
            for (int ks = 0; ks < 8; ++ks) Qf[ks] = *(const bf16x8*)(u + (t0 + 16 * wid + fr) * 6144 + h * 256 + 32 * ks + 8 * fq);
            __syncthreads();
            f32x4 sc[8];
#pragma unroll
            for (int mt = 0; mt < 8; ++mt) {
                sc[mt] = (f32x4){0.f, 0.f, 0.f, 0.f};
#pragma unroll
                for (int ks = 0; ks < 8; ++ks) {
                    const bf16x8 kf = *(const LAS bf16x8*)(Kl + (16 * mt + fr) * KS + (32 * ks + 8 * fq) * 2);
                    sc[mt] = __builtin_amdgcn_mfma_f32_16x16x32_bf16(kf, Qf[ks], sc[mt], 0, 0, 0);
                }
            }
            bf16x8 pf[4];
            const int nloc = 16 * wid + fr;
#pragma unroll
            for (int ks2 = 0; ks2 < 4; ++ks2) {
                float v[8];
#pragma unroll
                for (int t = 0; t < 2; ++t)
#pragma unroll
                    for (int r = 0; r < 4; ++r) { const int m = 32 * ks2 + 16 * t + 4 * fq + r; v[4 * t + r] = (m <= nloc) ? sc[2 * ks2 + t][r] : 0.f; }
                u32x4 w; w.x = pack2(v[0], v[1]); w.y = pack2(v[2], v[3]); w.z = pack2(v[4], v[5]); w.w = pack2(v[6], v[7]);
                pf[ks2] = __builtin_bit_cast(bf16x8, w);
            }
            f32x4 O[4];
#pragma unroll
            for (int vt = 0; vt < 4; ++vt) {
                O[vt] = (f32x4){0.f, 0.f, 0.f, 0.f};
#pragma unroll
                for (int ks2 = 0; ks2 < 4; ++ks2) {
                    const bf16x8 vf = cat8(tr4(Vl, 32 * ks2 + 4 * fq, 16 * vt, VS, lane), tr4(Vl, 32 * ks2 + 16 + 4 * fq, 16 * vt, VS, lane));
                    O[vt] = __builtin_amdgcn_mfma_f32_16x16x32_bf16(pf[ks2], vf, O[vt], 0, 0, 0);
                }
#pragma unroll
                for (int ks = 0; ks < 8; ++ks) {
                    const bf16x8 sf = *(const LAS bf16x8*)(Sl + (16 * vt + fr) * SS + (32 * ks + 8 * fq) * 2);
                    O[vt] = __builtin_amdgcn_mfma_f32_16x16x32_bf16(Qf[ks], sf, O[vt], 0, 0, 0);
                }
            }
#pragma unroll
            for (int r = 0; r < 4; ++r) {
                const int n = 16 * wid + 4 * fq + r;
                const float qd = exp2f((float)(n + 1) * lg2);
                float* op = RO + (t0 + n) * 2048 + h * 512 + vs * 64 + fr;
#pragma unroll
                for (int vt = 0; vt < 4; ++vt) op[16 * vt] = O[vt][r] * qd;
            }
#pragma unroll
            for (int ks3 = 0; ks3 < 4; ++ks3) {
                bf16x8 kt[2], vf[4];
#pragma unroll
                for (int dt = 0; dt < 2; ++dt) kt[dt] = cat8(tr4(Kl, 32 * ks3 + 8 * fq, 32 * wid + 16 * dt, KS, lane), tr4(Kl, 32 * ks3 + 8 * fq + 4, 32 * wid + 16 * dt, KS, lane));
#pragma unroll
                for (int vt = 0; vt < 4; ++vt) vf[vt] = cat8(tr4(Vl, 32 * ks3 + 8 * fq, 16 * vt, VS, lane), tr4(Vl, 32 * ks3 + 8 * fq + 4, 16 * vt, VS, lane));
#pragma unroll
                for (int dt = 0; dt < 2; ++dt)
#pragma unroll
                    for (int vt = 0; vt < 4; ++vt) Sacc[dt][vt] = __builtin_amdgcn_mfma_f32_16x16x32_bf16(kt[dt], vf[vt], Sacc[dt][vt], 0, 0, 0);
            }
            __syncthreads();
            const float cd = exp2f(128.0f * lg2);
#pragma unroll
            for (int dt = 0; dt < 2; ++dt)
#pragma unroll
                for (int vt = 0; vt < 4; ++vt) {
                    Sacc[dt][vt] *= cd;
                    u32x2 w; w.x = pack2(Sacc[dt][vt][0], Sacc[dt][vt][1]); w.y = pack2(Sacc[dt][vt][2], Sacc[dt][vt][3]);
                    *(LAS u32x2*)(Sl + (16 * vt + fr) * SS + (32 * wid + 16 * dt + 4 * fq) * 2) = w;
                }
        }
        __syncthreads();
    }
}
__device__ __forceinline__ void ret_norm_phase(LAS unsigned char* lds, const Params& p) {
    const int tid = tid_(), lane = tid & 63, wid = tid >> 6;
    LAS float* red = (LAS float*)lds;
    const bf16_t* u = (const bf16_t*)(p.ws + WS_U);
    const float* RO = (const float*)(p.ws + WS_SCR);
    bf16_t* yin = (bf16_t*)(p.ws + WS_YIN);
    for (int t = blockIdx.x; t < T; t += gridDim.x) {
        const f32x4 o = *(const f32x4*)(RO + (size_t)t * 2048 + tid * 4);
        const float ss = wave_sum(o[0] * o[0] + o[1] * o[1] + o[2] * o[2] + o[3] * o[3]);
        if (lane == 0) red[wid] = ss;
        __syncthreads();
        const float tot = red[(wid & ~1)] + red[(wid | 1)];
        const float rstd = rsqrtf(tot * (1.0f / 512.0f) + 1e-6f);
        const u32x2 gv = *(const u32x2*)(u + (size_t)t * 6144 + 4096 + tid * 4);
        const float g0 = __uint_as_float(gv.x << 16), g1 = __uint_as_float(gv.x & 0xffff0000u), g2 = __uint_as_float(gv.y << 16), g3 = __uint_as_float(gv.y & 0xffff0000u);
        u32x2 w; w.x = pack2(g0 * sigmoidf_(g0) * o[0] * rstd, g1 * sigmoidf_(g1) * o[1] * rstd); w.y = pack2(g2 * sigmoidf_(g2) * o[2] * rstd, g3 * sigmoidf_(g3) * o[3] * rstd);
        *(u32x2*)(yin + (size_t)t * 2048 + tid * 4) = w;
        __syncthreads();
    }
}

__device__ __forceinline__ void attn_core_phase(LAS unsigned char* lds, const Params& p) {
    const int tid = tid_(), lane = tid & 63, wid = tid >> 6, fr = lane & 15, fq = lane >> 4;
    constexpr int RS = 144, TILE = 272 * RS;
    LAS unsigned char* Kl = lds;
    LAS unsigned char* Vl = lds + TILE;
    const bf16_t* u = (const bf16_t*)(p.ws + WS_U);
    bf16_t* OP = (bf16_t*)(p.ws + WS_SCR);
    float* LSE = (float*)(p.ws + WS_SCR + 96 * MB);
    for (int i = tid; i < 16 * RS / 16; i += NTHREADS) { ((LAS u32x4*)(Kl + 256 * RS))[i] = (u32x4){0u, 0u, 0u, 0u}; ((LAS u32x4*)(Vl + 256 * RS))[i] = (u32x4){0u, 0u, 0u, 0u}; }
    for (int un = blockIdx.x; un < 3 * 2048; un += gridDim.x) {
        const int g = un >> 11, rem = un & 2047, b = rem >> 8, h = (rem >> 4) & 15, x = rem & 15;
        const int dl = (g == 0) ? 1 : (g == 1 ? 4 : 16), r_ = x & (dl - 1), n = x / dl;
        const float slope = exp2f(-0.5f * (float)(h + 1)) * (float)dl;
        const bf16_t* ub = u + (size_t)b * SEQ * 9216;
#pragma unroll
        for (int i = 0; i < 4; ++i) {
            const int piece = tid + NTHREADS * i, row = piece >> 3, ch = piece & 7;
            const int sk = ((n - 1) * 128 + row) * dl + r_;
            u32x4 kv = (u32x4){0u, 0u, 0u, 0u}, vv = (u32x4){0u, 0u, 0u, 0u};
            if (sk >= 0) { const bf16_t* src = ub + (size_t)sk * 9216 + h * 64 + ch * 8; kv = *(const u32x4*)(src + (3 + g) * 1024); vv = *(const u32x4*)(src + (6 + g) * 1024); }
            *(LAS u32x4*)(Kl + row * RS + ch * 16) = kv; *(LAS u32x4*)(Vl + row * RS + ch * 16) = vv;
        }
        const int qi = 16 * wid + fr, sq = (n * 128 + qi) * dl + r_;
        bf16x8 Qf[2];
#pragma unroll
        for (int ks = 0; ks < 2; ++ks) Qf[ks] = *(const bf16x8*)(ub + (size_t)sq * 9216 + g * 1024 + h * 64 + 32 * ks + 8 * fq);
        __syncthreads();
        f32x4 sc[9];
        float mx = -INFINITY;
#pragma unroll
        for (int kt = 0; kt < 9; ++kt) {
            sc[kt] = (f32x4){0.f, 0.f, 0.f, 0.f};
#pragma unroll
            for (int ks = 0; ks < 2; ++ks) {
                const bf16x8 kf = *(const LAS bf16x8*)(Kl + (16 * (wid + kt) + fr) * RS + (32 * ks + 8 * fq) * 2);
                sc[kt] = __builtin_amdgcn_mfma_f32_16x16x32_bf16(kf, Qf[ks], sc[kt], 0, 0, 0);
            }
#pragma unroll
            for (int r = 0; r < 4; ++r) {
                const int ki = 16 * (wid + kt) + 4 * fq + r, steps = qi + 128 - ki;
                const bool ok = (steps >= 0) && (steps <= 128) && (n > 0 || ki >= 128);
                const float v = ok ? sc[kt][r] * 0.125f - slope * (float)steps : -INFINITY;
                sc[kt][r] = v; mx = fmaxf(mx, v);
            }
        }
        mx = fmaxf(mx, __shfl_xor(mx, 16)); mx = fmaxf(mx, __shfl_xor(mx, 32));
        float l = 0.f;
#pragma unroll
        for (int kt = 0; kt < 9; ++kt)
#pragma unroll
            for (int r = 0; r < 4; ++r) { const float pv = __expf(sc[kt][r] - mx); sc[kt][r] = pv; l += pv; }
        l += __shfl_xor(l, 16); l += __shfl_xor(l, 32);
        f32x4 O[4];
#pragma unroll
        for (int dt = 0; dt < 4; ++dt) O[dt] = (f32x4){0.f, 0.f, 0.f, 0.f};
#pragma unroll
        for (int ks5 = 0; ks5 < 5; ++ks5) {
            const f32x4 p0 = sc[2 * ks5], p1 = (ks5 < 4) ? sc[(ks5 < 4) ? 2 * ks5 + 1 : 0] : (f32x4){0.f, 0.f, 0.f, 0.f};
            u32x4 w; w.x = pack2(p0[0], p0[1]); w.y = pack2(p0[2], p0[3]); w.z = pack2(p1[0], p1[1]); w.w = pack2(p1[2], p1[3]);
            const bf16x8 pf = __builtin_bit_cast(bf16x8, w);
#pragma unroll
            for (int dt = 0; dt < 4; ++dt) {
                const bf16x8 vf = cat8(tr4(Vl, 16 * (wid + 2 * ks5) + 4 * fq, 16 * dt, RS, lane), tr4(Vl, 16 * (wid + 2 * ks5 + 1) + 4 * fq, 16 * dt, RS, lane));
                O[dt] = __builtin_amdgcn_mfma_f32_16x16x32_bf16(vf, pf, O[dt], 0, 0, 0);
            }
        }
        const float inv = 1.0f / l;
        const size_t tq = (size_t)b * SEQ + sq;
#pragma unroll
        for (int dt = 0; dt < 4; ++dt) {
            u32x2 w; w.x = pack2(O[dt][0] * inv, O[dt][1] * inv); w.y = pack2(O[dt][2] * inv, O[dt][3] * inv);
            *(u32x2*)(OP + ((size_t)g * T + tq) * D + h * 64 + 16 * dt + 4 * fq) = w;
        }
        if (fq == 0) LSE[((size_t)g * T + tq) * 16 + h] = mx + __logf(l);
        __syncthreads();
    }
}
__device__ __forceinline__ void attn_merge_phase(const Params& p) {
    const int tid = tid_();
    const bf16_t* OP = (const bf16_t*)(p.ws + WS_SCR);
    const float* LSE = (const float*)(p.ws + WS_SCR + 96 * MB);
    bf16_t* yin = (bf16_t*)(p.ws + WS_YIN);
    for (size_t i = (size_t)blockIdx.x * NTHREADS + tid; i < (size_t)T * D / 8; i += (size_t)gridDim.x * NTHREADS) {
        const size_t t = i >> 7; const int c8 = (int)(i & 127), h = c8 >> 3;
        const float l0 = LSE[t * 16 + h], l1 = LSE[((size_t)T + t) * 16 + h], l2 = LSE[((size_t)2 * T + t) * 16 + h];
        const float m = fmaxf(l0, fmaxf(l1, l2));
        float w0 = __expf(l0 - m), w1 = __expf(l1 - m), w2 = __expf(l2 - m);
        const float inv = 1.0f / (w0 + w1 + w2); w0 *= inv; w1 *= inv; w2 *= inv;
        const u32x4 a = *(const u32x4*)(OP + t * D + c8 * 8), bq = *(const u32x4*)(OP + ((size_t)T + t) * D + c8 * 8), c = *(const u32x4*)(OP + ((size_t)2 * T + t) * D + c8 * 8);
        u32x4 o;
#define MRG(f) o.f = pack2(w0 * __uint_as_float(a.f << 16) + w1 * __uint_as_float(bq.f << 16) + w2 * __uint_as_float(c.f << 16), \
                           w0 * __uint_as_float(a.f & 0xffff0000u) + w1 * __uint_as_float(bq.f & 0xffff0000u) + w2 * __uint_as_float(c.f & 0xffff0000u))
        MRG(x); MRG(y); MRG(z); MRG(w);
#undef MRG
        *(u32x4*)(yin + t * D + c8 * 8) = o;
    }
}

__device__ __forceinline__ void ln1_router_phase(LAS unsigned char* lds, const Params& p, int layer) {
    const int tid = tid_(), lane = tid & 63, wid = tid >> 6, fr = lane & 15, fq = lane >> 4;
    constexpr int XS = 2064;
    LAS unsigned char* xh = lds;
    LAS unsigned char* xl = lds + 16 * XS;
    LAS float* part = (LAS float*)(lds + 32 * XS);
    LAS float* logit = part + 8 * 16 * 32;
    LAS int* tkE = (LAS int*)(logit + 16 * 32);
    LAS int* tkR = tkE + 512;
    LAS int* hist = tkR + 512;
    LAS int* hbase = hist + 32;
    float* xf = (float*)(p.ws + WS_XF); bf16_t* xb = (bf16_t*)(p.ws + WS_XB);
    const float* ymix = (const float*)(p.ws + WS_YMIX);
    int* tope = (int*)(p.ws + WS_TOPE); float* gates = (float*)(p.ws + WS_GATES); int* pos = (int*)(p.ws + WS_POS);
    unsigned char* xq = p.ws + WS_XQ; int* elist = (int*)(p.ws + WS_LIST);
    unsigned* ctl = (unsigned*)(p.ws + WS_CTL);
    const float* gain = p.ln_gain + (size_t)(layer * 2) * D; const float* bias = p.ln_bias + (size_t)(layer * 2) * D;
    const float* brt = p.moe_b_router + (size_t)layer * NEXP;
    const bf16_t* rth = (const bf16_t*)(p.ws + WS_RT) + (size_t)layer * 2 * NEXP * D; const bf16_t* rtl = rth + NEXP * D;
    bf16x8 Wh[2][4], Wl[2][4];
#pragma unroll
    for (int nt = 0; nt < 2; ++nt)
#pragma unroll
        for (int ks = 0; ks < 4; ++ks) { const size_t o = (size_t)(16 * nt + fr) * D + 128 * wid + 32 * ks + 8 * fq; Wh[nt][ks] = *(const bf16x8*)(rth + o); Wl[nt][ks] = *(const bf16x8*)(rtl + o); }
    if (tid < NEXP) hist[tid] = 0;
    int it = 0;
    for (int tile = blockIdx.x; tile < T / 16; tile += gridDim.x) {
#pragma unroll
        for (int tt = 0; tt < 2; ++tt) {
            const int trow = 2 * wid + tt; const size_t t = (size_t)tile * 16 + trow;
            f32x4 z[4];
#pragma unroll
            for (int i = 0; i < 4; ++i) { const int c = 256 * i + 4 * lane; z[i] = DN_ALPHA * *(const f32x4*)(xf + t * D + c) + *(const f32x4*)(ymix + t * D + c); }
            float sm = 0.f;
#pragma unroll
            for (int i = 0; i < 4; ++i) sm += (z[i][0] + z[i][1]) + (z[i][2] + z[i][3]);
            const float mean = wave_sum(sm) * (1.0f / D);
            float sq = 0.f;
#pragma unroll
            for (int i = 0; i < 4; ++i) { const f32x4 dd = z[i] - mean; sq += (dd[0] * dd[0] + dd[1] * dd[1]) + (dd[2] * dd[2] + dd[3] * dd[3]); }
            const float rstd = rsqrtf(wave_sum(sq) * (1.0f / D) + LN_EPS);
#pragma unroll
            for (int i = 0; i < 4; ++i) {
                const int c = 256 * i + 4 * lane;
                const f32x4 v = (z[i] - mean) * rstd * *(const f32x4*)(gain + c) + *(const f32x4*)(bias + c);
                *(f32x4*)(xf + t * D + c) = v;
                u32x2 wh; wh.x = pack2(v[0], v[1]); wh.y = pack2(v[2], v[3]);
                *(u32x2*)(xb + t * D + c) = wh;
                *(unsigned*)(xq + t * D + c) = pk_fp8x4(v[0], v[1], v[2], v[3]);
                const float r0 = v[0] - __uint_as_float(wh.x << 16), r1 = v[1] - __uint_as_float(wh.x & 0xffff0000u), r2 = v[2] - __uint_as_float(wh.y << 16), r3 = v[3] - __uint_as_float(wh.y & 0xffff0000u);
                u32x2 wl; wl.x = pack2(r0, r1); wl.y = pack2(r2, r3);
                *(LAS u32x2*)(xh + trow * XS + c * 2) = wh; *(LAS u32x2*)(xl + trow * XS + c * 2) = wl;
            }
        }
        __syncthreads();
        {
            f32x4 acc[2] = {(f32x4){0.f, 0.f, 0.f, 0.f}, (f32x4){0.f, 0.f, 0.f, 0.f}};
#pragma unroll
            for (int ks = 0; ks < 4; ++ks) {
                const bf16x8 ah = *(const LAS bf16x8*)(xh + fr * XS + (128 * wid + 32 * ks + 8 * fq) * 2), al = *(const LAS bf16x8*)(xl + fr * XS + (128 * wid + 32 * ks + 8 * fq) * 2);
#pragma unroll
                for (int nt = 0; nt < 2; ++nt) {
                    acc[nt] = __builtin_amdgcn_mfma_f32_16x16x32_bf16(Wh[nt][ks], ah, acc[nt], 0, 0, 0);
                    acc[nt] = __builtin_amdgcn_mfma_f32_16x16x32_bf16(Wh[nt][ks], al, acc[nt], 0, 0, 0);
                    acc[nt] = __builtin_amdgcn_mfma_f32_16x16x32_bf16(Wl[nt][ks], ah, acc[nt], 0, 0, 0);
                }
            }
#pragma unroll
            for (int nt = 0; nt < 2; ++nt) *(LAS f32x4*)(part + (wid * 16 + fr) * 32 + 16 * nt + 4 * fq) = acc[nt];
        }
        __syncthreads();
        {
            const int tk = tid >> 5, e = tid & 31;
            float sacc = brt[e];
#pragma unroll
            for (int w = 0; w < 8; ++w) sacc += part[(w * 16 + tk) * 32 + e];
            logit[tk * 32 + e] = sacc;
        }
        __syncthreads();
        if (tid < 16) {
            const size_t t = (size_t)tile * 16 + tid;
            float v0 = -INFINITY, v1 = -INFINITY, v2 = -INFINITY, v3 = -INFINITY; int i0 = 0, i1 = 0, i2 = 0, i3 = 0;
#pragma unroll
            for (int e = 0; e < NEXP; ++e) {
                const float v = logit[tid * 32 + e];
                if (v > v3) {
                    if (v > v0) { v3 = v2; i3 = i2; v2 = v1; i2 = i1; v1 = v0; i1 = i0; v0 = v; i0 = e; }
                    else if (v > v1) { v3 = v2; i3 = i2; v2 = v1; i2 = i1; v1 = v; i1 = e; }
                    else if (v > v2) { v3 = v2; i3 = i2; v2 = v; i2 = e; }
                    else { v3 = v; i3 = e; }
                }
            }
            const float e1 = __expf(v1 - v0), e2 = __expf(v2 - v0), e3 = __expf(v3 - v0), inv = 1.0f / (1.0f + e1 + e2 + e3);
            tope[t * 4 + 0] = i0; tope[t * 4 + 1] = i1; tope[t * 4 + 2] = i2; tope[t * 4 + 3] = i3;
            gates[t * 4 + 0] = inv; gates[t * 4 + 1] = e1 * inv; gates[t * 4 + 2] = e2 * inv; gates[t * 4 + 3] = e3 * inv;
            const int sl = (it & 7) * 16 + tid;
            tkE[sl * 4 + 0] = i0; tkR[sl * 4 + 0] = (int)atomicAdd((unsigned*)(hist + i0), 1u);
            tkE[sl * 4 + 1] = i1; tkR[sl * 4 + 1] = (int)atomicAdd((unsigned*)(hist + i1), 1u);
            tkE[sl * 4 + 2] = i2; tkR[sl * 4 + 2] = (int)atomicAdd((unsigned*)(hist + i2), 1u);
            tkE[sl * 4 + 3] = i3; tkR[sl * 4 + 3] = (int)atomicAdd((unsigned*)(hist + i3), 1u);
        }
        ++it;
        if ((it & 7) == 0 || tile + (int)gridDim.x >= T / 16) {
            __syncthreads();
            if (tid < NEXP) { const unsigned h = (unsigned)hist[tid]; hbase[tid] = h ? (int)atomicAdd(ctl + CW_CNT + layer * 64 + tid, h) : 0; hist[tid] = 0; }
            __syncthreads();
            const int nsl = (((it - 1) & 7) + 1) * 16;
            for (int a = tid; a < nsl * 4; a += NTHREADS) {
                const int sl = a >> 2, e = tkE[a], ps = hbase[e] + tkR[a];
                const int t = (tile - (((it - 1) & 7) - (sl >> 4)) * (int)gridDim.x) * 16 + (sl & 15);
                pos[t * 4 + (a & 3)] = ps; elist[(size_t)e * T + ps] = t;
            }
            __syncthreads();
        }
    }
    __syncthreads();
}
__device__ __forceinline__ void ln2_phase(LAS unsigned char* lds, const Params& p, int layer) {
    const int tid = tid_(), lane = tid & 63, wid = tid >> 6;
    moe_tables(lds, (const unsigned*)(p.ws + WS_CTL), layer);
    LAS const int* tab = (LAS const int*)(lds + TAB_OFF);
    const int* tope = (const int*)(p.ws + WS_TOPE); const int* pos = (const int*)(p.ws + WS_POS);
    float* xf = (float*)(p.ws + WS_XF); bf16_t* xb = (bf16_t*)(p.ws + WS_XB);
    const bf16_t* yrows = (const bf16_t*)(p.ws + WS_YROWS);
    const float* gates = (const float*)(p.ws + WS_GATES);
    const float* gain = p.ln_gain + (size_t)(layer * 2 + 1) * D; const float* bias = p.ln_bias + (size_t)(layer * 2 + 1) * D;
    for (int t = blockIdx.x * 8 + wid; t < T; t += gridDim.x * 8) {
        f32x4 z[4];
        int dk[4]; float gk[4];
#pragma unroll
        for (int k = 0; k < 4; ++k) { dk[k] = tab[tope[t * 4 + k]] * 256 + pos[t * 4 + k]; gk[k] = gates[t * 4 + k]; }
#pragma unroll
        for (int i = 0; i < 4; ++i) {
            const int c = 256 * i + 4 * lane;
            f32x4 f = (f32x4){0.f, 0.f, 0.f, 0.f};
#pragma unroll
            for (int k = 0; k < 4; ++k) { const u32x2 yv = *(const u32x2*)(yrows + (size_t)dk[k] * D + c);
                f[0] += gk[k] * __uint_as_float(yv.x << 16); f[1] += gk[k] * __uint_as_float(yv.x & 0xffff0000u); f[2] += gk[k] * __uint_as_float(yv.y << 16); f[3] += gk[k] * __uint_as_float(yv.y & 0xffff0000u); }
            z[i] = DN_ALPHA * *(const f32x4*)(xf + (size_t)t * D + c) + f;
        }
        float sm = 0.f;
#pragma unroll
        for (int i = 0; i < 4; ++i) sm += (z[i][0] + z[i][1]) + (z[i][2] + z[i][3]);
        const float mean = wave_sum(sm) * (1.0f / D);
        float sq = 0.f;
#pragma unroll
        for (int i = 0; i < 4; ++i) { const f32x4 dd = z[i] - mean; sq += (dd[0] * dd[0] + dd[1] * dd[1]) + (dd[2] * dd[2] + dd[3] * dd[3]); }
        const float rstd = rsqrtf(wave_sum(sq) * (1.0f / D) + LN_EPS);
#pragma unroll
        for (int i = 0; i < 4; ++i) {
            const int c = 256 * i + 4 * lane;
            z[i] = (z[i] - mean) * rstd * *(const f32x4*)(gain + c) + *(const f32x4*)(bias + c);
            if (layer == DEPTH - 1) *(f32x4*)(p.out + (size_t)t * D + c) = z[i];
            else { *(f32x4*)(xf + (size_t)t * D + c) = z[i]; u32x2 w; w.x = pack2(z[i][0], z[i][1]); w.y = pack2(z[i][2], z[i][3]); *(u32x2*)(xb + (size_t)t * D + c) = w; }
        }
    }
}

__device__ __forceinline__ void moe_scatter_phase(LAS unsigned char* lds, const Params& p, int layer) {
    const int tid = tid_();
    LAS int* pstart = (LAS int*)lds;
    unsigned* ctl = (unsigned*)(p.ws + WS_CTL);
    const int* tope = (const int*)(p.ws + WS_TOPE); const int* pos = (const int*)(p.ws + WS_POS);
    int* dest = (int*)(p.ws + WS_DEST); int* rowtok = (int*)(p.ws + WS_ROWTOK);
    if (tid == 0) {
        int acc = 0;
        for (int e = 0; e < NEXP; ++e) { const int c = (int)ctl[CW_CNT + layer * 64 + e]; pstart[e] = acc; pstart[32 + e] = c; acc += ((c + 255) >> 8) << 8; }
        pstart[64] = acc;
        if (blockIdx.x == 0) {
            ctl[CW_MDYN + layer * 64] = (unsigned)acc;
            for (int e = 0; e < NEXP; ++e) { const int nb = (pstart[32 + e] + 255) >> 8; for (int b = 0; b < nb; ++b) ctl[CW_TEXP + layer * 512 + (pstart[e] >> 8) + b] = (unsigned)e; }
        }
    }
    __syncthreads();
    for (int i = blockIdx.x * NTHREADS + tid; i < T * TOPK; i += gridDim.x * NTHREADS) {
        const int e = tope[i], row = pstart[e] + pos[i];
        dest[i] = row; rowtok[row] = i >> 2;
    }
    for (int i = blockIdx.x * NTHREADS + tid; i < NEXP * 256; i += gridDim.x * NTHREADS) {
        const int e = i >> 8, r = i & 255, c = pstart[32 + e], padded = ((c + 255) >> 8) << 8;
        if (c + r < padded) rowtok[pstart[e] + c + r] = 0;
    }
    __syncthreads();
}

constexpr int PH_PER_LAYER = 9;
constexpr int NPHASES = 1 + DEPTH * PH_PER_LAYER;
constexpr int LDS_BYTES = 132 * 1024;


#ifndef PHMASK
#define PHMASK 0x3FF
#endif
#define PHK(j) ((PHMASK >> (j)) & 1)
#ifndef PROBE_MASK
#define PROBE_MASK 0
#endif
#define REPS(j) ((((PROBE_MASK) >> (j)) & 1) ? 2 : 1)
#define IN(k) (lo <= (k) && (k) < hi)
#if MK_ONE_LAUNCH
#define SEAM(k) do { if (IN(k) && IN((k) + 1)) xcd_barrier_nv(bar.bar, bar.x, bar.st); } while (0)
#else
#define SEAM(k) do {} while (0)
#endif
template <int layer>
__device__ __forceinline__ void run_layer(const Params& p, LAS unsigned char* lds, const XcdBarrier& bar) {
    const int lo = p.ph_lo, hi = p.ph_hi;
    unsigned char* ws = p.ws;
    unsigned* ctl = (unsigned*)(ws + WS_CTL);
        constexpr int base = 1 + layer * PH_PER_LAYER, kind = layer % 3, idx = layer / 3;
        for (int rep_ = 0; rep_ < REPS(1); ++rep_) if (PHK(1) && IN(base + 0)) {
            constexpr int N = (kind == 0) ? 2048 : (kind == 1 ? 6144 : 9216);
            const bf16_t* Bt = (kind == 0) ? (const bf16_t*)(ws + WS_AWIN) + (size_t)idx * 2048 * D : (kind == 1 ? (const bf16_t*)(ws + WS_BWIN) : (const bf16_t*)(ws + WS_CWIN));
            g8::SchedPlain S; S.init(ws + WS_XB, Bt, T, N, D, (int)gridDim.x, (int)blockIdx.x);
            g8::EpiBf16 E{(bf16_t*)(ws + WS_U), N, nullptr, 0, 1.0f};
            g8::gemm_phase<g8::EpiBf16, g8::SchedPlain, false>(lds, D, S, E);
        }
        SEAM(base + 0);
        for (int rep_ = 0; rep_ < REPS(2); ++rep_) if (PHK(2) && IN(base + 1)) {
            if (kind == 0) lru_gates_phase(lds, p, idx);
            else if (kind == 1) ret_core_phase(lds, p);
            else attn_core_phase(lds, p);
        }
        SEAM(base + 1);
        for (int rep_ = 0; rep_ < REPS(3); ++rep_) if (PHK(3) && IN(base + 2)) {
            if (kind == 0) lru_scan_phase(p);
            else if (kind == 1) ret_norm_phase(lds, p);
            else attn_merge_phase(p);
        }
        SEAM(base + 2);
        for (int rep_ = 0; rep_ < REPS(4); ++rep_) if (PHK(4) && IN(base + 3)) {
            constexpr int K = (kind == 1) ? 2048 : D;
            const bf16_t* Bt = (kind == 0) ? (const bf16_t*)(ws + WS_AWOUT) + (size_t)idx * D * D : (kind == 1 ? (const bf16_t*)(ws + WS_BWOUT) : (const bf16_t*)(ws + WS_CWOUT));
            g8::SchedPlain S; S.init(ws + WS_YIN, Bt, T, D, K, (int)gridDim.x, (int)blockIdx.x);
            g8::EpiF32 E{(float*)(ws + WS_YMIX), D, nullptr, 0};
            g8::gemm_phase<g8::EpiF32, g8::SchedPlain, false>(lds, K, S, E);
        }
        SEAM(base + 3);
        for (int rep_ = 0; rep_ < REPS(5); ++rep_) if (PHK(5) && IN(base + 4)) ln1_router_phase(lds, p, layer);
        SEAM(base + 4);
        for (int rep_ = 0; rep_ < REPS(7); ++rep_) if (PHK(7) && IN(base + 6)) {
            moe_tables(lds, ctl, layer);
            g8::SchedGU S{(const char*)(ws + WS_XQ), (const char*)(ws + WS_GU) + (size_t)layer * NEXP * 2048 * D, (const int*)(ws + WS_LIST), (LAS const int*)(lds + TAB_OFF), (int)gridDim.x, (int)blockIdx.x};
            g8::EpiSwiglu E{ws + WS_HID, p.moe_b_gu + (size_t)layer * NEXP * 2048, 1.0f / GU_WSCALE};
            g8::gemm_phase<g8::EpiSwiglu, g8::SchedGU, true, 1>(lds, D, S, E);
        }
        SEAM(base + 6);
        for (int rep_ = 0; rep_ < REPS(8); ++rep_) if (PHK(8) && IN(base + 7)) {
            moe_tables(lds, ctl, layer);
            g8::SchedDown S{(const char*)(ws + WS_HID), (const char*)(ws + WS_DN) + (size_t)layer * NEXP * D * D, (LAS const int*)(lds + TAB_OFF), (int)gridDim.x, (int)blockIdx.x};
            g8::EpiBf16 E{(bf16_t*)(ws + WS_YROWS), D, p.moe_b_down + (size_t)layer * NEXP * D, D, 1.0f / DN_WSCALE};
            g8::gemm_phase<g8::EpiBf16, g8::SchedDown, false, 1>(lds, D, S, E);
        }
        SEAM(base + 7);
        for (int rep_ = 0; rep_ < REPS(9); ++rep_) if (PHK(9) && IN(base + 8)) ln2_phase(lds, p, layer);
        SEAM(base + 8);
    }
#undef IN
#undef SEAM
__global__ void __launch_bounds__(NTHREADS, 2) fwd_kernel(Params p) {
    extern __shared__ __attribute__((aligned(16))) unsigned char lds_raw[];
    LAS unsigned char* lds = (LAS unsigned char*)lds_raw;
    const int lo = p.ph_lo, hi = p.ph_hi;
    unsigned char* ws = p.ws;
    unsigned* ctl = (unsigned*)(ws + WS_CTL);
#if MK_ONE_LAUNCH
    volatile LAS unsigned* bst = (volatile LAS unsigned*)(lds + LDS_BYTES - 16);
    if (threadIdx.x == 0) { bst[0] = 0u; bst[1] = 0u; bst[2] = 0u; bst[3] = 0u; }
    __syncthreads();
    XcdBarrier bar = xcd_barrier_post(ctl, bst);
#define GRID_BAR() xcd_barrier_nv(bar.bar, bar.x, bar.st)
#else
    XcdBarrier bar; bar.bar = ctl; bar.x = 0; bar.st = nullptr;
#define GRID_BAR() do {} while (0)
#endif
#define IN(k) (lo <= (k) && (k) < hi)
#define SEAM(k) do { if (IN(k) && IN((k) + 1)) GRID_BAR(); } while (0)

    for (int rep_ = 0; rep_ < REPS(0); ++rep_) if (PHK(0) && IN(0)) {
        LAS float* tile = (LAS float*)lds;
        convert_big<true>(lds, p.moe_w_gu, ws + WS_GU, D, 2048, DEPTH * NEXP, GU_WSCALE);
        convert_big<true>(lds, p.moe_w_down, ws + WS_DN, D, D, DEPTH * NEXP, DN_WSCALE);
        convert_big<false>(lds, p.a_w_in, (bf16_t*)(ws + WS_AWIN), D, 2048, 2, 1.0f);
        convert_big<false>(lds, p.a_w_out, (bf16_t*)(ws + WS_AWOUT), D, D, 2, 1.0f);
        convert_big<false>(lds, p.b_w_in, (bf16_t*)(ws + WS_BWIN), D, 6144, 1, 1.0f);
        convert_big<false>(lds, p.b_w_out, (bf16_t*)(ws + WS_BWOUT), 2048, D, 1, 1.0f);
        convert_big<false>(lds, p.c_w_in, (bf16_t*)(ws + WS_CWIN), D, 9216, 1, 1.0f);
        convert_big<false>(lds, p.c_w_out, (bf16_t*)(ws + WS_CWOUT), D, D, 1, 1.0f);
        convert_job(tile, p.a_w_rgate, (bf16_t*)(ws + WS_AGT), 128, 128, 8);
        convert_job(tile, p.a_w_igate, (bf16_t*)(ws + WS_AGT) + (size_t)8 * 128 * 128, 128, 128, 8);
        convert_job(tile, p.a_w_rgate + (size_t)8 * 128 * 128, (bf16_t*)(ws + WS_AGT) + (size_t)16 * 128 * 128, 128, 128, 8);
        convert_job(tile, p.a_w_igate + (size_t)8 * 128 * 128, (bf16_t*)(ws + WS_AGT) + (size_t)24 * 128 * 128, 128, 128, 8);
        {
            bf16_t* rt = (bf16_t*)(ws + WS_RT);
            for (int i = blockIdx.x * NTHREADS + threadIdx.x; i < DEPTH * NEXP * D; i += gridDim.x * NTHREADS) {
                const int l = i / (NEXP * D), r_ = i % (NEXP * D), e = r_ / D, k = r_ % D;
                const float w = p.moe_w_router[((size_t)l * D + k) * NEXP + e];
                const bf16_t hi = f2bf(w); const bf16_t lo = f2bf(w - bf2f(hi));
                rt[((size_t)l * 2 + 0) * NEXP * D + (size_t)e * D + k] = hi; rt[((size_t)l * 2 + 1) * NEXP * D + (size_t)e * D + k] = lo;
            }
        }
        float* xf = (float*)(ws + WS_XF); bf16_t* xb = (bf16_t*)(ws + WS_XB);
        {
            const size_t stride = (size_t)gridDim.x * NTHREADS;
            for (size_t i = (size_t)blockIdx.x * NTHREADS + threadIdx.x; i < (size_t)T * D / 4; i += 4 * stride) {
                f32x4 v[4];
#pragma unroll
                for (int q = 0; q < 4; ++q) v[q] = *(const f32x4*)(p.x + (i + q * stride) * 4);
#pragma unroll
                for (int q = 0; q < 4; ++q) { *(f32x4*)(xf + (i + q * stride) * 4) = v[q]; u32x2 w; w.x = pack2(v[q][0], v[q][1]); w.y = pack2(v[q][2], v[q][3]); *(u32x2*)(xb + (i + q * stride) * 4) = w; }
            }
        }
    }
    SEAM(0);

    run_layer<0>(p, lds, bar); run_layer<1>(p, lds, bar); run_layer<2>(p, lds, bar); run_layer<3>(p, lds, bar);
#undef IN
#undef SEAM
}

extern "C" void kernel_launch(void* const* d_in, const int* in_sizes, int n_in, void* d_out, int out_size, void* d_ws, size_t ws_size, hipStream_t stream) {
    static int grid = 0;
    if (grid == 0) {
        if (n_in != 22 || out_size != T * D || ws_size < WS_END) { fprintf(stderr, "kernel_launch: unexpected shapes (n_in %d out %d ws %zu need %zu)\n", n_in, out_size, ws_size, (size_t)WS_END); grid = -1; return; }
        if (hipFuncSetAttribute((const void*)fwd_kernel, hipFuncAttributeMaxDynamicSharedMemorySize, LDS_BYTES) != hipSuccess) { fprintf(stderr, "kernel_launch: hipFuncSetAttribute failed\n"); grid = -1; return; }
        int dev = 0, cus = 0;
        if (hipGetDevice(&dev) != hipSuccess || hipDeviceGetAttribute(&cus, hipDeviceAttributeMultiprocessorCount, dev) != hipSuccess) { grid = -1; return; }
        grid = cus;
    }
    if (grid < 0) return;
    (void)hipMemsetAsync((char*)d_ws + WS_CTL, 0, CTL_BYTES, stream);
    Params p{};
    const float** pp = (const float**)&p;
    for (int i = 0; i < 22; ++i) pp[i] = (const float*)d_in[i];
    p.out = (float*)d_out; p.ws = (unsigned char*)d_ws;
#if MK_ONE_LAUNCH
    p.ph_lo = 0; p.ph_hi = NPHASES;
    hipLaunchKernelGGL(fwd_kernel, dim3(grid), dim3(NTHREADS), LDS_BYTES, stream, p);
#else
    for (int ph = 0; ph < NPHASES; ++ph) {
        p.ph_lo = ph; p.ph_hi = ph + 1;
        hipLaunchKernelGGL(fwd_kernel, dim3(grid), dim3(NTHREADS), LDS_BYTES, stream, p);
    }
#endif
}
```

```cpp
#include <hip/hip_runtime.h>
#include <stdint.h>
#include <stdio.h>

#ifndef MK_ONE_LAUNCH
#define MK_ONE_LAUNCH 1
#endif

#define LAS __attribute__((address_space(3)))
typedef unsigned short bf16_t;
typedef short bf16x8 __attribute__((ext_vector_type(8)));
typedef float f32x4 __attribute__((ext_vector_type(4)));
typedef unsigned u32x4 __attribute__((ext_vector_type(4)));
typedef unsigned u32x2 __attribute__((ext_vector_type(2)));

constexpr int T = 16384, D = 1024, SEQ = 2048, NBATCH = 8, DEPTH = 4;
constexpr int NEXP = 32, TOPK = 4;
constexpr int MAXROWS = 73728;
constexpr float DN_ALPHA = 1.681792830507429f;
constexpr float LN_EPS = 1e-5f;
constexpr float GU_WSCALE = 64.0f, DN_WSCALE = 128.0f;
constexpr int NTHREADS = 512;

constexpr size_t MB = 1ull << 20;
constexpr size_t WS_CTL = 0;
constexpr size_t CTL_BYTES = 65536;
constexpr size_t WS_AWIN = 1 * MB;
constexpr size_t WS_AWOUT = WS_AWIN + 8 * MB;
constexpr size_t WS_BWIN = WS_AWOUT + 4 * MB;
constexpr size_t WS_BWOUT = WS_BWIN + 12 * MB;
constexpr size_t WS_CWIN = WS_BWOUT + 4 * MB;
constexpr size_t WS_CWOUT = WS_CWIN + 18 * MB;
constexpr size_t WS_GU = WS_CWOUT + 2 * MB;
constexpr size_t WS_DN = WS_GU + 512 * MB;
constexpr size_t WS_XF = WS_DN + 256 * MB;
constexpr size_t WS_XB = WS_XF + 64 * MB;
constexpr size_t WS_U = WS_XB + 32 * MB;
constexpr size_t WS_YIN = WS_U + 288 * MB;
constexpr size_t WS_YMIX = WS_YIN + 64 * MB;
constexpr size_t WS_SCR = WS_YMIX + 64 * MB;
constexpr size_t WS_TOPE = WS_SCR + 128 * MB;
constexpr size_t WS_GATES = WS_TOPE + 256 * 1024;
constexpr size_t WS_POS = WS_GATES + 256 * 1024;
constexpr size_t WS_DEST = WS_POS + 256 * 1024;
constexpr size_t WS_ROWTOK = WS_DEST + 256 * 1024;
constexpr size_t WS_HID = WS_ROWTOK + 1 * MB;
constexpr size_t WS_YROWS = WS_HID + 144 * MB;
constexpr size_t WS_LSUM = WS_YROWS + 288 * MB;
constexpr size_t WS_AGT = WS_LSUM + 2 * MB;
constexpr size_t WS_RT = WS_AGT + 1 * MB;
constexpr size_t WS_XQ = WS_RT + 1 * MB;
constexpr size_t WS_LIST = WS_XQ + 16 * MB;
constexpr size_t WS_END = WS_LIST + 2 * MB;

constexpr int CW_CNT = 4096;
constexpr int CW_MDYN = 8192;
constexpr int CW_TEXP = 12288;

#define XB_TMO      128
#define XB_XCNT(j)  (256  + 64 * (j))
#define XB_XSUB(j)  (1280 + 64 * (j))
#define XB_XGEN(j)  (2304 + 64 * (j))
#define XB_TOP      3328
#define XB_TOPGEN   3392
#define XCD_BAR_WORDS 3456
#define XB_SPIN_CAP (1u << 22)

__device__ __forceinline__ unsigned xb_ld(unsigned* p)              { return __hip_atomic_load(p, __ATOMIC_RELAXED, __HIP_MEMORY_SCOPE_AGENT); }
__device__ __forceinline__ unsigned xb_add(unsigned* p, unsigned v) { return __hip_atomic_fetch_add(p, v, __ATOMIC_RELAXED, __HIP_MEMORY_SCOPE_AGENT); }
__device__ __forceinline__ unsigned xb_xcc_id() { return (unsigned)__builtin_amdgcn_s_getreg((3 << 11) | 20) & 0xFu; }
#define XB_SPIN(cond, bar) do { unsigned _sp = 0; while (cond) { __builtin_amdgcn_s_sleep(1); \
    if ((++_sp & 255u) == 0u) { if (xb_ld(&(bar)[XB_TMO])) break; if (_sp > XB_SPIN_CAP) { atomicAdd(&(bar)[XB_TMO], 1u); break; } } } } while (0)

struct XcdBarrier { unsigned* bar; unsigned x; volatile LAS unsigned* st; };

__device__ __forceinline__ XcdBarrier xcd_barrier_post(unsigned* bar, volatile LAS unsigned* st) {
    XcdBarrier b; b.bar = bar; b.x = xb_xcc_id(); b.st = st;
    if (threadIdx.x == 0) (void)xb_add(&bar[XB_XCNT(b.x)], 1u);
    return b;
}
__device__ __forceinline__ void xcd_barrier_complete(unsigned* bar, unsigned x, unsigned& nloc, unsigned& nx) {
    const unsigned G = gridDim.x * gridDim.y * gridDim.z;
    unsigned sum, cnt, mine, sp = 0u;
    for (;;) {
        sum = 0u; cnt = 0u; mine = 0u;
#pragma unroll
        for (unsigned j = 0; j < 16; ++j) { const unsigned c = xb_ld(&bar[XB_XCNT(j)]); sum += c; cnt += (c > 0u) ? 1u : 0u; mine = (j == x) ? c : mine; }
        if (sum == G) break;
        __builtin_amdgcn_s_sleep(1);
        if ((++sp & 255u) == 0u) { if (xb_ld(&bar[XB_TMO])) break; if (sp > XB_SPIN_CAP) { atomicAdd(&bar[XB_TMO], 1u); break; } }
    }
    nloc = mine > 0u ? mine : 1u; nx = cnt > 0u ? cnt : 1u;
}
__device__ __noinline__ void xcd_barrier_nv(unsigned* bbar, unsigned bx, volatile LAS unsigned* bst) {
    XcdBarrier b; b.bar = bbar; b.x = bx; b.st = bst;
    asm volatile("s_waitcnt vmcnt(0)" ::: "memory");
    __syncthreads();
    if (threadIdx.x == 0) {
        unsigned* bar = b.bar;
        __builtin_amdgcn_s_waitcnt(0);
        unsigned nloc = b.st[0], nx = b.st[1];
        if (nloc == 0u) { xcd_barrier_complete(bar, b.x, nloc, nx); b.st[0] = nloc; b.st[1] = nx; }
        const unsigned old = xb_add(&bar[XB_XSUB(b.x)], 1u);
        const unsigned gen = old / nloc;
        if (old + 1u == (gen + 1u) * nloc) {
            __builtin_amdgcn_fence(__ATOMIC_RELEASE, "agent");
            asm volatile("s_waitcnt vmcnt(0)" ::: "memory");
            const unsigned og = xb_add(&bar[XB_TOP], 1u);
            const unsigned tg = og / nx;
            if (og + 1u == (tg + 1u) * nx) xb_add(&bar[XB_TOPGEN], 1u);
            else XB_SPIN(xb_ld(&bar[XB_TOPGEN]) == tg, bar);
            __builtin_amdgcn_fence(__ATOMIC_ACQUIRE, "agent");
            xb_add(&bar[XB_XGEN(b.x)], 1u);
            asm volatile("s_waitcnt vmcnt(0)" ::: "memory");
        } else {
            XB_SPIN(xb_ld(&bar[XB_XGEN(b.x)]) == gen, bar);
            __builtin_amdgcn_fence(__ATOMIC_ACQUIRE, "agent");
            asm volatile("s_waitcnt vmcnt(0)" ::: "memory");
        }
    }
    __syncthreads();
}

__device__ __forceinline__ int tid_() { int t = threadIdx.x; asm volatile("" : "+v"(t)); return t; }
__device__ __forceinline__ float bf2f(bf16_t v) { return __uint_as_float(((unsigned)v) << 16); }
__device__ __forceinline__ bf16_t f2bf(float f) { unsigned u = __float_as_uint(f); u += 0x7FFFu + ((u >> 16) & 1u); return (bf16_t)(u >> 16); }
__device__ __forceinline__ unsigned pack2(float lo, float hi) { return (unsigned)f2bf(lo) | ((unsigned)f2bf(hi) << 16); }
__device__ __forceinline__ float wave_sum(float v) {
#pragma unroll
    for (int o = 32; o >= 1; o >>= 1) v += __shfl_xor(v, o);
    return v;
}
__device__ __forceinline__ float wave_max(float v) {
#pragma unroll
    for (int o = 32; o >= 1; o >>= 1) v = fmaxf(v, __shfl_xor(v, o));
    return v;
}
__device__ __forceinline__ float sigmoidf_(float x) { return 1.0f / (1.0f + __expf(-x)); }
__device__ __forceinline__ float gelu_tanh(float x) { const float u = 0.7978845608028654f * (x + 0.044715f * x * x * x); return 0.5f * x * (1.0f + tanhf(u)); }
__device__ __forceinline__ unsigned pk_fp8x4(float a, float b, float c, float d) { int w = 0; w = __builtin_amdgcn_cvt_pk_fp8_f32(a, b, w, false); w = __builtin_amdgcn_cvt_pk_fp8_f32(c, d, w, true); return (unsigned)w; }
__device__ __forceinline__ float swiglu(float gate, float up) {
    const float g = fminf(gate, 7.0f), u = fminf(fmaxf(up, -7.0f), 7.0f);
    return (u + 1.0f) * g * sigmoidf_(1.702f * g);
}

struct Params {
    const float* x; const float* a_w_in; const float* a_conv_w; const float* a_conv_b; const float* a_w_rgate; const float* a_b_rgate;
    const float* a_w_igate; const float* a_b_igate; const float* a_lambda; const float* a_w_out; const float* b_w_in; const float* b_w_out;
    const float* c_w_in; const float* c_w_out; const float* ln_gain; const float* ln_bias; const float* moe_w_router; const float* moe_b_router;
    const float* moe_w_gu; const float* moe_b_gu; const float* moe_w_down; const float* moe_b_down;
    float* out; unsigned char* ws;
    int ph_lo, ph_hi;
};

__device__ __forceinline__ void convert_job(LAS float* tile, const float* src, bf16_t* dst, int K, int N, int batch) {
    const int tid = tid_();
    const int tk = K / 64, tn = N / 64, per = tk * tn; const long total = (long)per * batch;
    for (long u = blockIdx.x; u < total; u += gridDim.x) {
        const int bidx = (int)(u / per), r = (int)(u % per), kt = r / tn, nt = r % tn;
        const float* s = src + (size_t)bidx * K * N + (size_t)(kt * 64) * N + nt * 64;
#pragma unroll
        for (int pass = 0; pass < 2; ++pass) {
            const int row = (tid >> 4) + 32 * pass, c4 = tid & 15;
            const f32x4 v = *(const f32x4*)(s + (size_t)row * N + c4 * 4);
            tile[row * 65 + c4 * 4 + 0] = v[0]; tile[row * 65 + c4 * 4 + 1] = v[1]; tile[row * 65 + c4 * 4 + 2] = v[2]; tile[row * 65 + c4 * 4 + 3] = v[3];
        }
        __syncthreads();
        {
            const int n = tid >> 3, k8 = tid & 7;
            float v[8];
#pragma unroll
            for (int j = 0; j < 8; ++j) v[j] = tile[(k8 * 8 + j) * 65 + n];
            u32x4 w; w.x = pack2(v[0], v[1]); w.y = pack2(v[2], v[3]); w.z = pack2(v[4], v[5]); w.w = pack2(v[6], v[7]);
            *(u32x4*)(dst + (size_t)bidx * N * K + (size_t)(nt * 64 + n) * K + kt * 64 + k8 * 8) = w;
        }
        __syncthreads();
    }
}

struct GemmS {
    const bf16_t* A; int lda;
    const bf16_t* Bt; int ldb;
    int M, N, K;
    const unsigned* Mdyn;
    const int* row_idx;
    const unsigned* tile_exp;
    size_t b_exp_stride;
    const float* bias; int bias_es;
    float* Cf; bf16_t* Cb; int ldc;
};
template <int MODE>
__device__ __forceinline__ void gemm_simple(LAS unsigned char* lds, const GemmS& g) {
    const int tid = tid_(), lane = tid & 63, wid = tid >> 6, wr = wid >> 1, wc = wid & 1, fr = lane & 15, fq = lane >> 4;
    const int M = g.Mdyn ? (int)*g.Mdyn : g.M;
    const int tiles_n = (MODE == 1) ? (g.N / 256) * 2 : g.N / 128;
    const int tiles_m = M / 128, nunits = tiles_m * tiles_n, nk = g.K / 32;
    LAS bf16_t* As = (LAS bf16_t*)lds;
    LAS bf16_t* Bs = As + 2 * 128 * 40;
    const int lrow = tid >> 2, lch = tid & 3;
    for (int u = blockIdx.x; u < nunits; u += gridDim.x) {
        const int tm = u / tiles_n, tn = u % tiles_n, m0 = tm * 128;
        const int e = (MODE != 0) ? (int)g.tile_exp[m0 >> 8] : 0;
        const bf16_t* Bbase = g.Bt + (size_t)e * g.b_exp_stride;
        int arow = m0 + lrow; if (MODE == 1) arow = g.row_idx[arow];
        int brow;
        if (MODE == 1) { const int bwc = lrow >> 6, ni = (lrow & 63) >> 4, r = lrow & 15; brow = ((ni & 1) ? 1024 : 0) + tn * 64 + bwc * 32 + (ni >> 1) * 16 + r; }
        else brow = tn * 128 + lrow;
        const bf16_t* ap = g.A + (size_t)arow * g.lda + lch * 8;
        const bf16_t* bp = Bbase + (size_t)brow * g.ldb + lch * 8;
        f32x4 acc[2][4];
#pragma unroll
        for (int mi = 0; mi < 2; ++mi)
#pragma unroll
            for (int ni = 0; ni < 4; ++ni) acc[mi][ni] = (f32x4){0.f, 0.f, 0.f, 0.f};
        u32x4 ra = *(const u32x4*)ap, rb = *(const u32x4*)bp;
        *(LAS u32x4*)(As + lrow * 40 + lch * 8) = ra; *(LAS u32x4*)(Bs + lrow * 40 + lch * 8) = rb;
        __syncthreads();
        for (int kt = 0; kt < nk; ++kt) {
            const int cur = kt & 1;
            if (kt + 1 < nk) { ra = *(const u32x4*)(ap + (kt + 1) * 32); rb = *(const u32x4*)(bp + (kt + 1) * 32); }
            bf16x8 af[2], bfr[4];
#pragma unroll
            for (int mi = 0; mi < 2; ++mi) af[mi] = *(const LAS bf16x8*)(As + cur * 5120 + (wr * 32 + mi * 16 + fr) * 40 + fq * 8);
#pragma unroll
            for (int ni = 0; ni < 4; ++ni) bfr[ni] = *(const LAS bf16x8*)(Bs + cur * 5120 + (wc * 64 + ni * 16 + fr) * 40 + fq * 8);
#pragma unroll
            for (int mi = 0; mi < 2; ++mi)
#pragma unroll
                for (int ni = 0; ni < 4; ++ni) acc[mi][ni] = __builtin_amdgcn_mfma_f32_16x16x32_bf16(bfr[ni], af[mi], acc[mi][ni], 0, 0, 0);
            if (kt + 1 < nk) { *(LAS u32x4*)(As + (cur ^ 1) * 5120 + lrow * 40 + lch * 8) = ra; *(LAS u32x4*)(Bs + (cur ^ 1) * 5120 + lrow * 40 + lch * 8) = rb; }
            __syncthreads();
        }
#pragma unroll
        for (int mi = 0; mi < 2; ++mi) {
            const int m = m0 + wr * 32 + mi * 16 + fr;
            if (MODE == 1) {
#pragma unroll
                for (int q = 0; q < 2; ++q) {
                    const int hc = tn * 64 + wc * 32 + q * 16 + 4 * fq;
                    const f32x4 bg = *(const f32x4*)(g.bias + (size_t)e * g.bias_es + hc), bu = *(const f32x4*)(g.bias + (size_t)e * g.bias_es + 1024 + hc);
                    const f32x4 gt = acc[mi][2 * q] + bg, up = acc[mi][2 * q + 1] + bu;
                    u32x2 w; w.x = pack2(swiglu(gt[0], up[0]), swiglu(gt[1], up[1])); w.y = pack2(swiglu(gt[2], up[2]), swiglu(gt[3], up[3]));
                    *(u32x2*)(g.Cb + (size_t)m * g.ldc + hc) = w;
                }
            } else {
#pragma unroll
                for (int ni = 0; ni < 4; ++ni) {
                    const int n = tn * 128 + wc * 64 + ni * 16 + 4 * fq;
                    f32x4 v = acc[mi][ni];
                    if (g.bias) v += *(const f32x4*)(g.bias + (size_t)e * g.bias_es + n);
                    if (g.Cf) *(f32x4*)(g.Cf + (size_t)m * g.ldc + n) = v;
                    else { u32x2 w; w.x = pack2(v[0], v[1]); w.y = pack2(v[2], v[3]); *(u32x2*)(g.Cb + (size_t)m * g.ldc + n) = w; }
                }
            }
        }
    }
}


constexpr int TAB_OFF = 131072;
__device__ __forceinline__ void moe_tables(LAS unsigned char* lds, const unsigned* ctl, int layer) {
    LAS int* tab = (LAS int*)(lds + TAB_OFF);
    const int tid = tid_();
    __syncthreads();
    if (tid == 0) { int acc = 0; for (int e = 0; e < NEXP; ++e) { tab[e] = acc; acc += ((int)ctl[CW_CNT + layer * 64 + e] + 255) >> 8; } tab[32] = acc; }
    __syncthreads();
    if (tid < 288) { int e = 0; for (int q = 1; q < NEXP; ++q) e += (tab[q] <= tid) ? 1 : 0; tab[64 + tid] = e; }
    __syncthreads();
}

namespace g8 {
constexpr int BM = 256, BK = 64, HALF = 128, HTB = HALF * BK * 2, STAGE_BYTES = 8 * HTB, NXCD = 8, WGM = 8;
__device__ __forceinline__ int lds_byte(int r, int c) { const int st = (r >> 4) * 2 + (c >> 5), rr = r & 15, cc = c & 31, ob = rr * 64 + cc * 2; return st * 1024 + (ob ^ (((ob >> 9) & 1) << 5)); }
__device__ __forceinline__ void stage_rc(int b, int& R, int& C) { const int st = b / 1024, sb = b % 1024, swz = sb ^ (((sb >> 9) & 1) << 5); R = (st >> 1) * 16 + swz / 64; C = (st & 1) * 32 + (swz % 64) / 2; }
__device__ __forceinline__ int perm32(int rho) { const int n = rho >> 4, i = rho & 15; return 8 * (i >> 2) + 4 * n + (i & 3); }
__device__ __forceinline__ unsigned cvt_pk_bf16(float lo, float hi) { unsigned r; asm volatile("v_cvt_pk_bf16_f32 %0, %1, %2" : "=v"(r) : "v"(lo), "v"(hi)); return r; }

struct Unit { const char* a0; const char* a1; const char* b0; const char* b1; const int* rows; int row0, col0, e; };

struct SchedPlain {
    const char* A; const char* Bt; size_t hstepA, hstepB; int nM, nN, nwg, G, c;
    __device__ __forceinline__ void init(const void* A_, const void* Bt_, int M, int N, int K, int G_, int c_) { A = (const char*)A_; Bt = (const char*)Bt_; hstepA = (size_t)HALF * K * 2; hstepB = hstepA; nM = M / BM; nN = N / BM; nwg = nM * nN; G = G_; c = c_; }
    __device__ __forceinline__ bool next(int i, Unit& u) const {
        const long L = (long)i * G + c; if (L >= nwg) return false;
        int wgid = (int)L; { const int q = nwg / NXCD, r = nwg % NXCD, xcd = wgid % NXCD, off = wgid / NXCD; wgid = (xcd < r ? xcd * (q + 1) : r * (q + 1) + (xcd - r) * q) + off; }
        const int nig = WGM * nN, gid = wgid / nig, fm = gid * WGM, gsz = (nM - fm) < WGM ? (nM - fm) : WGM;
        const int pm = fm + ((wgid % nig) % gsz), pn = (wgid % nig) / gsz;
        u.a0 = A + (size_t)pm * 2 * hstepA; u.a1 = u.a0 + hstepA; u.b0 = Bt + (size_t)pn * 2 * hstepB; u.b1 = u.b0 + hstepB; u.rows = nullptr; u.row0 = pm * BM; u.col0 = pn * BM; u.e = 0;
        return true;
    }
};
struct SchedGU {
    const char* A; const char* W; const int* elist; LAS const int* tab; int G, c;
    __device__ __forceinline__ bool next(int i, Unit& u) const {
        const int L = i * G + c, rt = L >> 3, pn = L & 7; if (rt >= __builtin_amdgcn_readfirstlane(tab[32])) return false;
        const int e = __builtin_amdgcn_readfirstlane(tab[64 + rt]), j = rt - __builtin_amdgcn_readfirstlane(tab[e]);
        u.a0 = A; u.a1 = A; u.rows = elist + (size_t)e * T + j * BM; u.b0 = W + ((size_t)e * 2048 + pn * 128) * D; u.b1 = u.b0 + (size_t)1024 * D; u.row0 = rt * BM; u.col0 = pn * 128; u.e = e;
        return true;
    }
};
struct SchedDown {
    const char* A; const char* W; LAS const int* tab; int G, c;
    __device__ __forceinline__ bool next(int i, Unit& u) const {
        const int L = i * G + c, rt = L >> 2, pn = L & 3; if (rt >= __builtin_amdgcn_readfirstlane(tab[32])) return false;
        const int e = __builtin_amdgcn_readfirstlane(tab[64 + rt]);
        u.a0 = A + (size_t)rt * BM * D; u.a1 = u.a0 + (size_t)HALF * D; u.rows = nullptr; u.b0 = W + ((size_t)e * 1024 + pn * BM) * D; u.b1 = u.b0 + (size_t)HALF * D; u.row0 = rt * BM; u.col0 = pn * BM; u.e = e;
        return true;
    }
};

struct EpiF32 {
    static constexpr bool PERM = false;
    float* C; int ldc; const float* bias; int bias_es;
    __device__ __forceinline__ void operator()(const f32x4 (&acc)[2][2][4][2], const Unit& u, int wr, int wc, int fr, int fq) const {
        const int row0 = u.row0 + wr * 64 + fr, col0 = u.col0 + wc * 32 + 4 * fq;
        f32x4 bv[2][2];
#pragma unroll
        for (int bj = 0; bj < 2; ++bj)
#pragma unroll
            for (int n = 0; n < 2; ++n) bv[bj][n] = bias ? *(const f32x4*)(bias + (size_t)u.e * bias_es + col0 + bj * HALF + n * 16) : (f32x4){0.f, 0.f, 0.f, 0.f};
#pragma unroll
        for (int ai = 0; ai < 2; ++ai)
#pragma unroll
            for (int m = 0; m < 4; ++m) { float* rowp = C + (size_t)(row0 + ai * HALF + m * 16) * ldc + col0;
#pragma unroll
                for (int bj = 0; bj < 2; ++bj)
#pragma unroll
                    for (int n = 0; n < 2; ++n) *(f32x4*)(rowp + bj * HALF + n * 16) = acc[ai][bj][m][n] + bv[bj][n]; }
    }
};
struct EpiBf16 {
    static constexpr bool PERM = true;
    bf16_t* O; int ldc; const float* bias; int bias_es; float scale;
    __device__ __forceinline__ void operator()(const f32x4 (&acc)[2][2][4][2], const Unit& u, int wr, int wc, int fr, int fq) const {
        const int row0 = u.row0 + wr * 64 + fr, col0 = u.col0 + wc * 32 + 8 * fq;
        f32x4 bv[2][2];
#pragma unroll
        for (int bj = 0; bj < 2; ++bj)
#pragma unroll
            for (int n = 0; n < 2; ++n) bv[bj][n] = bias ? *(const f32x4*)(bias + (size_t)u.e * bias_es + col0 + bj * HALF + 4 * n) : (f32x4){0.f, 0.f, 0.f, 0.f};
#pragma unroll
        for (int ai = 0; ai < 2; ++ai)
#pragma unroll
            for (int m = 0; m < 4; ++m) { bf16_t* rowp = O + (size_t)(row0 + ai * HALF + m * 16) * ldc + col0;
#pragma unroll
                for (int bj = 0; bj < 2; ++bj) { const f32x4 v0 = acc[ai][bj][m][0] * scale + bv[bj][0], v1 = acc[ai][bj][m][1] * scale + bv[bj][1];
                    u32x4 w; w.x = cvt_pk_bf16(v0[0], v0[1]); w.y = cvt_pk_bf16(v0[2], v0[3]); w.z = cvt_pk_bf16(v1[0], v1[1]); w.w = cvt_pk_bf16(v1[2], v1[3]);
                    *(u32x4*)(rowp + bj * HALF) = w; } }
    }
};
struct EpiSwiglu {
    static constexpr bool PERM = true;
    unsigned char* O; const float* bias; float scale;
    __device__ __forceinline__ void operator()(const f32x4 (&acc)[2][2][4][2], const Unit& u, int wr, int wc, int fr, int fq) const {
        const int row0 = u.row0 + wr * 64 + fr, hc = u.col0 + wc * 32 + 8 * fq;
        const float* bp = bias + (size_t)u.e * 2048 + hc;
        const f32x4 bg0 = *(const f32x4*)(bp), bg1 = *(const f32x4*)(bp + 4), bu0 = *(const f32x4*)(bp + 1024), bu1 = *(const f32x4*)(bp + 1028);
#pragma unroll
        for (int ai = 0; ai < 2; ++ai)
#pragma unroll
            for (int m = 0; m < 4; ++m) {
                const f32x4 g0 = acc[ai][0][m][0] * scale + bg0, g1 = acc[ai][0][m][1] * scale + bg1, u0 = acc[ai][1][m][0] * scale + bu0, u1 = acc[ai][1][m][1] * scale + bu1;
                u32x2 w; w.x = pk_fp8x4(swiglu(g0[0], u0[0]), swiglu(g0[1], u0[1]), swiglu(g0[2], u0[2]), swiglu(g0[3], u0[3]));
                w.y = pk_fp8x4(swiglu(g1[0], u1[0]), swiglu(g1[1], u1[1]), swiglu(g1[2], u1[2]), swiglu(g1[3], u1[3]));
                *(u32x2*)(O + (size_t)(row0 + ai * HALF + m * 16) * D + hc) = w;
            }
    }
};

typedef int i32x8 __attribute__((ext_vector_type(8)));
typedef int i32x4 __attribute__((ext_vector_type(4)));
template <class Epi, class Sched, bool GATHER, int ESZ = 2>
__device__ __forceinline__ void gemm_phase(LAS unsigned char* lds, const int K, const Sched& S, const Epi& E) {
    const int tid = tid_(), wid = __builtin_amdgcn_readfirstlane(tid >> 6), lane = tid & 63, wr = wid >> 2, wc = wid & 3, fr = lane & 15, fq = lane >> 4;
    const int nt = K * ESZ / 128, KP = K * ESZ;
    int sR[2], sC[2];
    unsigned voffB[2];
#pragma unroll
    for (int i = 0; i < 2; ++i) { stage_rc(tid * 16 + i * 8192, sR[i], sC[i]); const int Rb = Epi::PERM ? ((sR[i] & ~31) + perm32(sR[i] & 31)) : sR[i]; voffB[i] = (unsigned)(Rb * KP + sC[i] * 2); }
    unsigned cvA0[2], cvA1[2], nvA0[2], nvA1[2];
#define G8_VOFF(u, v0, v1) do { _Pragma("unroll") for (int _i = 0; _i < 2; ++_i) { \
        if (GATHER) { unsigned t0_ = (unsigned)(u).rows[sR[_i]], t1_ = (unsigned)(u).rows[HALF + sR[_i]]; t0_ = t0_ < (unsigned)T ? t0_ : 0u; t1_ = t1_ < (unsigned)T ? t1_ : 0u;     \
            v0[_i] = t0_ * (unsigned)KP + (unsigned)(sC[_i] * 2); v1[_i] = t1_ * (unsigned)KP + (unsigned)(sC[_i] * 2); } \
        else { v0[_i] = (unsigned)(sR[_i] * KP + sC[_i] * 2); v1[_i] = v0[_i]; } } } while (0)
    const size_t kstep = (size_t)(BK * 2);
    const unsigned ldsw = (unsigned)wid * 1024u;
    const int aoff = lds_byte(wr * 64 + fr, fq * 8), boff = lds_byte(wc * 32 + fr, fq * 8);
#define PG8_SA(b, h) (((b) * 2 + (h)) * HTB)
#define PG8_SB(b, h) ((4 + (b) * 2 + (h)) * HTB)
#define PG8_STAGE(bufoff, gbase, voff) do { _Pragma("unroll") for (int _i = 0; _i < 2; ++_i) \
        __builtin_amdgcn_global_load_lds((const unsigned*)((const char*)(gbase) + (voff)[_i]), (LAS unsigned*)(lds + (bufoff) + ldsw + _i * 8192), 16, 0, 0); } while (0)
#define PG8_LDA(dst, b, h) do { _Pragma("unroll") for (int m = 0; m < 4; ++m) { dst[m].lo = *(const LAS i32x4*)(lds + PG8_SA(b, h) + aoff + m * 2048); dst[m].hi = *(const LAS i32x4*)(lds + PG8_SA(b, h) + aoff + m * 2048 + 1024); } } while (0)
#define PG8_LDB(dst, b, h) do { _Pragma("unroll") for (int n = 0; n < 2; ++n) { dst[n].lo = *(const LAS i32x4*)(lds + PG8_SB(b, h) + boff + n * 2048); dst[n].hi = *(const LAS i32x4*)(lds + PG8_SB(b, h) + boff + n * 2048 + 1024); } } while (0)
#define PG8_MMA(ai, bj, At, Bt) do { __builtin_amdgcn_s_setprio(1); _Pragma("unroll") for (int m = 0; m < 4; ++m) _Pragma("unroll") for (int n = 0; n < 2; ++n) { \
        if (ESZ == 2) { acc[ai][bj][m][n] = __builtin_amdgcn_mfma_f32_16x16x32_bf16(__builtin_bit_cast(bf16x8, (i32x4)__builtin_shufflevector(Bt[n], Bt[n], 0, 1, 2, 3)), __builtin_bit_cast(bf16x8, (i32x4)__builtin_shufflevector(At[m], At[m], 0, 1, 2, 3)), acc[ai][bj][m][n], 0, 0, 0); \
                        acc[ai][bj][m][n] = __builtin_amdgcn_mfma_f32_16x16x32_bf16(__builtin_bit_cast(bf16x8, (i32x4)__builtin_shufflevector(Bt[n], Bt[n], 4, 5, 6, 7)), __builtin_bit_cast(bf16x8, (i32x4)__builtin_shufflevector(At[m], At[m], 4, 5, 6, 7)), acc[ai][bj][m][n], 0, 0, 0); } \
        else asm volatile("v_mfma_f32_16x16x128_f8f6f4 %0, %1, %2, %0" : "+v"(acc[ai][bj][m][n]) : "v"(Bt[n]), "v"(At[m])); } __builtin_amdgcn_s_setprio(0); } while (0)
#define PG8_WAIT_V(n) asm volatile("s_waitcnt vmcnt(" #n ")" ::: "memory")
#define PG8_WAIT_L(n) asm volatile("s_waitcnt lgkmcnt(" #n ")" ::: "memory")
#define PG8_BAR __builtin_amdgcn_s_barrier()
#define PG8_SCHED __builtin_amdgcn_sched_barrier(0)
    Unit cur, nxt; int ui = 0;
    if (!S.next(0, cur)) return;
    f32x4 acc[2][2][4][2];
#pragma unroll
    for (int a = 0; a < 2; ++a)
#pragma unroll
        for (int b = 0; b < 2; ++b)
#pragma unroll
            for (int m = 0; m < 4; ++m)
#pragma unroll
                for (int n = 0; n < 2; ++n) acc[a][b][m][n] = (f32x4){0.f, 0.f, 0.f, 0.f};
    i32x8 At[4], B0[2], B1[2];
    const char* cA0 = cur.a0; const char* cA1 = cur.a1; const char* cB0 = cur.b0; const char* cB1 = cur.b1;
    G8_VOFF(cur, cvA0, cvA1);
    PG8_STAGE(PG8_SB(0, 0), cB0, voffB); PG8_STAGE(PG8_SB(0, 1), cB1, voffB); PG8_STAGE(PG8_SA(0, 0), cA0, cvA0); PG8_STAGE(PG8_SA(0, 1), cA1, cvA1);
    if (wr == 1) PG8_BAR;
    PG8_WAIT_V(2); PG8_BAR;
    PG8_STAGE(PG8_SB(1, 0), cB0 + kstep, voffB); PG8_STAGE(PG8_SA(1, 0), cA0 + kstep, cvA0); PG8_STAGE(PG8_SB(1, 1), cB1 + kstep, voffB);
    PG8_WAIT_V(6); PG8_BAR;
    for (;;) {
        const bool has_next = S.next(ui + 1, nxt);
        const char* nA0 = has_next ? nxt.a0 : cA0; const char* nA1 = has_next ? nxt.a1 : cA1; const char* nB0 = has_next ? nxt.b0 : cB0; const char* nB1 = has_next ? nxt.b1 : cB1;
        if (GATHER) { if (has_next) { G8_VOFF(nxt, nvA0, nvA1); } else { nvA0[0] = cvA0[0]; nvA0[1] = cvA0[1]; nvA1[0] = cvA1[0]; nvA1[1] = cvA1[1]; } }
#pragma unroll 1
        for (int t = 0; t < nt; t += 2) {
            const bool last = (t == nt - 2);
            const char* a1_1 = cA1 + (size_t)(t + 1) * kstep;
            const char* a2_0 = last ? nA0 : cA0 + (size_t)(t + 2) * kstep; const char* a2_1 = last ? nA1 : cA1 + (size_t)(t + 2) * kstep;
            const char* b2_0 = last ? nB0 : cB0 + (size_t)(t + 2) * kstep; const char* b2_1 = last ? nB1 : cB1 + (size_t)(t + 2) * kstep;
            const char* a3_0 = a2_0 + kstep; const char* b3_0 = b2_0 + kstep; const char* b3_1 = b2_1 + kstep;
            unsigned vA0[2], vA1[2];
            if (GATHER) { vA0[0] = last ? nvA0[0] : cvA0[0]; vA0[1] = last ? nvA0[1] : cvA0[1]; vA1[0] = last ? nvA1[0] : cvA1[0]; vA1[1] = last ? nvA1[1] : cvA1[1]; }
            else { vA0[0] = cvA0[0]; vA0[1] = cvA0[1]; vA1[0] = cvA0[0]; vA1[1] = cvA0[1]; }
            PG8_LDB(B0, 0, 0); PG8_LDB(B1, 0, 1); PG8_SCHED; PG8_LDA(At, 0, 0); PG8_STAGE(PG8_SA(1, 1), a1_1, cvA1);
            PG8_WAIT_V(8); PG8_WAIT_L(0); PG8_BAR; PG8_MMA(0, 0, At, B0); PG8_MMA(0, 1, At, B1); PG8_BAR; PG8_SCHED;
            PG8_LDA(At, 0, 1); PG8_STAGE(PG8_SB(0, 0), b2_0, voffB); PG8_STAGE(PG8_SB(0, 1), b2_1, voffB); PG8_STAGE(PG8_SA(0, 0), a2_0, vA0);
            PG8_WAIT_V(8); PG8_WAIT_L(0); PG8_BAR; PG8_MMA(1, 0, At, B0); PG8_MMA(1, 1, At, B1); PG8_BAR; PG8_SCHED;
            PG8_LDB(B0, 1, 0); PG8_LDB(B1, 1, 1); PG8_SCHED; PG8_LDA(At, 1, 0); PG8_STAGE(PG8_SA(0, 1), a2_1, vA1);
            PG8_WAIT_V(8); PG8_WAIT_L(0); PG8_BAR; PG8_MMA(0, 0, At, B0); PG8_MMA(0, 1, At, B1); PG8_BAR; PG8_SCHED;
            PG8_LDA(At, 1, 1); PG8_STAGE(PG8_SB(1, 0), b3_0, voffB); PG8_STAGE(PG8_SB(1, 1), b3_1, voffB); PG8_STAGE(PG8_SA(1, 0), a3_0, vA0);
            PG8_WAIT_V(8); PG8_WAIT_L(0); PG8_BAR; PG8_MMA(1, 0, At, B0); PG8_MMA(1, 1, At, B1); PG8_BAR; PG8_SCHED;
        }
        if (wr == 0) PG8_BAR;
        if (ESZ == 1) asm volatile("s_nop 15\n\ts_nop 15" ::: "memory");
        E(acc, cur, wr, wc, fr, fq);
        if (!has_next) break;
#pragma unroll
        for (int a = 0; a < 2; ++a)
#pragma unroll
            for (int b = 0; b < 2; ++b)
#pragma unroll
                for (int m = 0; m < 4; ++m)
#pragma unroll
                    for (int n = 0; n < 2; ++n) acc[a][b][m][n] = (f32x4){0.f, 0.f, 0.f, 0.f};
        cur = nxt; cA0 = nA0; cA1 = nA1; cB0 = nB0; cB1 = nB1; ++ui;
        if (GATHER) { cvA0[0] = nvA0[0]; cvA0[1] = nvA0[1]; cvA1[0] = nvA1[0]; cvA1[1] = nvA1[1]; }
        if (wr == 1) PG8_BAR;
    }
    PG8_WAIT_V(0);
    PG8_BAR;
#undef G8_VOFF
#undef PG8_SA
#undef PG8_SB
#undef PG8_STAGE
#undef PG8_LDA
#undef PG8_LDB
#undef PG8_MMA
#undef PG8_WAIT_V
#undef PG8_WAIT_L
#undef PG8_BAR
#undef PG8_SCHED
}
}


template <bool F8>
__device__ __forceinline__ void convert_big(LAS unsigned char* lds, const float* src, void* dstv, int K, int N, int batch, float scale) {
    const int tid = tid_(), lane = tid & 63, wid = tid >> 6;
    const int nbn = N / 256, per = (K / 128) * nbn, total = per * batch, G = (int)gridDim.x;
    constexpr int ESZ = F8 ? 1 : 2, ROWB = 128 * ESZ, TILEB = 256 * ROWB;
    f32x4 ra[16], rb[16];
#define CV_LOAD(uu, reg) do { const int bidx = (uu) / per, r_ = (uu) % per, kb = r_ / nbn, nb = r_ % nbn; \
        const float* sp = src + (size_t)bidx * K * N + (size_t)(kb * 128 + 16 * wid) * N + nb * 256 + 4 * lane; \
        _Pragma("unroll") for (int i = 0; i < 16; ++i) reg[i] = *(const f32x4*)(sp + (size_t)i * N); } while (0)
#define CV_PACK(reg, tl) do { _Pragma("unroll") for (int j = 0; j < 4; ++j) { \
        if (F8) { u32x4 w0; w0.x = pk_fp8x4(reg[0][j] * scale, reg[1][j] * scale, reg[2][j] * scale, reg[3][j] * scale); w0.y = pk_fp8x4(reg[4][j] * scale, reg[5][j] * scale, reg[6][j] * scale, reg[7][j] * scale); \
            w0.z = pk_fp8x4(reg[8][j] * scale, reg[9][j] * scale, reg[10][j] * scale, reg[11][j] * scale); w0.w = pk_fp8x4(reg[12][j] * scale, reg[13][j] * scale, reg[14][j] * scale, reg[15][j] * scale); \
            *(LAS u32x4*)((tl) + (4 * lane + j) * ROWB + ((wid ^ (lane & 7)) * 16)) = w0; } \
        else { u32x4 w0, w1; \
            w0.x = g8::cvt_pk_bf16(reg[0][j], reg[1][j]); w0.y = g8::cvt_pk_bf16(reg[2][j], reg[3][j]); w0.z = g8::cvt_pk_bf16(reg[4][j], reg[5][j]); w0.w = g8::cvt_pk_bf16(reg[6][j], reg[7][j]); \
            w1.x = g8::cvt_pk_bf16(reg[8][j], reg[9][j]); w1.y = g8::cvt_pk_bf16(reg[10][j], reg[11][j]); w1.z = g8::cvt_pk_bf16(reg[12][j], reg[13][j]); w1.w = g8::cvt_pk_bf16(reg[14][j], reg[15][j]); \
            *(LAS u32x4*)((tl) + (4 * lane + j) * ROWB + (((2 * wid) ^ (lane & 15)) * 16)) = w0; *(LAS u32x4*)((tl) + (4 * lane + j) * ROWB + (((2 * wid + 1) ^ (lane & 15)) * 16)) = w1; } } } while (0)
#define CV_STORE(uu, tl) do { const int bidx = (uu) / per, r_ = (uu) % per, kb = r_ / nbn, nb = r_ % nbn; \
        unsigned char* dp = (unsigned char*)dstv + ((size_t)bidx * N * K + (size_t)(nb * 256) * K + kb * 128) * ESZ; \
        _Pragma("unroll") for (int i = 0; i < 4 * ESZ; ++i) { const int pc = tid + NTHREADS * i, n = pc / (8 * ESZ), c = pc % (8 * ESZ); \
            *(u32x4*)(dp + (size_t)n * K * ESZ + c * 16) = *(const LAS u32x4*)((tl) + n * ROWB + ((c ^ ((n >> 2) & (8 * ESZ - 1))) * 16)); } } while (0)
    const int u0 = blockIdx.x;
    if (u0 < total) CV_LOAD(u0, ra);
    if (u0 + G < total) CV_LOAD(u0 + G, rb);
    for (int u = u0; u < total; u += 2 * G) {
        CV_PACK(ra, lds);
        if (u + 2 * G < total) CV_LOAD(u + 2 * G, ra);
        __syncthreads();
        CV_STORE(u, lds);
        const bool has_b = (u + G < total);
        if (has_b) { CV_PACK(rb, lds + TILEB); if (u + 3 * G < total) CV_LOAD(u + 3 * G, rb); }
        __syncthreads();
        if (has_b) CV_STORE(u + G, lds + TILEB);
    }
    __syncthreads();
#undef CV_LOAD
#undef CV_PACK
#undef CV_STORE
}

__device__ __forceinline__ float gelu_fast(float x) { const float u2 = 1.5957691216057308f * (x + 0.044715f * x * x * x); return x / (1.0f + __expf(-u2)); }
__device__ __forceinline__ void lru_gates_phase(LAS unsigned char* lds, const Params& p, int idx) {
    const int tid = tid_(), lane = tid & 63, wid = tid >> 6, fr = lane & 15, fq = lane >> 4;
    LAS bf16_t* xcb = (LAS bf16_t*)lds;
    LAS float* xcf = (LAS float*)(lds + 17408);
    LAS float* sa = (LAS float*)(lds + 17408 + 33792);
    LAS float* sb = sa + 64 * 132;
    LAS float* comb = sb + 64 * 132;
    const bf16_t* u = (const bf16_t*)(p.ws + WS_U);
    bf16_t* Carr = (bf16_t*)(p.ws + WS_SCR); bf16_t* Barr = Carr + (size_t)T * D;
    float* SP = (float*)(p.ws + WS_LSUM); float* SH = SP + NBATCH * 32 * D;
    const int hd = blockIdx.x & 7, slot = blockIdx.x >> 3, nslots = gridDim.x >> 3;
    const float* conv_w = p.a_conv_w + (size_t)idx * 4 * D; const float* conv_b = p.a_conv_b + (size_t)idx * D;
    const bf16_t* wrt = (const bf16_t*)(p.ws + WS_AGT) + ((size_t)(idx * 2 + 0) * 8 + hd) * 128 * 128;
    const bf16_t* wit = (const bf16_t*)(p.ws + WS_AGT) + ((size_t)(idx * 2 + 1) * 8 + hd) * 128 * 128;
    bf16x8 Br[4], Bi[4];
#pragma unroll
    for (int ks = 0; ks < 4; ++ks) { Br[ks] = *(const bf16x8*)(wrt + (size_t)(16 * wid + fr) * 128 + 32 * ks + 8 * fq); Bi[ks] = *(const bf16x8*)(wit + (size_t)(16 * wid + fr) * 128 + 32 * ks + 8 * fq); }
    const int cg = hd * 128 + 16 * wid + 4 * fq;
    const f32x4 brv = *(const f32x4*)(p.a_b_rgate + (size_t)idx * D + cg), biv = *(const f32x4*)(p.a_b_igate + (size_t)idx * D + cg), lmv = *(const f32x4*)(p.a_lambda + (size_t)idx * D + cg);
    f32x4 spv;
#pragma unroll
    for (int r = 0; r < 4; ++r) spv[r] = (lmv[r] > 15.f) ? __expf(-lmv[r]) : log1pf(__expf(-lmv[r]));
    const int cc = (tid & 31) * 4, cch = hd * 128 + cc;
    f32x4 cw[4];
#pragma unroll
    for (int j = 0; j < 4; ++j) cw[j] = *(const f32x4*)(conv_w + j * D + cch);
    const f32x4 cb = *(const f32x4*)(conv_b + cch);
    for (int tile = slot; tile < T / 64; tile += nslots) {
        const int t0 = tile * 64;
#pragma unroll
        for (int k = 0; k < 4; ++k) {
            const int tl = (tid >> 5) + 16 * k, t = t0 + tl, s_ = t & (SEQ - 1);
            f32x4 acc = cb;
#pragma unroll
            for (int j = 0; j < 4; ++j) {
                if (s_ - 3 + j >= 0) {
                    const u32x2 rv = *(const u32x2*)(u + (size_t)(t - 3 + j) * 2048 + 1024 + cch);
                    acc[0] += cw[j][0] * __uint_as_float(rv.x << 16); acc[1] += cw[j][1] * __uint_as_float(rv.x & 0xffff0000u);
                    acc[2] += cw[j][2] * __uint_as_float(rv.y << 16); acc[3] += cw[j][3] * __uint_as_float(rv.y & 0xffff0000u);
                }
            }
            *(LAS f32x4*)(xcf + tl * 132 + cc) = acc;
            u32x2 w; w.x = pack2(acc[0], acc[1]); w.y = pack2(acc[2], acc[3]);
            *(LAS u32x2*)(xcb + tl * 136 + cc) = w;
        }
        __syncthreads();
        f32x4 ar[4], ai[4];
#pragma unroll
        for (int mt = 0; mt < 4; ++mt) { ar[mt] = (f32x4){0.f, 0.f, 0.f, 0.f}; ai[mt] = (f32x4){0.f, 0.f, 0.f, 0.f}; }
#pragma unroll
        for (int ks = 0; ks < 4; ++ks)
#pragma unroll
            for (int mt = 0; mt < 4; ++mt) {
                const bf16x8 af = *(const LAS bf16x8*)(xcb + (mt * 16 + fr) * 136 + 32 * ks + 8 * fq);
                ar[mt] = __builtin_amdgcn_mfma_f32_16x16x32_bf16(Br[ks], af, ar[mt], 0, 0, 0);
                ai[mt] = __builtin_amdgcn_mfma_f32_16x16x32_bf16(Bi[ks], af, ai[mt], 0, 0, 0);
            }
#pragma unroll
        for (int mt = 0; mt < 4; ++mt) {
            const int tl = mt * 16 + fr, cl = 16 * wid + 4 * fq;
            const f32x4 rec = *(const LAS f32x4*)(xcf + tl * 132 + cl);
            f32x4 av, bv, cv;
#pragma unroll
            for (int r = 0; r < 4; ++r) {
                const float rg = sigmoidf_(ar[mt][r] + brv[r]), ig = sigmoidf_(ai[mt][r] + biv[r]);
                const float log_a = -8.0f * rg * spv[r];
                const float cc_ = bf2f(f2bf(-expm1f(log_a)));
                av[r] = 1.0f - cc_; cv[r] = cc_;
                bv[r] = bf2f(f2bf(sqrtf(fmaxf(-expm1f(2.0f * log_a), 0.f)) * ig * rec[r]));
            }
            { u32x2 wc_, wb_; wc_.x = pack2(cv[0], cv[1]); wc_.y = pack2(cv[2], cv[3]); wb_.x = pack2(bv[0], bv[1]); wb_.y = pack2(bv[2], bv[3]);
              *(u32x2*)(Carr + (size_t)(t0 + tl) * D + cg) = wc_; *(u32x2*)(Barr + (size_t)(t0 + tl) * D + cg) = wb_; }
            *(LAS f32x4*)(sa + tl * 132 + cl) = av; *(LAS f32x4*)(sb + tl * 132 + cl) = bv;
        }
        __syncthreads();
        {
            const int j = tid & 127, q = tid >> 7;
            float P = 1.f, H = 0.f;
#pragma unroll
            for (int s_ = 0; s_ < 16; ++s_) { const float a = sa[(q * 16 + s_) * 132 + j], bb = sb[(q * 16 + s_) * 132 + j]; H = a * H + bb; P *= a; }
            comb[(q * 128 + j) * 2 + 0] = P; comb[(q * 128 + j) * 2 + 1] = H;
        }
        __syncthreads();
        if (tid < 128) {
            float P = comb[tid * 2], H = comb[tid * 2 + 1];
#pragma unroll
            for (int q = 1; q < 4; ++q) { const float Pq = comb[(q * 128 + tid) * 2], Hq = comb[(q * 128 + tid) * 2 + 1]; H = Pq * H + Hq; P *= Pq; }
            SP[(size_t)tile * D + hd * 128 + tid] = P; SH[(size_t)tile * D + hd * 128 + tid] = H;
        }
    }
}
__device__ __forceinline__ void lru_scan_phase(const Params& p) {
    const int tid = tid_();
    const bf16_t* u = (const bf16_t*)(p.ws + WS_U);
    const bf16_t* Carr = (const bf16_t*)(p.ws + WS_SCR); const bf16_t* Barr = Carr + (size_t)T * D;
    const float* SP = (const float*)(p.ws + WS_LSUM); const float* SH = SP + NBATCH * 32 * D;
    bf16_t* yin = (bf16_t*)(p.ws + WS_YIN);
    const int nunits = NBATCH * 32 * 2;
    for (int un = blockIdx.x; un < nunits; un += gridDim.x) {
        const int tile = un >> 1, c = (un & 1) * 512 + tid, b = tile >> 5, chunk = tile & 31;
        float h = 0.f;
        for (int k = 0; k < chunk; ++k) h = SP[(size_t)(b * 32 + k) * D + c] * h + SH[(size_t)(b * 32 + k) * D + c];
        const size_t tb = (size_t)tile * 64;
#pragma unroll 16
        for (int s_ = 0; s_ < 64; ++s_) {
            const size_t t = tb + s_;
            h = (1.0f - bf2f(Carr[t * D + c])) * h + bf2f(Barr[t * D + c]);
            yin[t * D + c] = f2bf(gelu_fast(bf2f(u[t * 2048 + c])) * h);
        }
    }
}

typedef short s16x4 __attribute__((ext_vector_type(4)));
__device__ __forceinline__ s16x4 tr4(LAS const unsigned char* base, int row0, int col0, int stride, int lane) {
    const int q = (lane & 15) >> 2, pp = lane & 3;
    return __builtin_amdgcn_ds_read_tr16_b64_v4i16((LAS s16x4*)(base + (row0 + q) * stride + (col0 + 4 * pp) * 2));
}
__device__ __forceinline__ bf16x8 cat8(s16x4 a, s16x4 b) { return (bf16x8){a[0], a[1], a[2], a[3], b[0], b[1], b[2], b[3]}; }
__device__ __forceinline__ void ret_core_phase(LAS unsigned char* lds, const Params& p) {
    const int tid0_ = tid_(); const int tid = tid0_, lane = tid & 63, wid = tid >> 6, fr = lane & 15, fq = lane >> 4;
    constexpr int KS = 528, VS = 160, SS = 528;
    LAS unsigned char* Kl = lds;
    LAS unsigned char* Vl = lds + 128 * KS;
    LAS unsigned char* Sl = Vl + 128 * VS;
    const bf16_t* ul_ = (const bf16_t*)(p.ws + WS_U);
    bf16_t* RO = (bf16_t*)(p.ws + WS_SCR);
    for (int un = blockIdx.x; un < NBATCH * 4 * 8; un += gridDim.x) {
        const int b = un >> 5, h = (un >> 3) & 3, vs = un & 7;
        const float lg2 = log2f(1.0f - exp2f(-5.0f - (float)h));
        f32x4 Sacc[2][4];
#pragma unroll
        for (int dt = 0; dt < 2; ++dt)
#pragma unroll
            for (int vt = 0; vt < 4; ++vt) Sacc[dt][vt] = (f32x4){0.f, 0.f, 0.f, 0.f};
        for (int i = tid; i < 64 * SS / 16; i += NTHREADS) ((LAS u32x4*)Sl)[i] = (u32x4){0u, 0u, 0u, 0u};
        u32x4 kraw[8], vraw[2]; bf16x8 Qf[8];
#define RET_LOAD(ch_) do { const size_t tl_ = (size_t)b * SEQ + (ch_) * 128; const bf16_t* u = ul_; int tid = tid0_; asm volatile("" : "+s"(u), "+v"(tid));     \
            _Pragma("unroll") for (int i = 0; i < 8; ++i) { const int piece = tid + NTHREADS * i, m = piece >> 5, ch = piece & 31; kraw[i] = *(const u32x4*)(u + (tl_ + m) * 6144 + 1024 + h * 256 + ch * 8); } \
            _Pragma("unroll") for (int i = 0; i < 2; ++i) { const int piece = tid + NTHREADS * i, m = piece >> 3, ch = piece & 7; vraw[i] = *(const u32x4*)(u + (tl_ + m) * 6144 + 2048 + h * 512 + vs * 64 + ch * 8); } } while (0)
#define RET_LOADQ(ch_) do { const size_t tl_ = (size_t)b * SEQ + (ch_) * 128; const bf16_t* u = ul_; int tid = tid0_; asm volatile("" : "+s"(u), "+v"(tid)); const int wid = tid >> 6, fr = tid & 15, fq = (tid & 63) >> 4; \
            _Pragma("unroll") for (int ks = 0; ks < 8; ++ks) Qf[ks] = *(const bf16x8*)(u + (tl_ + 16 * wid + fr) * 6144 + h * 256 + 32 * ks + 8 * fq); } while (0)
        RET_LOAD(0); RET_LOADQ(0);
        for (int chunk = 0; chunk < 16; ++chunk) {
            const size_t t0 = (size_t)b * SEQ + chunk * 128;
            int tst = tid0_; asm volatile("" : "+v"(tst));
#pragma unroll
            for (int i = 0; i < 8; ++i) {
                const int piece = tst + NTHREADS * i, m = piece >> 5, ch = piece & 31;
                const u32x4 kv = kraw[i];
                const float sc = exp2f(-(float)(m + 1) * lg2) * 0.0625f;
                u32x4 w;
                w.x = pack2(__uint_as_float(kv.x << 16) * sc, __uint_as_float(kv.x & 0xffff0000u) * sc); w.y = pack2(__uint_as_float(kv.y << 16) * sc, __uint_as_float(kv.y & 0xffff0000u) * sc);
                w.z = pack2(__uint_as_float(kv.z << 16) * sc, __uint_as_float(kv.z & 0xffff0000u) * sc); w.w = pack2(__uint_as_float(kv.w << 16) * sc, __uint_as_float(kv.w & 0xffff0000u) * sc);
                *(LAS u32x4*)(Kl + m * KS + ch * 16) = w;
            }
#pragma unroll
            for (int i = 0; i < 2; ++i) {
                const int piece = tst + NTHREADS * i, m = piece >> 3, ch = piece & 7;
                *(LAS u32x4*)(Vl + m * VS + ch * 16) = vraw[i];
            }
            __syncthreads();
            if (chunk + 1 < 16) RET_LOAD(chunk + 1);
            f32x4 sc[8];
#pragma unroll
            for (int mt = 0; mt < 8; ++mt) {
                sc[mt] = (f32x4){0.f, 0.f, 0.f, 0.f};
#pragma unroll
                for (int ks = 0; ks < 8; ++ks) {
                    const bf16x8 kf = *(const LAS bf16x8*)(Kl + (16 * mt + fr) * KS + (32 * ks + 8 * fq) * 2);
                    sc[mt] = __builtin_amdgcn_mfma_f32_16x16x32_bf16(kf, Qf[ks], sc[mt], 0, 0, 0);
                }
                if (mt & 1) __builtin_amdgcn_sched_barrier(0);
            }
            bf16x8 pf[4];
            const int nloc = 16 * wid + fr;
#pragma unroll
            for (int ks2 = 0; ks2 < 4; ++ks2) {
                float v[8];
#pragma unroll
                for (int t = 0; t < 2; ++t)
#pragma unroll
                    for (int r = 0; r < 4; ++r) { const int m = 32 * ks2 + 16 * t + 4 * fq + r; v[4 * t + r] = (m <= nloc) ? sc[2 * ks2 + t][r] : 0.f; }
                u32x4 w; w.x = pack2(v[0], v[1]); w.y = pack2(v[2], v[3]); w.z = pack2(v[4], v[5]); w.w = pack2(v[6], v[7]);
                pf[ks2] = __builtin_bit_cast(bf16x8, w);
            }
            f32x4 O[4];
#pragma unroll
            for (int vt = 0; vt < 4; ++vt) {
                O[vt] = (f32x4){0.f, 0.f, 0.f, 0.f};
#pragma unroll
                for (int ks2 = 0; ks2 < 4; ++ks2) {
                    const bf16x8 vf = cat8(tr4(Vl, 32 * ks2 + 4 * fq, 16 * vt, VS, lane), tr4(Vl, 32 * ks2 + 16 + 4 * fq, 16 * vt, VS, lane));
                    O[vt] = __builtin_amdgcn_mfma_f32_16x16x32_bf16(pf[ks2], vf, O[vt], 0, 0, 0);
                }
#pragma unroll
                for (int ks = 0; ks < 8; ++ks) {
                    const bf16x8 sf = *(const LAS bf16x8*)(Sl + (16 * vt + fr) * SS + (32 * ks + 8 * fq) * 2);
                    O[vt] = __builtin_amdgcn_mfma_f32_16x16x32_bf16(Qf[ks], sf, O[vt], 0, 0, 0);
                }
                __builtin_amdgcn_sched_barrier(0);
            }
#pragma unroll
            for (int r = 0; r < 4; ++r) {
                const int n = 16 * wid + 4 * fq + r;
                const float qd = exp2f((float)(n + 1) * lg2);
                bf16_t* op = RO + (t0 + n) * 2048 + h * 512 + vs * 64 + fr;
#pragma unroll
                for (int vt = 0; vt < 4; ++vt) op[16 * vt] = f2bf(O[vt][r] * qd);
            }
            if (chunk + 1 < 16) RET_LOADQ(chunk + 1);
#pragma unroll
            for (int ks3 = 0; ks3 < 4; ++ks3) {
                bf16x8 kt[2], vf[4];
#pragma unroll
                for (int dt = 0; dt < 2; ++dt) kt[dt] = cat8(tr4(Kl, 32 * ks3 + 8 * fq, 32 * wid + 16 * dt, KS, lane), tr4(Kl, 32 * ks3 + 8 * fq + 4, 32 * wid + 16 * dt, KS, lane));
#pragma unroll
                for (int vt = 0; vt < 4; ++vt) vf[vt] = cat8(tr4(Vl, 32 * ks3 + 8 * fq, 16 * vt, VS, lane), tr4(Vl, 32 * ks3 + 8 * fq + 4, 16 * vt, VS, lane));
#pragma unroll
                for (int dt = 0; dt < 2; ++dt)
#pragma unroll
                    for (int vt = 0; vt < 4; ++vt) Sacc[dt][vt] = __builtin_amdgcn_mfma_f32_16x16x32_bf16(kt[dt], vf[vt], Sacc[dt][vt], 0, 0, 0);
                __builtin_amdgcn_sched_barrier(0);
            }
            __syncthreads();
            const float cd = exp2f(128.0f * lg2);
#pragma unroll
            for (int dt = 0; dt < 2; ++dt)
#pragma unroll
                for (int vt = 0; vt < 4; ++vt) {
                    Sacc[dt][vt] *= cd;
                    u32x2 w; w.x = pack2(Sacc[dt][vt][0], Sacc[dt][vt][1]); w.y = pack2(Sacc[dt][vt][2], Sacc[dt][vt][3]);
                    *(LAS u32x2*)(Sl + (16 * vt + fr) * SS + (32 * wid + 16 * dt + 4 * fq) * 2) = w;
                }
        }
        __syncthreads();
#undef RET_LOAD
#undef RET_LOADQ
    }
}
__device__ __forceinline__ void ret_norm_phase(LAS unsigned char* lds, const Params& p) {
    const int tid = tid_(), lane = tid & 63, wid = tid >> 6;
    LAS float* red = (LAS float*)lds;
    const bf16_t* u = (const bf16_t*)(p.ws + WS_U);
    const bf16_t* RO = (const bf16_t*)(p.ws + WS_SCR);
    bf16_t* yin = (bf16_t*)(p.ws + WS_YIN);
    for (int t = blockIdx.x; t < T; t += gridDim.x) {
        const u32x2 ov = *(const u32x2*)(RO + (size_t)t * 2048 + tid * 4);
        const f32x4 o = (f32x4){__uint_as_float(ov.x << 16), __uint_as_float(ov.x & 0xffff0000u), __uint_as_float(ov.y << 16), __uint_as_float(ov.y & 0xffff0000u)};
        const float ss = wave_sum(o[0] * o[0] + o[1] * o[1] + o[2] * o[2] + o[3] * o[3]);
        if (lane == 0) red[wid] = ss;
        __syncthreads();
        const float tot = red[(wid & ~1)] + red[(wid | 1)];
        const float rstd = rsqrtf(tot * (1.0f / 512.0f) + 1e-6f);
        const u32x2 gv = *(const u32x2*)(u + (size_t)t * 6144 + 4096 + tid * 4);
        const float g0 = __uint_as_float(gv.x << 16), g1 = __uint_as_float(gv.x & 0xffff0000u), g2 = __uint_as_float(gv.y << 16), g3 = __uint_as_float(gv.y & 0xffff0000u);
        u32x2 w; w.x = pack2(g0 * sigmoidf_(g0) * o[0] * rstd, g1 * sigmoidf_(g1) * o[1] * rstd); w.y = pack2(g2 * sigmoidf_(g2) * o[2] * rstd, g3 * sigmoidf_(g3) * o[3] * rstd);
        *(u32x2*)(yin + (size_t)t * 2048 + tid * 4) = w;
        __syncthreads();
    }
}

__device__ __forceinline__ void attn_core_phase(LAS unsigned char* lds, const Params& p) {
    const int tid = tid_(), lane = tid & 63, wid = tid >> 6, fr = lane & 15, fq = lane >> 4;
    constexpr int RS = 144, TILE = 272 * RS;
    LAS unsigned char* Kl = lds;
    LAS unsigned char* Vl = lds + TILE;
    const bf16_t* u = (const bf16_t*)(p.ws + WS_U);
    bf16_t* OP = (bf16_t*)(p.ws + WS_SCR);
    float* LSE = (float*)(p.ws + WS_SCR + 96 * MB);
    for (int i = tid; i < 16 * RS / 16; i += NTHREADS) { ((LAS u32x4*)(Kl + 256 * RS))[i] = (u32x4){0u, 0u, 0u, 0u}; ((LAS u32x4*)(Vl + 256 * RS))[i] = (u32x4){0u, 0u, 0u, 0u}; }
    for (int un = blockIdx.x; un < 3 * 2048; un += gridDim.x) {
        const int g = un >> 11, rem = un & 2047, b = rem >> 8, h = (rem >> 4) & 15, x = rem & 15;
        const int dl = (g == 0) ? 1 : (g == 1 ? 4 : 16), r_ = x & (dl - 1), n = x / dl;
        const float slope = exp2f(-0.5f * (float)(h + 1)) * (float)dl;
        const bf16_t* ub = u + (size_t)b * SEQ * 9216;
#pragma unroll
        for (int i = 0; i < 4; ++i) {
            const int piece = tid + NTHREADS * i, row = piece >> 3, ch = piece & 7;
            const int sk = ((n - 1) * 128 + row) * dl + r_;
            u32x4 kv = (u32x4){0u, 0u, 0u, 0u}, vv = (u32x4){0u, 0u, 0u, 0u};
            if (sk >= 0) { const bf16_t* src = ub + (size_t)sk * 9216 + h * 64 + ch * 8; kv = *(const u32x4*)(src + (3 + g) * 1024); vv = *(const u32x4*)(src + (6 + g) * 1024); }
            *(LAS u32x4*)(Kl + row * RS + ch * 16) = kv; *(LAS u32x4*)(Vl + row * RS + ch * 16) = vv;
        }
        const int qi = 16 * wid + fr, sq = (n * 128 + qi) * dl + r_;
        bf16x8 Qf[2];
#pragma unroll
        for (int ks = 0; ks < 2; ++ks) Qf[ks] = *(const bf16x8*)(ub + (size_t)sq * 9216 + g * 1024 + h * 64 + 32 * ks + 8 * fq);
        __syncthreads();
        f32x4 sc[9];
        float mx = -INFINITY;
#pragma unroll
        for (int kt = 0; kt < 9; ++kt) {
            sc[kt] = (f32x4){0.f, 0.f, 0.f, 0.f};
#pragma unroll
            for (int ks = 0; ks < 2; ++ks) {
                const bf16x8 kf = *(const LAS bf16x8*)(Kl + (16 * (wid + kt) + fr) * RS + (32 * ks + 8 * fq) * 2);
                sc[kt] = __builtin_amdgcn_mfma_f32_16x16x32_bf16(kf, Qf[ks], sc[kt], 0, 0, 0);
            }
#pragma unroll
            for (int r = 0; r < 4; ++r) {
                const int ki = 16 * (wid + kt) + 4 * fq + r, steps = qi + 128 - ki;
                const bool ok = (steps >= 0) && (steps <= 128) && (n > 0 || ki >= 128);
                const float v = ok ? sc[kt][r] * 0.125f - slope * (float)steps : -INFINITY;
                sc[kt][r] = v; mx = fmaxf(mx, v);
            }
        }
        mx = fmaxf(mx, __shfl_xor(mx, 16)); mx = fmaxf(mx, __shfl_xor(mx, 32));
        float l = 0.f;
#pragma unroll
        for (int kt = 0; kt < 9; ++kt)
#pragma unroll
            for (int r = 0; r < 4; ++r) { const float pv = __expf(sc[kt][r] - mx); sc[kt][r] = pv; l += pv; }
        l += __shfl_xor(l, 16); l += __shfl_xor(l, 32);
        f32x4 O[4];
#pragma unroll
        for (int dt = 0; dt < 4; ++dt) O[dt] = (f32x4){0.f, 0.f, 0.f, 0.f};
#pragma unroll
        for (int ks5 = 0; ks5 < 5; ++ks5) {
            const f32x4 p0 = sc[2 * ks5], p1 = (ks5 < 4) ? sc[(ks5 < 4) ? 2 * ks5 + 1 : 0] : (f32x4){0.f, 0.f, 0.f, 0.f};
            u32x4 w; w.x = pack2(p0[0], p0[1]); w.y = pack2(p0[2], p0[3]); w.z = pack2(p1[0], p1[1]); w.w = pack2(p1[2], p1[3]);
            const bf16x8 pf = __builtin_bit_cast(bf16x8, w);
#pragma unroll
            for (int dt = 0; dt < 4; ++dt) {
                const bf16x8 vf = cat8(tr4(Vl, 16 * (wid + 2 * ks5) + 4 * fq, 16 * dt, RS, lane), tr4(Vl, 16 * (wid + 2 * ks5 + 1) + 4 * fq, 16 * dt, RS, lane));
                O[dt] = __builtin_amdgcn_mfma_f32_16x16x32_bf16(vf, pf, O[dt], 0, 0, 0);
            }
        }
        const float inv = 1.0f / l;
        const size_t tq = (size_t)b * SEQ + sq;
#pragma unroll
        for (int dt = 0; dt < 4; ++dt) {
            u32x2 w; w.x = pack2(O[dt][0] * inv, O[dt][1] * inv); w.y = pack2(O[dt][2] * inv, O[dt][3] * inv);
            *(u32x2*)(OP + ((size_t)g * T + tq) * D + h * 64 + 16 * dt + 4 * fq) = w;
        }
        if (fq == 0) LSE[((size_t)g * T + tq) * 16 + h] = mx + __logf(l);
        __syncthreads();
    }
}
__device__ __forceinline__ void attn_merge_phase(const Params& p) {
    const int tid = tid_();
    const bf16_t* OP = (const bf16_t*)(p.ws + WS_SCR);
    const float* LSE = (const float*)(p.ws + WS_SCR + 96 * MB);
    bf16_t* yin = (bf16_t*)(p.ws + WS_YIN);
    for (size_t i = (size_t)blockIdx.x * NTHREADS + tid; i < (size_t)T * D / 8; i += (size_t)gridDim.x * NTHREADS) {
        const size_t t = i >> 7; const int c8 = (int)(i & 127), h = c8 >> 3;
        const float l0 = LSE[t * 16 + h], l1 = LSE[((size_t)T + t) * 16 + h], l2 = LSE[((size_t)2 * T + t) * 16 + h];
        const float m = fmaxf(l0, fmaxf(l1, l2));
        float w0 = __expf(l0 - m), w1 = __expf(l1 - m), w2 = __expf(l2 - m);
        const float inv = 1.0f / (w0 + w1 + w2); w0 *= inv; w1 *= inv; w2 *= inv;
        const u32x4 a = *(const u32x4*)(OP + t * D + c8 * 8), bq = *(const u32x4*)(OP + ((size_t)T + t) * D + c8 * 8), c = *(const u32x4*)(OP + ((size_t)2 * T + t) * D + c8 * 8);
        u32x4 o;
#define MRG(f) o.f = pack2(w0 * __uint_as_float(a.f << 16) + w1 * __uint_as_float(bq.f << 16) + w2 * __uint_as_float(c.f << 16), \
                           w0 * __uint_as_float(a.f & 0xffff0000u) + w1 * __uint_as_float(bq.f & 0xffff0000u) + w2 * __uint_as_float(c.f & 0xffff0000u))
        MRG(x); MRG(y); MRG(z); MRG(w);
#undef MRG
        *(u32x4*)(yin + t * D + c8 * 8) = o;
    }
}

__device__ __forceinline__ void ln1_router_phase(LAS unsigned char* lds, const Params& p, int layer) {
    const int tid = tid_(), lane = tid & 63, wid = tid >> 6, fr = lane & 15, fq = lane >> 4;
    constexpr int XS = 2064;
    LAS unsigned char* xh = lds;
    LAS unsigned char* xl = lds + 16 * XS;
    LAS float* part = (LAS float*)(lds + 32 * XS);
    LAS float* logit = part + 8 * 16 * 32;
    LAS int* tkE = (LAS int*)(logit + 16 * 32);
    LAS int* tkR = tkE + 512;
    LAS int* hist = tkR + 512;
    LAS int* hbase = hist + 32;
    float* xf = (float*)(p.ws + WS_XF); bf16_t* xb = (bf16_t*)(p.ws + WS_XB);
    const bf16_t* ymix = (const bf16_t*)(p.ws + WS_YMIX);
    int* tope = (int*)(p.ws + WS_TOPE); float* gates = (float*)(p.ws + WS_GATES); int* pos = (int*)(p.ws + WS_POS);
    unsigned char* xq = p.ws + WS_XQ; int* elist = (int*)(p.ws + WS_LIST);
    unsigned* ctl = (unsigned*)(p.ws + WS_CTL);
    const float* gain = p.ln_gain + (size_t)(layer * 2) * D; const float* bias = p.ln_bias + (size_t)(layer * 2) * D;
    const float* brt = p.moe_b_router + (size_t)layer * NEXP;
    const bf16_t* rth = (const bf16_t*)(p.ws + WS_RT) + (size_t)layer * 2 * NEXP * D; const bf16_t* rtl = rth + NEXP * D;
    bf16x8 Wh[2][4], Wl[2][4];
#pragma unroll
    for (int nt = 0; nt < 2; ++nt)
#pragma unroll
        for (int ks = 0; ks < 4; ++ks) { const size_t o = (size_t)(16 * nt + fr) * D + 128 * wid + 32 * ks + 8 * fq; Wh[nt][ks] = *(const bf16x8*)(rth + o); Wl[nt][ks] = *(const bf16x8*)(rtl + o); }
    if (tid < NEXP) hist[tid] = 0;
    int it = 0;
    for (int tile = blockIdx.x; tile < T / 16; tile += gridDim.x) {
#pragma unroll
        for (int tt = 0; tt < 2; ++tt) {
            const int trow = 2 * wid + tt; const size_t t = (size_t)tile * 16 + trow;
            f32x4 z[4];
#pragma unroll
            for (int i = 0; i < 4; ++i) { const int c = 256 * i + 4 * lane; const u32x2 yv = *(const u32x2*)(ymix + t * D + c);
                z[i] = DN_ALPHA * *(const f32x4*)(xf + t * D + c) + (f32x4){__uint_as_float(yv.x << 16), __uint_as_float(yv.x & 0xffff0000u), __uint_as_float(yv.y << 16), __uint_as_float(yv.y & 0xffff0000u)}; }
            float sm = 0.f;
#pragma unroll
            for (int i = 0; i < 4; ++i) sm += (z[i][0] + z[i][1]) + (z[i][2] + z[i][3]);
            const float mean = wave_sum(sm) * (1.0f / D);
            float sq = 0.f;
#pragma unroll
            for (int i = 0; i < 4; ++i) { const f32x4 dd = z[i] - mean; sq += (dd[0] * dd[0] + dd[1] * dd[1]) + (dd[2] * dd[2] + dd[3] * dd[3]); }
            const float rstd = rsqrtf(wave_sum(sq) * (1.0f / D) + LN_EPS);
#pragma unroll
            for (int i = 0; i < 4; ++i) {
                const int c = 256 * i + 4 * lane;
                const f32x4 v = (z[i] - mean) * rstd * *(const f32x4*)(gain + c) + *(const f32x4*)(bias + c);
                *(f32x4*)(xf + t * D + c) = v;
                u32x2 wh; wh.x = pack2(v[0], v[1]); wh.y = pack2(v[2], v[3]);
                *(u32x2*)(xb + t * D + c) = wh;
                *(unsigned*)(xq + t * D + c) = pk_fp8x4(v[0], v[1], v[2], v[3]);
                const float r0 = v[0] - __uint_as_float(wh.x << 16), r1 = v[1] - __uint_as_float(wh.x & 0xffff0000u), r2 = v[2] - __uint_as_float(wh.y << 16), r3 = v[3] - __uint_as_float(wh.y & 0xffff0000u);
                u32x2 wl; wl.x = pack2(r0, r1); wl.y = pack2(r2, r3);
                *(LAS u32x2*)(xh + trow * XS + c * 2) = wh; *(LAS u32x2*)(xl + trow * XS + c * 2) = wl;
            }
        }
        __syncthreads();
        {
            f32x4 acc[2] = {(f32x4){0.f, 0.f, 0.f, 0.f}, (f32x4){0.f, 0.f, 0.f, 0.f}};
#pragma unroll
            for (int ks = 0; ks < 4; ++ks) {
                const bf16x8 ah = *(const LAS bf16x8*)(xh + fr * XS + (128 * wid + 32 * ks + 8 * fq) * 2), al = *(const LAS bf16x8*)(xl + fr * XS + (128 * wid + 32 * ks + 8 * fq) * 2);
#pragma unroll
                for (int nt = 0; nt < 2; ++nt) {
                    acc[nt] = __builtin_amdgcn_mfma_f32_16x16x32_bf16(Wh[nt][ks], ah, acc[nt], 0, 0, 0);
                    acc[nt] = __builtin_amdgcn_mfma_f32_16x16x32_bf16(Wh[nt][ks], al, acc[nt], 0, 0, 0);
                    acc[nt] = __builtin_amdgcn_mfma_f32_16x16x32_bf16(Wl[nt][ks], ah, acc[nt], 0, 0, 0);
                }
            }
#pragma unroll
            for (int nt = 0; nt < 2; ++nt) *(LAS f32x4*)(part + (wid * 16 + fr) * 32 + 16 * nt + 4 * fq) = acc[nt];
        }
        __syncthreads();
        {
            const int tk = tid >> 5, e = tid & 31;
            float sacc = brt[e];
#pragma unroll
            for (int w = 0; w < 8; ++w) sacc += part[(w * 16 + tk) * 32 + e];
            logit[tk * 32 + e] = sacc;
        }
        __syncthreads();
        if (tid < 16) {
            const size_t t = (size_t)tile * 16 + tid;
            float v0 = -INFINITY, v1 = -INFINITY, v2 = -INFINITY, v3 = -INFINITY; int i0 = 0, i1 = 0, i2 = 0, i3 = 0;
#pragma unroll
            for (int e = 0; e < NEXP; ++e) {
                const float v = logit[tid * 32 + e];
                if (v > v3) {
                    if (v > v0) { v3 = v2; i3 = i2; v2 = v1; i2 = i1; v1 = v0; i1 = i0; v0 = v; i0 = e; }
                    else if (v > v1) { v3 = v2; i3 = i2; v2 = v1; i2 = i1; v1 = v; i1 = e; }
                    else if (v > v2) { v3 = v2; i3 = i2; v2 = v; i2 = e; }
                    else { v3 = v; i3 = e; }
                }
            }
            const float e1 = __expf(v1 - v0), e2 = __expf(v2 - v0), e3 = __expf(v3 - v0), inv = 1.0f / (1.0f + e1 + e2 + e3);
            tope[t * 4 + 0] = i0; tope[t * 4 + 1] = i1; tope[t * 4 + 2] = i2; tope[t * 4 + 3] = i3;
            gates[t * 4 + 0] = inv; gates[t * 4 + 1] = e1 * inv; gates[t * 4 + 2] = e2 * inv; gates[t * 4 + 3] = e3 * inv;
            const int sl = (it & 7) * 16 + tid;
            tkE[sl * 4 + 0] = i0; tkR[sl * 4 + 0] = (int)atomicAdd((unsigned*)(hist + i0), 1u);
            tkE[sl * 4 + 1] = i1; tkR[sl * 4 + 1] = (int)atomicAdd((unsigned*)(hist + i1), 1u);
            tkE[sl * 4 + 2] = i2; tkR[sl * 4 + 2] = (int)atomicAdd((unsigned*)(hist + i2), 1u);
            tkE[sl * 4 + 3] = i3; tkR[sl * 4 + 3] = (int)atomicAdd((unsigned*)(hist + i3), 1u);
        }
        ++it;
        if ((it & 7) == 0 || tile + (int)gridDim.x >= T / 16) {
            __syncthreads();
            if (tid < NEXP) { const unsigned h = (unsigned)hist[tid]; hbase[tid] = h ? (int)atomicAdd(ctl + CW_CNT + layer * 64 + tid, h) : 0; hist[tid] = 0; }
            __syncthreads();
            const int nsl = (((it - 1) & 7) + 1) * 16;
            for (int a = tid; a < nsl * 4; a += NTHREADS) {
                const int sl = a >> 2, e = tkE[a], ps = hbase[e] + tkR[a];
                const int t = (tile - (((it - 1) & 7) - (sl >> 4)) * (int)gridDim.x) * 16 + (sl & 15);
                pos[t * 4 + (a & 3)] = ps; elist[(size_t)e * T + ps] = t;
            }
            __syncthreads();
        }
    }
    __syncthreads();
}
__device__ __forceinline__ void ln2_phase(LAS unsigned char* lds, const Params& p, int layer) {
    const int tid = tid_(), lane = tid & 63, wid = tid >> 6;
    moe_tables(lds, (const unsigned*)(p.ws + WS_CTL), layer);
    LAS const int* tab = (LAS const int*)(lds + TAB_OFF);
    const int* tope = (const int*)(p.ws + WS_TOPE); const int* pos = (const int*)(p.ws + WS_POS);
    float* xf = (float*)(p.ws + WS_XF); bf16_t* xb = (bf16_t*)(p.ws + WS_XB);
    const bf16_t* yrows = (const bf16_t*)(p.ws + WS_YROWS);
    const float* gates = (const float*)(p.ws + WS_GATES);
    const float* gain = p.ln_gain + (size_t)(layer * 2 + 1) * D; const float* bias = p.ln_bias + (size_t)(layer * 2 + 1) * D;
    for (int t = blockIdx.x * 8 + wid; t < T; t += gridDim.x * 8) {
        f32x4 z[4];
        int dk[4]; float gk[4];
#pragma unroll
        for (int k = 0; k < 4; ++k) { dk[k] = tab[tope[t * 4 + k]] * 256 + pos[t * 4 + k]; gk[k] = gates[t * 4 + k]; }
#pragma unroll
        for (int i = 0; i < 4; ++i) {
            const int c = 256 * i + 4 * lane;
            f32x4 f = (f32x4){0.f, 0.f, 0.f, 0.f};
#pragma unroll
            for (int k = 0; k < 4; ++k) { const u32x2 yv = *(const u32x2*)(yrows + (size_t)dk[k] * D + c);
                f[0] += gk[k] * __uint_as_float(yv.x << 16); f[1] += gk[k] * __uint_as_float(yv.x & 0xffff0000u); f[2] += gk[k] * __uint_as_float(yv.y << 16); f[3] += gk[k] * __uint_as_float(yv.y & 0xffff0000u); }
            z[i] = DN_ALPHA * *(const f32x4*)(xf + (size_t)t * D + c) + f;
        }
        float sm = 0.f;
#pragma unroll
        for (int i = 0; i < 4; ++i) sm += (z[i][0] + z[i][1]) + (z[i][2] + z[i][3]);
        const float mean = wave_sum(sm) * (1.0f / D);
        float sq = 0.f;
#pragma unroll
        for (int i = 0; i < 4; ++i) { const f32x4 dd = z[i] - mean; sq += (dd[0] * dd[0] + dd[1] * dd[1]) + (dd[2] * dd[2] + dd[3] * dd[3]); }
        const float rstd = rsqrtf(wave_sum(sq) * (1.0f / D) + LN_EPS);
#pragma unroll
        for (int i = 0; i < 4; ++i) {
            const int c = 256 * i + 4 * lane;
            z[i] = (z[i] - mean) * rstd * *(const f32x4*)(gain + c) + *(const f32x4*)(bias + c);
            if (layer == DEPTH - 1) *(f32x4*)(p.out + (size_t)t * D + c) = z[i];
            else { *(f32x4*)(xf + (size_t)t * D + c) = z[i]; u32x2 w; w.x = pack2(z[i][0], z[i][1]); w.y = pack2(z[i][2], z[i][3]); *(u32x2*)(xb + (size_t)t * D + c) = w; }
        }
    }
}

__device__ __forceinline__ void moe_scatter_phase(LAS unsigned char* lds, const Params& p, int layer) {
    const int tid = tid_();
    LAS int* pstart = (LAS int*)lds;
    unsigned* ctl = (unsigned*)(p.ws + WS_CTL);
    const int* tope = (const int*)(p.ws + WS_TOPE); const int* pos = (const int*)(p.ws + WS_POS);
    int* dest = (int*)(p.ws + WS_DEST); int* rowtok = (int*)(p.ws + WS_ROWTOK);
    if (tid == 0) {
        int acc = 0;
        for (int e = 0; e < NEXP; ++e) { const int c = (int)ctl[CW_CNT + layer * 64 + e]; pstart[e] = acc; pstart[32 + e] = c; acc += ((c + 255) >> 8) << 8; }
        pstart[64] = acc;
        if (blockIdx.x == 0) {
            ctl[CW_MDYN + layer * 64] = (unsigned)acc;
            for (int e = 0; e < NEXP; ++e) { const int nb = (pstart[32 + e] + 255) >> 8; for (int b = 0; b < nb; ++b) ctl[CW_TEXP + layer * 512 + (pstart[e] >> 8) + b] = (unsigned)e; }
        }
    }
    __syncthreads();
    for (int i = blockIdx.x * NTHREADS + tid; i < T * TOPK; i += gridDim.x * NTHREADS) {
        const int e = tope[i], row = pstart[e] + pos[i];
        dest[i] = row; rowtok[row] = i >> 2;
    }
    for (int i = blockIdx.x * NTHREADS + tid; i < NEXP * 256; i += gridDim.x * NTHREADS) {
        const int e = i >> 8, r = i & 255, c = pstart[32 + e], padded = ((c + 255) >> 8) << 8;
        if (c + r < padded) rowtok[pstart[e] + c + r] = 0;
    }
    __syncthreads();
}

constexpr int PH_PER_LAYER = 9;
constexpr int NPHASES = 1 + DEPTH * PH_PER_LAYER;
constexpr int LDS_BYTES = 132 * 1024;


#ifndef PHMASK
#define PHMASK 0x3FF
#endif
#define PHK(j) ((PHMASK >> (j)) & 1)
#ifndef PROBE_MASK
#define PROBE_MASK 0
#endif
#ifndef PROBE_LAYERS
#define PROBE_LAYERS 0xF
#endif
#define REPS(j) ((((PROBE_MASK) >> (j)) & 1) ? 2 : 1)
#define REPSL(j) (((((PROBE_MASK) >> (j)) & 1) && (((PROBE_LAYERS) >> layer) & 1)) ? 2 : 1)
#define IN(k) (lo <= (k) && (k) < hi)
#if MK_ONE_LAUNCH
#define SEAM(k) do { if (IN(k) && IN((k) + 1)) xcd_barrier_nv(bar.bar, bar.x, bar.st); } while (0)
#else
#define SEAM(k) do {} while (0)
#endif
template <int layer>
__device__ __forceinline__ void run_layer(const Params& p, LAS unsigned char* lds, const XcdBarrier& bar) {
    const int lo = p.ph_lo, hi = p.ph_hi;
    unsigned char* ws = p.ws;
    unsigned* ctl = (unsigned*)(ws + WS_CTL);
        constexpr int base = 1 + layer * PH_PER_LAYER, kind = layer % 3, idx = layer / 3;
        for (int rep_ = 0; rep_ < REPSL(1); ++rep_) if (PHK(1) && IN(base + 0)) {
            constexpr int N = (kind == 0) ? 2048 : (kind == 1 ? 6144 : 9216);
            const bf16_t* Bt = (kind == 0) ? (const bf16_t*)(ws + WS_AWIN) + (size_t)idx * 2048 * D : (kind == 1 ? (const bf16_t*)(ws + WS_BWIN) : (const bf16_t*)(ws + WS_CWIN));
            g8::SchedPlain S; S.init(ws + WS_XB, Bt, T, N, D, (int)gridDim.x, (int)blockIdx.x);
            g8::EpiBf16 E{(bf16_t*)(ws + WS_U), N, nullptr, 0, 1.0f};
            g8::gemm_phase<g8::EpiBf16, g8::SchedPlain, false>(lds, D, S, E);
        }
        SEAM(base + 0);
        for (int rep_ = 0; rep_ < REPSL(2); ++rep_) if (PHK(2) && IN(base + 1)) {
            if (kind == 0) lru_gates_phase(lds, p, idx);
            else if (kind == 1) ret_core_phase(lds, p);
            else attn_core_phase(lds, p);
        }
        SEAM(base + 1);
        for (int rep_ = 0; rep_ < REPSL(3); ++rep_) if (PHK(3) && IN(base + 2)) {
            if (kind == 0) lru_scan_phase(p);
            else if (kind == 1) ret_norm_phase(lds, p);
            else attn_merge_phase(p);
        }
        SEAM(base + 2);
        for (int rep_ = 0; rep_ < REPSL(4); ++rep_) if (PHK(4) && IN(base + 3)) {
            constexpr int K = (kind == 1) ? 2048 : D;
            const bf16_t* Bt = (kind == 0) ? (const bf16_t*)(ws + WS_AWOUT) + (size_t)idx * D * D : (kind == 1 ? (const bf16_t*)(ws + WS_BWOUT) : (const bf16_t*)(ws + WS_CWOUT));
            g8::SchedPlain S; S.init(ws + WS_YIN, Bt, T, D, K, (int)gridDim.x, (int)blockIdx.x);
            g8::EpiBf16 E{(bf16_t*)(ws + WS_YMIX), D, nullptr, 0, 1.0f};
            g8::gemm_phase<g8::EpiBf16, g8::SchedPlain, false>(lds, K, S, E);
        }
        SEAM(base + 3);
        for (int rep_ = 0; rep_ < REPSL(5); ++rep_) if (PHK(5) && IN(base + 4)) ln1_router_phase(lds, p, layer);
        SEAM(base + 4);
        for (int rep_ = 0; rep_ < REPSL(7); ++rep_) if (PHK(7) && IN(base + 6)) {
            moe_tables(lds, ctl, layer);
            g8::SchedGU S{(const char*)(ws + WS_XQ), (const char*)(ws + WS_GU) + (size_t)layer * NEXP * 2048 * D, (const int*)(ws + WS_LIST), (LAS const int*)(lds + TAB_OFF), (int)gridDim.x, (int)blockIdx.x};
            g8::EpiSwiglu E{ws + WS_HID, p.moe_b_gu + (size_t)layer * NEXP * 2048, 1.0f / GU_WSCALE};
            g8::gemm_phase<g8::EpiSwiglu, g8::SchedGU, true, 1>(lds, D, S, E);
        }
        SEAM(base + 6);
        for (int rep_ = 0; rep_ < REPSL(8); ++rep_) if (PHK(8) && IN(base + 7)) {
            moe_tables(lds, ctl, layer);
            g8::SchedDown S{(const char*)(ws + WS_HID), (const char*)(ws + WS_DN) + (size_t)layer * NEXP * D * D, (LAS const int*)(lds + TAB_OFF), (int)gridDim.x, (int)blockIdx.x};
            g8::EpiBf16 E{(bf16_t*)(ws + WS_YROWS), D, p.moe_b_down + (size_t)layer * NEXP * D, D, 1.0f / DN_WSCALE};
            g8::gemm_phase<g8::EpiBf16, g8::SchedDown, false, 1>(lds, D, S, E);
        }
        SEAM(base + 7);
        for (int rep_ = 0; rep_ < REPSL(9); ++rep_) if (PHK(9) && IN(base + 8)) ln2_phase(lds, p, layer);
        SEAM(base + 8);
    }
#undef IN
#undef SEAM
__global__ void __launch_bounds__(NTHREADS, 2) fwd_kernel(Params p) {
    extern __shared__ __attribute__((aligned(16))) unsigned char lds_raw[];
    LAS unsigned char* lds = (LAS unsigned char*)lds_raw;
    const int lo = p.ph_lo, hi = p.ph_hi;
    unsigned char* ws = p.ws;
    unsigned* ctl = (unsigned*)(ws + WS_CTL);
#if MK_ONE_LAUNCH
    volatile LAS unsigned* bst = (volatile LAS unsigned*)(lds + LDS_BYTES - 16);
    if (threadIdx.x == 0) { bst[0] = 0u; bst[1] = 0u; bst[2] = 0u; bst[3] = 0u; }
    __syncthreads();
    XcdBarrier bar = xcd_barrier_post(ctl, bst);
#define GRID_BAR() xcd_barrier_nv(bar.bar, bar.x, bar.st)
#else
    XcdBarrier bar; bar.bar = ctl; bar.x = 0; bar.st = nullptr;
#define GRID_BAR() do {} while (0)
#endif
#define IN(k) (lo <= (k) && (k) < hi)
#define SEAM(k) do { if (IN(k) && IN((k) + 1)) GRID_BAR(); } while (0)

    for (int rep_ = 0; rep_ < REPS(0); ++rep_) if (PHK(0) && IN(0)) {
        LAS float* tile = (LAS float*)lds;
        convert_big<true>(lds, p.moe_w_gu, ws + WS_GU, D, 2048, DEPTH * NEXP, GU_WSCALE);
        convert_big<true>(lds, p.moe_w_down, ws + WS_DN, D, D, DEPTH * NEXP, DN_WSCALE);
        convert_big<false>(lds, p.a_w_in, (bf16_t*)(ws + WS_AWIN), D, 2048, 2, 1.0f);
        convert_big<false>(lds, p.a_w_out, (bf16_t*)(ws + WS_AWOUT), D, D, 2, 1.0f);
        convert_big<false>(lds, p.b_w_in, (bf16_t*)(ws + WS_BWIN), D, 6144, 1, 1.0f);
        convert_big<false>(lds, p.b_w_out, (bf16_t*)(ws + WS_BWOUT), 2048, D, 1, 1.0f);
        convert_big<false>(lds, p.c_w_in, (bf16_t*)(ws + WS_CWIN), D, 9216, 1, 1.0f);
        convert_big<false>(lds, p.c_w_out, (bf16_t*)(ws + WS_CWOUT), D, D, 1, 1.0f);
        convert_job(tile, p.a_w_rgate, (bf16_t*)(ws + WS_AGT), 128, 128, 8);
        convert_job(tile, p.a_w_igate, (bf16_t*)(ws + WS_AGT) + (size_t)8 * 128 * 128, 128, 128, 8);
        convert_job(tile, p.a_w_rgate + (size_t)8 * 128 * 128, (bf16_t*)(ws + WS_AGT) + (size_t)16 * 128 * 128, 128, 128, 8);
        convert_job(tile, p.a_w_igate + (size_t)8 * 128 * 128, (bf16_t*)(ws + WS_AGT) + (size_t)24 * 128 * 128, 128, 128, 8);
        {
            bf16_t* rt = (bf16_t*)(ws + WS_RT);
            for (int i = blockIdx.x * NTHREADS + threadIdx.x; i < DEPTH * NEXP * D; i += gridDim.x * NTHREADS) {
                const int l = i / (NEXP * D), r_ = i % (NEXP * D), e = r_ / D, k = r_ % D;
                const float w = p.moe_w_router[((size_t)l * D + k) * NEXP + e];
                const bf16_t hi = f2bf(w); const bf16_t lo = f2bf(w - bf2f(hi));
                rt[((size_t)l * 2 + 0) * NEXP * D + (size_t)e * D + k] = hi; rt[((size_t)l * 2 + 1) * NEXP * D + (size_t)e * D + k] = lo;
            }
        }
        float* xf = (float*)(ws + WS_XF); bf16_t* xb = (bf16_t*)(ws + WS_XB);
        {
            const size_t stride = (size_t)gridDim.x * NTHREADS;
            for (size_t i = (size_t)blockIdx.x * NTHREADS + threadIdx.x; i < (size_t)T * D / 4; i += 4 * stride) {
                f32x4 v[4];
#pragma unroll
                for (int q = 0; q < 4; ++q) v[q] = *(const f32x4*)(p.x + (i + q * stride) * 4);
#pragma unroll
                for (int q = 0; q < 4; ++q) { *(f32x4*)(xf + (i + q * stride) * 4) = v[q]; u32x2 w; w.x = pack2(v[q][0], v[q][1]); w.y = pack2(v[q][2], v[q][3]); *(u32x2*)(xb + (i + q * stride) * 4) = w; }
            }
        }
    }
    SEAM(0);

    run_layer<0>(p, lds, bar); run_layer<1>(p, lds, bar); run_layer<2>(p, lds, bar); run_layer<3>(p, lds, bar);
#undef IN
#undef SEAM
}

extern "C" void kernel_launch(void* const* d_in, const int* in_sizes, int n_in, void* d_out, int out_size, void* d_ws, size_t ws_size, hipStream_t stream) {
    static int grid = 0;
    if (grid == 0) {
        if (n_in != 22 || out_size != T * D || ws_size < WS_END) { fprintf(stderr, "kernel_launch: unexpected shapes (n_in %d out %d ws %zu need %zu)\n", n_in, out_size, ws_size, (size_t)WS_END); grid = -1; return; }
        if (hipFuncSetAttribute((const void*)fwd_kernel, hipFuncAttributeMaxDynamicSharedMemorySize, LDS_BYTES) != hipSuccess) { fprintf(stderr, "kernel_launch: hipFuncSetAttribute failed\n"); grid = -1; return; }
        int dev = 0, cus = 0;
        if (hipGetDevice(&dev) != hipSuccess || hipDeviceGetAttribute(&cus, hipDeviceAttributeMultiprocessorCount, dev) != hipSuccess) { grid = -1; return; }
        grid = cus;
    }
    if (grid < 0) return;
    (void)hipMemsetAsync((char*)d_ws + WS_CTL, 0, CTL_BYTES, stream);
    Params p{};
    const float** pp = (const float**)&p;
    for (int i = 0; i < 22; ++i) pp[i] = (const float*)d_in[i];
    p.out = (float*)d_out; p.ws = (unsigned char*)d_ws;
#if MK_ONE_LAUNCH
    p.ph_lo = 0; p.ph_hi = NPHASES;
    hipLaunchKernelGGL(fwd_kernel, dim3(grid), dim3(NTHREADS), LDS_BYTES, stream, p);
#else
    for (int ph = 0; ph < NPHASES; ++ph) {
        p.ph_lo = ph; p.ph_hi = ph + 1;
        hipLaunchKernelGGL(fwd_kernel, dim3(grid), dim3(NTHREADS), LDS_BYTES, stream, p);
    }
#endif
}
```

```cpp
#include <hip/hip_runtime.h>
#include <stdint.h>
#include <stdio.h>

#ifndef MK_ONE_LAUNCH
#define MK_ONE_LAUNCH 1
#endif

#define LAS __attribute__((address_space(3)))
typedef unsigned short bf16_t;
typedef short bf16x8 __attribute__((ext_vector_type(8)));
typedef float f32x4 __attribute__((ext_vector_type(4)));
typedef unsigned u32x4 __attribute__((ext_vector_type(4)));
typedef unsigned u32x2 __attribute__((ext_vector_type(2)));

constexpr int T = 16384, D = 1024, SEQ = 2048, NBATCH = 8, DEPTH = 4;
constexpr int NEXP = 32, TOPK = 4;
constexpr int MAXROWS = 73728;
constexpr float DN_ALPHA = 1.681792830507429f;
constexpr float LN_EPS = 1e-5f;
constexpr float GU_WSCALE = 64.0f, DN_WSCALE = 128.0f;
constexpr int NTHREADS = 512;

constexpr size_t MB = 1ull << 20;
constexpr size_t WS_CTL = 0;
constexpr size_t CTL_BYTES = 65536;
constexpr size_t WS_AWIN = 1 * MB;
constexpr size_t WS_AWOUT = WS_AWIN + 8 * MB;
constexpr size_t WS_BWIN = WS_AWOUT + 4 * MB;
constexpr size_t WS_BWOUT = WS_BWIN + 12 * MB;
constexpr size_t WS_CWIN = WS_BWOUT + 4 * MB;
constexpr size_t WS_CWOUT = WS_CWIN + 18 * MB;
constexpr size_t WS_GU = WS_CWOUT + 2 * MB;
constexpr size_t WS_DN = WS_GU + 512 * MB;
constexpr size_t WS_XF = WS_DN + 256 * MB;
constexpr size_t WS_XB = WS_XF + 64 * MB;
constexpr size_t WS_U = WS_XB + 32 * MB;
constexpr size_t WS_YIN = WS_U + 288 * MB;
constexpr size_t WS_YMIX = WS_YIN + 64 * MB;
constexpr size_t WS_SCR = WS_YMIX + 64 * MB;
constexpr size_t WS_TOPE = WS_SCR + 128 * MB;
constexpr size_t WS_GATES = WS_TOPE + 256 * 1024;
constexpr size_t WS_POS = WS_GATES + 256 * 1024;
constexpr size_t WS_DEST = WS_POS + 256 * 1024;
constexpr size_t WS_ROWTOK = WS_DEST + 256 * 1024;
constexpr size_t WS_HID = WS_ROWTOK + 1 * MB;
constexpr size_t WS_YROWS = WS_HID + 144 * MB;
constexpr size_t WS_LSUM = WS_YROWS + 288 * MB;
constexpr size_t WS_AGT = WS_LSUM + 2 * MB;
constexpr size_t WS_RT = WS_AGT + 1 * MB;
constexpr size_t WS_XQ = WS_RT + 1 * MB;
constexpr size_t WS_LIST = WS_XQ + 16 * MB;
constexpr size_t WS_END = WS_LIST + 2 * MB;

constexpr int CW_CNT = 4096;
constexpr int CW_MDYN = 8192;
constexpr int CW_TEXP = 12288;

#define XB_TMO      128
#define XB_XCNT(j)  (256  + 64 * (j))
#define XB_XSUB(j)  (1280 + 64 * (j))
#define XB_XGEN(j)  (2304 + 64 * (j))
#define XB_TOP      3328
#define XB_TOPGEN   3392
#define XCD_BAR_WORDS 3456
#define XB_SPIN_CAP (1u << 22)

__device__ __forceinline__ unsigned xb_ld(unsigned* p)              { return __hip_atomic_load(p, __ATOMIC_RELAXED, __HIP_MEMORY_SCOPE_AGENT); }
__device__ __forceinline__ unsigned xb_add(unsigned* p, unsigned v) { return __hip_atomic_fetch_add(p, v, __ATOMIC_RELAXED, __HIP_MEMORY_SCOPE_AGENT); }
__device__ __forceinline__ unsigned xb_xcc_id() { return (unsigned)__builtin_amdgcn_s_getreg((3 << 11) | 20) & 0xFu; }
#define XB_SPIN(cond, bar) do { unsigned _sp = 0; while (cond) { __builtin_amdgcn_s_sleep(1); \
    if ((++_sp & 255u) == 0u) { if (xb_ld(&(bar)[XB_TMO])) break; if (_sp > XB_SPIN_CAP) { atomicAdd(&(bar)[XB_TMO], 1u); break; } } } } while (0)

struct XcdBarrier { unsigned* bar; unsigned x; volatile LAS unsigned* st; };

__device__ __forceinline__ XcdBarrier xcd_barrier_post(unsigned* bar, volatile LAS unsigned* st) {
    XcdBarrier b; b.bar = bar; b.x = xb_xcc_id(); b.st = st;
    if (threadIdx.x == 0) (void)xb_add(&bar[XB_XCNT(b.x)], 1u);
    return b;
}
__device__ __forceinline__ void xcd_barrier_complete(unsigned* bar, unsigned x, unsigned& nloc, unsigned& nx) {
    const unsigned G = gridDim.x * gridDim.y * gridDim.z;
    unsigned sum, cnt, mine, sp = 0u;
    for (;;) {
        sum = 0u; cnt = 0u; mine = 0u;
#pragma unroll
        for (unsigned j = 0; j < 16; ++j) { const unsigned c = xb_ld(&bar[XB_XCNT(j)]); sum += c; cnt += (c > 0u) ? 1u : 0u; mine = (j == x) ? c : mine; }
        if (sum == G) break;
        __builtin_amdgcn_s_sleep(1);
        if ((++sp & 255u) == 0u) { if (xb_ld(&bar[XB_TMO])) break; if (sp > XB_SPIN_CAP) { atomicAdd(&bar[XB_TMO], 1u); break; } }
    }
    nloc = mine > 0u ? mine : 1u; nx = cnt > 0u ? cnt : 1u;
}
__device__ __forceinline__ void xcd_barrier_nv(unsigned* bbar, unsigned bx, volatile LAS unsigned* bst) {
    XcdBarrier b; b.bar = bbar; b.x = bx; b.st = bst;
    asm volatile("s_waitcnt vmcnt(0)" ::: "memory");
    __syncthreads();
    if (threadIdx.x == 0) {
        unsigned* bar = b.bar;
        __builtin_amdgcn_s_waitcnt(0);
        unsigned nloc = b.st[0], nx = b.st[1];
        if (nloc == 0u) { xcd_barrier_complete(bar, b.x, nloc, nx); b.st[0] = nloc; b.st[1] = nx; }
        const unsigned old = xb_add(&bar[XB_XSUB(b.x)], 1u);
        const unsigned gen = old / nloc;
        if (old + 1u == (gen + 1u) * nloc) {
            __builtin_amdgcn_fence(__ATOMIC_RELEASE, "agent");
            asm volatile("s_waitcnt vmcnt(0)" ::: "memory");
            const unsigned og = xb_add(&bar[XB_TOP], 1u);
            const unsigned tg = og / nx;
            if (og + 1u == (tg + 1u) * nx) xb_add(&bar[XB_TOPGEN], 1u);
            else XB_SPIN(xb_ld(&bar[XB_TOPGEN]) == tg, bar);
            __builtin_amdgcn_fence(__ATOMIC_ACQUIRE, "agent");
            xb_add(&bar[XB_XGEN(b.x)], 1u);
            asm volatile("s_waitcnt vmcnt(0)" ::: "memory");
        } else {
            XB_SPIN(xb_ld(&bar[XB_XGEN(b.x)]) == gen, bar);
            __builtin_amdgcn_fence(__ATOMIC_ACQUIRE, "agent");
            asm volatile("s_waitcnt vmcnt(0)" ::: "memory");
        }
    }
    __syncthreads();
}

__device__ __forceinline__ int tid_() { int t = threadIdx.x; asm volatile("" : "+v"(t)); return t; }
__device__ __forceinline__ float bf2f(bf16_t v) { return __uint_as_float(((unsigned)v) << 16); }
__device__ __forceinline__ bf16_t f2bf(float f) { unsigned u = __float_as_uint(f); u += 0x7FFFu + ((u >> 16) & 1u); return (bf16_t)(u >> 16); }
__device__ __forceinline__ unsigned pack2(float lo, float hi) { return (unsigned)f2bf(lo) | ((unsigned)f2bf(hi) << 16); }
__device__ __forceinline__ float wave_sum(float v) {
#pragma unroll
    for (int o = 32; o >= 1; o >>= 1) v += __shfl_xor(v, o);
    return v;
}
__device__ __forceinline__ float wave_max(float v) {
#pragma unroll
    for (int o = 32; o >= 1; o >>= 1) v = fmaxf(v, __shfl_xor(v, o));
    return v;
}
__device__ __forceinline__ float sigmoidf_(float x) { return 1.0f / (1.0f + __expf(-x)); }
__device__ __forceinline__ float gelu_tanh(float x) { const float u = 0.7978845608028654f * (x + 0.044715f * x * x * x); return 0.5f * x * (1.0f + tanhf(u)); }
__device__ __forceinline__ unsigned pk_fp8x4(float a, float b, float c, float d) { int w = 0; w = __builtin_amdgcn_cvt_pk_fp8_f32(a, b, w, false); w = __builtin_amdgcn_cvt_pk_fp8_f32(c, d, w, true); return (unsigned)w; }
__device__ __forceinline__ float swiglu(float gate, float up) {
    const float g = fminf(gate, 7.0f), u = fminf(fmaxf(up, -7.0f), 7.0f);
    return (u + 1.0f) * g * sigmoidf_(1.702f * g);
}

struct Params {
    const float* x; const float* a_w_in; const float* a_conv_w; const float* a_conv_b; const float* a_w_rgate; const float* a_b_rgate;
    const float* a_w_igate; const float* a_b_igate; const float* a_lambda; const float* a_w_out; const float* b_w_in; const float* b_w_out;
    const float* c_w_in; const float* c_w_out; const float* ln_gain; const float* ln_bias; const float* moe_w_router; const float* moe_b_router;
    const float* moe_w_gu; const float* moe_b_gu; const float* moe_w_down; const float* moe_b_down;
    float* out; unsigned char* ws;
    int ph_lo, ph_hi;
};

__device__ __forceinline__ void convert_job(LAS float* tile, const float* src, bf16_t* dst, int K, int N, int batch) {
    const int tid = tid_();
    const int tk = K / 64, tn = N / 64, per = tk * tn; const long total = (long)per * batch;
    for (long u = blockIdx.x; u < total; u += gridDim.x) {
        const int bidx = (int)(u / per), r = (int)(u % per), kt = r / tn, nt = r % tn;
        const float* s = src + (size_t)bidx * K * N + (size_t)(kt * 64) * N + nt * 64;
#pragma unroll
        for (int pass = 0; pass < 2; ++pass) {
            const int row = (tid >> 4) + 32 * pass, c4 = tid & 15;
            const f32x4 v = *(const f32x4*)(s + (size_t)row * N + c4 * 4);
            tile[row * 65 + c4 * 4 + 0] = v[0]; tile[row * 65 + c4 * 4 + 1] = v[1]; tile[row * 65 + c4 * 4 + 2] = v[2]; tile[row * 65 + c4 * 4 + 3] = v[3];
        }
        __syncthreads();
        {
            const int n = tid >> 3, k8 = tid & 7;
            float v[8];
#pragma unroll
            for (int j = 0; j < 8; ++j) v[j] = tile[(k8 * 8 + j) * 65 + n];
            u32x4 w; w.x = pack2(v[0], v[1]); w.y = pack2(v[2], v[3]); w.z = pack2(v[4], v[5]); w.w = pack2(v[6], v[7]);
            *(u32x4*)(dst + (size_t)bidx * N * K + (size_t)(nt * 64 + n) * K + kt * 64 + k8 * 8) = w;
        }
        __syncthreads();
    }
}

struct GemmS {
    const bf16_t* A; int lda;
    const bf16_t* Bt; int ldb;
    int M, N, K;
    const unsigned* Mdyn;
    const int* row_idx;
    const unsigned* tile_exp;
    size_t b_exp_stride;
    const float* bias; int bias_es;
    float* Cf; bf16_t* Cb; int ldc;
};
template <int MODE>
__device__ __forceinline__ void gemm_simple(LAS unsigned char* lds, const GemmS& g) {
    const int tid = tid_(), lane = tid & 63, wid = tid >> 6, wr = wid >> 1, wc = wid & 1, fr = lane & 15, fq = lane >> 4;
    const int M = g.Mdyn ? (int)*g.Mdyn : g.M;
    const int tiles_n = (MODE == 1) ? (g.N / 256) * 2 : g.N / 128;
    const int tiles_m = M / 128, nunits = tiles_m * tiles_n, nk = g.K / 32;
    LAS bf16_t* As = (LAS bf16_t*)lds;
    LAS bf16_t* Bs = As + 2 * 128 * 40;
    const int lrow = tid >> 2, lch = tid & 3;
    for (int u = blockIdx.x; u < nunits; u += gridDim.x) {
        const int tm = u / tiles_n, tn = u % tiles_n, m0 = tm * 128;
        const int e = (MODE != 0) ? (int)g.tile_exp[m0 >> 8] : 0;
        const bf16_t* Bbase = g.Bt + (size_t)e * g.b_exp_stride;
        int arow = m0 + lrow; if (MODE == 1) arow = g.row_idx[arow];
        int brow;
        if (MODE == 1) { const int bwc = lrow >> 6, ni = (lrow & 63) >> 4, r = lrow & 15; brow = ((ni & 1) ? 1024 : 0) + tn * 64 + bwc * 32 + (ni >> 1) * 16 + r; }
        else brow = tn * 128 + lrow;
        const bf16_t* ap = g.A + (size_t)arow * g.lda + lch * 8;
        const bf16_t* bp = Bbase + (size_t)brow * g.ldb + lch * 8;
        f32x4 acc[2][4];
#pragma unroll
        for (int mi = 0; mi < 2; ++mi)
#pragma unroll
            for (int ni = 0; ni < 4; ++ni) acc[mi][ni] = (f32x4){0.f, 0.f, 0.f, 0.f};
        u32x4 ra = *(const u32x4*)ap, rb = *(const u32x4*)bp;
        *(LAS u32x4*)(As + lrow * 40 + lch * 8) = ra; *(LAS u32x4*)(Bs + lrow * 40 + lch * 8) = rb;
        __syncthreads();
        for (int kt = 0; kt < nk; ++kt) {
            const int cur = kt & 1;
            if (kt + 1 < nk) { ra = *(const u32x4*)(ap + (kt + 1) * 32); rb = *(const u32x4*)(bp + (kt + 1) * 32); }
            bf16x8 af[2], bfr[4];
#pragma unroll
            for (int mi = 0; mi < 2; ++mi) af[mi] = *(const LAS bf16x8*)(As + cur * 5120 + (wr * 32 + mi * 16 + fr) * 40 + fq * 8);
#pragma unroll
            for (int ni = 0; ni < 4; ++ni) bfr[ni] = *(const LAS bf16x8*)(Bs + cur * 5120 + (wc * 64 + ni * 16 + fr) * 40 + fq * 8);
#pragma unroll
            for (int mi = 0; mi < 2; ++mi)
#pragma unroll
                for (int ni = 0; ni < 4; ++ni) acc[mi][ni] = __builtin_amdgcn_mfma_f32_16x16x32_bf16(bfr[ni], af[mi], acc[mi][ni], 0, 0, 0);
            if (kt + 1 < nk) { *(LAS u32x4*)(As + (cur ^ 1) * 5120 + lrow * 40 + lch * 8) = ra; *(LAS u32x4*)(Bs + (cur ^ 1) * 5120 + lrow * 40 + lch * 8) = rb; }
            __syncthreads();
        }
#pragma unroll
        for (int mi = 0; mi < 2; ++mi) {
            const int m = m0 + wr * 32 + mi * 16 + fr;
            if (MODE == 1) {
#pragma unroll
                for (int q = 0; q < 2; ++q) {
                    const int hc = tn * 64 + wc * 32 + q * 16 + 4 * fq;
                    const f32x4 bg = *(const f32x4*)(g.bias + (size_t)e * g.bias_es + hc), bu = *(const f32x4*)(g.bias + (size_t)e * g.bias_es + 1024 + hc);
                    const f32x4 gt = acc[mi][2 * q] + bg, up = acc[mi][2 * q + 1] + bu;
                    u32x2 w; w.x = pack2(swiglu(gt[0], up[0]), swiglu(gt[1], up[1])); w.y = pack2(swiglu(gt[2], up[2]), swiglu(gt[3], up[3]));
                    *(u32x2*)(g.Cb + (size_t)m * g.ldc + hc) = w;
                }
            } else {
#pragma unroll
                for (int ni = 0; ni < 4; ++ni) {
                    const int n = tn * 128 + wc * 64 + ni * 16 + 4 * fq;
                    f32x4 v = acc[mi][ni];
                    if (g.bias) v += *(const f32x4*)(g.bias + (size_t)e * g.bias_es + n);
                    if (g.Cf) *(f32x4*)(g.Cf + (size_t)m * g.ldc + n) = v;
                    else { u32x2 w; w.x = pack2(v[0], v[1]); w.y = pack2(v[2], v[3]); *(u32x2*)(g.Cb + (size_t)m * g.ldc + n) = w; }
                }
            }
        }
    }
}


constexpr int TAB_OFF = 131072;
__device__ __forceinline__ void moe_tables(LAS unsigned char* lds, const unsigned* ctl, int layer) {
    LAS int* tab = (LAS int*)(lds + TAB_OFF);
    const int tid = tid_();
    __syncthreads();
    if (tid == 0) { int acc = 0; for (int e = 0; e < NEXP; ++e) { tab[e] = acc; acc += ((int)ctl[CW_CNT + layer * 64 + e] + 255) >> 8; } tab[32] = acc; }
    __syncthreads();
    if (tid < 288) { int e = 0; for (int q = 1; q < NEXP; ++q) e += (tab[q] <= tid) ? 1 : 0; tab[64 + tid] = e; }
    __syncthreads();
}

namespace g8 {
constexpr int BM = 256, BK = 64, HALF = 128, HTB = HALF * BK * 2, STAGE_BYTES = 8 * HTB, NXCD = 8, WGM = 8;
__device__ __forceinline__ int lds_byte(int r, int c) { const int st = (r >> 4) * 2 + (c >> 5), rr = r & 15, cc = c & 31, ob = rr * 64 + cc * 2; return st * 1024 + (ob ^ (((ob >> 9) & 1) << 5)); }
__device__ __forceinline__ void stage_rc(int b, int& R, int& C) { const int st = b / 1024, sb = b % 1024, swz = sb ^ (((sb >> 9) & 1) << 5); R = (st >> 1) * 16 + swz / 64; C = (st & 1) * 32 + (swz % 64) / 2; }
__device__ __forceinline__ int perm32(int rho) { const int n = rho >> 4, i = rho & 15; return 8 * (i >> 2) + 4 * n + (i & 3); }
__device__ __forceinline__ unsigned cvt_pk_bf16(float lo, float hi) { unsigned r; asm volatile("v_cvt_pk_bf16_f32 %0, %1, %2" : "=v"(r) : "v"(lo), "v"(hi)); return r; }

struct Unit { const char* a0; const char* a1; const char* b0; const char* b1; const int* rows; int row0, col0, e; };

struct SchedPlain {
    const char* A; const char* Bt; size_t hstepA, hstepB; int nM, nN, nwg, G, c;
    __device__ __forceinline__ void init(const void* A_, const void* Bt_, int M, int N, int K, int G_, int c_) { A = (const char*)A_; Bt = (const char*)Bt_; hstepA = (size_t)HALF * K * 2; hstepB = hstepA; nM = M / BM; nN = N / BM; nwg = nM * nN; G = G_; c = c_; }
    __device__ __forceinline__ bool next(int i, Unit& u) const {
        const long L = (long)i * G + c; if (L >= nwg) return false;
        int wgid = (int)L; { const int q = nwg / NXCD, r = nwg % NXCD, xcd = wgid % NXCD, off = wgid / NXCD; wgid = (xcd < r ? xcd * (q + 1) : r * (q + 1) + (xcd - r) * q) + off; }
        const int nig = WGM * nN, gid = wgid / nig, fm = gid * WGM, gsz = (nM - fm) < WGM ? (nM - fm) : WGM;
        const int pm = fm + ((wgid % nig) % gsz), pn = (wgid % nig) / gsz;
        u.a0 = A + (size_t)pm * 2 * hstepA; u.a1 = u.a0 + hstepA; u.b0 = Bt + (size_t)pn * 2 * hstepB; u.b1 = u.b0 + hstepB; u.rows = nullptr; u.row0 = pm * BM; u.col0 = pn * BM; u.e = 0;
        return true;
    }
};
struct SchedGU {
    const char* A; const char* W; const int* elist; LAS const int* tab; int G, c;
    __device__ __forceinline__ bool next(int i, Unit& u) const {
        const int L = i * G + c, rt = L >> 3, pn = L & 7; if (rt >= __builtin_amdgcn_readfirstlane(tab[32])) return false;
        const int e = __builtin_amdgcn_readfirstlane(tab[64 + rt]), j = rt - __builtin_amdgcn_readfirstlane(tab[e]);
        u.a0 = A; u.a1 = A; u.rows = elist + (size_t)e * T + j * BM; u.b0 = W + ((size_t)e * 2048 + pn * 128) * D; u.b1 = u.b0 + (size_t)1024 * D; u.row0 = rt * BM; u.col0 = pn * 128; u.e = e;
        return true;
    }
};
struct SchedDown {
    const char* A; const char* W; LAS const int* tab; int G, c;
    __device__ __forceinline__ bool next(int i, Unit& u) const {
        const int L = i * G + c, rt = L >> 2, pn = L & 3; if (rt >= __builtin_amdgcn_readfirstlane(tab[32])) return false;
        const int e = __builtin_amdgcn_readfirstlane(tab[64 + rt]);
        u.a0 = A + (size_t)rt * BM * D; u.a1 = u.a0 + (size_t)HALF * D; u.rows = nullptr; u.b0 = W + ((size_t)e * 1024 + pn * BM) * D; u.b1 = u.b0 + (size_t)HALF * D; u.row0 = rt * BM; u.col0 = pn * BM; u.e = e;
        return true;
    }
};

struct EpiF32 {
    static constexpr bool PERM = false;
    float* C; int ldc; const float* bias; int bias_es;
    __device__ __forceinline__ void operator()(const f32x4 (&acc)[2][2][4][2], const Unit& u, int wr, int wc, int fr, int fq) const {
        const int row0 = u.row0 + wr * 64 + fr, col0 = u.col0 + wc * 32 + 4 * fq;
        f32x4 bv[2][2];
#pragma unroll
        for (int bj = 0; bj < 2; ++bj)
#pragma unroll
            for (int n = 0; n < 2; ++n) bv[bj][n] = bias ? *(const f32x4*)(bias + (size_t)u.e * bias_es + col0 + bj * HALF + n * 16) : (f32x4){0.f, 0.f, 0.f, 0.f};
#pragma unroll
        for (int ai = 0; ai < 2; ++ai)
#pragma unroll
            for (int m = 0; m < 4; ++m) { float* rowp = C + (size_t)(row0 + ai * HALF + m * 16) * ldc + col0;
#pragma unroll
                for (int bj = 0; bj < 2; ++bj)
#pragma unroll
                    for (int n = 0; n < 2; ++n) *(f32x4*)(rowp + bj * HALF + n * 16) = acc[ai][bj][m][n] + bv[bj][n]; }
    }
};
struct EpiBf16 {
    static constexpr bool PERM = true;
    bf16_t* O; int ldc; const float* bias; int bias_es; float scale;
    __device__ __forceinline__ void operator()(const f32x4 (&acc)[2][2][4][2], const Unit& u, int wr, int wc, int fr, int fq) const {
        const int row0 = u.row0 + wr * 64 + fr, col0 = u.col0 + wc * 32 + 8 * fq;
        f32x4 bv[2][2];
#pragma unroll
        for (int bj = 0; bj < 2; ++bj)
#pragma unroll
            for (int n = 0; n < 2; ++n) bv[bj][n] = bias ? *(const f32x4*)(bias + (size_t)u.e * bias_es + col0 + bj * HALF + 4 * n) : (f32x4){0.f, 0.f, 0.f, 0.f};
#pragma unroll
        for (int ai = 0; ai < 2; ++ai)
#pragma unroll
            for (int m = 0; m < 4; ++m) { bf16_t* rowp = O + (size_t)(row0 + ai * HALF + m * 16) * ldc + col0;
#pragma unroll
                for (int bj = 0; bj < 2; ++bj) { const f32x4 v0 = acc[ai][bj][m][0] * scale + bv[bj][0], v1 = acc[ai][bj][m][1] * scale + bv[bj][1];
                    u32x4 w; w.x = cvt_pk_bf16(v0[0], v0[1]); w.y = cvt_pk_bf16(v0[2], v0[3]); w.z = cvt_pk_bf16(v1[0], v1[1]); w.w = cvt_pk_bf16(v1[2], v1[3]);
                    *(u32x4*)(rowp + bj * HALF) = w; } }
    }
};
struct EpiSwiglu {
    static constexpr bool PERM = true;
    unsigned char* O; const float* bias; float scale;
    __device__ __forceinline__ void operator()(const f32x4 (&acc)[2][2][4][2], const Unit& u, int wr, int wc, int fr, int fq) const {
        const int row0 = u.row0 + wr * 64 + fr, hc = u.col0 + wc * 32 + 8 * fq;
        const float* bp = bias + (size_t)u.e * 2048 + hc;
        const f32x4 bg0 = *(const f32x4*)(bp), bg1 = *(const f32x4*)(bp + 4), bu0 = *(const f32x4*)(bp + 1024), bu1 = *(const f32x4*)(bp + 1028);
#pragma unroll
        for (int ai = 0; ai < 2; ++ai)
#pragma unroll
            for (int m = 0; m < 4; ++m) {
                const f32x4 g0 = acc[ai][0][m][0] * scale + bg0, g1 = acc[ai][0][m][1] * scale + bg1, u0 = acc[ai][1][m][0] * scale + bu0, u1 = acc[ai][1][m][1] * scale + bu1;
                u32x2 w; w.x = pk_fp8x4(swiglu(g0[0], u0[0]), swiglu(g0[1], u0[1]), swiglu(g0[2], u0[2]), swiglu(g0[3], u0[3]));
                w.y = pk_fp8x4(swiglu(g1[0], u1[0]), swiglu(g1[1], u1[1]), swiglu(g1[2], u1[2]), swiglu(g1[3], u1[3]));
                *(u32x2*)(O + (size_t)(row0 + ai * HALF + m * 16) * D + hc) = w;
            }
    }
};

typedef int i32x8 __attribute__((ext_vector_type(8)));
typedef int i32x4 __attribute__((ext_vector_type(4)));
template <class Epi, class Sched, bool GATHER, int ESZ = 2>
__device__ __forceinline__ void gemm_phase(LAS unsigned char* lds, const int K, const Sched& S, const Epi& E) {
    const int tid = tid_(), wid = __builtin_amdgcn_readfirstlane(tid >> 6), lane = tid & 63, wr = wid >> 2, wc = wid & 3, fr = lane & 15, fq = lane >> 4;
    const int nt = K * ESZ / 128, KP = K * ESZ;
    int sR[2], sC[2];
    unsigned voffB[2];
#pragma unroll
    for (int i = 0; i < 2; ++i) { stage_rc(tid * 16 + i * 8192, sR[i], sC[i]); const int Rb = Epi::PERM ? ((sR[i] & ~31) + perm32(sR[i] & 31)) : sR[i]; voffB[i] = (unsigned)(Rb * KP + sC[i] * 2); }
    unsigned cvA0[2], cvA1[2], nvA0[2], nvA1[2];
#define G8_VOFF(u, v0, v1) do { _Pragma("unroll") for (int _i = 0; _i < 2; ++_i) { \
        if (GATHER) { unsigned t0_ = (unsigned)(u).rows[sR[_i]], t1_ = (unsigned)(u).rows[HALF + sR[_i]]; t0_ = t0_ < (unsigned)T ? t0_ : 0u; t1_ = t1_ < (unsigned)T ? t1_ : 0u;     \
            v0[_i] = t0_ * (unsigned)KP + (unsigned)(sC[_i] * 2); v1[_i] = t1_ * (unsigned)KP + (unsigned)(sC[_i] * 2); } \
        else { v0[_i] = (unsigned)(sR[_i] * KP + sC[_i] * 2); v1[_i] = v0[_i]; } } } while (0)
    const size_t kstep = (size_t)(BK * 2);
    const unsigned ldsw = (unsigned)wid * 1024u;
    const int aoff = lds_byte(wr * 64 + fr, fq * 8), boff = lds_byte(wc * 32 + fr, fq * 8);
#define PG8_SA(b, h) (((b) * 2 + (h)) * HTB)
#define PG8_SB(b, h) ((4 + (b) * 2 + (h)) * HTB)
#define PG8_STAGE(bufoff, gbase, voff) do { _Pragma("unroll") for (int _i = 0; _i < 2; ++_i) \
        __builtin_amdgcn_global_load_lds((const unsigned*)((const char*)(gbase) + (voff)[_i]), (LAS unsigned*)(lds + (bufoff) + ldsw + _i * 8192), 16, 0, 0); } while (0)
#define PG8_LDA(dst, b, h) do { _Pragma("unroll") for (int m = 0; m < 4; ++m) { dst[m].lo = *(const LAS i32x4*)(lds + PG8_SA(b, h) + aoff + m * 2048); dst[m].hi = *(const LAS i32x4*)(lds + PG8_SA(b, h) + aoff + m * 2048 + 1024); } } while (0)
#define PG8_LDB(dst, b, h) do { _Pragma("unroll") for (int n = 0; n < 2; ++n) { dst[n].lo = *(const LAS i32x4*)(lds + PG8_SB(b, h) + boff + n * 2048); dst[n].hi = *(const LAS i32x4*)(lds + PG8_SB(b, h) + boff + n * 2048 + 1024); } } while (0)
#define PG8_MMA(ai, bj, At, Bt) do { __builtin_amdgcn_s_setprio(1); _Pragma("unroll") for (int m = 0; m < 4; ++m) _Pragma("unroll") for (int n = 0; n < 2; ++n) { \
        if (ESZ == 2) { acc[ai][bj][m][n] = __builtin_amdgcn_mfma_f32_16x16x32_bf16(__builtin_bit_cast(bf16x8, (i32x4)__builtin_shufflevector(Bt[n], Bt[n], 0, 1, 2, 3)), __builtin_bit_cast(bf16x8, (i32x4)__builtin_shufflevector(At[m], At[m], 0, 1, 2, 3)), acc[ai][bj][m][n], 0, 0, 0); \
                        acc[ai][bj][m][n] = __builtin_amdgcn_mfma_f32_16x16x32_bf16(__builtin_bit_cast(bf16x8, (i32x4)__builtin_shufflevector(Bt[n], Bt[n], 4, 5, 6, 7)), __builtin_bit_cast(bf16x8, (i32x4)__builtin_shufflevector(At[m], At[m], 4, 5, 6, 7)), acc[ai][bj][m][n], 0, 0, 0); } \
        else asm volatile("v_mfma_f32_16x16x128_f8f6f4 %0, %1, %2, %0" : "+v"(acc[ai][bj][m][n]) : "v"(Bt[n]), "v"(At[m])); } __builtin_amdgcn_s_setprio(0); } while (0)
#define PG8_WAIT_V(n) asm volatile("s_waitcnt vmcnt(" #n ")" ::: "memory")
#define PG8_WAIT_L(n) asm volatile("s_waitcnt lgkmcnt(" #n ")" ::: "memory")
#define PG8_BAR __builtin_amdgcn_s_barrier()
#define PG8_SCHED __builtin_amdgcn_sched_barrier(0)
    Unit cur, nxt; int ui = 0;
    if (!S.next(0, cur)) return;
    f32x4 acc[2][2][4][2];
#pragma unroll
    for (int a = 0; a < 2; ++a)
#pragma unroll
        for (int b = 0; b < 2; ++b)
#pragma unroll
            for (int m = 0; m < 4; ++m)
#pragma unroll
                for (int n = 0; n < 2; ++n) acc[a][b][m][n] = (f32x4){0.f, 0.f, 0.f, 0.f};
    i32x8 At[4], B0[2], B1[2];
    const char* cA0 = cur.a0; const char* cA1 = cur.a1; const char* cB0 = cur.b0; const char* cB1 = cur.b1;
    G8_VOFF(cur, cvA0, cvA1);
    PG8_STAGE(PG8_SB(0, 0), cB0, voffB); PG8_STAGE(PG8_SB(0, 1), cB1, voffB); PG8_STAGE(PG8_SA(0, 0), cA0, cvA0); PG8_STAGE(PG8_SA(0, 1), cA1, cvA1);
    if (wr == 1) PG8_BAR;
    PG8_WAIT_V(2); PG8_BAR;
    PG8_STAGE(PG8_SB(1, 0), cB0 + kstep, voffB); PG8_STAGE(PG8_SA(1, 0), cA0 + kstep, cvA0); PG8_STAGE(PG8_SB(1, 1), cB1 + kstep, voffB);
    PG8_WAIT_V(6); PG8_BAR;
    for (;;) {
        const bool has_next = S.next(ui + 1, nxt);
        const char* nA0 = has_next ? nxt.a0 : cA0; const char* nA1 = has_next ? nxt.a1 : cA1; const char* nB0 = has_next ? nxt.b0 : cB0; const char* nB1 = has_next ? nxt.b1 : cB1;
        if (GATHER) { if (has_next) { G8_VOFF(nxt, nvA0, nvA1); } else { nvA0[0] = cvA0[0]; nvA0[1] = cvA0[1]; nvA1[0] = cvA1[0]; nvA1[1] = cvA1[1]; } }
#pragma unroll 1
        for (int t = 0; t < nt; t += 2) {
            const bool last = (t == nt - 2);
            const char* a1_1 = cA1 + (size_t)(t + 1) * kstep;
            const char* a2_0 = last ? nA0 : cA0 + (size_t)(t + 2) * kstep; const char* a2_1 = last ? nA1 : cA1 + (size_t)(t + 2) * kstep;
            const char* b2_0 = last ? nB0 : cB0 + (size_t)(t + 2) * kstep; const char* b2_1 = last ? nB1 : cB1 + (size_t)(t + 2) * kstep;
            const char* a3_0 = a2_0 + kstep; const char* b3_0 = b2_0 + kstep; const char* b3_1 = b2_1 + kstep;
            unsigned vA0[2], vA1[2];
            if (GATHER) { vA0[0] = last ? nvA0[0] : cvA0[0]; vA0[1] = last ? nvA0[1] : cvA0[1]; vA1[0] = last ? nvA1[0] : cvA1[0]; vA1[1] = last ? nvA1[1] : cvA1[1]; }
            else { vA0[0] = cvA0[0]; vA0[1] = cvA0[1]; vA1[0] = cvA0[0]; vA1[1] = cvA0[1]; }
            PG8_LDB(B0, 0, 0); PG8_LDB(B1, 0, 1); PG8_SCHED; PG8_LDA(At, 0, 0); PG8_STAGE(PG8_SA(1, 1), a1_1, cvA1);
            PG8_WAIT_V(8); PG8_WAIT_L(0); PG8_BAR; PG8_MMA(0, 0, At, B0); PG8_MMA(0, 1, At, B1); PG8_BAR; PG8_SCHED;
            PG8_LDA(At, 0, 1); PG8_STAGE(PG8_SB(0, 0), b2_0, voffB); PG8_STAGE(PG8_SB(0, 1), b2_1, voffB); PG8_STAGE(PG8_SA(0, 0), a2_0, vA0);
            PG8_WAIT_V(8); PG8_WAIT_L(0); PG8_BAR; PG8_MMA(1, 0, At, B0); PG8_MMA(1, 1, At, B1); PG8_BAR; PG8_SCHED;
            PG8_LDB(B0, 1, 0); PG8_LDB(B1, 1, 1); PG8_SCHED; PG8_LDA(At, 1, 0); PG8_STAGE(PG8_SA(0, 1), a2_1, vA1);
            PG8_WAIT_V(8); PG8_WAIT_L(0); PG8_BAR; PG8_MMA(0, 0, At, B0); PG8_MMA(0, 1, At, B1); PG8_BAR; PG8_SCHED;
            PG8_LDA(At, 1, 1); PG8_STAGE(PG8_SB(1, 0), b3_0, voffB); PG8_STAGE(PG8_SB(1, 1), b3_1, voffB); PG8_STAGE(PG8_SA(1, 0), a3_0, vA0);
            PG8_WAIT_V(8); PG8_WAIT_L(0); PG8_BAR; PG8_MMA(1, 0, At, B0); PG8_MMA(1, 1, At, B1); PG8_BAR; PG8_SCHED;
        }
        if (wr == 0) PG8_BAR;
        if (ESZ == 1) asm volatile("s_nop 15\n\ts_nop 15" ::: "memory");
        E(acc, cur, wr, wc, fr, fq);
        if (!has_next) break;
#pragma unroll
        for (int a = 0; a < 2; ++a)
#pragma unroll
            for (int b = 0; b < 2; ++b)
#pragma unroll
                for (int m = 0; m < 4; ++m)
#pragma unroll
                    for (int n = 0; n < 2; ++n) acc[a][b][m][n] = (f32x4){0.f, 0.f, 0.f, 0.f};
        cur = nxt; cA0 = nA0; cA1 = nA1; cB0 = nB0; cB1 = nB1; ++ui;
        if (GATHER) { cvA0[0] = nvA0[0]; cvA0[1] = nvA0[1]; cvA1[0] = nvA1[0]; cvA1[1] = nvA1[1]; }
        if (wr == 1) PG8_BAR;
    }
    PG8_WAIT_V(0);
    PG8_BAR;
#undef G8_VOFF
#undef PG8_SA
#undef PG8_SB
#undef PG8_STAGE
#undef PG8_LDA
#undef PG8_LDB
#undef PG8_MMA
#undef PG8_WAIT_V
#undef PG8_WAIT_L
#undef PG8_BAR
#undef PG8_SCHED
}
}


template <bool F8>
__device__ __forceinline__ void convert_big(LAS unsigned char* lds, const float* src, void* dstv, int K, int N, int batch, float scale) {
    const int tid = tid_(), lane = tid & 63, wid = tid >> 6;
    const int nbn = N / 256, per = (K / 128) * nbn, total = per * batch, G = (int)gridDim.x;
    constexpr int ESZ = F8 ? 1 : 2, ROWB = 128 * ESZ, TILEB = 256 * ROWB;
    f32x4 ra[16], rb[16];
#define CV_LOAD(uu, reg) do { const int bidx = (uu) / per, r_ = (uu) % per, kb = r_ / nbn, nb = r_ % nbn; \
        const float* sp = src + (size_t)bidx * K * N + (size_t)(kb * 128 + 16 * wid) * N + nb * 256 + 4 * lane; \
        _Pragma("unroll") for (int i = 0; i < 16; ++i) reg[i] = *(const f32x4*)(sp + (size_t)i * N); } while (0)
#define CV_PACK(reg, tl) do { _Pragma("unroll") for (int j = 0; j < 4; ++j) { \
        if (F8) { u32x4 w0; w0.x = pk_fp8x4(reg[0][j] * scale, reg[1][j] * scale, reg[2][j] * scale, reg[3][j] * scale); w0.y = pk_fp8x4(reg[4][j] * scale, reg[5][j] * scale, reg[6][j] * scale, reg[7][j] * scale); \
            w0.z = pk_fp8x4(reg[8][j] * scale, reg[9][j] * scale, reg[10][j] * scale, reg[11][j] * scale); w0.w = pk_fp8x4(reg[12][j] * scale, reg[13][j] * scale, reg[14][j] * scale, reg[15][j] * scale); \
            *(LAS u32x4*)((tl) + (4 * lane + j) * ROWB + ((wid ^ (lane & 7)) * 16)) = w0; } \
        else { u32x4 w0, w1; \
            w0.x = g8::cvt_pk_bf16(reg[0][j], reg[1][j]); w0.y = g8::cvt_pk_bf16(reg[2][j], reg[3][j]); w0.z = g8::cvt_pk_bf16(reg[4][j], reg[5][j]); w0.w = g8::cvt_pk_bf16(reg[6][j], reg[7][j]); \
            w1.x = g8::cvt_pk_bf16(reg[8][j], reg[9][j]); w1.y = g8::cvt_pk_bf16(reg[10][j], reg[11][j]); w1.z = g8::cvt_pk_bf16(reg[12][j], reg[13][j]); w1.w = g8::cvt_pk_bf16(reg[14][j], reg[15][j]); \
            *(LAS u32x4*)((tl) + (4 * lane + j) * ROWB + (((2 * wid) ^ (lane & 15)) * 16)) = w0; *(LAS u32x4*)((tl) + (4 * lane + j) * ROWB + (((2 * wid + 1) ^ (lane & 15)) * 16)) = w1; } } } while (0)
#define CV_STORE(uu, tl) do { const int bidx = (uu) / per, r_ = (uu) % per, kb = r_ / nbn, nb = r_ % nbn; \
        unsigned char* dp = (unsigned char*)dstv + ((size_t)bidx * N * K + (size_t)(nb * 256) * K + kb * 128) * ESZ; \
        _Pragma("unroll") for (int i = 0; i < 4 * ESZ; ++i) { const int pc = tid + NTHREADS * i, n = pc / (8 * ESZ), c = pc % (8 * ESZ); \
            *(u32x4*)(dp + (size_t)n * K * ESZ + c * 16) = *(const LAS u32x4*)((tl) + n * ROWB + ((c ^ ((n >> 2) & (8 * ESZ - 1))) * 16)); } } while (0)
    const int u0 = blockIdx.x;
    if (u0 < total) CV_LOAD(u0, ra);
    if (u0 + G < total) CV_LOAD(u0 + G, rb);
    for (int u = u0; u < total; u += 2 * G) {
        CV_PACK(ra, lds);
        if (u + 2 * G < total) CV_LOAD(u + 2 * G, ra);
        __syncthreads();
        CV_STORE(u, lds);
        const bool has_b = (u + G < total);
        if (has_b) { CV_PACK(rb, lds + TILEB); if (u + 3 * G < total) CV_LOAD(u + 3 * G, rb); }
        __syncthreads();
        if (has_b) CV_STORE(u + G, lds + TILEB);
    }
    __syncthreads();
#undef CV_LOAD
#undef CV_PACK
#undef CV_STORE
}

__device__ __forceinline__ float gelu_fast(float x) { const float u2 = 1.5957691216057308f * (x + 0.044715f * x * x * x); return x / (1.0f + __expf(-u2)); }
__device__ __forceinline__ void lru_gates_phase(LAS unsigned char* lds, const Params& p, int idx) {
    const int tid = tid_(), lane = tid & 63, wid = tid >> 6, fr = lane & 15, fq = lane >> 4;
    LAS bf16_t* xcb = (LAS bf16_t*)lds;
    LAS float* xcf = (LAS float*)(lds + 17408);
    LAS float* sa = (LAS float*)(lds + 17408 + 33792);
    LAS float* sb = sa + 64 * 132;
    LAS float* comb = sb + 64 * 132;
    const bf16_t* u = (const bf16_t*)(p.ws + WS_U);
    bf16_t* Carr = (bf16_t*)(p.ws + WS_SCR); bf16_t* Barr = Carr + (size_t)T * D;
    float* SP = (float*)(p.ws + WS_LSUM); float* SH = SP + NBATCH * 32 * D;
    const int hd = blockIdx.x & 7, slot = blockIdx.x >> 3, nslots = gridDim.x >> 3;
    const float* conv_w = p.a_conv_w + (size_t)idx * 4 * D; const float* conv_b = p.a_conv_b + (size_t)idx * D;
    const bf16_t* wrt = (const bf16_t*)(p.ws + WS_AGT) + ((size_t)(idx * 2 + 0) * 8 + hd) * 128 * 128;
    const bf16_t* wit = (const bf16_t*)(p.ws + WS_AGT) + ((size_t)(idx * 2 + 1) * 8 + hd) * 128 * 128;
    bf16x8 Br[4], Bi[4];
#pragma unroll
    for (int ks = 0; ks < 4; ++ks) { Br[ks] = *(const bf16x8*)(wrt + (size_t)(16 * wid + fr) * 128 + 32 * ks + 8 * fq); Bi[ks] = *(const bf16x8*)(wit + (size_t)(16 * wid + fr) * 128 + 32 * ks + 8 * fq); }
    const int cg = hd * 128 + 16 * wid + 4 * fq;
    const f32x4 brv = *(const f32x4*)(p.a_b_rgate + (size_t)idx * D + cg), biv = *(const f32x4*)(p.a_b_igate + (size_t)idx * D + cg), lmv = *(const f32x4*)(p.a_lambda + (size_t)idx * D + cg);
    f32x4 spv;
#pragma unroll
    for (int r = 0; r < 4; ++r) spv[r] = (lmv[r] > 15.f) ? __expf(-lmv[r]) : log1pf(__expf(-lmv[r]));
    const int cc = (tid & 31) * 4, cch = hd * 128 + cc;
    f32x4 cw[4];
#pragma unroll
    for (int j = 0; j < 4; ++j) cw[j] = *(const f32x4*)(conv_w + j * D + cch);
    const f32x4 cb = *(const f32x4*)(conv_b + cch);
    for (int tile = slot; tile < T / 64; tile += nslots) {
        const int t0 = tile * 64;
#pragma unroll
        for (int k = 0; k < 4; ++k) {
            const int tl = (tid >> 5) + 16 * k, t = t0 + tl, s_ = t & (SEQ - 1);
            f32x4 acc = cb;
#pragma unroll
            for (int j = 0; j < 4; ++j) {
                if (s_ - 3 + j >= 0) {
                    const u32x2 rv = *(const u32x2*)(u + (size_t)(t - 3 + j) * 2048 + 1024 + cch);
                    acc[0] += cw[j][0] * __uint_as_float(rv.x << 16); acc[1] += cw[j][1] * __uint_as_float(rv.x & 0xffff0000u);
                    acc[2] += cw[j][2] * __uint_as_float(rv.y << 16); acc[3] += cw[j][3] * __uint_as_float(rv.y & 0xffff0000u);
                }
            }
            *(LAS f32x4*)(xcf + tl * 132 + cc) = acc;
            u32x2 w; w.x = pack2(acc[0], acc[1]); w.y = pack2(acc[2], acc[3]);
            *(LAS u32x2*)(xcb + tl * 136 + cc) = w;
        }
        __syncthreads();
        f32x4 ar[4], ai[4];
#pragma unroll
        for (int mt = 0; mt < 4; ++mt) { ar[mt] = (f32x4){0.f, 0.f, 0.f, 0.f}; ai[mt] = (f32x4){0.f, 0.f, 0.f, 0.f}; }
#pragma unroll
        for (int ks = 0; ks < 4; ++ks)
#pragma unroll
            for (int mt = 0; mt < 4; ++mt) {
                const bf16x8 af = *(const LAS bf16x8*)(xcb + (mt * 16 + fr) * 136 + 32 * ks + 8 * fq);
                ar[mt] = __builtin_amdgcn_mfma_f32_16x16x32_bf16(Br[ks], af, ar[mt], 0, 0, 0);
                ai[mt] = __builtin_amdgcn_mfma_f32_16x16x32_bf16(Bi[ks], af, ai[mt], 0, 0, 0);
            }
#pragma unroll
        for (int mt = 0; mt < 4; ++mt) {
            const int tl = mt * 16 + fr, cl = 16 * wid + 4 * fq;
            const f32x4 rec = *(const LAS f32x4*)(xcf + tl * 132 + cl);
            f32x4 av, bv, cv;
#pragma unroll
            for (int r = 0; r < 4; ++r) {
                const float rg = sigmoidf_(ar[mt][r] + brv[r]), ig = sigmoidf_(ai[mt][r] + biv[r]);
                const float log_a = -8.0f * rg * spv[r];
                const float cc_ = bf2f(f2bf(-expm1f(log_a)));
                av[r] = 1.0f - cc_; cv[r] = cc_;
                bv[r] = bf2f(f2bf(sqrtf(fmaxf(-expm1f(2.0f * log_a), 0.f)) * ig * rec[r]));
            }
            { u32x2 wc_, wb_; wc_.x = pack2(cv[0], cv[1]); wc_.y = pack2(cv[2], cv[3]); wb_.x = pack2(bv[0], bv[1]); wb_.y = pack2(bv[2], bv[3]);
              *(u32x2*)(Carr + (size_t)(t0 + tl) * D + cg) = wc_; *(u32x2*)(Barr + (size_t)(t0 + tl) * D + cg) = wb_; }
            *(LAS f32x4*)(sa + tl * 132 + cl) = av; *(LAS f32x4*)(sb + tl * 132 + cl) = bv;
        }
        __syncthreads();
        {
            const int j = tid & 127, q = tid >> 7;
            float P = 1.f, H = 0.f;
#pragma unroll
            for (int s_ = 0; s_ < 16; ++s_) { const float a = sa[(q * 16 + s_) * 132 + j], bb = sb[(q * 16 + s_) * 132 + j]; H = a * H + bb; P *= a; }
            comb[(q * 128 + j) * 2 + 0] = P; comb[(q * 128 + j) * 2 + 1] = H;
        }
        __syncthreads();
        if (tid < 128) {
            float P = comb[tid * 2], H = comb[tid * 2 + 1];
#pragma unroll
            for (int q = 1; q < 4; ++q) { const float Pq = comb[(q * 128 + tid) * 2], Hq = comb[(q * 128 + tid) * 2 + 1]; H = Pq * H + Hq; P *= Pq; }
            SP[(size_t)tile * D + hd * 128 + tid] = P; SH[(size_t)tile * D + hd * 128 + tid] = H;
        }
    }
}
__device__ __forceinline__ void lru_scan_phase(const Params& p) {
    const int tid = tid_();
    const bf16_t* u = (const bf16_t*)(p.ws + WS_U);
    const bf16_t* Carr = (const bf16_t*)(p.ws + WS_SCR); const bf16_t* Barr = Carr + (size_t)T * D;
    const float* SP = (const float*)(p.ws + WS_LSUM); const float* SH = SP + NBATCH * 32 * D;
    bf16_t* yin = (bf16_t*)(p.ws + WS_YIN);
    const int nunits = NBATCH * 32 * 2;
    for (int un = blockIdx.x; un < nunits; un += gridDim.x) {
        const int tile = un >> 1, c = (un & 1) * 512 + tid, b = tile >> 5, chunk = tile & 31;
        float h = 0.f;
        for (int k = 0; k < chunk; ++k) h = SP[(size_t)(b * 32 + k) * D + c] * h + SH[(size_t)(b * 32 + k) * D + c];
        const size_t tb = (size_t)tile * 64;
#pragma unroll 16
        for (int s_ = 0; s_ < 64; ++s_) {
            const size_t t = tb + s_;
            h = (1.0f - bf2f(Carr[t * D + c])) * h + bf2f(Barr[t * D + c]);
            yin[t * D + c] = f2bf(gelu_fast(bf2f(u[t * 2048 + c])) * h);
        }
    }
}

typedef short s16x4 __attribute__((ext_vector_type(4)));
__device__ __forceinline__ s16x4 tr4(LAS const unsigned char* base, int row0, int col0, int stride, int lane) {
    const int q = (lane & 15) >> 2, pp = lane & 3;
    return __builtin_amdgcn_ds_read_tr16_b64_v4i16((LAS s16x4*)(base + (row0 + q) * stride + (col0 + 4 * pp) * 2));
}
__device__ __forceinline__ bf16x8 cat8(s16x4 a, s16x4 b) { return (bf16x8){a[0], a[1], a[2], a[3], b[0], b[1], b[2], b[3]}; }
__device__ __forceinline__ void ret_core_phase(LAS unsigned char* lds, const Params& p) {
    const int tid0_ = tid_(); const int tid = tid0_, lane = tid & 63, wid = tid >> 6, fr = lane & 15, fq = lane >> 4;
    constexpr int KS = 528, VS = 160, SS = 528;
    LAS unsigned char* Kl = lds;
    LAS unsigned char* Vl = lds + 128 * KS;
    LAS unsigned char* Sl = Vl + 128 * VS;
    const bf16_t* ul_ = (const bf16_t*)(p.ws + WS_U);
    bf16_t* RO = (bf16_t*)(p.ws + WS_SCR);
    for (int un = blockIdx.x; un < NBATCH * 4 * 8; un += gridDim.x) {
        const int b = un >> 5, h = (un >> 3) & 3, vs = un & 7;
        const float lg2 = log2f(1.0f - exp2f(-5.0f - (float)h));
        f32x4 Sacc[2][4];
#pragma unroll
        for (int dt = 0; dt < 2; ++dt)
#pragma unroll
            for (int vt = 0; vt < 4; ++vt) Sacc[dt][vt] = (f32x4){0.f, 0.f, 0.f, 0.f};
        for (int i = tid; i < 64 * SS / 16; i += NTHREADS) ((LAS u32x4*)Sl)[i] = (u32x4){0u, 0u, 0u, 0u};
        u32x4 kraw[8], vraw[2]; bf16x8 Qf[8];
#define RET_LOAD(ch_) do { const size_t tl_ = (size_t)b * SEQ + (ch_) * 128; const bf16_t* u = ul_; int tid = tid0_; asm volatile("" : "+s"(u), "+v"(tid));     \
            _Pragma("unroll") for (int i = 0; i < 8; ++i) { const int piece = tid + NTHREADS * i, m = piece >> 5, ch = piece & 31; kraw[i] = *(const u32x4*)(u + (tl_ + m) * 6144 + 1024 + h * 256 + ch * 8); } \
            _Pragma("unroll") for (int i = 0; i < 2; ++i) { const int piece = tid + NTHREADS * i, m = piece >> 3, ch = piece & 7; vraw[i] = *(const u32x4*)(u + (tl_ + m) * 6144 + 2048 + h * 512 + vs * 64 + ch * 8); } } while (0)
#define RET_LOADQ(ch_) do { const size_t tl_ = (size_t)b * SEQ + (ch_) * 128; const bf16_t* u = ul_; int tid = tid0_; asm volatile("" : "+s"(u), "+v"(tid)); const int wid = tid >> 6, fr = tid & 15, fq = (tid & 63) >> 4; \
            _Pragma("unroll") for (int ks = 0; ks < 8; ++ks) Qf[ks] = *(const bf16x8*)(u + (tl_ + 16 * wid + fr) * 6144 + h * 256 + 32 * ks + 8 * fq); } while (0)
        RET_LOAD(0); RET_LOADQ(0);
        for (int chunk = 0; chunk < 16; ++chunk) {
            const size_t t0 = (size_t)b * SEQ + chunk * 128;
            int tst = tid0_; asm volatile("" : "+v"(tst));
#pragma unroll
            for (int i = 0; i < 8; ++i) {
                const int piece = tst + NTHREADS * i, m = piece >> 5, ch = piece & 31;
                const u32x4 kv = kraw[i];
                const float sc = exp2f(-(float)(m + 1) * lg2) * 0.0625f;
                u32x4 w;
                w.x = pack2(__uint_as_float(kv.x << 16) * sc, __uint_as_float(kv.x & 0xffff0000u) * sc); w.y = pack2(__uint_as_float(kv.y << 16) * sc, __uint_as_float(kv.y & 0xffff0000u) * sc);
                w.z = pack2(__uint_as_float(kv.z << 16) * sc, __uint_as_float(kv.z & 0xffff0000u) * sc); w.w = pack2(__uint_as_float(kv.w << 16) * sc, __uint_as_float(kv.w & 0xffff0000u) * sc);
                *(LAS u32x4*)(Kl + m * KS + ch * 16) = w;
            }
#pragma unroll
            for (int i = 0; i < 2; ++i) {
                const int piece = tst + NTHREADS * i, m = piece >> 3, ch = piece & 7;
                *(LAS u32x4*)(Vl + m * VS + ch * 16) = vraw[i];
            }
            __syncthreads();
            if (chunk + 1 < 16) RET_LOAD(chunk + 1);
            f32x4 sc[8];
#pragma unroll
            for (int mt = 0; mt < 8; ++mt) {
                sc[mt] = (f32x4){0.f, 0.f, 0.f, 0.f};
#pragma unroll
                for (int ks = 0; ks < 8; ++ks) {
                    const bf16x8 kf = *(const LAS bf16x8*)(Kl + (16 * mt + fr) * KS + (32 * ks + 8 * fq) * 2);
                    sc[mt] = __builtin_amdgcn_mfma_f32_16x16x32_bf16(kf, Qf[ks], sc[mt], 0, 0, 0);
                }
                if (mt & 1) __builtin_amdgcn_sched_barrier(0);
            }
            bf16x8 pf[4];
            const int nloc = 16 * wid + fr;
#pragma unroll
            for (int ks2 = 0; ks2 < 4; ++ks2) {
                float v[8];
#pragma unroll
                for (int t = 0; t < 2; ++t)
#pragma unroll
                    for (int r = 0; r < 4; ++r) { const int m = 32 * ks2 + 16 * t + 4 * fq + r; v[4 * t + r] = (m <= nloc) ? sc[2 * ks2 + t][r] : 0.f; }
                u32x4 w; w.x = pack2(v[0], v[1]); w.y = pack2(v[2], v[3]); w.z = pack2(v[4], v[5]); w.w = pack2(v[6], v[7]);
                pf[ks2] = __builtin_bit_cast(bf16x8, w);
            }
            f32x4 O[4];
#pragma unroll
            for (int vt = 0; vt < 4; ++vt) {
                O[vt] = (f32x4){0.f, 0.f, 0.f, 0.f};
#pragma unroll
                for (int ks2 = 0; ks2 < 4; ++ks2) {
                    const bf16x8 vf = cat8(tr4(Vl, 32 * ks2 + 4 * fq, 16 * vt, VS, lane), tr4(Vl, 32 * ks2 + 16 + 4 * fq, 16 * vt, VS, lane));
                    O[vt] = __builtin_amdgcn_mfma_f32_16x16x32_bf16(pf[ks2], vf, O[vt], 0, 0, 0);
                }
#pragma unroll
                for (int ks = 0; ks < 8; ++ks) {
                    const bf16x8 sf = *(const LAS bf16x8*)(Sl + (16 * vt + fr) * SS + (32 * ks + 8 * fq) * 2);
                    O[vt] = __builtin_amdgcn_mfma_f32_16x16x32_bf16(Qf[ks], sf, O[vt], 0, 0, 0);
                }
                __builtin_amdgcn_sched_barrier(0);
            }
#pragma unroll
            for (int r = 0; r < 4; ++r) {
                const int n = 16 * wid + 4 * fq + r;
                const float qd = exp2f((float)(n + 1) * lg2);
                bf16_t* op = RO + (t0 + n) * 2048 + h * 512 + vs * 64 + fr;
#pragma unroll
                for (int vt = 0; vt < 4; ++vt) op[16 * vt] = f2bf(O[vt][r] * qd);
            }
            if (chunk + 1 < 16) RET_LOADQ(chunk + 1);
#pragma unroll
            for (int ks3 = 0; ks3 < 4; ++ks3) {
                bf16x8 kt[2], vf[4];
#pragma unroll
                for (int dt = 0; dt < 2; ++dt) kt[dt] = cat8(tr4(Kl, 32 * ks3 + 8 * fq, 32 * wid + 16 * dt, KS, lane), tr4(Kl, 32 * ks3 + 8 * fq + 4, 32 * wid + 16 * dt, KS, lane));
#pragma unroll
                for (int vt = 0; vt < 4; ++vt) vf[vt] = cat8(tr4(Vl, 32 * ks3 + 8 * fq, 16 * vt, VS, lane), tr4(Vl, 32 * ks3 + 8 * fq + 4, 16 * vt, VS, lane));
#pragma unroll
                for (int dt = 0; dt < 2; ++dt)
#pragma unroll
                    for (int vt = 0; vt < 4; ++vt) Sacc[dt][vt] = __builtin_amdgcn_mfma_f32_16x16x32_bf16(kt[dt], vf[vt], Sacc[dt][vt], 0, 0, 0);
                __builtin_amdgcn_sched_barrier(0);
            }
            __syncthreads();
            const float cd = exp2f(128.0f * lg2);
#pragma unroll
            for (int dt = 0; dt < 2; ++dt)
#pragma unroll
                for (int vt = 0; vt < 4; ++vt) {
                    Sacc[dt][vt] *= cd;
                    u32x2 w; w.x = pack2(Sacc[dt][vt][0], Sacc[dt][vt][1]); w.y = pack2(Sacc[dt][vt][2], Sacc[dt][vt][3]);
                    *(LAS u32x2*)(Sl + (16 * vt + fr) * SS + (32 * wid + 16 * dt + 4 * fq) * 2) = w;
                }
        }
        __syncthreads();
#undef RET_LOAD
#undef RET_LOADQ
    }
}
__device__ __forceinline__ void ret_norm_phase(LAS unsigned char* lds, const Params& p) {
    const int tid = tid_(), lane = tid & 63, wid = tid >> 6;
    LAS float* red = (LAS float*)lds;
    const bf16_t* u = (const bf16_t*)(p.ws + WS_U);
    const bf16_t* RO = (const bf16_t*)(p.ws + WS_SCR);
    bf16_t* yin = (bf16_t*)(p.ws + WS_YIN);
    for (int t = blockIdx.x; t < T; t += gridDim.x) {
        const u32x2 ov = *(const u32x2*)(RO + (size_t)t * 2048 + tid * 4);
        const f32x4 o = (f32x4){__uint_as_float(ov.x << 16), __uint_as_float(ov.x & 0xffff0000u), __uint_as_float(ov.y << 16), __uint_as_float(ov.y & 0xffff0000u)};
        const float ss = wave_sum(o[0] * o[0] + o[1] * o[1] + o[2] * o[2] + o[3] * o[3]);
        if (lane == 0) red[wid] = ss;
        __syncthreads();
        const float tot = red[(wid & ~1)] + red[(wid | 1)];
        const float rstd = rsqrtf(tot * (1.0f / 512.0f) + 1e-6f);
        const u32x2 gv = *(const u32x2*)(u + (size_t)t * 6144 + 4096 + tid * 4);
        const float g0 = __uint_as_float(gv.x << 16), g1 = __uint_as_float(gv.x & 0xffff0000u), g2 = __uint_as_float(gv.y << 16), g3 = __uint_as_float(gv.y & 0xffff0000u);
        u32x2 w; w.x = pack2(g0 * sigmoidf_(g0) * o[0] * rstd, g1 * sigmoidf_(g1) * o[1] * rstd); w.y = pack2(g2 * sigmoidf_(g2) * o[2] * rstd, g3 * sigmoidf_(g3) * o[3] * rstd);
        *(u32x2*)(yin + (size_t)t * 2048 + tid * 4) = w;
        __syncthreads();
    }
}

__device__ __forceinline__ void attn_core_phase(LAS unsigned char* lds, const Params& p) {
    const int tid0_ = tid_(); const int tid = tid0_, lane = tid & 63, wid = tid >> 6, fr = lane & 15, fq = lane >> 4;
    constexpr int RS = 144, TILE = 272 * RS;
    LAS unsigned char* Kl = lds;
    LAS unsigned char* Vl = lds + TILE;
    const bf16_t* u = (const bf16_t*)(p.ws + WS_U);
    bf16_t* OP = (bf16_t*)(p.ws + WS_SCR);
    float* LSE = (float*)(p.ws + WS_SCR + 96 * MB);
    for (int i = tid; i < 16 * RS / 16; i += NTHREADS) { ((LAS u32x4*)(Kl + 256 * RS))[i] = (u32x4){0u, 0u, 0u, 0u}; ((LAS u32x4*)(Vl + 256 * RS))[i] = (u32x4){0u, 0u, 0u, 0u}; }
    u32x4 kraw[4], vraw[4]; bf16x8 Qn[2];
#define ATT_DECODE(un_) const int g = (un_) >> 11, rem = (un_) & 2047, b = rem >> 8, h = (rem >> 4) & 15, x = rem & 15; \
        const int dl = (g == 0) ? 1 : (g == 1 ? 4 : 16), r_ = x & (dl - 1), n = x / dl
#define ATT_LOAD(un_) do { ATT_DECODE(un_); int tl_ = tid0_; const bf16_t* ub = u; asm volatile("" : "+v"(tl_), "+s"(ub)); ub += (size_t)b * SEQ * 9216; \
        _Pragma("unroll") for (int i = 0; i < 4; ++i) { const int piece = tl_ + NTHREADS * i, row = piece >> 3, ch = piece & 7; const int sk = ((n - 1) * 128 + row) * dl + r_; \
            kraw[i] = (u32x4){0u, 0u, 0u, 0u}; vraw[i] = (u32x4){0u, 0u, 0u, 0u}; \
            if (sk >= 0) { const bf16_t* src = ub + (size_t)sk * 9216 + h * 64 + ch * 8; kraw[i] = *(const u32x4*)(src + (3 + g) * 1024); vraw[i] = *(const u32x4*)(src + (6 + g) * 1024); } } \
        { const int sq_ = (n * 128 + 16 * (tl_ >> 6) + (tl_ & 15)) * dl + r_; \
          _Pragma("unroll") for (int ks = 0; ks < 2; ++ks) Qn[ks] = *(const bf16x8*)(ub + (size_t)sq_ * 9216 + g * 1024 + h * 64 + 32 * ks + 8 * ((tl_ & 63) >> 4)); } } while (0)
    if ((int)blockIdx.x < 3 * 2048) ATT_LOAD((int)blockIdx.x);
    for (int un = blockIdx.x; un < 3 * 2048; un += gridDim.x) {
        ATT_DECODE(un);
        const float slope = exp2f(-0.5f * (float)(h + 1)) * (float)dl;
        { int tl_ = tid0_; asm volatile("" : "+v"(tl_));
#pragma unroll
          for (int i = 0; i < 4; ++i) {
            const int piece = tl_ + NTHREADS * i, row = piece >> 3, ch = piece & 7;
            *(LAS u32x4*)(Kl + row * RS + ch * 16) = kraw[i]; *(LAS u32x4*)(Vl + row * RS + ch * 16) = vraw[i];
          } }
        const int qi = 16 * wid + fr, sq = (n * 128 + qi) * dl + r_;
        bf16x8 Qf[2];
#pragma unroll
        for (int ks = 0; ks < 2; ++ks) Qf[ks] = Qn[ks];
        __syncthreads();
        if (un + (int)gridDim.x < 3 * 2048) ATT_LOAD(un + (int)gridDim.x);
        f32x4 sc[9];
        float mx = -INFINITY;
#pragma unroll
        for (int kt = 0; kt < 9; ++kt) {
            sc[kt] = (f32x4){0.f, 0.f, 0.f, 0.f};
#pragma unroll
            for (int ks = 0; ks < 2; ++ks) {
                const bf16x8 kf = *(const LAS bf16x8*)(Kl + (16 * (wid + kt) + fr) * RS + (32 * ks + 8 * fq) * 2);
                sc[kt] = __builtin_amdgcn_mfma_f32_16x16x32_bf16(kf, Qf[ks], sc[kt], 0, 0, 0);
            }
#pragma unroll
            for (int r = 0; r < 4; ++r) {
                const int ki = 16 * (wid + kt) + 4 * fq + r, steps = qi + 128 - ki;
                const bool ok = (steps >= 0) && (steps <= 128) && (n > 0 || ki >= 128);
                const float v = ok ? sc[kt][r] * 0.125f - slope * (float)steps : -INFINITY;
                sc[kt][r] = v; mx = fmaxf(mx, v);
            }
        }
        mx = fmaxf(mx, __shfl_xor(mx, 16)); mx = fmaxf(mx, __shfl_xor(mx, 32));
        float l = 0.f;
#pragma unroll
        for (int kt = 0; kt < 9; ++kt)
#pragma unroll
            for (int r = 0; r < 4; ++r) { const float pv = __expf(sc[kt][r] - mx); sc[kt][r] = pv; l += pv; }
        l += __shfl_xor(l, 16); l += __shfl_xor(l, 32);
        f32x4 O[4];
#pragma unroll
        for (int dt = 0; dt < 4; ++dt) O[dt] = (f32x4){0.f, 0.f, 0.f, 0.f};
#pragma unroll
        for (int ks5 = 0; ks5 < 5; ++ks5) {
            const f32x4 p0 = sc[2 * ks5], p1 = (ks5 < 4) ? sc[(ks5 < 4) ? 2 * ks5 + 1 : 0] : (f32x4){0.f, 0.f, 0.f, 0.f};
            u32x4 w; w.x = pack2(p0[0], p0[1]); w.y = pack2(p0[2], p0[3]); w.z = pack2(p1[0], p1[1]); w.w = pack2(p1[2], p1[3]);
            const bf16x8 pf = __builtin_bit_cast(bf16x8, w);
#pragma unroll
            for (int dt = 0; dt < 4; ++dt) {
                const bf16x8 vf = cat8(tr4(Vl, 16 * (wid + 2 * ks5) + 4 * fq, 16 * dt, RS, lane), tr4(Vl, 16 * (wid + 2 * ks5 + 1) + 4 * fq, 16 * dt, RS, lane));
                O[dt] = __builtin_amdgcn_mfma_f32_16x16x32_bf16(vf, pf, O[dt], 0, 0, 0);
            }
        }
        const float inv = 1.0f / l;
        const size_t tq = (size_t)b * SEQ + sq;
#pragma unroll
        for (int dt = 0; dt < 4; ++dt) {
            u32x2 w; w.x = pack2(O[dt][0] * inv, O[dt][1] * inv); w.y = pack2(O[dt][2] * inv, O[dt][3] * inv);
            *(u32x2*)(OP + ((size_t)g * T + tq) * D + h * 64 + 16 * dt + 4 * fq) = w;
        }
        if (fq == 0) LSE[((size_t)g * T + tq) * 16 + h] = mx + __logf(l);
        __syncthreads();
    }
#undef ATT_DECODE
#undef ATT_LOAD
}
__device__ __forceinline__ void attn_merge_phase(const Params& p) {
    const int tid = tid_();
    const bf16_t* OP = (const bf16_t*)(p.ws + WS_SCR);
    const float* LSE = (const float*)(p.ws + WS_SCR + 96 * MB);
    bf16_t* yin = (bf16_t*)(p.ws + WS_YIN);
    for (size_t i = (size_t)blockIdx.x * NTHREADS + tid; i < (size_t)T * D / 8; i += (size_t)gridDim.x * NTHREADS) {
        const size_t t = i >> 7; const int c8 = (int)(i & 127), h = c8 >> 3;
        const float l0 = LSE[t * 16 + h], l1 = LSE[((size_t)T + t) * 16 + h], l2 = LSE[((size_t)2 * T + t) * 16 + h];
        const float m = fmaxf(l0, fmaxf(l1, l2));
        float w0 = __expf(l0 - m), w1 = __expf(l1 - m), w2 = __expf(l2 - m);
        const float inv = 1.0f / (w0 + w1 + w2); w0 *= inv; w1 *= inv; w2 *= inv;
        const u32x4 a = *(const u32x4*)(OP + t * D + c8 * 8), bq = *(const u32x4*)(OP + ((size_t)T + t) * D + c8 * 8), c = *(const u32x4*)(OP + ((size_t)2 * T + t) * D + c8 * 8);
        u32x4 o;
#define MRG(f) o.f = pack2(w0 * __uint_as_float(a.f << 16) + w1 * __uint_as_float(bq.f << 16) + w2 * __uint_as_float(c.f << 16), \
                           w0 * __uint_as_float(a.f & 0xffff0000u) + w1 * __uint_as_float(bq.f & 0xffff0000u) + w2 * __uint_as_float(c.f & 0xffff0000u))
        MRG(x); MRG(y); MRG(z); MRG(w);
#undef MRG
        *(u32x4*)(yin + t * D + c8 * 8) = o;
    }
}

__device__ __forceinline__ void ln1_router_phase(LAS unsigned char* lds, const Params& p, int layer) {
    const int tid = tid_(), lane = tid & 63, wid = tid >> 6, fr = lane & 15, fq = lane >> 4;
    constexpr int XS = 2064;
    LAS unsigned char* xh = lds;
    LAS unsigned char* xl = lds + 16 * XS;
    LAS float* part = (LAS float*)(lds + 32 * XS);
    LAS float* logit = part + 8 * 16 * 32;
    LAS int* tkE = (LAS int*)(logit + 16 * 32);
    LAS int* tkR = tkE + 512;
    LAS int* hist = tkR + 512;
    LAS int* hbase = hist + 32;
    float* xf = (float*)(p.ws + WS_XF); bf16_t* xb = (bf16_t*)(p.ws + WS_XB);
    const bf16_t* ymix = (const bf16_t*)(p.ws + WS_YMIX);
    int* tope = (int*)(p.ws + WS_TOPE); float* gates = (float*)(p.ws + WS_GATES); int* pos = (int*)(p.ws + WS_POS);
    unsigned char* xq = p.ws + WS_XQ; int* elist = (int*)(p.ws + WS_LIST);
    unsigned* ctl = (unsigned*)(p.ws + WS_CTL);
    const float* gain = p.ln_gain + (size_t)(layer * 2) * D; const float* bias = p.ln_bias + (size_t)(layer * 2) * D;
    const float* brt = p.moe_b_router + (size_t)layer * NEXP;
    const bf16_t* rth = (const bf16_t*)(p.ws + WS_RT) + (size_t)layer * 2 * NEXP * D; const bf16_t* rtl = rth + NEXP * D;
    bf16x8 Wh[2][4], Wl[2][4];
#pragma unroll
    for (int nt = 0; nt < 2; ++nt)
#pragma unroll
        for (int ks = 0; ks < 4; ++ks) { const size_t o = (size_t)(16 * nt + fr) * D + 128 * wid + 32 * ks + 8 * fq; Wh[nt][ks] = *(const bf16x8*)(rth + o); Wl[nt][ks] = *(const bf16x8*)(rtl + o); }
    if (tid < NEXP) hist[tid] = 0;
    int it = 0;
    for (int tile = blockIdx.x; tile < T / 16; tile += gridDim.x) {
#pragma unroll
        for (int tt = 0; tt < 2; ++tt) {
            const int trow = 2 * wid + tt; const size_t t = (size_t)tile * 16 + trow;
            f32x4 z[4];
#pragma unroll
            for (int i = 0; i < 4; ++i) { const int c = 256 * i + 4 * lane; const u32x2 yv = *(const u32x2*)(ymix + t * D + c);
                z[i] = DN_ALPHA * *(const f32x4*)(xf + t * D + c) + (f32x4){__uint_as_float(yv.x << 16), __uint_as_float(yv.x & 0xffff0000u), __uint_as_float(yv.y << 16), __uint_as_float(yv.y & 0xffff0000u)}; }
            float sm = 0.f;
#pragma unroll
            for (int i = 0; i < 4; ++i) sm += (z[i][0] + z[i][1]) + (z[i][2] + z[i][3]);
            const float mean = wave_sum(sm) * (1.0f / D);
            float sq = 0.f;
#pragma unroll
            for (int i = 0; i < 4; ++i) { const f32x4 dd = z[i] - mean; sq += (dd[0] * dd[0] + dd[1] * dd[1]) + (dd[2] * dd[2] + dd[3] * dd[3]); }
            const float rstd = rsqrtf(wave_sum(sq) * (1.0f / D) + LN_EPS);
#pragma unroll
            for (int i = 0; i < 4; ++i) {
                const int c = 256 * i + 4 * lane;
                const f32x4 v = (z[i] - mean) * rstd * *(const f32x4*)(gain + c) + *(const f32x4*)(bias + c);
                *(f32x4*)(xf + t * D + c) = v;
                u32x2 wh; wh.x = pack2(v[0], v[1]); wh.y = pack2(v[2], v[3]);
                *(unsigned*)(xq + t * D + c) = pk_fp8x4(v[0], v[1], v[2], v[3]);
                const float r0 = v[0] - __uint_as_float(wh.x << 16), r1 = v[1] - __uint_as_float(wh.x & 0xffff0000u), r2 = v[2] - __uint_as_float(wh.y << 16), r3 = v[3] - __uint_as_float(wh.y & 0xffff0000u);
                u32x2 wl; wl.x = pack2(r0, r1); wl.y = pack2(r2, r3);
                *(LAS u32x2*)(xh + trow * XS + c * 2) = wh; *(LAS u32x2*)(xl + trow * XS + c * 2) = wl;
            }
        }
        __syncthreads();
        {
            f32x4 acc[2] = {(f32x4){0.f, 0.f, 0.f, 0.f}, (f32x4){0.f, 0.f, 0.f, 0.f}};
#pragma unroll
            for (int ks = 0; ks < 4; ++ks) {
                const bf16x8 ah = *(const LAS bf16x8*)(xh + fr * XS + (128 * wid + 32 * ks + 8 * fq) * 2), al = *(const LAS bf16x8*)(xl + fr * XS + (128 * wid + 32 * ks + 8 * fq) * 2);
#pragma unroll
                for (int nt = 0; nt < 2; ++nt) {
                    acc[nt] = __builtin_amdgcn_mfma_f32_16x16x32_bf16(Wh[nt][ks], ah, acc[nt], 0, 0, 0);
                    acc[nt] = __builtin_amdgcn_mfma_f32_16x16x32_bf16(Wh[nt][ks], al, acc[nt], 0, 0, 0);
                    acc[nt] = __builtin_amdgcn_mfma_f32_16x16x32_bf16(Wl[nt][ks], ah, acc[nt], 0, 0, 0);
                }
            }
#pragma unroll
            for (int nt = 0; nt < 2; ++nt) *(LAS f32x4*)(part + (wid * 16 + fr) * 32 + 16 * nt + 4 * fq) = acc[nt];
        }
        __syncthreads();
        {
            const int tk = tid >> 5, e = tid & 31;
            float sacc = brt[e];
#pragma unroll
            for (int w = 0; w < 8; ++w) sacc += part[(w * 16 + tk) * 32 + e];
            logit[tk * 32 + e] = sacc;
        }
        __syncthreads();
        if (tid < 16) {
            const size_t t = (size_t)tile * 16 + tid;
            float v0 = -INFINITY, v1 = -INFINITY, v2 = -INFINITY, v3 = -INFINITY; int i0 = 0, i1 = 0, i2 = 0, i3 = 0;
#pragma unroll
            for (int e = 0; e < NEXP; ++e) {
                const float v = logit[tid * 32 + e];
                if (v > v3) {
                    if (v > v0) { v3 = v2; i3 = i2; v2 = v1; i2 = i1; v1 = v0; i1 = i0; v0 = v; i0 = e; }
                    else if (v > v1) { v3 = v2; i3 = i2; v2 = v1; i2 = i1; v1 = v; i1 = e; }
                    else if (v > v2) { v3 = v2; i3 = i2; v2 = v; i2 = e; }
                    else { v3 = v; i3 = e; }
                }
            }
            const float e1 = __expf(v1 - v0), e2 = __expf(v2 - v0), e3 = __expf(v3 - v0), inv = 1.0f / (1.0f + e1 + e2 + e3);
            tope[t * 4 + 0] = i0; tope[t * 4 + 1] = i1; tope[t * 4 + 2] = i2; tope[t * 4 + 3] = i3;
            gates[t * 4 + 0] = inv; gates[t * 4 + 1] = e1 * inv; gates[t * 4 + 2] = e2 * inv; gates[t * 4 + 3] = e3 * inv;
            const int sl = (it & 7) * 16 + tid;
            tkE[sl * 4 + 0] = i0; tkR[sl * 4 + 0] = (int)atomicAdd((unsigned*)(hist + i0), 1u);
            tkE[sl * 4 + 1] = i1; tkR[sl * 4 + 1] = (int)atomicAdd((unsigned*)(hist + i1), 1u);
            tkE[sl * 4 + 2] = i2; tkR[sl * 4 + 2] = (int)atomicAdd((unsigned*)(hist + i2), 1u);
            tkE[sl * 4 + 3] = i3; tkR[sl * 4 + 3] = (int)atomicAdd((unsigned*)(hist + i3), 1u);
        }
        ++it;
        if ((it & 7) == 0 || tile + (int)gridDim.x >= T / 16) {
            __syncthreads();
            if (tid < NEXP) { const unsigned h = (unsigned)hist[tid]; hbase[tid] = h ? (int)atomicAdd(ctl + CW_CNT + layer * 64 + tid, h) : 0; hist[tid] = 0; }
            __syncthreads();
            const int nsl = (((it - 1) & 7) + 1) * 16;
            for (int a = tid; a < nsl * 4; a += NTHREADS) {
                const int sl = a >> 2, e = tkE[a], ps = hbase[e] + tkR[a];
                const int t = (tile - (((it - 1) & 7) - (sl >> 4)) * (int)gridDim.x) * 16 + (sl & 15);
                pos[t * 4 + (a & 3)] = ps; elist[(size_t)e * T + ps] = t;
            }
            __syncthreads();
        }
    }
    __syncthreads();
}
__device__ __forceinline__ void ln2_phase(LAS unsigned char* lds, const Params& p, int layer) {
    const int tid = tid_(), lane = tid & 63, wid = tid >> 6;
    moe_tables(lds, (const unsigned*)(p.ws + WS_CTL), layer);
    LAS const int* tab = (LAS const int*)(lds + TAB_OFF);
    const int* tope = (const int*)(p.ws + WS_TOPE); const int* pos = (const int*)(p.ws + WS_POS);
    float* xf = (float*)(p.ws + WS_XF); bf16_t* xb = (bf16_t*)(p.ws + WS_XB);
    const bf16_t* yrows = (const bf16_t*)(p.ws + WS_YROWS);
    const float* gates = (const float*)(p.ws + WS_GATES);
    const float* gain = p.ln_gain + (size_t)(layer * 2 + 1) * D; const float* bias = p.ln_bias + (size_t)(layer * 2 + 1) * D;
    for (int t = blockIdx.x * 8 + wid; t < T; t += gridDim.x * 8) {
        f32x4 z[4];
        int dk[4]; float gk[4];
#pragma unroll
        for (int k = 0; k < 4; ++k) { dk[k] = tab[tope[t * 4 + k]] * 256 + pos[t * 4 + k]; gk[k] = gates[t * 4 + k]; }
#pragma unroll
        for (int i = 0; i < 4; ++i) {
            const int c = 256 * i + 4 * lane;
            f32x4 f = (f32x4){0.f, 0.f, 0.f, 0.f};
#pragma unroll
            for (int k = 0; k < 4; ++k) { const u32x2 yv = *(const u32x2*)(yrows + (size_t)dk[k] * D + c);
                f[0] += gk[k] * __uint_as_float(yv.x << 16); f[1] += gk[k] * __uint_as_float(yv.x & 0xffff0000u); f[2] += gk[k] * __uint_as_float(yv.y << 16); f[3] += gk[k] * __uint_as_float(yv.y & 0xffff0000u); }
            z[i] = DN_ALPHA * *(const f32x4*)(xf + (size_t)t * D + c) + f;
        }
        float sm = 0.f;
#pragma unroll
        for (int i = 0; i < 4; ++i) sm += (z[i][0] + z[i][1]) + (z[i][2] + z[i][3]);
        const float mean = wave_sum(sm) * (1.0f / D);
        float sq = 0.f;
#pragma unroll
        for (int i = 0; i < 4; ++i) { const f32x4 dd = z[i] - mean; sq += (dd[0] * dd[0] + dd[1] * dd[1]) + (dd[2] * dd[2] + dd[3] * dd[3]); }
        const float rstd = rsqrtf(wave_sum(sq) * (1.0f / D) + LN_EPS);
#pragma unroll
        for (int i = 0; i < 4; ++i) {
            const int c = 256 * i + 4 * lane;
            z[i] = (z[i] - mean) * rstd * *(const f32x4*)(gain + c) + *(const f32x4*)(bias + c);
            if (layer == DEPTH - 1) *(f32x4*)(p.out + (size_t)t * D + c) = z[i];
            else { *(f32x4*)(xf + (size_t)t * D + c) = z[i]; *(unsigned*)(p.ws + WS_XQ + (size_t)t * D + c) = pk_fp8x4(z[i][0], z[i][1], z[i][2], z[i][3]); }
        }
    }
}

__device__ __forceinline__ void moe_scatter_phase(LAS unsigned char* lds, const Params& p, int layer) {
    const int tid = tid_();
    LAS int* pstart = (LAS int*)lds;
    unsigned* ctl = (unsigned*)(p.ws + WS_CTL);
    const int* tope = (const int*)(p.ws + WS_TOPE); const int* pos = (const int*)(p.ws + WS_POS);
    int* dest = (int*)(p.ws + WS_DEST); int* rowtok = (int*)(p.ws + WS_ROWTOK);
    if (tid == 0) {
        int acc = 0;
        for (int e = 0; e < NEXP; ++e) { const int c = (int)ctl[CW_CNT + layer * 64 + e]; pstart[e] = acc; pstart[32 + e] = c; acc += ((c + 255) >> 8) << 8; }
        pstart[64] = acc;
        if (blockIdx.x == 0) {
            ctl[CW_MDYN + layer * 64] = (unsigned)acc;
            for (int e = 0; e < NEXP; ++e) { const int nb = (pstart[32 + e] + 255) >> 8; for (int b = 0; b < nb; ++b) ctl[CW_TEXP + layer * 512 + (pstart[e] >> 8) + b] = (unsigned)e; }
        }
    }
    __syncthreads();
    for (int i = blockIdx.x * NTHREADS + tid; i < T * TOPK; i += gridDim.x * NTHREADS) {
        const int e = tope[i], row = pstart[e] + pos[i];
        dest[i] = row; rowtok[row] = i >> 2;
    }
    for (int i = blockIdx.x * NTHREADS + tid; i < NEXP * 256; i += gridDim.x * NTHREADS) {
        const int e = i >> 8, r = i & 255, c = pstart[32 + e], padded = ((c + 255) >> 8) << 8;
        if (c + r < padded) rowtok[pstart[e] + c + r] = 0;
    }
    __syncthreads();
}

constexpr int PH_PER_LAYER = 9;
constexpr int NPHASES = 1 + DEPTH * PH_PER_LAYER;
constexpr int LDS_BYTES = 132 * 1024;


#ifndef PHMASK
#define PHMASK 0x3FF
#endif
#define PHK(j) ((PHMASK >> (j)) & 1)
#ifndef PROBE_MASK
#define PROBE_MASK 0
#endif
#ifndef PROBE_LAYERS
#define PROBE_LAYERS 0xF
#endif
#define REPS(j) ((((PROBE_MASK) >> (j)) & 1) ? 2 : 1)
#define REPSL(j) (((((PROBE_MASK) >> (j)) & 1) && (((PROBE_LAYERS) >> layer) & 1)) ? 2 : 1)
#define IN(k) (lo <= (k) && (k) < hi)
#if MK_ONE_LAUNCH
#define SEAM(k) do { if (IN(k) && IN((k) + 1)) xcd_barrier_nv(bar.bar, bar.x, bar.st); } while (0)
#else
#define SEAM(k) do {} while (0)
#endif
template <int layer>
__device__ __forceinline__ void run_layer(const Params& p, LAS unsigned char* lds, const XcdBarrier& bar) {
    const int lo = p.ph_lo, hi = p.ph_hi;
    unsigned char* ws = p.ws;
    unsigned* ctl = (unsigned*)(ws + WS_CTL);
        constexpr int base = 1 + layer * PH_PER_LAYER, kind = layer % 3, idx = layer / 3;
        for (int rep_ = 0; rep_ < REPSL(1); ++rep_) if (PHK(1) && IN(base + 0)) {
            constexpr int N = (kind == 0) ? 2048 : (kind == 1 ? 6144 : 9216);
            const unsigned char* Bt = (kind == 0) ? ws + WS_AWIN + (size_t)idx * 2048 * D : (kind == 1 ? ws + WS_BWIN : ws + WS_CWIN);
            g8::SchedPlain S; S.init(ws + WS_XQ, Bt, T, N, D / 2, (int)gridDim.x, (int)blockIdx.x);
            g8::EpiBf16 E{(bf16_t*)(ws + WS_U), N, nullptr, 0, 1.0f / GU_WSCALE};
            g8::gemm_phase<g8::EpiBf16, g8::SchedPlain, false, 1>(lds, D, S, E);
        }
        SEAM(base + 0);
        for (int rep_ = 0; rep_ < REPSL(2); ++rep_) if (PHK(2) && IN(base + 1)) {
            if (kind == 0) lru_gates_phase(lds, p, idx);
            else if (kind == 1) ret_core_phase(lds, p);
            else attn_core_phase(lds, p);
        }
        SEAM(base + 1);
        for (int rep_ = 0; rep_ < REPSL(3); ++rep_) if (PHK(3) && IN(base + 2)) {
            if (kind == 0) lru_scan_phase(p);
            else if (kind == 1) ret_norm_phase(lds, p);
            else attn_merge_phase(p);
        }
        SEAM(base + 2);
        for (int rep_ = 0; rep_ < REPSL(4); ++rep_) if (PHK(4) && IN(base + 3)) {
            constexpr int K = (kind == 1) ? 2048 : D;
            const bf16_t* Bt = (kind == 0) ? (const bf16_t*)(ws + WS_AWOUT) + (size_t)idx * D * D : (kind == 1 ? (const bf16_t*)(ws + WS_BWOUT) : (const bf16_t*)(ws + WS_CWOUT));
            g8::SchedPlain S; S.init(ws + WS_YIN, Bt, T, D, K, (int)gridDim.x, (int)blockIdx.x);
            g8::EpiBf16 E{(bf16_t*)(ws + WS_YMIX), D, nullptr, 0, 1.0f};
            g8::gemm_phase<g8::EpiBf16, g8::SchedPlain, false>(lds, K, S, E);
        }
        SEAM(base + 3);
        for (int rep_ = 0; rep_ < REPSL(5); ++rep_) if (PHK(5) && IN(base + 4)) ln1_router_phase(lds, p, layer);
        SEAM(base + 4);
        for (int rep_ = 0; rep_ < REPSL(7); ++rep_) if (PHK(7) && IN(base + 6)) {
            moe_tables(lds, ctl, layer);
            g8::SchedGU S{(const char*)(ws + WS_XQ), (const char*)(ws + WS_GU) + (size_t)layer * NEXP * 2048 * D, (const int*)(ws + WS_LIST), (LAS const int*)(lds + TAB_OFF), (int)gridDim.x, (int)blockIdx.x};
            g8::EpiSwiglu E{ws + WS_HID, p.moe_b_gu + (size_t)layer * NEXP * 2048, 1.0f / GU_WSCALE};
            g8::gemm_phase<g8::EpiSwiglu, g8::SchedGU, true, 1>(lds, D, S, E);
        }
        SEAM(base + 6);
        for (int rep_ = 0; rep_ < REPSL(8); ++rep_) if (PHK(8) && IN(base + 7)) {
            moe_tables(lds, ctl, layer);
            g8::SchedDown S{(const char*)(ws + WS_HID), (const char*)(ws + WS_DN) + (size_t)layer * NEXP * D * D, (LAS const int*)(lds + TAB_OFF), (int)gridDim.x, (int)blockIdx.x};
            g8::EpiBf16 E{(bf16_t*)(ws + WS_YROWS), D, p.moe_b_down + (size_t)layer * NEXP * D, D, 1.0f / DN_WSCALE};
            g8::gemm_phase<g8::EpiBf16, g8::SchedDown, false, 1>(lds, D, S, E);
        }
        SEAM(base + 7);
        for (int rep_ = 0; rep_ < REPSL(9); ++rep_) if (PHK(9) && IN(base + 8)) ln2_phase(lds, p, layer);
        SEAM(base + 8);
    }
#undef IN
#undef SEAM
__global__ void __launch_bounds__(NTHREADS, 2) fwd_kernel(Params p) {
    extern __shared__ __attribute__((aligned(16))) unsigned char lds_raw[];
    LAS unsigned char* lds = (LAS unsigned char*)lds_raw;
    const int lo = p.ph_lo, hi = p.ph_hi;
    unsigned char* ws = p.ws;
    unsigned* ctl = (unsigned*)(ws + WS_CTL);
#if MK_ONE_LAUNCH
    volatile LAS unsigned* bst = (volatile LAS unsigned*)(lds + LDS_BYTES - 16);
    if (threadIdx.x == 0) { bst[0] = 0u; bst[1] = 0u; bst[2] = 0u; bst[3] = 0u; }
    __syncthreads();
    XcdBarrier bar = xcd_barrier_post(ctl, bst);
#define GRID_BAR() xcd_barrier_nv(bar.bar, bar.x, bar.st)
#else
    XcdBarrier bar; bar.bar = ctl; bar.x = 0; bar.st = nullptr;
#define GRID_BAR() do {} while (0)
#endif
#define IN(k) (lo <= (k) && (k) < hi)
#define SEAM(k) do { if (IN(k) && IN((k) + 1)) GRID_BAR(); } while (0)

    for (int rep_ = 0; rep_ < REPS(0); ++rep_) if (PHK(0) && IN(0)) {
        LAS float* tile = (LAS float*)lds;
#pragma unroll 1
        for (int j = 0; j < 5; ++j) {
            const float* src = j == 0 ? p.moe_w_gu : (j == 1 ? p.moe_w_down : (j == 2 ? p.a_w_in : (j == 3 ? p.b_w_in : p.c_w_in)));
            const size_t dsto = j == 0 ? WS_GU : (j == 1 ? WS_DN : (j == 2 ? WS_AWIN : (j == 3 ? WS_BWIN : WS_CWIN)));
            const int N = j == 0 ? 2048 : (j == 1 ? D : (j == 2 ? 2048 : (j == 3 ? 6144 : 9216)));
            const int batch = j < 2 ? DEPTH * NEXP : (j == 2 ? 2 : 1);
            convert_big<true>(lds, src, ws + dsto, D, N, batch, j == 1 ? DN_WSCALE : GU_WSCALE);
        }
#pragma unroll 1
        for (int j = 0; j < 3; ++j) {
            const float* src = j == 0 ? p.a_w_out : (j == 1 ? p.b_w_out : p.c_w_out);
            const size_t dsto = j == 0 ? WS_AWOUT : (j == 1 ? WS_BWOUT : WS_CWOUT);
            convert_big<false>(lds, src, ws + dsto, j == 1 ? 2048 : D, D, j == 0 ? 2 : 1, 1.0f);
        }
        convert_job(tile, p.a_w_rgate, (bf16_t*)(ws + WS_AGT), 128, 128, 8);
        convert_job(tile, p.a_w_igate, (bf16_t*)(ws + WS_AGT) + (size_t)8 * 128 * 128, 128, 128, 8);
        convert_job(tile, p.a_w_rgate + (size_t)8 * 128 * 128, (bf16_t*)(ws + WS_AGT) + (size_t)16 * 128 * 128, 128, 128, 8);
        convert_job(tile, p.a_w_igate + (size_t)8 * 128 * 128, (bf16_t*)(ws + WS_AGT) + (size_t)24 * 128 * 128, 128, 128, 8);
        {
            bf16_t* rt = (bf16_t*)(ws + WS_RT);
            for (int i = blockIdx.x * NTHREADS + threadIdx.x; i < DEPTH * NEXP * D; i += gridDim.x * NTHREADS) {
                const int l = i / (NEXP * D), r_ = i % (NEXP * D), e = r_ / D, k = r_ % D;
                const float w = p.moe_w_router[((size_t)l * D + k) * NEXP + e];
                const bf16_t hi = f2bf(w); const bf16_t lo = f2bf(w - bf2f(hi));
                rt[((size_t)l * 2 + 0) * NEXP * D + (size_t)e * D + k] = hi; rt[((size_t)l * 2 + 1) * NEXP * D + (size_t)e * D + k] = lo;
            }
        }
        float* xf = (float*)(ws + WS_XF); bf16_t* xb = (bf16_t*)(ws + WS_XB);
        {
            const size_t stride = (size_t)gridDim.x * NTHREADS;
            for (size_t i = (size_t)blockIdx.x * NTHREADS + threadIdx.x; i < (size_t)T * D / 4; i += 4 * stride) {
                f32x4 v[4];
#pragma unroll
                for (int q = 0; q < 4; ++q) v[q] = *(const f32x4*)(p.x + (i + q * stride) * 4);
#pragma unroll
                for (int q = 0; q < 4; ++q) { *(f32x4*)(xf + (i + q * stride) * 4) = v[q]; *(unsigned*)(ws + WS_XQ + (i + q * stride) * 4) = pk_fp8x4(v[q][0], v[q][1], v[q][2], v[q][3]); }
            }
        }
    }
    SEAM(0);

    run_layer<0>(p, lds, bar); run_layer<1>(p, lds, bar); run_layer<2>(p, lds, bar); run_layer<3>(p, lds, bar);
#undef IN
#undef SEAM
}

extern "C" void kernel_launch(void* const* d_in, const int* in_sizes, int n_in, void* d_out, int out_size, void* d_ws, size_t ws_size, hipStream_t stream) {
    static int grid = 0;
    if (grid == 0) {
        if (n_in != 22 || out_size != T * D || ws_size < WS_END) { fprintf(stderr, "kernel_launch: unexpected shapes (n_in %d out %d ws %zu need %zu)\n", n_in, out_size, ws_size, (size_t)WS_END); grid = -1; return; }
        if (hipFuncSetAttribute((const void*)fwd_kernel, hipFuncAttributeMaxDynamicSharedMemorySize, LDS_BYTES) != hipSuccess) { fprintf(stderr, "kernel_launch: hipFuncSetAttribute failed\n"); grid = -1; return; }
        int dev = 0, cus = 0;
        if (hipGetDevice(&dev) != hipSuccess || hipDeviceGetAttribute(&cus, hipDeviceAttributeMultiprocessorCount, dev) != hipSuccess) { grid = -1; return; }
        grid = cus;
    }
    if (grid < 0) return;
    (void)hipMemsetAsync((char*)d_ws + WS_CTL, 0, CTL_BYTES, stream);
    Params p{};
    const float** pp = (const float**)&p;
    for (int i = 0; i < 22; ++i) pp[i] = (const float*)d_in[i];
    p.out = (float*)d_out; p.ws = (unsigned char*)d_ws;
#if MK_ONE_LAUNCH
    p.ph_lo = 0; p.ph_hi = NPHASES;
    hipLaunchKernelGGL(fwd_kernel, dim3(grid), dim3(NTHREADS), LDS_BYTES, stream, p);
#else
    for (int ph = 0; ph < NPHASES; ++ph) {
        p.ph_lo = ph; p.ph_hi = ph + 1;
        hipLaunchKernelGGL(fwd_kernel, dim3(grid), dim3(NTHREADS), LDS_BYTES, stream, p);
    }
#endif
}
```

```cpp
#include <hip/hip_runtime.h>
#include <stdint.h>
#include <stdio.h>

#ifndef MK_ONE_LAUNCH
#define MK_ONE_LAUNCH 1
#endif

#define LAS __attribute__((address_space(3)))
typedef unsigned short bf16_t;
typedef short bf16x8 __attribute__((ext_vector_type(8)));
typedef float f32x4 __attribute__((ext_vector_type(4)));
typedef unsigned u32x4 __attribute__((ext_vector_type(4)));
typedef unsigned u32x2 __attribute__((ext_vector_type(2)));

constexpr int T = 16384, D = 1024, SEQ = 2048, NBATCH = 8, DEPTH = 4;
constexpr int NEXP = 32, TOPK = 4;
constexpr int MAXROWS = 73728;
constexpr float DN_ALPHA = 1.681792830507429f;
constexpr float LN_EPS = 1e-5f;
constexpr float GU_WSCALE = 64.0f, DN_WSCALE = 128.0f;
constexpr int NTHREADS = 512;

constexpr size_t MB = 1ull << 20;
constexpr size_t WS_CTL = 0;
constexpr size_t CTL_BYTES = 65536;
constexpr size_t WS_AWIN = 1 * MB;
constexpr size_t WS_AWOUT = WS_AWIN + 8 * MB;
constexpr size_t WS_BWIN = WS_AWOUT + 4 * MB;
constexpr size_t WS_BWOUT = WS_BWIN + 12 * MB;
constexpr size_t WS_CWIN = WS_BWOUT + 4 * MB;
constexpr size_t WS_CWOUT = WS_CWIN + 18 * MB;
constexpr size_t WS_GU = WS_CWOUT + 2 * MB;
constexpr size_t WS_DN = WS_GU + 512 * MB;
constexpr size_t WS_XF = WS_DN + 256 * MB;
constexpr size_t WS_XB = WS_XF + 64 * MB;
constexpr size_t WS_U = WS_XB + 32 * MB;
constexpr size_t WS_YIN = WS_U + 288 * MB;
constexpr size_t WS_YMIX = WS_YIN + 64 * MB;
constexpr size_t WS_SCR = WS_YMIX + 64 * MB;
constexpr size_t WS_TOPE = WS_SCR + 128 * MB;
constexpr size_t WS_GATES = WS_TOPE + 256 * 1024;
constexpr size_t WS_POS = WS_GATES + 256 * 1024;
constexpr size_t WS_DEST = WS_POS + 256 * 1024;
constexpr size_t WS_ROWTOK = WS_DEST + 256 * 1024;
constexpr size_t WS_HID = WS_ROWTOK + 1 * MB;
constexpr size_t WS_YROWS = WS_HID + 144 * MB;
constexpr size_t WS_LSUM = WS_YROWS + 288 * MB;
constexpr size_t WS_AGT = WS_LSUM + 2 * MB;
constexpr size_t WS_RT = WS_AGT + 1 * MB;
constexpr size_t WS_XQ = WS_RT + 1 * MB;
constexpr size_t WS_LIST = WS_XQ + 16 * MB;
constexpr size_t WS_END = WS_LIST + 2 * MB;

constexpr int CW_CNT = 4096;
constexpr int CW_MDYN = 8192;
constexpr int CW_TEXP = 12288;

#define XB_TMO      128
#define XB_XCNT(j)  (256  + 64 * (j))
#define XB_XSUB(j)  (1280 + 64 * (j))
#define XB_XGEN(j)  (2304 + 64 * (j))
#define XB_TOP      3328
#define XB_TOPGEN   3392
#define XCD_BAR_WORDS 3456
#define XB_SPIN_CAP (1u << 22)

__device__ __forceinline__ unsigned xb_ld(unsigned* p)              { return __hip_atomic_load(p, __ATOMIC_RELAXED, __HIP_MEMORY_SCOPE_AGENT); }
__device__ __forceinline__ unsigned xb_add(unsigned* p, unsigned v) { return __hip_atomic_fetch_add(p, v, __ATOMIC_RELAXED, __HIP_MEMORY_SCOPE_AGENT); }
__device__ __forceinline__ unsigned xb_xcc_id() { return (unsigned)__builtin_amdgcn_s_getreg((3 << 11) | 20) & 0xFu; }
#define XB_SPIN(cond, bar) do { unsigned _sp = 0; while (cond) { __builtin_amdgcn_s_sleep(1); \
    if ((++_sp & 255u) == 0u) { if (xb_ld(&(bar)[XB_TMO])) break; if (_sp > XB_SPIN_CAP) { atomicAdd(&(bar)[XB_TMO], 1u); break; } } } } while (0)

struct XcdBarrier { unsigned* bar; unsigned x; volatile LAS unsigned* st; };

__device__ __forceinline__ XcdBarrier xcd_barrier_post(unsigned* bar, volatile LAS unsigned* st) {
    XcdBarrier b; b.bar = bar; b.x = xb_xcc_id(); b.st = st;
    if (threadIdx.x == 0) (void)xb_add(&bar[XB_XCNT(b.x)], 1u);
    return b;
}
__device__ __forceinline__ void xcd_barrier_complete(unsigned* bar, unsigned x, unsigned& nloc, unsigned& nx) {
    const unsigned G = gridDim.x * gridDim.y * gridDim.z;
    unsigned sum, cnt, mine, sp = 0u;
    for (;;) {
        sum = 0u; cnt = 0u; mine = 0u;
#pragma unroll
        for (unsigned j = 0; j < 16; ++j) { const unsigned c = xb_ld(&bar[XB_XCNT(j)]); sum += c; cnt += (c > 0u) ? 1u : 0u; mine = (j == x) ? c : mine; }
        if (sum == G) break;
        __builtin_amdgcn_s_sleep(1);
        if ((++sp & 255u) == 0u) { if (xb_ld(&bar[XB_TMO])) break; if (sp > XB_SPIN_CAP) { atomicAdd(&bar[XB_TMO], 1u); break; } }
    }
    nloc = mine > 0u ? mine : 1u; nx = cnt > 0u ? cnt : 1u;
}
__device__ __forceinline__ void xcd_barrier_nv(unsigned* bbar, unsigned bx, volatile LAS unsigned* bst) {
    XcdBarrier b; b.bar = bbar; b.x = bx; b.st = bst;
    asm volatile("s_waitcnt vmcnt(0)" ::: "memory");
    __syncthreads();
    if (threadIdx.x == 0) {
        unsigned* bar = b.bar;
        __builtin_amdgcn_s_waitcnt(0);
        unsigned nloc = b.st[0], nx = b.st[1];
        if (nloc == 0u) { xcd_barrier_complete(bar, b.x, nloc, nx); b.st[0] = nloc; b.st[1] = nx; }
        const unsigned old = xb_add(&bar[XB_XSUB(b.x)], 1u);
        const unsigned gen = old / nloc;
        if (old + 1u == (gen + 1u) * nloc) {
            __builtin_amdgcn_fence(__ATOMIC_RELEASE, "agent");
            asm volatile("s_waitcnt vmcnt(0)" ::: "memory");
            const unsigned og = xb_add(&bar[XB_TOP], 1u);
            const unsigned tg = og / nx;
            if (og + 1u == (tg + 1u) * nx) xb_add(&bar[XB_TOPGEN], 1u);
            else XB_SPIN(xb_ld(&bar[XB_TOPGEN]) == tg, bar);
            __builtin_amdgcn_fence(__ATOMIC_ACQUIRE, "agent");
            xb_add(&bar[XB_XGEN(b.x)], 1u);
            asm volatile("s_waitcnt vmcnt(0)" ::: "memory");
        } else {
            XB_SPIN(xb_ld(&bar[XB_XGEN(b.x)]) == gen, bar);
            __builtin_amdgcn_fence(__ATOMIC_ACQUIRE, "agent");
            asm volatile("s_waitcnt vmcnt(0)" ::: "memory");
        }
    }
    __syncthreads();
}

__device__ __forceinline__ int tid_() { int t = threadIdx.x; asm volatile("" : "+v"(t)); return t; }
__device__ __forceinline__ float bf2f(bf16_t v) { return __uint_as_float(((unsigned)v) << 16); }
__device__ __forceinline__ unsigned pack2(float lo, float hi) { unsigned r; asm("v_cvt_pk_bf16_f32 %0, %1, %2" : "=v"(r) : "v"(lo), "v"(hi)); return r; }
__device__ __forceinline__ bf16_t f2bf(float f) { return (bf16_t)(pack2(f, f) & 0xffffu); }
__device__ __forceinline__ float wave_sum(float v) {
#pragma unroll
    for (int o = 32; o >= 1; o >>= 1) v += __shfl_xor(v, o);
    return v;
}
__device__ __forceinline__ float wave_max(float v) {
#pragma unroll
    for (int o = 32; o >= 1; o >>= 1) v = fmaxf(v, __shfl_xor(v, o));
    return v;
}
__device__ __forceinline__ float sigmoidf_(float x) { return __builtin_amdgcn_rcpf(1.0f + __builtin_amdgcn_exp2f(-1.4426950408889634f * x)); }
__device__ __forceinline__ float gelu_tanh(float x) { const float u = 0.7978845608028654f * (x + 0.044715f * x * x * x); return 0.5f * x * (1.0f + tanhf(u)); }
__device__ __forceinline__ unsigned pk_fp8x4(float a, float b, float c, float d) { int w = 0; w = __builtin_amdgcn_cvt_pk_fp8_f32(a, b, w, false); w = __builtin_amdgcn_cvt_pk_fp8_f32(c, d, w, true); return (unsigned)w; }
__device__ __forceinline__ float swiglu(float gate, float up) {
    const float g = fminf(gate, 7.0f), u = fminf(fmaxf(up, -7.0f), 7.0f);
    return (u + 1.0f) * g * sigmoidf_(1.702f * g);
}

struct Params {
    const float* x; const float* a_w_in; const float* a_conv_w; const float* a_conv_b; const float* a_w_rgate; const float* a_b_rgate;
    const float* a_w_igate; const float* a_b_igate; const float* a_lambda; const float* a_w_out; const float* b_w_in; const float* b_w_out;
    const float* c_w_in; const float* c_w_out; const float* ln_gain; const float* ln_bias; const float* moe_w_router; const float* moe_b_router;
    const float* moe_w_gu; const float* moe_b_gu; const float* moe_w_down; const float* moe_b_down;
    float* out; unsigned char* ws;
    int ph_lo, ph_hi;
};

__device__ __forceinline__ void convert_job(LAS float* tile, const float* src, bf16_t* dst, int K, int N, int batch) {
    const int tid = tid_();
    const int tk = K / 64, tn = N / 64, per = tk * tn; const long total = (long)per * batch;
    for (long u = blockIdx.x; u < total; u += gridDim.x) {
        const int bidx = (int)(u / per), r = (int)(u % per), kt = r / tn, nt = r % tn;
        const float* s = src + (size_t)bidx * K * N + (size_t)(kt * 64) * N + nt * 64;
#pragma unroll
        for (int pass = 0; pass < 2; ++pass) {
            const int row = (tid >> 4) + 32 * pass, c4 = tid & 15;
            const f32x4 v = *(const f32x4*)(s + (size_t)row * N + c4 * 4);
            tile[row * 65 + c4 * 4 + 0] = v[0]; tile[row * 65 + c4 * 4 + 1] = v[1]; tile[row * 65 + c4 * 4 + 2] = v[2]; tile[row * 65 + c4 * 4 + 3] = v[3];
        }
        __syncthreads();
        {
            const int n = tid >> 3, k8 = tid & 7;
            float v[8];
#pragma unroll
            for (int j = 0; j < 8; ++j) v[j] = tile[(k8 * 8 + j) * 65 + n];
            u32x4 w; w.x = pack2(v[0], v[1]); w.y = pack2(v[2], v[3]); w.z = pack2(v[4], v[5]); w.w = pack2(v[6], v[7]);
            *(u32x4*)(dst + (size_t)bidx * N * K + (size_t)(nt * 64 + n) * K + kt * 64 + k8 * 8) = w;
        }
        __syncthreads();
    }
}

struct GemmS {
    const bf16_t* A; int lda;
    const bf16_t* Bt; int ldb;
    int M, N, K;
    const unsigned* Mdyn;
    const int* row_idx;
    const unsigned* tile_exp;
    size_t b_exp_stride;
    const float* bias; int bias_es;
    float* Cf; bf16_t* Cb; int ldc;
};
template <int MODE>
__device__ __forceinline__ void gemm_simple(LAS unsigned char* lds, const GemmS& g) {
    const int tid = tid_(), lane = tid & 63, wid = tid >> 6, wr = wid >> 1, wc = wid & 1, fr = lane & 15, fq = lane >> 4;
    const int M = g.Mdyn ? (int)*g.Mdyn : g.M;
    const int tiles_n = (MODE == 1) ? (g.N / 256) * 2 : g.N / 128;
    const int tiles_m = M / 128, nunits = tiles_m * tiles_n, nk = g.K / 32;
    LAS bf16_t* As = (LAS bf16_t*)lds;
    LAS bf16_t* Bs = As + 2 * 128 * 40;
    const int lrow = tid >> 2, lch = tid & 3;
    for (int u = blockIdx.x; u < nunits; u += gridDim.x) {
        const int tm = u / tiles_n, tn = u % tiles_n, m0 = tm * 128;
        const int e = (MODE != 0) ? (int)g.tile_exp[m0 >> 8] : 0;
        const bf16_t* Bbase = g.Bt + (size_t)e * g.b_exp_stride;
        int arow = m0 + lrow; if (MODE == 1) arow = g.row_idx[arow];
        int brow;
        if (MODE == 1) { const int bwc = lrow >> 6, ni = (lrow & 63) >> 4, r = lrow & 15; brow = ((ni & 1) ? 1024 : 0) + tn * 64 + bwc * 32 + (ni >> 1) * 16 + r; }
        else brow = tn * 128 + lrow;
        const bf16_t* ap = g.A + (size_t)arow * g.lda + lch * 8;
        const bf16_t* bp = Bbase + (size_t)brow * g.ldb + lch * 8;
        f32x4 acc[2][4];
#pragma unroll
        for (int mi = 0; mi < 2; ++mi)
#pragma unroll
            for (int ni = 0; ni < 4; ++ni) acc[mi][ni] = (f32x4){0.f, 0.f, 0.f, 0.f};
        u32x4 ra = *(const u32x4*)ap, rb = *(const u32x4*)bp;
        *(LAS u32x4*)(As + lrow * 40 + lch * 8) = ra; *(LAS u32x4*)(Bs + lrow * 40 + lch * 8) = rb;
        __syncthreads();
        for (int kt = 0; kt < nk; ++kt) {
            const int cur = kt & 1;
            if (kt + 1 < nk) { ra = *(const u32x4*)(ap + (kt + 1) * 32); rb = *(const u32x4*)(bp + (kt + 1) * 32); }
            bf16x8 af[2], bfr[4];
#pragma unroll
            for (int mi = 0; mi < 2; ++mi) af[mi] = *(const LAS bf16x8*)(As + cur * 5120 + (wr * 32 + mi * 16 + fr) * 40 + fq * 8);
#pragma unroll
            for (int ni = 0; ni < 4; ++ni) bfr[ni] = *(const LAS bf16x8*)(Bs + cur * 5120 + (wc * 64 + ni * 16 + fr) * 40 + fq * 8);
#pragma unroll
            for (int mi = 0; mi < 2; ++mi)
#pragma unroll
                for (int ni = 0; ni < 4; ++ni) acc[mi][ni] = __builtin_amdgcn_mfma_f32_16x16x32_bf16(bfr[ni], af[mi], acc[mi][ni], 0, 0, 0);
            if (kt + 1 < nk) { *(LAS u32x4*)(As + (cur ^ 1) * 5120 + lrow * 40 + lch * 8) = ra; *(LAS u32x4*)(Bs + (cur ^ 1) * 5120 + lrow * 40 + lch * 8) = rb; }
            __syncthreads();
        }
#pragma unroll
        for (int mi = 0; mi < 2; ++mi) {
            const int m = m0 + wr * 32 + mi * 16 + fr;
            if (MODE == 1) {
#pragma unroll
                for (int q = 0; q < 2; ++q) {
                    const int hc = tn * 64 + wc * 32 + q * 16 + 4 * fq;
                    const f32x4 bg = *(const f32x4*)(g.bias + (size_t)e * g.bias_es + hc), bu = *(const f32x4*)(g.bias + (size_t)e * g.bias_es + 1024 + hc);
                    const f32x4 gt = acc[mi][2 * q] + bg, up = acc[mi][2 * q + 1] + bu;
                    u32x2 w; w.x = pack2(swiglu(gt[0], up[0]), swiglu(gt[1], up[1])); w.y = pack2(swiglu(gt[2], up[2]), swiglu(gt[3], up[3]));
                    *(u32x2*)(g.Cb + (size_t)m * g.ldc + hc) = w;
                }
            } else {
#pragma unroll
                for (int ni = 0; ni < 4; ++ni) {
                    const int n = tn * 128 + wc * 64 + ni * 16 + 4 * fq;
                    f32x4 v = acc[mi][ni];
                    if (g.bias) v += *(const f32x4*)(g.bias + (size_t)e * g.bias_es + n);
                    if (g.Cf) *(f32x4*)(g.Cf + (size_t)m * g.ldc + n) = v;
                    else { u32x2 w; w.x = pack2(v[0], v[1]); w.y = pack2(v[2], v[3]); *(u32x2*)(g.Cb + (size_t)m * g.ldc + n) = w; }
                }
            }
        }
    }
}


constexpr int TAB_OFF = 131072;
__device__ __forceinline__ void moe_tables(LAS unsigned char* lds, const unsigned* ctl, int layer) {
    LAS int* tab = (LAS int*)(lds + TAB_OFF);
    const int tid = tid_();
    __syncthreads();
    if (tid == 0) { int acc = 0; for (int e = 0; e < NEXP; ++e) { tab[e] = acc; acc += ((int)ctl[CW_CNT + layer * 64 + e] + 255) >> 8; } tab[32] = acc; }
    __syncthreads();
    if (tid < 288) { int e = 0; for (int q = 1; q < NEXP; ++q) e += (tab[q] <= tid) ? 1 : 0; tab[64 + tid] = e; }
    __syncthreads();
}

namespace g8 {
constexpr int BM = 256, BK = 64, HALF = 128, HTB = HALF * BK * 2, STAGE_BYTES = 8 * HTB, NXCD = 8, WGM = 8;
__device__ __forceinline__ int lds_byte(int r, int c) { const int st = (r >> 4) * 2 + (c >> 5), rr = r & 15, cc = c & 31, ob = rr * 64 + cc * 2; return st * 1024 + (ob ^ (((ob >> 9) & 1) << 5)); }
__device__ __forceinline__ void stage_rc(int b, int& R, int& C) { const int st = b / 1024, sb = b % 1024, swz = sb ^ (((sb >> 9) & 1) << 5); R = (st >> 1) * 16 + swz / 64; C = (st & 1) * 32 + (swz % 64) / 2; }
__device__ __forceinline__ int perm32(int rho) { const int n = rho >> 4, i = rho & 15; return 8 * (i >> 2) + 4 * n + (i & 3); }
__device__ __forceinline__ unsigned cvt_pk_bf16(float lo, float hi) { unsigned r; asm volatile("v_cvt_pk_bf16_f32 %0, %1, %2" : "=v"(r) : "v"(lo), "v"(hi)); return r; }

struct Unit { const char* a0; const char* a1; const char* b0; const char* b1; const int* rows; int row0, col0, e; };

struct SchedPlain {
    const char* A; const char* Bt; size_t hstepA, hstepB; int nM, nN, nwg, G, c;
    __device__ __forceinline__ void init(const void* A_, const void* Bt_, int M, int N, int K, int G_, int c_) { A = (const char*)A_; Bt = (const char*)Bt_; hstepA = (size_t)HALF * K * 2; hstepB = hstepA; nM = M / BM; nN = N / BM; nwg = nM * nN; G = G_; c = c_; }
    __device__ __forceinline__ bool next(int i, Unit& u) const {
        const long L = (long)i * G + c; if (L >= nwg) return false;
        int wgid = (int)L; { const int q = nwg / NXCD, r = nwg % NXCD, xcd = wgid % NXCD, off = wgid / NXCD; wgid = (xcd < r ? xcd * (q + 1) : r * (q + 1) + (xcd - r) * q) + off; }
        const int nig = WGM * nN, gid = wgid / nig, fm = gid * WGM, gsz = (nM - fm) < WGM ? (nM - fm) : WGM;
        const int pm = fm + ((wgid % nig) % gsz), pn = (wgid % nig) / gsz;
        u.a0 = A + (size_t)pm * 2 * hstepA; u.a1 = u.a0 + hstepA; u.b0 = Bt + (size_t)pn * 2 * hstepB; u.b1 = u.b0 + hstepB; u.rows = nullptr; u.row0 = pm * BM; u.col0 = pn * BM; u.e = 0;
        return true;
    }
};
struct SchedGU {
    const char* A; const char* W; const int* elist; LAS const int* tab; int G, c;
    __device__ __forceinline__ bool next(int i, Unit& u) const {
        const int L = i * G + c, rt = L >> 3, pn = L & 7; if (rt >= __builtin_amdgcn_readfirstlane(tab[32])) return false;
        const int e = __builtin_amdgcn_readfirstlane(tab[64 + rt]), j = rt - __builtin_amdgcn_readfirstlane(tab[e]);
        u.a0 = A; u.a1 = A; u.rows = elist + (size_t)e * T + j * BM; u.b0 = W + ((size_t)e * 2048 + pn * 128) * D; u.b1 = u.b0 + (size_t)1024 * D; u.row0 = rt * BM; u.col0 = pn * 128; u.e = e;
        return true;
    }
};
struct SchedDown {
    const char* A; const char* W; LAS const int* tab; int G, c;
    __device__ __forceinline__ bool next(int i, Unit& u) const {
        const int L = i * G + c, rt = L >> 2, pn = L & 3; if (rt >= __builtin_amdgcn_readfirstlane(tab[32])) return false;
        const int e = __builtin_amdgcn_readfirstlane(tab[64 + rt]);
        u.a0 = A + (size_t)rt * BM * D; u.a1 = u.a0 + (size_t)HALF * D; u.rows = nullptr; u.b0 = W + ((size_t)e * 1024 + pn * BM) * D; u.b1 = u.b0 + (size_t)HALF * D; u.row0 = rt * BM; u.col0 = pn * BM; u.e = e;
        return true;
    }
};

struct EpiF32 {
    static constexpr bool PERM = false;
    float* C; int ldc; const float* bias; int bias_es;
    __device__ __forceinline__ void operator()(const f32x4 (&acc)[2][2][4][2], const Unit& u, int wr, int wc, int fr, int fq) const {
        const int row0 = u.row0 + wr * 64 + fr, col0 = u.col0 + wc * 32 + 4 * fq;
        f32x4 bv[2][2];
#pragma unroll
        for (int bj = 0; bj < 2; ++bj)
#pragma unroll
            for (int n = 0; n < 2; ++n) bv[bj][n] = bias ? *(const f32x4*)(bias + (size_t)u.e * bias_es + col0 + bj * HALF + n * 16) : (f32x4){0.f, 0.f, 0.f, 0.f};
#pragma unroll
        for (int ai = 0; ai < 2; ++ai)
#pragma unroll
            for (int m = 0; m < 4; ++m) { float* rowp = C + (size_t)(row0 + ai * HALF + m * 16) * ldc + col0;
#pragma unroll
                for (int bj = 0; bj < 2; ++bj)
#pragma unroll
                    for (int n = 0; n < 2; ++n) *(f32x4*)(rowp + bj * HALF + n * 16) = acc[ai][bj][m][n] + bv[bj][n]; }
    }
};
struct EpiBf16 {
    static constexpr bool PERM = true;
    bf16_t* O; int ldc; const float* bias; int bias_es; float scale;
    __device__ __forceinline__ void operator()(const f32x4 (&acc)[2][2][4][2], const Unit& u, int wr, int wc, int fr, int fq) const {
        const int row0 = u.row0 + wr * 64 + fr, col0 = u.col0 + wc * 32 + 8 * fq;
        f32x4 bv[2][2];
#pragma unroll
        for (int bj = 0; bj < 2; ++bj)
#pragma unroll
            for (int n = 0; n < 2; ++n) bv[bj][n] = bias ? *(const f32x4*)(bias + (size_t)u.e * bias_es + col0 + bj * HALF + 4 * n) : (f32x4){0.f, 0.f, 0.f, 0.f};
#pragma unroll
        for (int ai = 0; ai < 2; ++ai)
#pragma unroll
            for (int m = 0; m < 4; ++m) { bf16_t* rowp = O + (size_t)(row0 + ai * HALF + m * 16) * ldc + col0;
#pragma unroll
                for (int bj = 0; bj < 2; ++bj) { const f32x4 v0 = acc[ai][bj][m][0] * scale + bv[bj][0], v1 = acc[ai][bj][m][1] * scale + bv[bj][1];
                    u32x4 w; w.x = cvt_pk_bf16(v0[0], v0[1]); w.y = cvt_pk_bf16(v0[2], v0[3]); w.z = cvt_pk_bf16(v1[0], v1[1]); w.w = cvt_pk_bf16(v1[2], v1[3]);
                    *(u32x4*)(rowp + bj * HALF) = w; } }
    }
};
struct EpiSwiglu {
    static constexpr bool PERM = true;
    unsigned char* O; const float* bias; float scale;
    __device__ __forceinline__ void operator()(const f32x4 (&acc)[2][2][4][2], const Unit& u, int wr, int wc, int fr, int fq) const {
        const int row0 = u.row0 + wr * 64 + fr, hc = u.col0 + wc * 32 + 8 * fq;
        const float* bp = bias + (size_t)u.e * 2048 + hc;
        const f32x4 bg0 = *(const f32x4*)(bp), bg1 = *(const f32x4*)(bp + 4), bu0 = *(const f32x4*)(bp + 1024), bu1 = *(const f32x4*)(bp + 1028);
#pragma unroll
        for (int ai = 0; ai < 2; ++ai)
#pragma unroll
            for (int m = 0; m < 4; ++m) {
                const f32x4 g0 = acc[ai][0][m][0] * scale + bg0, g1 = acc[ai][0][m][1] * scale + bg1, u0 = acc[ai][1][m][0] * scale + bu0, u1 = acc[ai][1][m][1] * scale + bu1;
                u32x2 w; w.x = pk_fp8x4(swiglu(g0[0], u0[0]), swiglu(g0[1], u0[1]), swiglu(g0[2], u0[2]), swiglu(g0[3], u0[3]));
                w.y = pk_fp8x4(swiglu(g1[0], u1[0]), swiglu(g1[1], u1[1]), swiglu(g1[2], u1[2]), swiglu(g1[3], u1[3]));
                *(u32x2*)(O + (size_t)(row0 + ai * HALF + m * 16) * D + hc) = w;
            }
    }
};

typedef int i32x8 __attribute__((ext_vector_type(8)));
typedef int i32x4 __attribute__((ext_vector_type(4)));
template <class Epi, class Sched, bool GATHER, int ESZ = 2>
__device__ __forceinline__ void gemm_phase(LAS unsigned char* lds, const int K, const Sched& S, const Epi& E) {
    const int tid = tid_(), wid = __builtin_amdgcn_readfirstlane(tid >> 6), lane = tid & 63, wr = wid >> 2, wc = wid & 3, fr = lane & 15, fq = lane >> 4;
    const int nt = K * ESZ / 128, KP = K * ESZ;
    int sR[2], sC[2];
    unsigned voffB[2];
#pragma unroll
    for (int i = 0; i < 2; ++i) { stage_rc(tid * 16 + i * 8192, sR[i], sC[i]); const int Rb = Epi::PERM ? ((sR[i] & ~31) + perm32(sR[i] & 31)) : sR[i]; voffB[i] = (unsigned)(Rb * KP + sC[i] * 2); }
    unsigned cvA0[2], cvA1[2], nvA0[2], nvA1[2];
#define G8_VOFF(u, v0, v1) do { _Pragma("unroll") for (int _i = 0; _i < 2; ++_i) { \
        if (GATHER) { unsigned t0_ = (unsigned)(u).rows[sR[_i]], t1_ = (unsigned)(u).rows[HALF + sR[_i]]; t0_ = t0_ < (unsigned)T ? t0_ : 0u; t1_ = t1_ < (unsigned)T ? t1_ : 0u;     \
            v0[_i] = t0_ * (unsigned)KP + (unsigned)(sC[_i] * 2); v1[_i] = t1_ * (unsigned)KP + (unsigned)(sC[_i] * 2); } \
        else { v0[_i] = (unsigned)(sR[_i] * KP + sC[_i] * 2); v1[_i] = v0[_i]; } } } while (0)
    const size_t kstep = (size_t)(BK * 2);
    const unsigned ldsw = (unsigned)wid * 1024u;
    const int aoff = lds_byte(wr * 64 + fr, fq * 8), boff = lds_byte(wc * 32 + fr, fq * 8);
#define PG8_SA(b, h) (((b) * 2 + (h)) * HTB)
#define PG8_SB(b, h) ((4 + (b) * 2 + (h)) * HTB)
#define PG8_STAGE(bufoff, gbase, voff) do { _Pragma("unroll") for (int _i = 0; _i < 2; ++_i) \
        __builtin_amdgcn_global_load_lds((const unsigned*)((const char*)(gbase) + (voff)[_i]), (LAS unsigned*)(lds + (bufoff) + ldsw + _i * 8192), 16, 0, 0); } while (0)
#define PG8_LDA(dst, b, h) do { _Pragma("unroll") for (int m = 0; m < 4; ++m) { dst[m].lo = *(const LAS i32x4*)(lds + PG8_SA(b, h) + aoff + m * 2048); dst[m].hi = *(const LAS i32x4*)(lds + PG8_SA(b, h) + aoff + m * 2048 + 1024); } } while (0)
#define PG8_LDB(dst, b, h) do { _Pragma("unroll") for (int n = 0; n < 2; ++n) { dst[n].lo = *(const LAS i32x4*)(lds + PG8_SB(b, h) + boff + n * 2048); dst[n].hi = *(const LAS i32x4*)(lds + PG8_SB(b, h) + boff + n * 2048 + 1024); } } while (0)
#define PG8_MMA(ai, bj, At, Bt) do { __builtin_amdgcn_s_setprio(1); _Pragma("unroll") for (int m = 0; m < 4; ++m) _Pragma("unroll") for (int n = 0; n < 2; ++n) { \
        if (ESZ == 2) { acc[ai][bj][m][n] = __builtin_amdgcn_mfma_f32_16x16x32_bf16(__builtin_bit_cast(bf16x8, (i32x4)__builtin_shufflevector(Bt[n], Bt[n], 0, 1, 2, 3)), __builtin_bit_cast(bf16x8, (i32x4)__builtin_shufflevector(At[m], At[m], 0, 1, 2, 3)), acc[ai][bj][m][n], 0, 0, 0); \
                        acc[ai][bj][m][n] = __builtin_amdgcn_mfma_f32_16x16x32_bf16(__builtin_bit_cast(bf16x8, (i32x4)__builtin_shufflevector(Bt[n], Bt[n], 4, 5, 6, 7)), __builtin_bit_cast(bf16x8, (i32x4)__builtin_shufflevector(At[m], At[m], 4, 5, 6, 7)), acc[ai][bj][m][n], 0, 0, 0); } \
        else asm volatile("v_mfma_f32_16x16x128_f8f6f4 %0, %1, %2, %0" : "+v"(acc[ai][bj][m][n]) : "v"(Bt[n]), "v"(At[m])); } __builtin_amdgcn_s_setprio(0); } while (0)
#define PG8_WAIT_V(n) asm volatile("s_waitcnt vmcnt(" #n ")" ::: "memory")
#define PG8_WAIT_L(n) asm volatile("s_waitcnt lgkmcnt(" #n ")" ::: "memory")
#define PG8_BAR __builtin_amdgcn_s_barrier()
#define PG8_SCHED __builtin_amdgcn_sched_barrier(0)
    Unit cur, nxt; int ui = 0;
    if (!S.next(0, cur)) return;
    f32x4 acc[2][2][4][2];
#pragma unroll
    for (int a = 0; a < 2; ++a)
#pragma unroll
        for (int b = 0; b < 2; ++b)
#pragma unroll
            for (int m = 0; m < 4; ++m)
#pragma unroll
                for (int n = 0; n < 2; ++n) acc[a][b][m][n] = (f32x4){0.f, 0.f, 0.f, 0.f};
    i32x8 At[4], B0[2], B1[2];
    const char* cA0 = cur.a0; const char* cA1 = cur.a1; const char* cB0 = cur.b0; const char* cB1 = cur.b1;
    G8_VOFF(cur, cvA0, cvA1);
    PG8_STAGE(PG8_SB(0, 0), cB0, voffB); PG8_STAGE(PG8_SB(0, 1), cB1, voffB); PG8_STAGE(PG8_SA(0, 0), cA0, cvA0); PG8_STAGE(PG8_SA(0, 1), cA1, cvA1);
    if (wr == 1) PG8_BAR;
    PG8_WAIT_V(2); PG8_BAR;
    PG8_STAGE(PG8_SB(1, 0), cB0 + kstep, voffB); PG8_STAGE(PG8_SA(1, 0), cA0 + kstep, cvA0); PG8_STAGE(PG8_SB(1, 1), cB1 + kstep, voffB);
    PG8_WAIT_V(6); PG8_BAR;
    for (;;) {
        const bool has_next = S.next(ui + 1, nxt);
        const char* nA0 = has_next ? nxt.a0 : cA0; const char* nA1 = has_next ? nxt.a1 : cA1; const char* nB0 = has_next ? nxt.b0 : cB0; const char* nB1 = has_next ? nxt.b1 : cB1;
        if (GATHER) { if (has_next) { G8_VOFF(nxt, nvA0, nvA1); } else { nvA0[0] = cvA0[0]; nvA0[1] = cvA0[1]; nvA1[0] = cvA1[0]; nvA1[1] = cvA1[1]; } }
#pragma unroll 1
        for (int t = 0; t < nt; t += 2) {
            const bool last = (t == nt - 2);
            const char* a1_1 = cA1 + (size_t)(t + 1) * kstep;
            const char* a2_0 = last ? nA0 : cA0 + (size_t)(t + 2) * kstep; const char* a2_1 = last ? nA1 : cA1 + (size_t)(t + 2) * kstep;
            const char* b2_0 = last ? nB0 : cB0 + (size_t)(t + 2) * kstep; const char* b2_1 = last ? nB1 : cB1 + (size_t)(t + 2) * kstep;
            const char* a3_0 = a2_0 + kstep; const char* b3_0 = b2_0 + kstep; const char* b3_1 = b2_1 + kstep;
            unsigned vA0[2], vA1[2];
            if (GATHER) { vA0[0] = last ? nvA0[0] : cvA0[0]; vA0[1] = last ? nvA0[1] : cvA0[1]; vA1[0] = last ? nvA1[0] : cvA1[0]; vA1[1] = last ? nvA1[1] : cvA1[1]; }
            else { vA0[0] = cvA0[0]; vA0[1] = cvA0[1]; vA1[0] = cvA0[0]; vA1[1] = cvA0[1]; }
            PG8_LDB(B0, 0, 0); PG8_LDB(B1, 0, 1); PG8_SCHED; PG8_LDA(At, 0, 0); PG8_STAGE(PG8_SA(1, 1), a1_1, cvA1);
            PG8_WAIT_V(8); PG8_WAIT_L(0); PG8_BAR; PG8_MMA(0, 0, At, B0); PG8_MMA(0, 1, At, B1); PG8_BAR; PG8_SCHED;
            PG8_LDA(At, 0, 1); PG8_STAGE(PG8_SB(0, 0), b2_0, voffB); PG8_STAGE(PG8_SB(0, 1), b2_1, voffB); PG8_STAGE(PG8_SA(0, 0), a2_0, vA0);
            PG8_WAIT_V(8); PG8_WAIT_L(0); PG8_BAR; PG8_MMA(1, 0, At, B0); PG8_MMA(1, 1, At, B1); PG8_BAR; PG8_SCHED;
            PG8_LDB(B0, 1, 0); PG8_LDB(B1, 1, 1); PG8_SCHED; PG8_LDA(At, 1, 0); PG8_STAGE(PG8_SA(0, 1), a2_1, vA1);
            PG8_WAIT_V(8); PG8_WAIT_L(0); PG8_BAR; PG8_MMA(0, 0, At, B0); PG8_MMA(0, 1, At, B1); PG8_BAR; PG8_SCHED;
            PG8_LDA(At, 1, 1); PG8_STAGE(PG8_SB(1, 0), b3_0, voffB); PG8_STAGE(PG8_SB(1, 1), b3_1, voffB); PG8_STAGE(PG8_SA(1, 0), a3_0, vA0);
            PG8_WAIT_V(8); PG8_WAIT_L(0); PG8_BAR; PG8_MMA(1, 0, At, B0); PG8_MMA(1, 1, At, B1); PG8_BAR; PG8_SCHED;
        }
        if (wr == 0) PG8_BAR;
        if (ESZ == 1) asm volatile("s_nop 15\n\ts_nop 15" ::: "memory");
        E(acc, cur, wr, wc, fr, fq);
        if (!has_next) break;
#pragma unroll
        for (int a = 0; a < 2; ++a)
#pragma unroll
            for (int b = 0; b < 2; ++b)
#pragma unroll
                for (int m = 0; m < 4; ++m)
#pragma unroll
                    for (int n = 0; n < 2; ++n) acc[a][b][m][n] = (f32x4){0.f, 0.f, 0.f, 0.f};
        cur = nxt; cA0 = nA0; cA1 = nA1; cB0 = nB0; cB1 = nB1; ++ui;
        if (GATHER) { cvA0[0] = nvA0[0]; cvA0[1] = nvA0[1]; cvA1[0] = nvA1[0]; cvA1[1] = nvA1[1]; }
        if (wr == 1) PG8_BAR;
    }
    PG8_WAIT_V(0);
    PG8_BAR;
#undef G8_VOFF
#undef PG8_SA
#undef PG8_SB
#undef PG8_STAGE
#undef PG8_LDA
#undef PG8_LDB
#undef PG8_MMA
#undef PG8_WAIT_V
#undef PG8_WAIT_L
#undef PG8_BAR
#undef PG8_SCHED
}
}


template <bool F8>
__device__ __forceinline__ void convert_big(LAS unsigned char* lds, const float* src, void* dstv, int K, int N, int batch, float scale) {
    const int tid = tid_(), lane = tid & 63, wid = tid >> 6;
    const int nbn = N / 256, per = (K / 128) * nbn, total = per * batch, G = (int)gridDim.x;
    constexpr int ESZ = F8 ? 1 : 2, ROWB = 128 * ESZ, TILEB = 256 * ROWB;
    f32x4 ra[16], rb[16];
#define CV_LOAD(uu, reg) do { const int bidx = (uu) / per, r_ = (uu) % per, kb = r_ / nbn, nb = r_ % nbn; \
        const float* sp = src + (size_t)bidx * K * N + (size_t)(kb * 128 + 16 * wid) * N + nb * 256 + 4 * lane; \
        _Pragma("unroll") for (int i = 0; i < 16; ++i) reg[i] = *(const f32x4*)(sp + (size_t)i * N); } while (0)
#define CV_PACK(reg, tl) do { _Pragma("unroll") for (int j = 0; j < 4; ++j) { \
        if (F8) { u32x4 w0; w0.x = pk_fp8x4(reg[0][j] * scale, reg[1][j] * scale, reg[2][j] * scale, reg[3][j] * scale); w0.y = pk_fp8x4(reg[4][j] * scale, reg[5][j] * scale, reg[6][j] * scale, reg[7][j] * scale); \
            w0.z = pk_fp8x4(reg[8][j] * scale, reg[9][j] * scale, reg[10][j] * scale, reg[11][j] * scale); w0.w = pk_fp8x4(reg[12][j] * scale, reg[13][j] * scale, reg[14][j] * scale, reg[15][j] * scale); \
            *(LAS u32x4*)((tl) + (4 * lane + j) * ROWB + ((wid ^ (lane & 7)) * 16)) = w0; } \
        else { u32x4 w0, w1; \
            w0.x = g8::cvt_pk_bf16(reg[0][j], reg[1][j]); w0.y = g8::cvt_pk_bf16(reg[2][j], reg[3][j]); w0.z = g8::cvt_pk_bf16(reg[4][j], reg[5][j]); w0.w = g8::cvt_pk_bf16(reg[6][j], reg[7][j]); \
            w1.x = g8::cvt_pk_bf16(reg[8][j], reg[9][j]); w1.y = g8::cvt_pk_bf16(reg[10][j], reg[11][j]); w1.z = g8::cvt_pk_bf16(reg[12][j], reg[13][j]); w1.w = g8::cvt_pk_bf16(reg[14][j], reg[15][j]); \
            *(LAS u32x4*)((tl) + (4 * lane + j) * ROWB + (((2 * wid) ^ (lane & 15)) * 16)) = w0; *(LAS u32x4*)((tl) + (4 * lane + j) * ROWB + (((2 * wid + 1) ^ (lane & 15)) * 16)) = w1; } } } while (0)
#define CV_STORE(uu, tl) do { const int bidx = (uu) / per, r_ = (uu) % per, kb = r_ / nbn, nb = r_ % nbn; \
        unsigned char* dp = (unsigned char*)dstv + ((size_t)bidx * N * K + (size_t)(nb * 256) * K + kb * 128) * ESZ; \
        _Pragma("unroll") for (int i = 0; i < 4 * ESZ; ++i) { const int pc = tid + NTHREADS * i, n = pc / (8 * ESZ), c = pc % (8 * ESZ); \
            *(u32x4*)(dp + (size_t)n * K * ESZ + c * 16) = *(const LAS u32x4*)((tl) + n * ROWB + ((c ^ ((n >> 2) & (8 * ESZ - 1))) * 16)); } } while (0)
    const int u0 = blockIdx.x;
    if (u0 < total) CV_LOAD(u0, ra);
    if (u0 + G < total) CV_LOAD(u0 + G, rb);
    for (int u = u0; u < total; u += 2 * G) {
        CV_PACK(ra, lds);
        if (u + 2 * G < total) CV_LOAD(u + 2 * G, ra);
        __syncthreads();
        CV_STORE(u, lds);
        const bool has_b = (u + G < total);
        if (has_b) { CV_PACK(rb, lds + TILEB); if (u + 3 * G < total) CV_LOAD(u + 3 * G, rb); }
        __syncthreads();
        if (has_b) CV_STORE(u + G, lds + TILEB);
    }
    __syncthreads();
#undef CV_LOAD
#undef CV_PACK
#undef CV_STORE
}

__device__ __forceinline__ float gelu_fast(float x) { const float u2 = 1.5957691216057308f * (x + 0.044715f * x * x * x); return x * __builtin_amdgcn_rcpf(1.0f + __builtin_amdgcn_exp2f(-1.4426950408889634f * u2)); }
__device__ __forceinline__ void lru_gates_phase(LAS unsigned char* lds, const Params& p, int idx) {
    const int tid = tid_(), lane = tid & 63, wid = tid >> 6, fr = lane & 15, fq = lane >> 4;
    LAS bf16_t* xcb = (LAS bf16_t*)lds;
    LAS float* xcf = (LAS float*)(lds + 17408);
    LAS float* sa = (LAS float*)(lds + 17408 + 33792);
    LAS float* sb = sa + 64 * 132;
    LAS float* comb = sb + 64 * 132;
    const bf16_t* u = (const bf16_t*)(p.ws + WS_U);
    bf16_t* Carr = (bf16_t*)(p.ws + WS_SCR); bf16_t* Barr = Carr + (size_t)T * D;
    float* SP = (float*)(p.ws + WS_LSUM); float* SH = SP + NBATCH * 32 * D;
    const int hd = blockIdx.x & 7, slot = blockIdx.x >> 3, nslots = gridDim.x >> 3;
    const float* conv_w = p.a_conv_w + (size_t)idx * 4 * D; const float* conv_b = p.a_conv_b + (size_t)idx * D;
    const bf16_t* wrt = (const bf16_t*)(p.ws + WS_AGT) + ((size_t)(idx * 2 + 0) * 8 + hd) * 128 * 128;
    const bf16_t* wit = (const bf16_t*)(p.ws + WS_AGT) + ((size_t)(idx * 2 + 1) * 8 + hd) * 128 * 128;
    bf16x8 Br[4], Bi[4];
#pragma unroll
    for (int ks = 0; ks < 4; ++ks) { Br[ks] = *(const bf16x8*)(wrt + (size_t)(16 * wid + fr) * 128 + 32 * ks + 8 * fq); Bi[ks] = *(const bf16x8*)(wit + (size_t)(16 * wid + fr) * 128 + 32 * ks + 8 * fq); }
    const int cg = hd * 128 + 16 * wid + 4 * fq;
    const f32x4 brv = *(const f32x4*)(p.a_b_rgate + (size_t)idx * D + cg), biv = *(const f32x4*)(p.a_b_igate + (size_t)idx * D + cg), lmv = *(const f32x4*)(p.a_lambda + (size_t)idx * D + cg);
    f32x4 spv;
#pragma unroll
    for (int r = 0; r < 4; ++r) spv[r] = (lmv[r] > 15.f) ? __expf(-lmv[r]) : log1pf(__expf(-lmv[r]));
    const int cc = (tid & 31) * 4, cch = hd * 128 + cc;
    f32x4 cw[4];
#pragma unroll
    for (int j = 0; j < 4; ++j) cw[j] = *(const f32x4*)(conv_w + j * D + cch);
    const f32x4 cb = *(const f32x4*)(conv_b + cch);
    for (int tile = slot; tile < T / 64; tile += nslots) {
        const int t0 = tile * 64;
#pragma unroll
        for (int k = 0; k < 4; ++k) {
            const int tl = (tid >> 5) + 16 * k, t = t0 + tl, s_ = t & (SEQ - 1);
            f32x4 acc = cb;
#pragma unroll
            for (int j = 0; j < 4; ++j) {
                if (s_ - 3 + j >= 0) {
                    const u32x2 rv = *(const u32x2*)(u + (size_t)(t - 3 + j) * 2048 + 1024 + cch);
                    acc[0] += cw[j][0] * __uint_as_float(rv.x << 16); acc[1] += cw[j][1] * __uint_as_float(rv.x & 0xffff0000u);
                    acc[2] += cw[j][2] * __uint_as_float(rv.y << 16); acc[3] += cw[j][3] * __uint_as_float(rv.y & 0xffff0000u);
                }
            }
            *(LAS f32x4*)(xcf + tl * 132 + cc) = acc;
            u32x2 w; w.x = pack2(acc[0], acc[1]); w.y = pack2(acc[2], acc[3]);
            *(LAS u32x2*)(xcb + tl * 136 + cc) = w;
        }
        __syncthreads();
        f32x4 ar[4], ai[4];
#pragma unroll
        for (int mt = 0; mt < 4; ++mt) { ar[mt] = (f32x4){0.f, 0.f, 0.f, 0.f}; ai[mt] = (f32x4){0.f, 0.f, 0.f, 0.f}; }
#pragma unroll
        for (int ks = 0; ks < 4; ++ks)
#pragma unroll
            for (int mt = 0; mt < 4; ++mt) {
                const bf16x8 af = *(const LAS bf16x8*)(xcb + (mt * 16 + fr) * 136 + 32 * ks + 8 * fq);
                ar[mt] = __builtin_amdgcn_mfma_f32_16x16x32_bf16(Br[ks], af, ar[mt], 0, 0, 0);
                ai[mt] = __builtin_amdgcn_mfma_f32_16x16x32_bf16(Bi[ks], af, ai[mt], 0, 0, 0);
            }
#pragma unroll
        for (int mt = 0; mt < 4; ++mt) {
            const int tl = mt * 16 + fr, cl = 16 * wid + 4 * fq;
            const f32x4 rec = *(const LAS f32x4*)(xcf + tl * 132 + cl);
            f32x4 av, bv, cv;
#pragma unroll
            for (int r = 0; r < 4; ++r) {
                const float rg = sigmoidf_(ar[mt][r] + brv[r]), ig = sigmoidf_(ai[mt][r] + biv[r]);
                const float xl = -8.0f * rg * spv[r];
                const float cex = -xl * (1.0f + xl * (0.5f + xl * (0.16666667f + xl * (0.041666668f + xl * 0.0083333338f))));
                const float cc_ = bf2f(f2bf(cex));
                av[r] = 1.0f - cc_; cv[r] = cc_;
                bv[r] = bf2f(f2bf(__builtin_amdgcn_sqrtf(fmaxf(cex * (2.0f - cex), 0.f)) * ig * rec[r]));
            }
            { u32x2 wc_, wb_; wc_.x = pack2(cv[0], cv[1]); wc_.y = pack2(cv[2], cv[3]); wb_.x = pack2(bv[0], bv[1]); wb_.y = pack2(bv[2], bv[3]);
              *(u32x2*)(Carr + (size_t)(t0 + tl) * D + cg) = wc_; *(u32x2*)(Barr + (size_t)(t0 + tl) * D + cg) = wb_; }
            *(LAS f32x4*)(sa + tl * 132 + cl) = av; *(LAS f32x4*)(sb + tl * 132 + cl) = bv;
        }
        __syncthreads();
        {
            const int j = tid & 127, q = tid >> 7;
            float P = 1.f, H = 0.f;
#pragma unroll
            for (int s_ = 0; s_ < 16; ++s_) { const float a = sa[(q * 16 + s_) * 132 + j], bb = sb[(q * 16 + s_) * 132 + j]; H = a * H + bb; P *= a; }
            comb[(q * 128 + j) * 2 + 0] = P; comb[(q * 128 + j) * 2 + 1] = H;
        }
        __syncthreads();
        if (tid < 128) {
            float P = comb[tid * 2], H = comb[tid * 2 + 1];
#pragma unroll
            for (int q = 1; q < 4; ++q) { const float Pq = comb[(q * 128 + tid) * 2], Hq = comb[(q * 128 + tid) * 2 + 1]; H = Pq * H + Hq; P *= Pq; }
            SP[(size_t)tile * D + hd * 128 + tid] = P; SH[(size_t)tile * D + hd * 128 + tid] = H;
        }
    }
}
__device__ __forceinline__ void lru_scan_phase(const Params& p) {
    const int tid = tid_();
    const bf16_t* u = (const bf16_t*)(p.ws + WS_U);
    const bf16_t* Carr = (const bf16_t*)(p.ws + WS_SCR); const bf16_t* Barr = Carr + (size_t)T * D;
    const float* SP = (const float*)(p.ws + WS_LSUM); const float* SH = SP + NBATCH * 32 * D;
    bf16_t* yin = (bf16_t*)(p.ws + WS_YIN);
    const int nunits = NBATCH * 32 * 2;
    for (int un = blockIdx.x; un < nunits; un += gridDim.x) {
        const int tile = un >> 1, c = (un & 1) * 512 + tid, b = tile >> 5, chunk = tile & 31;
        float h = 0.f;
        for (int k = 0; k < chunk; ++k) h = SP[(size_t)(b * 32 + k) * D + c] * h + SH[(size_t)(b * 32 + k) * D + c];
        const size_t tb = (size_t)tile * 64;
#pragma unroll 16
        for (int s_ = 0; s_ < 64; ++s_) {
            const size_t t = tb + s_;
            h = (1.0f - bf2f(Carr[t * D + c])) * h + bf2f(Barr[t * D + c]);
            yin[t * D + c] = f2bf(gelu_fast(bf2f(u[t * 2048 + c])) * h);
        }
    }
}

typedef short s16x4 __attribute__((ext_vector_type(4)));
__device__ __forceinline__ s16x4 tr4(LAS const unsigned char* base, int row0, int col0, int stride, int lane) {
    const int q = (lane & 15) >> 2, pp = lane & 3;
    return __builtin_amdgcn_ds_read_tr16_b64_v4i16((LAS s16x4*)(base + (row0 + q) * stride + (col0 + 4 * pp) * 2));
}
__device__ __forceinline__ bf16x8 cat8(s16x4 a, s16x4 b) { return (bf16x8){a[0], a[1], a[2], a[3], b[0], b[1], b[2], b[3]}; }
__device__ __forceinline__ void ret_core_phase(LAS unsigned char* lds, const Params& p) {
    const int tid0_ = tid_(); const int tid = tid0_, lane = tid & 63, wid = tid >> 6, fr = lane & 15, fq = lane >> 4;
    constexpr int KS = 528, VS = 160, SS = 528;
    LAS unsigned char* Kl = lds;
    LAS unsigned char* Vl = lds + 128 * KS;
    LAS unsigned char* Sl = Vl + 128 * VS;
    const bf16_t* ul_ = (const bf16_t*)(p.ws + WS_U);
    bf16_t* RO = (bf16_t*)(p.ws + WS_SCR);
    for (int un = blockIdx.x; un < NBATCH * 4 * 8; un += gridDim.x) {
        const int b = un >> 5, h = (un >> 3) & 3, vs = un & 7;
        const float lg2 = log2f(1.0f - exp2f(-5.0f - (float)h));
        f32x4 Sacc[2][4];
#pragma unroll
        for (int dt = 0; dt < 2; ++dt)
#pragma unroll
            for (int vt = 0; vt < 4; ++vt) Sacc[dt][vt] = (f32x4){0.f, 0.f, 0.f, 0.f};
        for (int i = tid; i < 64 * SS / 16; i += NTHREADS) ((LAS u32x4*)Sl)[i] = (u32x4){0u, 0u, 0u, 0u};
        u32x4 kraw[8], vraw[2]; bf16x8 Qf[8];
#define RET_LOAD(ch_) do { const size_t tl_ = (size_t)b * SEQ + (ch_) * 128; const bf16_t* u = ul_; int tid = tid0_; asm volatile("" : "+s"(u), "+v"(tid));     \
            _Pragma("unroll") for (int i = 0; i < 8; ++i) { const int piece = tid + NTHREADS * i, m = piece >> 5, ch = piece & 31; kraw[i] = *(const u32x4*)(u + (tl_ + m) * 6144 + 1024 + h * 256 + ch * 8); } \
            _Pragma("unroll") for (int i = 0; i < 2; ++i) { const int piece = tid + NTHREADS * i, m = piece >> 3, ch = piece & 7; vraw[i] = *(const u32x4*)(u + (tl_ + m) * 6144 + 2048 + h * 512 + vs * 64 + ch * 8); } } while (0)
#define RET_LOADQ(ch_) do { const size_t tl_ = (size_t)b * SEQ + (ch_) * 128; const bf16_t* u = ul_; int tid = tid0_; asm volatile("" : "+s"(u), "+v"(tid)); const int wid = tid >> 6, fr = tid & 15, fq = (tid & 63) >> 4; \
            _Pragma("unroll") for (int ks = 0; ks < 8; ++ks) Qf[ks] = *(const bf16x8*)(u + (tl_ + 16 * wid + fr) * 6144 + h * 256 + 32 * ks + 8 * fq); } while (0)
        RET_LOAD(0); RET_LOADQ(0);
        for (int chunk = 0; chunk < 16; ++chunk) {
            const size_t t0 = (size_t)b * SEQ + chunk * 128;
            int tst = tid0_; asm volatile("" : "+v"(tst));
#pragma unroll
            for (int i = 0; i < 8; ++i) {
                const int piece = tst + NTHREADS * i, m = piece >> 5, ch = piece & 31;
                const u32x4 kv = kraw[i];
                const float sc = exp2f(-(float)(m + 1) * lg2) * 0.0625f;
                u32x4 w;
                w.x = pack2(__uint_as_float(kv.x << 16) * sc, __uint_as_float(kv.x & 0xffff0000u) * sc); w.y = pack2(__uint_as_float(kv.y << 16) * sc, __uint_as_float(kv.y & 0xffff0000u) * sc);
                w.z = pack2(__uint_as_float(kv.z << 16) * sc, __uint_as_float(kv.z & 0xffff0000u) * sc); w.w = pack2(__uint_as_float(kv.w << 16) * sc, __uint_as_float(kv.w & 0xffff0000u) * sc);
                *(LAS u32x4*)(Kl + m * KS + ch * 16) = w;
            }
#pragma unroll
            for (int i = 0; i < 2; ++i) {
                const int piece = tst + NTHREADS * i, m = piece >> 3, ch = piece & 7;
                *(LAS u32x4*)(Vl + m * VS + ch * 16) = vraw[i];
            }
            __syncthreads();
            if (chunk + 1 < 16) RET_LOAD(chunk + 1);
            f32x4 sc[8];
#pragma unroll
            for (int mt = 0; mt < 8; ++mt) {
                sc[mt] = (f32x4){0.f, 0.f, 0.f, 0.f};
#pragma unroll
                for (int ks = 0; ks < 8; ++ks) {
                    const bf16x8 kf = *(const LAS bf16x8*)(Kl + (16 * mt + fr) * KS + (32 * ks + 8 * fq) * 2);
                    sc[mt] = __builtin_amdgcn_mfma_f32_16x16x32_bf16(kf, Qf[ks], sc[mt], 0, 0, 0);
                }
                if (mt & 1) __builtin_amdgcn_sched_barrier(0);
            }
            bf16x8 pf[4];
            const int nloc = 16 * wid + fr;
#pragma unroll
            for (int ks2 = 0; ks2 < 4; ++ks2) {
                float v[8];
#pragma unroll
                for (int t = 0; t < 2; ++t)
#pragma unroll
                    for (int r = 0; r < 4; ++r) { const int m = 32 * ks2 + 16 * t + 4 * fq + r; v[4 * t + r] = (m <= nloc) ? sc[2 * ks2 + t][r] : 0.f; }
                u32x4 w; w.x = pack2(v[0], v[1]); w.y = pack2(v[2], v[3]); w.z = pack2(v[4], v[5]); w.w = pack2(v[6], v[7]);
                pf[ks2] = __builtin_bit_cast(bf16x8, w);
            }
            f32x4 O[4];
#pragma unroll
            for (int vt = 0; vt < 4; ++vt) {
                O[vt] = (f32x4){0.f, 0.f, 0.f, 0.f};
#pragma unroll
                for (int ks2 = 0; ks2 < 4; ++ks2) {
                    const bf16x8 vf = cat8(tr4(Vl, 32 * ks2 + 4 * fq, 16 * vt, VS, lane), tr4(Vl, 32 * ks2 + 16 + 4 * fq, 16 * vt, VS, lane));
                    O[vt] = __builtin_amdgcn_mfma_f32_16x16x32_bf16(pf[ks2], vf, O[vt], 0, 0, 0);
                }
#pragma unroll
                for (int ks = 0; ks < 8; ++ks) {
                    const bf16x8 sf = *(const LAS bf16x8*)(Sl + (16 * vt + fr) * SS + (32 * ks + 8 * fq) * 2);
                    O[vt] = __builtin_amdgcn_mfma_f32_16x16x32_bf16(Qf[ks], sf, O[vt], 0, 0, 0);
                }
                __builtin_amdgcn_sched_barrier(0);
            }
#pragma unroll
            for (int r = 0; r < 4; ++r) {
                const int n = 16 * wid + 4 * fq + r;
                const float qd = exp2f((float)(n + 1) * lg2);
                bf16_t* op = RO + (t0 + n) * 2048 + h * 512 + vs * 64 + fr;
#pragma unroll
                for (int vt = 0; vt < 4; ++vt) op[16 * vt] = f2bf(O[vt][r] * qd);
            }
            if (chunk + 1 < 16) RET_LOADQ(chunk + 1);
#pragma unroll
            for (int ks3 = 0; ks3 < 4; ++ks3) {
                bf16x8 kt[2], vf[4];
#pragma unroll
                for (int dt = 0; dt < 2; ++dt) kt[dt] = cat8(tr4(Kl, 32 * ks3 + 8 * fq, 32 * wid + 16 * dt, KS, lane), tr4(Kl, 32 * ks3 + 8 * fq + 4, 32 * wid + 16 * dt, KS, lane));
#pragma unroll
                for (int vt = 0; vt < 4; ++vt) vf[vt] = cat8(tr4(Vl, 32 * ks3 + 8 * fq, 16 * vt, VS, lane), tr4(Vl, 32 * ks3 + 8 * fq + 4, 16 * vt, VS, lane));
#pragma unroll
                for (int dt = 0; dt < 2; ++dt)
#pragma unroll
                    for (int vt = 0; vt < 4; ++vt) Sacc[dt][vt] = __builtin_amdgcn_mfma_f32_16x16x32_bf16(kt[dt], vf[vt], Sacc[dt][vt], 0, 0, 0);
                __builtin_amdgcn_sched_barrier(0);
            }
            __syncthreads();
            const float cd = exp2f(128.0f * lg2);
#pragma unroll
            for (int dt = 0; dt < 2; ++dt)
#pragma unroll
                for (int vt = 0; vt < 4; ++vt) {
                    Sacc[dt][vt] *= cd;
                    u32x2 w; w.x = pack2(Sacc[dt][vt][0], Sacc[dt][vt][1]); w.y = pack2(Sacc[dt][vt][2], Sacc[dt][vt][3]);
                    *(LAS u32x2*)(Sl + (16 * vt + fr) * SS + (32 * wid + 16 * dt + 4 * fq) * 2) = w;
                }
        }
        __syncthreads();
#undef RET_LOAD
#undef RET_LOADQ
    }
}
__device__ __forceinline__ void ret_norm_phase(LAS unsigned char* lds, const Params& p) {
    const int tid = tid_(), lane = tid & 63, wid = tid >> 6;
    LAS float* red = (LAS float*)lds;
    const bf16_t* u = (const bf16_t*)(p.ws + WS_U);
    const bf16_t* RO = (const bf16_t*)(p.ws + WS_SCR);
    bf16_t* yin = (bf16_t*)(p.ws + WS_YIN);
    for (int t = blockIdx.x; t < T; t += gridDim.x) {
        const u32x2 ov = *(const u32x2*)(RO + (size_t)t * 2048 + tid * 4);
        const f32x4 o = (f32x4){__uint_as_float(ov.x << 16), __uint_as_float(ov.x & 0xffff0000u), __uint_as_float(ov.y << 16), __uint_as_float(ov.y & 0xffff0000u)};
        const float ss = wave_sum(o[0] * o[0] + o[1] * o[1] + o[2] * o[2] + o[3] * o[3]);
        if (lane == 0) red[wid] = ss;
        __syncthreads();
        const float tot = red[(wid & ~1)] + red[(wid | 1)];
        const float rstd = rsqrtf(tot * (1.0f / 512.0f) + 1e-6f);
        const u32x2 gv = *(const u32x2*)(u + (size_t)t * 6144 + 4096 + tid * 4);
        const float g0 = __uint_as_float(gv.x << 16), g1 = __uint_as_float(gv.x & 0xffff0000u), g2 = __uint_as_float(gv.y << 16), g3 = __uint_as_float(gv.y & 0xffff0000u);
        u32x2 w; w.x = pack2(g0 * sigmoidf_(g0) * o[0] * rstd, g1 * sigmoidf_(g1) * o[1] * rstd); w.y = pack2(g2 * sigmoidf_(g2) * o[2] * rstd, g3 * sigmoidf_(g3) * o[3] * rstd);
        *(u32x2*)(yin + (size_t)t * 2048 + tid * 4) = w;
        __syncthreads();
    }
}

__device__ __forceinline__ void attn_core_phase(LAS unsigned char* lds, const Params& p) {
    const int tid0_ = tid_(); const int tid = tid0_, lane = tid & 63, wid = tid >> 6, fr = lane & 15, fq = lane >> 4;
    constexpr int RS = 144, TILE = 272 * RS;
    LAS unsigned char* Kl = lds;
    LAS unsigned char* Vl = lds + TILE;
    const bf16_t* u = (const bf16_t*)(p.ws + WS_U);
    bf16_t* OP = (bf16_t*)(p.ws + WS_SCR);
    float* LSE = (float*)(p.ws + WS_SCR + 96 * MB);
    for (int i = tid; i < 16 * RS / 16; i += NTHREADS) { ((LAS u32x4*)(Kl + 256 * RS))[i] = (u32x4){0u, 0u, 0u, 0u}; ((LAS u32x4*)(Vl + 256 * RS))[i] = (u32x4){0u, 0u, 0u, 0u}; }
    u32x4 kraw[4], vraw[4]; bf16x8 Qn[2];
#define ATT_DECODE(un_) const int g = (un_) >> 11, rem = (un_) & 2047, b = rem >> 8, h = (rem >> 4) & 15, x = rem & 15; \
        const int dl = (g == 0) ? 1 : (g == 1 ? 4 : 16), r_ = x & (dl - 1), n = x / dl
#define ATT_LOAD(un_) do { ATT_DECODE(un_); int tl_ = tid0_; const bf16_t* ub = u; asm volatile("" : "+v"(tl_), "+s"(ub)); ub += (size_t)b * SEQ * 9216; \
        _Pragma("unroll") for (int i = 0; i < 4; ++i) { const int piece = tl_ + NTHREADS * i, row = piece >> 3, ch = piece & 7; const int sk = ((n - 1) * 128 + row) * dl + r_; \
            kraw[i] = (u32x4){0u, 0u, 0u, 0u}; vraw[i] = (u32x4){0u, 0u, 0u, 0u}; \
            if (sk >= 0) { const bf16_t* src = ub + (size_t)sk * 9216 + h * 64 + ch * 8; kraw[i] = *(const u32x4*)(src + (3 + g) * 1024); vraw[i] = *(const u32x4*)(src + (6 + g) * 1024); } } \
        { const int sq_ = (n * 128 + 16 * (tl_ >> 6) + (tl_ & 15)) * dl + r_; \
          _Pragma("unroll") for (int ks = 0; ks < 2; ++ks) Qn[ks] = *(const bf16x8*)(ub + (size_t)sq_ * 9216 + g * 1024 + h * 64 + 32 * ks + 8 * ((tl_ & 63) >> 4)); } } while (0)
    if ((int)blockIdx.x < 3 * 2048) ATT_LOAD((int)blockIdx.x);
    for (int un = blockIdx.x; un < 3 * 2048; un += gridDim.x) {
        ATT_DECODE(un);
        const float slope = exp2f(-0.5f * (float)(h + 1)) * (float)dl;
        { int tl_ = tid0_; asm volatile("" : "+v"(tl_));
#pragma unroll
          for (int i = 0; i < 4; ++i) {
            const int piece = tl_ + NTHREADS * i, row = piece >> 3, ch = piece & 7;
            *(LAS u32x4*)(Kl + row * RS + ch * 16) = kraw[i]; *(LAS u32x4*)(Vl + row * RS + ch * 16) = vraw[i];
          } }
        const int qi = 16 * wid + fr, sq = (n * 128 + qi) * dl + r_;
        bf16x8 Qf[2];
#pragma unroll
        for (int ks = 0; ks < 2; ++ks) Qf[ks] = Qn[ks];
        __syncthreads();
        if (un + (int)gridDim.x < 3 * 2048) ATT_LOAD(un + (int)gridDim.x);
        f32x4 sc[9];
        float mx = -INFINITY;
#pragma unroll
        for (int kt = 0; kt < 9; ++kt) {
            sc[kt] = (f32x4){0.f, 0.f, 0.f, 0.f};
#pragma unroll
            for (int ks = 0; ks < 2; ++ks) {
                const bf16x8 kf = *(const LAS bf16x8*)(Kl + (16 * (wid + kt) + fr) * RS + (32 * ks + 8 * fq) * 2);
                sc[kt] = __builtin_amdgcn_mfma_f32_16x16x32_bf16(kf, Qf[ks], sc[kt], 0, 0, 0);
            }
#pragma unroll
            for (int r = 0; r < 4; ++r) {
                const int ki = 16 * (wid + kt) + 4 * fq + r, steps = qi + 128 - ki;
                const bool ok = (steps >= 0) && (steps <= 128) && (n > 0 || ki >= 128);
                const float v = ok ? sc[kt][r] * 0.125f - slope * (float)steps : -INFINITY;
                sc[kt][r] = v; mx = fmaxf(mx, v);
            }
        }
        mx = fmaxf(mx, __shfl_xor(mx, 16)); mx = fmaxf(mx, __shfl_xor(mx, 32));
        float l = 0.f;
#pragma unroll
        for (int kt = 0; kt < 9; ++kt)
#pragma unroll
            for (int r = 0; r < 4; ++r) { const float pv = __expf(sc[kt][r] - mx); sc[kt][r] = pv; l += pv; }
        l += __shfl_xor(l, 16); l += __shfl_xor(l, 32);
        f32x4 O[4];
#pragma unroll
        for (int dt = 0; dt < 4; ++dt) O[dt] = (f32x4){0.f, 0.f, 0.f, 0.f};
#pragma unroll
        for (int ks5 = 0; ks5 < 5; ++ks5) {
            const f32x4 p0 = sc[2 * ks5], p1 = (ks5 < 4) ? sc[(ks5 < 4) ? 2 * ks5 + 1 : 0] : (f32x4){0.f, 0.f, 0.f, 0.f};
            u32x4 w; w.x = pack2(p0[0], p0[1]); w.y = pack2(p0[2], p0[3]); w.z = pack2(p1[0], p1[1]); w.w = pack2(p1[2], p1[3]);
            const bf16x8 pf = __builtin_bit_cast(bf16x8, w);
#pragma unroll
            for (int dt = 0; dt < 4; ++dt) {
                const bf16x8 vf = cat8(tr4(Vl, 16 * (wid + 2 * ks5) + 4 * fq, 16 * dt, RS, lane), tr4(Vl, 16 * (wid + 2 * ks5 + 1) + 4 * fq, 16 * dt, RS, lane));
                O[dt] = __builtin_amdgcn_mfma_f32_16x16x32_bf16(vf, pf, O[dt], 0, 0, 0);
            }
        }
        const float inv = __builtin_amdgcn_rcpf(l);
        const size_t tq = (size_t)b * SEQ + sq;
#pragma unroll
        for (int dt = 0; dt < 4; ++dt) {
            u32x2 w; w.x = pack2(O[dt][0] * inv, O[dt][1] * inv); w.y = pack2(O[dt][2] * inv, O[dt][3] * inv);
            *(u32x2*)(OP + ((size_t)g * T + tq) * D + h * 64 + 16 * dt + 4 * fq) = w;
        }
        if (fq == 0) LSE[((size_t)g * T + tq) * 16 + h] = mx + __logf(l);
        __syncthreads();
    }
#undef ATT_DECODE
#undef ATT_LOAD
}
__device__ __forceinline__ void attn_merge_phase(const Params& p) {
    const int tid = tid_();
    const bf16_t* OP = (const bf16_t*)(p.ws + WS_SCR);
    const float* LSE = (const float*)(p.ws + WS_SCR + 96 * MB);
    bf16_t* yin = (bf16_t*)(p.ws + WS_YIN);
    for (size_t i = (size_t)blockIdx.x * NTHREADS + tid; i < (size_t)T * D / 8; i += (size_t)gridDim.x * NTHREADS) {
        const size_t t = i >> 7; const int c8 = (int)(i & 127), h = c8 >> 3;
        const float l0 = LSE[t * 16 + h], l1 = LSE[((size_t)T + t) * 16 + h], l2 = LSE[((size_t)2 * T + t) * 16 + h];
        const float m = fmaxf(l0, fmaxf(l1, l2));
        float w0 = __expf(l0 - m), w1 = __expf(l1 - m), w2 = __expf(l2 - m);
        const float inv = 1.0f / (w0 + w1 + w2); w0 *= inv; w1 *= inv; w2 *= inv;
        const u32x4 a = *(const u32x4*)(OP + t * D + c8 * 8), bq = *(const u32x4*)(OP + ((size_t)T + t) * D + c8 * 8), c = *(const u32x4*)(OP + ((size_t)2 * T + t) * D + c8 * 8);
        u32x4 o;
#define MRG(f) o.f = pack2(w0 * __uint_as_float(a.f << 16) + w1 * __uint_as_float(bq.f << 16) + w2 * __uint_as_float(c.f << 16), \
                           w0 * __uint_as_float(a.f & 0xffff0000u) + w1 * __uint_as_float(bq.f & 0xffff0000u) + w2 * __uint_as_float(c.f & 0xffff0000u))
        MRG(x); MRG(y); MRG(z); MRG(w);
#undef MRG
        *(u32x4*)(yin + t * D + c8 * 8) = o;
    }
}

__device__ __forceinline__ void ln1_router_phase(LAS unsigned char* lds, const Params& p, int layer) {
    const int tid = tid_(), lane = tid & 63, wid = tid >> 6, fr = lane & 15, fq = lane >> 4;
    constexpr int XS = 2064;
    LAS unsigned char* xh = lds;
    LAS unsigned char* xl = lds + 16 * XS;
    LAS float* part = (LAS float*)(lds + 32 * XS);
    LAS float* logit = part + 8 * 16 * 32;
    LAS int* tkE = (LAS int*)(logit + 16 * 32);
    LAS int* tkR = tkE + 512;
    LAS int* hist = tkR + 512;
    LAS int* hbase = hist + 32;
    float* xf = (float*)(p.ws + WS_XF); bf16_t* xb = (bf16_t*)(p.ws + WS_XB);
    const bf16_t* ymix = (const bf16_t*)(p.ws + WS_YMIX);
    int* tope = (int*)(p.ws + WS_TOPE); float* gates = (float*)(p.ws + WS_GATES); int* pos = (int*)(p.ws + WS_POS);
    unsigned char* xq = p.ws + WS_XQ; int* elist = (int*)(p.ws + WS_LIST);
    unsigned* ctl = (unsigned*)(p.ws + WS_CTL);
    const float* gain = p.ln_gain + (size_t)(layer * 2) * D; const float* bias = p.ln_bias + (size_t)(layer * 2) * D;
    const float* brt = p.moe_b_router + (size_t)layer * NEXP;
    const bf16_t* rth = (const bf16_t*)(p.ws + WS_RT) + (size_t)layer * 2 * NEXP * D; const bf16_t* rtl = rth + NEXP * D;
    bf16x8 Wh[2][4], Wl[2][4];
#pragma unroll
    for (int nt = 0; nt < 2; ++nt)
#pragma unroll
        for (int ks = 0; ks < 4; ++ks) { const size_t o = (size_t)(16 * nt + fr) * D + 128 * wid + 32 * ks + 8 * fq; Wh[nt][ks] = *(const bf16x8*)(rth + o); Wl[nt][ks] = *(const bf16x8*)(rtl + o); }
    if (tid < NEXP) hist[tid] = 0;
    int it = 0;
    for (int tile = blockIdx.x; tile < T / 16; tile += gridDim.x) {
#pragma unroll
        for (int tt = 0; tt < 2; ++tt) {
            const int trow = 2 * wid + tt; const size_t t = (size_t)tile * 16 + trow;
            f32x4 z[4];
#pragma unroll
            for (int i = 0; i < 4; ++i) { const int c = 256 * i + 4 * lane; const u32x2 yv = *(const u32x2*)(ymix + t * D + c);
                z[i] = DN_ALPHA * *(const f32x4*)(xf + t * D + c) + (f32x4){__uint_as_float(yv.x << 16), __uint_as_float(yv.x & 0xffff0000u), __uint_as_float(yv.y << 16), __uint_as_float(yv.y & 0xffff0000u)}; }
            float sm = 0.f;
#pragma unroll
            for (int i = 0; i < 4; ++i) sm += (z[i][0] + z[i][1]) + (z[i][2] + z[i][3]);
            const float mean = wave_sum(sm) * (1.0f / D);
            float sq = 0.f;
#pragma unroll
            for (int i = 0; i < 4; ++i) { const f32x4 dd = z[i] - mean; sq += (dd[0] * dd[0] + dd[1] * dd[1]) + (dd[2] * dd[2] + dd[3] * dd[3]); }
            const float rstd = rsqrtf(wave_sum(sq) * (1.0f / D) + LN_EPS);
#pragma unroll
            for (int i = 0; i < 4; ++i) {
                const int c = 256 * i + 4 * lane;
                const f32x4 v = (z[i] - mean) * rstd * *(const f32x4*)(gain + c) + *(const f32x4*)(bias + c);
                *(f32x4*)(xf + t * D + c) = v;
                u32x2 wh; wh.x = pack2(v[0], v[1]); wh.y = pack2(v[2], v[3]);
                *(unsigned*)(xq + t * D + c) = pk_fp8x4(v[0], v[1], v[2], v[3]);
                const float r0 = v[0] - __uint_as_float(wh.x << 16), r1 = v[1] - __uint_as_float(wh.x & 0xffff0000u), r2 = v[2] - __uint_as_float(wh.y << 16), r3 = v[3] - __uint_as_float(wh.y & 0xffff0000u);
                u32x2 wl; wl.x = pack2(r0, r1); wl.y = pack2(r2, r3);
                *(LAS u32x2*)(xh + trow * XS + c * 2) = wh; *(LAS u32x2*)(xl + trow * XS + c * 2) = wl;
            }
        }
        __syncthreads();
        {
            f32x4 acc[2] = {(f32x4){0.f, 0.f, 0.f, 0.f}, (f32x4){0.f, 0.f, 0.f, 0.f}};
#pragma unroll
            for (int ks = 0; ks < 4; ++ks) {
                const bf16x8 ah = *(const LAS bf16x8*)(xh + fr * XS + (128 * wid + 32 * ks + 8 * fq) * 2), al = *(const LAS bf16x8*)(xl + fr * XS + (128 * wid + 32 * ks + 8 * fq) * 2);
#pragma unroll
                for (int nt = 0; nt < 2; ++nt) {
                    acc[nt] = __builtin_amdgcn_mfma_f32_16x16x32_bf16(Wh[nt][ks], ah, acc[nt], 0, 0, 0);
                    acc[nt] = __builtin_amdgcn_mfma_f32_16x16x32_bf16(Wh[nt][ks], al, acc[nt], 0, 0, 0);
                    acc[nt] = __builtin_amdgcn_mfma_f32_16x16x32_bf16(Wl[nt][ks], ah, acc[nt], 0, 0, 0);
                }
            }
#pragma unroll
            for (int nt = 0; nt < 2; ++nt) *(LAS f32x4*)(part + (wid * 16 + fr) * 32 + 16 * nt + 4 * fq) = acc[nt];
        }
        __syncthreads();
        {
            const int tk = tid >> 5, e = tid & 31;
            float sacc = brt[e];
#pragma unroll
            for (int w = 0; w < 8; ++w) sacc += part[(w * 16 + tk) * 32 + e];
            logit[tk * 32 + e] = sacc;
        }
        __syncthreads();
        if (tid < 16) {
            const size_t t = (size_t)tile * 16 + tid;
            float v0 = -INFINITY, v1 = -INFINITY, v2 = -INFINITY, v3 = -INFINITY; int i0 = 0, i1 = 0, i2 = 0, i3 = 0;
#pragma unroll
            for (int e = 0; e < NEXP; ++e) {
                const float v = logit[tid * 32 + e];
                if (v > v3) {
                    if (v > v0) { v3 = v2; i3 = i2; v2 = v1; i2 = i1; v1 = v0; i1 = i0; v0 = v; i0 = e; }
                    else if (v > v1) { v3 = v2; i3 = i2; v2 = v1; i2 = i1; v1 = v; i1 = e; }
                    else if (v > v2) { v3 = v2; i3 = i2; v2 = v; i2 = e; }
                    else { v3 = v; i3 = e; }
                }
            }
            const float e1 = __expf(v1 - v0), e2 = __expf(v2 - v0), e3 = __expf(v3 - v0), inv = 1.0f / (1.0f + e1 + e2 + e3);
            tope[t * 4 + 0] = i0; tope[t * 4 + 1] = i1; tope[t * 4 + 2] = i2; tope[t * 4 + 3] = i3;
            gates[t * 4 + 0] = inv; gates[t * 4 + 1] = e1 * inv; gates[t * 4 + 2] = e2 * inv; gates[t * 4 + 3] = e3 * inv;
            const int sl = (it & 7) * 16 + tid;
            tkE[sl * 4 + 0] = i0; tkR[sl * 4 + 0] = (int)atomicAdd((unsigned*)(hist + i0), 1u);
            tkE[sl * 4 + 1] = i1; tkR[sl * 4 + 1] = (int)atomicAdd((unsigned*)(hist + i1), 1u);
            tkE[sl * 4 + 2] = i2; tkR[sl * 4 + 2] = (int)atomicAdd((unsigned*)(hist + i2), 1u);
            tkE[sl * 4 + 3] = i3; tkR[sl * 4 + 3] = (int)atomicAdd((unsigned*)(hist + i3), 1u);
        }
        ++it;
        if ((it & 7) == 0 || tile + (int)gridDim.x >= T / 16) {
            __syncthreads();
            if (tid < NEXP) { const unsigned h = (unsigned)hist[tid]; hbase[tid] = h ? (int)atomicAdd(ctl + CW_CNT + layer * 64 + tid, h) : 0; hist[tid] = 0; }
            __syncthreads();
            const int nsl = (((it - 1) & 7) + 1) * 16;
            for (int a = tid; a < nsl * 4; a += NTHREADS) {
                const int sl = a >> 2, e = tkE[a], ps = hbase[e] + tkR[a];
                const int t = (tile - (((it - 1) & 7) - (sl >> 4)) * (int)gridDim.x) * 16 + (sl & 15);
                pos[t * 4 + (a & 3)] = ps; elist[(size_t)e * T + ps] = t;
            }
            __syncthreads();
        }
    }
    __syncthreads();
}
__device__ __forceinline__ void ln2_phase(LAS unsigned char* lds, const Params& p, int layer) {
    const int tid = tid_(), lane = tid & 63, wid = tid >> 6;
    moe_tables(lds, (const unsigned*)(p.ws + WS_CTL), layer);
    LAS const int* tab = (LAS const int*)(lds + TAB_OFF);
    const int* tope = (const int*)(p.ws + WS_TOPE); const int* pos = (const int*)(p.ws + WS_POS);
    float* xf = (float*)(p.ws + WS_XF); bf16_t* xb = (bf16_t*)(p.ws + WS_XB);
    const bf16_t* yrows = (const bf16_t*)(p.ws + WS_YROWS);
    const float* gates = (const float*)(p.ws + WS_GATES);
    const float* gain = p.ln_gain + (size_t)(layer * 2 + 1) * D; const float* bias = p.ln_bias + (size_t)(layer * 2 + 1) * D;
    for (int t = blockIdx.x * 8 + wid; t < T; t += gridDim.x * 8) {
        f32x4 z[4];
        int dk[4]; float gk[4];
#pragma unroll
        for (int k = 0; k < 4; ++k) { dk[k] = tab[tope[t * 4 + k]] * 256 + pos[t * 4 + k]; gk[k] = gates[t * 4 + k]; }
#pragma unroll
        for (int i = 0; i < 4; ++i) {
            const int c = 256 * i + 4 * lane;
            f32x4 f = (f32x4){0.f, 0.f, 0.f, 0.f};
#pragma unroll
            for (int k = 0; k < 4; ++k) { const u32x2 yv = *(const u32x2*)(yrows + (size_t)dk[k] * D + c);
                f[0] += gk[k] * __uint_as_float(yv.x << 16); f[1] += gk[k] * __uint_as_float(yv.x & 0xffff0000u); f[2] += gk[k] * __uint_as_float(yv.y << 16); f[3] += gk[k] * __uint_as_float(yv.y & 0xffff0000u); }
            z[i] = DN_ALPHA * *(const f32x4*)(xf + (size_t)t * D + c) + f;
        }
        float sm = 0.f;
#pragma unroll
        for (int i = 0; i < 4; ++i) sm += (z[i][0] + z[i][1]) + (z[i][2] + z[i][3]);
        const float mean = wave_sum(sm) * (1.0f / D);
        float sq = 0.f;
#pragma unroll
        for (int i = 0; i < 4; ++i) { const f32x4 dd = z[i] - mean; sq += (dd[0] * dd[0] + dd[1] * dd[1]) + (dd[2] * dd[2] + dd[3] * dd[3]); }
        const float rstd = rsqrtf(wave_sum(sq) * (1.0f / D) + LN_EPS);
#pragma unroll
        for (int i = 0; i < 4; ++i) {
            const int c = 256 * i + 4 * lane;
            z[i] = (z[i] - mean) * rstd * *(const f32x4*)(gain + c) + *(const f32x4*)(bias + c);
            if (layer == DEPTH - 1) *(f32x4*)(p.out + (size_t)t * D + c) = z[i];
            else { *(f32x4*)(xf + (size_t)t * D + c) = z[i]; *(unsigned*)(p.ws + WS_XQ + (size_t)t * D + c) = pk_fp8x4(z[i][0], z[i][1], z[i][2], z[i][3]); }
        }
    }
}

__device__ __forceinline__ void moe_scatter_phase(LAS unsigned char* lds, const Params& p, int layer) {
    const int tid = tid_();
    LAS int* pstart = (LAS int*)lds;
    unsigned* ctl = (unsigned*)(p.ws + WS_CTL);
    const int* tope = (const int*)(p.ws + WS_TOPE); const int* pos = (const int*)(p.ws + WS_POS);
    int* dest = (int*)(p.ws + WS_DEST); int* rowtok = (int*)(p.ws + WS_ROWTOK);
    if (tid == 0) {
        int acc = 0;
        for (int e = 0; e < NEXP; ++e) { const int c = (int)ctl[CW_CNT + layer * 64 + e]; pstart[e] = acc; pstart[32 + e] = c; acc += ((c + 255) >> 8) << 8; }
        pstart[64] = acc;
        if (blockIdx.x == 0) {
            ctl[CW_MDYN + layer * 64] = (unsigned)acc;
            for (int e = 0; e < NEXP; ++e) { const int nb = (pstart[32 + e] + 255) >> 8; for (int b = 0; b < nb; ++b) ctl[CW_TEXP + layer * 512 + (pstart[e] >> 8) + b] = (unsigned)e; }
        }
    }
    __syncthreads();
    for (int i = blockIdx.x * NTHREADS + tid; i < T * TOPK; i += gridDim.x * NTHREADS) {
        const int e = tope[i], row = pstart[e] + pos[i];
        dest[i] = row; rowtok[row] = i >> 2;
    }
    for (int i = blockIdx.x * NTHREADS + tid; i < NEXP * 256; i += gridDim.x * NTHREADS) {
        const int e = i >> 8, r = i & 255, c = pstart[32 + e], padded = ((c + 255) >> 8) << 8;
        if (c + r < padded) rowtok[pstart[e] + c + r] = 0;
    }
    __syncthreads();
}

constexpr int PH_PER_LAYER = 9;
constexpr int NPHASES = 1 + DEPTH * PH_PER_LAYER;
constexpr int LDS_BYTES = 132 * 1024;


#ifndef PHMASK
#define PHMASK 0x3FF
#endif
#define PHK(j) ((PHMASK >> (j)) & 1)
#ifndef PROBE_MASK
#define PROBE_MASK 0
#endif
#ifndef PROBE_LAYERS
#define PROBE_LAYERS 0xF
#endif
#define REPS(j) ((((PROBE_MASK) >> (j)) & 1) ? 2 : 1)
#define REPSL(j) (((((PROBE_MASK) >> (j)) & 1) && (((PROBE_LAYERS) >> layer) & 1)) ? 2 : 1)
#define IN(k) (lo <= (k) && (k) < hi)
#if MK_ONE_LAUNCH
#define SEAM(k) do { if (IN(k) && IN((k) + 1)) xcd_barrier_nv(bar.bar, bar.x, bar.st); } while (0)
#else
#define SEAM(k) do {} while (0)
#endif
template <int layer>
__device__ __forceinline__ void run_layer(const Params& p, LAS unsigned char* lds, const XcdBarrier& bar) {
    const int lo = p.ph_lo, hi = p.ph_hi;
    unsigned char* ws = p.ws;
    unsigned* ctl = (unsigned*)(ws + WS_CTL);
        constexpr int base = 1 + layer * PH_PER_LAYER, kind = layer % 3, idx = layer / 3;
        for (int rep_ = 0; rep_ < REPSL(1); ++rep_) if (PHK(1) && IN(base + 0)) {
            constexpr int N = (kind == 0) ? 2048 : (kind == 1 ? 6144 : 9216);
            const unsigned char* Bt = (kind == 0) ? ws + WS_AWIN + (size_t)idx * 2048 * D : (kind == 1 ? ws + WS_BWIN : ws + WS_CWIN);
            g8::SchedPlain S; S.init(ws + WS_XQ, Bt, T, N, D / 2, (int)gridDim.x, (int)blockIdx.x);
            g8::EpiBf16 E{(bf16_t*)(ws + WS_U), N, nullptr, 0, 1.0f / GU_WSCALE};
            g8::gemm_phase<g8::EpiBf16, g8::SchedPlain, false, 1>(lds, D, S, E);
        }
        SEAM(base + 0);
        for (int rep_ = 0; rep_ < REPSL(2); ++rep_) if (PHK(2) && IN(base + 1)) {
            if (kind == 0) lru_gates_phase(lds, p, idx);
            else if (kind == 1) ret_core_phase(lds, p);
            else attn_core_phase(lds, p);
        }
        SEAM(base + 1);
        for (int rep_ = 0; rep_ < REPSL(3); ++rep_) if (PHK(3) && IN(base + 2)) {
            if (kind == 0) lru_scan_phase(p);
            else if (kind == 1) ret_norm_phase(lds, p);
            else attn_merge_phase(p);
        }
        SEAM(base + 2);
        for (int rep_ = 0; rep_ < REPSL(4); ++rep_) if (PHK(4) && IN(base + 3)) {
            constexpr int K = (kind == 1) ? 2048 : D;
            const bf16_t* Bt = (kind == 0) ? (const bf16_t*)(ws + WS_AWOUT) + (size_t)idx * D * D : (kind == 1 ? (const bf16_t*)(ws + WS_BWOUT) : (const bf16_t*)(ws + WS_CWOUT));
            g8::SchedPlain S; S.init(ws + WS_YIN, Bt, T, D, K, (int)gridDim.x, (int)blockIdx.x);
            g8::EpiBf16 E{(bf16_t*)(ws + WS_YMIX), D, nullptr, 0, 1.0f};
            g8::gemm_phase<g8::EpiBf16, g8::SchedPlain, false>(lds, K, S, E);
        }
        SEAM(base + 3);
        for (int rep_ = 0; rep_ < REPSL(5); ++rep_) if (PHK(5) && IN(base + 4)) ln1_router_phase(lds, p, layer);
        SEAM(base + 4);
        for (int rep_ = 0; rep_ < REPSL(7); ++rep_) if (PHK(7) && IN(base + 6)) {
            moe_tables(lds, ctl, layer);
            g8::SchedGU S{(const char*)(ws + WS_XQ), (const char*)(ws + WS_GU) + (size_t)layer * NEXP * 2048 * D, (const int*)(ws + WS_LIST), (LAS const int*)(lds + TAB_OFF), (int)gridDim.x, (int)blockIdx.x};
            g8::EpiSwiglu E{ws + WS_HID, p.moe_b_gu + (size_t)layer * NEXP * 2048, 1.0f / GU_WSCALE};
            g8::gemm_phase<g8::EpiSwiglu, g8::SchedGU, true, 1>(lds, D, S, E);
        }
        SEAM(base + 6);
        for (int rep_ = 0; rep_ < REPSL(8); ++rep_) if (PHK(8) && IN(base + 7)) {
            moe_tables(lds, ctl, layer);
            g8::SchedDown S{(const char*)(ws + WS_HID), (const char*)(ws + WS_DN) + (size_t)layer * NEXP * D * D, (LAS const int*)(lds + TAB_OFF), (int)gridDim.x, (int)blockIdx.x};
            g8::EpiBf16 E{(bf16_t*)(ws + WS_YROWS), D, p.moe_b_down + (size_t)layer * NEXP * D, D, 1.0f / DN_WSCALE};
            g8::gemm_phase<g8::EpiBf16, g8::SchedDown, false, 1>(lds, D, S, E);
        }
        SEAM(base + 7);
        for (int rep_ = 0; rep_ < REPSL(9); ++rep_) if (PHK(9) && IN(base + 8)) ln2_phase(lds, p, layer);
        SEAM(base + 8);
    }
#undef IN
#undef SEAM
__global__ void __launch_bounds__(NTHREADS, 2) fwd_kernel(Params p) {
    extern __shared__ __attribute__((aligned(16))) unsigned char lds_raw[];
    LAS unsigned char* lds = (LAS unsigned char*)lds_raw;
    const int lo = p.ph_lo, hi = p.ph_hi;
    unsigned char* ws = p.ws;
    unsigned* ctl = (unsigned*)(ws + WS_CTL);
#if MK_ONE_LAUNCH
    volatile LAS unsigned* bst = (volatile LAS unsigned*)(lds + LDS_BYTES - 16);
    if (threadIdx.x == 0) { bst[0] = 0u; bst[1] = 0u; bst[2] = 0u; bst[3] = 0u; }
    __syncthreads();
    XcdBarrier bar = xcd_barrier_post(ctl, bst);
#define GRID_BAR() xcd_barrier_nv(bar.bar, bar.x, bar.st)
#else
    XcdBarrier bar; bar.bar = ctl; bar.x = 0; bar.st = nullptr;
#define GRID_BAR() do {} while (0)
#endif
#define IN(k) (lo <= (k) && (k) < hi)
#define SEAM(k) do { if (IN(k) && IN((k) + 1)) GRID_BAR(); } while (0)

    for (int rep_ = 0; rep_ < REPS(0); ++rep_) if (PHK(0) && IN(0)) {
        LAS float* tile = (LAS float*)lds;
#pragma unroll 1
        for (int j = 0; j < 5; ++j) {
            const float* src = j == 0 ? p.moe_w_gu : (j == 1 ? p.moe_w_down : (j == 2 ? p.a_w_in : (j == 3 ? p.b_w_in : p.c_w_in)));
            const size_t dsto = j == 0 ? WS_GU : (j == 1 ? WS_DN : (j == 2 ? WS_AWIN : (j == 3 ? WS_BWIN : WS_CWIN)));
            const int N = j == 0 ? 2048 : (j == 1 ? D : (j == 2 ? 2048 : (j == 3 ? 6144 : 9216)));
            const int batch = j < 2 ? DEPTH * NEXP : (j == 2 ? 2 : 1);
            convert_big<true>(lds, src, ws + dsto, D, N, batch, j == 1 ? DN_WSCALE : GU_WSCALE);
        }
#pragma unroll 1
        for (int j = 0; j < 3; ++j) {
            const float* src = j == 0 ? p.a_w_out : (j == 1 ? p.b_w_out : p.c_w_out);
            const size_t dsto = j == 0 ? WS_AWOUT : (j == 1 ? WS_BWOUT : WS_CWOUT);
            convert_big<false>(lds, src, ws + dsto, j == 1 ? 2048 : D, D, j == 0 ? 2 : 1, 1.0f);
        }
        convert_job(tile, p.a_w_rgate, (bf16_t*)(ws + WS_AGT), 128, 128, 8);
        convert_job(tile, p.a_w_igate, (bf16_t*)(ws + WS_AGT) + (size_t)8 * 128 * 128, 128, 128, 8);
        convert_job(tile, p.a_w_rgate + (size_t)8 * 128 * 128, (bf16_t*)(ws + WS_AGT) + (size_t)16 * 128 * 128, 128, 128, 8);
        convert_job(tile, p.a_w_igate + (size_t)8 * 128 * 128, (bf16_t*)(ws + WS_AGT) + (size_t)24 * 128 * 128, 128, 128, 8);
        {
            bf16_t* rt = (bf16_t*)(ws + WS_RT);
            for (int i = blockIdx.x * NTHREADS + threadIdx.x; i < DEPTH * NEXP * D; i += gridDim.x * NTHREADS) {
                const int l = i / (NEXP * D), r_ = i % (NEXP * D), e = r_ / D, k = r_ % D;
                const float w = p.moe_w_router[((size_t)l * D + k) * NEXP + e];
                const bf16_t hi = f2bf(w); const bf16_t lo = f2bf(w - bf2f(hi));
                rt[((size_t)l * 2 + 0) * NEXP * D + (size_t)e * D + k] = hi; rt[((size_t)l * 2 + 1) * NEXP * D + (size_t)e * D + k] = lo;
            }
        }
        float* xf = (float*)(ws + WS_XF); bf16_t* xb = (bf16_t*)(ws + WS_XB);
        {
            const size_t stride = (size_t)gridDim.x * NTHREADS;
            for (size_t i = (size_t)blockIdx.x * NTHREADS + threadIdx.x; i < (size_t)T * D / 4; i += 4 * stride) {
                f32x4 v[4];
#pragma unroll
                for (int q = 0; q < 4; ++q) v[q] = *(const f32x4*)(p.x + (i + q * stride) * 4);
#pragma unroll
                for (int q = 0; q < 4; ++q) { *(f32x4*)(xf + (i + q * stride) * 4) = v[q]; *(unsigned*)(ws + WS_XQ + (i + q * stride) * 4) = pk_fp8x4(v[q][0], v[q][1], v[q][2], v[q][3]); }
            }
        }
    }
    SEAM(0);

    run_layer<0>(p, lds, bar); run_layer<1>(p, lds, bar); run_layer<2>(p, lds, bar); run_layer<3>(p, lds, bar);
#undef IN
#undef SEAM
}

extern "C" void kernel_launch(void* const* d_in, const int* in_sizes, int n_in, void* d_out, int out_size, void* d_ws, size_t ws_size, hipStream_t stream) {
    static int grid = 0;
    if (grid == 0) {
        if (n_in != 22 || out_size != T * D || ws_size < WS_END) { fprintf(stderr, "kernel_launch: unexpected shapes (n_in %d out %d ws %zu need %zu)\n", n_in, out_size, ws_size, (size_t)WS_END); grid = -1; return; }
        if (hipFuncSetAttribute((const void*)fwd_kernel, hipFuncAttributeMaxDynamicSharedMemorySize, LDS_BYTES) != hipSuccess) { fprintf(stderr, "kernel_launch: hipFuncSetAttribute failed\n"); grid = -1; return; }
        int dev = 0, cus = 0;
        if (hipGetDevice(&dev) != hipSuccess || hipDeviceGetAttribute(&cus, hipDeviceAttributeMultiprocessorCount, dev) != hipSuccess) { grid = -1; return; }
        grid = cus;
    }
    if (grid < 0) return;
    (void)hipMemsetAsync((char*)d_ws + WS_CTL, 0, CTL_BYTES, stream);
    Params p{};
    const float** pp = (const float**)&p;
    for (int i = 0; i < 22; ++i) pp[i] = (const float*)d_in[i];
    p.out = (float*)d_out; p.ws = (unsigned char*)d_ws;
#if MK_ONE_LAUNCH
    p.ph_lo = 0; p.ph_hi = NPHASES;
    hipLaunchKernelGGL(fwd_kernel, dim3(grid), dim3(NTHREADS), LDS_BYTES, stream, p);
#else
    for (int ph = 0; ph < NPHASES; ++ph) {
        p.ph_lo = ph; p.ph_hi = ph + 1;
        hipLaunchKernelGGL(fwd_kernel, dim3(grid), dim3(NTHREADS), LDS_BYTES, stream, p);
    }
#endif
}
```

```cpp
#include <hip/hip_runtime.h>
#include <stdint.h>
#include <stdio.h>

#ifndef MK_ONE_LAUNCH
#define MK_ONE_LAUNCH 1
#endif

#define LAS __attribute__((address_space(3)))
typedef unsigned short bf16_t;
typedef short bf16x8 __attribute__((ext_vector_type(8)));
typedef float f32x4 __attribute__((ext_vector_type(4)));
typedef unsigned u32x4 __attribute__((ext_vector_type(4)));
typedef unsigned u32x2 __attribute__((ext_vector_type(2)));

constexpr int T = 16384, D = 1024, SEQ = 2048, NBATCH = 8, DEPTH = 4;
constexpr int NEXP = 32, TOPK = 4;
constexpr int MAXROWS = 73728;
constexpr float DN_ALPHA = 1.681792830507429f;
constexpr float LN_EPS = 1e-5f;
constexpr float GU_WSCALE = 64.0f, DN_WSCALE = 128.0f;
constexpr int NTHREADS = 512;

constexpr size_t MB = 1ull << 20;
constexpr size_t WS_CTL = 0;
constexpr size_t CTL_BYTES = 65536;
constexpr size_t WS_AWIN = 1 * MB;
constexpr size_t WS_AWOUT = WS_AWIN + 8 * MB;
constexpr size_t WS_BWIN = WS_AWOUT + 4 * MB;
constexpr size_t WS_BWOUT = WS_BWIN + 12 * MB;
constexpr size_t WS_CWIN = WS_BWOUT + 4 * MB;
constexpr size_t WS_CWOUT = WS_CWIN + 18 * MB;
constexpr size_t WS_GU = WS_CWOUT + 2 * MB;
constexpr size_t WS_DN = WS_GU + 512 * MB;
constexpr size_t WS_XF = WS_DN + 256 * MB;
constexpr size_t WS_XB = WS_XF + 64 * MB;
constexpr size_t WS_U = WS_XB + 32 * MB;
constexpr size_t WS_YIN = WS_U + 288 * MB;
constexpr size_t WS_YMIX = WS_YIN + 64 * MB;
constexpr size_t WS_SCR = WS_YMIX + 64 * MB;
constexpr size_t WS_TOPE = WS_SCR + 128 * MB;
constexpr size_t WS_GATES = WS_TOPE + 256 * 1024;
constexpr size_t WS_POS = WS_GATES + 256 * 1024;
constexpr size_t WS_DEST = WS_POS + 256 * 1024;
constexpr size_t WS_ROWTOK = WS_DEST + 256 * 1024;
constexpr size_t WS_HID = WS_ROWTOK + 1 * MB;
constexpr size_t WS_YROWS = WS_HID + 144 * MB;
constexpr size_t WS_LSUM = WS_YROWS + 288 * MB;
constexpr size_t WS_AGT = WS_LSUM + 2 * MB;
constexpr size_t WS_RT = WS_AGT + 1 * MB;
constexpr size_t WS_XQ = WS_RT + 1 * MB;
constexpr size_t WS_LIST = WS_XQ + 16 * MB;
constexpr size_t WS_END = WS_LIST + 2 * MB;

constexpr int CW_CNT = 4096;
constexpr int CW_MDYN = 8192;
constexpr int CW_TEXP = 12288;

#define XB_TMO      128
#define XB_XCNT(j)  (256  + 64 * (j))
#define XB_XSUB(j)  (1280 + 64 * (j))
#define XB_XGEN(j)  (2304 + 64 * (j))
#define XB_TOP      3328
#define XB_TOPGEN   3392
#define XCD_BAR_WORDS 3456
#define XB_SPIN_CAP (1u << 22)

__device__ __forceinline__ unsigned xb_ld(unsigned* p)              { return __hip_atomic_load(p, __ATOMIC_RELAXED, __HIP_MEMORY_SCOPE_AGENT); }
__device__ __forceinline__ unsigned xb_add(unsigned* p, unsigned v) { return __hip_atomic_fetch_add(p, v, __ATOMIC_RELAXED, __HIP_MEMORY_SCOPE_AGENT); }
__device__ __forceinline__ unsigned xb_xcc_id() { return (unsigned)__builtin_amdgcn_s_getreg((3 << 11) | 20) & 0xFu; }
#define XB_SPIN(cond, bar) do { unsigned _sp = 0; while (cond) { __builtin_amdgcn_s_sleep(1); \
    if ((++_sp & 255u) == 0u) { if (xb_ld(&(bar)[XB_TMO])) break; if (_sp > XB_SPIN_CAP) { atomicAdd(&(bar)[XB_TMO], 1u); break; } } } } while (0)

struct XcdBarrier { unsigned* bar; unsigned x; volatile LAS unsigned* st; };

__device__ __forceinline__ XcdBarrier xcd_barrier_post(unsigned* bar, volatile LAS unsigned* st) {
    XcdBarrier b; b.bar = bar; b.x = xb_xcc_id(); b.st = st;
    if (threadIdx.x == 0) (void)xb_add(&bar[XB_XCNT(b.x)], 1u);
    return b;
}
__device__ __forceinline__ void xcd_barrier_complete(unsigned* bar, unsigned x, unsigned& nloc, unsigned& nx) {
    const unsigned G = gridDim.x * gridDim.y * gridDim.z;
    unsigned sum, cnt, mine, sp = 0u;
    for (;;) {
        sum = 0u; cnt = 0u; mine = 0u;
#pragma unroll
        for (unsigned j = 0; j < 16; ++j) { const unsigned c = xb_ld(&bar[XB_XCNT(j)]); sum += c; cnt += (c > 0u) ? 1u : 0u; mine = (j == x) ? c : mine; }
        if (sum == G) break;
        __builtin_amdgcn_s_sleep(1);
        if ((++sp & 255u) == 0u) { if (xb_ld(&bar[XB_TMO])) break; if (sp > XB_SPIN_CAP) { atomicAdd(&bar[XB_TMO], 1u); break; } }
    }
    nloc = mine > 0u ? mine : 1u; nx = cnt > 0u ? cnt : 1u;
}
__device__ __forceinline__ void xcd_barrier_nv(unsigned* bbar, unsigned bx, volatile LAS unsigned* bst) {
    XcdBarrier b; b.bar = bbar; b.x = bx; b.st = bst;
    asm volatile("s_waitcnt vmcnt(0)" ::: "memory");
    __syncthreads();
    if (threadIdx.x == 0) {
        unsigned* bar = b.bar;
        __builtin_amdgcn_s_waitcnt(0);
        unsigned nloc = b.st[0], nx = b.st[1];
        if (nloc == 0u) { xcd_barrier_complete(bar, b.x, nloc, nx); b.st[0] = nloc; b.st[1] = nx; }
        const unsigned old = xb_add(&bar[XB_XSUB(b.x)], 1u);
        const unsigned gen = old / nloc;
        if (old + 1u == (gen + 1u) * nloc) {
            __builtin_amdgcn_fence(__ATOMIC_RELEASE, "agent");
            asm volatile("s_waitcnt vmcnt(0)" ::: "memory");
            const unsigned og = xb_add(&bar[XB_TOP], 1u);
            const unsigned tg = og / nx;
            if (og + 1u == (tg + 1u) * nx) xb_add(&bar[XB_TOPGEN], 1u);
            else XB_SPIN(xb_ld(&bar[XB_TOPGEN]) == tg, bar);
            __builtin_amdgcn_fence(__ATOMIC_ACQUIRE, "agent");
            xb_add(&bar[XB_XGEN(b.x)], 1u);
            asm volatile("s_waitcnt vmcnt(0)" ::: "memory");
        } else {
            XB_SPIN(xb_ld(&bar[XB_XGEN(b.x)]) == gen, bar);
            __builtin_amdgcn_fence(__ATOMIC_ACQUIRE, "agent");
            asm volatile("s_waitcnt vmcnt(0)" ::: "memory");
        }
    }
    __syncthreads();
}

__device__ __forceinline__ int tid_() { int t = threadIdx.x; asm volatile("" : "+v"(t)); return t; }
__device__ __forceinline__ float bf2f(bf16_t v) { return __uint_as_float(((unsigned)v) << 16); }
__device__ __forceinline__ unsigned pack2(float lo, float hi) { unsigned r; asm("v_cvt_pk_bf16_f32 %0, %1, %2" : "=v"(r) : "v"(lo), "v"(hi)); return r; }
__device__ __forceinline__ bf16_t f2bf(float f) { return (bf16_t)(pack2(f, f) & 0xffffu); }
__device__ __forceinline__ float wave_sum(float v) {
#pragma unroll
    for (int o = 32; o >= 1; o >>= 1) v += __shfl_xor(v, o);
    return v;
}
__device__ __forceinline__ float wave_max(float v) {
#pragma unroll
    for (int o = 32; o >= 1; o >>= 1) v = fmaxf(v, __shfl_xor(v, o));
    return v;
}
__device__ __forceinline__ float sigmoidf_(float x) { return __builtin_amdgcn_rcpf(1.0f + __builtin_amdgcn_exp2f(-1.4426950408889634f * x)); }
__device__ __forceinline__ float gelu_tanh(float x) { const float u = 0.7978845608028654f * (x + 0.044715f * x * x * x); return 0.5f * x * (1.0f + tanhf(u)); }
__device__ __forceinline__ unsigned pk_fp8x4(float a, float b, float c, float d) { int w = 0; w = __builtin_amdgcn_cvt_pk_fp8_f32(a, b, w, false); w = __builtin_amdgcn_cvt_pk_fp8_f32(c, d, w, true); return (unsigned)w; }
__device__ __forceinline__ float swiglu(float gate, float up) {
    const float g = fminf(gate, 7.0f), u = fminf(fmaxf(up, -7.0f), 7.0f);
    return (u + 1.0f) * g * sigmoidf_(1.702f * g);
}

struct Params {
    const float* x; const float* a_w_in; const float* a_conv_w; const float* a_conv_b; const float* a_w_rgate; const float* a_b_rgate;
    const float* a_w_igate; const float* a_b_igate; const float* a_lambda; const float* a_w_out; const float* b_w_in; const float* b_w_out;
    const float* c_w_in; const float* c_w_out; const float* ln_gain; const float* ln_bias; const float* moe_w_router; const float* moe_b_router;
    const float* moe_w_gu; const float* moe_b_gu; const float* moe_w_down; const float* moe_b_down;
    float* out; unsigned char* ws;
    int ph_lo, ph_hi;
};

__device__ __forceinline__ void convert_job(LAS float* tile, const float* src, bf16_t* dst, int K, int N, int batch) {
    const int tid = tid_();
    const int tk = K / 64, tn = N / 64, per = tk * tn; const long total = (long)per * batch;
    for (long u = blockIdx.x; u < total; u += gridDim.x) {
        const int bidx = (int)(u / per), r = (int)(u % per), kt = r / tn, nt = r % tn;
        const float* s = src + (size_t)bidx * K * N + (size_t)(kt * 64) * N + nt * 64;
#pragma unroll
        for (int pass = 0; pass < 2; ++pass) {
            const int row = (tid >> 4) + 32 * pass, c4 = tid & 15;
            const f32x4 v = *(const f32x4*)(s + (size_t)row * N + c4 * 4);
            tile[row * 65 + c4 * 4 + 0] = v[0]; tile[row * 65 + c4 * 4 + 1] = v[1]; tile[row * 65 + c4 * 4 + 2] = v[2]; tile[row * 65 + c4 * 4 + 3] = v[3];
        }
        __syncthreads();
        {
            const int n = tid >> 3, k8 = tid & 7;
            float v[8];
#pragma unroll
            for (int j = 0; j < 8; ++j) v[j] = tile[(k8 * 8 + j) * 65 + n];
            u32x4 w; w.x = pack2(v[0], v[1]); w.y = pack2(v[2], v[3]); w.z = pack2(v[4], v[5]); w.w = pack2(v[6], v[7]);
            *(u32x4*)(dst + (size_t)bidx * N * K + (size_t)(nt * 64 + n) * K + kt * 64 + k8 * 8) = w;
        }
        __syncthreads();
    }
}

struct GemmS {
    const bf16_t* A; int lda;
    const bf16_t* Bt; int ldb;
    int M, N, K;
    const unsigned* Mdyn;
    const int* row_idx;
    const unsigned* tile_exp;
    size_t b_exp_stride;
    const float* bias; int bias_es;
    float* Cf; bf16_t* Cb; int ldc;
};
template <int MODE>
__device__ __forceinline__ void gemm_simple(LAS unsigned char* lds, const GemmS& g) {
    const int tid = tid_(), lane = tid & 63, wid = tid >> 6, wr = wid >> 1, wc = wid & 1, fr = lane & 15, fq = lane >> 4;
    const int M = g.Mdyn ? (int)*g.Mdyn : g.M;
    const int tiles_n = (MODE == 1) ? (g.N / 256) * 2 : g.N / 128;
    const int tiles_m = M / 128, nunits = tiles_m * tiles_n, nk = g.K / 32;
    LAS bf16_t* As = (LAS bf16_t*)lds;
    LAS bf16_t* Bs = As + 2 * 128 * 40;
    const int lrow = tid >> 2, lch = tid & 3;
    for (int u = blockIdx.x; u < nunits; u += gridDim.x) {
        const int tm = u / tiles_n, tn = u % tiles_n, m0 = tm * 128;
        const int e = (MODE != 0) ? (int)g.tile_exp[m0 >> 8] : 0;
        const bf16_t* Bbase = g.Bt + (size_t)e * g.b_exp_stride;
        int arow = m0 + lrow; if (MODE == 1) arow = g.row_idx[arow];
        int brow;
        if (MODE == 1) { const int bwc = lrow >> 6, ni = (lrow & 63) >> 4, r = lrow & 15; brow = ((ni & 1) ? 1024 : 0) + tn * 64 + bwc * 32 + (ni >> 1) * 16 + r; }
        else brow = tn * 128 + lrow;
        const bf16_t* ap = g.A + (size_t)arow * g.lda + lch * 8;
        const bf16_t* bp = Bbase + (size_t)brow * g.ldb + lch * 8;
        f32x4 acc[2][4];
#pragma unroll
        for (int mi = 0; mi < 2; ++mi)
#pragma unroll
            for (int ni = 0; ni < 4; ++ni) acc[mi][ni] = (f32x4){0.f, 0.f, 0.f, 0.f};
        u32x4 ra = *(const u32x4*)ap, rb = *(const u32x4*)bp;
        *(LAS u32x4*)(As + lrow * 40 + lch * 8) = ra; *(LAS u32x4*)(Bs + lrow * 40 + lch * 8) = rb;
        __syncthreads();
        for (int kt = 0; kt < nk; ++kt) {
            const int cur = kt & 1;
            if (kt + 1 < nk) { ra = *(const u32x4*)(ap + (kt + 1) * 32); rb = *(const u32x4*)(bp + (kt + 1) * 32); }
            bf16x8 af[2], bfr[4];
#pragma unroll
            for (int mi = 0; mi < 2; ++mi) af[mi] = *(const LAS bf16x8*)(As + cur * 5120 + (wr * 32 + mi * 16 + fr) * 40 + fq * 8);
#pragma unroll
            for (int ni = 0; ni < 4; ++ni) bfr[ni] = *(const LAS bf16x8*)(Bs + cur * 5120 + (wc * 64 + ni * 16 + fr) * 40 + fq * 8);
#pragma unroll
            for (int mi = 0; mi < 2; ++mi)
#pragma unroll
                for (int ni = 0; ni < 4; ++ni) acc[mi][ni] = __builtin_amdgcn_mfma_f32_16x16x32_bf16(bfr[ni], af[mi], acc[mi][ni], 0, 0, 0);
            if (kt + 1 < nk) { *(LAS u32x4*)(As + (cur ^ 1) * 5120 + lrow * 40 + lch * 8) = ra; *(LAS u32x4*)(Bs + (cur ^ 1) * 5120 + lrow * 40 + lch * 8) = rb; }
            __syncthreads();
        }
#pragma unroll
        for (int mi = 0; mi < 2; ++mi) {
            const int m = m0 + wr * 32 + mi * 16 + fr;
            if (MODE == 1) {
#pragma unroll
                for (int q = 0; q < 2; ++q) {
                    const int hc = tn * 64 + wc * 32 + q * 16 + 4 * fq;
                    const f32x4 bg = *(const f32x4*)(g.bias + (size_t)e * g.bias_es + hc), bu = *(const f32x4*)(g.bias + (size_t)e * g.bias_es + 1024 + hc);
                    const f32x4 gt = acc[mi][2 * q] + bg, up = acc[mi][2 * q + 1] + bu;
                    u32x2 w; w.x = pack2(swiglu(gt[0], up[0]), swiglu(gt[1], up[1])); w.y = pack2(swiglu(gt[2], up[2]), swiglu(gt[3], up[3]));
                    *(u32x2*)(g.Cb + (size_t)m * g.ldc + hc) = w;
                }
            } else {
#pragma unroll
                for (int ni = 0; ni < 4; ++ni) {
                    const int n = tn * 128 + wc * 64 + ni * 16 + 4 * fq;
                    f32x4 v = acc[mi][ni];
                    if (g.bias) v += *(const f32x4*)(g.bias + (size_t)e * g.bias_es + n);
                    if (g.Cf) *(f32x4*)(g.Cf + (size_t)m * g.ldc + n) = v;
                    else { u32x2 w; w.x = pack2(v[0], v[1]); w.y = pack2(v[2], v[3]); *(u32x2*)(g.Cb + (size_t)m * g.ldc + n) = w; }
                }
            }
        }
    }
}


constexpr int TAB_OFF = 131072;
__device__ __forceinline__ void moe_tables(LAS unsigned char* lds, const unsigned* ctl, int layer) {
    LAS int* tab = (LAS int*)(lds + TAB_OFF);
    const int tid = tid_();
    __syncthreads();
    if (tid == 0) { int acc = 0; for (int e = 0; e < NEXP; ++e) { tab[e] = acc; acc += ((int)ctl[CW_CNT + layer * 64 + e] + 255) >> 8; } tab[32] = acc; }
    __syncthreads();
    if (tid < 288) { int e = 0; for (int q = 1; q < NEXP; ++q) e += (tab[q] <= tid) ? 1 : 0; tab[64 + tid] = e; }
    __syncthreads();
}

namespace g8 {
constexpr int BM = 256, BK = 64, HALF = 128, HTB = HALF * BK * 2, STAGE_BYTES = 8 * HTB, NXCD = 8, WGM = 8;
__device__ __forceinline__ int lds_byte(int r, int c) { const int st = (r >> 4) * 2 + (c >> 5), rr = r & 15, cc = c & 31, ob = rr * 64 + cc * 2; return st * 1024 + (ob ^ (((ob >> 9) & 1) << 5)); }
__device__ __forceinline__ void stage_rc(int b, int& R, int& C) { const int st = b / 1024, sb = b % 1024, swz = sb ^ (((sb >> 9) & 1) << 5); R = (st >> 1) * 16 + swz / 64; C = (st & 1) * 32 + (swz % 64) / 2; }
__device__ __forceinline__ int perm32(int rho) { const int n = rho >> 4, i = rho & 15; return 8 * (i >> 2) + 4 * n + (i & 3); }
__device__ __forceinline__ unsigned cvt_pk_bf16(float lo, float hi) { unsigned r; asm volatile("v_cvt_pk_bf16_f32 %0, %1, %2" : "=v"(r) : "v"(lo), "v"(hi)); return r; }

struct Unit { const char* a0; const char* a1; const char* b0; const char* b1; const int* rows; int row0, col0, e; };

struct SchedPlain {
    const char* A; const char* Bt; size_t hstepA, hstepB; int nM, nN, nwg, G, c;
    __device__ __forceinline__ void init(const void* A_, const void* Bt_, int M, int N, int K, int G_, int c_) { A = (const char*)A_; Bt = (const char*)Bt_; hstepA = (size_t)HALF * K * 2; hstepB = hstepA; nM = M / BM; nN = N / BM; nwg = nM * nN; G = G_; c = c_; }
    __device__ __forceinline__ bool next(int i, Unit& u) const {
        const long L = (long)i * G + c; if (L >= nwg) return false;
        int wgid = (int)L; { const int q = nwg / NXCD, r = nwg % NXCD, xcd = wgid % NXCD, off = wgid / NXCD; wgid = (xcd < r ? xcd * (q + 1) : r * (q + 1) + (xcd - r) * q) + off; }
        const int nig = WGM * nN, gid = wgid / nig, fm = gid * WGM, gsz = (nM - fm) < WGM ? (nM - fm) : WGM;
        const int pm = fm + ((wgid % nig) % gsz), pn = (wgid % nig) / gsz;
        u.a0 = A + (size_t)pm * 2 * hstepA; u.a1 = u.a0 + hstepA; u.b0 = Bt + (size_t)pn * 2 * hstepB; u.b1 = u.b0 + hstepB; u.rows = nullptr; u.row0 = pm * BM; u.col0 = pn * BM; u.e = 0;
        return true;
    }
};
struct SchedGU {
    const char* A; const char* W; const int* elist; LAS const int* tab; int G, c;
    __device__ __forceinline__ bool next(int i, Unit& u) const {
        const int L = i * G + c, rt = L >> 3, pn = L & 7; if (rt >= __builtin_amdgcn_readfirstlane(tab[32])) return false;
        const int e = __builtin_amdgcn_readfirstlane(tab[64 + rt]), j = rt - __builtin_amdgcn_readfirstlane(tab[e]);
        u.a0 = A; u.a1 = A; u.rows = elist + (size_t)e * T + j * BM; u.b0 = W + ((size_t)e * 2048 + pn * 128) * D; u.b1 = u.b0 + (size_t)1024 * D; u.row0 = rt * BM; u.col0 = pn * 128; u.e = e;
        return true;
    }
};
struct SchedDown {
    const char* A; const char* W; LAS const int* tab; int G, c;
    __device__ __forceinline__ bool next(int i, Unit& u) const {
        const int L = i * G + c, rt = L >> 2, pn = L & 3; if (rt >= __builtin_amdgcn_readfirstlane(tab[32])) return false;
        const int e = __builtin_amdgcn_readfirstlane(tab[64 + rt]);
        u.a0 = A + (size_t)rt * BM * D; u.a1 = u.a0 + (size_t)HALF * D; u.rows = nullptr; u.b0 = W + ((size_t)e * 1024 + pn * BM) * D; u.b1 = u.b0 + (size_t)HALF * D; u.row0 = rt * BM; u.col0 = pn * BM; u.e = e;
        return true;
    }
};

struct EpiF32 {
    static constexpr bool PERM = false;
    float* C; int ldc; const float* bias; int bias_es;
    __device__ __forceinline__ void operator()(const f32x4 (&acc)[2][2][4][2], const Unit& u, int wr, int wc, int fr, int fq) const {
        const int row0 = u.row0 + wr * 64 + fr, col0 = u.col0 + wc * 32 + 4 * fq;
        f32x4 bv[2][2];
#pragma unroll
        for (int bj = 0; bj < 2; ++bj)
#pragma unroll
            for (int n = 0; n < 2; ++n) bv[bj][n] = bias ? *(const f32x4*)(bias + (size_t)u.e * bias_es + col0 + bj * HALF + n * 16) : (f32x4){0.f, 0.f, 0.f, 0.f};
#pragma unroll
        for (int ai = 0; ai < 2; ++ai)
#pragma unroll
            for (int m = 0; m < 4; ++m) { float* rowp = C + (size_t)(row0 + ai * HALF + m * 16) * ldc + col0;
#pragma unroll
                for (int bj = 0; bj < 2; ++bj)
#pragma unroll
                    for (int n = 0; n < 2; ++n) *(f32x4*)(rowp + bj * HALF + n * 16) = acc[ai][bj][m][n] + bv[bj][n]; }
    }
};
struct EpiBf16 {
    static constexpr bool PERM = true;
    bf16_t* O; int ldc; const float* bias; int bias_es; float scale;
    __device__ __forceinline__ void operator()(const f32x4 (&acc)[2][2][4][2], const Unit& u, int wr, int wc, int fr, int fq) const {
        const int row0 = u.row0 + wr * 64 + fr, col0 = u.col0 + wc * 32 + 8 * fq;
        f32x4 bv[2][2];
#pragma unroll
        for (int bj = 0; bj < 2; ++bj)
#pragma unroll
            for (int n = 0; n < 2; ++n) bv[bj][n] = bias ? *(const f32x4*)(bias + (size_t)u.e * bias_es + col0 + bj * HALF + 4 * n) : (f32x4){0.f, 0.f, 0.f, 0.f};
#pragma unroll
        for (int ai = 0; ai < 2; ++ai)
#pragma unroll
            for (int m = 0; m < 4; ++m) { bf16_t* rowp = O + (size_t)(row0 + ai * HALF + m * 16) * ldc + col0;
#pragma unroll
                for (int bj = 0; bj < 2; ++bj) { const f32x4 v0 = acc[ai][bj][m][0] * scale + bv[bj][0], v1 = acc[ai][bj][m][1] * scale + bv[bj][1];
                    u32x4 w; w.x = cvt_pk_bf16(v0[0], v0[1]); w.y = cvt_pk_bf16(v0[2], v0[3]); w.z = cvt_pk_bf16(v1[0], v1[1]); w.w = cvt_pk_bf16(v1[2], v1[3]);
                    *(u32x4*)(rowp + bj * HALF) = w; } }
    }
};
struct EpiSwiglu {
    static constexpr bool PERM = true;
    unsigned char* O; const float* bias; float scale;
    __device__ __forceinline__ void operator()(const f32x4 (&acc)[2][2][4][2], const Unit& u, int wr, int wc, int fr, int fq) const {
        const int row0 = u.row0 + wr * 64 + fr, hc = u.col0 + wc * 32 + 8 * fq;
        const float* bp = bias + (size_t)u.e * 2048 + hc;
        const f32x4 bg0 = *(const f32x4*)(bp), bg1 = *(const f32x4*)(bp + 4), bu0 = *(const f32x4*)(bp + 1024), bu1 = *(const f32x4*)(bp + 1028);
#pragma unroll
        for (int ai = 0; ai < 2; ++ai)
#pragma unroll
            for (int m = 0; m < 4; ++m) {
                const f32x4 g0 = acc[ai][0][m][0] * scale + bg0, g1 = acc[ai][0][m][1] * scale + bg1, u0 = acc[ai][1][m][0] * scale + bu0, u1 = acc[ai][1][m][1] * scale + bu1;
                u32x2 w; w.x = pk_fp8x4(swiglu(g0[0], u0[0]), swiglu(g0[1], u0[1]), swiglu(g0[2], u0[2]), swiglu(g0[3], u0[3]));
                w.y = pk_fp8x4(swiglu(g1[0], u1[0]), swiglu(g1[1], u1[1]), swiglu(g1[2], u1[2]), swiglu(g1[3], u1[3]));
                *(u32x2*)(O + (size_t)(row0 + ai * HALF + m * 16) * D + hc) = w;
            }
    }
};

typedef int i32x8 __attribute__((ext_vector_type(8)));
typedef int i32x4 __attribute__((ext_vector_type(4)));
template <class Epi, class Sched, bool GATHER, int ESZ = 2>
__device__ __forceinline__ void gemm_phase(LAS unsigned char* lds, const int K, const Sched& S, const Epi& E) {
    const int tid = tid_(), wid = __builtin_amdgcn_readfirstlane(tid >> 6), lane = tid & 63, wr = wid >> 2, wc = wid & 3, fr = lane & 15, fq = lane >> 4;
    const int nt = K * ESZ / 128, KP = K * ESZ;
    int sR[2], sC[2];
    unsigned voffB[2];
#pragma unroll
    for (int i = 0; i < 2; ++i) { stage_rc(tid * 16 + i * 8192, sR[i], sC[i]); const int Rb = Epi::PERM ? ((sR[i] & ~31) + perm32(sR[i] & 31)) : sR[i]; voffB[i] = (unsigned)(Rb * KP + sC[i] * 2); }
    unsigned cvA0[2], cvA1[2], nvA0[2], nvA1[2];
#define G8_VOFF(u, v0, v1) do { _Pragma("unroll") for (int _i = 0; _i < 2; ++_i) { \
        if (GATHER) { unsigned t0_ = (unsigned)(u).rows[sR[_i]], t1_ = (unsigned)(u).rows[HALF + sR[_i]]; t0_ = t0_ < (unsigned)T ? t0_ : 0u; t1_ = t1_ < (unsigned)T ? t1_ : 0u;     \
            v0[_i] = t0_ * (unsigned)KP + (unsigned)(sC[_i] * 2); v1[_i] = t1_ * (unsigned)KP + (unsigned)(sC[_i] * 2); } \
        else { v0[_i] = (unsigned)(sR[_i] * KP + sC[_i] * 2); v1[_i] = v0[_i]; } } } while (0)
    const size_t kstep = (size_t)(BK * 2);
    const unsigned ldsw = (unsigned)wid * 1024u;
    const int aoff = lds_byte(wr * 64 + fr, fq * 8), boff = lds_byte(wc * 32 + fr, fq * 8);
#define PG8_SA(b, h) (((b) * 2 + (h)) * HTB)
#define PG8_SB(b, h) ((4 + (b) * 2 + (h)) * HTB)
#define PG8_STAGE(bufoff, gbase, voff) do { _Pragma("unroll") for (int _i = 0; _i < 2; ++_i) \
        __builtin_amdgcn_global_load_lds((const unsigned*)((const char*)(gbase) + (voff)[_i]), (LAS unsigned*)(lds + (bufoff) + ldsw + _i * 8192), 16, 0, 0); } while (0)
#define PG8_LDA(dst, b, h) do { _Pragma("unroll") for (int m = 0; m < 4; ++m) { dst[m].lo = *(const LAS i32x4*)(lds + PG8_SA(b, h) + aoff + m * 2048); dst[m].hi = *(const LAS i32x4*)(lds + PG8_SA(b, h) + aoff + m * 2048 + 1024); } } while (0)
#define PG8_LDB(dst, b, h) do { _Pragma("unroll") for (int n = 0; n < 2; ++n) { dst[n].lo = *(const LAS i32x4*)(lds + PG8_SB(b, h) + boff + n * 2048); dst[n].hi = *(const LAS i32x4*)(lds + PG8_SB(b, h) + boff + n * 2048 + 1024); } } while (0)
#define PG8_MMA(ai, bj, At, Bt) do { __builtin_amdgcn_s_setprio(1); _Pragma("unroll") for (int m = 0; m < 4; ++m) _Pragma("unroll") for (int n = 0; n < 2; ++n) { \
        if (ESZ == 2) { acc[ai][bj][m][n] = __builtin_amdgcn_mfma_f32_16x16x32_bf16(__builtin_bit_cast(bf16x8, (i32x4)__builtin_shufflevector(Bt[n], Bt[n], 0, 1, 2, 3)), __builtin_bit_cast(bf16x8, (i32x4)__builtin_shufflevector(At[m], At[m], 0, 1, 2, 3)), acc[ai][bj][m][n], 0, 0, 0); \
                        acc[ai][bj][m][n] = __builtin_amdgcn_mfma_f32_16x16x32_bf16(__builtin_bit_cast(bf16x8, (i32x4)__builtin_shufflevector(Bt[n], Bt[n], 4, 5, 6, 7)), __builtin_bit_cast(bf16x8, (i32x4)__builtin_shufflevector(At[m], At[m], 4, 5, 6, 7)), acc[ai][bj][m][n], 0, 0, 0); } \
        else asm volatile("v_mfma_f32_16x16x128_f8f6f4 %0, %1, %2, %0" : "+v"(acc[ai][bj][m][n]) : "v"(Bt[n]), "v"(At[m])); } __builtin_amdgcn_s_setprio(0); } while (0)
#define PG8_WAIT_V(n) asm volatile("s_waitcnt vmcnt(" #n ")" ::: "memory")
#define PG8_WAIT_L(n) asm volatile("s_waitcnt lgkmcnt(" #n ")" ::: "memory")
#define PG8_BAR __builtin_amdgcn_s_barrier()
#define PG8_SCHED __builtin_amdgcn_sched_barrier(0)
    Unit cur, nxt; int ui = 0;
    if (!S.next(0, cur)) return;
    f32x4 acc[2][2][4][2];
#pragma unroll
    for (int a = 0; a < 2; ++a)
#pragma unroll
        for (int b = 0; b < 2; ++b)
#pragma unroll
            for (int m = 0; m < 4; ++m)
#pragma unroll
                for (int n = 0; n < 2; ++n) acc[a][b][m][n] = (f32x4){0.f, 0.f, 0.f, 0.f};
    i32x8 At[4], B0[2], B1[2];
    const char* cA0 = cur.a0; const char* cA1 = cur.a1; const char* cB0 = cur.b0; const char* cB1 = cur.b1;
    G8_VOFF(cur, cvA0, cvA1);
    PG8_STAGE(PG8_SB(0, 0), cB0, voffB); PG8_STAGE(PG8_SB(0, 1), cB1, voffB); PG8_STAGE(PG8_SA(0, 0), cA0, cvA0); PG8_STAGE(PG8_SA(0, 1), cA1, cvA1);
    if (wr == 1) PG8_BAR;
    PG8_WAIT_V(2); PG8_BAR;
    PG8_STAGE(PG8_SB(1, 0), cB0 + kstep, voffB); PG8_STAGE(PG8_SA(1, 0), cA0 + kstep, cvA0); PG8_STAGE(PG8_SB(1, 1), cB1 + kstep, voffB);
    PG8_WAIT_V(6); PG8_BAR;
    for (;;) {
        const bool has_next = S.next(ui + 1, nxt);
        const char* nA0 = has_next ? nxt.a0 : cA0; const char* nA1 = has_next ? nxt.a1 : cA1; const char* nB0 = has_next ? nxt.b0 : cB0; const char* nB1 = has_next ? nxt.b1 : cB1;
        if (GATHER) { if (has_next) { G8_VOFF(nxt, nvA0, nvA1); } else { nvA0[0] = cvA0[0]; nvA0[1] = cvA0[1]; nvA1[0] = cvA1[0]; nvA1[1] = cvA1[1]; } }
#pragma unroll 1
        for (int t = 0; t < nt; t += 2) {
            const bool last = (t == nt - 2);
            const char* a1_1 = cA1 + (size_t)(t + 1) * kstep;
            const char* a2_0 = last ? nA0 : cA0 + (size_t)(t + 2) * kstep; const char* a2_1 = last ? nA1 : cA1 + (size_t)(t + 2) * kstep;
            const char* b2_0 = last ? nB0 : cB0 + (size_t)(t + 2) * kstep; const char* b2_1 = last ? nB1 : cB1 + (size_t)(t + 2) * kstep;
            const char* a3_0 = a2_0 + kstep; const char* b3_0 = b2_0 + kstep; const char* b3_1 = b2_1 + kstep;
            unsigned vA0[2], vA1[2];
            if (GATHER) { vA0[0] = last ? nvA0[0] : cvA0[0]; vA0[1] = last ? nvA0[1] : cvA0[1]; vA1[0] = last ? nvA1[0] : cvA1[0]; vA1[1] = last ? nvA1[1] : cvA1[1]; }
            else { vA0[0] = cvA0[0]; vA0[1] = cvA0[1]; vA1[0] = cvA0[0]; vA1[1] = cvA0[1]; }
            PG8_LDB(B0, 0, 0); PG8_LDB(B1, 0, 1); PG8_SCHED; PG8_LDA(At, 0, 0); PG8_STAGE(PG8_SA(1, 1), a1_1, cvA1);
            PG8_WAIT_V(8); PG8_WAIT_L(0); PG8_BAR; PG8_MMA(0, 0, At, B0); PG8_MMA(0, 1, At, B1); PG8_BAR; PG8_SCHED;
            PG8_LDA(At, 0, 1); PG8_STAGE(PG8_SB(0, 0), b2_0, voffB); PG8_STAGE(PG8_SB(0, 1), b2_1, voffB); PG8_STAGE(PG8_SA(0, 0), a2_0, vA0);
            PG8_WAIT_V(8); PG8_WAIT_L(0); PG8_BAR; PG8_MMA(1, 0, At, B0); PG8_MMA(1, 1, At, B1); PG8_BAR; PG8_SCHED;
            PG8_LDB(B0, 1, 0); PG8_LDB(B1, 1, 1); PG8_SCHED; PG8_LDA(At, 1, 0); PG8_STAGE(PG8_SA(0, 1), a2_1, vA1);
            PG8_WAIT_V(8); PG8_WAIT_L(0); PG8_BAR; PG8_MMA(0, 0, At, B0); PG8_MMA(0, 1, At, B1); PG8_BAR; PG8_SCHED;
            PG8_LDA(At, 1, 1); PG8_STAGE(PG8_SB(1, 0), b3_0, voffB); PG8_STAGE(PG8_SB(1, 1), b3_1, voffB); PG8_STAGE(PG8_SA(1, 0), a3_0, vA0);
            PG8_WAIT_V(8); PG8_WAIT_L(0); PG8_BAR; PG8_MMA(1, 0, At, B0); PG8_MMA(1, 1, At, B1); PG8_BAR; PG8_SCHED;
        }
        if (wr == 0) PG8_BAR;
        if (ESZ == 1) asm volatile("s_nop 15\n\ts_nop 15" ::: "memory");
        E(acc, cur, wr, wc, fr, fq);
        if (!has_next) break;
#pragma unroll
        for (int a = 0; a < 2; ++a)
#pragma unroll
            for (int b = 0; b < 2; ++b)
#pragma unroll
                for (int m = 0; m < 4; ++m)
#pragma unroll
                    for (int n = 0; n < 2; ++n) acc[a][b][m][n] = (f32x4){0.f, 0.f, 0.f, 0.f};
        cur = nxt; cA0 = nA0; cA1 = nA1; cB0 = nB0; cB1 = nB1; ++ui;
        if (GATHER) { cvA0[0] = nvA0[0]; cvA0[1] = nvA0[1]; cvA1[0] = nvA1[0]; cvA1[1] = nvA1[1]; }
        if (wr == 1) PG8_BAR;
    }
    PG8_WAIT_V(0);
    PG8_BAR;
#undef G8_VOFF
#undef PG8_SA
#undef PG8_SB
#undef PG8_STAGE
#undef PG8_LDA
#undef PG8_LDB
#undef PG8_MMA
#undef PG8_WAIT_V
#undef PG8_WAIT_L
#undef PG8_BAR
#undef PG8_SCHED
}
}


template <bool F8>
__device__ __forceinline__ void convert_big(LAS unsigned char* lds, const float* src, void* dstv, int K, int N, int batch, float scale) {
    const int tid = tid_(), lane = tid & 63, wid = tid >> 6;
    const int nbn = N / 256, per = (K / 128) * nbn, total = per * batch, G = (int)gridDim.x;
    constexpr int ESZ = F8 ? 1 : 2, ROWB = 128 * ESZ, TILEB = 256 * ROWB;
    f32x4 ra[16], rb[16];
#define CV_LOAD(uu, reg) do { const int bidx = (uu) / per, r_ = (uu) % per, kb = r_ / nbn, nb = r_ % nbn; \
        const float* sp = src + (size_t)bidx * K * N + (size_t)(kb * 128 + 16 * wid) * N + nb * 256 + 4 * lane; \
        _Pragma("unroll") for (int i = 0; i < 16; ++i) reg[i] = *(const f32x4*)(sp + (size_t)i * N); } while (0)
#define CV_PACK(reg, tl) do { _Pragma("unroll") for (int j = 0; j < 4; ++j) { \
        if (F8) { u32x4 w0; w0.x = pk_fp8x4(reg[0][j] * scale, reg[1][j] * scale, reg[2][j] * scale, reg[3][j] * scale); w0.y = pk_fp8x4(reg[4][j] * scale, reg[5][j] * scale, reg[6][j] * scale, reg[7][j] * scale); \
            w0.z = pk_fp8x4(reg[8][j] * scale, reg[9][j] * scale, reg[10][j] * scale, reg[11][j] * scale); w0.w = pk_fp8x4(reg[12][j] * scale, reg[13][j] * scale, reg[14][j] * scale, reg[15][j] * scale); \
            *(LAS u32x4*)((tl) + (4 * lane + j) * ROWB + ((wid ^ (lane & 7)) * 16)) = w0; } \
        else { u32x4 w0, w1; \
            w0.x = g8::cvt_pk_bf16(reg[0][j], reg[1][j]); w0.y = g8::cvt_pk_bf16(reg[2][j], reg[3][j]); w0.z = g8::cvt_pk_bf16(reg[4][j], reg[5][j]); w0.w = g8::cvt_pk_bf16(reg[6][j], reg[7][j]); \
            w1.x = g8::cvt_pk_bf16(reg[8][j], reg[9][j]); w1.y = g8::cvt_pk_bf16(reg[10][j], reg[11][j]); w1.z = g8::cvt_pk_bf16(reg[12][j], reg[13][j]); w1.w = g8::cvt_pk_bf16(reg[14][j], reg[15][j]); \
            *(LAS u32x4*)((tl) + (4 * lane + j) * ROWB + (((2 * wid) ^ (lane & 15)) * 16)) = w0; *(LAS u32x4*)((tl) + (4 * lane + j) * ROWB + (((2 * wid + 1) ^ (lane & 15)) * 16)) = w1; } } } while (0)
#define CV_STORE(uu, tl) do { const int bidx = (uu) / per, r_ = (uu) % per, kb = r_ / nbn, nb = r_ % nbn; \
        unsigned char* dp = (unsigned char*)dstv + ((size_t)bidx * N * K + (size_t)(nb * 256) * K + kb * 128) * ESZ; \
        _Pragma("unroll") for (int i = 0; i < 4 * ESZ; ++i) { const int pc = tid + NTHREADS * i, n = pc / (8 * ESZ), c = pc % (8 * ESZ); \
            *(u32x4*)(dp + (size_t)n * K * ESZ + c * 16) = *(const LAS u32x4*)((tl) + n * ROWB + ((c ^ ((n >> 2) & (8 * ESZ - 1))) * 16)); } } while (0)
    const int u0 = blockIdx.x;
    if (u0 < total) CV_LOAD(u0, ra);
    if (u0 + G < total) CV_LOAD(u0 + G, rb);
    for (int u = u0; u < total; u += 2 * G) {
        CV_PACK(ra, lds);
        if (u + 2 * G < total) CV_LOAD(u + 2 * G, ra);
        __syncthreads();
        CV_STORE(u, lds);
        const bool has_b = (u + G < total);
        if (has_b) { CV_PACK(rb, lds + TILEB); if (u + 3 * G < total) CV_LOAD(u + 3 * G, rb); }
        __syncthreads();
        if (has_b) CV_STORE(u + G, lds + TILEB);
    }
    __syncthreads();
#undef CV_LOAD
#undef CV_PACK
#undef CV_STORE
}

__device__ __forceinline__ float gelu_fast(float x) { const float u2 = 1.5957691216057308f * (x + 0.044715f * x * x * x); return x * __builtin_amdgcn_rcpf(1.0f + __builtin_amdgcn_exp2f(-1.4426950408889634f * u2)); }
__device__ __forceinline__ void lru_gates_phase(LAS unsigned char* lds, const Params& p, int idx) {
    const int tid = tid_(), lane = tid & 63, wid = tid >> 6, fr = lane & 15, fq = lane >> 4;
    LAS bf16_t* xcb = (LAS bf16_t*)lds;
    LAS float* xcf = (LAS float*)(lds + 17408);
    LAS float* sa = (LAS float*)(lds + 17408 + 33792);
    LAS float* sb = sa + 64 * 132;
    LAS float* comb = sb + 64 * 132;
    const bf16_t* u = (const bf16_t*)(p.ws + WS_U);
    bf16_t* Carr = (bf16_t*)(p.ws + WS_SCR); bf16_t* Barr = Carr + (size_t)T * D;
    float* SP = (float*)(p.ws + WS_LSUM); float* SH = SP + NBATCH * 32 * D;
    const int hd = blockIdx.x & 7, slot = blockIdx.x >> 3, nslots = gridDim.x >> 3;
    const float* conv_w = p.a_conv_w + (size_t)idx * 4 * D; const float* conv_b = p.a_conv_b + (size_t)idx * D;
    const bf16_t* wrt = (const bf16_t*)(p.ws + WS_AGT) + ((size_t)(idx * 2 + 0) * 8 + hd) * 128 * 128;
    const bf16_t* wit = (const bf16_t*)(p.ws + WS_AGT) + ((size_t)(idx * 2 + 1) * 8 + hd) * 128 * 128;
    bf16x8 Br[4], Bi[4];
#pragma unroll
    for (int ks = 0; ks < 4; ++ks) { Br[ks] = *(const bf16x8*)(wrt + (size_t)(16 * wid + fr) * 128 + 32 * ks + 8 * fq); Bi[ks] = *(const bf16x8*)(wit + (size_t)(16 * wid + fr) * 128 + 32 * ks + 8 * fq); }
    const int cg = hd * 128 + 16 * wid + 4 * fq;
    const f32x4 brv = *(const f32x4*)(p.a_b_rgate + (size_t)idx * D + cg), biv = *(const f32x4*)(p.a_b_igate + (size_t)idx * D + cg), lmv = *(const f32x4*)(p.a_lambda + (size_t)idx * D + cg);
    f32x4 spv;
#pragma unroll
    for (int r = 0; r < 4; ++r) spv[r] = (lmv[r] > 15.f) ? __expf(-lmv[r]) : log1pf(__expf(-lmv[r]));
    const int cc = (tid & 31) * 4, cch = hd * 128 + cc;
    f32x4 cw[4];
#pragma unroll
    for (int j = 0; j < 4; ++j) cw[j] = *(const f32x4*)(conv_w + j * D + cch);
    const f32x4 cb = *(const f32x4*)(conv_b + cch);
    for (int tile = slot; tile < T / 64; tile += nslots) {
        const int t0 = tile * 64;
#pragma unroll
        for (int k = 0; k < 4; ++k) {
            const int tl = (tid >> 5) + 16 * k, t = t0 + tl, s_ = t & (SEQ - 1);
            f32x4 acc = cb;
#pragma unroll
            for (int j = 0; j < 4; ++j) {
                if (s_ - 3 + j >= 0) {
                    const u32x2 rv = *(const u32x2*)(u + (size_t)(t - 3 + j) * 2048 + 1024 + cch);
                    acc[0] += cw[j][0] * __uint_as_float(rv.x << 16); acc[1] += cw[j][1] * __uint_as_float(rv.x & 0xffff0000u);
                    acc[2] += cw[j][2] * __uint_as_float(rv.y << 16); acc[3] += cw[j][3] * __uint_as_float(rv.y & 0xffff0000u);
                }
            }
            *(LAS f32x4*)(xcf + tl * 132 + cc) = acc;
            u32x2 w; w.x = pack2(acc[0], acc[1]); w.y = pack2(acc[2], acc[3]);
            *(LAS u32x2*)(xcb + tl * 136 + cc) = w;
        }
        __syncthreads();
        f32x4 ar[4], ai[4];
#pragma unroll
        for (int mt = 0; mt < 4; ++mt) { ar[mt] = (f32x4){0.f, 0.f, 0.f, 0.f}; ai[mt] = (f32x4){0.f, 0.f, 0.f, 0.f}; }
#pragma unroll
        for (int ks = 0; ks < 4; ++ks)
#pragma unroll
            for (int mt = 0; mt < 4; ++mt) {
                const bf16x8 af = *(const LAS bf16x8*)(xcb + (mt * 16 + fr) * 136 + 32 * ks + 8 * fq);
                ar[mt] = __builtin_amdgcn_mfma_f32_16x16x32_bf16(Br[ks], af, ar[mt], 0, 0, 0);
                ai[mt] = __builtin_amdgcn_mfma_f32_16x16x32_bf16(Bi[ks], af, ai[mt], 0, 0, 0);
            }
#pragma unroll
        for (int mt = 0; mt < 4; ++mt) {
            const int tl = mt * 16 + fr, cl = 16 * wid + 4 * fq;
            const f32x4 rec = *(const LAS f32x4*)(xcf + tl * 132 + cl);
            f32x4 av, bv, cv;
#pragma unroll
            for (int r = 0; r < 4; ++r) {
                const float rg = sigmoidf_(ar[mt][r] + brv[r]), ig = sigmoidf_(ai[mt][r] + biv[r]);
                const float xl = -8.0f * rg * spv[r];
                const float cex = -xl * (1.0f + xl * (0.5f + xl * (0.16666667f + xl * (0.041666668f + xl * 0.0083333338f))));
                const float cc_ = bf2f(f2bf(cex));
                av[r] = 1.0f - cc_; cv[r] = cc_;
                bv[r] = bf2f(f2bf(__builtin_amdgcn_sqrtf(fmaxf(cex * (2.0f - cex), 0.f)) * ig * rec[r]));
            }
            { u32x2 wc_, wb_; wc_.x = pack2(cv[0], cv[1]); wc_.y = pack2(cv[2], cv[3]); wb_.x = pack2(bv[0], bv[1]); wb_.y = pack2(bv[2], bv[3]);
              *(u32x2*)(Carr + (size_t)(t0 + tl) * D + cg) = wc_; *(u32x2*)(Barr + (size_t)(t0 + tl) * D + cg) = wb_; }
            *(LAS f32x4*)(sa + tl * 132 + cl) = av; *(LAS f32x4*)(sb + tl * 132 + cl) = bv;
        }
        __syncthreads();
        {
            const int j = tid & 127, q = tid >> 7;
            float P = 1.f, H = 0.f;
#pragma unroll
            for (int s_ = 0; s_ < 16; ++s_) { const float a = sa[(q * 16 + s_) * 132 + j], bb = sb[(q * 16 + s_) * 132 + j]; H = a * H + bb; P *= a; }
            comb[(q * 128 + j) * 2 + 0] = P; comb[(q * 128 + j) * 2 + 1] = H;
        }
        __syncthreads();
        if (tid < 128) {
            float P = comb[tid * 2], H = comb[tid * 2 + 1];
#pragma unroll
            for (int q = 1; q < 4; ++q) { const float Pq = comb[(q * 128 + tid) * 2], Hq = comb[(q * 128 + tid) * 2 + 1]; H = Pq * H + Hq; P *= Pq; }
            SP[(size_t)tile * D + hd * 128 + tid] = P; SH[(size_t)tile * D + hd * 128 + tid] = H;
        }
    }
}
__device__ __forceinline__ void lru_scan_phase(const Params& p) {
    const int tid = tid_();
    const bf16_t* u = (const bf16_t*)(p.ws + WS_U);
    const bf16_t* Carr = (const bf16_t*)(p.ws + WS_SCR); const bf16_t* Barr = Carr + (size_t)T * D;
    const float* SP = (const float*)(p.ws + WS_LSUM); const float* SH = SP + NBATCH * 32 * D;
    bf16_t* yin = (bf16_t*)(p.ws + WS_YIN);
    typedef float f32x2 __attribute__((ext_vector_type(2)));
    for (int tile = blockIdx.x; tile < NBATCH * 32; tile += gridDim.x) {
        const int c = 2 * tid, b = tile >> 5, chunk = tile & 31;
        f32x2 sp[31], sh[31];
#pragma unroll
        for (int k = 0; k < 31; ++k) { const bool on = k < chunk; const size_t o = (size_t)(b * 32 + (on ? k : 0)) * D + c;
            sp[k] = *(const f32x2*)(SP + o); sh[k] = *(const f32x2*)(SH + o); if (!on) { sp[k] = (f32x2){1.f, 1.f}; sh[k] = (f32x2){0.f, 0.f}; } }
        float h0 = 0.f, h1 = 0.f;
#pragma unroll
        for (int k = 0; k < 31; ++k) { h0 = sp[k][0] * h0 + sh[k][0]; h1 = sp[k][1] * h1 + sh[k][1]; }
        const size_t tb = (size_t)tile * 64;
#pragma unroll 16
        for (int s_ = 0; s_ < 64; ++s_) {
            const size_t t = tb + s_;
            const unsigned cw = *(const unsigned*)(Carr + t * D + c), bw = *(const unsigned*)(Barr + t * D + c), gw = *(const unsigned*)(u + t * 2048 + c);
            h0 = (1.0f - __uint_as_float(cw << 16)) * h0 + __uint_as_float(bw << 16);
            h1 = (1.0f - __uint_as_float(cw & 0xffff0000u)) * h1 + __uint_as_float(bw & 0xffff0000u);
            *(unsigned*)(yin + t * D + c) = pack2(gelu_fast(__uint_as_float(gw << 16)) * h0, gelu_fast(__uint_as_float(gw & 0xffff0000u)) * h1);
        }
    }
}

typedef short s16x4 __attribute__((ext_vector_type(4)));
__device__ __forceinline__ s16x4 tr4(LAS const unsigned char* base, int row0, int col0, int stride, int lane) {
    const int q = (lane & 15) >> 2, pp = lane & 3;
    return __builtin_amdgcn_ds_read_tr16_b64_v4i16((LAS s16x4*)(base + (row0 + q) * stride + (col0 + 4 * pp) * 2));
}
__device__ __forceinline__ bf16x8 cat8(s16x4 a, s16x4 b) { return (bf16x8){a[0], a[1], a[2], a[3], b[0], b[1], b[2], b[3]}; }
__device__ __forceinline__ void ret_core_phase(LAS unsigned char* lds, const Params& p) {
    const int tid0_ = tid_(); const int tid = tid0_, lane = tid & 63, wid = tid >> 6, fr = lane & 15, fq = lane >> 4;
    constexpr int KS = 528, VS = 160, SS = 528;
    LAS unsigned char* Kl = lds;
    LAS unsigned char* Vl = lds + 128 * KS;
    LAS unsigned char* Sl = Vl + 128 * VS;
    const bf16_t* ul_ = (const bf16_t*)(p.ws + WS_U);
    bf16_t* RO = (bf16_t*)(p.ws + WS_SCR);
    for (int un = blockIdx.x; un < NBATCH * 4 * 8; un += gridDim.x) {
        const int b = un >> 5, h = (un >> 3) & 3, vs = un & 7;
        const float lg2 = log2f(1.0f - exp2f(-5.0f - (float)h));
        f32x4 Sacc[2][4];
#pragma unroll
        for (int dt = 0; dt < 2; ++dt)
#pragma unroll
            for (int vt = 0; vt < 4; ++vt) Sacc[dt][vt] = (f32x4){0.f, 0.f, 0.f, 0.f};
        for (int i = tid; i < 64 * SS / 16; i += NTHREADS) ((LAS u32x4*)Sl)[i] = (u32x4){0u, 0u, 0u, 0u};
        u32x4 kraw[8], vraw[2]; bf16x8 Qf[8];
#define RET_LOAD(ch_) do { const size_t tl_ = (size_t)b * SEQ + (ch_) * 128; const bf16_t* u = ul_; int tid = tid0_; asm volatile("" : "+s"(u), "+v"(tid));     \
            _Pragma("unroll") for (int i = 0; i < 8; ++i) { const int piece = tid + NTHREADS * i, m = piece >> 5, ch = piece & 31; kraw[i] = *(const u32x4*)(u + (tl_ + m) * 6144 + 1024 + h * 256 + ch * 8); } \
            _Pragma("unroll") for (int i = 0; i < 2; ++i) { const int piece = tid + NTHREADS * i, m = piece >> 3, ch = piece & 7; vraw[i] = *(const u32x4*)(u + (tl_ + m) * 6144 + 2048 + h * 512 + vs * 64 + ch * 8); } } while (0)
#define RET_LOADQ(ch_) do { const size_t tl_ = (size_t)b * SEQ + (ch_) * 128; const bf16_t* u = ul_; int tid = tid0_; asm volatile("" : "+s"(u), "+v"(tid)); const int wid = tid >> 6, fr = tid & 15, fq = (tid & 63) >> 4; \
            _Pragma("unroll") for (int ks = 0; ks < 8; ++ks) Qf[ks] = *(const bf16x8*)(u + (tl_ + 16 * wid + fr) * 6144 + h * 256 + 32 * ks + 8 * fq); } while (0)
        RET_LOAD(0); RET_LOADQ(0);
        for (int chunk = 0; chunk < 16; ++chunk) {
            const size_t t0 = (size_t)b * SEQ + chunk * 128;
            int tst = tid0_; asm volatile("" : "+v"(tst));
#pragma unroll
            for (int i = 0; i < 8; ++i) {
                const int piece = tst + NTHREADS * i, m = piece >> 5, ch = piece & 31;
                const u32x4 kv = kraw[i];
                const float sc = exp2f(-(float)(m + 1) * lg2) * 0.0625f;
                u32x4 w;
                w.x = pack2(__uint_as_float(kv.x << 16) * sc, __uint_as_float(kv.x & 0xffff0000u) * sc); w.y = pack2(__uint_as_float(kv.y << 16) * sc, __uint_as_float(kv.y & 0xffff0000u) * sc);
                w.z = pack2(__uint_as_float(kv.z << 16) * sc, __uint_as_float(kv.z & 0xffff0000u) * sc); w.w = pack2(__uint_as_float(kv.w << 16) * sc, __uint_as_float(kv.w & 0xffff0000u) * sc);
                *(LAS u32x4*)(Kl + m * KS + ch * 16) = w;
            }
#pragma unroll
            for (int i = 0; i < 2; ++i) {
                const int piece = tst + NTHREADS * i, m = piece >> 3, ch = piece & 7;
                *(LAS u32x4*)(Vl + m * VS + ch * 16) = vraw[i];
            }
            __syncthreads();
            if (chunk + 1 < 16) RET_LOAD(chunk + 1);
            f32x4 sc[8];
#pragma unroll
            for (int mt = 0; mt < 8; ++mt) {
                sc[mt] = (f32x4){0.f, 0.f, 0.f, 0.f};
#pragma unroll
                for (int ks = 0; ks < 8; ++ks) {
                    const bf16x8 kf = *(const LAS bf16x8*)(Kl + (16 * mt + fr) * KS + (32 * ks + 8 * fq) * 2);
                    sc[mt] = __builtin_amdgcn_mfma_f32_16x16x32_bf16(kf, Qf[ks], sc[mt], 0, 0, 0);
                }
                if (mt & 1) __builtin_amdgcn_sched_barrier(0);
            }
            bf16x8 pf[4];
            const int nloc = 16 * wid + fr;
#pragma unroll
            for (int ks2 = 0; ks2 < 4; ++ks2) {
                float v[8];
#pragma unroll
                for (int t = 0; t < 2; ++t)
#pragma unroll
                    for (int r = 0; r < 4; ++r) { const int m = 32 * ks2 + 16 * t + 4 * fq + r; v[4 * t + r] = (m <= nloc) ? sc[2 * ks2 + t][r] : 0.f; }
                u32x4 w; w.x = pack2(v[0], v[1]); w.y = pack2(v[2], v[3]); w.z = pack2(v[4], v[5]); w.w = pack2(v[6], v[7]);
                pf[ks2] = __builtin_bit_cast(bf16x8, w);
            }
            f32x4 O[4];
#pragma unroll
            for (int vt = 0; vt < 4; ++vt) {
                O[vt] = (f32x4){0.f, 0.f, 0.f, 0.f};
#pragma unroll
                for (int ks2 = 0; ks2 < 4; ++ks2) {
                    const bf16x8 vf = cat8(tr4(Vl, 32 * ks2 + 4 * fq, 16 * vt, VS, lane), tr4(Vl, 32 * ks2 + 16 + 4 * fq, 16 * vt, VS, lane));
                    O[vt] = __builtin_amdgcn_mfma_f32_16x16x32_bf16(pf[ks2], vf, O[vt], 0, 0, 0);
                }
#pragma unroll
                for (int ks = 0; ks < 8; ++ks) {
                    const bf16x8 sf = *(const LAS bf16x8*)(Sl + (16 * vt + fr) * SS + (32 * ks + 8 * fq) * 2);
                    O[vt] = __builtin_amdgcn_mfma_f32_16x16x32_bf16(Qf[ks], sf, O[vt], 0, 0, 0);
                }
                __builtin_amdgcn_sched_barrier(0);
            }
#pragma unroll
            for (int r = 0; r < 4; ++r) {
                const int n = 16 * wid + 4 * fq + r;
                const float qd = exp2f((float)(n + 1) * lg2);
                bf16_t* op = RO + (t0 + n) * 2048 + h * 512 + vs * 64 + fr;
#pragma unroll
                for (int vt = 0; vt < 4; ++vt) op[16 * vt] = f2bf(O[vt][r] * qd);
            }
            if (chunk + 1 < 16) RET_LOADQ(chunk + 1);
#pragma unroll
            for (int ks3 = 0; ks3 < 4; ++ks3) {
                bf16x8 kt[2], vf[4];
#pragma unroll
                for (int dt = 0; dt < 2; ++dt) kt[dt] = cat8(tr4(Kl, 32 * ks3 + 8 * fq, 32 * wid + 16 * dt, KS, lane), tr4(Kl, 32 * ks3 + 8 * fq + 4, 32 * wid + 16 * dt, KS, lane));
#pragma unroll
                for (int vt = 0; vt < 4; ++vt) vf[vt] = cat8(tr4(Vl, 32 * ks3 + 8 * fq, 16 * vt, VS, lane), tr4(Vl, 32 * ks3 + 8 * fq + 4, 16 * vt, VS, lane));
#pragma unroll
                for (int dt = 0; dt < 2; ++dt)
#pragma unroll
                    for (int vt = 0; vt < 4; ++vt) Sacc[dt][vt] = __builtin_amdgcn_mfma_f32_16x16x32_bf16(kt[dt], vf[vt], Sacc[dt][vt], 0, 0, 0);
                __builtin_amdgcn_sched_barrier(0);
            }
            __syncthreads();
            const float cd = exp2f(128.0f * lg2);
#pragma unroll
            for (int dt = 0; dt < 2; ++dt)
#pragma unroll
                for (int vt = 0; vt < 4; ++vt) {
                    Sacc[dt][vt] *= cd;
                    u32x2 w; w.x = pack2(Sacc[dt][vt][0], Sacc[dt][vt][1]); w.y = pack2(Sacc[dt][vt][2], Sacc[dt][vt][3]);
                    *(LAS u32x2*)(Sl + (16 * vt + fr) * SS + (32 * wid + 16 * dt + 4 * fq) * 2) = w;
                }
        }
        __syncthreads();
#undef RET_LOAD
#undef RET_LOADQ
    }
}
__device__ __forceinline__ void ret_norm_phase(LAS unsigned char* lds, const Params& p) {
    const int tid = tid_(), lane = tid & 63, wid = tid >> 6;
    const bf16_t* u = (const bf16_t*)(p.ws + WS_U);
    const bf16_t* RO = (const bf16_t*)(p.ws + WS_SCR);
    bf16_t* yin = (bf16_t*)(p.ws + WS_YIN);
    const int nwu = T * 4, stride = (int)gridDim.x * 8;
    for (int wu0 = blockIdx.x * 8 + wid; wu0 < nwu; wu0 += 2 * stride) {
        u32x4 ov[2], gv[2];
#pragma unroll
        for (int q = 0; q < 2; ++q) { const int wu = wu0 + q * stride; const size_t t = (size_t)(wu >> 2); const int h = wu & 3;
            if (wu < nwu) { ov[q] = *(const u32x4*)(RO + t * 2048 + h * 512 + lane * 8); gv[q] = *(const u32x4*)(u + t * 6144 + 4096 + h * 512 + lane * 8); } }
#pragma unroll
        for (int q = 0; q < 2; ++q) { const int wu = wu0 + q * stride; const size_t t = (size_t)(wu >> 2); const int h = wu & 3;
            if (wu < nwu) {
                float o[8], g[8];
                o[0] = __uint_as_float(ov[q].x << 16); o[1] = __uint_as_float(ov[q].x & 0xffff0000u); o[2] = __uint_as_float(ov[q].y << 16); o[3] = __uint_as_float(ov[q].y & 0xffff0000u);
                o[4] = __uint_as_float(ov[q].z << 16); o[5] = __uint_as_float(ov[q].z & 0xffff0000u); o[6] = __uint_as_float(ov[q].w << 16); o[7] = __uint_as_float(ov[q].w & 0xffff0000u);
                g[0] = __uint_as_float(gv[q].x << 16); g[1] = __uint_as_float(gv[q].x & 0xffff0000u); g[2] = __uint_as_float(gv[q].y << 16); g[3] = __uint_as_float(gv[q].y & 0xffff0000u);
                g[4] = __uint_as_float(gv[q].z << 16); g[5] = __uint_as_float(gv[q].z & 0xffff0000u); g[6] = __uint_as_float(gv[q].w << 16); g[7] = __uint_as_float(gv[q].w & 0xffff0000u);
                float ss = 0.f;
#pragma unroll
                for (int j = 0; j < 8; ++j) ss += o[j] * o[j];
                const float rstd = rsqrtf(wave_sum(ss) * (1.0f / 512.0f) + 1e-6f);
                float y[8];
#pragma unroll
                for (int j = 0; j < 8; ++j) y[j] = g[j] * sigmoidf_(g[j]) * o[j] * rstd;
                u32x4 w; w.x = pack2(y[0], y[1]); w.y = pack2(y[2], y[3]); w.z = pack2(y[4], y[5]); w.w = pack2(y[6], y[7]);
                *(u32x4*)(yin + t * 2048 + h * 512 + lane * 8) = w;
            } }
    }
}

__device__ __forceinline__ void attn_core_phase(LAS unsigned char* lds, const Params& p) {
    const int tid0_ = tid_(); const int tid = tid0_, lane = tid & 63, wid = tid >> 6, fr = lane & 15, fq = lane >> 4;
    constexpr int RS = 144, TILE = 272 * RS;
    LAS unsigned char* Kl = lds;
    LAS unsigned char* Vl = lds + TILE;
    const bf16_t* u = (const bf16_t*)(p.ws + WS_U);
    bf16_t* OP = (bf16_t*)(p.ws + WS_SCR);
    float* LSE = (float*)(p.ws + WS_SCR + 96 * MB);
    for (int i = tid; i < 16 * RS / 16; i += NTHREADS) { ((LAS u32x4*)(Kl + 256 * RS))[i] = (u32x4){0u, 0u, 0u, 0u}; ((LAS u32x4*)(Vl + 256 * RS))[i] = (u32x4){0u, 0u, 0u, 0u}; }
    u32x4 kraw[4], vraw[4]; bf16x8 Qn[2];
#define ATT_DECODE(un_) const int g = (un_) >> 11, rem = (un_) & 2047, b = rem >> 8, h = (rem >> 4) & 15, x = rem & 15; \
        const int dl = (g == 0) ? 1 : (g == 1 ? 4 : 16), r_ = x & (dl - 1), n = x / dl
#define ATT_LOAD(un_) do { ATT_DECODE(un_); int tl_ = tid0_; const bf16_t* ub = u; asm volatile("" : "+v"(tl_), "+s"(ub)); ub += (size_t)b * SEQ * 9216; \
        _Pragma("unroll") for (int i = 0; i < 4; ++i) { const int piece = tl_ + NTHREADS * i, row = piece >> 3, ch = piece & 7; const int sk = ((n - 1) * 128 + row) * dl + r_; \
            kraw[i] = (u32x4){0u, 0u, 0u, 0u}; vraw[i] = (u32x4){0u, 0u, 0u, 0u}; \
            if (sk >= 0) { const bf16_t* src = ub + (size_t)sk * 9216 + h * 64 + ch * 8; kraw[i] = *(const u32x4*)(src + (3 + g) * 1024); vraw[i] = *(const u32x4*)(src + (6 + g) * 1024); } } \
        { const int sq_ = (n * 128 + 16 * (tl_ >> 6) + (tl_ & 15)) * dl + r_; \
          _Pragma("unroll") for (int ks = 0; ks < 2; ++ks) Qn[ks] = *(const bf16x8*)(ub + (size_t)sq_ * 9216 + g * 1024 + h * 64 + 32 * ks + 8 * ((tl_ & 63) >> 4)); } } while (0)
    if ((int)blockIdx.x < 3 * 2048) ATT_LOAD((int)blockIdx.x);
    for (int un = blockIdx.x; un < 3 * 2048; un += gridDim.x) {
        ATT_DECODE(un);
        const float slope = exp2f(-0.5f * (float)(h + 1)) * (float)dl;
        { int tl_ = tid0_; asm volatile("" : "+v"(tl_));
#pragma unroll
          for (int i = 0; i < 4; ++i) {
            const int piece = tl_ + NTHREADS * i, row = piece >> 3, ch = piece & 7;
            *(LAS u32x4*)(Kl + row * RS + ch * 16) = kraw[i]; *(LAS u32x4*)(Vl + row * RS + ch * 16) = vraw[i];
          } }
        const int qi = 16 * wid + fr, sq = (n * 128 + qi) * dl + r_;
        bf16x8 Qf[2];
#pragma unroll
        for (int ks = 0; ks < 2; ++ks) Qf[ks] = Qn[ks];
        __syncthreads();
        if (un + (int)gridDim.x < 3 * 2048) ATT_LOAD(un + (int)gridDim.x);
        f32x4 sc[9];
        float mx = -INFINITY;
#pragma unroll
        for (int kt = 0; kt < 9; ++kt) {
            sc[kt] = (f32x4){0.f, 0.f, 0.f, 0.f};
#pragma unroll
            for (int ks = 0; ks < 2; ++ks) {
                const bf16x8 kf = *(const LAS bf16x8*)(Kl + (16 * (wid + kt) + fr) * RS + (32 * ks + 8 * fq) * 2);
                sc[kt] = __builtin_amdgcn_mfma_f32_16x16x32_bf16(kf, Qf[ks], sc[kt], 0, 0, 0);
            }
#pragma unroll
            for (int r = 0; r < 4; ++r) {
                const int ki = 16 * (wid + kt) + 4 * fq + r, steps = qi + 128 - ki;
                const bool ok = (steps >= 0) && (steps <= 128) && (n > 0 || ki >= 128);
                const float v = ok ? sc[kt][r] * 0.125f - slope * (float)steps : -INFINITY;
                sc[kt][r] = v; mx = fmaxf(mx, v);
            }
        }
        mx = fmaxf(mx, __shfl_xor(mx, 16)); mx = fmaxf(mx, __shfl_xor(mx, 32));
        float l = 0.f;
#pragma unroll
        for (int kt = 0; kt < 9; ++kt)
#pragma unroll
            for (int r = 0; r < 4; ++r) { const float pv = __expf(sc[kt][r] - mx); sc[kt][r] = pv; l += pv; }
        l += __shfl_xor(l, 16); l += __shfl_xor(l, 32);
        f32x4 O[4];
#pragma unroll
        for (int dt = 0; dt < 4; ++dt) O[dt] = (f32x4){0.f, 0.f, 0.f, 0.f};
#pragma unroll
        for (int ks5 = 0; ks5 < 5; ++ks5) {
            const f32x4 p0 = sc[2 * ks5], p1 = (ks5 < 4) ? sc[(ks5 < 4) ? 2 * ks5 + 1 : 0] : (f32x4){0.f, 0.f, 0.f, 0.f};
            u32x4 w; w.x = pack2(p0[0], p0[1]); w.y = pack2(p0[2], p0[3]); w.z = pack2(p1[0], p1[1]); w.w = pack2(p1[2], p1[3]);
            const bf16x8 pf = __builtin_bit_cast(bf16x8, w);
#pragma unroll
            for (int dt = 0; dt < 4; ++dt) {
                const bf16x8 vf = cat8(tr4(Vl, 16 * (wid + 2 * ks5) + 4 * fq, 16 * dt, RS, lane), tr4(Vl, 16 * (wid + 2 * ks5 + 1) + 4 * fq, 16 * dt, RS, lane));
                O[dt] = __builtin_amdgcn_mfma_f32_16x16x32_bf16(vf, pf, O[dt], 0, 0, 0);
            }
        }
        const float inv = __builtin_amdgcn_rcpf(l);
        const size_t tq = (size_t)b * SEQ + sq;
#pragma unroll
        for (int dt = 0; dt < 4; ++dt) {
            u32x2 w; w.x = pack2(O[dt][0] * inv, O[dt][1] * inv); w.y = pack2(O[dt][2] * inv, O[dt][3] * inv);
            *(u32x2*)(OP + ((size_t)g * T + tq) * D + h * 64 + 16 * dt + 4 * fq) = w;
        }
        if (fq == 0) LSE[((size_t)g * T + tq) * 16 + h] = mx + __logf(l);
        __syncthreads();
    }
#undef ATT_DECODE
#undef ATT_LOAD
}
__device__ __forceinline__ void attn_merge_phase(const Params& p) {
    const int tid = tid_();
    const bf16_t* OP = (const bf16_t*)(p.ws + WS_SCR);
    const float* LSE = (const float*)(p.ws + WS_SCR + 96 * MB);
    bf16_t* yin = (bf16_t*)(p.ws + WS_YIN);
    const size_t n = (size_t)T * D / 8, stride = (size_t)gridDim.x * NTHREADS;
    for (size_t i0 = (size_t)blockIdx.x * NTHREADS + tid; i0 < n; i0 += 2 * stride) {
        u32x4 a[2], bq[2], c[2]; float l0[2], l1[2], l2[2];
#pragma unroll
        for (int q = 0; q < 2; ++q) { const size_t i = i0 + q * stride; if (i < n) { const size_t t = i >> 7; const int c8 = (int)(i & 127), h = c8 >> 3;
            l0[q] = LSE[t * 16 + h]; l1[q] = LSE[((size_t)T + t) * 16 + h]; l2[q] = LSE[((size_t)2 * T + t) * 16 + h];
            a[q] = *(const u32x4*)(OP + t * D + c8 * 8); bq[q] = *(const u32x4*)(OP + ((size_t)T + t) * D + c8 * 8); c[q] = *(const u32x4*)(OP + ((size_t)2 * T + t) * D + c8 * 8); } }
#pragma unroll
        for (int q = 0; q < 2; ++q) { const size_t i = i0 + q * stride; if (i < n) { const size_t t = i >> 7; const int c8 = (int)(i & 127);
            const float m = fmaxf(l0[q], fmaxf(l1[q], l2[q]));
            float w0 = __expf(l0[q] - m), w1 = __expf(l1[q] - m), w2 = __expf(l2[q] - m);
            const float inv = __builtin_amdgcn_rcpf(w0 + w1 + w2); w0 *= inv; w1 *= inv; w2 *= inv;
            u32x4 o;
#define MRG(f) o.f = pack2(w0 * __uint_as_float(a[q].f << 16) + w1 * __uint_as_float(bq[q].f << 16) + w2 * __uint_as_float(c[q].f << 16), \
                           w0 * __uint_as_float(a[q].f & 0xffff0000u) + w1 * __uint_as_float(bq[q].f & 0xffff0000u) + w2 * __uint_as_float(c[q].f & 0xffff0000u))
            MRG(x); MRG(y); MRG(z); MRG(w);
#undef MRG
            *(u32x4*)(yin + t * D + c8 * 8) = o; } }
    }
}

__device__ __forceinline__ void ln1_router_phase(LAS unsigned char* lds, const Params& p, int layer) {
    const int tid = tid_(), lane = tid & 63, wid = tid >> 6, fr = lane & 15, fq = lane >> 4;
    constexpr int XS = 2064;
    LAS unsigned char* xh = lds;
    LAS unsigned char* xl = lds + 16 * XS;
    LAS float* part = (LAS float*)(lds + 32 * XS);
    LAS float* logit = part + 8 * 16 * 32;
    LAS int* tkE = (LAS int*)(logit + 16 * 32);
    LAS int* tkR = tkE + 512;
    LAS int* hist = tkR + 512;
    LAS int* hbase = hist + 32;
    float* xf = (float*)(p.ws + WS_XF); bf16_t* xb = (bf16_t*)(p.ws + WS_XB);
    const bf16_t* ymix = (const bf16_t*)(p.ws + WS_YMIX);
    int* tope = (int*)(p.ws + WS_TOPE); float* gates = (float*)(p.ws + WS_GATES); int* pos = (int*)(p.ws + WS_POS);
    unsigned char* xq = p.ws + WS_XQ; int* elist = (int*)(p.ws + WS_LIST);
    unsigned* ctl = (unsigned*)(p.ws + WS_CTL);
    const float* gain = p.ln_gain + (size_t)(layer * 2) * D; const float* bias = p.ln_bias + (size_t)(layer * 2) * D;
    const float* brt = p.moe_b_router + (size_t)layer * NEXP;
    const bf16_t* rth = (const bf16_t*)(p.ws + WS_RT) + (size_t)layer * 2 * NEXP * D; const bf16_t* rtl = rth + NEXP * D;
    bf16x8 Wh[2][4], Wl[2][4];
#pragma unroll
    for (int nt = 0; nt < 2; ++nt)
#pragma unroll
        for (int ks = 0; ks < 4; ++ks) { const size_t o = (size_t)(16 * nt + fr) * D + 128 * wid + 32 * ks + 8 * fq; Wh[nt][ks] = *(const bf16x8*)(rth + o); Wl[nt][ks] = *(const bf16x8*)(rtl + o); }
    if (tid < NEXP) hist[tid] = 0;
    int it = 0;
    for (int tile = blockIdx.x; tile < T / 16; tile += gridDim.x) {
#pragma unroll
        for (int tt = 0; tt < 2; ++tt) {
            const int trow = 2 * wid + tt; const size_t t = (size_t)tile * 16 + trow;
            f32x4 z[4];
#pragma unroll
            for (int i = 0; i < 4; ++i) { const int c = 256 * i + 4 * lane; const u32x2 yv = *(const u32x2*)(ymix + t * D + c);
                z[i] = DN_ALPHA * *(const f32x4*)(xf + t * D + c) + (f32x4){__uint_as_float(yv.x << 16), __uint_as_float(yv.x & 0xffff0000u), __uint_as_float(yv.y << 16), __uint_as_float(yv.y & 0xffff0000u)}; }
            float sm = 0.f;
#pragma unroll
            for (int i = 0; i < 4; ++i) sm += (z[i][0] + z[i][1]) + (z[i][2] + z[i][3]);
            const float mean = wave_sum(sm) * (1.0f / D);
            float sq = 0.f;
#pragma unroll
            for (int i = 0; i < 4; ++i) { const f32x4 dd = z[i] - mean; sq += (dd[0] * dd[0] + dd[1] * dd[1]) + (dd[2] * dd[2] + dd[3] * dd[3]); }
            const float rstd = rsqrtf(wave_sum(sq) * (1.0f / D) + LN_EPS);
#pragma unroll
            for (int i = 0; i < 4; ++i) {
                const int c = 256 * i + 4 * lane;
                const f32x4 v = (z[i] - mean) * rstd * *(const f32x4*)(gain + c) + *(const f32x4*)(bias + c);
                *(f32x4*)(xf + t * D + c) = v;
                u32x2 wh; wh.x = pack2(v[0], v[1]); wh.y = pack2(v[2], v[3]);
                *(unsigned*)(xq + t * D + c) = pk_fp8x4(v[0], v[1], v[2], v[3]);
                const float r0 = v[0] - __uint_as_float(wh.x << 16), r1 = v[1] - __uint_as_float(wh.x & 0xffff0000u), r2 = v[2] - __uint_as_float(wh.y << 16), r3 = v[3] - __uint_as_float(wh.y & 0xffff0000u);
                u32x2 wl; wl.x = pack2(r0, r1); wl.y = pack2(r2, r3);
                *(LAS u32x2*)(xh + trow * XS + c * 2) = wh; *(LAS u32x2*)(xl + trow * XS + c * 2) = wl;
            }
        }
        __syncthreads();
        {
            f32x4 acc[2] = {(f32x4){0.f, 0.f, 0.f, 0.f}, (f32x4){0.f, 0.f, 0.f, 0.f}};
#pragma unroll
            for (int ks = 0; ks < 4; ++ks) {
                const bf16x8 ah = *(const LAS bf16x8*)(xh + fr * XS + (128 * wid + 32 * ks + 8 * fq) * 2), al = *(const LAS bf16x8*)(xl + fr * XS + (128 * wid + 32 * ks + 8 * fq) * 2);
#pragma unroll
                for (int nt = 0; nt < 2; ++nt) {
                    acc[nt] = __builtin_amdgcn_mfma_f32_16x16x32_bf16(Wh[nt][ks], ah, acc[nt], 0, 0, 0);
                    acc[nt] = __builtin_amdgcn_mfma_f32_16x16x32_bf16(Wh[nt][ks], al, acc[nt], 0, 0, 0);
                    acc[nt] = __builtin_amdgcn_mfma_f32_16x16x32_bf16(Wl[nt][ks], ah, acc[nt], 0, 0, 0);
                }
            }
#pragma unroll
            for (int nt = 0; nt < 2; ++nt) *(LAS f32x4*)(part + (wid * 16 + fr) * 32 + 16 * nt + 4 * fq) = acc[nt];
        }
        __syncthreads();
        {
            const int tk = tid >> 5, e = tid & 31;
            float sacc = brt[e];
#pragma unroll
            for (int w = 0; w < 8; ++w) sacc += part[(w * 16 + tk) * 32 + e];
            logit[tk * 32 + e] = sacc;
        }
        __syncthreads();
        if (tid < 16) {
            const size_t t = (size_t)tile * 16 + tid;
            float v0 = -INFINITY, v1 = -INFINITY, v2 = -INFINITY, v3 = -INFINITY; int i0 = 0, i1 = 0, i2 = 0, i3 = 0;
#pragma unroll
            for (int e = 0; e < NEXP; ++e) {
                const float v = logit[tid * 32 + e];
                if (v > v3) {
                    if (v > v0) { v3 = v2; i3 = i2; v2 = v1; i2 = i1; v1 = v0; i1 = i0; v0 = v; i0 = e; }
                    else if (v > v1) { v3 = v2; i3 = i2; v2 = v1; i2 = i1; v1 = v; i1 = e; }
                    else if (v > v2) { v3 = v2; i3 = i2; v2 = v; i2 = e; }
                    else { v3 = v; i3 = e; }
                }
            }
            const float e1 = __expf(v1 - v0), e2 = __expf(v2 - v0), e3 = __expf(v3 - v0), inv = 1.0f / (1.0f + e1 + e2 + e3);
            tope[t * 4 + 0] = i0; tope[t * 4 + 1] = i1; tope[t * 4 + 2] = i2; tope[t * 4 + 3] = i3;
            gates[t * 4 + 0] = inv; gates[t * 4 + 1] = e1 * inv; gates[t * 4 + 2] = e2 * inv; gates[t * 4 + 3] = e3 * inv;
            const int sl = (it & 7) * 16 + tid;
            tkE[sl * 4 + 0] = i0; tkR[sl * 4 + 0] = (int)atomicAdd((unsigned*)(hist + i0), 1u);
            tkE[sl * 4 + 1] = i1; tkR[sl * 4 + 1] = (int)atomicAdd((unsigned*)(hist + i1), 1u);
            tkE[sl * 4 + 2] = i2; tkR[sl * 4 + 2] = (int)atomicAdd((unsigned*)(hist + i2), 1u);
            tkE[sl * 4 + 3] = i3; tkR[sl * 4 + 3] = (int)atomicAdd((unsigned*)(hist + i3), 1u);
        }
        ++it;
        if ((it & 7) == 0 || tile + (int)gridDim.x >= T / 16) {
            __syncthreads();
            if (tid < NEXP) { const unsigned h = (unsigned)hist[tid]; hbase[tid] = h ? (int)atomicAdd(ctl + CW_CNT + layer * 64 + tid, h) : 0; hist[tid] = 0; }
            __syncthreads();
            const int nsl = (((it - 1) & 7) + 1) * 16;
            for (int a = tid; a < nsl * 4; a += NTHREADS) {
                const int sl = a >> 2, e = tkE[a], ps = hbase[e] + tkR[a];
                const int t = (tile - (((it - 1) & 7) - (sl >> 4)) * (int)gridDim.x) * 16 + (sl & 15);
                pos[t * 4 + (a & 3)] = ps; elist[(size_t)e * T + ps] = t;
            }
            __syncthreads();
        }
    }
    __syncthreads();
}
__device__ __forceinline__ void ln2_phase(LAS unsigned char* lds, const Params& p, int layer) {
    const int tid = tid_(), lane = tid & 63, wid = tid >> 6;
    moe_tables(lds, (const unsigned*)(p.ws + WS_CTL), layer);
    LAS const int* tab = (LAS const int*)(lds + TAB_OFF);
    const int* tope = (const int*)(p.ws + WS_TOPE); const int* pos = (const int*)(p.ws + WS_POS);
    float* xf = (float*)(p.ws + WS_XF);
    const bf16_t* yrows = (const bf16_t*)(p.ws + WS_YROWS);
    const float* gates = (const float*)(p.ws + WS_GATES);
    const float* gain = p.ln_gain + (size_t)(layer * 2 + 1) * D; const float* bias = p.ln_bias + (size_t)(layer * 2 + 1) * D;
    const int stride = (int)gridDim.x * 8;
    for (int t0 = blockIdx.x * 8 + wid; t0 < T; t0 += 2 * stride) {
        int dk[2][4]; float gk[2][4];
#pragma unroll
        for (int q = 0; q < 2; ++q) { const int t = (t0 + q * stride < T) ? t0 + q * stride : t0;
#pragma unroll
            for (int k = 0; k < 4; ++k) { dk[q][k] = tab[tope[t * 4 + k]] * 256 + pos[t * 4 + k]; gk[q][k] = gates[t * 4 + k]; } }
        u32x2 yv[2][4][4]; f32x4 xv[2][4];
#pragma unroll
        for (int q = 0; q < 2; ++q) { const int t = (t0 + q * stride < T) ? t0 + q * stride : t0;
#pragma unroll
            for (int i = 0; i < 4; ++i) { const int c = 256 * i + 4 * lane; xv[q][i] = *(const f32x4*)(xf + (size_t)t * D + c);
#pragma unroll
                for (int k = 0; k < 4; ++k) yv[q][i][k] = *(const u32x2*)(yrows + (size_t)dk[q][k] * D + c); } }
#pragma unroll
        for (int q = 0; q < 2; ++q) { const int t = t0 + q * stride; if (t < T) {
            f32x4 z[4];
#pragma unroll
            for (int i = 0; i < 4; ++i) {
                f32x4 f = (f32x4){0.f, 0.f, 0.f, 0.f};
#pragma unroll
                for (int k = 0; k < 4; ++k) { const u32x2 y2 = yv[q][i][k]; const float gg = gk[q][k];
                    f[0] += gg * __uint_as_float(y2.x << 16); f[1] += gg * __uint_as_float(y2.x & 0xffff0000u); f[2] += gg * __uint_as_float(y2.y << 16); f[3] += gg * __uint_as_float(y2.y & 0xffff0000u); }
                z[i] = DN_ALPHA * xv[q][i] + f;
            }
            float sm = 0.f;
#pragma unroll
            for (int i = 0; i < 4; ++i) sm += (z[i][0] + z[i][1]) + (z[i][2] + z[i][3]);
            const float mean = wave_sum(sm) * (1.0f / D);
            float sq = 0.f;
#pragma unroll
            for (int i = 0; i < 4; ++i) { const f32x4 dd = z[i] - mean; sq += (dd[0] * dd[0] + dd[1] * dd[1]) + (dd[2] * dd[2] + dd[3] * dd[3]); }
            const float rstd = rsqrtf(wave_sum(sq) * (1.0f / D) + LN_EPS);
#pragma unroll
            for (int i = 0; i < 4; ++i) {
                const int c = 256 * i + 4 * lane;
                z[i] = (z[i] - mean) * rstd * *(const f32x4*)(gain + c) + *(const f32x4*)(bias + c);
                if (layer == DEPTH - 1) *(f32x4*)(p.out + (size_t)t * D + c) = z[i];
                else { *(f32x4*)(xf + (size_t)t * D + c) = z[i]; *(unsigned*)(p.ws + WS_XQ + (size_t)t * D + c) = pk_fp8x4(z[i][0], z[i][1], z[i][2], z[i][3]); }
            }
        } }
    }
}

__device__ __forceinline__ void moe_scatter_phase(LAS unsigned char* lds, const Params& p, int layer) {
    const int tid = tid_();
    LAS int* pstart = (LAS int*)lds;
    unsigned* ctl = (unsigned*)(p.ws + WS_CTL);
    const int* tope = (const int*)(p.ws + WS_TOPE); const int* pos = (const int*)(p.ws + WS_POS);
    int* dest = (int*)(p.ws + WS_DEST); int* rowtok = (int*)(p.ws + WS_ROWTOK);
    if (tid == 0) {
        int acc = 0;
        for (int e = 0; e < NEXP; ++e) { const int c = (int)ctl[CW_CNT + layer * 64 + e]; pstart[e] = acc; pstart[32 + e] = c; acc += ((c + 255) >> 8) << 8; }
        pstart[64] = acc;
        if (blockIdx.x == 0) {
            ctl[CW_MDYN + layer * 64] = (unsigned)acc;
            for (int e = 0; e < NEXP; ++e) { const int nb = (pstart[32 + e] + 255) >> 8; for (int b = 0; b < nb; ++b) ctl[CW_TEXP + layer * 512 + (pstart[e] >> 8) + b] = (unsigned)e; }
        }
    }
    __syncthreads();
    for (int i = blockIdx.x * NTHREADS + tid; i < T * TOPK; i += gridDim.x * NTHREADS) {
        const int e = tope[i], row = pstart[e] + pos[i];
        dest[i] = row; rowtok[row] = i >> 2;
    }
    for (int i = blockIdx.x * NTHREADS + tid; i < NEXP * 256; i += gridDim.x * NTHREADS) {
        const int e = i >> 8, r = i & 255, c = pstart[32 + e], padded = ((c + 255) >> 8) << 8;
        if (c + r < padded) rowtok[pstart[e] + c + r] = 0;
    }
    __syncthreads();
}

constexpr int PH_PER_LAYER = 9;
constexpr int NPHASES = 1 + DEPTH * PH_PER_LAYER;
constexpr int LDS_BYTES = 132 * 1024;


#ifndef PHMASK
#define PHMASK 0x3FF
#endif
#define PHK(j) ((PHMASK >> (j)) & 1)
#ifndef PROBE_MASK
#define PROBE_MASK 0
#endif
#ifndef PROBE_LAYERS
#define PROBE_LAYERS 0xF
#endif
#define REPS(j) ((((PROBE_MASK) >> (j)) & 1) ? 2 : 1)
#define REPSL(j) (((((PROBE_MASK) >> (j)) & 1) && (((PROBE_LAYERS) >> layer) & 1)) ? 2 : 1)
#define IN(k) (lo <= (k) && (k) < hi)
#if MK_ONE_LAUNCH
#define SEAM(k) do { if (IN(k) && IN((k) + 1)) xcd_barrier_nv(bar.bar, bar.x, bar.st); } while (0)
#else
#define SEAM(k) do {} while (0)
#endif
template <int layer>
__device__ __forceinline__ void run_layer(const Params& p, LAS unsigned char* lds, const XcdBarrier& bar) {
    const int lo = p.ph_lo, hi = p.ph_hi;
    unsigned char* ws = p.ws;
    unsigned* ctl = (unsigned*)(ws + WS_CTL);
        constexpr int base = 1 + layer * PH_PER_LAYER, kind = layer % 3, idx = layer / 3;
        for (int rep_ = 0; rep_ < REPSL(1); ++rep_) if (PHK(1) && IN(base + 0)) {
            constexpr int N = (kind == 0) ? 2048 : (kind == 1 ? 6144 : 9216);
            const unsigned char* Bt = (kind == 0) ? ws + WS_AWIN + (size_t)idx * 2048 * D : (kind == 1 ? ws + WS_BWIN : ws + WS_CWIN);
            g8::SchedPlain S; S.init(ws + WS_XQ, Bt, T, N, D / 2, (int)gridDim.x, (int)blockIdx.x);
            g8::EpiBf16 E{(bf16_t*)(ws + WS_U), N, nullptr, 0, 1.0f / GU_WSCALE};
            g8::gemm_phase<g8::EpiBf16, g8::SchedPlain, false, 1>(lds, D, S, E);
        }
        SEAM(base + 0);
        for (int rep_ = 0; rep_ < REPSL(2); ++rep_) if (PHK(2) && IN(base + 1)) {
            if (kind == 0) lru_gates_phase(lds, p, idx);
            else if (kind == 1) ret_core_phase(lds, p);
            else attn_core_phase(lds, p);
        }
        SEAM(base + 1);
        for (int rep_ = 0; rep_ < REPSL(3); ++rep_) if (PHK(3) && IN(base + 2)) {
            if (kind == 0) lru_scan_phase(p);
            else if (kind == 1) ret_norm_phase(lds, p);
            else attn_merge_phase(p);
        }
        SEAM(base + 2);
        for (int rep_ = 0; rep_ < REPSL(4); ++rep_) if (PHK(4) && IN(base + 3)) {
            constexpr int K = (kind == 1) ? 2048 : D;
            const bf16_t* Bt = (kind == 0) ? (const bf16_t*)(ws + WS_AWOUT) + (size_t)idx * D * D : (kind == 1 ? (const bf16_t*)(ws + WS_BWOUT) : (const bf16_t*)(ws + WS_CWOUT));
            g8::SchedPlain S; S.init(ws + WS_YIN, Bt, T, D, K, (int)gridDim.x, (int)blockIdx.x);
            g8::EpiBf16 E{(bf16_t*)(ws + WS_YMIX), D, nullptr, 0, 1.0f};
            g8::gemm_phase<g8::EpiBf16, g8::SchedPlain, false>(lds, K, S, E);
        }
        SEAM(base + 3);
        for (int rep_ = 0; rep_ < REPSL(5); ++rep_) if (PHK(5) && IN(base + 4)) ln1_router_phase(lds, p, layer);
        SEAM(base + 4);
        for (int rep_ = 0; rep_ < REPSL(7); ++rep_) if (PHK(7) && IN(base + 6)) {
            moe_tables(lds, ctl, layer);
            g8::SchedGU S{(const char*)(ws + WS_XQ), (const char*)(ws + WS_GU) + (size_t)layer * NEXP * 2048 * D, (const int*)(ws + WS_LIST), (LAS const int*)(lds + TAB_OFF), (int)gridDim.x, (int)blockIdx.x};
            g8::EpiSwiglu E{ws + WS_HID, p.moe_b_gu + (size_t)layer * NEXP * 2048, 1.0f / GU_WSCALE};
            g8::gemm_phase<g8::EpiSwiglu, g8::SchedGU, true, 1>(lds, D, S, E);
        }
        SEAM(base + 6);
        for (int rep_ = 0; rep_ < REPSL(8); ++rep_) if (PHK(8) && IN(base + 7)) {
            moe_tables(lds, ctl, layer);
            g8::SchedDown S{(const char*)(ws + WS_HID), (const char*)(ws + WS_DN) + (size_t)layer * NEXP * D * D, (LAS const int*)(lds + TAB_OFF), (int)gridDim.x, (int)blockIdx.x};
            g8::EpiBf16 E{(bf16_t*)(ws + WS_YROWS), D, p.moe_b_down + (size_t)layer * NEXP * D, D, 1.0f / DN_WSCALE};
            g8::gemm_phase<g8::EpiBf16, g8::SchedDown, false, 1>(lds, D, S, E);
        }
        SEAM(base + 7);
        for (int rep_ = 0; rep_ < REPSL(9); ++rep_) if (PHK(9) && IN(base + 8)) ln2_phase(lds, p, layer);
        SEAM(base + 8);
    }
#undef IN
#undef SEAM
__global__ void __launch_bounds__(NTHREADS, 2) fwd_kernel(Params p) {
    extern __shared__ __attribute__((aligned(16))) unsigned char lds_raw[];
    LAS unsigned char* lds = (LAS unsigned char*)lds_raw;
    const int lo = p.ph_lo, hi = p.ph_hi;
    unsigned char* ws = p.ws;
    unsigned* ctl = (unsigned*)(ws + WS_CTL);
#if MK_ONE_LAUNCH
    volatile LAS unsigned* bst = (volatile LAS unsigned*)(lds + LDS_BYTES - 16);
    if (threadIdx.x == 0) { bst[0] = 0u; bst[1] = 0u; bst[2] = 0u; bst[3] = 0u; }
    __syncthreads();
    XcdBarrier bar = xcd_barrier_post(ctl, bst);
#define GRID_BAR() xcd_barrier_nv(bar.bar, bar.x, bar.st)
#else
    XcdBarrier bar; bar.bar = ctl; bar.x = 0; bar.st = nullptr;
#define GRID_BAR() do {} while (0)
#endif
#define IN(k) (lo <= (k) && (k) < hi)
#define SEAM(k) do { if (IN(k) && IN((k) + 1)) GRID_BAR(); } while (0)

    for (int rep_ = 0; rep_ < REPS(0); ++rep_) if (PHK(0) && IN(0)) {
        LAS float* tile = (LAS float*)lds;
#pragma unroll 1
        for (int j = 0; j < 5; ++j) {
            const float* src = j == 0 ? p.moe_w_gu : (j == 1 ? p.moe_w_down : (j == 2 ? p.a_w_in : (j == 3 ? p.b_w_in : p.c_w_in)));
            const size_t dsto = j == 0 ? WS_GU : (j == 1 ? WS_DN : (j == 2 ? WS_AWIN : (j == 3 ? WS_BWIN : WS_CWIN)));
            const int N = j == 0 ? 2048 : (j == 1 ? D : (j == 2 ? 2048 : (j == 3 ? 6144 : 9216)));
            const int batch = j < 2 ? DEPTH * NEXP : (j == 2 ? 2 : 1);
            convert_big<true>(lds, src, ws + dsto, D, N, batch, j == 1 ? DN_WSCALE : GU_WSCALE);
        }
#pragma unroll 1
        for (int j = 0; j < 3; ++j) {
            const float* src = j == 0 ? p.a_w_out : (j == 1 ? p.b_w_out : p.c_w_out);
            const size_t dsto = j == 0 ? WS_AWOUT : (j == 1 ? WS_BWOUT : WS_CWOUT);
            convert_big<false>(lds, src, ws + dsto, j == 1 ? 2048 : D, D, j == 0 ? 2 : 1, 1.0f);
        }
        convert_job(tile, p.a_w_rgate, (bf16_t*)(ws + WS_AGT), 128, 128, 8);
        convert_job(tile, p.a_w_igate, (bf16_t*)(ws + WS_AGT) + (size_t)8 * 128 * 128, 128, 128, 8);
        convert_job(tile, p.a_w_rgate + (size_t)8 * 128 * 128, (bf16_t*)(ws + WS_AGT) + (size_t)16 * 128 * 128, 128, 128, 8);
        convert_job(tile, p.a_w_igate + (size_t)8 * 128 * 128, (bf16_t*)(ws + WS_AGT) + (size_t)24 * 128 * 128, 128, 128, 8);
        {
            bf16_t* rt = (bf16_t*)(ws + WS_RT);
            for (int i = blockIdx.x * NTHREADS + threadIdx.x; i < DEPTH * NEXP * D; i += gridDim.x * NTHREADS) {
                const int l = i / (NEXP * D), r_ = i % (NEXP * D), e = r_ / D, k = r_ % D;
                const float w = p.moe_w_router[((size_t)l * D + k) * NEXP + e];
                const bf16_t hi = f2bf(w); const bf16_t lo = f2bf(w - bf2f(hi));
                rt[((size_t)l * 2 + 0) * NEXP * D + (size_t)e * D + k] = hi; rt[((size_t)l * 2 + 1) * NEXP * D + (size_t)e * D + k] = lo;
            }
        }
        float* xf = (float*)(ws + WS_XF); bf16_t* xb = (bf16_t*)(ws + WS_XB);
        {
            const size_t stride = (size_t)gridDim.x * NTHREADS;
            for (size_t i = (size_t)blockIdx.x * NTHREADS + threadIdx.x; i < (size_t)T * D / 4; i += 4 * stride) {
                f32x4 v[4];
#pragma unroll
                for (int q = 0; q < 4; ++q) v[q] = *(const f32x4*)(p.x + (i + q * stride) * 4);
#pragma unroll
                for (int q = 0; q < 4; ++q) { *(f32x4*)(xf + (i + q * stride) * 4) = v[q]; *(unsigned*)(ws + WS_XQ + (i + q * stride) * 4) = pk_fp8x4(v[q][0], v[q][1], v[q][2], v[q][3]); }
            }
        }
    }
    SEAM(0);

    run_layer<0>(p, lds, bar); run_layer<1>(p, lds, bar); run_layer<2>(p, lds, bar); run_layer<3>(p, lds, bar);
#undef IN
#undef SEAM
}

extern "C" void kernel_launch(void* const* d_in, const int* in_sizes, int n_in, void* d_out, int out_size, void* d_ws, size_t ws_size, hipStream_t stream) {
    static int grid = 0;
    if (grid == 0) {
        if (n_in != 22 || out_size != T * D || ws_size < WS_END) { fprintf(stderr, "kernel_launch: unexpected shapes (n_in %d out %d ws %zu need %zu)\n", n_in, out_size, ws_size, (size_t)WS_END); grid = -1; return; }
        if (hipFuncSetAttribute((const void*)fwd_kernel, hipFuncAttributeMaxDynamicSharedMemorySize, LDS_BYTES) != hipSuccess) { fprintf(stderr, "kernel_launch: hipFuncSetAttribute failed\n"); grid = -1; return; }
        int dev = 0, cus = 0;
        if (hipGetDevice(&dev) != hipSuccess || hipDeviceGetAttribute(&cus, hipDeviceAttributeMultiprocessorCount, dev) != hipSuccess) { grid = -1; return; }
        grid = cus;
    }
    if (grid < 0) return;
    (void)hipMemsetAsync((char*)d_ws + WS_CTL, 0, CTL_BYTES, stream);
    Params p{};
    const float** pp = (const float**)&p;
    for (int i = 0; i < 22; ++i) pp[i] = (const float*)d_in[i];
    p.out = (float*)d_out; p.ws = (unsigned char*)d_ws;
#if MK_ONE_LAUNCH
    p.ph_lo = 0; p.ph_hi = NPHASES;
    hipLaunchKernelGGL(fwd_kernel, dim3(grid), dim3(NTHREADS), LDS_BYTES, stream, p);
#else
    for (int ph = 0; ph < NPHASES; ++ph) {
        p.ph_lo = ph; p.ph_hi = ph + 1;
        hipLaunchKernelGGL(fwd_kernel, dim3(grid), dim3(NTHREADS), LDS_BYTES, stream, p);
    }
#endif
}
```

```cpp
#include <hip/hip_runtime.h>
#include <stdint.h>
#include <stdio.h>

#ifndef MK_ONE_LAUNCH
#define MK_ONE_LAUNCH 1
#endif

#define LAS __attribute__((address_space(3)))
typedef unsigned short bf16_t;
typedef short bf16x8 __attribute__((ext_vector_type(8)));
typedef float f32x4 __attribute__((ext_vector_type(4)));
typedef unsigned u32x4 __attribute__((ext_vector_type(4)));
typedef unsigned u32x2 __attribute__((ext_vector_type(2)));

constexpr int T = 16384, D = 1024, SEQ = 2048, NBATCH = 8, DEPTH = 4;
constexpr int NEXP = 32, TOPK = 4;
constexpr int MAXROWS = 73728;
constexpr float DN_ALPHA = 1.681792830507429f;
constexpr float LN_EPS = 1e-5f;
constexpr float GU_WSCALE = 64.0f, DN_WSCALE = 128.0f;
constexpr int NTHREADS = 512;

constexpr size_t MB = 1ull << 20;
constexpr size_t WS_CTL = 0;
constexpr size_t CTL_BYTES = 65536;
constexpr size_t WS_AWIN = 1 * MB;
constexpr size_t WS_AWOUT = WS_AWIN + 8 * MB;
constexpr size_t WS_BWIN = WS_AWOUT + 4 * MB;
constexpr size_t WS_BWOUT = WS_BWIN + 12 * MB;
constexpr size_t WS_CWIN = WS_BWOUT + 4 * MB;
constexpr size_t WS_CWOUT = WS_CWIN + 18 * MB;
constexpr size_t WS_GU = WS_CWOUT + 2 * MB;
constexpr size_t WS_DN = WS_GU + 512 * MB;
constexpr size_t WS_XF = WS_DN + 256 * MB;
constexpr size_t WS_XB = WS_XF + 64 * MB;
constexpr size_t WS_U = WS_XB + 32 * MB;
constexpr size_t WS_YIN = WS_U + 288 * MB;
constexpr size_t WS_YMIX = WS_YIN + 64 * MB;
constexpr size_t WS_SCR = WS_YMIX + 64 * MB;
constexpr size_t WS_TOPE = WS_SCR + 128 * MB;
constexpr size_t WS_GATES = WS_TOPE + 256 * 1024;
constexpr size_t WS_POS = WS_GATES + 256 * 1024;
constexpr size_t WS_DEST = WS_POS + 256 * 1024;
constexpr size_t WS_ROWTOK = WS_DEST + 256 * 1024;
constexpr size_t WS_HID = WS_ROWTOK + 1 * MB;
constexpr size_t WS_YROWS = WS_HID + 144 * MB;
constexpr size_t WS_LSUM = WS_YROWS + 288 * MB;
constexpr size_t WS_AGT = WS_LSUM + 2 * MB;
constexpr size_t WS_RT = WS_AGT + 1 * MB;
constexpr size_t WS_XQ = WS_RT + 1 * MB;
constexpr size_t WS_LIST = WS_XQ + 16 * MB;
constexpr size_t WS_END = WS_LIST + 2 * MB;

constexpr int CW_CNT = 4096;
constexpr int CW_MDYN = 8192;
constexpr int CW_TEXP = 12288;

#define XB_TMO      128
#define XB_XCNT(j)  (256  + 64 * (j))
#define XB_XSUB(j)  (1280 + 64 * (j))
#define XB_XGEN(j)  (2304 + 64 * (j))
#define XB_TOP      3328
#define XB_TOPGEN   3392
#define XCD_BAR_WORDS 3456
#define XB_SPIN_CAP (1u << 22)

__device__ __forceinline__ unsigned xb_ld(unsigned* p)              { return __hip_atomic_load(p, __ATOMIC_RELAXED, __HIP_MEMORY_SCOPE_AGENT); }
__device__ __forceinline__ unsigned xb_add(unsigned* p, unsigned v) { return __hip_atomic_fetch_add(p, v, __ATOMIC_RELAXED, __HIP_MEMORY_SCOPE_AGENT); }
__device__ __forceinline__ unsigned xb_xcc_id() { return (unsigned)__builtin_amdgcn_s_getreg((3 << 11) | 20) & 0xFu; }
#define XB_SPIN(cond, bar) do { unsigned _sp = 0; while (cond) { __builtin_amdgcn_s_sleep(1); \
    if ((++_sp & 255u) == 0u) { if (xb_ld(&(bar)[XB_TMO])) break; if (_sp > XB_SPIN_CAP) { atomicAdd(&(bar)[XB_TMO], 1u); break; } } } } while (0)

struct XcdBarrier { unsigned* bar; unsigned x; volatile LAS unsigned* st; };

__device__ __forceinline__ XcdBarrier xcd_barrier_post(unsigned* bar, volatile LAS unsigned* st) {
    XcdBarrier b; b.bar = bar; b.x = xb_xcc_id(); b.st = st;
    if (threadIdx.x == 0) (void)xb_add(&bar[XB_XCNT(b.x)], 1u);
    return b;
}
__device__ __forceinline__ void xcd_barrier_complete(unsigned* bar, unsigned x, unsigned& nloc, unsigned& nx) {
    const unsigned G = gridDim.x * gridDim.y * gridDim.z;
    unsigned sum, cnt, mine, sp = 0u;
    for (;;) {
        sum = 0u; cnt = 0u; mine = 0u;
#pragma unroll
        for (unsigned j = 0; j < 16; ++j) { const unsigned c = xb_ld(&bar[XB_XCNT(j)]); sum += c; cnt += (c > 0u) ? 1u : 0u; mine = (j == x) ? c : mine; }
        if (sum == G) break;
        __builtin_amdgcn_s_sleep(1);
        if ((++sp & 255u) == 0u) { if (xb_ld(&bar[XB_TMO])) break; if (sp > XB_SPIN_CAP) { atomicAdd(&bar[XB_TMO], 1u); break; } }
    }
    nloc = mine > 0u ? mine : 1u; nx = cnt > 0u ? cnt : 1u;
}
__device__ __forceinline__ void xcd_barrier_nv(unsigned* bbar, unsigned bx, volatile LAS unsigned* bst) {
    XcdBarrier b; b.bar = bbar; b.x = bx; b.st = bst;
    asm volatile("s_waitcnt vmcnt(0)" ::: "memory");
    __syncthreads();
    if (threadIdx.x == 0) {
        unsigned* bar = b.bar;
        __builtin_amdgcn_s_waitcnt(0);
        unsigned nloc = b.st[0], nx = b.st[1];
        if (nloc == 0u) { xcd_barrier_complete(bar, b.x, nloc, nx); b.st[0] = nloc; b.st[1] = nx; }
        const unsigned old = xb_add(&bar[XB_XSUB(b.x)], 1u);
        const unsigned gen = old / nloc;
        if (old + 1u == (gen + 1u) * nloc) {
            __builtin_amdgcn_fence(__ATOMIC_RELEASE, "agent");
            asm volatile("s_waitcnt vmcnt(0)" ::: "memory");
            const unsigned og = xb_add(&bar[XB_TOP], 1u);
            const unsigned tg = og / nx;
            if (og + 1u == (tg + 1u) * nx) xb_add(&bar[XB_TOPGEN], 1u);
            else XB_SPIN(xb_ld(&bar[XB_TOPGEN]) == tg, bar);
            __builtin_amdgcn_fence(__ATOMIC_ACQUIRE, "agent");
            xb_add(&bar[XB_XGEN(b.x)], 1u);
            asm volatile("s_waitcnt vmcnt(0)" ::: "memory");
        } else {
            XB_SPIN(xb_ld(&bar[XB_XGEN(b.x)]) == gen, bar);
            __builtin_amdgcn_fence(__ATOMIC_ACQUIRE, "agent");
            asm volatile("s_waitcnt vmcnt(0)" ::: "memory");
        }
    }
    __syncthreads();
}

__device__ __forceinline__ int tid_() { int t = threadIdx.x; asm volatile("" : "+v"(t)); return t; }
__device__ __forceinline__ float bf2f(bf16_t v) { return __uint_as_float(((unsigned)v) << 16); }
__device__ __forceinline__ unsigned pack2(float lo, float hi) { unsigned r; asm("v_cvt_pk_bf16_f32 %0, %1, %2" : "=v"(r) : "v"(lo), "v"(hi)); return r; }
__device__ __forceinline__ bf16_t f2bf(float f) { return (bf16_t)(pack2(f, f) & 0xffffu); }
__device__ __forceinline__ float wave_sum(float v) {
#pragma unroll
    for (int o = 32; o >= 1; o >>= 1) v += __shfl_xor(v, o);
    return v;
}
__device__ __forceinline__ float wave_max(float v) {
#pragma unroll
    for (int o = 32; o >= 1; o >>= 1) v = fmaxf(v, __shfl_xor(v, o));
    return v;
}
__device__ __forceinline__ float sigmoidf_(float x) { return __builtin_amdgcn_rcpf(1.0f + __builtin_amdgcn_exp2f(-1.4426950408889634f * x)); }
__device__ __forceinline__ float gelu_tanh(float x) { const float u = 0.7978845608028654f * (x + 0.044715f * x * x * x); return 0.5f * x * (1.0f + tanhf(u)); }
__device__ __forceinline__ unsigned pk_fp8x4(float a, float b, float c, float d) { int w = 0; w = __builtin_amdgcn_cvt_pk_fp8_f32(a, b, w, false); w = __builtin_amdgcn_cvt_pk_fp8_f32(c, d, w, true); return (unsigned)w; }
typedef float f32x2 __attribute__((ext_vector_type(2)));
__device__ __forceinline__ f32x2 swiglu2(f32x2 gate, f32x2 up) {
    f32x2 g, u; g.x = fminf(gate.x, 7.0f); g.y = fminf(gate.y, 7.0f); u.x = __builtin_amdgcn_fmed3f(up.x, -7.0f, 7.0f); u.y = __builtin_amdgcn_fmed3f(up.y, -7.0f, 7.0f);
    const f32x2 t = g * (-1.702f * 1.4426950408889634f);
    f32x2 e; e.x = __builtin_amdgcn_exp2f(t.x); e.y = __builtin_amdgcn_exp2f(t.y);
    const f32x2 d = e + 1.0f;
    f32x2 r; r.x = __builtin_amdgcn_rcpf(d.x); r.y = __builtin_amdgcn_rcpf(d.y);
    return ((u + 1.0f) * g) * r;
}
__device__ __forceinline__ float swiglu(float gate, float up) {
    const float g = fminf(gate, 7.0f), u = fminf(fmaxf(up, -7.0f), 7.0f);
    return (u + 1.0f) * g * sigmoidf_(1.702f * g);
}

struct Params {
    const float* x; const float* a_w_in; const float* a_conv_w; const float* a_conv_b; const float* a_w_rgate; const float* a_b_rgate;
    const float* a_w_igate; const float* a_b_igate; const float* a_lambda; const float* a_w_out; const float* b_w_in; const float* b_w_out;
    const float* c_w_in; const float* c_w_out; const float* ln_gain; const float* ln_bias; const float* moe_w_router; const float* moe_b_router;
    const float* moe_w_gu; const float* moe_b_gu; const float* moe_w_down; const float* moe_b_down;
    float* out; unsigned char* ws;
    int ph_lo, ph_hi;
};

__device__ __forceinline__ void convert_job(LAS float* tile, const float* src, bf16_t* dst, int K, int N, int batch) {
    const int tid = tid_();
    const int tk = K / 64, tn = N / 64, per = tk * tn; const long total = (long)per * batch;
    for (long u = blockIdx.x; u < total; u += gridDim.x) {
        const int bidx = (int)(u / per), r = (int)(u % per), kt = r / tn, nt = r % tn;
        const float* s = src + (size_t)bidx * K * N + (size_t)(kt * 64) * N + nt * 64;
#pragma unroll
        for (int pass = 0; pass < 2; ++pass) {
            const int row = (tid >> 4) + 32 * pass, c4 = tid & 15;
            const f32x4 v = *(const f32x4*)(s + (size_t)row * N + c4 * 4);
            tile[row * 65 + c4 * 4 + 0] = v[0]; tile[row * 65 + c4 * 4 + 1] = v[1]; tile[row * 65 + c4 * 4 + 2] = v[2]; tile[row * 65 + c4 * 4 + 3] = v[3];
        }
        __syncthreads();
        {
            const int n = tid >> 3, k8 = tid & 7;
            float v[8];
#pragma unroll
            for (int j = 0; j < 8; ++j) v[j] = tile[(k8 * 8 + j) * 65 + n];
            u32x4 w; w.x = pack2(v[0], v[1]); w.y = pack2(v[2], v[3]); w.z = pack2(v[4], v[5]); w.w = pack2(v[6], v[7]);
            *(u32x4*)(dst + (size_t)bidx * N * K + (size_t)(nt * 64 + n) * K + kt * 64 + k8 * 8) = w;
        }
        __syncthreads();
    }
}


constexpr int TAB_OFF = 131072;
__device__ __forceinline__ void moe_tables(LAS unsigned char* lds, const unsigned* ctl, int layer) {
    LAS int* tab = (LAS int*)(lds + TAB_OFF);
    const int tid = tid_();
    __syncthreads();
    if (tid == 0) { int acc = 0; for (int e = 0; e < NEXP; ++e) { tab[e] = acc; acc += ((int)ctl[CW_CNT + layer * 64 + e] + 255) >> 8; } tab[32] = acc; }
    __syncthreads();
    if (tid < 288) { int e = 0; for (int q = 1; q < NEXP; ++q) e += (tab[q] <= tid) ? 1 : 0; tab[64 + tid] = e; }
    __syncthreads();
}

namespace g8 {
constexpr int BM = 256, BK = 64, HALF = 128, HTB = HALF * BK * 2, STAGE_BYTES = 8 * HTB, NXCD = 8, WGM = 8;
__device__ __forceinline__ int lds_byte(int r, int c) { const int st = (r >> 4) * 2 + (c >> 5), rr = r & 15, cc = c & 31, ob = rr * 64 + cc * 2; return st * 1024 + (ob ^ (((ob >> 9) & 1) << 5)); }
__device__ __forceinline__ void stage_rc(int b, int& R, int& C) { const int st = b / 1024, sb = b % 1024, swz = sb ^ (((sb >> 9) & 1) << 5); R = (st >> 1) * 16 + swz / 64; C = (st & 1) * 32 + (swz % 64) / 2; }
__device__ __forceinline__ int perm32(int rho) { const int n = rho >> 4, i = rho & 15; return 8 * (i >> 2) + 4 * n + (i & 3); }
__device__ __forceinline__ unsigned cvt_pk_bf16(float lo, float hi) { unsigned r; asm volatile("v_cvt_pk_bf16_f32 %0, %1, %2" : "=v"(r) : "v"(lo), "v"(hi)); return r; }

struct Unit { const char* a0; const char* a1; const char* b0; const char* b1; const int* rows; int row0, col0, e; };

struct SchedPlain {
    const char* A; const char* Bt; size_t hstepA, hstepB; int nM, nN, nwg, G, c;
    __device__ __forceinline__ void init(const void* A_, const void* Bt_, int M, int N, int K, int G_, int c_) { A = (const char*)A_; Bt = (const char*)Bt_; hstepA = (size_t)HALF * K * 2; hstepB = hstepA; nM = M / BM; nN = N / BM; nwg = nM * nN; G = G_; c = c_; }
    __device__ __forceinline__ bool next(int i, Unit& u) const {
        const long L = (long)i * G + c; if (L >= nwg) return false;
        int wgid = (int)L; { const int q = nwg / NXCD, r = nwg % NXCD, xcd = wgid % NXCD, off = wgid / NXCD; wgid = (xcd < r ? xcd * (q + 1) : r * (q + 1) + (xcd - r) * q) + off; }
        const int nig = WGM * nN, gid = wgid / nig, fm = gid * WGM, gsz = (nM - fm) < WGM ? (nM - fm) : WGM;
        const int pm = fm + ((wgid % nig) % gsz), pn = (wgid % nig) / gsz;
        u.a0 = A + (size_t)pm * 2 * hstepA; u.a1 = u.a0 + hstepA; u.b0 = Bt + (size_t)pn * 2 * hstepB; u.b1 = u.b0 + hstepB; u.rows = nullptr; u.row0 = pm * BM; u.col0 = pn * BM; u.e = 0;
        return true;
    }
};
struct SchedGU {
    const char* A; const char* W; const int* elist; LAS const int* tab; int G, c;
    __device__ __forceinline__ bool next(int i, Unit& u) const {
        const int L = i * G + c, rt = L >> 3, pn = L & 7; if (rt >= __builtin_amdgcn_readfirstlane(tab[32])) return false;
        const int e = __builtin_amdgcn_readfirstlane(tab[64 + rt]), j = rt - __builtin_amdgcn_readfirstlane(tab[e]);
        u.a0 = A; u.a1 = A; u.rows = elist + (size_t)e * T + j * BM; u.b0 = W + ((size_t)e * 2048 + pn * 128) * D; u.b1 = u.b0 + (size_t)1024 * D; u.row0 = rt * BM; u.col0 = pn * 128; u.e = e;
        return true;
    }
};
struct SchedDown {
    const char* A; const char* W; LAS const int* tab; int G, c;
    __device__ __forceinline__ bool next(int i, Unit& u) const {
        const int L = i * G + c, rt = L >> 2, pn = L & 3; if (rt >= __builtin_amdgcn_readfirstlane(tab[32])) return false;
        const int e = __builtin_amdgcn_readfirstlane(tab[64 + rt]);
        u.a0 = A + (size_t)rt * BM * D; u.a1 = u.a0 + (size_t)HALF * D; u.rows = nullptr; u.b0 = W + ((size_t)e * 1024 + pn * BM) * D; u.b1 = u.b0 + (size_t)HALF * D; u.row0 = rt * BM; u.col0 = pn * BM; u.e = e;
        return true;
    }
};

struct EpiF32 {
    static constexpr bool PERM = false;
    float* C; int ldc; const float* bias; int bias_es;
    __device__ __forceinline__ void operator()(const f32x4 (&acc)[2][2][4][2], const Unit& u, int wr, int wc, int fr, int fq) const {
        const int row0 = u.row0 + wr * 64 + fr, col0 = u.col0 + wc * 32 + 4 * fq;
        f32x4 bv[2][2];
#pragma unroll
        for (int bj = 0; bj < 2; ++bj)
#pragma unroll
            for (int n = 0; n < 2; ++n) bv[bj][n] = bias ? *(const f32x4*)(bias + (size_t)u.e * bias_es + col0 + bj * HALF + n * 16) : (f32x4){0.f, 0.f, 0.f, 0.f};
#pragma unroll
        for (int ai = 0; ai < 2; ++ai)
#pragma unroll
            for (int m = 0; m < 4; ++m) { float* rowp = C + (size_t)(row0 + ai * HALF + m * 16) * ldc + col0;
#pragma unroll
                for (int bj = 0; bj < 2; ++bj)
#pragma unroll
                    for (int n = 0; n < 2; ++n) *(f32x4*)(rowp + bj * HALF + n * 16) = acc[ai][bj][m][n] + bv[bj][n]; }
    }
};
struct EpiBf16 {
    static constexpr bool PERM = true;
    bf16_t* O; int ldc; const float* bias; int bias_es; float scale;
    __device__ __forceinline__ void operator()(const f32x4 (&acc)[2][2][4][2], const Unit& u, int wr, int wc, int fr, int fq) const {
        const int row0 = u.row0 + wr * 64 + fr, col0 = u.col0 + wc * 32 + 8 * fq;
        f32x4 bv[2][2];
#pragma unroll
        for (int bj = 0; bj < 2; ++bj)
#pragma unroll
            for (int n = 0; n < 2; ++n) bv[bj][n] = bias ? *(const f32x4*)(bias + (size_t)u.e * bias_es + col0 + bj * HALF + 4 * n) : (f32x4){0.f, 0.f, 0.f, 0.f};
#pragma unroll
        for (int ai = 0; ai < 2; ++ai)
#pragma unroll
            for (int m = 0; m < 4; ++m) { bf16_t* rowp = O + (size_t)(row0 + ai * HALF + m * 16) * ldc + col0;
#pragma unroll
                for (int bj = 0; bj < 2; ++bj) { const f32x4 v0 = acc[ai][bj][m][0] * scale + bv[bj][0], v1 = acc[ai][bj][m][1] * scale + bv[bj][1];
                    u32x4 w; w.x = cvt_pk_bf16(v0[0], v0[1]); w.y = cvt_pk_bf16(v0[2], v0[3]); w.z = cvt_pk_bf16(v1[0], v1[1]); w.w = cvt_pk_bf16(v1[2], v1[3]);
                    *(u32x4*)(rowp + bj * HALF) = w; } }
    }
};
struct EpiSwiglu {
    static constexpr bool PERM = true;
    unsigned char* O; const float* bias; float scale;
    __device__ __forceinline__ void operator()(const f32x4 (&acc)[2][2][4][2], const Unit& u, int wr, int wc, int fr, int fq) const {
        const int row0 = u.row0 + wr * 64 + fr, hc = u.col0 + wc * 32 + 8 * fq;
        const float* bp = bias + (size_t)u.e * 2048 + hc;
        const f32x4 bg0 = *(const f32x4*)(bp), bg1 = *(const f32x4*)(bp + 4), bu0 = *(const f32x4*)(bp + 1024), bu1 = *(const f32x4*)(bp + 1028);
#pragma unroll
        for (int ai = 0; ai < 2; ++ai)
#pragma unroll
            for (int m = 0; m < 4; ++m) {
                const f32x4 g0 = acc[ai][0][m][0] * scale + bg0, g1 = acc[ai][0][m][1] * scale + bg1, u0 = acc[ai][1][m][0] * scale + bu0, u1 = acc[ai][1][m][1] * scale + bu1;
                const f32x2 h0 = swiglu2((f32x2){g0[0], g0[1]}, (f32x2){u0[0], u0[1]}), h1 = swiglu2((f32x2){g0[2], g0[3]}, (f32x2){u0[2], u0[3]});
                const f32x2 h2 = swiglu2((f32x2){g1[0], g1[1]}, (f32x2){u1[0], u1[1]}), h3 = swiglu2((f32x2){g1[2], g1[3]}, (f32x2){u1[2], u1[3]});
                u32x2 w; w.x = pk_fp8x4(h0.x, h0.y, h1.x, h1.y); w.y = pk_fp8x4(h2.x, h2.y, h3.x, h3.y);
                *(u32x2*)(O + (size_t)(row0 + ai * HALF + m * 16) * D + hc) = w;
            }
    }
};

typedef int i32x8 __attribute__((ext_vector_type(8)));
typedef int i32x4 __attribute__((ext_vector_type(4)));
template <class Epi, class Sched, bool GATHER, int ESZ = 2>
__device__ __forceinline__ void gemm_phase(LAS unsigned char* lds, const int K, const Sched& S, const Epi& E) {
    const int tid = tid_(), wid = __builtin_amdgcn_readfirstlane(tid >> 6), lane = tid & 63, wr = wid >> 2, wc = wid & 3, fr = lane & 15, fq = lane >> 4;
    const int nt = K * ESZ / 128, KP = K * ESZ;
    int sR[2], sC[2];
    unsigned voffB[2];
#pragma unroll
    for (int i = 0; i < 2; ++i) { stage_rc(tid * 16 + i * 8192, sR[i], sC[i]); const int Rb = Epi::PERM ? ((sR[i] & ~31) + perm32(sR[i] & 31)) : sR[i]; voffB[i] = (unsigned)(Rb * KP + sC[i] * 2); }
    unsigned cvA0[2], cvA1[2], nvA0[2], nvA1[2];
#define G8_VOFF(u, v0, v1) do { _Pragma("unroll") for (int _i = 0; _i < 2; ++_i) { \
        if (GATHER) { unsigned t0_ = (unsigned)(u).rows[sR[_i]], t1_ = (unsigned)(u).rows[HALF + sR[_i]]; t0_ = t0_ < (unsigned)T ? t0_ : 0u; t1_ = t1_ < (unsigned)T ? t1_ : 0u;     \
            v0[_i] = t0_ * (unsigned)KP + (unsigned)(sC[_i] * 2); v1[_i] = t1_ * (unsigned)KP + (unsigned)(sC[_i] * 2); } \
        else { v0[_i] = (unsigned)(sR[_i] * KP + sC[_i] * 2); v1[_i] = v0[_i]; } } } while (0)
    const size_t kstep = (size_t)(BK * 2);
    const unsigned ldsw = (unsigned)wid * 1024u;
    const int aoff = lds_byte(wr * 64 + fr, fq * 8), boff = lds_byte(wc * 32 + fr, fq * 8);
#define PG8_SA(b, h) (((b) * 2 + (h)) * HTB)
#define PG8_SB(b, h) ((4 + (b) * 2 + (h)) * HTB)
#define PG8_STAGE(bufoff, gbase, voff) do { _Pragma("unroll") for (int _i = 0; _i < 2; ++_i) \
        __builtin_amdgcn_global_load_lds((const unsigned*)((const char*)(gbase) + (voff)[_i]), (LAS unsigned*)(lds + (bufoff) + ldsw + _i * 8192), 16, 0, 0); } while (0)
#define PG8_LDA(dst, b, h) do { _Pragma("unroll") for (int m = 0; m < 4; ++m) { dst[m].lo = *(const LAS i32x4*)(lds + PG8_SA(b, h) + aoff + m * 2048); dst[m].hi = *(const LAS i32x4*)(lds + PG8_SA(b, h) + aoff + m * 2048 + 1024); } } while (0)
#define PG8_LDB(dst, b, h) do { _Pragma("unroll") for (int n = 0; n < 2; ++n) { dst[n].lo = *(const LAS i32x4*)(lds + PG8_SB(b, h) + boff + n * 2048); dst[n].hi = *(const LAS i32x4*)(lds + PG8_SB(b, h) + boff + n * 2048 + 1024); } } while (0)
#define PG8_MMA(ai, bj, At, Bt) do { __builtin_amdgcn_s_setprio(1); _Pragma("unroll") for (int m = 0; m < 4; ++m) _Pragma("unroll") for (int n = 0; n < 2; ++n) { \
        if (ESZ == 2) { acc[ai][bj][m][n] = __builtin_amdgcn_mfma_f32_16x16x32_bf16(__builtin_bit_cast(bf16x8, (i32x4)__builtin_shufflevector(Bt[n], Bt[n], 0, 1, 2, 3)), __builtin_bit_cast(bf16x8, (i32x4)__builtin_shufflevector(At[m], At[m], 0, 1, 2, 3)), acc[ai][bj][m][n], 0, 0, 0); \
                        acc[ai][bj][m][n] = __builtin_amdgcn_mfma_f32_16x16x32_bf16(__builtin_bit_cast(bf16x8, (i32x4)__builtin_shufflevector(Bt[n], Bt[n], 4, 5, 6, 7)), __builtin_bit_cast(bf16x8, (i32x4)__builtin_shufflevector(At[m], At[m], 4, 5, 6, 7)), acc[ai][bj][m][n], 0, 0, 0); } \
        else asm volatile("v_mfma_f32_16x16x128_f8f6f4 %0, %1, %2, %0" : "+v"(acc[ai][bj][m][n]) : "v"(Bt[n]), "v"(At[m])); } __builtin_amdgcn_s_setprio(0); } while (0)
#define PG8_WAIT_V(n) asm volatile("s_waitcnt vmcnt(" #n ")" ::: "memory")
#define PG8_WAIT_L(n) asm volatile("s_waitcnt lgkmcnt(" #n ")" ::: "memory")
#define PG8_BAR __builtin_amdgcn_s_barrier()
#define PG8_SCHED __builtin_amdgcn_sched_barrier(0)
    Unit cur, nxt; int ui = 0;
    if (!S.next(0, cur)) return;
    f32x4 acc[2][2][4][2];
#pragma unroll
    for (int a = 0; a < 2; ++a)
#pragma unroll
        for (int b = 0; b < 2; ++b)
#pragma unroll
            for (int m = 0; m < 4; ++m)
#pragma unroll
                for (int n = 0; n < 2; ++n) acc[a][b][m][n] = (f32x4){0.f, 0.f, 0.f, 0.f};
    i32x8 At[4], B0[2], B1[2];
    const char* cA0 = cur.a0; const char* cA1 = cur.a1; const char* cB0 = cur.b0; const char* cB1 = cur.b1;
    G8_VOFF(cur, cvA0, cvA1);
    PG8_STAGE(PG8_SB(0, 0), cB0, voffB); PG8_STAGE(PG8_SB(0, 1), cB1, voffB); PG8_STAGE(PG8_SA(0, 0), cA0, cvA0); PG8_STAGE(PG8_SA(0, 1), cA1, cvA1);
    if (wr == 1) PG8_BAR;
    PG8_WAIT_V(2); PG8_BAR;
    PG8_STAGE(PG8_SB(1, 0), cB0 + kstep, voffB); PG8_STAGE(PG8_SA(1, 0), cA0 + kstep, cvA0); PG8_STAGE(PG8_SB(1, 1), cB1 + kstep, voffB);
    PG8_WAIT_V(6); PG8_BAR;
    for (;;) {
        const bool has_next = S.next(ui + 1, nxt);
        const char* nA0 = has_next ? nxt.a0 : cA0; const char* nA1 = has_next ? nxt.a1 : cA1; const char* nB0 = has_next ? nxt.b0 : cB0; const char* nB1 = has_next ? nxt.b1 : cB1;
        if (GATHER) { if (has_next) { G8_VOFF(nxt, nvA0, nvA1); } else { nvA0[0] = cvA0[0]; nvA0[1] = cvA0[1]; nvA1[0] = cvA1[0]; nvA1[1] = cvA1[1]; } }
#pragma unroll 1
        for (int t = 0; t < nt; t += 2) {
            const bool last = (t == nt - 2);
            const char* a1_1 = cA1 + (size_t)(t + 1) * kstep;
            const char* a2_0 = last ? nA0 : cA0 + (size_t)(t + 2) * kstep; const char* a2_1 = last ? nA1 : cA1 + (size_t)(t + 2) * kstep;
            const char* b2_0 = last ? nB0 : cB0 + (size_t)(t + 2) * kstep; const char* b2_1 = last ? nB1 : cB1 + (size_t)(t + 2) * kstep;
            const char* a3_0 = a2_0 + kstep; const char* b3_0 = b2_0 + kstep; const char* b3_1 = b2_1 + kstep;
            unsigned vA0[2], vA1[2];
            if (GATHER) { vA0[0] = last ? nvA0[0] : cvA0[0]; vA0[1] = last ? nvA0[1] : cvA0[1]; vA1[0] = last ? nvA1[0] : cvA1[0]; vA1[1] = last ? nvA1[1] : cvA1[1]; }
            else { vA0[0] = cvA0[0]; vA0[1] = cvA0[1]; vA1[0] = cvA0[0]; vA1[1] = cvA0[1]; }
            PG8_LDB(B0, 0, 0); PG8_LDB(B1, 0, 1); PG8_SCHED; PG8_LDA(At, 0, 0); PG8_STAGE(PG8_SA(1, 1), a1_1, cvA1);
            PG8_WAIT_V(8); PG8_WAIT_L(0); PG8_BAR; PG8_MMA(0, 0, At, B0); PG8_MMA(0, 1, At, B1); PG8_BAR; PG8_SCHED;
            PG8_LDA(At, 0, 1); PG8_STAGE(PG8_SB(0, 0), b2_0, voffB); PG8_STAGE(PG8_SB(0, 1), b2_1, voffB); PG8_STAGE(PG8_SA(0, 0), a2_0, vA0);
            PG8_WAIT_V(8); PG8_WAIT_L(0); PG8_BAR; PG8_MMA(1, 0, At, B0); PG8_MMA(1, 1, At, B1); PG8_BAR; PG8_SCHED;
            PG8_LDB(B0, 1, 0); PG8_LDB(B1, 1, 1); PG8_SCHED; PG8_LDA(At, 1, 0); PG8_STAGE(PG8_SA(0, 1), a2_1, vA1);
            PG8_WAIT_V(8); PG8_WAIT_L(0); PG8_BAR; PG8_MMA(0, 0, At, B0); PG8_MMA(0, 1, At, B1); PG8_BAR; PG8_SCHED;
            PG8_LDA(At, 1, 1); PG8_STAGE(PG8_SB(1, 0), b3_0, voffB); PG8_STAGE(PG8_SB(1, 1), b3_1, voffB); PG8_STAGE(PG8_SA(1, 0), a3_0, vA0);
            PG8_WAIT_V(8); PG8_WAIT_L(0); PG8_BAR; PG8_MMA(1, 0, At, B0); PG8_MMA(1, 1, At, B1); PG8_BAR; PG8_SCHED;
        }
        if (wr == 0) PG8_BAR;
        if (ESZ == 1) asm volatile("s_nop 15\n\ts_nop 15" ::: "memory");
        E(acc, cur, wr, wc, fr, fq);
        if (!has_next) break;
#pragma unroll
        for (int a = 0; a < 2; ++a)
#pragma unroll
            for (int b = 0; b < 2; ++b)
#pragma unroll
                for (int m = 0; m < 4; ++m)
#pragma unroll
                    for (int n = 0; n < 2; ++n) acc[a][b][m][n] = (f32x4){0.f, 0.f, 0.f, 0.f};
        cur = nxt; cA0 = nA0; cA1 = nA1; cB0 = nB0; cB1 = nB1; ++ui;
        if (GATHER) { cvA0[0] = nvA0[0]; cvA0[1] = nvA0[1]; cvA1[0] = nvA1[0]; cvA1[1] = nvA1[1]; }
        if (wr == 1) PG8_BAR;
    }
    PG8_WAIT_V(0);
    PG8_BAR;
#undef G8_VOFF
#undef PG8_SA
#undef PG8_SB
#undef PG8_STAGE
#undef PG8_LDA
#undef PG8_LDB
#undef PG8_MMA
#undef PG8_WAIT_V
#undef PG8_WAIT_L
#undef PG8_BAR
#undef PG8_SCHED
}
}


template <bool F8>
__device__ __forceinline__ void convert_big(LAS unsigned char* lds, const float* src, void* dstv, int K, int N, int batch, float scale) {
    const int tid = tid_(), lane = tid & 63, wid = tid >> 6;
    const int nbn = N / 256, per = (K / 128) * nbn, total = per * batch, G = (int)gridDim.x;
    constexpr int ESZ = F8 ? 1 : 2, ROWB = 128 * ESZ, TILEB = 256 * ROWB;
    f32x4 ra[16], rb[16];
#define CV_LOAD(uu, reg) do { const int bidx = (uu) / per, r_ = (uu) % per, kb = r_ / nbn, nb = r_ % nbn; \
        const float* sp = src + (size_t)bidx * K * N + (size_t)(kb * 128 + 16 * wid) * N + nb * 256 + 4 * lane; \
        _Pragma("unroll") for (int i = 0; i < 16; ++i) reg[i] = *(const f32x4*)(sp + (size_t)i * N); } while (0)
#define CV_PACK(reg, tl) do { _Pragma("unroll") for (int j = 0; j < 4; ++j) { \
        if (F8) { u32x4 w0; w0.x = pk_fp8x4(reg[0][j] * scale, reg[1][j] * scale, reg[2][j] * scale, reg[3][j] * scale); w0.y = pk_fp8x4(reg[4][j] * scale, reg[5][j] * scale, reg[6][j] * scale, reg[7][j] * scale); \
            w0.z = pk_fp8x4(reg[8][j] * scale, reg[9][j] * scale, reg[10][j] * scale, reg[11][j] * scale); w0.w = pk_fp8x4(reg[12][j] * scale, reg[13][j] * scale, reg[14][j] * scale, reg[15][j] * scale); \
            *(LAS u32x4*)((tl) + (4 * lane + j) * ROWB + ((wid ^ (lane & 7)) * 16)) = w0; } \
        else { u32x4 w0, w1; \
            w0.x = g8::cvt_pk_bf16(reg[0][j], reg[1][j]); w0.y = g8::cvt_pk_bf16(reg[2][j], reg[3][j]); w0.z = g8::cvt_pk_bf16(reg[4][j], reg[5][j]); w0.w = g8::cvt_pk_bf16(reg[6][j], reg[7][j]); \
            w1.x = g8::cvt_pk_bf16(reg[8][j], reg[9][j]); w1.y = g8::cvt_pk_bf16(reg[10][j], reg[11][j]); w1.z = g8::cvt_pk_bf16(reg[12][j], reg[13][j]); w1.w = g8::cvt_pk_bf16(reg[14][j], reg[15][j]); \
            *(LAS u32x4*)((tl) + (4 * lane + j) * ROWB + (((2 * wid) ^ (lane & 15)) * 16)) = w0; *(LAS u32x4*)((tl) + (4 * lane + j) * ROWB + (((2 * wid + 1) ^ (lane & 15)) * 16)) = w1; } } } while (0)
#define CV_STORE(uu, tl) do { const int bidx = (uu) / per, r_ = (uu) % per, kb = r_ / nbn, nb = r_ % nbn; \
        unsigned char* dp = (unsigned char*)dstv + ((size_t)bidx * N * K + (size_t)(nb * 256) * K + kb * 128) * ESZ; \
        _Pragma("unroll") for (int i = 0; i < 4 * ESZ; ++i) { const int pc = tid + NTHREADS * i, n = pc / (8 * ESZ), c = pc % (8 * ESZ); \
            *(u32x4*)(dp + (size_t)n * K * ESZ + c * 16) = *(const LAS u32x4*)((tl) + n * ROWB + ((c ^ ((n >> 2) & (8 * ESZ - 1))) * 16)); } } while (0)
    const int u0 = blockIdx.x;
    if (u0 < total) CV_LOAD(u0, ra);
    if (u0 + G < total) CV_LOAD(u0 + G, rb);
    for (int u = u0; u < total; u += 2 * G) {
        CV_PACK(ra, lds);
        if (u + 2 * G < total) CV_LOAD(u + 2 * G, ra);
        __syncthreads();
        CV_STORE(u, lds);
        const bool has_b = (u + G < total);
        if (has_b) { CV_PACK(rb, lds + TILEB); if (u + 3 * G < total) CV_LOAD(u + 3 * G, rb); }
        __syncthreads();
        if (has_b) CV_STORE(u + G, lds + TILEB);
    }
    __syncthreads();
#undef CV_LOAD
#undef CV_PACK
#undef CV_STORE
}

__device__ __forceinline__ float gelu_fast(float x) { const float u2 = 1.5957691216057308f * (x + 0.044715f * x * x * x); return x * __builtin_amdgcn_rcpf(1.0f + __builtin_amdgcn_exp2f(-1.4426950408889634f * u2)); }
__device__ __forceinline__ void lru_gates_phase(LAS unsigned char* lds, const Params& p, int idx) {
    const int tid = tid_(), lane = tid & 63, wid = tid >> 6, fr = lane & 15, fq = lane >> 4;
    LAS bf16_t* xcb = (LAS bf16_t*)lds;
    LAS float* xcf = (LAS float*)(lds + 17408);
    LAS float* sa = (LAS float*)(lds + 17408 + 33792);
    LAS float* sb = sa + 64 * 132;
    LAS float* comb = sb + 64 * 132;
    const bf16_t* u = (const bf16_t*)(p.ws + WS_U);
    bf16_t* Carr = (bf16_t*)(p.ws + WS_SCR); bf16_t* Barr = Carr + (size_t)T * D;
    float* SP = (float*)(p.ws + WS_LSUM); float* SH = SP + NBATCH * 32 * D;
    const int hd = blockIdx.x & 7, slot = blockIdx.x >> 3, nslots = gridDim.x >> 3;
    const float* conv_w = p.a_conv_w + (size_t)idx * 4 * D; const float* conv_b = p.a_conv_b + (size_t)idx * D;
    const bf16_t* wrt = (const bf16_t*)(p.ws + WS_AGT) + ((size_t)(idx * 2 + 0) * 8 + hd) * 128 * 128;
    const bf16_t* wit = (const bf16_t*)(p.ws + WS_AGT) + ((size_t)(idx * 2 + 1) * 8 + hd) * 128 * 128;
    bf16x8 Br[4], Bi[4];
#pragma unroll
    for (int ks = 0; ks < 4; ++ks) { Br[ks] = *(const bf16x8*)(wrt + (size_t)(16 * wid + fr) * 128 + 32 * ks + 8 * fq); Bi[ks] = *(const bf16x8*)(wit + (size_t)(16 * wid + fr) * 128 + 32 * ks + 8 * fq); }
    const int cg = hd * 128 + 16 * wid + 4 * fq;
    const f32x4 brv = *(const f32x4*)(p.a_b_rgate + (size_t)idx * D + cg), biv = *(const f32x4*)(p.a_b_igate + (size_t)idx * D + cg), lmv = *(const f32x4*)(p.a_lambda + (size_t)idx * D + cg);
    f32x4 spv;
#pragma unroll
    for (int r = 0; r < 4; ++r) spv[r] = (lmv[r] > 15.f) ? __expf(-lmv[r]) : log1pf(__expf(-lmv[r]));
    const int cc = (tid & 31) * 4, cch = hd * 128 + cc;
    f32x4 cw[4];
#pragma unroll
    for (int j = 0; j < 4; ++j) cw[j] = *(const f32x4*)(conv_w + j * D + cch);
    const f32x4 cb = *(const f32x4*)(conv_b + cch);
    for (int tile = slot; tile < T / 64; tile += nslots) {
        const int t0 = tile * 64;
#pragma unroll
        for (int k = 0; k < 4; ++k) {
            const int tl = (tid >> 5) + 16 * k, t = t0 + tl, s_ = t & (SEQ - 1);
            f32x4 acc = cb;
#pragma unroll
            for (int j = 0; j < 4; ++j) {
                if (s_ - 3 + j >= 0) {
                    const u32x2 rv = *(const u32x2*)(u + (size_t)(t - 3 + j) * 2048 + 1024 + cch);
                    acc[0] += cw[j][0] * __uint_as_float(rv.x << 16); acc[1] += cw[j][1] * __uint_as_float(rv.x & 0xffff0000u);
                    acc[2] += cw[j][2] * __uint_as_float(rv.y << 16); acc[3] += cw[j][3] * __uint_as_float(rv.y & 0xffff0000u);
                }
            }
            *(LAS f32x4*)(xcf + tl * 132 + cc) = acc;
            u32x2 w; w.x = pack2(acc[0], acc[1]); w.y = pack2(acc[2], acc[3]);
            *(LAS u32x2*)(xcb + tl * 136 + cc) = w;
        }
        __syncthreads();
        f32x4 ar[4], ai[4];
#pragma unroll
        for (int mt = 0; mt < 4; ++mt) { ar[mt] = (f32x4){0.f, 0.f, 0.f, 0.f}; ai[mt] = (f32x4){0.f, 0.f, 0.f, 0.f}; }
#pragma unroll
        for (int ks = 0; ks < 4; ++ks)
#pragma unroll
            for (int mt = 0; mt < 4; ++mt) {
                const bf16x8 af = *(const LAS bf16x8*)(xcb + (mt * 16 + fr) * 136 + 32 * ks + 8 * fq);
                ar[mt] = __builtin_amdgcn_mfma_f32_16x16x32_bf16(Br[ks], af, ar[mt], 0, 0, 0);
                ai[mt] = __builtin_amdgcn_mfma_f32_16x16x32_bf16(Bi[ks], af, ai[mt], 0, 0, 0);
            }
#pragma unroll
        for (int mt = 0; mt < 4; ++mt) {
            const int tl = mt * 16 + fr, cl = 16 * wid + 4 * fq;
            const f32x4 rec = *(const LAS f32x4*)(xcf + tl * 132 + cl);
            f32x4 av, bv, cv;
#pragma unroll
            for (int r = 0; r < 4; ++r) {
                const float rg = sigmoidf_(ar[mt][r] + brv[r]), ig = sigmoidf_(ai[mt][r] + biv[r]);
                const float xl = -8.0f * rg * spv[r];
                const float cex = -xl * (1.0f + xl * (0.5f + xl * (0.16666667f + xl * (0.041666668f + xl * 0.0083333338f))));
                const float cc_ = bf2f(f2bf(cex));
                av[r] = 1.0f - cc_; cv[r] = cc_;
                bv[r] = bf2f(f2bf(__builtin_amdgcn_sqrtf(fmaxf(cex * (2.0f - cex), 0.f)) * ig * rec[r]));
            }
            { u32x2 wc_, wb_; wc_.x = pack2(cv[0], cv[1]); wc_.y = pack2(cv[2], cv[3]); wb_.x = pack2(bv[0], bv[1]); wb_.y = pack2(bv[2], bv[3]);
              *(u32x2*)(Carr + (size_t)(t0 + tl) * D + cg) = wc_; *(u32x2*)(Barr + (size_t)(t0 + tl) * D + cg) = wb_; }
            *(LAS f32x4*)(sa + tl * 132 + cl) = av; *(LAS f32x4*)(sb + tl * 132 + cl) = bv;
        }
        __syncthreads();
        {
            const int j = tid & 127, q = tid >> 7;
            float P = 1.f, H = 0.f;
#pragma unroll
            for (int s_ = 0; s_ < 16; ++s_) { const float a = sa[(q * 16 + s_) * 132 + j], bb = sb[(q * 16 + s_) * 132 + j]; H = a * H + bb; P *= a; }
            comb[(q * 128 + j) * 2 + 0] = P; comb[(q * 128 + j) * 2 + 1] = H;
        }
        __syncthreads();
        if (tid < 128) {
            float P = comb[tid * 2], H = comb[tid * 2 + 1];
#pragma unroll
            for (int q = 1; q < 4; ++q) { const float Pq = comb[(q * 128 + tid) * 2], Hq = comb[(q * 128 + tid) * 2 + 1]; H = Pq * H + Hq; P *= Pq; }
            SP[(size_t)tile * D + hd * 128 + tid] = P; SH[(size_t)tile * D + hd * 128 + tid] = H;
        }
    }
}
__device__ __forceinline__ void lru_scan_phase(const Params& p) {
    const int tid = tid_();
    const bf16_t* u = (const bf16_t*)(p.ws + WS_U);
    const bf16_t* Carr = (const bf16_t*)(p.ws + WS_SCR); const bf16_t* Barr = Carr + (size_t)T * D;
    const float* SP = (const float*)(p.ws + WS_LSUM); const float* SH = SP + NBATCH * 32 * D;
    bf16_t* yin = (bf16_t*)(p.ws + WS_YIN);
    typedef float f32x2 __attribute__((ext_vector_type(2)));
    for (int tile = blockIdx.x; tile < NBATCH * 32; tile += gridDim.x) {
        const int c = 2 * tid, b = tile >> 5, chunk = tile & 31;
        f32x2 sp[31], sh[31];
#pragma unroll
        for (int k = 0; k < 31; ++k) { const bool on = k < chunk; const size_t o = (size_t)(b * 32 + (on ? k : 0)) * D + c;
            sp[k] = *(const f32x2*)(SP + o); sh[k] = *(const f32x2*)(SH + o); if (!on) { sp[k] = (f32x2){1.f, 1.f}; sh[k] = (f32x2){0.f, 0.f}; } }
        float h0 = 0.f, h1 = 0.f;
#pragma unroll
        for (int k = 0; k < 31; ++k) { h0 = sp[k][0] * h0 + sh[k][0]; h1 = sp[k][1] * h1 + sh[k][1]; }
        const size_t tb = (size_t)tile * 64;
#pragma unroll 16
        for (int s_ = 0; s_ < 64; ++s_) {
            const size_t t = tb + s_;
            const unsigned cw = *(const unsigned*)(Carr + t * D + c), bw = *(const unsigned*)(Barr + t * D + c), gw = *(const unsigned*)(u + t * 2048 + c);
            h0 = (1.0f - __uint_as_float(cw << 16)) * h0 + __uint_as_float(bw << 16);
            h1 = (1.0f - __uint_as_float(cw & 0xffff0000u)) * h1 + __uint_as_float(bw & 0xffff0000u);
            *(unsigned*)(yin + t * D + c) = pack2(gelu_fast(__uint_as_float(gw << 16)) * h0, gelu_fast(__uint_as_float(gw & 0xffff0000u)) * h1);
        }
    }
}

typedef short s16x4 __attribute__((ext_vector_type(4)));
__device__ __forceinline__ s16x4 tr4(LAS const unsigned char* base, int row0, int col0, int stride, int lane) {
    const int q = (lane & 15) >> 2, pp = lane & 3;
    return __builtin_amdgcn_ds_read_tr16_b64_v4i16((LAS s16x4*)(base + (row0 + q) * stride + (col0 + 4 * pp) * 2));
}
__device__ __forceinline__ bf16x8 cat8(s16x4 a, s16x4 b) { return (bf16x8){a[0], a[1], a[2], a[3], b[0], b[1], b[2], b[3]}; }
__device__ __forceinline__ void ret_core_phase(LAS unsigned char* lds, const Params& p) {
    const int tid0_ = tid_(); const int tid = tid0_, lane = tid & 63, wid = tid >> 6, fr = lane & 15, fq = lane >> 4;
    constexpr int KS = 528, VS = 160, SS = 528;
    LAS unsigned char* Kl = lds;
    LAS unsigned char* Vl = lds + 128 * KS;
    LAS unsigned char* Sl = Vl + 128 * VS;
    const bf16_t* ul_ = (const bf16_t*)(p.ws + WS_U);
    bf16_t* RO = (bf16_t*)(p.ws + WS_SCR);
    for (int un = blockIdx.x; un < NBATCH * 4 * 8; un += gridDim.x) {
        const int b = un >> 5, h = (un >> 3) & 3, vs = un & 7;
        const float lg2 = log2f(1.0f - exp2f(-5.0f - (float)h));
        f32x4 Sacc[2][4];
#pragma unroll
        for (int dt = 0; dt < 2; ++dt)
#pragma unroll
            for (int vt = 0; vt < 4; ++vt) Sacc[dt][vt] = (f32x4){0.f, 0.f, 0.f, 0.f};
        for (int i = tid; i < 64 * SS / 16; i += NTHREADS) ((LAS u32x4*)Sl)[i] = (u32x4){0u, 0u, 0u, 0u};
        u32x4 kraw[8], vraw[2]; bf16x8 Qf[8];
#define RET_LOAD(ch_) do { const size_t tl_ = (size_t)b * SEQ + (ch_) * 128; const bf16_t* u = ul_; int tid = tid0_; asm volatile("" : "+s"(u), "+v"(tid));     \
            _Pragma("unroll") for (int i = 0; i < 8; ++i) { const int piece = tid + NTHREADS * i, m = piece >> 5, ch = piece & 31; kraw[i] = *(const u32x4*)(u + (tl_ + m) * 6144 + 1024 + h * 256 + ch * 8); } \
            _Pragma("unroll") for (int i = 0; i < 2; ++i) { const int piece = tid + NTHREADS * i, m = piece >> 3, ch = piece & 7; vraw[i] = *(const u32x4*)(u + (tl_ + m) * 6144 + 2048 + h * 512 + vs * 64 + ch * 8); } } while (0)
#define RET_LOADQ(ch_) do { const size_t tl_ = (size_t)b * SEQ + (ch_) * 128; const bf16_t* u = ul_; int tid = tid0_; asm volatile("" : "+s"(u), "+v"(tid)); const int wid = tid >> 6, fr = tid & 15, fq = (tid & 63) >> 4; \
            _Pragma("unroll") for (int ks = 0; ks < 8; ++ks) Qf[ks] = *(const bf16x8*)(u + (tl_ + 16 * wid + fr) * 6144 + h * 256 + 32 * ks + 8 * fq); } while (0)
        RET_LOAD(0); RET_LOADQ(0);
        for (int chunk = 0; chunk < 16; ++chunk) {
            const size_t t0 = (size_t)b * SEQ + chunk * 128;
            int tst = tid0_; asm volatile("" : "+v"(tst));
#pragma unroll
            for (int i = 0; i < 8; ++i) {
                const int piece = tst + NTHREADS * i, m = piece >> 5, ch = piece & 31;
                const u32x4 kv = kraw[i];
                const float sc = exp2f(-(float)(m + 1) * lg2) * 0.0625f;
                u32x4 w;
                w.x = pack2(__uint_as_float(kv.x << 16) * sc, __uint_as_float(kv.x & 0xffff0000u) * sc); w.y = pack2(__uint_as_float(kv.y << 16) * sc, __uint_as_float(kv.y & 0xffff0000u) * sc);
                w.z = pack2(__uint_as_float(kv.z << 16) * sc, __uint_as_float(kv.z & 0xffff0000u) * sc); w.w = pack2(__uint_as_float(kv.w << 16) * sc, __uint_as_float(kv.w & 0xffff0000u) * sc);
                *(LAS u32x4*)(Kl + m * KS + ch * 16) = w;
            }
#pragma unroll
            for (int i = 0; i < 2; ++i) {
                const int piece = tst + NTHREADS * i, m = piece >> 3, ch = piece & 7;
                *(LAS u32x4*)(Vl + m * VS + ch * 16) = vraw[i];
            }
            __syncthreads();
            if (chunk + 1 < 16) RET_LOAD(chunk + 1);
            f32x4 sc[8];
#pragma unroll
            for (int mt = 0; mt < 8; ++mt) {
                sc[mt] = (f32x4){0.f, 0.f, 0.f, 0.f};
#pragma unroll
                for (int ks = 0; ks < 8; ++ks) {
                    const bf16x8 kf = *(const LAS bf16x8*)(Kl + (16 * mt + fr) * KS + (32 * ks + 8 * fq) * 2);
                    sc[mt] = __builtin_amdgcn_mfma_f32_16x16x32_bf16(kf, Qf[ks], sc[mt], 0, 0, 0);
                }
                if (mt & 1) __builtin_amdgcn_sched_barrier(0);
            }
            bf16x8 pf[4];
            const int nloc = 16 * wid + fr;
#pragma unroll
            for (int ks2 = 0; ks2 < 4; ++ks2) {
                float v[8];
#pragma unroll
                for (int t = 0; t < 2; ++t)
#pragma unroll
                    for (int r = 0; r < 4; ++r) { const int m = 32 * ks2 + 16 * t + 4 * fq + r; v[4 * t + r] = (m <= nloc) ? sc[2 * ks2 + t][r] : 0.f; }
                u32x4 w; w.x = pack2(v[0], v[1]); w.y = pack2(v[2], v[3]); w.z = pack2(v[4], v[5]); w.w = pack2(v[6], v[7]);
                pf[ks2] = __builtin_bit_cast(bf16x8, w);
            }
            f32x4 O[4];
#pragma unroll
            for (int vt = 0; vt < 4; ++vt) {
                O[vt] = (f32x4){0.f, 0.f, 0.f, 0.f};
#pragma unroll
                for (int ks2 = 0; ks2 < 4; ++ks2) {
                    const bf16x8 vf = cat8(tr4(Vl, 32 * ks2 + 4 * fq, 16 * vt, VS, lane), tr4(Vl, 32 * ks2 + 16 + 4 * fq, 16 * vt, VS, lane));
                    O[vt] = __builtin_amdgcn_mfma_f32_16x16x32_bf16(pf[ks2], vf, O[vt], 0, 0, 0);
                }
#pragma unroll
                for (int ks = 0; ks < 8; ++ks) {
                    const bf16x8 sf = *(const LAS bf16x8*)(Sl + (16 * vt + fr) * SS + (32 * ks + 8 * fq) * 2);
                    O[vt] = __builtin_amdgcn_mfma_f32_16x16x32_bf16(Qf[ks], sf, O[vt], 0, 0, 0);
                }
                __builtin_amdgcn_sched_barrier(0);
            }
#pragma unroll
            for (int r = 0; r < 4; ++r) {
                const int n = 16 * wid + 4 * fq + r;
                const float qd = exp2f((float)(n + 1) * lg2);
                bf16_t* op = RO + (t0 + n) * 2048 + h * 512 + vs * 64 + fr;
#pragma unroll
                for (int vt = 0; vt < 4; ++vt) op[16 * vt] = f2bf(O[vt][r] * qd);
            }
            if (chunk + 1 < 16) RET_LOADQ(chunk + 1);
#pragma unroll
            for (int ks3 = 0; ks3 < 4; ++ks3) {
                bf16x8 kt[2], vf[4];
#pragma unroll
                for (int dt = 0; dt < 2; ++dt) kt[dt] = cat8(tr4(Kl, 32 * ks3 + 8 * fq, 32 * wid + 16 * dt, KS, lane), tr4(Kl, 32 * ks3 + 8 * fq + 4, 32 * wid + 16 * dt, KS, lane));
#pragma unroll
                for (int vt = 0; vt < 4; ++vt) vf[vt] = cat8(tr4(Vl, 32 * ks3 + 8 * fq, 16 * vt, VS, lane), tr4(Vl, 32 * ks3 + 8 * fq + 4, 16 * vt, VS, lane));
#pragma unroll
                for (int dt = 0; dt < 2; ++dt)
#pragma unroll
                    for (int vt = 0; vt < 4; ++vt) Sacc[dt][vt] = __builtin_amdgcn_mfma_f32_16x16x32_bf16(kt[dt], vf[vt], Sacc[dt][vt], 0, 0, 0);
                __builtin_amdgcn_sched_barrier(0);
            }
            __syncthreads();
            const float cd = exp2f(128.0f * lg2);
#pragma unroll
            for (int dt = 0; dt < 2; ++dt)
#pragma unroll
                for (int vt = 0; vt < 4; ++vt) {
                    Sacc[dt][vt] *= cd;
                    u32x2 w; w.x = pack2(Sacc[dt][vt][0], Sacc[dt][vt][1]); w.y = pack2(Sacc[dt][vt][2], Sacc[dt][vt][3]);
                    *(LAS u32x2*)(Sl + (16 * vt + fr) * SS + (32 * wid + 16 * dt + 4 * fq) * 2) = w;
                }
        }
        __syncthreads();
#undef RET_LOAD
#undef RET_LOADQ
    }
}
__device__ __forceinline__ void ret_norm_phase(LAS unsigned char* lds, const Params& p) {
    const int tid = tid_(), lane = tid & 63, wid = tid >> 6;
    const bf16_t* u = (const bf16_t*)(p.ws + WS_U);
    const bf16_t* RO = (const bf16_t*)(p.ws + WS_SCR);
    bf16_t* yin = (bf16_t*)(p.ws + WS_YIN);
    const int nwu = T * 4, stride = (int)gridDim.x * 8;
    for (int wu0 = blockIdx.x * 8 + wid; wu0 < nwu; wu0 += 2 * stride) {
        u32x4 ov[2], gv[2];
#pragma unroll
        for (int q = 0; q < 2; ++q) { const int wu = wu0 + q * stride; const size_t t = (size_t)(wu >> 2); const int h = wu & 3;
            if (wu < nwu) { ov[q] = *(const u32x4*)(RO + t * 2048 + h * 512 + lane * 8); gv[q] = *(const u32x4*)(u + t * 6144 + 4096 + h * 512 + lane * 8); } }
#pragma unroll
        for (int q = 0; q < 2; ++q) { const int wu = wu0 + q * stride; const size_t t = (size_t)(wu >> 2); const int h = wu & 3;
            if (wu < nwu) {
                float o[8], g[8];
                o[0] = __uint_as_float(ov[q].x << 16); o[1] = __uint_as_float(ov[q].x & 0xffff0000u); o[2] = __uint_as_float(ov[q].y << 16); o[3] = __uint_as_float(ov[q].y & 0xffff0000u);
                o[4] = __uint_as_float(ov[q].z << 16); o[5] = __uint_as_float(ov[q].z & 0xffff0000u); o[6] = __uint_as_float(ov[q].w << 16); o[7] = __uint_as_float(ov[q].w & 0xffff0000u);
                g[0] = __uint_as_float(gv[q].x << 16); g[1] = __uint_as_float(gv[q].x & 0xffff0000u); g[2] = __uint_as_float(gv[q].y << 16); g[3] = __uint_as_float(gv[q].y & 0xffff0000u);
                g[4] = __uint_as_float(gv[q].z << 16); g[5] = __uint_as_float(gv[q].z & 0xffff0000u); g[6] = __uint_as_float(gv[q].w << 16); g[7] = __uint_as_float(gv[q].w & 0xffff0000u);
                float ss = 0.f;
#pragma unroll
                for (int j = 0; j < 8; ++j) ss += o[j] * o[j];
                const float rstd = rsqrtf(wave_sum(ss) * (1.0f / 512.0f) + 1e-6f);
                float y[8];
#pragma unroll
                for (int j = 0; j < 8; ++j) y[j] = g[j] * sigmoidf_(g[j]) * o[j] * rstd;
                u32x4 w; w.x = pack2(y[0], y[1]); w.y = pack2(y[2], y[3]); w.z = pack2(y[4], y[5]); w.w = pack2(y[6], y[7]);
                *(u32x4*)(yin + t * 2048 + h * 512 + lane * 8) = w;
            } }
    }
}

__device__ __forceinline__ void attn_core_phase(LAS unsigned char* lds, const Params& p) {
    const int tid0_ = tid_(); const int tid = tid0_, lane = tid & 63, wid = tid >> 6, fr = lane & 15, fq = lane >> 4;
    constexpr int RS = 144, TILE = 272 * RS;
    LAS unsigned char* Kl = lds;
    LAS unsigned char* Vl = lds + TILE;
    const bf16_t* u = (const bf16_t*)(p.ws + WS_U);
    bf16_t* OP = (bf16_t*)(p.ws + WS_SCR);
    float* LSE = (float*)(p.ws + WS_SCR + 96 * MB);
    for (int i = tid; i < 16 * RS / 16; i += NTHREADS) { ((LAS u32x4*)(Kl + 256 * RS))[i] = (u32x4){0u, 0u, 0u, 0u}; ((LAS u32x4*)(Vl + 256 * RS))[i] = (u32x4){0u, 0u, 0u, 0u}; }
    u32x4 kraw[4], vraw[4]; bf16x8 Qn[2];
#define ATT_DECODE(un_) const int g = (un_) >> 11, rem = (un_) & 2047, b = rem >> 8, h = (rem >> 4) & 15, x = rem & 15; \
        const int dl = (g == 0) ? 1 : (g == 1 ? 4 : 16), r_ = x & (dl - 1), n = x / dl
#define ATT_LOAD(un_) do { ATT_DECODE(un_); int tl_ = tid0_; const bf16_t* ub = u; asm volatile("" : "+v"(tl_), "+s"(ub)); ub += (size_t)b * SEQ * 9216; \
        _Pragma("unroll") for (int i = 0; i < 4; ++i) { const int piece = tl_ + NTHREADS * i, row = piece >> 3, ch = piece & 7; const int sk = ((n - 1) * 128 + row) * dl + r_; \
            kraw[i] = (u32x4){0u, 0u, 0u, 0u}; vraw[i] = (u32x4){0u, 0u, 0u, 0u}; \
            if (sk >= 0) { const bf16_t* src = ub + (size_t)sk * 9216 + h * 64 + ch * 8; kraw[i] = *(const u32x4*)(src + (3 + g) * 1024); vraw[i] = *(const u32x4*)(src + (6 + g) * 1024); } } \
        { const int sq_ = (n * 128 + 16 * (tl_ >> 6) + (tl_ & 15)) * dl + r_; \
          _Pragma("unroll") for (int ks = 0; ks < 2; ++ks) Qn[ks] = *(const bf16x8*)(ub + (size_t)sq_ * 9216 + g * 1024 + h * 64 + 32 * ks + 8 * ((tl_ & 63) >> 4)); } } while (0)
    if ((int)blockIdx.x < 3 * 2048) ATT_LOAD((int)blockIdx.x);
    for (int un = blockIdx.x; un < 3 * 2048; un += gridDim.x) {
        ATT_DECODE(un);
        const float slope = exp2f(-0.5f * (float)(h + 1)) * (float)dl;
        { int tl_ = tid0_; asm volatile("" : "+v"(tl_));
#pragma unroll
          for (int i = 0; i < 4; ++i) {
            const int piece = tl_ + NTHREADS * i, row = piece >> 3, ch = piece & 7;
            *(LAS u32x4*)(Kl + row * RS + ch * 16) = kraw[i]; *(LAS u32x4*)(Vl + row * RS + ch * 16) = vraw[i];
          } }
        const int qi = 16 * wid + fr, sq = (n * 128 + qi) * dl + r_;
        bf16x8 Qf[2];
#pragma unroll
        for (int ks = 0; ks < 2; ++ks) Qf[ks] = Qn[ks];
        __syncthreads();
        if (un + (int)gridDim.x < 3 * 2048) ATT_LOAD(un + (int)gridDim.x);
        f32x4 sc[9];
        float mx = -INFINITY;
#pragma unroll
        for (int kt = 0; kt < 9; ++kt) {
            sc[kt] = (f32x4){0.f, 0.f, 0.f, 0.f};
#pragma unroll
            for (int ks = 0; ks < 2; ++ks) {
                const bf16x8 kf = *(const LAS bf16x8*)(Kl + (16 * (wid + kt) + fr) * RS + (32 * ks + 8 * fq) * 2);
                sc[kt] = __builtin_amdgcn_mfma_f32_16x16x32_bf16(kf, Qf[ks], sc[kt], 0, 0, 0);
            }
#pragma unroll
            for (int r = 0; r < 4; ++r) {
                const int ki = 16 * (wid + kt) + 4 * fq + r, steps = qi + 128 - ki;
                const bool ok = (steps >= 0) && (steps <= 128) && (n > 0 || ki >= 128);
                const float v = ok ? sc[kt][r] * 0.125f - slope * (float)steps : -INFINITY;
                sc[kt][r] = v; mx = fmaxf(mx, v);
            }
        }
        mx = fmaxf(mx, __shfl_xor(mx, 16)); mx = fmaxf(mx, __shfl_xor(mx, 32));
        float l = 0.f;
#pragma unroll
        for (int kt = 0; kt < 9; ++kt)
#pragma unroll
            for (int r = 0; r < 4; ++r) { const float pv = __expf(sc[kt][r] - mx); sc[kt][r] = pv; l += pv; }
        l += __shfl_xor(l, 16); l += __shfl_xor(l, 32);
        f32x4 O[4];
#pragma unroll
        for (int dt = 0; dt < 4; ++dt) O[dt] = (f32x4){0.f, 0.f, 0.f, 0.f};
#pragma unroll
        for (int ks5 = 0; ks5 < 5; ++ks5) {
            const f32x4 p0 = sc[2 * ks5], p1 = (ks5 < 4) ? sc[(ks5 < 4) ? 2 * ks5 + 1 : 0] : (f32x4){0.f, 0.f, 0.f, 0.f};
            u32x4 w; w.x = pack2(p0[0], p0[1]); w.y = pack2(p0[2], p0[3]); w.z = pack2(p1[0], p1[1]); w.w = pack2(p1[2], p1[3]);
            const bf16x8 pf = __builtin_bit_cast(bf16x8, w);
#pragma unroll
            for (int dt = 0; dt < 4; ++dt) {
                const bf16x8 vf = cat8(tr4(Vl, 16 * (wid + 2 * ks5) + 4 * fq, 16 * dt, RS, lane), tr4(Vl, 16 * (wid + 2 * ks5 + 1) + 4 * fq, 16 * dt, RS, lane));
                O[dt] = __builtin_amdgcn_mfma_f32_16x16x32_bf16(vf, pf, O[dt], 0, 0, 0);
            }
        }
        const float inv = __builtin_amdgcn_rcpf(l);
        const size_t tq = (size_t)b * SEQ + sq;
#pragma unroll
        for (int dt = 0; dt < 4; ++dt) {
            u32x2 w; w.x = pack2(O[dt][0] * inv, O[dt][1] * inv); w.y = pack2(O[dt][2] * inv, O[dt][3] * inv);
            *(u32x2*)(OP + ((size_t)g * T + tq) * D + h * 64 + 16 * dt + 4 * fq) = w;
        }
        if (fq == 0) LSE[((size_t)g * T + tq) * 16 + h] = mx + __logf(l);
        __syncthreads();
    }
#undef ATT_DECODE
#undef ATT_LOAD
}
__device__ __forceinline__ void attn_merge_phase(const Params& p) {
    const int tid = tid_();
    const bf16_t* OP = (const bf16_t*)(p.ws + WS_SCR);
    const float* LSE = (const float*)(p.ws + WS_SCR + 96 * MB);
    bf16_t* yin = (bf16_t*)(p.ws + WS_YIN);
    const size_t n = (size_t)T * D / 8, stride = (size_t)gridDim.x * NTHREADS;
    for (size_t i0 = (size_t)blockIdx.x * NTHREADS + tid; i0 < n; i0 += 2 * stride) {
        u32x4 a[2], bq[2], c[2]; float l0[2], l1[2], l2[2];
#pragma unroll
        for (int q = 0; q < 2; ++q) { const size_t i = i0 + q * stride; if (i < n) { const size_t t = i >> 7; const int c8 = (int)(i & 127), h = c8 >> 3;
            l0[q] = LSE[t * 16 + h]; l1[q] = LSE[((size_t)T + t) * 16 + h]; l2[q] = LSE[((size_t)2 * T + t) * 16 + h];
            a[q] = *(const u32x4*)(OP + t * D + c8 * 8); bq[q] = *(const u32x4*)(OP + ((size_t)T + t) * D + c8 * 8); c[q] = *(const u32x4*)(OP + ((size_t)2 * T + t) * D + c8 * 8); } }
#pragma unroll
        for (int q = 0; q < 2; ++q) { const size_t i = i0 + q * stride; if (i < n) { const size_t t = i >> 7; const int c8 = (int)(i & 127);
            const float m = fmaxf(l0[q], fmaxf(l1[q], l2[q]));
            float w0 = __expf(l0[q] - m), w1 = __expf(l1[q] - m), w2 = __expf(l2[q] - m);
            const float inv = __builtin_amdgcn_rcpf(w0 + w1 + w2); w0 *= inv; w1 *= inv; w2 *= inv;
            u32x4 o;
#define MRG(f) o.f = pack2(w0 * __uint_as_float(a[q].f << 16) + w1 * __uint_as_float(bq[q].f << 16) + w2 * __uint_as_float(c[q].f << 16), \
                           w0 * __uint_as_float(a[q].f & 0xffff0000u) + w1 * __uint_as_float(bq[q].f & 0xffff0000u) + w2 * __uint_as_float(c[q].f & 0xffff0000u))
            MRG(x); MRG(y); MRG(z); MRG(w);
#undef MRG
            *(u32x4*)(yin + t * D + c8 * 8) = o; } }
    }
}

__device__ __forceinline__ void ln1_router_phase(LAS unsigned char* lds, const Params& p, int layer) {
    const int tid = tid_(), lane = tid & 63, wid = tid >> 6, fr = lane & 15, fq = lane >> 4;
    constexpr int XS = 2064;
    LAS unsigned char* xh = lds;
    LAS unsigned char* xl = lds + 16 * XS;
    LAS float* part = (LAS float*)(lds + 32 * XS);
    LAS float* logit = part + 8 * 16 * 32;
    LAS int* tkE = (LAS int*)(logit + 16 * 32);
    LAS int* tkR = tkE + 512;
    LAS int* hist = tkR + 512;
    LAS int* hbase = hist + 32;
    float* xf = (float*)(p.ws + WS_XF); bf16_t* xb = (bf16_t*)(p.ws + WS_XB);
    const bf16_t* ymix = (const bf16_t*)(p.ws + WS_YMIX);
    int* tope = (int*)(p.ws + WS_TOPE); float* gates = (float*)(p.ws + WS_GATES); int* pos = (int*)(p.ws + WS_POS);
    unsigned char* xq = p.ws + WS_XQ; int* elist = (int*)(p.ws + WS_LIST);
    unsigned* ctl = (unsigned*)(p.ws + WS_CTL);
    const float* gain = p.ln_gain + (size_t)(layer * 2) * D; const float* bias = p.ln_bias + (size_t)(layer * 2) * D;
    const float* brt = p.moe_b_router + (size_t)layer * NEXP;
    const bf16_t* rth = (const bf16_t*)(p.ws + WS_RT) + (size_t)layer * 2 * NEXP * D; const bf16_t* rtl = rth + NEXP * D;
    bf16x8 Wh[2][4], Wl[2][4];
#pragma unroll
    for (int nt = 0; nt < 2; ++nt)
#pragma unroll
        for (int ks = 0; ks < 4; ++ks) { const size_t o = (size_t)(16 * nt + fr) * D + 128 * wid + 32 * ks + 8 * fq; Wh[nt][ks] = *(const bf16x8*)(rth + o); Wl[nt][ks] = *(const bf16x8*)(rtl + o); }
    if (tid < NEXP) hist[tid] = 0;
    int it = 0;
    for (int tile = blockIdx.x; tile < T / 16; tile += gridDim.x) {
#pragma unroll
        for (int tt = 0; tt < 2; ++tt) {
            const int trow = 2 * wid + tt; const size_t t = (size_t)tile * 16 + trow;
            f32x4 z[4];
#pragma unroll
            for (int i = 0; i < 4; ++i) { const int c = 256 * i + 4 * lane; const u32x2 yv = *(const u32x2*)(ymix + t * D + c);
                z[i] = DN_ALPHA * *(const f32x4*)(xf + t * D + c) + (f32x4){__uint_as_float(yv.x << 16), __uint_as_float(yv.x & 0xffff0000u), __uint_as_float(yv.y << 16), __uint_as_float(yv.y & 0xffff0000u)}; }
            float sm = 0.f;
#pragma unroll
            for (int i = 0; i < 4; ++i) sm += (z[i][0] + z[i][1]) + (z[i][2] + z[i][3]);
            const float mean = wave_sum(sm) * (1.0f / D);
            float sq = 0.f;
#pragma unroll
            for (int i = 0; i < 4; ++i) { const f32x4 dd = z[i] - mean; sq += (dd[0] * dd[0] + dd[1] * dd[1]) + (dd[2] * dd[2] + dd[3] * dd[3]); }
            const float rstd = rsqrtf(wave_sum(sq) * (1.0f / D) + LN_EPS);
#pragma unroll
            for (int i = 0; i < 4; ++i) {
                const int c = 256 * i + 4 * lane;
                const f32x4 v = (z[i] - mean) * rstd * *(const f32x4*)(gain + c) + *(const f32x4*)(bias + c);
                *(f32x4*)(xf + t * D + c) = v;
                u32x2 wh; wh.x = pack2(v[0], v[1]); wh.y = pack2(v[2], v[3]);
                *(unsigned*)(xq + t * D + c) = pk_fp8x4(v[0], v[1], v[2], v[3]);
                const float r0 = v[0] - __uint_as_float(wh.x << 16), r1 = v[1] - __uint_as_float(wh.x & 0xffff0000u), r2 = v[2] - __uint_as_float(wh.y << 16), r3 = v[3] - __uint_as_float(wh.y & 0xffff0000u);
                u32x2 wl; wl.x = pack2(r0, r1); wl.y = pack2(r2, r3);
                *(LAS u32x2*)(xh + trow * XS + c * 2) = wh; *(LAS u32x2*)(xl + trow * XS + c * 2) = wl;
            }
        }
        __syncthreads();
        {
            f32x4 acc[2] = {(f32x4){0.f, 0.f, 0.f, 0.f}, (f32x4){0.f, 0.f, 0.f, 0.f}};
#pragma unroll
            for (int ks = 0; ks < 4; ++ks) {
                const bf16x8 ah = *(const LAS bf16x8*)(xh + fr * XS + (128 * wid + 32 * ks + 8 * fq) * 2), al = *(const LAS bf16x8*)(xl + fr * XS + (128 * wid + 32 * ks + 8 * fq) * 2);
#pragma unroll
                for (int nt = 0; nt < 2; ++nt) {
                    acc[nt] = __builtin_amdgcn_mfma_f32_16x16x32_bf16(Wh[nt][ks], ah, acc[nt], 0, 0, 0);
                    acc[nt] = __builtin_amdgcn_mfma_f32_16x16x32_bf16(Wh[nt][ks], al, acc[nt], 0, 0, 0);
                    acc[nt] = __builtin_amdgcn_mfma_f32_16x16x32_bf16(Wl[nt][ks], ah, acc[nt], 0, 0, 0);
                }
            }
#pragma unroll
            for (int nt = 0; nt < 2; ++nt) *(LAS f32x4*)(part + (wid * 16 + fr) * 32 + 16 * nt + 4 * fq) = acc[nt];
        }
        __syncthreads();
        {
            const int tk = tid >> 5, e = tid & 31;
            float sacc = brt[e];
#pragma unroll
            for (int w = 0; w < 8; ++w) sacc += part[(w * 16 + tk) * 32 + e];
            logit[tk * 32 + e] = sacc;
        }
        __syncthreads();
        if (tid < 16) {
            const size_t t = (size_t)tile * 16 + tid;
            float v0 = -INFINITY, v1 = -INFINITY, v2 = -INFINITY, v3 = -INFINITY; int i0 = 0, i1 = 0, i2 = 0, i3 = 0;
#pragma unroll
            for (int e = 0; e < NEXP; ++e) {
                const float v = logit[tid * 32 + e];
                if (v > v3) {
                    if (v > v0) { v3 = v2; i3 = i2; v2 = v1; i2 = i1; v1 = v0; i1 = i0; v0 = v; i0 = e; }
                    else if (v > v1) { v3 = v2; i3 = i2; v2 = v1; i2 = i1; v1 = v; i1 = e; }
                    else if (v > v2) { v3 = v2; i3 = i2; v2 = v; i2 = e; }
                    else { v3 = v; i3 = e; }
                }
            }
            const float e1 = __expf(v1 - v0), e2 = __expf(v2 - v0), e3 = __expf(v3 - v0), inv = 1.0f / (1.0f + e1 + e2 + e3);
            tope[t * 4 + 0] = i0; tope[t * 4 + 1] = i1; tope[t * 4 + 2] = i2; tope[t * 4 + 3] = i3;
            gates[t * 4 + 0] = inv; gates[t * 4 + 1] = e1 * inv; gates[t * 4 + 2] = e2 * inv; gates[t * 4 + 3] = e3 * inv;
            const int sl = (it & 7) * 16 + tid;
            tkE[sl * 4 + 0] = i0; tkR[sl * 4 + 0] = (int)atomicAdd((unsigned*)(hist + i0), 1u);
            tkE[sl * 4 + 1] = i1; tkR[sl * 4 + 1] = (int)atomicAdd((unsigned*)(hist + i1), 1u);
            tkE[sl * 4 + 2] = i2; tkR[sl * 4 + 2] = (int)atomicAdd((unsigned*)(hist + i2), 1u);
            tkE[sl * 4 + 3] = i3; tkR[sl * 4 + 3] = (int)atomicAdd((unsigned*)(hist + i3), 1u);
        }
        ++it;
        if ((it & 7) == 0 || tile + (int)gridDim.x >= T / 16) {
            __syncthreads();
            if (tid < NEXP) { const unsigned h = (unsigned)hist[tid]; hbase[tid] = h ? (int)atomicAdd(ctl + CW_CNT + layer * 64 + tid, h) : 0; hist[tid] = 0; }
            __syncthreads();
            const int nsl = (((it - 1) & 7) + 1) * 16;
            for (int a = tid; a < nsl * 4; a += NTHREADS) {
                const int sl = a >> 2, e = tkE[a], ps = hbase[e] + tkR[a];
                const int t = (tile - (((it - 1) & 7) - (sl >> 4)) * (int)gridDim.x) * 16 + (sl & 15);
                pos[t * 4 + (a & 3)] = ps; elist[(size_t)e * T + ps] = t;
            }
            __syncthreads();
        }
    }
    __syncthreads();
}
__device__ __forceinline__ void ln2_phase(LAS unsigned char* lds, const Params& p, int layer) {
    const int tid = tid_(), lane = tid & 63, wid = tid >> 6;
    moe_tables(lds, (const unsigned*)(p.ws + WS_CTL), layer);
    LAS const int* tab = (LAS const int*)(lds + TAB_OFF);
    const int* tope = (const int*)(p.ws + WS_TOPE); const int* pos = (const int*)(p.ws + WS_POS);
    float* xf = (float*)(p.ws + WS_XF);
    const bf16_t* yrows = (const bf16_t*)(p.ws + WS_YROWS);
    const float* gates = (const float*)(p.ws + WS_GATES);
    const float* gain = p.ln_gain + (size_t)(layer * 2 + 1) * D; const float* bias = p.ln_bias + (size_t)(layer * 2 + 1) * D;
    const int stride = (int)gridDim.x * 8;
    for (int t0 = blockIdx.x * 8 + wid; t0 < T; t0 += 2 * stride) {
        int dk[2][4]; float gk[2][4];
#pragma unroll
        for (int q = 0; q < 2; ++q) { const int t = (t0 + q * stride < T) ? t0 + q * stride : t0;
#pragma unroll
            for (int k = 0; k < 4; ++k) { dk[q][k] = tab[tope[t * 4 + k]] * 256 + pos[t * 4 + k]; gk[q][k] = gates[t * 4 + k]; } }
        u32x2 yv[2][4][4]; f32x4 xv[2][4];
#pragma unroll
        for (int q = 0; q < 2; ++q) { const int t = (t0 + q * stride < T) ? t0 + q * stride : t0;
#pragma unroll
            for (int i = 0; i < 4; ++i) { const int c = 256 * i + 4 * lane; xv[q][i] = *(const f32x4*)(xf + (size_t)t * D + c);
#pragma unroll
                for (int k = 0; k < 4; ++k) yv[q][i][k] = *(const u32x2*)(yrows + (size_t)dk[q][k] * D + c); } }
#pragma unroll
        for (int q = 0; q < 2; ++q) { const int t = t0 + q * stride; if (t < T) {
            f32x4 z[4];
#pragma unroll
            for (int i = 0; i < 4; ++i) {
                f32x4 f = (f32x4){0.f, 0.f, 0.f, 0.f};
#pragma unroll
                for (int k = 0; k < 4; ++k) { const u32x2 y2 = yv[q][i][k]; const float gg = gk[q][k];
                    f[0] += gg * __uint_as_float(y2.x << 16); f[1] += gg * __uint_as_float(y2.x & 0xffff0000u); f[2] += gg * __uint_as_float(y2.y << 16); f[3] += gg * __uint_as_float(y2.y & 0xffff0000u); }
                z[i] = DN_ALPHA * xv[q][i] + f;
            }
            float sm = 0.f;
#pragma unroll
            for (int i = 0; i < 4; ++i) sm += (z[i][0] + z[i][1]) + (z[i][2] + z[i][3]);
            const float mean = wave_sum(sm) * (1.0f / D);
            float sq = 0.f;
#pragma unroll
            for (int i = 0; i < 4; ++i) { const f32x4 dd = z[i] - mean; sq += (dd[0] * dd[0] + dd[1] * dd[1]) + (dd[2] * dd[2] + dd[3] * dd[3]); }
            const float rstd = rsqrtf(wave_sum(sq) * (1.0f / D) + LN_EPS);
#pragma unroll
            for (int i = 0; i < 4; ++i) {
                const int c = 256 * i + 4 * lane;
                z[i] = (z[i] - mean) * rstd * *(const f32x4*)(gain + c) + *(const f32x4*)(bias + c);
                if (layer == DEPTH - 1) *(f32x4*)(p.out + (size_t)t * D + c) = z[i];
                else { *(f32x4*)(xf + (size_t)t * D + c) = z[i]; *(unsigned*)(p.ws + WS_XQ + (size_t)t * D + c) = pk_fp8x4(z[i][0], z[i][1], z[i][2], z[i][3]); }
            }
        } }
    }
}

constexpr int PH_PER_LAYER = 9;
constexpr int NPHASES = 1 + DEPTH * PH_PER_LAYER;
constexpr int LDS_BYTES = 132 * 1024;


#ifndef PHMASK
#define PHMASK 0x3FF
#endif
#define PHK(j) ((PHMASK >> (j)) & 1)
#ifndef PROBE_MASK
#define PROBE_MASK 0
#endif
#ifndef PROBE_LAYERS
#define PROBE_LAYERS 0xF
#endif
#define REPS(j) ((((PROBE_MASK) >> (j)) & 1) ? 2 : 1)
#define REPSL(j) (((((PROBE_MASK) >> (j)) & 1) && (((PROBE_LAYERS) >> layer) & 1)) ? 2 : 1)
#define IN(k) (lo <= (k) && (k) < hi)
#if MK_ONE_LAUNCH
#define SEAM(k) do { if (IN(k) && IN((k) + 1)) xcd_barrier_nv(bar.bar, bar.x, bar.st); } while (0)
#else
#define SEAM(k) do {} while (0)
#endif
template <int layer>
__device__ __forceinline__ void run_layer(const Params& p, LAS unsigned char* lds, const XcdBarrier& bar) {
    const int lo = p.ph_lo, hi = p.ph_hi;
    unsigned char* ws = p.ws;
    unsigned* ctl = (unsigned*)(ws + WS_CTL);
        constexpr int base = 1 + layer * PH_PER_LAYER, kind = layer % 3, idx = layer / 3;
        for (int rep_ = 0; rep_ < REPSL(1); ++rep_) if (PHK(1) && IN(base + 0)) {
            constexpr int N = (kind == 0) ? 2048 : (kind == 1 ? 6144 : 9216);
            const unsigned char* Bt = (kind == 0) ? ws + WS_AWIN + (size_t)idx * 2048 * D : (kind == 1 ? ws + WS_BWIN : ws + WS_CWIN);
            g8::SchedPlain S; S.init(ws + WS_XQ, Bt, T, N, D / 2, (int)gridDim.x, (int)blockIdx.x);
            g8::EpiBf16 E{(bf16_t*)(ws + WS_U), N, nullptr, 0, 1.0f / GU_WSCALE};
            g8::gemm_phase<g8::EpiBf16, g8::SchedPlain, false, 1>(lds, D, S, E);
        }
        SEAM(base + 0);
        for (int rep_ = 0; rep_ < REPSL(2); ++rep_) if (PHK(2) && IN(base + 1)) {
            if (kind == 0) lru_gates_phase(lds, p, idx);
            else if (kind == 1) ret_core_phase(lds, p);
            else attn_core_phase(lds, p);
        }
        SEAM(base + 1);
        for (int rep_ = 0; rep_ < REPSL(3); ++rep_) if (PHK(3) && IN(base + 2)) {
            if (kind == 0) lru_scan_phase(p);
            else if (kind == 1) ret_norm_phase(lds, p);
            else attn_merge_phase(p);
        }
        SEAM(base + 2);
        for (int rep_ = 0; rep_ < REPSL(4); ++rep_) if (PHK(4) && IN(base + 3)) {
            constexpr int K = (kind == 1) ? 2048 : D;
            const bf16_t* Bt = (kind == 0) ? (const bf16_t*)(ws + WS_AWOUT) + (size_t)idx * D * D : (kind == 1 ? (const bf16_t*)(ws + WS_BWOUT) : (const bf16_t*)(ws + WS_CWOUT));
            g8::SchedPlain S; S.init(ws + WS_YIN, Bt, T, D, K, (int)gridDim.x, (int)blockIdx.x);
            g8::EpiBf16 E{(bf16_t*)(ws + WS_YMIX), D, nullptr, 0, 1.0f};
            g8::gemm_phase<g8::EpiBf16, g8::SchedPlain, false>(lds, K, S, E);
        }
        SEAM(base + 3);
        for (int rep_ = 0; rep_ < REPSL(5); ++rep_) if (PHK(5) && IN(base + 4)) ln1_router_phase(lds, p, layer);
        SEAM(base + 4);
        for (int rep_ = 0; rep_ < REPSL(7); ++rep_) if (PHK(7) && IN(base + 6)) {
            moe_tables(lds, ctl, layer);
            g8::SchedGU S{(const char*)(ws + WS_XQ), (const char*)(ws + WS_GU) + (size_t)layer * NEXP * 2048 * D, (const int*)(ws + WS_LIST), (LAS const int*)(lds + TAB_OFF), (int)gridDim.x, (int)blockIdx.x};
            g8::EpiSwiglu E{ws + WS_HID, p.moe_b_gu + (size_t)layer * NEXP * 2048, 1.0f / GU_WSCALE};
            g8::gemm_phase<g8::EpiSwiglu, g8::SchedGU, true, 1>(lds, D, S, E);
        }
        SEAM(base + 6);
        for (int rep_ = 0; rep_ < REPSL(8); ++rep_) if (PHK(8) && IN(base + 7)) {
            moe_tables(lds, ctl, layer);
            g8::SchedDown S{(const char*)(ws + WS_HID), (const char*)(ws + WS_DN) + (size_t)layer * NEXP * D * D, (LAS const int*)(lds + TAB_OFF), (int)gridDim.x, (int)blockIdx.x};
            g8::EpiBf16 E{(bf16_t*)(ws + WS_YROWS), D, p.moe_b_down + (size_t)layer * NEXP * D, D, 1.0f / DN_WSCALE};
            g8::gemm_phase<g8::EpiBf16, g8::SchedDown, false, 1>(lds, D, S, E);
        }
        SEAM(base + 7);
        for (int rep_ = 0; rep_ < REPSL(9); ++rep_) if (PHK(9) && IN(base + 8)) ln2_phase(lds, p, layer);
        SEAM(base + 8);
    }
#undef IN
#undef SEAM
__global__ void __launch_bounds__(NTHREADS, 2) fwd_kernel(Params p) {
    extern __shared__ __attribute__((aligned(16))) unsigned char lds_raw[];
    LAS unsigned char* lds = (LAS unsigned char*)lds_raw;
    const int lo = p.ph_lo, hi = p.ph_hi;
    unsigned char* ws = p.ws;
    unsigned* ctl = (unsigned*)(ws + WS_CTL);
#if MK_ONE_LAUNCH
    volatile LAS unsigned* bst = (volatile LAS unsigned*)(lds + LDS_BYTES - 16);
    if (threadIdx.x == 0) { bst[0] = 0u; bst[1] = 0u; bst[2] = 0u; bst[3] = 0u; }
    __syncthreads();
    XcdBarrier bar = xcd_barrier_post(ctl, bst);
#define GRID_BAR() xcd_barrier_nv(bar.bar, bar.x, bar.st)
#else
    XcdBarrier bar; bar.bar = ctl; bar.x = 0; bar.st = nullptr;
#define GRID_BAR() do {} while (0)
#endif
#define IN(k) (lo <= (k) && (k) < hi)
#define SEAM(k) do { if (IN(k) && IN((k) + 1)) GRID_BAR(); } while (0)

    for (int rep_ = 0; rep_ < REPS(0); ++rep_) if (PHK(0) && IN(0)) {
        LAS float* tile = (LAS float*)lds;
#pragma unroll 1
        for (int j = 0; j < 5; ++j) {
            const float* src = j == 0 ? p.moe_w_gu : (j == 1 ? p.moe_w_down : (j == 2 ? p.a_w_in : (j == 3 ? p.b_w_in : p.c_w_in)));
            const size_t dsto = j == 0 ? WS_GU : (j == 1 ? WS_DN : (j == 2 ? WS_AWIN : (j == 3 ? WS_BWIN : WS_CWIN)));
            const int N = j == 0 ? 2048 : (j == 1 ? D : (j == 2 ? 2048 : (j == 3 ? 6144 : 9216)));
            const int batch = j < 2 ? DEPTH * NEXP : (j == 2 ? 2 : 1);
            convert_big<true>(lds, src, ws + dsto, D, N, batch, j == 1 ? DN_WSCALE : GU_WSCALE);
        }
#pragma unroll 1
        for (int j = 0; j < 3; ++j) {
            const float* src = j == 0 ? p.a_w_out : (j == 1 ? p.b_w_out : p.c_w_out);
            const size_t dsto = j == 0 ? WS_AWOUT : (j == 1 ? WS_BWOUT : WS_CWOUT);
            convert_big<false>(lds, src, ws + dsto, j == 1 ? 2048 : D, D, j == 0 ? 2 : 1, 1.0f);
        }
        convert_job(tile, p.a_w_rgate, (bf16_t*)(ws + WS_AGT), 128, 128, 8);
        convert_job(tile, p.a_w_igate, (bf16_t*)(ws + WS_AGT) + (size_t)8 * 128 * 128, 128, 128, 8);
        convert_job(tile, p.a_w_rgate + (size_t)8 * 128 * 128, (bf16_t*)(ws + WS_AGT) + (size_t)16 * 128 * 128, 128, 128, 8);
        convert_job(tile, p.a_w_igate + (size_t)8 * 128 * 128, (bf16_t*)(ws + WS_AGT) + (size_t)24 * 128 * 128, 128, 128, 8);
        {
            bf16_t* rt = (bf16_t*)(ws + WS_RT);
            for (int i = blockIdx.x * NTHREADS + threadIdx.x; i < DEPTH * NEXP * D; i += gridDim.x * NTHREADS) {
                const int l = i / (NEXP * D), r_ = i % (NEXP * D), e = r_ / D, k = r_ % D;
                const float w = p.moe_w_router[((size_t)l * D + k) * NEXP + e];
                const bf16_t hi = f2bf(w); const bf16_t lo = f2bf(w - bf2f(hi));
                rt[((size_t)l * 2 + 0) * NEXP * D + (size_t)e * D + k] = hi; rt[((size_t)l * 2 + 1) * NEXP * D + (size_t)e * D + k] = lo;
            }
        }
        float* xf = (float*)(ws + WS_XF); bf16_t* xb = (bf16_t*)(ws + WS_XB);
        {
            const size_t stride = (size_t)gridDim.x * NTHREADS;
            for (size_t i = (size_t)blockIdx.x * NTHREADS + threadIdx.x; i < (size_t)T * D / 4; i += 4 * stride) {
                f32x4 v[4];
#pragma unroll
                for (int q = 0; q < 4; ++q) v[q] = *(const f32x4*)(p.x + (i + q * stride) * 4);
#pragma unroll
                for (int q = 0; q < 4; ++q) { *(f32x4*)(xf + (i + q * stride) * 4) = v[q]; *(unsigned*)(ws + WS_XQ + (i + q * stride) * 4) = pk_fp8x4(v[q][0], v[q][1], v[q][2], v[q][3]); }
            }
        }
    }
    SEAM(0);

    run_layer<0>(p, lds, bar); run_layer<1>(p, lds, bar); run_layer<2>(p, lds, bar); run_layer<3>(p, lds, bar);
#undef IN
#undef SEAM
}

extern "C" void kernel_launch(void* const* d_in, const int* in_sizes, int n_in, void* d_out, int out_size, void* d_ws, size_t ws_size, hipStream_t stream) {
    static int grid = 0;
    if (grid == 0) {
        if (n_in != 22 || out_size != T * D || ws_size < WS_END) { fprintf(stderr, "kernel_launch: unexpected shapes (n_in %d out %d ws %zu need %zu)\n", n_in, out_size, ws_size, (size_t)WS_END); grid = -1; return; }
        if (hipFuncSetAttribute((const void*)fwd_kernel, hipFuncAttributeMaxDynamicSharedMemorySize, LDS_BYTES) != hipSuccess) { fprintf(stderr, "kernel_launch: hipFuncSetAttribute failed\n"); grid = -1; return; }
        int dev = 0, cus = 0;
        if (hipGetDevice(&dev) != hipSuccess || hipDeviceGetAttribute(&cus, hipDeviceAttributeMultiprocessorCount, dev) != hipSuccess) { grid = -1; return; }
        grid = cus;
    }
    if (grid < 0) return;
    (void)hipMemsetAsync((char*)d_ws + WS_CTL, 0, CTL_BYTES, stream);
    Params p{};
    const float** pp = (const float**)&p;
    for (int i = 0; i < 22; ++i) pp[i] = (const float*)d_in[i];
    p.out = (float*)d_out; p.ws = (unsigned char*)d_ws;
#if MK_ONE_LAUNCH
    p.ph_lo = 0; p.ph_hi = NPHASES;
    hipLaunchKernelGGL(fwd_kernel, dim3(grid), dim3(NTHREADS), LDS_BYTES, stream, p);
#else
    for (int ph = 0; ph < NPHASES; ++ph) {
        p.ph_lo = ph; p.ph_hi = ph + 1;
        hipLaunchKernelGGL(fwd_kernel, dim3(grid), dim3(NTHREADS), LDS_BYTES, stream, p);
    }
#endif
}
```

```cpp
#include <hip/hip_runtime.h>
#include <stdint.h>
#include <stdio.h>

#ifndef MK_ONE_LAUNCH
#define MK_ONE_LAUNCH 1
#endif

#define LAS __attribute__((address_space(3)))
typedef unsigned short bf16_t;
typedef short bf16x8 __attribute__((ext_vector_type(8)));
typedef float f32x4 __attribute__((ext_vector_type(4)));
typedef unsigned u32x4 __attribute__((ext_vector_type(4)));
typedef unsigned u32x2 __attribute__((ext_vector_type(2)));

constexpr int T = 16384, D = 1024, SEQ = 2048, NBATCH = 8, DEPTH = 4;
constexpr int NEXP = 32, TOPK = 4;
constexpr int MAXROWS = 73728;
constexpr float DN_ALPHA = 1.681792830507429f;
constexpr float LN_EPS = 1e-5f;
constexpr float GU_WSCALE = 64.0f, DN_WSCALE = 128.0f;
constexpr int NTHREADS = 512;

constexpr size_t MB = 1ull << 20;
constexpr size_t WS_CTL = 0;
constexpr size_t CTL_BYTES = 65536;
constexpr size_t WS_AWIN = 1 * MB;
constexpr size_t WS_AWOUT = WS_AWIN + 8 * MB;
constexpr size_t WS_BWIN = WS_AWOUT + 4 * MB;
constexpr size_t WS_BWOUT = WS_BWIN + 12 * MB;
constexpr size_t WS_CWIN = WS_BWOUT + 4 * MB;
constexpr size_t WS_CWOUT = WS_CWIN + 18 * MB;
constexpr size_t WS_GU = WS_CWOUT + 2 * MB;
constexpr size_t WS_DN = WS_GU + 512 * MB;
constexpr size_t WS_XF = WS_DN + 256 * MB;
constexpr size_t WS_XB = WS_XF + 64 * MB;
constexpr size_t WS_U = WS_XB + 32 * MB;
constexpr size_t WS_YIN = WS_U + 288 * MB;
constexpr size_t WS_YMIX = WS_YIN + 64 * MB;
constexpr size_t WS_SCR = WS_YMIX + 64 * MB;
constexpr size_t WS_TOPE = WS_SCR + 128 * MB;
constexpr size_t WS_GATES = WS_TOPE + 256 * 1024;
constexpr size_t WS_POS = WS_GATES + 256 * 1024;
constexpr size_t WS_DEST = WS_POS + 256 * 1024;
constexpr size_t WS_ROWTOK = WS_DEST + 256 * 1024;
constexpr size_t WS_HID = WS_ROWTOK + 1 * MB;
constexpr size_t WS_YROWS = WS_HID + 144 * MB;
constexpr size_t WS_LSUM = WS_YROWS + 288 * MB;
constexpr size_t WS_AGT = WS_LSUM + 2 * MB;
constexpr size_t WS_RT = WS_AGT + 1 * MB;
constexpr size_t WS_XQ = WS_RT + 1 * MB;
constexpr size_t WS_LIST = WS_XQ + 16 * MB;
constexpr size_t WS_END = WS_LIST + 2 * MB;

constexpr int CW_CNT = 4096;
constexpr int CW_MDYN = 8192;
constexpr int CW_TEXP = 12288;

#define XB_TMO      128
#define XB_XCNT(j)  (256  + 64 * (j))
#define XB_XSUB(j)  (1280 + 64 * (j))
#define XB_XGEN(j)  (2304 + 64 * (j))
#define XB_TOP      3328
#define XB_TOPGEN   3392
#define XCD_BAR_WORDS 3456
#define XB_SPIN_CAP (1u << 22)

__device__ __forceinline__ unsigned xb_ld(unsigned* p)              { return __hip_atomic_load(p, __ATOMIC_RELAXED, __HIP_MEMORY_SCOPE_AGENT); }
__device__ __forceinline__ unsigned xb_add(unsigned* p, unsigned v) { return __hip_atomic_fetch_add(p, v, __ATOMIC_RELAXED, __HIP_MEMORY_SCOPE_AGENT); }
__device__ __forceinline__ unsigned xb_xcc_id() { return (unsigned)__builtin_amdgcn_s_getreg((3 << 11) | 20) & 0xFu; }
#define XB_SPIN(cond, bar) do { unsigned _sp = 0; while (cond) { __builtin_amdgcn_s_sleep(1); \
    if ((++_sp & 255u) == 0u) { if (xb_ld(&(bar)[XB_TMO])) break; if (_sp > XB_SPIN_CAP) { atomicAdd(&(bar)[XB_TMO], 1u); break; } } } } while (0)

struct XcdBarrier { unsigned* bar; unsigned x; volatile LAS unsigned* st; };

__device__ __forceinline__ XcdBarrier xcd_barrier_post(unsigned* bar, volatile LAS unsigned* st) {
    XcdBarrier b; b.bar = bar; b.x = xb_xcc_id(); b.st = st;
    if (threadIdx.x == 0) (void)xb_add(&bar[XB_XCNT(b.x)], 1u);
    return b;
}
__device__ __forceinline__ void xcd_barrier_complete(unsigned* bar, unsigned x, unsigned& nloc, unsigned& nx) {
    const unsigned G = gridDim.x * gridDim.y * gridDim.z;
    unsigned sum, cnt, mine, sp = 0u;
    for (;;) {
        sum = 0u; cnt = 0u; mine = 0u;
#pragma unroll
        for (unsigned j = 0; j < 16; ++j) { const unsigned c = xb_ld(&bar[XB_XCNT(j)]); sum += c; cnt += (c > 0u) ? 1u : 0u; mine = (j == x) ? c : mine; }
        if (sum == G) break;
        __builtin_amdgcn_s_sleep(1);
        if ((++sp & 255u) == 0u) { if (xb_ld(&bar[XB_TMO])) break; if (sp > XB_SPIN_CAP) { atomicAdd(&bar[XB_TMO], 1u); break; } }
    }
    nloc = mine > 0u ? mine : 1u; nx = cnt > 0u ? cnt : 1u;
}
__device__ __forceinline__ void xcd_barrier_nv(unsigned* bbar, unsigned bx, volatile LAS unsigned* bst) {
    XcdBarrier b; b.bar = bbar; b.x = bx; b.st = bst;
    asm volatile("s_waitcnt vmcnt(0)" ::: "memory");
    __syncthreads();
    if (threadIdx.x == 0) {
        unsigned* bar = b.bar;
        __builtin_amdgcn_s_waitcnt(0);
        unsigned nloc = b.st[0], nx = b.st[1];
        if (nloc == 0u) { xcd_barrier_complete(bar, b.x, nloc, nx); b.st[0] = nloc; b.st[1] = nx; }
        const unsigned old = xb_add(&bar[XB_XSUB(b.x)], 1u);
        const unsigned gen = old / nloc;
        if (old + 1u == (gen + 1u) * nloc) {
            __builtin_amdgcn_fence(__ATOMIC_RELEASE, "agent");
            asm volatile("s_waitcnt vmcnt(0)" ::: "memory");
            const unsigned og = xb_add(&bar[XB_TOP], 1u);
            const unsigned tg = og / nx;
            if (og + 1u == (tg + 1u) * nx) xb_add(&bar[XB_TOPGEN], 1u);
            else XB_SPIN(xb_ld(&bar[XB_TOPGEN]) == tg, bar);
            __builtin_amdgcn_fence(__ATOMIC_ACQUIRE, "agent");
            xb_add(&bar[XB_XGEN(b.x)], 1u);
            asm volatile("s_waitcnt vmcnt(0)" ::: "memory");
        } else {
            XB_SPIN(xb_ld(&bar[XB_XGEN(b.x)]) == gen, bar);
            __builtin_amdgcn_fence(__ATOMIC_ACQUIRE, "agent");
            asm volatile("s_waitcnt vmcnt(0)" ::: "memory");
        }
    }
    __syncthreads();
}

__device__ __forceinline__ int tid_() { int t = threadIdx.x; asm volatile("" : "+v"(t)); return t; }
__device__ __forceinline__ float bf2f(bf16_t v) { return __uint_as_float(((unsigned)v) << 16); }
__device__ __forceinline__ unsigned pack2(float lo, float hi) { unsigned r; asm("v_cvt_pk_bf16_f32 %0, %1, %2" : "=v"(r) : "v"(lo), "v"(hi)); return r; }
__device__ __forceinline__ bf16_t f2bf(float f) { return (bf16_t)(pack2(f, f) & 0xffffu); }
__device__ __forceinline__ float wave_sum(float v) {
#pragma unroll
    for (int o = 32; o >= 1; o >>= 1) v += __shfl_xor(v, o);
    return v;
}
__device__ __forceinline__ float wave_max(float v) {
#pragma unroll
    for (int o = 32; o >= 1; o >>= 1) v = fmaxf(v, __shfl_xor(v, o));
    return v;
}
__device__ __forceinline__ float sigmoidf_(float x) { return __builtin_amdgcn_rcpf(1.0f + __builtin_amdgcn_exp2f(-1.4426950408889634f * x)); }
__device__ __forceinline__ float gelu_tanh(float x) { const float u = 0.7978845608028654f * (x + 0.044715f * x * x * x); return 0.5f * x * (1.0f + tanhf(u)); }
__device__ __forceinline__ unsigned pk_fp8x4(float a, float b, float c, float d) { int w = 0; w = __builtin_amdgcn_cvt_pk_fp8_f32(a, b, w, false); w = __builtin_amdgcn_cvt_pk_fp8_f32(c, d, w, true); return (unsigned)w; }
typedef float f32x2 __attribute__((ext_vector_type(2)));
__device__ __forceinline__ f32x2 swiglu2(f32x2 gate, f32x2 up) {
    f32x2 g, u; g.x = fminf(gate.x, 7.0f); g.y = fminf(gate.y, 7.0f); u.x = __builtin_amdgcn_fmed3f(up.x, -7.0f, 7.0f); u.y = __builtin_amdgcn_fmed3f(up.y, -7.0f, 7.0f);
    const f32x2 t = g * (-1.702f * 1.4426950408889634f);
    f32x2 e; e.x = __builtin_amdgcn_exp2f(t.x); e.y = __builtin_amdgcn_exp2f(t.y);
    const f32x2 d = e + 1.0f;
    f32x2 r; r.x = __builtin_amdgcn_rcpf(d.x); r.y = __builtin_amdgcn_rcpf(d.y);
    return ((u + 1.0f) * g) * r;
}
__device__ __forceinline__ float swiglu(float gate, float up) {
    const float g = fminf(gate, 7.0f), u = fminf(fmaxf(up, -7.0f), 7.0f);
    return (u + 1.0f) * g * sigmoidf_(1.702f * g);
}

struct Params {
    const float* x; const float* a_w_in; const float* a_conv_w; const float* a_conv_b; const float* a_w_rgate; const float* a_b_rgate;
    const float* a_w_igate; const float* a_b_igate; const float* a_lambda; const float* a_w_out; const float* b_w_in; const float* b_w_out;
    const float* c_w_in; const float* c_w_out; const float* ln_gain; const float* ln_bias; const float* moe_w_router; const float* moe_b_router;
    const float* moe_w_gu; const float* moe_b_gu; const float* moe_w_down; const float* moe_b_down;
    float* out; unsigned char* ws;
    int ph_lo, ph_hi;
};

__device__ __forceinline__ void convert_job(LAS float* tile, const float* src, bf16_t* dst, int K, int N, int batch) {
    const int tid = tid_();
    const int tk = K / 64, tn = N / 64, per = tk * tn; const long total = (long)per * batch;
    for (long u = blockIdx.x; u < total; u += gridDim.x) {
        const int bidx = (int)(u / per), r = (int)(u % per), kt = r / tn, nt = r % tn;
        const float* s = src + (size_t)bidx * K * N + (size_t)(kt * 64) * N + nt * 64;
#pragma unroll
        for (int pass = 0; pass < 2; ++pass) {
            const int row = (tid >> 4) + 32 * pass, c4 = tid & 15;
            const f32x4 v = *(const f32x4*)(s + (size_t)row * N + c4 * 4);
            tile[row * 65 + c4 * 4 + 0] = v[0]; tile[row * 65 + c4 * 4 + 1] = v[1]; tile[row * 65 + c4 * 4 + 2] = v[2]; tile[row * 65 + c4 * 4 + 3] = v[3];
        }
        __syncthreads();
        {
            const int n = tid >> 3, k8 = tid & 7;
            float v[8];
#pragma unroll
            for (int j = 0; j < 8; ++j) v[j] = tile[(k8 * 8 + j) * 65 + n];
            u32x4 w; w.x = pack2(v[0], v[1]); w.y = pack2(v[2], v[3]); w.z = pack2(v[4], v[5]); w.w = pack2(v[6], v[7]);
            *(u32x4*)(dst + (size_t)bidx * N * K + (size_t)(nt * 64 + n) * K + kt * 64 + k8 * 8) = w;
        }
        __syncthreads();
    }
}


constexpr int TAB_OFF = 131072;
__device__ __forceinline__ void moe_tables(LAS unsigned char* lds, const unsigned* ctl, int layer) {
    LAS int* tab = (LAS int*)(lds + TAB_OFF);
    const int tid = tid_();
    __syncthreads();
    if (tid == 0) { int acc = 0; for (int e = 0; e < NEXP; ++e) { tab[e] = acc; acc += ((int)ctl[CW_CNT + layer * 64 + e] + 255) >> 8; } tab[32] = acc; }
    __syncthreads();
    if (tid < 288) { int e = 0; for (int q = 1; q < NEXP; ++q) e += (tab[q] <= tid) ? 1 : 0; tab[64 + tid] = e; }
    __syncthreads();
}

namespace g8 {
constexpr int BM = 256, BK = 64, HALF = 128, HTB = HALF * BK * 2, STAGE_BYTES = 8 * HTB, NXCD = 8, WGM = 8;
__device__ __forceinline__ int lds_byte(int r, int c) { const int st = (r >> 4) * 2 + (c >> 5), rr = r & 15, cc = c & 31, ob = rr * 64 + cc * 2; return st * 1024 + (ob ^ (((ob >> 9) & 1) << 5)); }
__device__ __forceinline__ void stage_rc(int b, int& R, int& C) { const int st = b / 1024, sb = b % 1024, swz = sb ^ (((sb >> 9) & 1) << 5); R = (st >> 1) * 16 + swz / 64; C = (st & 1) * 32 + (swz % 64) / 2; }
__device__ __forceinline__ int perm32(int rho) { const int n = rho >> 4, i = rho & 15; return 8 * (i >> 2) + 4 * n + (i & 3); }
__device__ __forceinline__ unsigned cvt_pk_bf16(float lo, float hi) { unsigned r; asm volatile("v_cvt_pk_bf16_f32 %0, %1, %2" : "=v"(r) : "v"(lo), "v"(hi)); return r; }

struct Unit { const char* a0; const char* a1; const char* b0; const char* b1; const int* rows; int row0, col0, e; };

struct SchedPlain {
    const char* A; const char* Bt; size_t hstepA, hstepB; int nM, nN, nwg, G, c;
    __device__ __forceinline__ void init(const void* A_, const void* Bt_, int M, int N, int K, int G_, int c_) { A = (const char*)A_; Bt = (const char*)Bt_; hstepA = (size_t)HALF * K * 2; hstepB = hstepA; nM = M / BM; nN = N / BM; nwg = nM * nN; G = G_; c = c_; }
    __device__ __forceinline__ bool next(int i, Unit& u) const {
        const long L = (long)i * G + c; if (L >= nwg) return false;
        int wgid = (int)L; { const int q = nwg / NXCD, r = nwg % NXCD, xcd = wgid % NXCD, off = wgid / NXCD; wgid = (xcd < r ? xcd * (q + 1) : r * (q + 1) + (xcd - r) * q) + off; }
        const int nig = WGM * nN, gid = wgid / nig, fm = gid * WGM, gsz = (nM - fm) < WGM ? (nM - fm) : WGM;
        const int pm = fm + ((wgid % nig) % gsz), pn = (wgid % nig) / gsz;
        u.a0 = A + (size_t)pm * 2 * hstepA; u.a1 = u.a0 + hstepA; u.b0 = Bt + (size_t)pn * 2 * hstepB; u.b1 = u.b0 + hstepB; u.rows = nullptr; u.row0 = pm * BM; u.col0 = pn * BM; u.e = 0;
        return true;
    }
};
struct SchedGU {
    const char* A; const char* W; const int* elist; LAS const int* tab; int G, c;
    __device__ __forceinline__ bool next(int i, Unit& u) const {
        const int L = i * G + c, rt = L >> 3, pn = L & 7; if (rt >= __builtin_amdgcn_readfirstlane(tab[32])) return false;
        const int e = __builtin_amdgcn_readfirstlane(tab[64 + rt]), j = rt - __builtin_amdgcn_readfirstlane(tab[e]);
        u.a0 = A; u.a1 = A; u.rows = elist + (size_t)e * T + j * BM; u.b0 = W + ((size_t)e * 2048 + pn * 128) * D; u.b1 = u.b0 + (size_t)1024 * D; u.row0 = rt * BM; u.col0 = pn * 128; u.e = e;
        return true;
    }
};
struct SchedDown {
    const char* A; const char* W; LAS const int* tab; int G, c;
    __device__ __forceinline__ bool next(int i, Unit& u) const {
        const int L = i * G + c, rt = L >> 2, pn = L & 3; if (rt >= __builtin_amdgcn_readfirstlane(tab[32])) return false;
        const int e = __builtin_amdgcn_readfirstlane(tab[64 + rt]);
        u.a0 = A + (size_t)rt * BM * D; u.a1 = u.a0 + (size_t)HALF * D; u.rows = nullptr; u.b0 = W + ((size_t)e * 1024 + pn * BM) * D; u.b1 = u.b0 + (size_t)HALF * D; u.row0 = rt * BM; u.col0 = pn * BM; u.e = e;
        return true;
    }
};

struct EpiF32 {
    static constexpr bool PERM = false, STAGED = false;
    float* C; int ldc; const float* bias; int bias_es;
    __device__ __forceinline__ void operator()(const f32x4 (&acc)[2][2][4][2], const Unit& u, int wr, int wc, int fr, int fq) const {
        const int row0 = u.row0 + wr * 64 + fr, col0 = u.col0 + wc * 32 + 4 * fq;
        f32x4 bv[2][2];
#pragma unroll
        for (int bj = 0; bj < 2; ++bj)
#pragma unroll
            for (int n = 0; n < 2; ++n) bv[bj][n] = bias ? *(const f32x4*)(bias + (size_t)u.e * bias_es + col0 + bj * HALF + n * 16) : (f32x4){0.f, 0.f, 0.f, 0.f};
#pragma unroll
        for (int ai = 0; ai < 2; ++ai)
#pragma unroll
            for (int m = 0; m < 4; ++m) { float* rowp = C + (size_t)(row0 + ai * HALF + m * 16) * ldc + col0;
#pragma unroll
                for (int bj = 0; bj < 2; ++bj)
#pragma unroll
                    for (int n = 0; n < 2; ++n) *(f32x4*)(rowp + bj * HALF + n * 16) = acc[ai][bj][m][n] + bv[bj][n]; }
    }
};
struct EpiBf16 {
    static constexpr bool PERM = true, STAGED = true;
    bf16_t* O; int ldc; const float* bias; int bias_es; float scale;
    __device__ __forceinline__ void staged(const f32x4 (&acc)[2][2][4][2], const Unit& u, int wr, int wc, int fr, int fq, LAS unsigned char* lds, int tid) const {
        const int col0 = u.col0 + wc * 32 + 8 * fq;
        f32x4 bv[2][2];
#pragma unroll
        for (int bj = 0; bj < 2; ++bj)
#pragma unroll
            for (int n = 0; n < 2; ++n) bv[bj][n] = bias ? *(const f32x4*)(bias + (size_t)u.e * bias_es + col0 + bj * HALF + 4 * n) : (f32x4){0.f, 0.f, 0.f, 0.f};
        LAS unsigned char* slab = lds + (wr ? (TAB_OFF + 2048) : 3 * HTB);
        const int j = tid & 255, rrow = j >> 5, rc = j & 31;
#pragma unroll
        for (int ai = 0; ai < 2; ++ai)
#pragma unroll
            for (int mp = 0; mp < 2; ++mp) {
#pragma unroll
                for (int mm = 0; mm < 2; ++mm)
#pragma unroll
                    for (int bj = 0; bj < 2; ++bj) {
                        const int m = 2 * mp + mm, row = 16 * mm + fr, chunk = 16 * bj + 4 * wc + fq;
                        const f32x4 v0 = acc[ai][bj][m][0] * scale + bv[bj][0], v1 = acc[ai][bj][m][1] * scale + bv[bj][1];
                        u32x4 w; w.x = cvt_pk_bf16(v0[0], v0[1]); w.y = cvt_pk_bf16(v0[2], v0[3]); w.z = cvt_pk_bf16(v1[0], v1[1]); w.w = cvt_pk_bf16(v1[2], v1[3]);
                        *(LAS u32x4*)(slab + row * 512 + ((chunk ^ (row & 15)) * 16)) = w;
                    }
                asm volatile("s_waitcnt lgkmcnt(0)" ::: "memory"); __builtin_amdgcn_s_barrier(); asm volatile("" ::: "memory");
#pragma unroll
                for (int i = 0; i < 4; ++i) {
                    const int row = rrow + 8 * i;
                    const u32x4 w = *(const LAS u32x4*)(slab + row * 512 + ((rc ^ (row & 15)) * 16));
                    *(u32x4*)(O + (size_t)(u.row0 + 128 * ai + 64 * wr + 32 * mp + row) * ldc + u.col0 + rc * 8) = w;
                }
                asm volatile("s_waitcnt lgkmcnt(0)" ::: "memory"); __builtin_amdgcn_s_barrier(); asm volatile("" ::: "memory");
            }
    }
};
struct EpiSwiglu {
    static constexpr bool PERM = true, STAGED = false;
    unsigned char* O; const float* bias; float scale;
    __device__ __forceinline__ void operator()(const f32x4 (&acc)[2][2][4][2], const Unit& u, int wr, int wc, int fr, int fq) const {
        const int row0 = u.row0 + wr * 64 + fr, hc = u.col0 + wc * 32 + 8 * fq;
        const float* bp = bias + (size_t)u.e * 2048 + hc;
        const f32x4 bg0 = *(const f32x4*)(bp), bg1 = *(const f32x4*)(bp + 4), bu0 = *(const f32x4*)(bp + 1024), bu1 = *(const f32x4*)(bp + 1028);
#pragma unroll
        for (int ai = 0; ai < 2; ++ai)
#pragma unroll
            for (int m = 0; m < 4; ++m) {
                const f32x4 g0 = acc[ai][0][m][0] * scale + bg0, g1 = acc[ai][0][m][1] * scale + bg1, u0 = acc[ai][1][m][0] * scale + bu0, u1 = acc[ai][1][m][1] * scale + bu1;
                const f32x2 h0 = swiglu2((f32x2){g0[0], g0[1]}, (f32x2){u0[0], u0[1]}), h1 = swiglu2((f32x2){g0[2], g0[3]}, (f32x2){u0[2], u0[3]});
                const f32x2 h2 = swiglu2((f32x2){g1[0], g1[1]}, (f32x2){u1[0], u1[1]}), h3 = swiglu2((f32x2){g1[2], g1[3]}, (f32x2){u1[2], u1[3]});
                u32x2 w; w.x = pk_fp8x4(h0.x, h0.y, h1.x, h1.y); w.y = pk_fp8x4(h2.x, h2.y, h3.x, h3.y);
                *(u32x2*)(O + (size_t)(row0 + ai * HALF + m * 16) * D + hc) = w;
            }
    }
};

typedef int i32x8 __attribute__((ext_vector_type(8)));
typedef int i32x4 __attribute__((ext_vector_type(4)));
template <class Epi, class Sched, bool GATHER, int ESZ = 2>
__device__ __forceinline__ void gemm_phase(LAS unsigned char* lds, const int K, const Sched& S, const Epi& E) {
    const int tid = tid_(), wid = __builtin_amdgcn_readfirstlane(tid >> 6), lane = tid & 63, wr = wid >> 2, wc = wid & 3, fr = lane & 15, fq = lane >> 4;
    const int nt = K * ESZ / 128, KP = K * ESZ;
    int sR[2], sC[2];
    unsigned voffB[2];
#pragma unroll
    for (int i = 0; i < 2; ++i) { stage_rc(tid * 16 + i * 8192, sR[i], sC[i]); const int Rb = Epi::PERM ? ((sR[i] & ~31) + perm32(sR[i] & 31)) : sR[i]; voffB[i] = (unsigned)(Rb * KP + sC[i] * 2); }
    unsigned cvA0[2], cvA1[2], nvA0[2], nvA1[2];
#define G8_VOFF(u, v0, v1) do { _Pragma("unroll") for (int _i = 0; _i < 2; ++_i) { \
        if (GATHER) { unsigned t0_ = (unsigned)(u).rows[sR[_i]], t1_ = (unsigned)(u).rows[HALF + sR[_i]]; t0_ = t0_ < (unsigned)T ? t0_ : 0u; t1_ = t1_ < (unsigned)T ? t1_ : 0u;     \
            v0[_i] = t0_ * (unsigned)KP + (unsigned)(sC[_i] * 2); v1[_i] = t1_ * (unsigned)KP + (unsigned)(sC[_i] * 2); } \
        else { v0[_i] = (unsigned)(sR[_i] * KP + sC[_i] * 2); v1[_i] = v0[_i]; } } } while (0)
    const size_t kstep = (size_t)(BK * 2);
    const unsigned ldsw = (unsigned)wid * 1024u;
    const int aoff = lds_byte(wr * 64 + fr, fq * 8), boff = lds_byte(wc * 32 + fr, fq * 8);
#define PG8_SA(b, h) (((b) * 2 + (h)) * HTB)
#define PG8_SB(b, h) ((4 + (b) * 2 + (h)) * HTB)
#define PG8_STAGE(bufoff, gbase, voff) do { _Pragma("unroll") for (int _i = 0; _i < 2; ++_i) \
        __builtin_amdgcn_global_load_lds((const unsigned*)((const char*)(gbase) + (voff)[_i]), (LAS unsigned*)(lds + (bufoff) + ldsw + _i * 8192), 16, 0, 0); } while (0)
#define PG8_LDA(dst, b, h) do { _Pragma("unroll") for (int m = 0; m < 4; ++m) { dst[m].lo = *(const LAS i32x4*)(lds + PG8_SA(b, h) + aoff + m * 2048); dst[m].hi = *(const LAS i32x4*)(lds + PG8_SA(b, h) + aoff + m * 2048 + 1024); } } while (0)
#define PG8_LDB(dst, b, h) do { _Pragma("unroll") for (int n = 0; n < 2; ++n) { dst[n].lo = *(const LAS i32x4*)(lds + PG8_SB(b, h) + boff + n * 2048); dst[n].hi = *(const LAS i32x4*)(lds + PG8_SB(b, h) + boff + n * 2048 + 1024); } } while (0)
#define PG8_MMA(ai, bj, At, Bt) do { __builtin_amdgcn_s_setprio(1); _Pragma("unroll") for (int m = 0; m < 4; ++m) _Pragma("unroll") for (int n = 0; n < 2; ++n) { \
        if (ESZ == 2) { acc[ai][bj][m][n] = __builtin_amdgcn_mfma_f32_16x16x32_bf16(__builtin_bit_cast(bf16x8, (i32x4)__builtin_shufflevector(Bt[n], Bt[n], 0, 1, 2, 3)), __builtin_bit_cast(bf16x8, (i32x4)__builtin_shufflevector(At[m], At[m], 0, 1, 2, 3)), acc[ai][bj][m][n], 0, 0, 0); \
                        acc[ai][bj][m][n] = __builtin_amdgcn_mfma_f32_16x16x32_bf16(__builtin_bit_cast(bf16x8, (i32x4)__builtin_shufflevector(Bt[n], Bt[n], 4, 5, 6, 7)), __builtin_bit_cast(bf16x8, (i32x4)__builtin_shufflevector(At[m], At[m], 4, 5, 6, 7)), acc[ai][bj][m][n], 0, 0, 0); } \
        else asm volatile("v_mfma_f32_16x16x128_f8f6f4 %0, %1, %2, %0" : "+v"(acc[ai][bj][m][n]) : "v"(Bt[n]), "v"(At[m])); } __builtin_amdgcn_s_setprio(0); } while (0)
#define PG8_WAIT_V(n) asm volatile("s_waitcnt vmcnt(" #n ")" ::: "memory")
#define PG8_WAIT_L(n) asm volatile("s_waitcnt lgkmcnt(" #n ")" ::: "memory")
#define PG8_BAR __builtin_amdgcn_s_barrier()
#define PG8_SCHED __builtin_amdgcn_sched_barrier(0)
    Unit cur, nxt; int ui = 0;
    if (!S.next(0, cur)) return;
    f32x4 acc[2][2][4][2];
#pragma unroll
    for (int a = 0; a < 2; ++a)
#pragma unroll
        for (int b = 0; b < 2; ++b)
#pragma unroll
            for (int m = 0; m < 4; ++m)
#pragma unroll
                for (int n = 0; n < 2; ++n) acc[a][b][m][n] = (f32x4){0.f, 0.f, 0.f, 0.f};
    i32x8 At[4], B0[2], B1[2];
    const char* cA0 = cur.a0; const char* cA1 = cur.a1; const char* cB0 = cur.b0; const char* cB1 = cur.b1;
    G8_VOFF(cur, cvA0, cvA1);
    PG8_STAGE(PG8_SB(0, 0), cB0, voffB); PG8_STAGE(PG8_SB(0, 1), cB1, voffB); PG8_STAGE(PG8_SA(0, 0), cA0, cvA0); PG8_STAGE(PG8_SA(0, 1), cA1, cvA1);
    if (wr == 1) PG8_BAR;
    PG8_WAIT_V(2); PG8_BAR;
    PG8_STAGE(PG8_SB(1, 0), cB0 + kstep, voffB); PG8_STAGE(PG8_SA(1, 0), cA0 + kstep, cvA0); PG8_STAGE(PG8_SB(1, 1), cB1 + kstep, voffB);
    PG8_WAIT_V(6); PG8_BAR;
    for (;;) {
        const bool has_next = S.next(ui + 1, nxt);
        const char* nA0 = has_next ? nxt.a0 : cA0; const char* nA1 = has_next ? nxt.a1 : cA1; const char* nB0 = has_next ? nxt.b0 : cB0; const char* nB1 = has_next ? nxt.b1 : cB1;
        if (GATHER) { if (has_next) { G8_VOFF(nxt, nvA0, nvA1); } else { nvA0[0] = cvA0[0]; nvA0[1] = cvA0[1]; nvA1[0] = cvA1[0]; nvA1[1] = cvA1[1]; } }
#pragma unroll 1
        for (int t = 0; t < nt; t += 2) {
            const bool last = (t == nt - 2);
            const char* a1_1 = cA1 + (size_t)(t + 1) * kstep;
            const char* a2_0 = last ? nA0 : cA0 + (size_t)(t + 2) * kstep; const char* a2_1 = last ? nA1 : cA1 + (size_t)(t + 2) * kstep;
            const char* b2_0 = last ? nB0 : cB0 + (size_t)(t + 2) * kstep; const char* b2_1 = last ? nB1 : cB1 + (size_t)(t + 2) * kstep;
            const char* a3_0 = a2_0 + kstep; const char* b3_0 = b2_0 + kstep; const char* b3_1 = b2_1 + kstep;
            unsigned vA0[2], vA1[2];
            if (GATHER) { vA0[0] = last ? nvA0[0] : cvA0[0]; vA0[1] = last ? nvA0[1] : cvA0[1]; vA1[0] = last ? nvA1[0] : cvA1[0]; vA1[1] = last ? nvA1[1] : cvA1[1]; }
            else { vA0[0] = cvA0[0]; vA0[1] = cvA0[1]; vA1[0] = cvA0[0]; vA1[1] = cvA0[1]; }
            PG8_LDB(B0, 0, 0); PG8_LDB(B1, 0, 1); PG8_SCHED; PG8_LDA(At, 0, 0); PG8_STAGE(PG8_SA(1, 1), a1_1, cvA1);
            PG8_WAIT_V(8); PG8_WAIT_L(0); PG8_BAR; PG8_MMA(0, 0, At, B0); PG8_MMA(0, 1, At, B1); PG8_BAR; PG8_SCHED;
            PG8_LDA(At, 0, 1); PG8_STAGE(PG8_SB(0, 0), b2_0, voffB); PG8_STAGE(PG8_SB(0, 1), b2_1, voffB); PG8_STAGE(PG8_SA(0, 0), a2_0, vA0);
            PG8_WAIT_V(8); PG8_WAIT_L(0); PG8_BAR; PG8_MMA(1, 0, At, B0); PG8_MMA(1, 1, At, B1); PG8_BAR; PG8_SCHED;
            PG8_LDB(B0, 1, 0); PG8_LDB(B1, 1, 1); PG8_SCHED; PG8_LDA(At, 1, 0); PG8_STAGE(PG8_SA(0, 1), a2_1, vA1);
            PG8_WAIT_V(8); PG8_WAIT_L(0); PG8_BAR; PG8_MMA(0, 0, At, B0); PG8_MMA(0, 1, At, B1); PG8_BAR; PG8_SCHED;
            PG8_LDA(At, 1, 1); PG8_STAGE(PG8_SB(1, 0), b3_0, voffB); PG8_STAGE(PG8_SB(1, 1), b3_1, voffB); PG8_STAGE(PG8_SA(1, 0), a3_0, vA0);
            PG8_WAIT_V(8); PG8_WAIT_L(0); PG8_BAR; PG8_MMA(1, 0, At, B0); PG8_MMA(1, 1, At, B1); PG8_BAR; PG8_SCHED;
        }
        if (wr == 0) PG8_BAR;
        if (ESZ == 1) asm volatile("s_nop 15\n\ts_nop 15" ::: "memory");
        if constexpr (Epi::STAGED) E.staged(acc, cur, wr, wc, fr, fq, lds, tid); else E(acc, cur, wr, wc, fr, fq);
        if (!has_next) break;
#pragma unroll
        for (int a = 0; a < 2; ++a)
#pragma unroll
            for (int b = 0; b < 2; ++b)
#pragma unroll
                for (int m = 0; m < 4; ++m)
#pragma unroll
                    for (int n = 0; n < 2; ++n) acc[a][b][m][n] = (f32x4){0.f, 0.f, 0.f, 0.f};
        cur = nxt; cA0 = nA0; cA1 = nA1; cB0 = nB0; cB1 = nB1; ++ui;
        if (GATHER) { cvA0[0] = nvA0[0]; cvA0[1] = nvA0[1]; cvA1[0] = nvA1[0]; cvA1[1] = nvA1[1]; }
        if (wr == 1) PG8_BAR;
    }
    PG8_WAIT_V(0);
    PG8_BAR;
#undef G8_VOFF
#undef PG8_SA
#undef PG8_SB
#undef PG8_STAGE
#undef PG8_LDA
#undef PG8_LDB
#undef PG8_MMA
#undef PG8_WAIT_V
#undef PG8_WAIT_L
#undef PG8_BAR
#undef PG8_SCHED
}
}


template <bool F8>
__device__ __forceinline__ void convert_big(LAS unsigned char* lds, const float* src, void* dstv, int K, int N, int batch, float scale) {
    const int tid = tid_(), lane = tid & 63, wid = tid >> 6;
    const int nbn = N / 256, per = (K / 128) * nbn, total = per * batch, G = (int)gridDim.x;
    constexpr int ESZ = F8 ? 1 : 2, ROWB = 128 * ESZ, TILEB = 256 * ROWB;
    f32x4 ra[16], rb[16];
#define CV_LOAD(uu, reg) do { const int bidx = (uu) / per, r_ = (uu) % per, kb = r_ / nbn, nb = r_ % nbn; \
        const float* sp = src + (size_t)bidx * K * N + (size_t)(kb * 128 + 16 * wid) * N + nb * 256 + 4 * lane; \
        _Pragma("unroll") for (int i = 0; i < 16; ++i) reg[i] = *(const f32x4*)(sp + (size_t)i * N); } while (0)
#define CV_PACK(reg, tl) do { _Pragma("unroll") for (int j = 0; j < 4; ++j) { \
        if (F8) { u32x4 w0; w0.x = pk_fp8x4(reg[0][j] * scale, reg[1][j] * scale, reg[2][j] * scale, reg[3][j] * scale); w0.y = pk_fp8x4(reg[4][j] * scale, reg[5][j] * scale, reg[6][j] * scale, reg[7][j] * scale); \
            w0.z = pk_fp8x4(reg[8][j] * scale, reg[9][j] * scale, reg[10][j] * scale, reg[11][j] * scale); w0.w = pk_fp8x4(reg[12][j] * scale, reg[13][j] * scale, reg[14][j] * scale, reg[15][j] * scale); \
            *(LAS u32x4*)((tl) + (4 * lane + j) * ROWB + ((wid ^ (lane & 7)) * 16)) = w0; } \
        else { u32x4 w0, w1; \
            w0.x = g8::cvt_pk_bf16(reg[0][j], reg[1][j]); w0.y = g8::cvt_pk_bf16(reg[2][j], reg[3][j]); w0.z = g8::cvt_pk_bf16(reg[4][j], reg[5][j]); w0.w = g8::cvt_pk_bf16(reg[6][j], reg[7][j]); \
            w1.x = g8::cvt_pk_bf16(reg[8][j], reg[9][j]); w1.y = g8::cvt_pk_bf16(reg[10][j], reg[11][j]); w1.z = g8::cvt_pk_bf16(reg[12][j], reg[13][j]); w1.w = g8::cvt_pk_bf16(reg[14][j], reg[15][j]); \
            *(LAS u32x4*)((tl) + (4 * lane + j) * ROWB + (((2 * wid) ^ (lane & 15)) * 16)) = w0; *(LAS u32x4*)((tl) + (4 * lane + j) * ROWB + (((2 * wid + 1) ^ (lane & 15)) * 16)) = w1; } } } while (0)
#define CV_STORE(uu, tl) do { const int bidx = (uu) / per, r_ = (uu) % per, kb = r_ / nbn, nb = r_ % nbn; \
        unsigned char* dp = (unsigned char*)dstv + ((size_t)bidx * N * K + (size_t)(nb * 256) * K + kb * 128) * ESZ; \
        _Pragma("unroll") for (int i = 0; i < 4 * ESZ; ++i) { const int pc = tid + NTHREADS * i, n = pc / (8 * ESZ), c = pc % (8 * ESZ); \
            *(u32x4*)(dp + (size_t)n * K * ESZ + c * 16) = *(const LAS u32x4*)((tl) + n * ROWB + ((c ^ ((n >> 2) & (8 * ESZ - 1))) * 16)); } } while (0)
    const int u0 = blockIdx.x;
    if (u0 < total) CV_LOAD(u0, ra);
    if (u0 + G < total) CV_LOAD(u0 + G, rb);
    for (int u = u0; u < total; u += 2 * G) {
        CV_PACK(ra, lds);
        if (u + 2 * G < total) CV_LOAD(u + 2 * G, ra);
        __syncthreads();
        CV_STORE(u, lds);
        const bool has_b = (u + G < total);
        if (has_b) { CV_PACK(rb, lds + TILEB); if (u + 3 * G < total) CV_LOAD(u + 3 * G, rb); }
        __syncthreads();
        if (has_b) CV_STORE(u + G, lds + TILEB);
    }
    __syncthreads();
#undef CV_LOAD
#undef CV_PACK
#undef CV_STORE
}

__device__ __forceinline__ float gelu_fast(float x) { const float u2 = 1.5957691216057308f * (x + 0.044715f * x * x * x); return x * __builtin_amdgcn_rcpf(1.0f + __builtin_amdgcn_exp2f(-1.4426950408889634f * u2)); }
__device__ __forceinline__ void lru_gates_phase(LAS unsigned char* lds, const Params& p, int idx) {
    const int tid = tid_(), lane = tid & 63, wid = tid >> 6, fr = lane & 15, fq = lane >> 4;
    LAS bf16_t* xcb = (LAS bf16_t*)lds;
    LAS float* xcf = (LAS float*)(lds + 17408);
    LAS float* sa = (LAS float*)(lds + 17408 + 33792);
    LAS float* sb = sa + 64 * 132;
    LAS float* comb = sb + 64 * 132;
    const bf16_t* u = (const bf16_t*)(p.ws + WS_U);
    bf16_t* Carr = (bf16_t*)(p.ws + WS_SCR); bf16_t* Barr = Carr + (size_t)T * D;
    float* SP = (float*)(p.ws + WS_LSUM); float* SH = SP + NBATCH * 32 * D;
    const int hd = blockIdx.x & 7, slot = blockIdx.x >> 3, nslots = gridDim.x >> 3;
    const float* conv_w = p.a_conv_w + (size_t)idx * 4 * D; const float* conv_b = p.a_conv_b + (size_t)idx * D;
    const bf16_t* wrt = (const bf16_t*)(p.ws + WS_AGT) + ((size_t)(idx * 2 + 0) * 8 + hd) * 128 * 128;
    const bf16_t* wit = (const bf16_t*)(p.ws + WS_AGT) + ((size_t)(idx * 2 + 1) * 8 + hd) * 128 * 128;
    bf16x8 Br[4], Bi[4];
#pragma unroll
    for (int ks = 0; ks < 4; ++ks) { Br[ks] = *(const bf16x8*)(wrt + (size_t)(16 * wid + fr) * 128 + 32 * ks + 8 * fq); Bi[ks] = *(const bf16x8*)(wit + (size_t)(16 * wid + fr) * 128 + 32 * ks + 8 * fq); }
    const int cg = hd * 128 + 16 * wid + 4 * fq;
    const f32x4 brv = *(const f32x4*)(p.a_b_rgate + (size_t)idx * D + cg), biv = *(const f32x4*)(p.a_b_igate + (size_t)idx * D + cg), lmv = *(const f32x4*)(p.a_lambda + (size_t)idx * D + cg);
    f32x4 spv;
#pragma unroll
    for (int r = 0; r < 4; ++r) spv[r] = (lmv[r] > 15.f) ? __expf(-lmv[r]) : log1pf(__expf(-lmv[r]));
    const int cc = (tid & 31) * 4, cch = hd * 128 + cc;
    f32x4 cw[4];
#pragma unroll
    for (int j = 0; j < 4; ++j) cw[j] = *(const f32x4*)(conv_w + j * D + cch);
    const f32x4 cb = *(const f32x4*)(conv_b + cch);
    for (int tile = slot; tile < T / 64; tile += nslots) {
        const int t0 = tile * 64;
#pragma unroll
        for (int k = 0; k < 4; ++k) {
            const int tl = (tid >> 5) + 16 * k, t = t0 + tl, s_ = t & (SEQ - 1);
            f32x4 acc = cb;
#pragma unroll
            for (int j = 0; j < 4; ++j) {
                if (s_ - 3 + j >= 0) {
                    const u32x2 rv = *(const u32x2*)(u + (size_t)(t - 3 + j) * 2048 + 1024 + cch);
                    acc[0] += cw[j][0] * __uint_as_float(rv.x << 16); acc[1] += cw[j][1] * __uint_as_float(rv.x & 0xffff0000u);
                    acc[2] += cw[j][2] * __uint_as_float(rv.y << 16); acc[3] += cw[j][3] * __uint_as_float(rv.y & 0xffff0000u);
                }
            }
            *(LAS f32x4*)(xcf + tl * 132 + cc) = acc;
            u32x2 w; w.x = pack2(acc[0], acc[1]); w.y = pack2(acc[2], acc[3]);
            *(LAS u32x2*)(xcb + tl * 136 + cc) = w;
        }
        __syncthreads();
        f32x4 ar[4], ai[4];
#pragma unroll
        for (int mt = 0; mt < 4; ++mt) { ar[mt] = (f32x4){0.f, 0.f, 0.f, 0.f}; ai[mt] = (f32x4){0.f, 0.f, 0.f, 0.f}; }
#pragma unroll
        for (int ks = 0; ks < 4; ++ks)
#pragma unroll
            for (int mt = 0; mt < 4; ++mt) {
                const bf16x8 af = *(const LAS bf16x8*)(xcb + (mt * 16 + fr) * 136 + 32 * ks + 8 * fq);
                ar[mt] = __builtin_amdgcn_mfma_f32_16x16x32_bf16(Br[ks], af, ar[mt], 0, 0, 0);
                ai[mt] = __builtin_amdgcn_mfma_f32_16x16x32_bf16(Bi[ks], af, ai[mt], 0, 0, 0);
            }
#pragma unroll
        for (int mt = 0; mt < 4; ++mt) {
            const int tl = mt * 16 + fr, cl = 16 * wid + 4 * fq;
            const f32x4 rec = *(const LAS f32x4*)(xcf + tl * 132 + cl);
            f32x4 av, bv, cv;
#pragma unroll
            for (int r = 0; r < 4; ++r) {
                const float rg = sigmoidf_(ar[mt][r] + brv[r]), ig = sigmoidf_(ai[mt][r] + biv[r]);
                const float xl = -8.0f * rg * spv[r];
                const float cex = -xl * (1.0f + xl * (0.5f + xl * (0.16666667f + xl * (0.041666668f + xl * 0.0083333338f))));
                const float cc_ = bf2f(f2bf(cex));
                av[r] = 1.0f - cc_; cv[r] = cc_;
                bv[r] = bf2f(f2bf(__builtin_amdgcn_sqrtf(fmaxf(cex * (2.0f - cex), 0.f)) * ig * rec[r]));
            }
            { u32x2 wc_, wb_; wc_.x = pack2(cv[0], cv[1]); wc_.y = pack2(cv[2], cv[3]); wb_.x = pack2(bv[0], bv[1]); wb_.y = pack2(bv[2], bv[3]);
              *(u32x2*)(Carr + (size_t)(t0 + tl) * D + cg) = wc_; *(u32x2*)(Barr + (size_t)(t0 + tl) * D + cg) = wb_; }
            *(LAS f32x4*)(sa + tl * 132 + cl) = av; *(LAS f32x4*)(sb + tl * 132 + cl) = bv;
        }
        __syncthreads();
        {
            const int j = tid & 127, q = tid >> 7;
            float P = 1.f, H = 0.f;
#pragma unroll
            for (int s_ = 0; s_ < 16; ++s_) { const float a = sa[(q * 16 + s_) * 132 + j], bb = sb[(q * 16 + s_) * 132 + j]; H = a * H + bb; P *= a; }
            comb[(q * 128 + j) * 2 + 0] = P; comb[(q * 128 + j) * 2 + 1] = H;
        }
        __syncthreads();
        if (tid < 128) {
            float P = comb[tid * 2], H = comb[tid * 2 + 1];
#pragma unroll
            for (int q = 1; q < 4; ++q) { const float Pq = comb[(q * 128 + tid) * 2], Hq = comb[(q * 128 + tid) * 2 + 1]; H = Pq * H + Hq; P *= Pq; }
            SP[(size_t)tile * D + hd * 128 + tid] = P; SH[(size_t)tile * D + hd * 128 + tid] = H;
        }
    }
}
__device__ __forceinline__ void lru_scan_phase(const Params& p) {
    const int tid = tid_();
    const bf16_t* u = (const bf16_t*)(p.ws + WS_U);
    const bf16_t* Carr = (const bf16_t*)(p.ws + WS_SCR); const bf16_t* Barr = Carr + (size_t)T * D;
    const float* SP = (const float*)(p.ws + WS_LSUM); const float* SH = SP + NBATCH * 32 * D;
    bf16_t* yin = (bf16_t*)(p.ws + WS_YIN);
    typedef float f32x2 __attribute__((ext_vector_type(2)));
    for (int tile = blockIdx.x; tile < NBATCH * 32; tile += gridDim.x) {
        const int c = 2 * tid, b = tile >> 5, chunk = tile & 31;
        f32x2 sp[31], sh[31];
#pragma unroll
        for (int k = 0; k < 31; ++k) { const bool on = k < chunk; const size_t o = (size_t)(b * 32 + (on ? k : 0)) * D + c;
            sp[k] = *(const f32x2*)(SP + o); sh[k] = *(const f32x2*)(SH + o); if (!on) { sp[k] = (f32x2){1.f, 1.f}; sh[k] = (f32x2){0.f, 0.f}; } }
        float h0 = 0.f, h1 = 0.f;
#pragma unroll
        for (int k = 0; k < 31; ++k) { h0 = sp[k][0] * h0 + sh[k][0]; h1 = sp[k][1] * h1 + sh[k][1]; }
        const size_t tb = (size_t)tile * 64;
#pragma unroll 16
        for (int s_ = 0; s_ < 64; ++s_) {
            const size_t t = tb + s_;
            const unsigned cw = *(const unsigned*)(Carr + t * D + c), bw = *(const unsigned*)(Barr + t * D + c), gw = *(const unsigned*)(u + t * 2048 + c);
            h0 = (1.0f - __uint_as_float(cw << 16)) * h0 + __uint_as_float(bw << 16);
            h1 = (1.0f - __uint_as_float(cw & 0xffff0000u)) * h1 + __uint_as_float(bw & 0xffff0000u);
            *(unsigned*)(yin + t * D + c) = pack2(gelu_fast(__uint_as_float(gw << 16)) * h0, gelu_fast(__uint_as_float(gw & 0xffff0000u)) * h1);
        }
    }
}

typedef short s16x4 __attribute__((ext_vector_type(4)));
__device__ __forceinline__ s16x4 tr4(LAS const unsigned char* base, int row0, int col0, int stride, int lane) {
    const int q = (lane & 15) >> 2, pp = lane & 3;
    return __builtin_amdgcn_ds_read_tr16_b64_v4i16((LAS s16x4*)(base + (row0 + q) * stride + (col0 + 4 * pp) * 2));
}
__device__ __forceinline__ bf16x8 cat8(s16x4 a, s16x4 b) { return (bf16x8){a[0], a[1], a[2], a[3], b[0], b[1], b[2], b[3]}; }
__device__ __forceinline__ void ret_core_phase(LAS unsigned char* lds, const Params& p) {
    const int tid0_ = tid_(); const int tid = tid0_, lane = tid & 63, wid = tid >> 6, fr = lane & 15, fq = lane >> 4;
    constexpr int KS = 528, VS = 160, SS = 528;
    LAS unsigned char* Kl = lds;
    LAS unsigned char* Vl = lds + 128 * KS;
    LAS unsigned char* Sl = Vl + 128 * VS;
    const bf16_t* ul_ = (const bf16_t*)(p.ws + WS_U);
    bf16_t* RO = (bf16_t*)(p.ws + WS_SCR);
    for (int un = blockIdx.x; un < NBATCH * 4 * 8; un += gridDim.x) {
        const int b = un >> 5, h = (un >> 3) & 3, vs = un & 7;
        const float lg2 = log2f(1.0f - exp2f(-5.0f - (float)h));
        f32x4 Sacc[2][4];
#pragma unroll
        for (int dt = 0; dt < 2; ++dt)
#pragma unroll
            for (int vt = 0; vt < 4; ++vt) Sacc[dt][vt] = (f32x4){0.f, 0.f, 0.f, 0.f};
        for (int i = tid; i < 64 * SS / 16; i += NTHREADS) ((LAS u32x4*)Sl)[i] = (u32x4){0u, 0u, 0u, 0u};
        u32x4 kraw[8], vraw[2]; bf16x8 Qf[8];
#define RET_LOAD(ch_) do { const size_t tl_ = (size_t)b * SEQ + (ch_) * 128; const bf16_t* u = ul_; int tid = tid0_; asm volatile("" : "+s"(u), "+v"(tid));     \
            _Pragma("unroll") for (int i = 0; i < 8; ++i) { const int piece = tid + NTHREADS * i, m = piece >> 5, ch = piece & 31; kraw[i] = *(const u32x4*)(u + (tl_ + m) * 6144 + 1024 + h * 256 + ch * 8); } \
            _Pragma("unroll") for (int i = 0; i < 2; ++i) { const int piece = tid + NTHREADS * i, m = piece >> 3, ch = piece & 7; vraw[i] = *(const u32x4*)(u + (tl_ + m) * 6144 + 2048 + h * 512 + vs * 64 + ch * 8); } } while (0)
#define RET_LOADQ(ch_) do { const size_t tl_ = (size_t)b * SEQ + (ch_) * 128; const bf16_t* u = ul_; int tid = tid0_; asm volatile("" : "+s"(u), "+v"(tid)); const int wid = tid >> 6, fr = tid & 15, fq = (tid & 63) >> 4; \
            _Pragma("unroll") for (int ks = 0; ks < 8; ++ks) Qf[ks] = *(const bf16x8*)(u + (tl_ + 16 * wid + fr) * 6144 + h * 256 + 32 * ks + 8 * fq); } while (0)
        RET_LOAD(0); RET_LOADQ(0);
        for (int chunk = 0; chunk < 16; ++chunk) {
            const size_t t0 = (size_t)b * SEQ + chunk * 128;
            int tst = tid0_; asm volatile("" : "+v"(tst));
#pragma unroll
            for (int i = 0; i < 8; ++i) {
                const int piece = tst + NTHREADS * i, m = piece >> 5, ch = piece & 31;
                const u32x4 kv = kraw[i];
                const float sc = exp2f(-(float)(m + 1) * lg2) * 0.0625f;
                u32x4 w;
                w.x = pack2(__uint_as_float(kv.x << 16) * sc, __uint_as_float(kv.x & 0xffff0000u) * sc); w.y = pack2(__uint_as_float(kv.y << 16) * sc, __uint_as_float(kv.y & 0xffff0000u) * sc);
                w.z = pack2(__uint_as_float(kv.z << 16) * sc, __uint_as_float(kv.z & 0xffff0000u) * sc); w.w = pack2(__uint_as_float(kv.w << 16) * sc, __uint_as_float(kv.w & 0xffff0000u) * sc);
                *(LAS u32x4*)(Kl + m * KS + ch * 16) = w;
            }
#pragma unroll
            for (int i = 0; i < 2; ++i) {
                const int piece = tst + NTHREADS * i, m = piece >> 3, ch = piece & 7;
                *(LAS u32x4*)(Vl + m * VS + ch * 16) = vraw[i];
            }
            __syncthreads();
            if (chunk + 1 < 16) RET_LOAD(chunk + 1);
            f32x4 sc[8];
#pragma unroll
            for (int mt = 0; mt < 8; ++mt) {
                sc[mt] = (f32x4){0.f, 0.f, 0.f, 0.f};
#pragma unroll
                for (int ks = 0; ks < 8; ++ks) {
                    const bf16x8 kf = *(const LAS bf16x8*)(Kl + (16 * mt + fr) * KS + (32 * ks + 8 * fq) * 2);
                    sc[mt] = __builtin_amdgcn_mfma_f32_16x16x32_bf16(kf, Qf[ks], sc[mt], 0, 0, 0);
                }
                if (mt & 1) __builtin_amdgcn_sched_barrier(0);
            }
            bf16x8 pf[4];
            const int nloc = 16 * wid + fr;
#pragma unroll
            for (int ks2 = 0; ks2 < 4; ++ks2) {
                float v[8];
#pragma unroll
                for (int t = 0; t < 2; ++t)
#pragma unroll
                    for (int r = 0; r < 4; ++r) { const int m = 32 * ks2 + 16 * t + 4 * fq + r; v[4 * t + r] = (m <= nloc) ? sc[2 * ks2 + t][r] : 0.f; }
                u32x4 w; w.x = pack2(v[0], v[1]); w.y = pack2(v[2], v[3]); w.z = pack2(v[4], v[5]); w.w = pack2(v[6], v[7]);
                pf[ks2] = __builtin_bit_cast(bf16x8, w);
            }
            f32x4 O[4];
#pragma unroll
            for (int vt = 0; vt < 4; ++vt) {
                O[vt] = (f32x4){0.f, 0.f, 0.f, 0.f};
#pragma unroll
                for (int ks2 = 0; ks2 < 4; ++ks2) {
                    const bf16x8 vf = cat8(tr4(Vl, 32 * ks2 + 4 * fq, 16 * vt, VS, lane), tr4(Vl, 32 * ks2 + 16 + 4 * fq, 16 * vt, VS, lane));
                    O[vt] = __builtin_amdgcn_mfma_f32_16x16x32_bf16(pf[ks2], vf, O[vt], 0, 0, 0);
                }
#pragma unroll
                for (int ks = 0; ks < 8; ++ks) {
                    const bf16x8 sf = *(const LAS bf16x8*)(Sl + (16 * vt + fr) * SS + (32 * ks + 8 * fq) * 2);
                    O[vt] = __builtin_amdgcn_mfma_f32_16x16x32_bf16(Qf[ks], sf, O[vt], 0, 0, 0);
                }
                __builtin_amdgcn_sched_barrier(0);
            }
#pragma unroll
            for (int r = 0; r < 4; ++r) {
                const int n = 16 * wid + 4 * fq + r;
                const float qd = exp2f((float)(n + 1) * lg2);
                bf16_t* op = RO + (t0 + n) * 2048 + h * 512 + vs * 64 + fr;
#pragma unroll
                for (int vt = 0; vt < 4; ++vt) op[16 * vt] = f2bf(O[vt][r] * qd);
            }
            if (chunk + 1 < 16) RET_LOADQ(chunk + 1);
#pragma unroll
            for (int ks3 = 0; ks3 < 4; ++ks3) {
                bf16x8 kt[2], vf[4];
#pragma unroll
                for (int dt = 0; dt < 2; ++dt) kt[dt] = cat8(tr4(Kl, 32 * ks3 + 8 * fq, 32 * wid + 16 * dt, KS, lane), tr4(Kl, 32 * ks3 + 8 * fq + 4, 32 * wid + 16 * dt, KS, lane));
#pragma unroll
                for (int vt = 0; vt < 4; ++vt) vf[vt] = cat8(tr4(Vl, 32 * ks3 + 8 * fq, 16 * vt, VS, lane), tr4(Vl, 32 * ks3 + 8 * fq + 4, 16 * vt, VS, lane));
#pragma unroll
                for (int dt = 0; dt < 2; ++dt)
#pragma unroll
                    for (int vt = 0; vt < 4; ++vt) Sacc[dt][vt] = __builtin_amdgcn_mfma_f32_16x16x32_bf16(kt[dt], vf[vt], Sacc[dt][vt], 0, 0, 0);
                __builtin_amdgcn_sched_barrier(0);
            }
            __syncthreads();
            const float cd = exp2f(128.0f * lg2);
#pragma unroll
            for (int dt = 0; dt < 2; ++dt)
#pragma unroll
                for (int vt = 0; vt < 4; ++vt) {
                    Sacc[dt][vt] *= cd;
                    u32x2 w; w.x = pack2(Sacc[dt][vt][0], Sacc[dt][vt][1]); w.y = pack2(Sacc[dt][vt][2], Sacc[dt][vt][3]);
                    *(LAS u32x2*)(Sl + (16 * vt + fr) * SS + (32 * wid + 16 * dt + 4 * fq) * 2) = w;
                }
        }
        __syncthreads();
#undef RET_LOAD
#undef RET_LOADQ
    }
}
__device__ __forceinline__ void ret_norm_phase(LAS unsigned char* lds, const Params& p) {
    const int tid = tid_(), lane = tid & 63, wid = tid >> 6;
    const bf16_t* u = (const bf16_t*)(p.ws + WS_U);
    const bf16_t* RO = (const bf16_t*)(p.ws + WS_SCR);
    bf16_t* yin = (bf16_t*)(p.ws + WS_YIN);
    const int nwu = T * 4, stride = (int)gridDim.x * 8;
    for (int wu0 = blockIdx.x * 8 + wid; wu0 < nwu; wu0 += 2 * stride) {
        u32x4 ov[2], gv[2];
#pragma unroll
        for (int q = 0; q < 2; ++q) { const int wu = wu0 + q * stride; const size_t t = (size_t)(wu >> 2); const int h = wu & 3;
            if (wu < nwu) { ov[q] = *(const u32x4*)(RO + t * 2048 + h * 512 + lane * 8); gv[q] = *(const u32x4*)(u + t * 6144 + 4096 + h * 512 + lane * 8); } }
#pragma unroll
        for (int q = 0; q < 2; ++q) { const int wu = wu0 + q * stride; const size_t t = (size_t)(wu >> 2); const int h = wu & 3;
            if (wu < nwu) {
                float o[8], g[8];
                o[0] = __uint_as_float(ov[q].x << 16); o[1] = __uint_as_float(ov[q].x & 0xffff0000u); o[2] = __uint_as_float(ov[q].y << 16); o[3] = __uint_as_float(ov[q].y & 0xffff0000u);
                o[4] = __uint_as_float(ov[q].z << 16); o[5] = __uint_as_float(ov[q].z & 0xffff0000u); o[6] = __uint_as_float(ov[q].w << 16); o[7] = __uint_as_float(ov[q].w & 0xffff0000u);
                g[0] = __uint_as_float(gv[q].x << 16); g[1] = __uint_as_float(gv[q].x & 0xffff0000u); g[2] = __uint_as_float(gv[q].y << 16); g[3] = __uint_as_float(gv[q].y & 0xffff0000u);
                g[4] = __uint_as_float(gv[q].z << 16); g[5] = __uint_as_float(gv[q].z & 0xffff0000u); g[6] = __uint_as_float(gv[q].w << 16); g[7] = __uint_as_float(gv[q].w & 0xffff0000u);
                float ss = 0.f;
#pragma unroll
                for (int j = 0; j < 8; ++j) ss += o[j] * o[j];
                const float rstd = rsqrtf(wave_sum(ss) * (1.0f / 512.0f) + 1e-6f);
                float y[8];
#pragma unroll
                for (int j = 0; j < 8; ++j) y[j] = g[j] * sigmoidf_(g[j]) * o[j] * rstd;
                u32x4 w; w.x = pack2(y[0], y[1]); w.y = pack2(y[2], y[3]); w.z = pack2(y[4], y[5]); w.w = pack2(y[6], y[7]);
                *(u32x4*)(yin + t * 2048 + h * 512 + lane * 8) = w;
            } }
    }
}

__device__ __forceinline__ void attn_core_phase(LAS unsigned char* lds, const Params& p) {
    const int tid0_ = tid_(); const int tid = tid0_, lane = tid & 63, wid = tid >> 6, fr = lane & 15, fq = lane >> 4;
    constexpr int RS = 144, TILE = 272 * RS;
    LAS unsigned char* Kl = lds;
    LAS unsigned char* Vl = lds + TILE;
    const bf16_t* u = (const bf16_t*)(p.ws + WS_U);
    bf16_t* OP = (bf16_t*)(p.ws + WS_SCR);
    float* LSE = (float*)(p.ws + WS_SCR + 96 * MB);
    for (int i = tid; i < 16 * RS / 16; i += NTHREADS) { ((LAS u32x4*)(Kl + 256 * RS))[i] = (u32x4){0u, 0u, 0u, 0u}; ((LAS u32x4*)(Vl + 256 * RS))[i] = (u32x4){0u, 0u, 0u, 0u}; }
    u32x4 kraw[4], vraw[4]; bf16x8 Qn[2];
#define ATT_DECODE(un_) const int g = (un_) >> 11, rem = (un_) & 2047, b = rem >> 8, h = (rem >> 4) & 15, x = rem & 15; \
        const int dl = (g == 0) ? 1 : (g == 1 ? 4 : 16), r_ = x & (dl - 1), n = x / dl
#define ATT_LOAD(un_) do { ATT_DECODE(un_); int tl_ = tid0_; const bf16_t* ub = u; asm volatile("" : "+v"(tl_), "+s"(ub)); ub += (size_t)b * SEQ * 9216; \
        _Pragma("unroll") for (int i = 0; i < 4; ++i) { const int piece = tl_ + NTHREADS * i, row = piece >> 3, ch = piece & 7; const int sk = ((n - 1) * 128 + row) * dl + r_; \
            kraw[i] = (u32x4){0u, 0u, 0u, 0u}; vraw[i] = (u32x4){0u, 0u, 0u, 0u}; \
            if (sk >= 0) { const bf16_t* src = ub + (size_t)sk * 9216 + h * 64 + ch * 8; kraw[i] = *(const u32x4*)(src + (3 + g) * 1024); vraw[i] = *(const u32x4*)(src + (6 + g) * 1024); } } \
        { const int sq_ = (n * 128 + 16 * (tl_ >> 6) + (tl_ & 15)) * dl + r_; \
          _Pragma("unroll") for (int ks = 0; ks < 2; ++ks) Qn[ks] = *(const bf16x8*)(ub + (size_t)sq_ * 9216 + g * 1024 + h * 64 + 32 * ks + 8 * ((tl_ & 63) >> 4)); } } while (0)
    if ((int)blockIdx.x < 3 * 2048) ATT_LOAD((int)blockIdx.x);
    for (int un = blockIdx.x; un < 3 * 2048; un += gridDim.x) {
        ATT_DECODE(un);
        const float slope = exp2f(-0.5f * (float)(h + 1)) * (float)dl;
        { int tl_ = tid0_; asm volatile("" : "+v"(tl_));
#pragma unroll
          for (int i = 0; i < 4; ++i) {
            const int piece = tl_ + NTHREADS * i, row = piece >> 3, ch = piece & 7;
            *(LAS u32x4*)(Kl + row * RS + ch * 16) = kraw[i]; *(LAS u32x4*)(Vl + row * RS + ch * 16) = vraw[i];
          } }
        const int qi = 16 * wid + fr, sq = (n * 128 + qi) * dl + r_;
        bf16x8 Qf[2];
#pragma unroll
        for (int ks = 0; ks < 2; ++ks) Qf[ks] = Qn[ks];
        __syncthreads();
        if (un + (int)gridDim.x < 3 * 2048) ATT_LOAD(un + (int)gridDim.x);
        f32x4 sc[9];
        float mx = -INFINITY;
#pragma unroll
        for (int kt = 0; kt < 9; ++kt) {
            sc[kt] = (f32x4){0.f, 0.f, 0.f, 0.f};
#pragma unroll
            for (int ks = 0; ks < 2; ++ks) {
                const bf16x8 kf = *(const LAS bf16x8*)(Kl + (16 * (wid + kt) + fr) * RS + (32 * ks + 8 * fq) * 2);
                sc[kt] = __builtin_amdgcn_mfma_f32_16x16x32_bf16(kf, Qf[ks], sc[kt], 0, 0, 0);
            }
#pragma unroll
            for (int r = 0; r < 4; ++r) {
                const int ki = 16 * (wid + kt) + 4 * fq + r, steps = qi + 128 - ki;
                const bool ok = (steps >= 0) && (steps <= 128) && (n > 0 || ki >= 128);
                const float v = ok ? sc[kt][r] * 0.125f - slope * (float)steps : -INFINITY;
                sc[kt][r] = v; mx = fmaxf(mx, v);
            }
        }
        mx = fmaxf(mx, __shfl_xor(mx, 16)); mx = fmaxf(mx, __shfl_xor(mx, 32));
        float l = 0.f;
#pragma unroll
        for (int kt = 0; kt < 9; ++kt)
#pragma unroll
            for (int r = 0; r < 4; ++r) { const float pv = __expf(sc[kt][r] - mx); sc[kt][r] = pv; l += pv; }
        l += __shfl_xor(l, 16); l += __shfl_xor(l, 32);
        f32x4 O[4];
#pragma unroll
        for (int dt = 0; dt < 4; ++dt) O[dt] = (f32x4){0.f, 0.f, 0.f, 0.f};
#pragma unroll
        for (int ks5 = 0; ks5 < 5; ++ks5) {
            const f32x4 p0 = sc[2 * ks5], p1 = (ks5 < 4) ? sc[(ks5 < 4) ? 2 * ks5 + 1 : 0] : (f32x4){0.f, 0.f, 0.f, 0.f};
            u32x4 w; w.x = pack2(p0[0], p0[1]); w.y = pack2(p0[2], p0[3]); w.z = pack2(p1[0], p1[1]); w.w = pack2(p1[2], p1[3]);
            const bf16x8 pf = __builtin_bit_cast(bf16x8, w);
#pragma unroll
            for (int dt = 0; dt < 4; ++dt) {
                const bf16x8 vf = cat8(tr4(Vl, 16 * (wid + 2 * ks5) + 4 * fq, 16 * dt, RS, lane), tr4(Vl, 16 * (wid + 2 * ks5 + 1) + 4 * fq, 16 * dt, RS, lane));
                O[dt] = __builtin_amdgcn_mfma_f32_16x16x32_bf16(vf, pf, O[dt], 0, 0, 0);
            }
        }
        const float inv = __builtin_amdgcn_rcpf(l);
        const size_t tq = (size_t)b * SEQ + sq;
#pragma unroll
        for (int dt = 0; dt < 4; ++dt) {
            u32x2 w; w.x = pack2(O[dt][0] * inv, O[dt][1] * inv); w.y = pack2(O[dt][2] * inv, O[dt][3] * inv);
            *(u32x2*)(OP + ((size_t)g * T + tq) * D + h * 64 + 16 * dt + 4 * fq) = w;
        }
        if (fq == 0) LSE[((size_t)g * T + tq) * 16 + h] = mx + __logf(l);
        __syncthreads();
    }
#undef ATT_DECODE
#undef ATT_LOAD
}
__device__ __forceinline__ void attn_merge_phase(const Params& p) {
    const int tid = tid_();
    const bf16_t* OP = (const bf16_t*)(p.ws + WS_SCR);
    const float* LSE = (const float*)(p.ws + WS_SCR + 96 * MB);
    bf16_t* yin = (bf16_t*)(p.ws + WS_YIN);
    const size_t n = (size_t)T * D / 8, stride = (size_t)gridDim.x * NTHREADS;
    for (size_t i0 = (size_t)blockIdx.x * NTHREADS + tid; i0 < n; i0 += 2 * stride) {
        u32x4 a[2], bq[2], c[2]; float l0[2], l1[2], l2[2];
#pragma unroll
        for (int q = 0; q < 2; ++q) { const size_t i = i0 + q * stride; if (i < n) { const size_t t = i >> 7; const int c8 = (int)(i & 127), h = c8 >> 3;
            l0[q] = LSE[t * 16 + h]; l1[q] = LSE[((size_t)T + t) * 16 + h]; l2[q] = LSE[((size_t)2 * T + t) * 16 + h];
            a[q] = *(const u32x4*)(OP + t * D + c8 * 8); bq[q] = *(const u32x4*)(OP + ((size_t)T + t) * D + c8 * 8); c[q] = *(const u32x4*)(OP + ((size_t)2 * T + t) * D + c8 * 8); } }
#pragma unroll
        for (int q = 0; q < 2; ++q) { const size_t i = i0 + q * stride; if (i < n) { const size_t t = i >> 7; const int c8 = (int)(i & 127);
            const float m = fmaxf(l0[q], fmaxf(l1[q], l2[q]));
            float w0 = __expf(l0[q] - m), w1 = __expf(l1[q] - m), w2 = __expf(l2[q] - m);
            const float inv = __builtin_amdgcn_rcpf(w0 + w1 + w2); w0 *= inv; w1 *= inv; w2 *= inv;
            u32x4 o;
#define MRG(f) o.f = pack2(w0 * __uint_as_float(a[q].f << 16) + w1 * __uint_as_float(bq[q].f << 16) + w2 * __uint_as_float(c[q].f << 16), \
                           w0 * __uint_as_float(a[q].f & 0xffff0000u) + w1 * __uint_as_float(bq[q].f & 0xffff0000u) + w2 * __uint_as_float(c[q].f & 0xffff0000u))
            MRG(x); MRG(y); MRG(z); MRG(w);
#undef MRG
            *(u32x4*)(yin + t * D + c8 * 8) = o; } }
    }
}

__device__ __forceinline__ void ln1_router_phase(LAS unsigned char* lds, const Params& p, int layer) {
    const int tid = tid_(), lane = tid & 63, wid = tid >> 6, fr = lane & 15, fq = lane >> 4;
    constexpr int XS = 2064;
    LAS unsigned char* xh = lds;
    LAS unsigned char* xl = lds + 16 * XS;
    LAS float* part = (LAS float*)(lds + 32 * XS);
    LAS float* logit = part + 8 * 16 * 32;
    LAS int* tkE = (LAS int*)(logit + 16 * 32);
    LAS int* tkR = tkE + 512;
    LAS int* hist = tkR + 512;
    LAS int* hbase = hist + 32;
    float* xf = (float*)(p.ws + WS_XF);
    const float* xin = (layer == 0) ? p.x : xf;
    const bf16_t* ymix = (const bf16_t*)(p.ws + WS_YMIX);
    int* tope = (int*)(p.ws + WS_TOPE); float* gates = (float*)(p.ws + WS_GATES); int* pos = (int*)(p.ws + WS_POS);
    unsigned char* xq = p.ws + WS_XQ; int* elist = (int*)(p.ws + WS_LIST);
    unsigned* ctl = (unsigned*)(p.ws + WS_CTL);
    const float* gain = p.ln_gain + (size_t)(layer * 2) * D; const float* bias = p.ln_bias + (size_t)(layer * 2) * D;
    const float* brt = p.moe_b_router + (size_t)layer * NEXP;
    const bf16_t* rth = (const bf16_t*)(p.ws + WS_RT) + (size_t)layer * 2 * NEXP * D; const bf16_t* rtl = rth + NEXP * D;
    bf16x8 Wh[2][4], Wl[2][4];
#pragma unroll
    for (int nt = 0; nt < 2; ++nt)
#pragma unroll
        for (int ks = 0; ks < 4; ++ks) { const size_t o = (size_t)(16 * nt + fr) * D + 128 * wid + 32 * ks + 8 * fq; Wh[nt][ks] = *(const bf16x8*)(rth + o); Wl[nt][ks] = *(const bf16x8*)(rtl + o); }
    if (tid < NEXP) hist[tid] = 0;
    int it = 0;
    for (int tile = blockIdx.x; tile < T / 16; tile += gridDim.x) {
#pragma unroll
        for (int tt = 0; tt < 2; ++tt) {
            const int trow = 2 * wid + tt; const size_t t = (size_t)tile * 16 + trow;
            f32x4 z[4];
#pragma unroll
            for (int i = 0; i < 4; ++i) { const int c = 256 * i + 4 * lane; const u32x2 yv = *(const u32x2*)(ymix + t * D + c);
                z[i] = DN_ALPHA * *(const f32x4*)(xin + t * D + c) + (f32x4){__uint_as_float(yv.x << 16), __uint_as_float(yv.x & 0xffff0000u), __uint_as_float(yv.y << 16), __uint_as_float(yv.y & 0xffff0000u)}; }
            float sm = 0.f;
#pragma unroll
            for (int i = 0; i < 4; ++i) sm += (z[i][0] + z[i][1]) + (z[i][2] + z[i][3]);
            const float mean = wave_sum(sm) * (1.0f / D);
            float sq = 0.f;
#pragma unroll
            for (int i = 0; i < 4; ++i) { const f32x4 dd = z[i] - mean; sq += (dd[0] * dd[0] + dd[1] * dd[1]) + (dd[2] * dd[2] + dd[3] * dd[3]); }
            const float rstd = rsqrtf(wave_sum(sq) * (1.0f / D) + LN_EPS);
#pragma unroll
            for (int i = 0; i < 4; ++i) {
                const int c = 256 * i + 4 * lane;
                const f32x4 v = (z[i] - mean) * rstd * *(const f32x4*)(gain + c) + *(const f32x4*)(bias + c);
                *(f32x4*)(xf + t * D + c) = v;
                u32x2 wh; wh.x = pack2(v[0], v[1]); wh.y = pack2(v[2], v[3]);
                *(unsigned*)(xq + t * D + c) = pk_fp8x4(v[0], v[1], v[2], v[3]);
                const float r0 = v[0] - __uint_as_float(wh.x << 16), r1 = v[1] - __uint_as_float(wh.x & 0xffff0000u), r2 = v[2] - __uint_as_float(wh.y << 16), r3 = v[3] - __uint_as_float(wh.y & 0xffff0000u);
                u32x2 wl; wl.x = pack2(r0, r1); wl.y = pack2(r2, r3);
                *(LAS u32x2*)(xh + trow * XS + c * 2) = wh; *(LAS u32x2*)(xl + trow * XS + c * 2) = wl;
            }
        }
        __syncthreads();
        {
            f32x4 acc[2] = {(f32x4){0.f, 0.f, 0.f, 0.f}, (f32x4){0.f, 0.f, 0.f, 0.f}};
#pragma unroll
            for (int ks = 0; ks < 4; ++ks) {
                const bf16x8 ah = *(const LAS bf16x8*)(xh + fr * XS + (128 * wid + 32 * ks + 8 * fq) * 2), al = *(const LAS bf16x8*)(xl + fr * XS + (128 * wid + 32 * ks + 8 * fq) * 2);
#pragma unroll
                for (int nt = 0; nt < 2; ++nt) {
                    acc[nt] = __builtin_amdgcn_mfma_f32_16x16x32_bf16(Wh[nt][ks], ah, acc[nt], 0, 0, 0);
                    acc[nt] = __builtin_amdgcn_mfma_f32_16x16x32_bf16(Wh[nt][ks], al, acc[nt], 0, 0, 0);
                    acc[nt] = __builtin_amdgcn_mfma_f32_16x16x32_bf16(Wl[nt][ks], ah, acc[nt], 0, 0, 0);
                }
            }
#pragma unroll
            for (int nt = 0; nt < 2; ++nt) *(LAS f32x4*)(part + (wid * 16 + fr) * 32 + 16 * nt + 4 * fq) = acc[nt];
        }
        __syncthreads();
        {
            const int tk = tid >> 5, e = tid & 31;
            float sacc = brt[e];
#pragma unroll
            for (int w = 0; w < 8; ++w) sacc += part[(w * 16 + tk) * 32 + e];
            logit[tk * 32 + e] = sacc;
        }
        __syncthreads();
        if (tid < 16) {
            const size_t t = (size_t)tile * 16 + tid;
            float v0 = -INFINITY, v1 = -INFINITY, v2 = -INFINITY, v3 = -INFINITY; int i0 = 0, i1 = 0, i2 = 0, i3 = 0;
#pragma unroll
            for (int e = 0; e < NEXP; ++e) {
                const float v = logit[tid * 32 + e];
                if (v > v3) {
                    if (v > v0) { v3 = v2; i3 = i2; v2 = v1; i2 = i1; v1 = v0; i1 = i0; v0 = v; i0 = e; }
                    else if (v > v1) { v3 = v2; i3 = i2; v2 = v1; i2 = i1; v1 = v; i1 = e; }
                    else if (v > v2) { v3 = v2; i3 = i2; v2 = v; i2 = e; }
                    else { v3 = v; i3 = e; }
                }
            }
            const float e1 = __expf(v1 - v0), e2 = __expf(v2 - v0), e3 = __expf(v3 - v0), inv = 1.0f / (1.0f + e1 + e2 + e3);
            tope[t * 4 + 0] = i0; tope[t * 4 + 1] = i1; tope[t * 4 + 2] = i2; tope[t * 4 + 3] = i3;
            gates[t * 4 + 0] = inv; gates[t * 4 + 1] = e1 * inv; gates[t * 4 + 2] = e2 * inv; gates[t * 4 + 3] = e3 * inv;
            const int sl = (it & 7) * 16 + tid;
            tkE[sl * 4 + 0] = i0; tkR[sl * 4 + 0] = (int)atomicAdd((unsigned*)(hist + i0), 1u);
            tkE[sl * 4 + 1] = i1; tkR[sl * 4 + 1] = (int)atomicAdd((unsigned*)(hist + i1), 1u);
            tkE[sl * 4 + 2] = i2; tkR[sl * 4 + 2] = (int)atomicAdd((unsigned*)(hist + i2), 1u);
            tkE[sl * 4 + 3] = i3; tkR[sl * 4 + 3] = (int)atomicAdd((unsigned*)(hist + i3), 1u);
        }
        ++it;
        if ((it & 7) == 0 || tile + (int)gridDim.x >= T / 16) {
            __syncthreads();
            if (tid < NEXP) { const unsigned h = (unsigned)hist[tid]; hbase[tid] = h ? (int)atomicAdd(ctl + CW_CNT + layer * 64 + tid, h) : 0; hist[tid] = 0; }
            __syncthreads();
            const int nsl = (((it - 1) & 7) + 1) * 16;
            for (int a = tid; a < nsl * 4; a += NTHREADS) {
                const int sl = a >> 2, e = tkE[a], ps = hbase[e] + tkR[a];
                const int t = (tile - (((it - 1) & 7) - (sl >> 4)) * (int)gridDim.x) * 16 + (sl & 15);
                pos[t * 4 + (a & 3)] = ps; elist[(size_t)e * T + ps] = t;
            }
            __syncthreads();
        }
    }
    __syncthreads();
}
__device__ __forceinline__ void ln2_phase(LAS unsigned char* lds, const Params& p, int layer) {
    const int tid = tid_(), lane = tid & 63, wid = tid >> 6;
    moe_tables(lds, (const unsigned*)(p.ws + WS_CTL), layer);
    LAS const int* tab = (LAS const int*)(lds + TAB_OFF);
    const int* tope = (const int*)(p.ws + WS_TOPE); const int* pos = (const int*)(p.ws + WS_POS);
    float* xf = (float*)(p.ws + WS_XF);
    const bf16_t* yrows = (const bf16_t*)(p.ws + WS_YROWS);
    const float* gates = (const float*)(p.ws + WS_GATES);
    const float* gain = p.ln_gain + (size_t)(layer * 2 + 1) * D; const float* bias = p.ln_bias + (size_t)(layer * 2 + 1) * D;
    const int stride = (int)gridDim.x * 8;
    for (int t0 = blockIdx.x * 8 + wid; t0 < T; t0 += 2 * stride) {
        int dk[2][4]; float gk[2][4];
#pragma unroll
        for (int q = 0; q < 2; ++q) { const int t = (t0 + q * stride < T) ? t0 + q * stride : t0;
#pragma unroll
            for (int k = 0; k < 4; ++k) { dk[q][k] = tab[tope[t * 4 + k]] * 256 + pos[t * 4 + k]; gk[q][k] = gates[t * 4 + k]; } }
        u32x2 yv[2][4][4]; f32x4 xv[2][4];
#pragma unroll
        for (int q = 0; q < 2; ++q) { const int t = (t0 + q * stride < T) ? t0 + q * stride : t0;
#pragma unroll
            for (int i = 0; i < 4; ++i) { const int c = 256 * i + 4 * lane; xv[q][i] = *(const f32x4*)(xf + (size_t)t * D + c);
#pragma unroll
                for (int k = 0; k < 4; ++k) yv[q][i][k] = *(const u32x2*)(yrows + (size_t)dk[q][k] * D + c); } }
#pragma unroll
        for (int q = 0; q < 2; ++q) { const int t = t0 + q * stride; if (t < T) {
            f32x4 z[4];
#pragma unroll
            for (int i = 0; i < 4; ++i) {
                f32x4 f = (f32x4){0.f, 0.f, 0.f, 0.f};
#pragma unroll
                for (int k = 0; k < 4; ++k) { const u32x2 y2 = yv[q][i][k]; const float gg = gk[q][k];
                    f[0] += gg * __uint_as_float(y2.x << 16); f[1] += gg * __uint_as_float(y2.x & 0xffff0000u); f[2] += gg * __uint_as_float(y2.y << 16); f[3] += gg * __uint_as_float(y2.y & 0xffff0000u); }
                z[i] = DN_ALPHA * xv[q][i] + f;
            }
            float sm = 0.f;
#pragma unroll
            for (int i = 0; i < 4; ++i) sm += (z[i][0] + z[i][1]) + (z[i][2] + z[i][3]);
            const float mean = wave_sum(sm) * (1.0f / D);
            float sq = 0.f;
#pragma unroll
            for (int i = 0; i < 4; ++i) { const f32x4 dd = z[i] - mean; sq += (dd[0] * dd[0] + dd[1] * dd[1]) + (dd[2] * dd[2] + dd[3] * dd[3]); }
            const float rstd = rsqrtf(wave_sum(sq) * (1.0f / D) + LN_EPS);
#pragma unroll
            for (int i = 0; i < 4; ++i) {
                const int c = 256 * i + 4 * lane;
                z[i] = (z[i] - mean) * rstd * *(const f32x4*)(gain + c) + *(const f32x4*)(bias + c);
                if (layer == DEPTH - 1) *(f32x4*)(p.out + (size_t)t * D + c) = z[i];
                else { *(f32x4*)(xf + (size_t)t * D + c) = z[i]; *(unsigned*)(p.ws + WS_XQ + (size_t)t * D + c) = pk_fp8x4(z[i][0], z[i][1], z[i][2], z[i][3]); }
            }
        } }
    }
}

constexpr int PH_PER_LAYER = 9;
constexpr int NPHASES = 1 + DEPTH * PH_PER_LAYER;
constexpr int LDS_BYTES = 150 * 1024;


#ifndef PHMASK
#define PHMASK 0x3FF
#endif
#define PHK(j) ((PHMASK >> (j)) & 1)
#ifndef PROBE_MASK
#define PROBE_MASK 0
#endif
#ifndef PROBE_LAYERS
#define PROBE_LAYERS 0xF
#endif
#define REPS(j) ((((PROBE_MASK) >> (j)) & 1) ? 2 : 1)
#define REPSL(j) (((((PROBE_MASK) >> (j)) & 1) && (((PROBE_LAYERS) >> layer) & 1)) ? 2 : 1)
#define IN(k) (lo <= (k) && (k) < hi)
#if MK_ONE_LAUNCH
#define SEAM(k) do { if (IN(k) && IN((k) + 1)) xcd_barrier_nv(bar.bar, bar.x, bar.st); } while (0)
#else
#define SEAM(k) do {} while (0)
#endif
template <int layer>
__device__ __forceinline__ void run_layer(const Params& p, LAS unsigned char* lds, const XcdBarrier& bar) {
    const int lo = p.ph_lo, hi = p.ph_hi;
    unsigned char* ws = p.ws;
    unsigned* ctl = (unsigned*)(ws + WS_CTL);
        constexpr int base = 1 + layer * PH_PER_LAYER, kind = layer % 3, idx = layer / 3;
        for (int rep_ = 0; rep_ < REPSL(1); ++rep_) if (PHK(1) && IN(base + 0)) {
            constexpr int N = (kind == 0) ? 2048 : (kind == 1 ? 6144 : 9216);
            const unsigned char* Bt = (kind == 0) ? ws + WS_AWIN + (size_t)idx * 2048 * D : (kind == 1 ? ws + WS_BWIN : ws + WS_CWIN);
            g8::SchedPlain S; S.init(ws + WS_XQ, Bt, T, N, D / 2, (int)gridDim.x, (int)blockIdx.x);
            g8::EpiBf16 E{(bf16_t*)(ws + WS_U), N, nullptr, 0, 1.0f / GU_WSCALE};
            g8::gemm_phase<g8::EpiBf16, g8::SchedPlain, false, 1>(lds, D, S, E);
        }
        SEAM(base + 0);
        for (int rep_ = 0; rep_ < REPSL(2); ++rep_) if (PHK(2) && IN(base + 1)) {
            if (kind == 0) lru_gates_phase(lds, p, idx);
            else if (kind == 1) ret_core_phase(lds, p);
            else attn_core_phase(lds, p);
        }
        SEAM(base + 1);
        for (int rep_ = 0; rep_ < REPSL(3); ++rep_) if (PHK(3) && IN(base + 2)) {
            if (kind == 0) lru_scan_phase(p);
            else if (kind == 1) ret_norm_phase(lds, p);
            else attn_merge_phase(p);
        }
        SEAM(base + 2);
        for (int rep_ = 0; rep_ < REPSL(4); ++rep_) if (PHK(4) && IN(base + 3)) {
            constexpr int K = (kind == 1) ? 2048 : D;
            const bf16_t* Bt = (kind == 0) ? (const bf16_t*)(ws + WS_AWOUT) + (size_t)idx * D * D : (kind == 1 ? (const bf16_t*)(ws + WS_BWOUT) : (const bf16_t*)(ws + WS_CWOUT));
            g8::SchedPlain S; S.init(ws + WS_YIN, Bt, T, D, K, (int)gridDim.x, (int)blockIdx.x);
            g8::EpiBf16 E{(bf16_t*)(ws + WS_YMIX), D, nullptr, 0, 1.0f};
            g8::gemm_phase<g8::EpiBf16, g8::SchedPlain, false>(lds, K, S, E);
        }
        SEAM(base + 3);
        for (int rep_ = 0; rep_ < REPSL(5); ++rep_) if (PHK(5) && IN(base + 4)) ln1_router_phase(lds, p, layer);
        SEAM(base + 4);
        for (int rep_ = 0; rep_ < REPSL(7); ++rep_) if (PHK(7) && IN(base + 6)) {
            moe_tables(lds, ctl, layer);
            g8::SchedGU S{(const char*)(ws + WS_XQ), (const char*)(ws + WS_GU) + (size_t)layer * NEXP * 2048 * D, (const int*)(ws + WS_LIST), (LAS const int*)(lds + TAB_OFF), (int)gridDim.x, (int)blockIdx.x};
            g8::EpiSwiglu E{ws + WS_HID, p.moe_b_gu + (size_t)layer * NEXP * 2048, 1.0f / GU_WSCALE};
            g8::gemm_phase<g8::EpiSwiglu, g8::SchedGU, true, 1>(lds, D, S, E);
        }
        SEAM(base + 6);
        for (int rep_ = 0; rep_ < REPSL(8); ++rep_) if (PHK(8) && IN(base + 7)) {
            moe_tables(lds, ctl, layer);
            g8::SchedDown S{(const char*)(ws + WS_HID), (const char*)(ws + WS_DN) + (size_t)layer * NEXP * D * D, (LAS const int*)(lds + TAB_OFF), (int)gridDim.x, (int)blockIdx.x};
            g8::EpiBf16 E{(bf16_t*)(ws + WS_YROWS), D, p.moe_b_down + (size_t)layer * NEXP * D, D, 1.0f / DN_WSCALE};
            g8::gemm_phase<g8::EpiBf16, g8::SchedDown, false, 1>(lds, D, S, E);
        }
        SEAM(base + 7);
        for (int rep_ = 0; rep_ < REPSL(9); ++rep_) if (PHK(9) && IN(base + 8)) ln2_phase(lds, p, layer);
        SEAM(base + 8);
    }
#undef IN
#undef SEAM
__global__ void __launch_bounds__(NTHREADS, 2) fwd_kernel(Params p) {
    extern __shared__ __attribute__((aligned(16))) unsigned char lds_raw[];
    LAS unsigned char* lds = (LAS unsigned char*)lds_raw;
    const int lo = p.ph_lo, hi = p.ph_hi;
    unsigned char* ws = p.ws;
    unsigned* ctl = (unsigned*)(ws + WS_CTL);
#if MK_ONE_LAUNCH
    volatile LAS unsigned* bst = (volatile LAS unsigned*)(lds + LDS_BYTES - 16);
    if (threadIdx.x == 0) { bst[0] = 0u; bst[1] = 0u; bst[2] = 0u; bst[3] = 0u; }
    __syncthreads();
    XcdBarrier bar = xcd_barrier_post(ctl, bst);
#define GRID_BAR() xcd_barrier_nv(bar.bar, bar.x, bar.st)
#else
    XcdBarrier bar; bar.bar = ctl; bar.x = 0; bar.st = nullptr;
#define GRID_BAR() do {} while (0)
#endif
#define IN(k) (lo <= (k) && (k) < hi)
#define SEAM(k) do { if (IN(k) && IN((k) + 1)) GRID_BAR(); } while (0)

    for (int rep_ = 0; rep_ < REPS(0); ++rep_) if (PHK(0) && IN(0)) {
        LAS float* tile = (LAS float*)lds;
#pragma unroll 1
        for (int j = 0; j < 5; ++j) {
            const float* src = j == 0 ? p.moe_w_gu : (j == 1 ? p.moe_w_down : (j == 2 ? p.a_w_in : (j == 3 ? p.b_w_in : p.c_w_in)));
            const size_t dsto = j == 0 ? WS_GU : (j == 1 ? WS_DN : (j == 2 ? WS_AWIN : (j == 3 ? WS_BWIN : WS_CWIN)));
            const int N = j == 0 ? 2048 : (j == 1 ? D : (j == 2 ? 2048 : (j == 3 ? 6144 : 9216)));
            const int batch = j < 2 ? DEPTH * NEXP : (j == 2 ? 2 : 1);
            convert_big<true>(lds, src, ws + dsto, D, N, batch, j == 1 ? DN_WSCALE : GU_WSCALE);
        }
#pragma unroll 1
        for (int j = 0; j < 3; ++j) {
            const float* src = j == 0 ? p.a_w_out : (j == 1 ? p.b_w_out : p.c_w_out);
            const size_t dsto = j == 0 ? WS_AWOUT : (j == 1 ? WS_BWOUT : WS_CWOUT);
            convert_big<false>(lds, src, ws + dsto, j == 1 ? 2048 : D, D, j == 0 ? 2 : 1, 1.0f);
        }
        convert_job(tile, p.a_w_rgate, (bf16_t*)(ws + WS_AGT), 128, 128, 8);
        convert_job(tile, p.a_w_igate, (bf16_t*)(ws + WS_AGT) + (size_t)8 * 128 * 128, 128, 128, 8);
        convert_job(tile, p.a_w_rgate + (size_t)8 * 128 * 128, (bf16_t*)(ws + WS_AGT) + (size_t)16 * 128 * 128, 128, 128, 8);
        convert_job(tile, p.a_w_igate + (size_t)8 * 128 * 128, (bf16_t*)(ws + WS_AGT) + (size_t)24 * 128 * 128, 128, 128, 8);
        {
            bf16_t* rt = (bf16_t*)(ws + WS_RT);
            for (int i = blockIdx.x * NTHREADS + threadIdx.x; i < DEPTH * NEXP * D; i += gridDim.x * NTHREADS) {
                const int l = i / (NEXP * D), r_ = i % (NEXP * D), e = r_ / D, k = r_ % D;
                const float w = p.moe_w_router[((size_t)l * D + k) * NEXP + e];
                const bf16_t hi = f2bf(w); const bf16_t lo = f2bf(w - bf2f(hi));
                rt[((size_t)l * 2 + 0) * NEXP * D + (size_t)e * D + k] = hi; rt[((size_t)l * 2 + 1) * NEXP * D + (size_t)e * D + k] = lo;
            }
        }
        {
            const size_t stride = (size_t)gridDim.x * NTHREADS;
            for (size_t i = (size_t)blockIdx.x * NTHREADS + threadIdx.x; i < (size_t)T * D / 4; i += 4 * stride) {
                f32x4 v[4];
#pragma unroll
                for (int q = 0; q < 4; ++q) v[q] = *(const f32x4*)(p.x + (i + q * stride) * 4);
#pragma unroll
                for (int q = 0; q < 4; ++q) *(unsigned*)(ws + WS_XQ + (i + q * stride) * 4) = pk_fp8x4(v[q][0], v[q][1], v[q][2], v[q][3]);
            }
        }
    }
    SEAM(0);

    run_layer<0>(p, lds, bar); run_layer<1>(p, lds, bar); run_layer<2>(p, lds, bar); run_layer<3>(p, lds, bar);
#undef IN
#undef SEAM
}

extern "C" void kernel_launch(void* const* d_in, const int* in_sizes, int n_in, void* d_out, int out_size, void* d_ws, size_t ws_size, hipStream_t stream) {
    static int grid = 0;
    if (grid == 0) {
        if (n_in != 22 || out_size != T * D || ws_size < WS_END) { fprintf(stderr, "kernel_launch: unexpected shapes (n_in %d out %d ws %zu need %zu)\n", n_in, out_size, ws_size, (size_t)WS_END); grid = -1; return; }
        if (hipFuncSetAttribute((const void*)fwd_kernel, hipFuncAttributeMaxDynamicSharedMemorySize, LDS_BYTES) != hipSuccess) { fprintf(stderr, "kernel_launch: hipFuncSetAttribute failed\n"); grid = -1; return; }
        int dev = 0, cus = 0;
        if (hipGetDevice(&dev) != hipSuccess || hipDeviceGetAttribute(&cus, hipDeviceAttributeMultiprocessorCount, dev) != hipSuccess) { grid = -1; return; }
        grid = cus;
    }
    if (grid < 0) return;
    (void)hipMemsetAsync((char*)d_ws + WS_CTL, 0, CTL_BYTES, stream);
    Params p{};
    const float** pp = (const float**)&p;
    for (int i = 0; i < 22; ++i) pp[i] = (const float*)d_in[i];
    p.out = (float*)d_out; p.ws = (unsigned char*)d_ws;
#if MK_ONE_LAUNCH
    p.ph_lo = 0; p.ph_hi = NPHASES;
    hipLaunchKernelGGL(fwd_kernel, dim3(grid), dim3(NTHREADS), LDS_BYTES, stream, p);
#else
    for (int ph = 0; ph < NPHASES; ++ph) {
        p.ph_lo = ph; p.ph_hi = ph + 1;
        hipLaunchKernelGGL(fwd_kernel, dim3(grid), dim3(NTHREADS), LDS_BYTES, stream, p);
    }
#endif
}
```

```cpp
#include <hip/hip_runtime.h>
#include <stdint.h>
#include <stdio.h>

#ifndef MK_ONE_LAUNCH
#define MK_ONE_LAUNCH 1
#endif

#define LAS __attribute__((address_space(3)))
typedef unsigned short bf16_t;
typedef short bf16x8 __attribute__((ext_vector_type(8)));
typedef float f32x4 __attribute__((ext_vector_type(4)));
typedef unsigned u32x4 __attribute__((ext_vector_type(4)));
typedef unsigned u32x2 __attribute__((ext_vector_type(2)));

constexpr int T = 16384, D = 1024, SEQ = 2048, NBATCH = 8, DEPTH = 4;
constexpr int NEXP = 32, TOPK = 4;
constexpr int MAXROWS = 73728;
constexpr float DN_ALPHA = 1.681792830507429f;
constexpr float LN_EPS = 1e-5f;
constexpr float GU_WSCALE = 64.0f, DN_WSCALE = 128.0f;
constexpr int NTHREADS = 512;

constexpr size_t MB = 1ull << 20;
constexpr size_t WS_CTL = 0;
constexpr size_t CTL_BYTES = 65536;
constexpr size_t WS_AWIN = 1 * MB;
constexpr size_t WS_AWOUT = WS_AWIN + 8 * MB;
constexpr size_t WS_BWIN = WS_AWOUT + 4 * MB;
constexpr size_t WS_BWOUT = WS_BWIN + 12 * MB;
constexpr size_t WS_CWIN = WS_BWOUT + 4 * MB;
constexpr size_t WS_CWOUT = WS_CWIN + 18 * MB;
constexpr size_t WS_GU = WS_CWOUT + 2 * MB;
constexpr size_t WS_DN = WS_GU + 512 * MB;
constexpr size_t WS_XF = WS_DN + 256 * MB;
constexpr size_t WS_XB = WS_XF + 64 * MB;
constexpr size_t WS_U = WS_XB + 32 * MB;
constexpr size_t WS_YIN = WS_U + 288 * MB;
constexpr size_t WS_YMIX = WS_YIN + 64 * MB;
constexpr size_t WS_SCR = WS_YMIX + 64 * MB;
constexpr size_t WS_TOPE = WS_SCR + 128 * MB;
constexpr size_t WS_GATES = WS_TOPE + 256 * 1024;
constexpr size_t WS_POS = WS_GATES + 256 * 1024;
constexpr size_t WS_DEST = WS_POS + 256 * 1024;
constexpr size_t WS_ROWTOK = WS_DEST + 256 * 1024;
constexpr size_t WS_HID = WS_ROWTOK + 1 * MB;
constexpr size_t WS_YROWS = WS_HID + 144 * MB;
constexpr size_t WS_LSUM = WS_YROWS + 288 * MB;
constexpr size_t WS_AGT = WS_LSUM + 2 * MB;
constexpr size_t WS_RT = WS_AGT + 1 * MB;
constexpr size_t WS_XQ = WS_RT + 1 * MB;
constexpr size_t WS_LIST = WS_XQ + 16 * MB;
constexpr size_t WS_END = WS_LIST + 2 * MB;

constexpr int CW_CNT = 4096;
constexpr int CW_MDYN = 8192;
constexpr int CW_TEXP = 12288;

#define XB_TMO      128
#define XB_XCNT(j)  (256  + 64 * (j))
#define XB_XSUB(j)  (1280 + 64 * (j))
#define XB_XGEN(j)  (2304 + 64 * (j))
#define XB_TOP      3328
#define XB_TOPGEN   3392
#define XCD_BAR_WORDS 3456
#define XB_SPIN_CAP (1u << 22)

__device__ __forceinline__ unsigned xb_ld(unsigned* p)              { return __hip_atomic_load(p, __ATOMIC_RELAXED, __HIP_MEMORY_SCOPE_AGENT); }
__device__ __forceinline__ unsigned xb_add(unsigned* p, unsigned v) { return __hip_atomic_fetch_add(p, v, __ATOMIC_RELAXED, __HIP_MEMORY_SCOPE_AGENT); }
__device__ __forceinline__ unsigned xb_xcc_id() { return (unsigned)__builtin_amdgcn_s_getreg((3 << 11) | 20) & 0xFu; }
#define XB_SPIN(cond, bar) do { unsigned _sp = 0; while (cond) { __builtin_amdgcn_s_sleep(1); \
    if ((++_sp & 255u) == 0u) { if (xb_ld(&(bar)[XB_TMO])) break; if (_sp > XB_SPIN_CAP) { atomicAdd(&(bar)[XB_TMO], 1u); break; } } } } while (0)

struct XcdBarrier { unsigned* bar; unsigned x; volatile LAS unsigned* st; };

__device__ __forceinline__ XcdBarrier xcd_barrier_post(unsigned* bar, volatile LAS unsigned* st) {
    XcdBarrier b; b.bar = bar; b.x = xb_xcc_id(); b.st = st;
    if (threadIdx.x == 0) (void)xb_add(&bar[XB_XCNT(b.x)], 1u);
    return b;
}
__device__ __forceinline__ void xcd_barrier_complete(unsigned* bar, unsigned x, unsigned& nloc, unsigned& nx) {
    const unsigned G = gridDim.x * gridDim.y * gridDim.z;
    unsigned sum, cnt, mine, sp = 0u;
    for (;;) {
        sum = 0u; cnt = 0u; mine = 0u;
#pragma unroll
        for (unsigned j = 0; j < 16; ++j) { const unsigned c = xb_ld(&bar[XB_XCNT(j)]); sum += c; cnt += (c > 0u) ? 1u : 0u; mine = (j == x) ? c : mine; }
        if (sum == G) break;
        __builtin_amdgcn_s_sleep(1);
        if ((++sp & 255u) == 0u) { if (xb_ld(&bar[XB_TMO])) break; if (sp > XB_SPIN_CAP) { atomicAdd(&bar[XB_TMO], 1u); break; } }
    }
    nloc = mine > 0u ? mine : 1u; nx = cnt > 0u ? cnt : 1u;
}
__device__ __forceinline__ void xcd_barrier_nv(unsigned* bbar, unsigned bx, volatile LAS unsigned* bst) {
    XcdBarrier b; b.bar = bbar; b.x = bx; b.st = bst;
    asm volatile("s_waitcnt vmcnt(0)" ::: "memory");
    __syncthreads();
    if (threadIdx.x == 0) {
        unsigned* bar = b.bar;
        __builtin_amdgcn_s_waitcnt(0);
        unsigned nloc = b.st[0], nx = b.st[1];
        if (nloc == 0u) { xcd_barrier_complete(bar, b.x, nloc, nx); b.st[0] = nloc; b.st[1] = nx; }
        const unsigned old = xb_add(&bar[XB_XSUB(b.x)], 1u);
        const unsigned gen = old / nloc;
        if (old + 1u == (gen + 1u) * nloc) {
            __builtin_amdgcn_fence(__ATOMIC_RELEASE, "agent");
            asm volatile("s_waitcnt vmcnt(0)" ::: "memory");
            const unsigned og = xb_add(&bar[XB_TOP], 1u);
            const unsigned tg = og / nx;
            if (og + 1u == (tg + 1u) * nx) xb_add(&bar[XB_TOPGEN], 1u);
            else XB_SPIN(xb_ld(&bar[XB_TOPGEN]) == tg, bar);
            __builtin_amdgcn_fence(__ATOMIC_ACQUIRE, "agent");
            xb_add(&bar[XB_XGEN(b.x)], 1u);
            asm volatile("s_waitcnt vmcnt(0)" ::: "memory");
        } else {
            XB_SPIN(xb_ld(&bar[XB_XGEN(b.x)]) == gen, bar);
            __builtin_amdgcn_fence(__ATOMIC_ACQUIRE, "agent");
            asm volatile("s_waitcnt vmcnt(0)" ::: "memory");
        }
    }
    __syncthreads();
}

__device__ __forceinline__ int tid_() { int t = threadIdx.x; asm volatile("" : "+v"(t)); return t; }
__device__ __forceinline__ float bf2f(bf16_t v) { return __uint_as_float(((unsigned)v) << 16); }
__device__ __forceinline__ unsigned pack2(float lo, float hi) { unsigned r; asm("v_cvt_pk_bf16_f32 %0, %1, %2" : "=v"(r) : "v"(lo), "v"(hi)); return r; }
__device__ __forceinline__ bf16_t f2bf(float f) { return (bf16_t)(pack2(f, f) & 0xffffu); }
__device__ __forceinline__ float wave_sum(float v) {
#pragma unroll
    for (int o = 32; o >= 1; o >>= 1) v += __shfl_xor(v, o);
    return v;
}
__device__ __forceinline__ float wave_max(float v) {
#pragma unroll
    for (int o = 32; o >= 1; o >>= 1) v = fmaxf(v, __shfl_xor(v, o));
    return v;
}
__device__ __forceinline__ float sigmoidf_(float x) { return __builtin_amdgcn_rcpf(1.0f + __builtin_amdgcn_exp2f(-1.4426950408889634f * x)); }
__device__ __forceinline__ float gelu_tanh(float x) { const float u = 0.7978845608028654f * (x + 0.044715f * x * x * x); return 0.5f * x * (1.0f + tanhf(u)); }
__device__ __forceinline__ unsigned pk_fp8x4(float a, float b, float c, float d) { int w = 0; w = __builtin_amdgcn_cvt_pk_fp8_f32(a, b, w, false); w = __builtin_amdgcn_cvt_pk_fp8_f32(c, d, w, true); return (unsigned)w; }
typedef float f32x2 __attribute__((ext_vector_type(2)));
__device__ __forceinline__ f32x2 swiglu2(f32x2 gate, f32x2 up) {
    f32x2 g, u; g.x = fminf(gate.x, 7.0f); g.y = fminf(gate.y, 7.0f); u.x = __builtin_amdgcn_fmed3f(up.x, -7.0f, 7.0f); u.y = __builtin_amdgcn_fmed3f(up.y, -7.0f, 7.0f);
    const f32x2 t = g * (-1.702f * 1.4426950408889634f);
    f32x2 e; e.x = __builtin_amdgcn_exp2f(t.x); e.y = __builtin_amdgcn_exp2f(t.y);
    const f32x2 d = e + 1.0f;
    f32x2 r; r.x = __builtin_amdgcn_rcpf(d.x); r.y = __builtin_amdgcn_rcpf(d.y);
    return ((u + 1.0f) * g) * r;
}
__device__ __forceinline__ float swiglu(float gate, float up) {
    const float g = fminf(gate, 7.0f), u = fminf(fmaxf(up, -7.0f), 7.0f);
    return (u + 1.0f) * g * sigmoidf_(1.702f * g);
}

struct Params {
    const float* x; const float* a_w_in; const float* a_conv_w; const float* a_conv_b; const float* a_w_rgate; const float* a_b_rgate;
    const float* a_w_igate; const float* a_b_igate; const float* a_lambda; const float* a_w_out; const float* b_w_in; const float* b_w_out;
    const float* c_w_in; const float* c_w_out; const float* ln_gain; const float* ln_bias; const float* moe_w_router; const float* moe_b_router;
    const float* moe_w_gu; const float* moe_b_gu; const float* moe_w_down; const float* moe_b_down;
    float* out; unsigned char* ws;
    int ph_lo, ph_hi;
};

__device__ __forceinline__ void convert_job(LAS float* tile, const float* src, bf16_t* dst, int K, int N, int batch) {
    const int tid = tid_();
    const int tk = K / 64, tn = N / 64, per = tk * tn; const long total = (long)per * batch;
    for (long u = blockIdx.x; u < total; u += gridDim.x) {
        const int bidx = (int)(u / per), r = (int)(u % per), kt = r / tn, nt = r % tn;
        const float* s = src + (size_t)bidx * K * N + (size_t)(kt * 64) * N + nt * 64;
#pragma unroll
        for (int pass = 0; pass < 2; ++pass) {
            const int row = (tid >> 4) + 32 * pass, c4 = tid & 15;
            const f32x4 v = *(const f32x4*)(s + (size_t)row * N + c4 * 4);
            tile[row * 65 + c4 * 4 + 0] = v[0]; tile[row * 65 + c4 * 4 + 1] = v[1]; tile[row * 65 + c4 * 4 + 2] = v[2]; tile[row * 65 + c4 * 4 + 3] = v[3];
        }
        __syncthreads();
        {
            const int n = tid >> 3, k8 = tid & 7;
            float v[8];
#pragma unroll
            for (int j = 0; j < 8; ++j) v[j] = tile[(k8 * 8 + j) * 65 + n];
            u32x4 w; w.x = pack2(v[0], v[1]); w.y = pack2(v[2], v[3]); w.z = pack2(v[4], v[5]); w.w = pack2(v[6], v[7]);
            *(u32x4*)(dst + (size_t)bidx * N * K + (size_t)(nt * 64 + n) * K + kt * 64 + k8 * 8) = w;
        }
        __syncthreads();
    }
}


constexpr int TAB_OFF = 131072;
__device__ __forceinline__ void moe_tables(LAS unsigned char* lds, const unsigned* ctl, int layer) {
    LAS int* tab = (LAS int*)(lds + TAB_OFF);
    const int tid = tid_();
    __syncthreads();
    if (tid == 0) { int acc = 0; for (int e = 0; e < NEXP; ++e) { tab[e] = acc; acc += ((int)ctl[CW_CNT + layer * 64 + e] + 255) >> 8; } tab[32] = acc; }
    __syncthreads();
    if (tid < 288) { int e = 0; for (int q = 1; q < NEXP; ++q) e += (tab[q] <= tid) ? 1 : 0; tab[64 + tid] = e; }
    __syncthreads();
}

namespace g8 {
constexpr int BM = 256, BK = 64, HALF = 128, HTB = HALF * BK * 2, STAGE_BYTES = 8 * HTB, NXCD = 8, WGM = 8;
__device__ __forceinline__ int lds_byte(int r, int c) { const int st = (r >> 4) * 2 + (c >> 5), rr = r & 15, cc = c & 31, ob = rr * 64 + cc * 2; return st * 1024 + (ob ^ (((ob >> 9) & 1) << 5)); }
__device__ __forceinline__ void stage_rc(int b, int& R, int& C) { const int st = b / 1024, sb = b % 1024, swz = sb ^ (((sb >> 9) & 1) << 5); R = (st >> 1) * 16 + swz / 64; C = (st & 1) * 32 + (swz % 64) / 2; }
__device__ __forceinline__ int perm32(int rho) { const int n = rho >> 4, i = rho & 15; return 8 * (i >> 2) + 4 * n + (i & 3); }
__device__ __forceinline__ unsigned cvt_pk_bf16(float lo, float hi) { unsigned r; asm volatile("v_cvt_pk_bf16_f32 %0, %1, %2" : "=v"(r) : "v"(lo), "v"(hi)); return r; }

struct Unit { const char* a0; const char* a1; const char* b0; const char* b1; const int* rows; int row0, col0, e; };

struct SchedPlain {
    const char* A; const char* Bt; size_t hstepA, hstepB; int nM, nN, nwg, G, c;
    __device__ __forceinline__ void init(const void* A_, const void* Bt_, int M, int N, int K, int G_, int c_) { A = (const char*)A_; Bt = (const char*)Bt_; hstepA = (size_t)HALF * K * 2; hstepB = hstepA; nM = M / BM; nN = N / BM; nwg = nM * nN; G = G_; c = c_; }
    __device__ __forceinline__ bool next(int i, Unit& u) const {
        const long L = (long)i * G + c; if (L >= nwg) return false;
        int wgid = (int)L; { const int q = nwg / NXCD, r = nwg % NXCD, xcd = wgid % NXCD, off = wgid / NXCD; wgid = (xcd < r ? xcd * (q + 1) : r * (q + 1) + (xcd - r) * q) + off; }
        const int nig = WGM * nN, gid = wgid / nig, fm = gid * WGM, gsz = (nM - fm) < WGM ? (nM - fm) : WGM;
        const int pm = fm + ((wgid % nig) % gsz), pn = (wgid % nig) / gsz;
        u.a0 = A + (size_t)pm * 2 * hstepA; u.a1 = u.a0 + hstepA; u.b0 = Bt + (size_t)pn * 2 * hstepB; u.b1 = u.b0 + hstepB; u.rows = nullptr; u.row0 = pm * BM; u.col0 = pn * BM; u.e = 0;
        return true;
    }
};
struct SchedGU {
    const char* A; const char* W; const int* elist; LAS const int* tab; int G, c;
    __device__ __forceinline__ bool next(int i, Unit& u) const {
        const int xx = c & 7, jj = c >> 3, rt = i * (G >> 3) + ((jj >> 1) << 1) + (xx >> 2), pn = 2 * (xx & 3) + (jj & 1); if (rt >= __builtin_amdgcn_readfirstlane(tab[32])) return false;
        const int e = __builtin_amdgcn_readfirstlane(tab[64 + rt]), j = rt - __builtin_amdgcn_readfirstlane(tab[e]);
        u.a0 = A; u.a1 = A; u.rows = elist + (size_t)e * T + j * BM; u.b0 = W + ((size_t)e * 2048 + pn * 128) * D; u.b1 = u.b0 + (size_t)1024 * D; u.row0 = rt * BM; u.col0 = pn * 128; u.e = e;
        return true;
    }
};
struct SchedDown {
    const char* A; const char* W; LAS const int* tab; int G, c;
    __device__ __forceinline__ bool next(int i, Unit& u) const {
        const int L = i * G + c, rt = L >> 2, pn = L & 3; if (rt >= __builtin_amdgcn_readfirstlane(tab[32])) return false;
        const int e = __builtin_amdgcn_readfirstlane(tab[64 + rt]);
        u.a0 = A + (size_t)rt * BM * D; u.a1 = u.a0 + (size_t)HALF * D; u.rows = nullptr; u.b0 = W + ((size_t)e * 1024 + pn * BM) * D; u.b1 = u.b0 + (size_t)HALF * D; u.row0 = rt * BM; u.col0 = pn * BM; u.e = e;
        return true;
    }
};

struct EpiF32 {
    static constexpr bool PERM = false, STAGED = false;
    float* C; int ldc; const float* bias; int bias_es;
    __device__ __forceinline__ void operator()(const f32x4 (&acc)[2][2][4][2], const Unit& u, int wr, int wc, int fr, int fq) const {
        const int row0 = u.row0 + wr * 64 + fr, col0 = u.col0 + wc * 32 + 4 * fq;
        f32x4 bv[2][2];
#pragma unroll
        for (int bj = 0; bj < 2; ++bj)
#pragma unroll
            for (int n = 0; n < 2; ++n) bv[bj][n] = bias ? *(const f32x4*)(bias + (size_t)u.e * bias_es + col0 + bj * HALF + n * 16) : (f32x4){0.f, 0.f, 0.f, 0.f};
#pragma unroll
        for (int ai = 0; ai < 2; ++ai)
#pragma unroll
            for (int m = 0; m < 4; ++m) { float* rowp = C + (size_t)(row0 + ai * HALF + m * 16) * ldc + col0;
#pragma unroll
                for (int bj = 0; bj < 2; ++bj)
#pragma unroll
                    for (int n = 0; n < 2; ++n) *(f32x4*)(rowp + bj * HALF + n * 16) = acc[ai][bj][m][n] + bv[bj][n]; }
    }
};
struct EpiBf16 {
    static constexpr bool PERM = true, STAGED = true;
    bf16_t* O; int ldc; const float* bias; int bias_es; float scale;
    __device__ __forceinline__ void staged(const f32x4 (&acc)[2][2][4][2], const Unit& u, int wr, int wc, int fr, int fq, LAS unsigned char* lds, int tid) const {
        const int col0 = u.col0 + wc * 32 + 8 * fq;
        f32x4 bv[2][2];
#pragma unroll
        for (int bj = 0; bj < 2; ++bj)
#pragma unroll
            for (int n = 0; n < 2; ++n) bv[bj][n] = bias ? *(const f32x4*)(bias + (size_t)u.e * bias_es + col0 + bj * HALF + 4 * n) : (f32x4){0.f, 0.f, 0.f, 0.f};
        LAS unsigned char* slab = lds + (wr ? (TAB_OFF + 2048) : 3 * HTB);
        const int j = tid & 255, rrow = j >> 5, rc = j & 31;
#pragma unroll
        for (int ai = 0; ai < 2; ++ai)
#pragma unroll
            for (int mp = 0; mp < 2; ++mp) {
#pragma unroll
                for (int mm = 0; mm < 2; ++mm)
#pragma unroll
                    for (int bj = 0; bj < 2; ++bj) {
                        const int m = 2 * mp + mm, row = 16 * mm + fr, chunk = 16 * bj + 4 * wc + fq;
                        const f32x4 v0 = acc[ai][bj][m][0] * scale + bv[bj][0], v1 = acc[ai][bj][m][1] * scale + bv[bj][1];
                        u32x4 w; w.x = cvt_pk_bf16(v0[0], v0[1]); w.y = cvt_pk_bf16(v0[2], v0[3]); w.z = cvt_pk_bf16(v1[0], v1[1]); w.w = cvt_pk_bf16(v1[2], v1[3]);
                        *(LAS u32x4*)(slab + row * 512 + ((chunk ^ (row & 15)) * 16)) = w;
                    }
                asm volatile("s_waitcnt lgkmcnt(0)" ::: "memory"); __builtin_amdgcn_s_barrier(); asm volatile("" ::: "memory");
#pragma unroll
                for (int i = 0; i < 4; ++i) {
                    const int row = rrow + 8 * i;
                    const u32x4 w = *(const LAS u32x4*)(slab + row * 512 + ((rc ^ (row & 15)) * 16));
                    *(u32x4*)(O + (size_t)(u.row0 + 128 * ai + 64 * wr + 32 * mp + row) * ldc + u.col0 + rc * 8) = w;
                }
                asm volatile("s_waitcnt lgkmcnt(0)" ::: "memory"); __builtin_amdgcn_s_barrier(); asm volatile("" ::: "memory");
            }
    }
};
struct EpiFp8 {
    static constexpr bool PERM = true, STAGED = false;
    unsigned char* O; int ldc; const float* bias; int bias_es; float scale;
    __device__ __forceinline__ void operator()(const f32x4 (&acc)[2][2][4][2], const Unit& u, int wr, int wc, int fr, int fq) const {
        const int row0 = u.row0 + wr * 64 + fr, col0 = u.col0 + wc * 32 + 8 * fq;
        f32x4 bv[2][2];
#pragma unroll
        for (int bj = 0; bj < 2; ++bj)
#pragma unroll
            for (int n = 0; n < 2; ++n) bv[bj][n] = *(const f32x4*)(bias + (size_t)u.e * bias_es + col0 + bj * HALF + 4 * n);
#pragma unroll
        for (int ai = 0; ai < 2; ++ai)
#pragma unroll
            for (int m = 0; m < 4; ++m) { unsigned char* rowp = O + (size_t)(row0 + ai * HALF + m * 16) * ldc + col0;
#pragma unroll
                for (int bj = 0; bj < 2; ++bj) { const f32x4 v0 = acc[ai][bj][m][0] * scale + bv[bj][0], v1 = acc[ai][bj][m][1] * scale + bv[bj][1];
                    u32x2 w; w.x = pk_fp8x4(v0[0], v0[1], v0[2], v0[3]); w.y = pk_fp8x4(v1[0], v1[1], v1[2], v1[3]);
                    *(u32x2*)(rowp + bj * HALF) = w; } }
    }
};
struct EpiSwiglu {
    static constexpr bool PERM = true, STAGED = false;
    unsigned char* O; const float* bias; float scale;
    __device__ __forceinline__ void operator()(const f32x4 (&acc)[2][2][4][2], const Unit& u, int wr, int wc, int fr, int fq) const {
        const int row0 = u.row0 + wr * 64 + fr, hc = u.col0 + wc * 32 + 8 * fq;
        const float* bp = bias + (size_t)u.e * 2048 + hc;
        const f32x4 bg0 = *(const f32x4*)(bp), bg1 = *(const f32x4*)(bp + 4), bu0 = *(const f32x4*)(bp + 1024), bu1 = *(const f32x4*)(bp + 1028);
#pragma unroll
        for (int ai = 0; ai < 2; ++ai)
#pragma unroll
            for (int m = 0; m < 4; ++m) {
                const f32x4 g0 = acc[ai][0][m][0] * scale + bg0, g1 = acc[ai][0][m][1] * scale + bg1, u0 = acc[ai][1][m][0] * scale + bu0, u1 = acc[ai][1][m][1] * scale + bu1;
                const f32x2 h0 = swiglu2((f32x2){g0[0], g0[1]}, (f32x2){u0[0], u0[1]}), h1 = swiglu2((f32x2){g0[2], g0[3]}, (f32x2){u0[2], u0[3]});
                const f32x2 h2 = swiglu2((f32x2){g1[0], g1[1]}, (f32x2){u1[0], u1[1]}), h3 = swiglu2((f32x2){g1[2], g1[3]}, (f32x2){u1[2], u1[3]});
                u32x2 w; w.x = pk_fp8x4(h0.x, h0.y, h1.x, h1.y); w.y = pk_fp8x4(h2.x, h2.y, h3.x, h3.y);
                *(u32x2*)(O + (size_t)(row0 + ai * HALF + m * 16) * D + hc) = w;
            }
    }
};

typedef int i32x8 __attribute__((ext_vector_type(8)));
typedef int i32x4 __attribute__((ext_vector_type(4)));
template <class Epi, class Sched, bool GATHER, int ESZ = 2>
__device__ __forceinline__ void gemm_phase(LAS unsigned char* lds, const int K, const Sched& S, const Epi& E) {
    const int tid = tid_(), wid = __builtin_amdgcn_readfirstlane(tid >> 6), lane = tid & 63, wr = wid >> 2, wc = wid & 3, fr = lane & 15, fq = lane >> 4;
    const int nt = K * ESZ / 128, KP = K * ESZ;
    int sR[2], sC[2];
    unsigned voffB[2];
#pragma unroll
    for (int i = 0; i < 2; ++i) { stage_rc(tid * 16 + i * 8192, sR[i], sC[i]); const int Rb = Epi::PERM ? ((sR[i] & ~31) + perm32(sR[i] & 31)) : sR[i]; voffB[i] = (unsigned)(Rb * KP + sC[i] * 2); }
    unsigned cvA0[2], cvA1[2], nvA0[2], nvA1[2];
#define G8_VOFF(u, v0, v1) do { _Pragma("unroll") for (int _i = 0; _i < 2; ++_i) { \
        if (GATHER) { unsigned t0_ = (unsigned)(u).rows[sR[_i]], t1_ = (unsigned)(u).rows[HALF + sR[_i]]; t0_ = t0_ < (unsigned)T ? t0_ : 0u; t1_ = t1_ < (unsigned)T ? t1_ : 0u;     \
            v0[_i] = t0_ * (unsigned)KP + (unsigned)(sC[_i] * 2); v1[_i] = t1_ * (unsigned)KP + (unsigned)(sC[_i] * 2); } \
        else { v0[_i] = (unsigned)(sR[_i] * KP + sC[_i] * 2); v1[_i] = v0[_i]; } } } while (0)
    const size_t kstep = (size_t)(BK * 2);
    const unsigned ldsw = (unsigned)wid * 1024u;
    const int aoff = lds_byte(wr * 64 + fr, fq * 8), boff = lds_byte(wc * 32 + fr, fq * 8);
#define PG8_SA(b, h) (((b) * 2 + (h)) * HTB)
#define PG8_SB(b, h) ((4 + (b) * 2 + (h)) * HTB)
#define PG8_STAGE(bufoff, gbase, voff) do { _Pragma("unroll") for (int _i = 0; _i < 2; ++_i) \
        __builtin_amdgcn_global_load_lds((const unsigned*)((const char*)(gbase) + (voff)[_i]), (LAS unsigned*)(lds + (bufoff) + ldsw + _i * 8192), 16, 0, 0); } while (0)
#define PG8_LDA(dst, b, h) do { _Pragma("unroll") for (int m = 0; m < 4; ++m) { dst[m].lo = *(const LAS i32x4*)(lds + PG8_SA(b, h) + aoff + m * 2048); dst[m].hi = *(const LAS i32x4*)(lds + PG8_SA(b, h) + aoff + m * 2048 + 1024); } } while (0)
#define PG8_LDB(dst, b, h) do { _Pragma("unroll") for (int n = 0; n < 2; ++n) { dst[n].lo = *(const LAS i32x4*)(lds + PG8_SB(b, h) + boff + n * 2048); dst[n].hi = *(const LAS i32x4*)(lds + PG8_SB(b, h) + boff + n * 2048 + 1024); } } while (0)
#define PG8_MMA(ai, bj, At, Bt) do { __builtin_amdgcn_s_setprio(1); _Pragma("unroll") for (int m = 0; m < 4; ++m) _Pragma("unroll") for (int n = 0; n < 2; ++n) { \
        if (ESZ == 2) { acc[ai][bj][m][n] = __builtin_amdgcn_mfma_f32_16x16x32_bf16(__builtin_bit_cast(bf16x8, (i32x4)__builtin_shufflevector(Bt[n], Bt[n], 0, 1, 2, 3)), __builtin_bit_cast(bf16x8, (i32x4)__builtin_shufflevector(At[m], At[m], 0, 1, 2, 3)), acc[ai][bj][m][n], 0, 0, 0); \
                        acc[ai][bj][m][n] = __builtin_amdgcn_mfma_f32_16x16x32_bf16(__builtin_bit_cast(bf16x8, (i32x4)__builtin_shufflevector(Bt[n], Bt[n], 4, 5, 6, 7)), __builtin_bit_cast(bf16x8, (i32x4)__builtin_shufflevector(At[m], At[m], 4, 5, 6, 7)), acc[ai][bj][m][n], 0, 0, 0); } \
        else asm volatile("v_mfma_f32_16x16x128_f8f6f4 %0, %1, %2, %0" : "+v"(acc[ai][bj][m][n]) : "v"(Bt[n]), "v"(At[m])); } __builtin_amdgcn_s_setprio(0); } while (0)
#define PG8_WAIT_V(n) asm volatile("s_waitcnt vmcnt(" #n ")" ::: "memory")
#define PG8_WAIT_L(n) asm volatile("s_waitcnt lgkmcnt(" #n ")" ::: "memory")
#define PG8_BAR __builtin_amdgcn_s_barrier()
#define PG8_SCHED __builtin_amdgcn_sched_barrier(0)
    Unit cur, nxt; int ui = 0;
    if (!S.next(0, cur)) return;
    f32x4 acc[2][2][4][2];
#pragma unroll
    for (int a = 0; a < 2; ++a)
#pragma unroll
        for (int b = 0; b < 2; ++b)
#pragma unroll
            for (int m = 0; m < 4; ++m)
#pragma unroll
                for (int n = 0; n < 2; ++n) acc[a][b][m][n] = (f32x4){0.f, 0.f, 0.f, 0.f};
    i32x8 At[4], B0[2], B1[2];
    const char* cA0 = cur.a0; const char* cA1 = cur.a1; const char* cB0 = cur.b0; const char* cB1 = cur.b1;
    G8_VOFF(cur, cvA0, cvA1);
    PG8_STAGE(PG8_SB(0, 0), cB0, voffB); PG8_STAGE(PG8_SB(0, 1), cB1, voffB); PG8_STAGE(PG8_SA(0, 0), cA0, cvA0); PG8_STAGE(PG8_SA(0, 1), cA1, cvA1);
    if (wr == 1) PG8_BAR;
    PG8_WAIT_V(2); PG8_BAR;
    PG8_STAGE(PG8_SB(1, 0), cB0 + kstep, voffB); PG8_STAGE(PG8_SA(1, 0), cA0 + kstep, cvA0); PG8_STAGE(PG8_SB(1, 1), cB1 + kstep, voffB);
    PG8_WAIT_V(6); PG8_BAR;
    for (;;) {
        const bool has_next = S.next(ui + 1, nxt);
        const char* nA0 = has_next ? nxt.a0 : cA0; const char* nA1 = has_next ? nxt.a1 : cA1; const char* nB0 = has_next ? nxt.b0 : cB0; const char* nB1 = has_next ? nxt.b1 : cB1;
        if (GATHER) { if (has_next) { G8_VOFF(nxt, nvA0, nvA1); } else { nvA0[0] = cvA0[0]; nvA0[1] = cvA0[1]; nvA1[0] = cvA1[0]; nvA1[1] = cvA1[1]; } }
#pragma unroll 1
        for (int t = 0; t < nt; t += 2) {
            const bool last = (t == nt - 2);
            const char* a1_1 = cA1 + (size_t)(t + 1) * kstep;
            const char* a2_0 = last ? nA0 : cA0 + (size_t)(t + 2) * kstep; const char* a2_1 = last ? nA1 : cA1 + (size_t)(t + 2) * kstep;
            const char* b2_0 = last ? nB0 : cB0 + (size_t)(t + 2) * kstep; const char* b2_1 = last ? nB1 : cB1 + (size_t)(t + 2) * kstep;
            const char* a3_0 = a2_0 + kstep; const char* b3_0 = b2_0 + kstep; const char* b3_1 = b2_1 + kstep;
            unsigned vA0[2], vA1[2];
            if (GATHER) { vA0[0] = last ? nvA0[0] : cvA0[0]; vA0[1] = last ? nvA0[1] : cvA0[1]; vA1[0] = last ? nvA1[0] : cvA1[0]; vA1[1] = last ? nvA1[1] : cvA1[1]; }
            else { vA0[0] = cvA0[0]; vA0[1] = cvA0[1]; vA1[0] = cvA0[0]; vA1[1] = cvA0[1]; }
            PG8_LDB(B0, 0, 0); PG8_LDB(B1, 0, 1); PG8_SCHED; PG8_LDA(At, 0, 0); PG8_STAGE(PG8_SA(1, 1), a1_1, cvA1);
            PG8_WAIT_V(8); PG8_WAIT_L(0); PG8_BAR; PG8_MMA(0, 0, At, B0); PG8_MMA(0, 1, At, B1); PG8_BAR; PG8_SCHED;
            PG8_LDA(At, 0, 1); PG8_STAGE(PG8_SB(0, 0), b2_0, voffB); PG8_STAGE(PG8_SB(0, 1), b2_1, voffB); PG8_STAGE(PG8_SA(0, 0), a2_0, vA0);
            PG8_WAIT_V(8); PG8_WAIT_L(0); PG8_BAR; PG8_MMA(1, 0, At, B0); PG8_MMA(1, 1, At, B1); PG8_BAR; PG8_SCHED;
            PG8_LDB(B0, 1, 0); PG8_LDB(B1, 1, 1); PG8_SCHED; PG8_LDA(At, 1, 0); PG8_STAGE(PG8_SA(0, 1), a2_1, vA1);
            PG8_WAIT_V(8); PG8_WAIT_L(0); PG8_BAR; PG8_MMA(0, 0, At, B0); PG8_MMA(0, 1, At, B1); PG8_BAR; PG8_SCHED;
            PG8_LDA(At, 1, 1); PG8_STAGE(PG8_SB(1, 0), b3_0, voffB); PG8_STAGE(PG8_SB(1, 1), b3_1, voffB); PG8_STAGE(PG8_SA(1, 0), a3_0, vA0);
            PG8_WAIT_V(8); PG8_WAIT_L(0); PG8_BAR; PG8_MMA(1, 0, At, B0); PG8_MMA(1, 1, At, B1); PG8_BAR; PG8_SCHED;
        }
        if (wr == 0) PG8_BAR;
        if (ESZ == 1) asm volatile("s_nop 15\n\ts_nop 15" ::: "memory");
        if constexpr (Epi::STAGED) E.staged(acc, cur, wr, wc, fr, fq, lds, tid); else E(acc, cur, wr, wc, fr, fq);
        if (!has_next) break;
#pragma unroll
        for (int a = 0; a < 2; ++a)
#pragma unroll
            for (int b = 0; b < 2; ++b)
#pragma unroll
                for (int m = 0; m < 4; ++m)
#pragma unroll
                    for (int n = 0; n < 2; ++n) acc[a][b][m][n] = (f32x4){0.f, 0.f, 0.f, 0.f};
        cur = nxt; cA0 = nA0; cA1 = nA1; cB0 = nB0; cB1 = nB1; ++ui;
        if (GATHER) { cvA0[0] = nvA0[0]; cvA0[1] = nvA0[1]; cvA1[0] = nvA1[0]; cvA1[1] = nvA1[1]; }
        if (wr == 1) PG8_BAR;
    }
    PG8_WAIT_V(0);
    PG8_BAR;
#undef G8_VOFF
#undef PG8_SA
#undef PG8_SB
#undef PG8_STAGE
#undef PG8_LDA
#undef PG8_LDB
#undef PG8_MMA
#undef PG8_WAIT_V
#undef PG8_WAIT_L
#undef PG8_BAR
#undef PG8_SCHED
}
}


template <bool F8>
__device__ __forceinline__ void convert_big(LAS unsigned char* lds, const float* src, void* dstv, int K, int N, int batch, float scale) {
    const int tid = tid_(), lane = tid & 63, wid = tid >> 6;
    const int nbn = N / 256, per = (K / 128) * nbn, total = per * batch, G = (int)gridDim.x;
    constexpr int ESZ = F8 ? 1 : 2, ROWB = 128 * ESZ, TILEB = 256 * ROWB;
    f32x4 ra[16], rb[16];
#define CV_LOAD(uu, reg) do { const int bidx = (uu) / per, r_ = (uu) % per, kb = r_ / nbn, nb = r_ % nbn; \
        const float* sp = src + (size_t)bidx * K * N + (size_t)(kb * 128 + 16 * wid) * N + nb * 256 + 4 * lane; \
        _Pragma("unroll") for (int i = 0; i < 16; ++i) reg[i] = *(const f32x4*)(sp + (size_t)i * N); } while (0)
#define CV_PACK(reg, tl) do { _Pragma("unroll") for (int j = 0; j < 4; ++j) { \
        if (F8) { u32x4 w0; w0.x = pk_fp8x4(reg[0][j] * scale, reg[1][j] * scale, reg[2][j] * scale, reg[3][j] * scale); w0.y = pk_fp8x4(reg[4][j] * scale, reg[5][j] * scale, reg[6][j] * scale, reg[7][j] * scale); \
            w0.z = pk_fp8x4(reg[8][j] * scale, reg[9][j] * scale, reg[10][j] * scale, reg[11][j] * scale); w0.w = pk_fp8x4(reg[12][j] * scale, reg[13][j] * scale, reg[14][j] * scale, reg[15][j] * scale); \
            *(LAS u32x4*)((tl) + (4 * lane + j) * ROWB + ((wid ^ (lane & 7)) * 16)) = w0; } \
        else { u32x4 w0, w1; \
            w0.x = g8::cvt_pk_bf16(reg[0][j], reg[1][j]); w0.y = g8::cvt_pk_bf16(reg[2][j], reg[3][j]); w0.z = g8::cvt_pk_bf16(reg[4][j], reg[5][j]); w0.w = g8::cvt_pk_bf16(reg[6][j], reg[7][j]); \
            w1.x = g8::cvt_pk_bf16(reg[8][j], reg[9][j]); w1.y = g8::cvt_pk_bf16(reg[10][j], reg[11][j]); w1.z = g8::cvt_pk_bf16(reg[12][j], reg[13][j]); w1.w = g8::cvt_pk_bf16(reg[14][j], reg[15][j]); \
            *(LAS u32x4*)((tl) + (4 * lane + j) * ROWB + (((2 * wid) ^ (lane & 15)) * 16)) = w0; *(LAS u32x4*)((tl) + (4 * lane + j) * ROWB + (((2 * wid + 1) ^ (lane & 15)) * 16)) = w1; } } } while (0)
#define CV_STORE(uu, tl) do { const int bidx = (uu) / per, r_ = (uu) % per, kb = r_ / nbn, nb = r_ % nbn; \
        unsigned char* dp = (unsigned char*)dstv + ((size_t)bidx * N * K + (size_t)(nb * 256) * K + kb * 128) * ESZ; \
        _Pragma("unroll") for (int i = 0; i < 4 * ESZ; ++i) { const int pc = tid + NTHREADS * i, n = pc / (8 * ESZ), c = pc % (8 * ESZ); \
            *(u32x4*)(dp + (size_t)n * K * ESZ + c * 16) = *(const LAS u32x4*)((tl) + n * ROWB + ((c ^ ((n >> 2) & (8 * ESZ - 1))) * 16)); } } while (0)
    const int u0 = blockIdx.x;
    if (u0 < total) CV_LOAD(u0, ra);
    if (u0 + G < total) CV_LOAD(u0 + G, rb);
    for (int u = u0; u < total; u += 2 * G) {
        CV_PACK(ra, lds);
        if (u + 2 * G < total) CV_LOAD(u + 2 * G, ra);
        __syncthreads();
        CV_STORE(u, lds);
        const bool has_b = (u + G < total);
        if (has_b) { CV_PACK(rb, lds + TILEB); if (u + 3 * G < total) CV_LOAD(u + 3 * G, rb); }
        __syncthreads();
        if (has_b) CV_STORE(u + G, lds + TILEB);
    }
    __syncthreads();
#undef CV_LOAD
#undef CV_PACK
#undef CV_STORE
}

__device__ __forceinline__ float gelu_fast(float x) { const float u2 = 1.5957691216057308f * (x + 0.044715f * x * x * x); return x * __builtin_amdgcn_rcpf(1.0f + __builtin_amdgcn_exp2f(-1.4426950408889634f * u2)); }
__device__ __forceinline__ void lru_gates_phase(LAS unsigned char* lds, const Params& p, int idx) {
    const int tid = tid_(), lane = tid & 63, wid = tid >> 6, fr = lane & 15, fq = lane >> 4;
    LAS bf16_t* xcb = (LAS bf16_t*)lds;
    LAS float* xcf = (LAS float*)(lds + 17408);
    LAS float* sa = (LAS float*)(lds + 17408 + 33792);
    LAS float* sb = sa + 64 * 132;
    LAS float* comb = sb + 64 * 132;
    const bf16_t* u = (const bf16_t*)(p.ws + WS_U);
    bf16_t* Carr = (bf16_t*)(p.ws + WS_SCR); bf16_t* Barr = Carr + (size_t)T * D;
    float* SP = (float*)(p.ws + WS_LSUM); float* SH = SP + NBATCH * 32 * D;
    const int hd = blockIdx.x & 7, slot = blockIdx.x >> 3, nslots = gridDim.x >> 3;
    const float* conv_w = p.a_conv_w + (size_t)idx * 4 * D; const float* conv_b = p.a_conv_b + (size_t)idx * D;
    const bf16_t* wrt = (const bf16_t*)(p.ws + WS_AGT) + ((size_t)(idx * 2 + 0) * 8 + hd) * 128 * 128;
    const bf16_t* wit = (const bf16_t*)(p.ws + WS_AGT) + ((size_t)(idx * 2 + 1) * 8 + hd) * 128 * 128;
    bf16x8 Br[4], Bi[4];
#pragma unroll
    for (int ks = 0; ks < 4; ++ks) { Br[ks] = *(const bf16x8*)(wrt + (size_t)(16 * wid + fr) * 128 + 32 * ks + 8 * fq); Bi[ks] = *(const bf16x8*)(wit + (size_t)(16 * wid + fr) * 128 + 32 * ks + 8 * fq); }
    const int cg = hd * 128 + 16 * wid + 4 * fq;
    const f32x4 brv = *(const f32x4*)(p.a_b_rgate + (size_t)idx * D + cg), biv = *(const f32x4*)(p.a_b_igate + (size_t)idx * D + cg), lmv = *(const f32x4*)(p.a_lambda + (size_t)idx * D + cg);
    f32x4 spv;
#pragma unroll
    for (int r = 0; r < 4; ++r) spv[r] = (lmv[r] > 15.f) ? __expf(-lmv[r]) : log1pf(__expf(-lmv[r]));
    const int cc = (tid & 31) * 4, cch = hd * 128 + cc;
    f32x4 cw[4];
#pragma unroll
    for (int j = 0; j < 4; ++j) cw[j] = *(const f32x4*)(conv_w + j * D + cch);
    const f32x4 cb = *(const f32x4*)(conv_b + cch);
    for (int tile = slot; tile < T / 64; tile += nslots) {
        const int t0 = tile * 64;
#pragma unroll
        for (int k = 0; k < 4; ++k) {
            const int tl = (tid >> 5) + 16 * k, t = t0 + tl, s_ = t & (SEQ - 1);
            f32x4 acc = cb;
#pragma unroll
            for (int j = 0; j < 4; ++j) {
                if (s_ - 3 + j >= 0) {
                    const u32x2 rv = *(const u32x2*)(u + (size_t)(t - 3 + j) * 2048 + 1024 + cch);
                    acc[0] += cw[j][0] * __uint_as_float(rv.x << 16); acc[1] += cw[j][1] * __uint_as_float(rv.x & 0xffff0000u);
                    acc[2] += cw[j][2] * __uint_as_float(rv.y << 16); acc[3] += cw[j][3] * __uint_as_float(rv.y & 0xffff0000u);
                }
            }
            *(LAS f32x4*)(xcf + tl * 132 + cc) = acc;
            u32x2 w; w.x = pack2(acc[0], acc[1]); w.y = pack2(acc[2], acc[3]);
            *(LAS u32x2*)(xcb + tl * 136 + cc) = w;
        }
        __syncthreads();
        f32x4 ar[4], ai[4];
#pragma unroll
        for (int mt = 0; mt < 4; ++mt) { ar[mt] = (f32x4){0.f, 0.f, 0.f, 0.f}; ai[mt] = (f32x4){0.f, 0.f, 0.f, 0.f}; }
#pragma unroll
        for (int ks = 0; ks < 4; ++ks)
#pragma unroll
            for (int mt = 0; mt < 4; ++mt) {
                const bf16x8 af = *(const LAS bf16x8*)(xcb + (mt * 16 + fr) * 136 + 32 * ks + 8 * fq);
                ar[mt] = __builtin_amdgcn_mfma_f32_16x16x32_bf16(Br[ks], af, ar[mt], 0, 0, 0);
                ai[mt] = __builtin_amdgcn_mfma_f32_16x16x32_bf16(Bi[ks], af, ai[mt], 0, 0, 0);
            }
#pragma unroll
        for (int mt = 0; mt < 4; ++mt) {
            const int tl = mt * 16 + fr, cl = 16 * wid + 4 * fq;
            const f32x4 rec = *(const LAS f32x4*)(xcf + tl * 132 + cl);
            f32x4 av, bv, cv;
#pragma unroll
            for (int r = 0; r < 4; ++r) {
                const float rg = sigmoidf_(ar[mt][r] + brv[r]), ig = sigmoidf_(ai[mt][r] + biv[r]);
                const float xl = -8.0f * rg * spv[r];
                const float cex = -xl * (1.0f + xl * (0.5f + xl * (0.16666667f + xl * (0.041666668f + xl * 0.0083333338f))));
                const float cc_ = bf2f(f2bf(cex));
                av[r] = 1.0f - cc_; cv[r] = cc_;
                bv[r] = bf2f(f2bf(__builtin_amdgcn_sqrtf(fmaxf(cex * (2.0f - cex), 0.f)) * ig * rec[r]));
            }
            { u32x2 wc_, wb_; wc_.x = pack2(cv[0], cv[1]); wc_.y = pack2(cv[2], cv[3]); wb_.x = pack2(bv[0], bv[1]); wb_.y = pack2(bv[2], bv[3]);
              *(u32x2*)(Carr + (size_t)(t0 + tl) * D + cg) = wc_; *(u32x2*)(Barr + (size_t)(t0 + tl) * D + cg) = wb_; }
            *(LAS f32x4*)(sa + tl * 132 + cl) = av; *(LAS f32x4*)(sb + tl * 132 + cl) = bv;
        }
        __syncthreads();
        {
            const int j = tid & 127, q = tid >> 7;
            float P = 1.f, H = 0.f;
#pragma unroll
            for (int s_ = 0; s_ < 16; ++s_) { const float a = sa[(q * 16 + s_) * 132 + j], bb = sb[(q * 16 + s_) * 132 + j]; H = a * H + bb; P *= a; }
            comb[(q * 128 + j) * 2 + 0] = P; comb[(q * 128 + j) * 2 + 1] = H;
        }
        __syncthreads();
        if (tid < 128) {
            float P = comb[tid * 2], H = comb[tid * 2 + 1];
#pragma unroll
            for (int q = 1; q < 4; ++q) { const float Pq = comb[(q * 128 + tid) * 2], Hq = comb[(q * 128 + tid) * 2 + 1]; H = Pq * H + Hq; P *= Pq; }
            SP[(size_t)tile * D + hd * 128 + tid] = P; SH[(size_t)tile * D + hd * 128 + tid] = H;
        }
    }
}
__device__ __forceinline__ void lru_scan_phase(const Params& p) {
    const int tid = tid_();
    const bf16_t* u = (const bf16_t*)(p.ws + WS_U);
    const bf16_t* Carr = (const bf16_t*)(p.ws + WS_SCR); const bf16_t* Barr = Carr + (size_t)T * D;
    const float* SP = (const float*)(p.ws + WS_LSUM); const float* SH = SP + NBATCH * 32 * D;
    bf16_t* yin = (bf16_t*)(p.ws + WS_YIN);
    typedef float f32x2 __attribute__((ext_vector_type(2)));
    for (int tile = blockIdx.x; tile < NBATCH * 32; tile += gridDim.x) {
        const int c = 2 * tid, b = tile >> 5, chunk = tile & 31;
        f32x2 sp[31], sh[31];
#pragma unroll
        for (int k = 0; k < 31; ++k) { const bool on = k < chunk; const size_t o = (size_t)(b * 32 + (on ? k : 0)) * D + c;
            sp[k] = *(const f32x2*)(SP + o); sh[k] = *(const f32x2*)(SH + o); if (!on) { sp[k] = (f32x2){1.f, 1.f}; sh[k] = (f32x2){0.f, 0.f}; } }
        float h0 = 0.f, h1 = 0.f;
#pragma unroll
        for (int k = 0; k < 31; ++k) { h0 = sp[k][0] * h0 + sh[k][0]; h1 = sp[k][1] * h1 + sh[k][1]; }
        const size_t tb = (size_t)tile * 64;
#pragma unroll 16
        for (int s_ = 0; s_ < 64; ++s_) {
            const size_t t = tb + s_;
            const unsigned cw = *(const unsigned*)(Carr + t * D + c), bw = *(const unsigned*)(Barr + t * D + c), gw = *(const unsigned*)(u + t * 2048 + c);
            h0 = (1.0f - __uint_as_float(cw << 16)) * h0 + __uint_as_float(bw << 16);
            h1 = (1.0f - __uint_as_float(cw & 0xffff0000u)) * h1 + __uint_as_float(bw & 0xffff0000u);
            *(unsigned*)(yin + t * D + c) = pack2(gelu_fast(__uint_as_float(gw << 16)) * h0, gelu_fast(__uint_as_float(gw & 0xffff0000u)) * h1);
        }
    }
}

typedef short s16x4 __attribute__((ext_vector_type(4)));
__device__ __forceinline__ s16x4 tr4(LAS const unsigned char* base, int row0, int col0, int stride, int lane) {
    const int q = (lane & 15) >> 2, pp = lane & 3;
    return __builtin_amdgcn_ds_read_tr16_b64_v4i16((LAS s16x4*)(base + (row0 + q) * stride + (col0 + 4 * pp) * 2));
}
__device__ __forceinline__ bf16x8 cat8(s16x4 a, s16x4 b) { return (bf16x8){a[0], a[1], a[2], a[3], b[0], b[1], b[2], b[3]}; }
__device__ __forceinline__ void ret_core_phase(LAS unsigned char* lds, const Params& p) {
    const int tid0_ = tid_(); const int tid = tid0_, lane = tid & 63, wid = tid >> 6, fr = lane & 15, fq = lane >> 4;
    constexpr int KS = 528, VS = 160, SS = 528;
    LAS unsigned char* Kl = lds;
    LAS unsigned char* Vl = lds + 128 * KS;
    LAS unsigned char* Sl = Vl + 128 * VS;
    const bf16_t* ul_ = (const bf16_t*)(p.ws + WS_U);
    bf16_t* RO = (bf16_t*)(p.ws + WS_SCR);
    for (int un = blockIdx.x; un < NBATCH * 4 * 8; un += gridDim.x) {
        const int b = un >> 5, h = (un >> 3) & 3, vs = un & 7;
        const float lg2 = log2f(1.0f - exp2f(-5.0f - (float)h));
        f32x4 Sacc[2][4];
#pragma unroll
        for (int dt = 0; dt < 2; ++dt)
#pragma unroll
            for (int vt = 0; vt < 4; ++vt) Sacc[dt][vt] = (f32x4){0.f, 0.f, 0.f, 0.f};
        for (int i = tid; i < 64 * SS / 16; i += NTHREADS) ((LAS u32x4*)Sl)[i] = (u32x4){0u, 0u, 0u, 0u};
        u32x4 kraw[8], vraw[2]; bf16x8 Qf[8];
#define RET_LOAD(ch_) do { const size_t tl_ = (size_t)b * SEQ + (ch_) * 128; const bf16_t* u = ul_; int tid = tid0_; asm volatile("" : "+s"(u), "+v"(tid));     \
            _Pragma("unroll") for (int i = 0; i < 8; ++i) { const int piece = tid + NTHREADS * i, m = piece >> 5, ch = piece & 31; kraw[i] = *(const u32x4*)(u + (tl_ + m) * 6144 + 1024 + h * 256 + ch * 8); } \
            _Pragma("unroll") for (int i = 0; i < 2; ++i) { const int piece = tid + NTHREADS * i, m = piece >> 3, ch = piece & 7; vraw[i] = *(const u32x4*)(u + (tl_ + m) * 6144 + 2048 + h * 512 + vs * 64 + ch * 8); } } while (0)
#define RET_LOADQ(ch_) do { const size_t tl_ = (size_t)b * SEQ + (ch_) * 128; const bf16_t* u = ul_; int tid = tid0_; asm volatile("" : "+s"(u), "+v"(tid)); const int wid = tid >> 6, fr = tid & 15, fq = (tid & 63) >> 4; \
            _Pragma("unroll") for (int ks = 0; ks < 8; ++ks) Qf[ks] = *(const bf16x8*)(u + (tl_ + 16 * wid + fr) * 6144 + h * 256 + 32 * ks + 8 * fq); } while (0)
        RET_LOAD(0); RET_LOADQ(0);
        for (int chunk = 0; chunk < 16; ++chunk) {
            const size_t t0 = (size_t)b * SEQ + chunk * 128;
            int tst = tid0_; asm volatile("" : "+v"(tst));
#pragma unroll
            for (int i = 0; i < 8; ++i) {
                const int piece = tst + NTHREADS * i, m = piece >> 5, ch = piece & 31;
                const u32x4 kv = kraw[i];
                const float sc = exp2f(-(float)(m + 1) * lg2) * 0.0625f;
                u32x4 w;
                w.x = pack2(__uint_as_float(kv.x << 16) * sc, __uint_as_float(kv.x & 0xffff0000u) * sc); w.y = pack2(__uint_as_float(kv.y << 16) * sc, __uint_as_float(kv.y & 0xffff0000u) * sc);
                w.z = pack2(__uint_as_float(kv.z << 16) * sc, __uint_as_float(kv.z & 0xffff0000u) * sc); w.w = pack2(__uint_as_float(kv.w << 16) * sc, __uint_as_float(kv.w & 0xffff0000u) * sc);
                *(LAS u32x4*)(Kl + m * KS + ch * 16) = w;
            }
#pragma unroll
            for (int i = 0; i < 2; ++i) {
                const int piece = tst + NTHREADS * i, m = piece >> 3, ch = piece & 7;
                *(LAS u32x4*)(Vl + m * VS + ch * 16) = vraw[i];
            }
            __syncthreads();
            if (chunk + 1 < 16) RET_LOAD(chunk + 1);
            f32x4 sc[8];
#pragma unroll
            for (int mt = 0; mt < 8; ++mt) {
                sc[mt] = (f32x4){0.f, 0.f, 0.f, 0.f};
#pragma unroll
                for (int ks = 0; ks < 8; ++ks) {
                    const bf16x8 kf = *(const LAS bf16x8*)(Kl + (16 * mt + fr) * KS + (32 * ks + 8 * fq) * 2);
                    sc[mt] = __builtin_amdgcn_mfma_f32_16x16x32_bf16(kf, Qf[ks], sc[mt], 0, 0, 0);
                }
                if (mt & 1) __builtin_amdgcn_sched_barrier(0);
            }
            bf16x8 pf[4];
            const int nloc = 16 * wid + fr;
#pragma unroll
            for (int ks2 = 0; ks2 < 4; ++ks2) {
                float v[8];
#pragma unroll
                for (int t = 0; t < 2; ++t)
#pragma unroll
                    for (int r = 0; r < 4; ++r) { const int m = 32 * ks2 + 16 * t + 4 * fq + r; v[4 * t + r] = (m <= nloc) ? sc[2 * ks2 + t][r] : 0.f; }
                u32x4 w; w.x = pack2(v[0], v[1]); w.y = pack2(v[2], v[3]); w.z = pack2(v[4], v[5]); w.w = pack2(v[6], v[7]);
                pf[ks2] = __builtin_bit_cast(bf16x8, w);
            }
            f32x4 O[4];
#pragma unroll
            for (int vt = 0; vt < 4; ++vt) {
                O[vt] = (f32x4){0.f, 0.f, 0.f, 0.f};
#pragma unroll
                for (int ks2 = 0; ks2 < 4; ++ks2) {
                    const bf16x8 vf = cat8(tr4(Vl, 32 * ks2 + 4 * fq, 16 * vt, VS, lane), tr4(Vl, 32 * ks2 + 16 + 4 * fq, 16 * vt, VS, lane));
                    O[vt] = __builtin_amdgcn_mfma_f32_16x16x32_bf16(pf[ks2], vf, O[vt], 0, 0, 0);
                }
#pragma unroll
                for (int ks = 0; ks < 8; ++ks) {
                    const bf16x8 sf = *(const LAS bf16x8*)(Sl + (16 * vt + fr) * SS + (32 * ks + 8 * fq) * 2);
                    O[vt] = __builtin_amdgcn_mfma_f32_16x16x32_bf16(Qf[ks], sf, O[vt], 0, 0, 0);
                }
                __builtin_amdgcn_sched_barrier(0);
            }
#pragma unroll
            for (int r = 0; r < 4; ++r) {
                const int n = 16 * wid + 4 * fq + r;
                const float qd = exp2f((float)(n + 1) * lg2);
                bf16_t* op = RO + (t0 + n) * 2048 + h * 512 + vs * 64 + fr;
#pragma unroll
                for (int vt = 0; vt < 4; ++vt) op[16 * vt] = f2bf(O[vt][r] * qd);
            }
            if (chunk + 1 < 16) RET_LOADQ(chunk + 1);
#pragma unroll
            for (int ks3 = 0; ks3 < 4; ++ks3) {
                bf16x8 kt[2], vf[4];
#pragma unroll
                for (int dt = 0; dt < 2; ++dt) kt[dt] = cat8(tr4(Kl, 32 * ks3 + 8 * fq, 32 * wid + 16 * dt, KS, lane), tr4(Kl, 32 * ks3 + 8 * fq + 4, 32 * wid + 16 * dt, KS, lane));
#pragma unroll
                for (int vt = 0; vt < 4; ++vt) vf[vt] = cat8(tr4(Vl, 32 * ks3 + 8 * fq, 16 * vt, VS, lane), tr4(Vl, 32 * ks3 + 8 * fq + 4, 16 * vt, VS, lane));
#pragma unroll
                for (int dt = 0; dt < 2; ++dt)
#pragma unroll
                    for (int vt = 0; vt < 4; ++vt) Sacc[dt][vt] = __builtin_amdgcn_mfma_f32_16x16x32_bf16(kt[dt], vf[vt], Sacc[dt][vt], 0, 0, 0);
                __builtin_amdgcn_sched_barrier(0);
            }
            __syncthreads();
            const float cd = exp2f(128.0f * lg2);
#pragma unroll
            for (int dt = 0; dt < 2; ++dt)
#pragma unroll
                for (int vt = 0; vt < 4; ++vt) {
                    Sacc[dt][vt] *= cd;
                    u32x2 w; w.x = pack2(Sacc[dt][vt][0], Sacc[dt][vt][1]); w.y = pack2(Sacc[dt][vt][2], Sacc[dt][vt][3]);
                    *(LAS u32x2*)(Sl + (16 * vt + fr) * SS + (32 * wid + 16 * dt + 4 * fq) * 2) = w;
                }
        }
        __syncthreads();
#undef RET_LOAD
#undef RET_LOADQ
    }
}
__device__ __forceinline__ void ret_norm_phase(LAS unsigned char* lds, const Params& p) {
    const int tid = tid_(), lane = tid & 63, wid = tid >> 6;
    const bf16_t* u = (const bf16_t*)(p.ws + WS_U);
    const bf16_t* RO = (const bf16_t*)(p.ws + WS_SCR);
    bf16_t* yin = (bf16_t*)(p.ws + WS_YIN);
    const int nwu = T * 4, stride = (int)gridDim.x * 8;
    for (int wu0 = blockIdx.x * 8 + wid; wu0 < nwu; wu0 += 2 * stride) {
        u32x4 ov[2], gv[2];
#pragma unroll
        for (int q = 0; q < 2; ++q) { const int wu = wu0 + q * stride; const size_t t = (size_t)(wu >> 2); const int h = wu & 3;
            if (wu < nwu) { ov[q] = *(const u32x4*)(RO + t * 2048 + h * 512 + lane * 8); gv[q] = *(const u32x4*)(u + t * 6144 + 4096 + h * 512 + lane * 8); } }
#pragma unroll
        for (int q = 0; q < 2; ++q) { const int wu = wu0 + q * stride; const size_t t = (size_t)(wu >> 2); const int h = wu & 3;
            if (wu < nwu) {
                float o[8], g[8];
                o[0] = __uint_as_float(ov[q].x << 16); o[1] = __uint_as_float(ov[q].x & 0xffff0000u); o[2] = __uint_as_float(ov[q].y << 16); o[3] = __uint_as_float(ov[q].y & 0xffff0000u);
                o[4] = __uint_as_float(ov[q].z << 16); o[5] = __uint_as_float(ov[q].z & 0xffff0000u); o[6] = __uint_as_float(ov[q].w << 16); o[7] = __uint_as_float(ov[q].w & 0xffff0000u);
                g[0] = __uint_as_float(gv[q].x << 16); g[1] = __uint_as_float(gv[q].x & 0xffff0000u); g[2] = __uint_as_float(gv[q].y << 16); g[3] = __uint_as_float(gv[q].y & 0xffff0000u);
                g[4] = __uint_as_float(gv[q].z << 16); g[5] = __uint_as_float(gv[q].z & 0xffff0000u); g[6] = __uint_as_float(gv[q].w << 16); g[7] = __uint_as_float(gv[q].w & 0xffff0000u);
                float ss = 0.f;
#pragma unroll
                for (int j = 0; j < 8; ++j) ss += o[j] * o[j];
                const float rstd = rsqrtf(wave_sum(ss) * (1.0f / 512.0f) + 1e-6f);
                float y[8];
#pragma unroll
                for (int j = 0; j < 8; ++j) y[j] = g[j] * sigmoidf_(g[j]) * o[j] * rstd;
                u32x4 w; w.x = pack2(y[0], y[1]); w.y = pack2(y[2], y[3]); w.z = pack2(y[4], y[5]); w.w = pack2(y[6], y[7]);
                *(u32x4*)(yin + t * 2048 + h * 512 + lane * 8) = w;
            } }
    }
}

__device__ __forceinline__ void attn_core_phase(LAS unsigned char* lds, const Params& p) {
    const int tid0_ = tid_(); const int tid = tid0_, lane = tid & 63, wid = tid >> 6, fr = lane & 15, fq = lane >> 4;
    constexpr int RS = 144, TILE = 272 * RS;
    LAS unsigned char* Kl = lds;
    LAS unsigned char* Vl = lds + TILE;
    const bf16_t* u = (const bf16_t*)(p.ws + WS_U);
    bf16_t* OP = (bf16_t*)(p.ws + WS_SCR);
    float* LSE = (float*)(p.ws + WS_SCR + 96 * MB);
    for (int i = tid; i < 16 * RS / 16; i += NTHREADS) { ((LAS u32x4*)(Kl + 256 * RS))[i] = (u32x4){0u, 0u, 0u, 0u}; ((LAS u32x4*)(Vl + 256 * RS))[i] = (u32x4){0u, 0u, 0u, 0u}; }
    u32x4 kraw[4], vraw[4]; bf16x8 Qn[2];
#define ATT_DECODE(un_) const int g = (un_) >> 11, rem = (un_) & 2047, b = rem >> 8, h = (rem >> 4) & 15, x = rem & 15; \
        const int dl = (g == 0) ? 1 : (g == 1 ? 4 : 16), r_ = x & (dl - 1), n = x / dl
#define ATT_LOAD(un_) do { ATT_DECODE(un_); int tl_ = tid0_; const bf16_t* ub = u; asm volatile("" : "+v"(tl_), "+s"(ub)); ub += (size_t)b * SEQ * 9216; \
        _Pragma("unroll") for (int i = 0; i < 4; ++i) { const int piece = tl_ + NTHREADS * i, row = piece >> 3, ch = piece & 7; const int sk = ((n - 1) * 128 + row) * dl + r_; \
            kraw[i] = (u32x4){0u, 0u, 0u, 0u}; vraw[i] = (u32x4){0u, 0u, 0u, 0u}; \
            if (sk >= 0) { const bf16_t* src = ub + (size_t)sk * 9216 + h * 64 + ch * 8; kraw[i] = *(const u32x4*)(src + (3 + g) * 1024); vraw[i] = *(const u32x4*)(src + (6 + g) * 1024); } } \
        { const int sq_ = (n * 128 + 16 * (tl_ >> 6) + (tl_ & 15)) * dl + r_; \
          _Pragma("unroll") for (int ks = 0; ks < 2; ++ks) Qn[ks] = *(const bf16x8*)(ub + (size_t)sq_ * 9216 + g * 1024 + h * 64 + 32 * ks + 8 * ((tl_ & 63) >> 4)); } } while (0)
    if ((int)blockIdx.x < 3 * 2048) ATT_LOAD((int)blockIdx.x);
    for (int un = blockIdx.x; un < 3 * 2048; un += gridDim.x) {
        ATT_DECODE(un);
        const float slope = exp2f(-0.5f * (float)(h + 1)) * (float)dl;
        { int tl_ = tid0_; asm volatile("" : "+v"(tl_));
#pragma unroll
          for (int i = 0; i < 4; ++i) {
            const int piece = tl_ + NTHREADS * i, row = piece >> 3, ch = piece & 7;
            *(LAS u32x4*)(Kl + row * RS + ch * 16) = kraw[i]; *(LAS u32x4*)(Vl + row * RS + ch * 16) = vraw[i];
          } }
        const int qi = 16 * wid + fr, sq = (n * 128 + qi) * dl + r_;
        bf16x8 Qf[2];
#pragma unroll
        for (int ks = 0; ks < 2; ++ks) Qf[ks] = Qn[ks];
        __syncthreads();
        if (un + (int)gridDim.x < 3 * 2048) ATT_LOAD(un + (int)gridDim.x);
        f32x4 sc[9];
        float mx = -INFINITY;
#pragma unroll
        for (int kt = 0; kt < 9; ++kt) {
            sc[kt] = (f32x4){0.f, 0.f, 0.f, 0.f};
#pragma unroll
            for (int ks = 0; ks < 2; ++ks) {
                const bf16x8 kf = *(const LAS bf16x8*)(Kl + (16 * (wid + kt) + fr) * RS + (32 * ks + 8 * fq) * 2);
                sc[kt] = __builtin_amdgcn_mfma_f32_16x16x32_bf16(kf, Qf[ks], sc[kt], 0, 0, 0);
            }
#pragma unroll
            for (int r = 0; r < 4; ++r) {
                const int ki = 16 * (wid + kt) + 4 * fq + r, steps = qi + 128 - ki;
                const bool ok = (steps >= 0) && (steps <= 128) && (n > 0 || ki >= 128);
                const float v = ok ? sc[kt][r] * 0.125f - slope * (float)steps : -INFINITY;
                sc[kt][r] = v; mx = fmaxf(mx, v);
            }
        }
        mx = fmaxf(mx, __shfl_xor(mx, 16)); mx = fmaxf(mx, __shfl_xor(mx, 32));
        float l = 0.f;
#pragma unroll
        for (int kt = 0; kt < 9; ++kt)
#pragma unroll
            for (int r = 0; r < 4; ++r) { const float pv = __expf(sc[kt][r] - mx); sc[kt][r] = pv; l += pv; }
        l += __shfl_xor(l, 16); l += __shfl_xor(l, 32);
        f32x4 O[4];
#pragma unroll
        for (int dt = 0; dt < 4; ++dt) O[dt] = (f32x4){0.f, 0.f, 0.f, 0.f};
#pragma unroll
        for (int ks5 = 0; ks5 < 5; ++ks5) {
            const f32x4 p0 = sc[2 * ks5], p1 = (ks5 < 4) ? sc[(ks5 < 4) ? 2 * ks5 + 1 : 0] : (f32x4){0.f, 0.f, 0.f, 0.f};
            u32x4 w; w.x = pack2(p0[0], p0[1]); w.y = pack2(p0[2], p0[3]); w.z = pack2(p1[0], p1[1]); w.w = pack2(p1[2], p1[3]);
            const bf16x8 pf = __builtin_bit_cast(bf16x8, w);
#pragma unroll
            for (int dt = 0; dt < 4; ++dt) {
                const bf16x8 vf = cat8(tr4(Vl, 16 * (wid + 2 * ks5) + 4 * fq, 16 * dt, RS, lane), tr4(Vl, 16 * (wid + 2 * ks5 + 1) + 4 * fq, 16 * dt, RS, lane));
                O[dt] = __builtin_amdgcn_mfma_f32_16x16x32_bf16(vf, pf, O[dt], 0, 0, 0);
            }
        }
        const float inv = __builtin_amdgcn_rcpf(l);
        const size_t tq = (size_t)b * SEQ + sq;
#pragma unroll
        for (int dt = 0; dt < 4; ++dt) {
            u32x2 w; w.x = pack2(O[dt][0] * inv, O[dt][1] * inv); w.y = pack2(O[dt][2] * inv, O[dt][3] * inv);
            *(u32x2*)(OP + ((size_t)g * T + tq) * D + h * 64 + 16 * dt + 4 * fq) = w;
        }
        if (fq == 0) LSE[((size_t)g * T + tq) * 16 + h] = mx + __logf(l);
        __syncthreads();
    }
#undef ATT_DECODE
#undef ATT_LOAD
}
__device__ __forceinline__ void attn_merge_phase(const Params& p) {
    const int tid = tid_();
    const bf16_t* OP = (const bf16_t*)(p.ws + WS_SCR);
    const float* LSE = (const float*)(p.ws + WS_SCR + 96 * MB);
    bf16_t* yin = (bf16_t*)(p.ws + WS_YIN);
    const size_t n = (size_t)T * D / 8, stride = (size_t)gridDim.x * NTHREADS;
    for (size_t i0 = (size_t)blockIdx.x * NTHREADS + tid; i0 < n; i0 += 2 * stride) {
        u32x4 a[2], bq[2], c[2]; float l0[2], l1[2], l2[2];
#pragma unroll
        for (int q = 0; q < 2; ++q) { const size_t i = i0 + q * stride; if (i < n) { const size_t t = i >> 7; const int c8 = (int)(i & 127), h = c8 >> 3;
            l0[q] = LSE[t * 16 + h]; l1[q] = LSE[((size_t)T + t) * 16 + h]; l2[q] = LSE[((size_t)2 * T + t) * 16 + h];
            a[q] = *(const u32x4*)(OP + t * D + c8 * 8); bq[q] = *(const u32x4*)(OP + ((size_t)T + t) * D + c8 * 8); c[q] = *(const u32x4*)(OP + ((size_t)2 * T + t) * D + c8 * 8); } }
#pragma unroll
        for (int q = 0; q < 2; ++q) { const size_t i = i0 + q * stride; if (i < n) { const size_t t = i >> 7; const int c8 = (int)(i & 127);
            const float m = fmaxf(l0[q], fmaxf(l1[q], l2[q]));
            float w0 = __expf(l0[q] - m), w1 = __expf(l1[q] - m), w2 = __expf(l2[q] - m);
            const float inv = __builtin_amdgcn_rcpf(w0 + w1 + w2); w0 *= inv; w1 *= inv; w2 *= inv;
            u32x4 o;
#define MRG(f) o.f = pack2(w0 * __uint_as_float(a[q].f << 16) + w1 * __uint_as_float(bq[q].f << 16) + w2 * __uint_as_float(c[q].f << 16), \
                           w0 * __uint_as_float(a[q].f & 0xffff0000u) + w1 * __uint_as_float(bq[q].f & 0xffff0000u) + w2 * __uint_as_float(c[q].f & 0xffff0000u))
            MRG(x); MRG(y); MRG(z); MRG(w);
#undef MRG
            *(u32x4*)(yin + t * D + c8 * 8) = o; } }
    }
}

__device__ __forceinline__ void ln1_router_phase(LAS unsigned char* lds, const Params& p, int layer) {
    const int tid = tid_(), lane = tid & 63, wid = tid >> 6, fr = lane & 15, fq = lane >> 4;
    constexpr int XS = 2064;
    LAS unsigned char* xh = lds;
    LAS unsigned char* xl = lds + 16 * XS;
    LAS float* part = (LAS float*)(lds + 32 * XS);
    LAS float* logit = part + 8 * 16 * 32;
    LAS int* tkE = (LAS int*)(logit + 16 * 32);
    LAS int* tkR = tkE + 512;
    LAS int* hist = tkR + 512;
    LAS int* hbase = hist + 32;
    bf16_t* xres = (bf16_t*)(p.ws + WS_XF);
    const bf16_t* ymix = (const bf16_t*)(p.ws + WS_YMIX);
    int* tope = (int*)(p.ws + WS_TOPE); float* gates = (float*)(p.ws + WS_GATES); int* pos = (int*)(p.ws + WS_POS);
    unsigned char* xq = p.ws + WS_XQ; int* elist = (int*)(p.ws + WS_LIST);
    unsigned* ctl = (unsigned*)(p.ws + WS_CTL);
    const float* gain = p.ln_gain + (size_t)(layer * 2) * D; const float* bias = p.ln_bias + (size_t)(layer * 2) * D;
    const float* brt = p.moe_b_router + (size_t)layer * NEXP;
    const bf16_t* rth = (const bf16_t*)(p.ws + WS_RT) + (size_t)layer * 2 * NEXP * D; const bf16_t* rtl = rth + NEXP * D;
    bf16x8 Wh[2][4], Wl[2][4];
#pragma unroll
    for (int nt = 0; nt < 2; ++nt)
#pragma unroll
        for (int ks = 0; ks < 4; ++ks) { const size_t o = (size_t)(16 * nt + fr) * D + 128 * wid + 32 * ks + 8 * fq; Wh[nt][ks] = *(const bf16x8*)(rth + o); Wl[nt][ks] = *(const bf16x8*)(rtl + o); }
    if (tid < NEXP) hist[tid] = 0;
    int it = 0;
    for (int tile = blockIdx.x; tile < T / 16; tile += gridDim.x) {
#pragma unroll
        for (int tt = 0; tt < 2; ++tt) {
            const int trow = 2 * wid + tt; const size_t t = (size_t)tile * 16 + trow;
            f32x4 z[4];
#pragma unroll
            for (int i = 0; i < 4; ++i) { const int c = 256 * i + 4 * lane; const u32x2 yv = *(const u32x2*)(ymix + t * D + c);
                f32x4 xv_;
                if (layer == 0) xv_ = *(const f32x4*)(p.x + t * D + c);
                else { const u32x2 xw = *(const u32x2*)(xres + t * D + c); xv_ = (f32x4){__uint_as_float(xw.x << 16), __uint_as_float(xw.x & 0xffff0000u), __uint_as_float(xw.y << 16), __uint_as_float(xw.y & 0xffff0000u)}; }
                z[i] = DN_ALPHA * xv_ + (f32x4){__uint_as_float(yv.x << 16), __uint_as_float(yv.x & 0xffff0000u), __uint_as_float(yv.y << 16), __uint_as_float(yv.y & 0xffff0000u)}; }
            float sm = 0.f;
#pragma unroll
            for (int i = 0; i < 4; ++i) sm += (z[i][0] + z[i][1]) + (z[i][2] + z[i][3]);
            const float mean = wave_sum(sm) * (1.0f / D);
            float sq = 0.f;
#pragma unroll
            for (int i = 0; i < 4; ++i) { const f32x4 dd = z[i] - mean; sq += (dd[0] * dd[0] + dd[1] * dd[1]) + (dd[2] * dd[2] + dd[3] * dd[3]); }
            const float rstd = rsqrtf(wave_sum(sq) * (1.0f / D) + LN_EPS);
#pragma unroll
            for (int i = 0; i < 4; ++i) {
                const int c = 256 * i + 4 * lane;
                const f32x4 v = (z[i] - mean) * rstd * *(const f32x4*)(gain + c) + *(const f32x4*)(bias + c);
                u32x2 wh; wh.x = pack2(v[0], v[1]); wh.y = pack2(v[2], v[3]);
                *(u32x2*)(xres + t * D + c) = wh;
                *(unsigned*)(xq + t * D + c) = pk_fp8x4(v[0], v[1], v[2], v[3]);
                const float r0 = v[0] - __uint_as_float(wh.x << 16), r1 = v[1] - __uint_as_float(wh.x & 0xffff0000u), r2 = v[2] - __uint_as_float(wh.y << 16), r3 = v[3] - __uint_as_float(wh.y & 0xffff0000u);
                u32x2 wl; wl.x = pack2(r0, r1); wl.y = pack2(r2, r3);
                *(LAS u32x2*)(xh + trow * XS + c * 2) = wh; *(LAS u32x2*)(xl + trow * XS + c * 2) = wl;
            }
        }
        __syncthreads();
        {
            f32x4 acc[2] = {(f32x4){0.f, 0.f, 0.f, 0.f}, (f32x4){0.f, 0.f, 0.f, 0.f}};
#pragma unroll
            for (int ks = 0; ks < 4; ++ks) {
                const bf16x8 ah = *(const LAS bf16x8*)(xh + fr * XS + (128 * wid + 32 * ks + 8 * fq) * 2), al = *(const LAS bf16x8*)(xl + fr * XS + (128 * wid + 32 * ks + 8 * fq) * 2);
#pragma unroll
                for (int nt = 0; nt < 2; ++nt) {
                    acc[nt] = __builtin_amdgcn_mfma_f32_16x16x32_bf16(Wh[nt][ks], ah, acc[nt], 0, 0, 0);
                    acc[nt] = __builtin_amdgcn_mfma_f32_16x16x32_bf16(Wh[nt][ks], al, acc[nt], 0, 0, 0);
                    acc[nt] = __builtin_amdgcn_mfma_f32_16x16x32_bf16(Wl[nt][ks], ah, acc[nt], 0, 0, 0);
                }
            }
#pragma unroll
            for (int nt = 0; nt < 2; ++nt) *(LAS f32x4*)(part + (wid * 16 + fr) * 32 + 16 * nt + 4 * fq) = acc[nt];
        }
        __syncthreads();
        {
            const int tk = tid >> 5, e = tid & 31;
            float sacc = brt[e];
#pragma unroll
            for (int w = 0; w < 8; ++w) sacc += part[(w * 16 + tk) * 32 + e];
            logit[tk * 32 + e] = sacc;
        }
        __syncthreads();
        if (tid < 16) {
            const size_t t = (size_t)tile * 16 + tid;
            float v0 = -INFINITY, v1 = -INFINITY, v2 = -INFINITY, v3 = -INFINITY; int i0 = 0, i1 = 0, i2 = 0, i3 = 0;
#pragma unroll
            for (int e = 0; e < NEXP; ++e) {
                const float v = logit[tid * 32 + e];
                if (v > v3) {
                    if (v > v0) { v3 = v2; i3 = i2; v2 = v1; i2 = i1; v1 = v0; i1 = i0; v0 = v; i0 = e; }
                    else if (v > v1) { v3 = v2; i3 = i2; v2 = v1; i2 = i1; v1 = v; i1 = e; }
                    else if (v > v2) { v3 = v2; i3 = i2; v2 = v; i2 = e; }
                    else { v3 = v; i3 = e; }
                }
            }
            const float e1 = __expf(v1 - v0), e2 = __expf(v2 - v0), e3 = __expf(v3 - v0), inv = 1.0f / (1.0f + e1 + e2 + e3);
            tope[t * 4 + 0] = i0; tope[t * 4 + 1] = i1; tope[t * 4 + 2] = i2; tope[t * 4 + 3] = i3;
            gates[t * 4 + 0] = inv; gates[t * 4 + 1] = e1 * inv; gates[t * 4 + 2] = e2 * inv; gates[t * 4 + 3] = e3 * inv;
            const int sl = (it & 7) * 16 + tid;
            tkE[sl * 4 + 0] = i0; tkR[sl * 4 + 0] = (int)atomicAdd((unsigned*)(hist + i0), 1u);
            tkE[sl * 4 + 1] = i1; tkR[sl * 4 + 1] = (int)atomicAdd((unsigned*)(hist + i1), 1u);
            tkE[sl * 4 + 2] = i2; tkR[sl * 4 + 2] = (int)atomicAdd((unsigned*)(hist + i2), 1u);
            tkE[sl * 4 + 3] = i3; tkR[sl * 4 + 3] = (int)atomicAdd((unsigned*)(hist + i3), 1u);
        }
        ++it;
        if ((it & 7) == 0 || tile + (int)gridDim.x >= T / 16) {
            __syncthreads();
            if (tid < NEXP) { const unsigned h = (unsigned)hist[tid]; hbase[tid] = h ? (int)atomicAdd(ctl + CW_CNT + layer * 64 + tid, h) : 0; hist[tid] = 0; }
            __syncthreads();
            const int nsl = (((it - 1) & 7) + 1) * 16;
            for (int a = tid; a < nsl * 4; a += NTHREADS) {
                const int sl = a >> 2, e = tkE[a], ps = hbase[e] + tkR[a];
                const int t = (tile - (((it - 1) & 7) - (sl >> 4)) * (int)gridDim.x) * 16 + (sl & 15);
                pos[t * 4 + (a & 3)] = ps; elist[(size_t)e * T + ps] = t;
            }
            __syncthreads();
        }
    }
    __syncthreads();
}
__device__ __forceinline__ void ln2_phase(LAS unsigned char* lds, const Params& p, int layer) {
    const int tid = tid_(), lane = tid & 63, wid = tid >> 6;
    moe_tables(lds, (const unsigned*)(p.ws + WS_CTL), layer);
    LAS const int* tab = (LAS const int*)(lds + TAB_OFF);
    const int* tope = (const int*)(p.ws + WS_TOPE); const int* pos = (const int*)(p.ws + WS_POS);
    bf16_t* xh = (bf16_t*)(p.ws + WS_XF);
    const unsigned char* yrows = p.ws + WS_YROWS;
    const float* gates = (const float*)(p.ws + WS_GATES);
    const float* gain = p.ln_gain + (size_t)(layer * 2 + 1) * D; const float* bias = p.ln_bias + (size_t)(layer * 2 + 1) * D;
    const int stride = (int)gridDim.x * 8;
    for (int t0 = blockIdx.x * 8 + wid; t0 < T; t0 += 2 * stride) {
        int dk[2][4]; float gk[2][4];
#pragma unroll
        for (int q = 0; q < 2; ++q) { const int t = (t0 + q * stride < T) ? t0 + q * stride : t0;
#pragma unroll
            for (int k = 0; k < 4; ++k) { dk[q][k] = tab[tope[t * 4 + k]] * 256 + pos[t * 4 + k]; gk[q][k] = gates[t * 4 + k]; } }
        unsigned yv[2][4][4]; u32x2 xv[2][4];
#pragma unroll
        for (int q = 0; q < 2; ++q) { const int t = (t0 + q * stride < T) ? t0 + q * stride : t0;
#pragma unroll
            for (int i = 0; i < 4; ++i) { const int c = 256 * i + 4 * lane; xv[q][i] = *(const u32x2*)(xh + (size_t)t * D + c);
#pragma unroll
                for (int k = 0; k < 4; ++k) yv[q][i][k] = *(const unsigned*)(yrows + (size_t)dk[q][k] * D + c); } }
#pragma unroll
        for (int q = 0; q < 2; ++q) { const int t = t0 + q * stride; if (t < T) {
            f32x4 z[4];
#pragma unroll
            for (int i = 0; i < 4; ++i) {
                f32x4 f = (f32x4){0.f, 0.f, 0.f, 0.f};
#pragma unroll
                for (int k = 0; k < 4; ++k) { const int y4 = (int)yv[q][i][k]; const float gg = gk[q][k];
                    const f32x2 lo = __builtin_amdgcn_cvt_pk_f32_fp8(y4, false), hi = __builtin_amdgcn_cvt_pk_f32_fp8(y4, true);
                    f[0] += gg * lo.x; f[1] += gg * lo.y; f[2] += gg * hi.x; f[3] += gg * hi.y; }
                const u32x2 xw = xv[q][i];
                z[i] = DN_ALPHA * (f32x4){__uint_as_float(xw.x << 16), __uint_as_float(xw.x & 0xffff0000u), __uint_as_float(xw.y << 16), __uint_as_float(xw.y & 0xffff0000u)} + f;
            }
            float sm = 0.f;
#pragma unroll
            for (int i = 0; i < 4; ++i) sm += (z[i][0] + z[i][1]) + (z[i][2] + z[i][3]);
            const float mean = wave_sum(sm) * (1.0f / D);
            float sq = 0.f;
#pragma unroll
            for (int i = 0; i < 4; ++i) { const f32x4 dd = z[i] - mean; sq += (dd[0] * dd[0] + dd[1] * dd[1]) + (dd[2] * dd[2] + dd[3] * dd[3]); }
            const float rstd = rsqrtf(wave_sum(sq) * (1.0f / D) + LN_EPS);
#pragma unroll
            for (int i = 0; i < 4; ++i) {
                const int c = 256 * i + 4 * lane;
                z[i] = (z[i] - mean) * rstd * *(const f32x4*)(gain + c) + *(const f32x4*)(bias + c);
                if (layer == DEPTH - 1) *(f32x4*)(p.out + (size_t)t * D + c) = z[i];
                else { u32x2 w; w.x = pack2(z[i][0], z[i][1]); w.y = pack2(z[i][2], z[i][3]); *(u32x2*)(xh + (size_t)t * D + c) = w; *(unsigned*)(p.ws + WS_XQ + (size_t)t * D + c) = pk_fp8x4(z[i][0], z[i][1], z[i][2], z[i][3]); }
            }
        } }
    }
}

constexpr int PH_PER_LAYER = 9;
constexpr int NPHASES = 1 + DEPTH * PH_PER_LAYER;
constexpr int LDS_BYTES = 150 * 1024;


#ifndef PHMASK
#define PHMASK 0x3FF
#endif
#define PHK(j) ((PHMASK >> (j)) & 1)
#ifndef PROBE_MASK
#define PROBE_MASK 0
#endif
#ifndef PROBE_LAYERS
#define PROBE_LAYERS 0xF
#endif
#define REPS(j) ((((PROBE_MASK) >> (j)) & 1) ? 2 : 1)
#define REPSL(j) (((((PROBE_MASK) >> (j)) & 1) && (((PROBE_LAYERS) >> layer) & 1)) ? 2 : 1)
#define IN(k) (lo <= (k) && (k) < hi)
#if MK_ONE_LAUNCH
#define SEAM(k) do { if (IN(k) && IN((k) + 1)) xcd_barrier_nv(bar.bar, bar.x, bar.st); } while (0)
#else
#define SEAM(k) do {} while (0)
#endif
template <int layer>
__device__ __forceinline__ void run_layer(const Params& p, LAS unsigned char* lds, const XcdBarrier& bar) {
    const int lo = p.ph_lo, hi = p.ph_hi;
    unsigned char* ws = p.ws;
    unsigned* ctl = (unsigned*)(ws + WS_CTL);
        constexpr int base = 1 + layer * PH_PER_LAYER, kind = layer % 3, idx = layer / 3;
        for (int rep_ = 0; rep_ < REPSL(1); ++rep_) if (PHK(1) && IN(base + 0)) {
            constexpr int N = (kind == 0) ? 2048 : (kind == 1 ? 6144 : 9216);
            const unsigned char* Bt = (kind == 0) ? ws + WS_AWIN + (size_t)idx * 2048 * D : (kind == 1 ? ws + WS_BWIN : ws + WS_CWIN);
            g8::SchedPlain S; S.init(ws + WS_XQ, Bt, T, N, D / 2, (int)gridDim.x, (int)blockIdx.x);
            g8::EpiBf16 E{(bf16_t*)(ws + WS_U), N, nullptr, 0, 1.0f / GU_WSCALE};
            g8::gemm_phase<g8::EpiBf16, g8::SchedPlain, false, 1>(lds, D, S, E);
        }
        SEAM(base + 0);
        for (int rep_ = 0; rep_ < REPSL(2); ++rep_) if (PHK(2) && IN(base + 1)) {
            if (kind == 0) lru_gates_phase(lds, p, idx);
            else if (kind == 1) ret_core_phase(lds, p);
            else attn_core_phase(lds, p);
        }
        SEAM(base + 1);
        for (int rep_ = 0; rep_ < REPSL(3); ++rep_) if (PHK(3) && IN(base + 2)) {
            if (kind == 0) lru_scan_phase(p);
            else if (kind == 1) ret_norm_phase(lds, p);
            else attn_merge_phase(p);
        }
        SEAM(base + 2);
        for (int rep_ = 0; rep_ < REPSL(4); ++rep_) if (PHK(4) && IN(base + 3)) {
            constexpr int K = (kind == 1) ? 2048 : D;
            const bf16_t* Bt = (kind == 0) ? (const bf16_t*)(ws + WS_AWOUT) + (size_t)idx * D * D : (kind == 1 ? (const bf16_t*)(ws + WS_BWOUT) : (const bf16_t*)(ws + WS_CWOUT));
            g8::SchedPlain S; S.init(ws + WS_YIN, Bt, T, D, K, (int)gridDim.x, (int)blockIdx.x);
            g8::EpiBf16 E{(bf16_t*)(ws + WS_YMIX), D, nullptr, 0, 1.0f};
            g8::gemm_phase<g8::EpiBf16, g8::SchedPlain, false>(lds, K, S, E);
        }
        SEAM(base + 3);
        for (int rep_ = 0; rep_ < REPSL(5); ++rep_) if (PHK(5) && IN(base + 4)) ln1_router_phase(lds, p, layer);
        SEAM(base + 4);
        for (int rep_ = 0; rep_ < REPSL(7); ++rep_) if (PHK(7) && IN(base + 6)) {
            moe_tables(lds, ctl, layer);
            g8::SchedGU S{(const char*)(ws + WS_XQ), (const char*)(ws + WS_GU) + (size_t)layer * NEXP * 2048 * D, (const int*)(ws + WS_LIST), (LAS const int*)(lds + TAB_OFF), (int)gridDim.x, (int)blockIdx.x};
            g8::EpiSwiglu E{ws + WS_HID, p.moe_b_gu + (size_t)layer * NEXP * 2048, 1.0f / GU_WSCALE};
            g8::gemm_phase<g8::EpiSwiglu, g8::SchedGU, true, 1>(lds, D, S, E);
        }
        SEAM(base + 6);
        for (int rep_ = 0; rep_ < REPSL(8); ++rep_) if (PHK(8) && IN(base + 7)) {
            moe_tables(lds, ctl, layer);
            g8::SchedDown S{(const char*)(ws + WS_HID), (const char*)(ws + WS_DN) + (size_t)layer * NEXP * D * D, (LAS const int*)(lds + TAB_OFF), (int)gridDim.x, (int)blockIdx.x};
            g8::EpiFp8 E{ws + WS_YROWS, D, p.moe_b_down + (size_t)layer * NEXP * D, D, 1.0f / DN_WSCALE};
            g8::gemm_phase<g8::EpiFp8, g8::SchedDown, false, 1>(lds, D, S, E);
        }
        SEAM(base + 7);
        for (int rep_ = 0; rep_ < REPSL(9); ++rep_) if (PHK(9) && IN(base + 8)) ln2_phase(lds, p, layer);
        SEAM(base + 8);
    }
#undef IN
#undef SEAM
__global__ void __launch_bounds__(NTHREADS, 2) fwd_kernel(Params p) {
    extern __shared__ __attribute__((aligned(16))) unsigned char lds_raw[];
    LAS unsigned char* lds = (LAS unsigned char*)lds_raw;
    const int lo = p.ph_lo, hi = p.ph_hi;
    unsigned char* ws = p.ws;
    unsigned* ctl = (unsigned*)(ws + WS_CTL);
#if MK_ONE_LAUNCH
    volatile LAS unsigned* bst = (volatile LAS unsigned*)(lds + LDS_BYTES - 16);
    if (threadIdx.x == 0) { bst[0] = 0u; bst[1] = 0u; bst[2] = 0u; bst[3] = 0u; }
    __syncthreads();
    XcdBarrier bar = xcd_barrier_post(ctl, bst);
#define GRID_BAR() xcd_barrier_nv(bar.bar, bar.x, bar.st)
#else
    XcdBarrier bar; bar.bar = ctl; bar.x = 0; bar.st = nullptr;
#define GRID_BAR() do {} while (0)
#endif
#define IN(k) (lo <= (k) && (k) < hi)
#define SEAM(k) do { if (IN(k) && IN((k) + 1)) GRID_BAR(); } while (0)

    for (int rep_ = 0; rep_ < REPS(0); ++rep_) if (PHK(0) && IN(0)) {
        LAS float* tile = (LAS float*)lds;
#pragma unroll 1
        for (int j = 0; j < 5; ++j) {
            const float* src = j == 0 ? p.moe_w_gu : (j == 1 ? p.moe_w_down : (j == 2 ? p.a_w_in : (j == 3 ? p.b_w_in : p.c_w_in)));
            const size_t dsto = j == 0 ? WS_GU : (j == 1 ? WS_DN : (j == 2 ? WS_AWIN : (j == 3 ? WS_BWIN : WS_CWIN)));
            const int N = j == 0 ? 2048 : (j == 1 ? D : (j == 2 ? 2048 : (j == 3 ? 6144 : 9216)));
            const int batch = j < 2 ? DEPTH * NEXP : (j == 2 ? 2 : 1);
            convert_big<true>(lds, src, ws + dsto, D, N, batch, j == 1 ? DN_WSCALE : GU_WSCALE);
        }
#pragma unroll 1
        for (int j = 0; j < 3; ++j) {
            const float* src = j == 0 ? p.a_w_out : (j == 1 ? p.b_w_out : p.c_w_out);
            const size_t dsto = j == 0 ? WS_AWOUT : (j == 1 ? WS_BWOUT : WS_CWOUT);
            convert_big<false>(lds, src, ws + dsto, j == 1 ? 2048 : D, D, j == 0 ? 2 : 1, 1.0f);
        }
        convert_job(tile, p.a_w_rgate, (bf16_t*)(ws + WS_AGT), 128, 128, 8);
        convert_job(tile, p.a_w_igate, (bf16_t*)(ws + WS_AGT) + (size_t)8 * 128 * 128, 128, 128, 8);
        convert_job(tile, p.a_w_rgate + (size_t)8 * 128 * 128, (bf16_t*)(ws + WS_AGT) + (size_t)16 * 128 * 128, 128, 128, 8);
        convert_job(tile, p.a_w_igate + (size_t)8 * 128 * 128, (bf16_t*)(ws + WS_AGT) + (size_t)24 * 128 * 128, 128, 128, 8);
        {
            bf16_t* rt = (bf16_t*)(ws + WS_RT);
            for (int i = blockIdx.x * NTHREADS + threadIdx.x; i < DEPTH * NEXP * D; i += gridDim.x * NTHREADS) {
                const int l = i / (NEXP * D), r_ = i % (NEXP * D), e = r_ / D, k = r_ % D;
                const float w = p.moe_w_router[((size_t)l * D + k) * NEXP + e];
                const bf16_t hi = f2bf(w); const bf16_t lo = f2bf(w - bf2f(hi));
                rt[((size_t)l * 2 + 0) * NEXP * D + (size_t)e * D + k] = hi; rt[((size_t)l * 2 + 1) * NEXP * D + (size_t)e * D + k] = lo;
            }
        }
        {
            const size_t stride = (size_t)gridDim.x * NTHREADS;
            for (size_t i = (size_t)blockIdx.x * NTHREADS + threadIdx.x; i < (size_t)T * D / 4; i += 4 * stride) {
                f32x4 v[4];
#pragma unroll
                for (int q = 0; q < 4; ++q) v[q] = *(const f32x4*)(p.x + (i + q * stride) * 4);
#pragma unroll
                for (int q = 0; q < 4; ++q) *(unsigned*)(ws + WS_XQ + (i + q * stride) * 4) = pk_fp8x4(v[q][0], v[q][1], v[q][2], v[q][3]);
            }
        }
    }
    SEAM(0);

    run_layer<0>(p, lds, bar); run_layer<1>(p, lds, bar); run_layer<2>(p, lds, bar); run_layer<3>(p, lds, bar);
#undef IN
#undef SEAM
}

extern "C" void kernel_launch(void* const* d_in, const int* in_sizes, int n_in, void* d_out, int out_size, void* d_ws, size_t ws_size, hipStream_t stream) {
    static int grid = 0;
    if (grid == 0) {
        if (n_in != 22 || out_size != T * D || ws_size < WS_END) { fprintf(stderr, "kernel_launch: unexpected shapes (n_in %d out %d ws %zu need %zu)\n", n_in, out_size, ws_size, (size_t)WS_END); grid = -1; return; }
        if (hipFuncSetAttribute((const void*)fwd_kernel, hipFuncAttributeMaxDynamicSharedMemorySize, LDS_BYTES) != hipSuccess) { fprintf(stderr, "kernel_launch: hipFuncSetAttribute failed\n"); grid = -1; return; }
        int dev = 0, cus = 0;
        if (hipGetDevice(&dev) != hipSuccess || hipDeviceGetAttribute(&cus, hipDeviceAttributeMultiprocessorCount, dev) != hipSuccess) { grid = -1; return; }
        grid = cus;
    }
    if (grid < 0) return;
    (void)hipMemsetAsync((char*)d_ws + WS_CTL, 0, CTL_BYTES, stream);
    Params p{};
    const float** pp = (const float**)&p;
    for (int i = 0; i < 22; ++i) pp[i] = (const float*)d_in[i];
    p.out = (float*)d_out; p.ws = (unsigned char*)d_ws;
#if MK_ONE_LAUNCH
    p.ph_lo = 0; p.ph_hi = NPHASES;
    hipLaunchKernelGGL(fwd_kernel, dim3(grid), dim3(NTHREADS), LDS_BYTES, stream, p);
#else
    for (int ph = 0; ph < NPHASES; ++ph) {
        p.ph_lo = ph; p.ph_hi = ph + 1;
        hipLaunchKernelGGL(fwd_kernel, dim3(grid), dim3(NTHREADS), LDS_BYTES, stream, p);
    }
#endif
}
```

```cpp
#include <hip/hip_runtime.h>
#include <stdint.h>
#include <stdio.h>

#ifndef MK_ONE_LAUNCH
#define MK_ONE_LAUNCH 1
#endif

#define LAS __attribute__((address_space(3)))
typedef unsigned short bf16_t;
typedef short bf16x8 __attribute__((ext_vector_type(8)));
typedef float f32x4 __attribute__((ext_vector_type(4)));
typedef unsigned u32x4 __attribute__((ext_vector_type(4)));
typedef unsigned u32x2 __attribute__((ext_vector_type(2)));
typedef int i32x4v __attribute__((ext_vector_type(4)));

constexpr int T = 16384, D = 1024, SEQ = 2048, NBATCH = 8, DEPTH = 4;
constexpr int NEXP = 32, TOPK = 4;
constexpr int MAXROWS = 73728;
constexpr float DN_ALPHA = 1.681792830507429f;
constexpr float LN_EPS = 1e-5f;
constexpr float GU_WSCALE = 64.0f, DN_WSCALE = 128.0f;
constexpr float YMSCALE = 16.0f;
constexpr float OUT_WSCALE = 128.0f, YSCALE = 4.0f;
constexpr int NTHREADS = 512;

constexpr size_t MB = 1ull << 20;
constexpr size_t WS_CTL = 0;
constexpr size_t CTL_BYTES = 65536;
constexpr size_t WS_AWIN = 1 * MB;
constexpr size_t WS_AWOUT = WS_AWIN + 8 * MB;
constexpr size_t WS_BWIN = WS_AWOUT + 4 * MB;
constexpr size_t WS_BWOUT = WS_BWIN + 12 * MB;
constexpr size_t WS_CWIN = WS_BWOUT + 4 * MB;
constexpr size_t WS_CWOUT = WS_CWIN + 18 * MB;
constexpr size_t WS_GU = WS_CWOUT + 2 * MB;
constexpr size_t WS_DN = WS_GU + 512 * MB;
constexpr size_t WS_XF = WS_DN + 256 * MB;
constexpr size_t WS_XB = WS_XF + 64 * MB;
constexpr size_t WS_U = WS_XB + 32 * MB;
constexpr size_t WS_UKV = WS_U + 128 * MB;
constexpr size_t WS_YIN = WS_U + 288 * MB;
constexpr size_t WS_YMIX = WS_YIN + 64 * MB;
constexpr size_t WS_SCR = WS_YMIX + 64 * MB;
constexpr size_t WS_TOPE = WS_SCR + 128 * MB;
constexpr size_t WS_GATES = WS_TOPE + 256 * 1024;
constexpr size_t WS_POS = WS_GATES + 256 * 1024;
constexpr size_t WS_DEST = WS_POS + 256 * 1024;
constexpr size_t WS_ROWTOK = WS_DEST + 256 * 1024;
constexpr size_t WS_HID = WS_ROWTOK + 1 * MB;
constexpr size_t WS_YROWS = WS_HID + 144 * MB;
constexpr size_t WS_LSUM = WS_YROWS + 288 * MB;
constexpr size_t WS_AGT = WS_LSUM + 2 * MB;
constexpr size_t WS_RT = WS_AGT + 1 * MB;
constexpr size_t WS_XQ = WS_RT + 1 * MB;
constexpr size_t WS_LIST = WS_XQ + 16 * MB;
constexpr size_t WS_END = WS_LIST + 2 * MB;

constexpr int CW_CNT = 4096;
constexpr int CW_MDYN = 8192;
constexpr int CW_TEXP = 12288;
constexpr int CW_CQ = 15360;

#define XB_TMO      128
#define XB_XCNT(j)  (256  + 64 * (j))
#define XB_XSUB(j)  (1280 + 64 * (j))
#define XB_XGEN(j)  (2304 + 64 * (j))
#define XB_TOP      3328
#define XB_TOPGEN   3392
#define XCD_BAR_WORDS 3456
#define XB_SPIN_CAP (1u << 22)

__device__ __forceinline__ unsigned xb_ld(unsigned* p)              { return __hip_atomic_load(p, __ATOMIC_RELAXED, __HIP_MEMORY_SCOPE_AGENT); }
__device__ __forceinline__ unsigned xb_add(unsigned* p, unsigned v) { return __hip_atomic_fetch_add(p, v, __ATOMIC_RELAXED, __HIP_MEMORY_SCOPE_AGENT); }
__device__ __forceinline__ unsigned xb_xcc_id() { return (unsigned)__builtin_amdgcn_s_getreg((3 << 11) | 20) & 0xFu; }
#define XB_SPIN(cond, bar) do { unsigned _sp = 0; while (cond) { __builtin_amdgcn_s_sleep(1); \
    if ((++_sp & 255u) == 0u) { if (xb_ld(&(bar)[XB_TMO])) break; if (_sp > XB_SPIN_CAP) { atomicAdd(&(bar)[XB_TMO], 1u); break; } } } } while (0)

struct XcdBarrier { unsigned* bar; unsigned x; volatile LAS unsigned* st; };

__device__ __forceinline__ XcdBarrier xcd_barrier_post(unsigned* bar, volatile LAS unsigned* st) {
    XcdBarrier b; b.bar = bar; b.x = xb_xcc_id(); b.st = st;
    if (threadIdx.x == 0) (void)xb_add(&bar[XB_XCNT(b.x)], 1u);
    return b;
}
__device__ __forceinline__ void xcd_barrier_complete(unsigned* bar, unsigned x, unsigned& nloc, unsigned& nx) {
    const unsigned G = gridDim.x * gridDim.y * gridDim.z;
    unsigned sum, cnt, mine, sp = 0u;
    for (;;) {
        sum = 0u; cnt = 0u; mine = 0u;
#pragma unroll
        for (unsigned j = 0; j < 16; ++j) { const unsigned c = xb_ld(&bar[XB_XCNT(j)]); sum += c; cnt += (c > 0u) ? 1u : 0u; mine = (j == x) ? c : mine; }
        if (sum == G) break;
        __builtin_amdgcn_s_sleep(1);
        if ((++sp & 255u) == 0u) { if (xb_ld(&bar[XB_TMO])) break; if (sp > XB_SPIN_CAP) { atomicAdd(&bar[XB_TMO], 1u); break; } }
    }
    nloc = mine > 0u ? mine : 1u; nx = cnt > 0u ? cnt : 1u;
}
__device__ __forceinline__ void xcd_barrier_nv(unsigned* bbar, unsigned bx, volatile LAS unsigned* bst) {
    XcdBarrier b; b.bar = bbar; b.x = bx; b.st = bst;
    asm volatile("s_waitcnt vmcnt(0)" ::: "memory");
    __syncthreads();
    if (threadIdx.x == 0) {
        unsigned* bar = b.bar;
        __builtin_amdgcn_s_waitcnt(0);
        unsigned nloc = b.st[0], nx = b.st[1];
        if (nloc == 0u) { xcd_barrier_complete(bar, b.x, nloc, nx); b.st[0] = nloc; b.st[1] = nx; }
        const unsigned old = xb_add(&bar[XB_XSUB(b.x)], 1u);
        const unsigned gen = old / nloc;
        if (old + 1u == (gen + 1u) * nloc) {
            __builtin_amdgcn_fence(__ATOMIC_RELEASE, "agent");
            asm volatile("s_waitcnt vmcnt(0)" ::: "memory");
            const unsigned og = xb_add(&bar[XB_TOP], 1u);
            const unsigned tg = og / nx;
            if (og + 1u == (tg + 1u) * nx) xb_add(&bar[XB_TOPGEN], 1u);
            else XB_SPIN(xb_ld(&bar[XB_TOPGEN]) == tg, bar);
            __builtin_amdgcn_fence(__ATOMIC_ACQUIRE, "agent");
            xb_add(&bar[XB_XGEN(b.x)], 1u);
            asm volatile("s_waitcnt vmcnt(0)" ::: "memory");
        } else {
            XB_SPIN(xb_ld(&bar[XB_XGEN(b.x)]) == gen, bar);
            __builtin_amdgcn_fence(__ATOMIC_ACQUIRE, "agent");
            asm volatile("s_waitcnt vmcnt(0)" ::: "memory");
        }
    }
    __syncthreads();
}

__device__ __forceinline__ int tid_() { int t = threadIdx.x; asm volatile("" : "+v"(t)); return t; }
__device__ __forceinline__ float bf2f(bf16_t v) { return __uint_as_float(((unsigned)v) << 16); }
__device__ __forceinline__ unsigned pack2(float lo, float hi) { unsigned r; asm("v_cvt_pk_bf16_f32 %0, %1, %2" : "=v"(r) : "v"(lo), "v"(hi)); return r; }
__device__ __forceinline__ bf16_t f2bf(float f) { return (bf16_t)(pack2(f, f) & 0xffffu); }
#define DPPF_(v, ctrl) __int_as_float(__builtin_amdgcn_update_dpp(0, __float_as_int(v), ctrl, 0xf, 0xf, false))
#define DPPU_(v, ctrl) ((unsigned)__builtin_amdgcn_update_dpp(0, (int)(v), ctrl, 0xf, 0xf, false))
__device__ __forceinline__ float wave_sum(float v) {
    v += DPPF_(v, 0xB1); v += DPPF_(v, 0x4E); v += DPPF_(v, 0x141); v += DPPF_(v, 0x140);
    const float r0 = __int_as_float(__builtin_amdgcn_readlane(__float_as_int(v), 0)), r1 = __int_as_float(__builtin_amdgcn_readlane(__float_as_int(v), 16));
    const float r2 = __int_as_float(__builtin_amdgcn_readlane(__float_as_int(v), 32)), r3 = __int_as_float(__builtin_amdgcn_readlane(__float_as_int(v), 48));
    return (r0 + r1) + (r2 + r3);
}
__device__ __forceinline__ unsigned half_umax(unsigned m) {
    unsigned a;
    a = DPPU_(m, 0xB1); m = m > a ? m : a; a = DPPU_(m, 0x4E); m = m > a ? m : a; a = DPPU_(m, 0x141); m = m > a ? m : a; a = DPPU_(m, 0x140); m = m > a ? m : a;
    const unsigned r0 = (unsigned)__builtin_amdgcn_readlane((int)m, 0), r1 = (unsigned)__builtin_amdgcn_readlane((int)m, 16);
    return r0 > r1 ? r0 : r1;
}
__device__ __forceinline__ float wave_max(float v) {
#pragma unroll
    for (int o = 32; o >= 1; o >>= 1) v = fmaxf(v, __shfl_xor(v, o));
    return v;
}
__device__ __forceinline__ float sigmoidf_(float x) { return __builtin_amdgcn_rcpf(1.0f + __builtin_amdgcn_exp2f(-1.4426950408889634f * x)); }
__device__ __forceinline__ float gelu_tanh(float x) { const float u = 0.7978845608028654f * (x + 0.044715f * x * x * x); return 0.5f * x * (1.0f + tanhf(u)); }
__device__ __forceinline__ unsigned pk_fp8x4(float a, float b, float c, float d) { int w = 0; w = __builtin_amdgcn_cvt_pk_fp8_f32(a, b, w, false); w = __builtin_amdgcn_cvt_pk_fp8_f32(c, d, w, true); return (unsigned)w; }
__device__ __forceinline__ float yq_(float v) { return __builtin_amdgcn_fmed3f(v * YSCALE, -448.0f, 448.0f); }
__device__ __forceinline__ unsigned pk_yq4(float a, float b, float c, float d) { return pk_fp8x4(yq_(a), yq_(b), yq_(c), yq_(d)); }
typedef float f32x2_ __attribute__((ext_vector_type(2)));
__device__ __forceinline__ u32x4 fp8x8_to_bf16x8(u32x2 w) {
    const f32x2_ a = __builtin_amdgcn_cvt_pk_f32_fp8((int)w.x, false), b = __builtin_amdgcn_cvt_pk_f32_fp8((int)w.x, true), c = __builtin_amdgcn_cvt_pk_f32_fp8((int)w.y, false), d = __builtin_amdgcn_cvt_pk_f32_fp8((int)w.y, true);
    u32x4 r; r.x = pack2(a.x, a.y); r.y = pack2(b.x, b.y); r.z = pack2(c.x, c.y); r.w = pack2(d.x, d.y); return r;
}
typedef float f32x2 __attribute__((ext_vector_type(2)));
__device__ __forceinline__ f32x2 swiglu2(f32x2 gate, f32x2 up) {
    f32x2 g, u; g.x = fminf(gate.x, 7.0f); g.y = fminf(gate.y, 7.0f); u.x = __builtin_amdgcn_fmed3f(up.x, -7.0f, 7.0f); u.y = __builtin_amdgcn_fmed3f(up.y, -7.0f, 7.0f);
    const f32x2 t = g * (-1.702f * 1.4426950408889634f);
    f32x2 e; e.x = __builtin_amdgcn_exp2f(t.x); e.y = __builtin_amdgcn_exp2f(t.y);
    const f32x2 d = e + 1.0f;
    f32x2 r; r.x = __builtin_amdgcn_rcpf(d.x); r.y = __builtin_amdgcn_rcpf(d.y);
    return ((u + 1.0f) * g) * r;
}
__device__ __forceinline__ float swiglu(float gate, float up) {
    const float g = fminf(gate, 7.0f), u = fminf(fmaxf(up, -7.0f), 7.0f);
    return (u + 1.0f) * g * sigmoidf_(1.702f * g);
}

struct Params {
    const float* x; const float* a_w_in; const float* a_conv_w; const float* a_conv_b; const float* a_w_rgate; const float* a_b_rgate;
    const float* a_w_igate; const float* a_b_igate; const float* a_lambda; const float* a_w_out; const float* b_w_in; const float* b_w_out;
    const float* c_w_in; const float* c_w_out; const float* ln_gain; const float* ln_bias; const float* moe_w_router; const float* moe_b_router;
    const float* moe_w_gu; const float* moe_b_gu; const float* moe_w_down; const float* moe_b_down;
    float* out; unsigned char* ws;
    int ph_lo, ph_hi;
};

__device__ __forceinline__ void convert_job(LAS float* tile, const float* src, bf16_t* dst, int K, int N, int batch) {
    const int tid = tid_();
    const int tk = K / 64, tn = N / 64, per = tk * tn; const long total = (long)per * batch;
    for (long u = blockIdx.x; u < total; u += gridDim.x) {
        const int bidx = (int)(u / per), r = (int)(u % per), kt = r / tn, nt = r % tn;
        const float* s = src + (size_t)bidx * K * N + (size_t)(kt * 64) * N + nt * 64;
#pragma unroll
        for (int pass = 0; pass < 2; ++pass) {
            const int row = (tid >> 4) + 32 * pass, c4 = tid & 15;
            const f32x4 v = *(const f32x4*)(s + (size_t)row * N + c4 * 4);
            tile[row * 65 + c4 * 4 + 0] = v[0]; tile[row * 65 + c4 * 4 + 1] = v[1]; tile[row * 65 + c4 * 4 + 2] = v[2]; tile[row * 65 + c4 * 4 + 3] = v[3];
        }
        __syncthreads();
        {
            const int n = tid >> 3, k8 = tid & 7;
            float v[8];
#pragma unroll
            for (int j = 0; j < 8; ++j) v[j] = tile[(k8 * 8 + j) * 65 + n];
            u32x4 w; w.x = pack2(v[0], v[1]); w.y = pack2(v[2], v[3]); w.z = pack2(v[4], v[5]); w.w = pack2(v[6], v[7]);
            *(u32x4*)(dst + (size_t)bidx * N * K + (size_t)(nt * 64 + n) * K + kt * 64 + k8 * 8) = w;
        }
        __syncthreads();
    }
}


constexpr int TAB_OFF = 131072;
constexpr int BIASL_OFF = TAB_OFF + 4096;
__device__ __forceinline__ void moe_tables(LAS unsigned char* lds, const unsigned* ctl, int layer) {
    LAS int* tab = (LAS int*)(lds + TAB_OFF);
    const int tid = tid_();
    __syncthreads();
    if (tid == 0) { int acc = 0; for (int e = 0; e < NEXP; ++e) { tab[e] = acc; acc += ((int)ctl[CW_CNT + layer * 64 + e] + 255) >> 8; } tab[32] = acc; }
    __syncthreads();
    if (tid < 288) { int e = 0; for (int q = 1; q < NEXP; ++q) e += (tab[q] <= tid) ? 1 : 0; tab[64 + tid] = e; }
    __syncthreads();
}

namespace g8 {
constexpr int BM = 256, BK = 64, HALF = 128, HTB = HALF * BK * 2, STAGE_BYTES = 8 * HTB, NXCD = 8, WGM = 8;
__device__ __forceinline__ int lds_byte(int r, int c) { const int st = (r >> 4) * 2 + (c >> 5), rr = r & 15, cc = c & 31, ob = rr * 64 + cc * 2; return st * 1024 + (ob ^ (((ob >> 9) & 1) << 5)); }
__device__ __forceinline__ void stage_rc(int b, int& R, int& C) { const int st = b / 1024, sb = b % 1024, swz = sb ^ (((sb >> 9) & 1) << 5); R = (st >> 1) * 16 + swz / 64; C = (st & 1) * 32 + (swz % 64) / 2; }
__device__ __forceinline__ int perm32(int rho) { const int n = rho >> 4, i = rho & 15; return 8 * (i >> 2) + 4 * n + (i & 3); }
__device__ __forceinline__ unsigned cvt_pk_bf16(float lo, float hi) { unsigned r; asm volatile("v_cvt_pk_bf16_f32 %0, %1, %2" : "=v"(r) : "v"(lo), "v"(hi)); return r; }

struct Unit { const char* a0; const char* a1; const char* b0; const char* b1; const int* rows; int row0, col0, e; };

struct SchedPlain {
    const char* A; const char* Bt; size_t hstepA, hstepB; int nM, nN, nwg, G, c;
    __device__ __forceinline__ void init(const void* A_, const void* Bt_, int M, int N, int K, int G_, int c_) { A = (const char*)A_; Bt = (const char*)Bt_; hstepA = (size_t)HALF * K * 2; hstepB = hstepA; nM = M / BM; nN = N / BM; nwg = nM * nN; G = G_; c = c_; }
    __device__ __forceinline__ bool next(int i, Unit& u) const {
        const long L = (long)i * G + c; if (L >= nwg) return false;
        int wgid = (int)L; { const int q = nwg / NXCD, r = nwg % NXCD, xcd = wgid % NXCD, off = wgid / NXCD; wgid = (xcd < r ? xcd * (q + 1) : r * (q + 1) + (xcd - r) * q) + off; }
        const int nig = WGM * nN, gid = wgid / nig, fm = gid * WGM, gsz = (nM - fm) < WGM ? (nM - fm) : WGM;
        const int pm = fm + ((wgid % nig) % gsz), pn = (wgid % nig) / gsz;
        u.a0 = A + (size_t)pm * 2 * hstepA; u.a1 = u.a0 + hstepA; u.b0 = Bt + (size_t)pn * 2 * hstepB; u.b1 = u.b0 + hstepB; u.rows = nullptr; u.row0 = pm * BM; u.col0 = pn * BM; u.e = 0;
        return true;
    }
};
struct SchedGU {
    const char* A; const char* W; const int* elist; LAS const int* tab; int G, c;
    __device__ __forceinline__ bool next(int i, Unit& u) const {
        const int xx = c & 7, jj = c >> 3, rt = i * (G >> 3) + ((jj >> 1) << 1) + (xx >> 2), pn = 2 * (xx & 3) + (jj & 1); if (rt >= __builtin_amdgcn_readfirstlane(tab[32])) return false;
        const int e = __builtin_amdgcn_readfirstlane(tab[64 + rt]), j = rt - __builtin_amdgcn_readfirstlane(tab[e]);
        u.a0 = A; u.a1 = A; u.rows = elist + (size_t)e * T + j * BM; u.b0 = W + ((size_t)e * 2048 + pn * 128) * D; u.b1 = u.b0 + (size_t)1024 * D; u.row0 = rt * BM; u.col0 = pn * 128; u.e = e;
        return true;
    }
};
struct SchedDown {
    const char* A; const char* W; LAS const int* tab; int G, c;
    __device__ __forceinline__ bool next(int i, Unit& u) const {
        const int L = i * G + c, rt = L >> 2, pn = L & 3; if (c >= G || rt >= __builtin_amdgcn_readfirstlane(tab[32])) return false;
        const int e = __builtin_amdgcn_readfirstlane(tab[64 + rt]);
        u.a0 = A + (size_t)rt * BM * D; u.a1 = u.a0 + (size_t)HALF * D; u.rows = nullptr; u.b0 = W + ((size_t)e * 1024 + pn * BM) * D; u.b1 = u.b0 + (size_t)HALF * D; u.row0 = rt * BM; u.col0 = pn * BM; u.e = e;
        return true;
    }
};

struct EpiF32 {
    static constexpr bool PERM = false, STAGED = false, BIASL = false;
    float* C; int ldc; const float* bias; int bias_es;
    __device__ __forceinline__ const float* bias_src(const Unit& u, int i) const { return bias; }
    __device__ __forceinline__ void operator()(const f32x4 (&acc)[2][2][4][2], const Unit& u, int wr, int wc, int fr, int fq, const LAS float* bl) const {
        const int row0 = u.row0 + wr * 64 + fr, col0 = u.col0 + wc * 32 + 4 * fq;
        f32x4 bv[2][2];
#pragma unroll
        for (int bj = 0; bj < 2; ++bj)
#pragma unroll
            for (int n = 0; n < 2; ++n) bv[bj][n] = bias ? *(const f32x4*)(bias + (size_t)u.e * bias_es + col0 + bj * HALF + n * 16) : (f32x4){0.f, 0.f, 0.f, 0.f};
#pragma unroll
        for (int ai = 0; ai < 2; ++ai)
#pragma unroll
            for (int m = 0; m < 4; ++m) { float* rowp = C + (size_t)(row0 + ai * HALF + m * 16) * ldc + col0;
#pragma unroll
                for (int bj = 0; bj < 2; ++bj)
#pragma unroll
                    for (int n = 0; n < 2; ++n) *(f32x4*)(rowp + bj * HALF + n * 16) = acc[ai][bj][m][n] + bv[bj][n]; }
    }
};
struct EpiBf16 {
    static constexpr bool PERM = true, STAGED = true, BIASL = false;
    bf16_t* O; int ldc; const float* bias; int bias_es; float scale;
    __device__ __forceinline__ const float* bias_src(const Unit& u, int i) const { return bias; }
    __device__ __forceinline__ void staged(const f32x4 (&acc)[2][2][4][2], const Unit& u, int wr, int wc, int fr, int fq, LAS unsigned char* lds, int tid) const {
        LAS unsigned char* slab = lds + (wr ? (TAB_OFF + 2048) : 3 * HTB);
        const int j = tid & 255, rrow = j >> 5, rc = j & 31;
#pragma unroll
        for (int ai = 0; ai < 2; ++ai)
#pragma unroll
            for (int mp = 0; mp < 2; ++mp) {
#pragma unroll
                for (int mm = 0; mm < 2; ++mm)
#pragma unroll
                    for (int bj = 0; bj < 2; ++bj) {
                        const int m = 2 * mp + mm, row = 16 * mm + fr, chunk = 16 * bj + 4 * wc + fq;
                        const f32x4 v0 = acc[ai][bj][m][0] * scale, v1 = acc[ai][bj][m][1] * scale;
                        u32x4 w; w.x = cvt_pk_bf16(v0[0], v0[1]); w.y = cvt_pk_bf16(v0[2], v0[3]); w.z = cvt_pk_bf16(v1[0], v1[1]); w.w = cvt_pk_bf16(v1[2], v1[3]);
                        *(LAS u32x4*)(slab + row * 512 + ((chunk ^ (row & 15)) * 16)) = w;
                    }
                asm volatile("s_waitcnt lgkmcnt(0)" ::: "memory"); __builtin_amdgcn_s_barrier(); asm volatile("" ::: "memory");
#pragma unroll
                for (int i = 0; i < 4; ++i) {
                    const int row = rrow + 8 * i;
                    const u32x4 w = *(const LAS u32x4*)(slab + row * 512 + ((rc ^ (row & 15)) * 16));
                    __builtin_nontemporal_store(w, (u32x4*)(O + (size_t)(u.row0 + 128 * ai + 64 * wr + 32 * mp + row) * ldc + u.col0 + rc * 8));
                }
                asm volatile("s_waitcnt lgkmcnt(0)" ::: "memory"); __builtin_amdgcn_s_barrier(); asm volatile("" ::: "memory");
            }
    }
};
struct EpiQKV {
    static constexpr bool PERM = true, STAGED = true, BIASL = false;
    bf16_t* Oq; unsigned char* Okv; float scale; int csplit, kvp;
    __device__ __forceinline__ const float* bias_src(const Unit& u, int i) const { return nullptr; }
    __device__ __forceinline__ void staged(const f32x4 (&acc)[2][2][4][2], const Unit& u, int wr, int wc, int fr, int fq, LAS unsigned char* lds, int tid) const {
        if (u.col0 < csplit) { const EpiBf16 E{Oq, csplit, nullptr, 0, scale}; E.staged(acc, u, wr, wc, fr, fq, lds, tid); return; }
        LAS unsigned char* slab = lds + (wr ? (TAB_OFF + 2048) : 3 * HTB);
        const int j = tid & 255, rrow = j >> 4, rc = j & 15, sub = (fq & 1) * 8;
#pragma unroll
        for (int ai = 0; ai < 2; ++ai) {
#pragma unroll
            for (int m = 0; m < 4; ++m)
#pragma unroll
                for (int bj = 0; bj < 2; ++bj) { const f32x4 v0 = acc[ai][bj][m][0] * scale, v1 = acc[ai][bj][m][1] * scale;
                    u32x2 w; w.x = pk_fp8x4(v0[0], v0[1], v0[2], v0[3]); w.y = pk_fp8x4(v1[0], v1[1], v1[2], v1[3]);
                    const int row = 16 * m + fr, chunk = 8 * bj + 2 * wc + (fq >> 1);
                    *(LAS u32x2*)(slab + row * 256 + ((chunk ^ (row & 15)) * 16) + sub) = w; }
            asm volatile("s_waitcnt lgkmcnt(0)" ::: "memory"); __builtin_amdgcn_s_barrier(); asm volatile("" ::: "memory");
#pragma unroll
            for (int i = 0; i < 4; ++i) {
                const int row = rrow + 16 * i;
                const u32x4 w = *(const LAS u32x4*)(slab + row * 256 + ((rc ^ (row & 15)) * 16));
                __builtin_nontemporal_store(w, (u32x4*)(Okv + (size_t)(u.row0 + 128 * ai + 64 * wr + row) * kvp + (u.col0 - csplit) + rc * 16));
            }
            asm volatile("s_waitcnt lgkmcnt(0)" ::: "memory"); __builtin_amdgcn_s_barrier(); asm volatile("" ::: "memory");
        }
    }
};
struct EpiFp8 {
    static constexpr bool PERM = true, STAGED = false, BIASL = true;
    unsigned char* O; int ldc; const float* bias; int bias_es; float scale;
    __device__ __forceinline__ const float* bias_src(const Unit& u, int i) const { return bias + (size_t)u.e * bias_es + u.col0 + i; }
    __device__ __forceinline__ void operator()(const f32x4 (&acc)[2][2][4][2], const Unit& u, int wr, int wc, int fr, int fq, const LAS float* bl) const {
        const int row0 = u.row0 + wr * 64 + fr, col0 = u.col0 + wc * 32 + 8 * fq;
        f32x4 bv[2][2];
#pragma unroll
        for (int bj = 0; bj < 2; ++bj)
#pragma unroll
            for (int n = 0; n < 2; ++n) bv[bj][n] = *(const LAS f32x4*)(bl + bj * HALF + wc * 32 + 8 * fq + 4 * n);
#pragma unroll
        for (int ai = 0; ai < 2; ++ai)
#pragma unroll
            for (int m = 0; m < 4; ++m) { unsigned char* rowp = O + (size_t)(row0 + ai * HALF + m * 16) * ldc + col0;
#pragma unroll
                for (int bj = 0; bj < 2; ++bj) { const f32x4 v0 = acc[ai][bj][m][0] * scale + bv[bj][0], v1 = acc[ai][bj][m][1] * scale + bv[bj][1];
                    u32x2 w; w.x = pk_fp8x4(v0[0], v0[1], v0[2], v0[3]); w.y = pk_fp8x4(v1[0], v1[1], v1[2], v1[3]);
                    *(u32x2*)(rowp + bj * HALF) = w; } }
    }
};
struct EpiSwiglu {
    static constexpr bool PERM = true, STAGED = false, BIASL = true;
    unsigned char* O; const float* bias; float scale;
    __device__ __forceinline__ const float* bias_src(const Unit& u, int i) const { return bias + (size_t)u.e * 2048 + (i >> 7) * 1024 + u.col0 + (i & 127); }
    __device__ __forceinline__ void operator()(const f32x4 (&acc)[2][2][4][2], const Unit& u, int wr, int wc, int fr, int fq, const LAS float* bl) const {
        const int row0 = u.row0 + wr * 64 + fr, hc = u.col0 + wc * 32 + 8 * fq;
        const LAS float* bp = bl + wc * 32 + 8 * fq;
        const f32x4 bg0 = *(const LAS f32x4*)(bp), bg1 = *(const LAS f32x4*)(bp + 4), bu0 = *(const LAS f32x4*)(bp + 128), bu1 = *(const LAS f32x4*)(bp + 132);
#pragma unroll
        for (int ai = 0; ai < 2; ++ai)
#pragma unroll
            for (int m = 0; m < 4; ++m) {
                const f32x4 g0 = acc[ai][0][m][0] * scale + bg0, g1 = acc[ai][0][m][1] * scale + bg1, u0 = acc[ai][1][m][0] * scale + bu0, u1 = acc[ai][1][m][1] * scale + bu1;
                const f32x2 h0 = swiglu2((f32x2){g0[0], g0[1]}, (f32x2){u0[0], u0[1]}), h1 = swiglu2((f32x2){g0[2], g0[3]}, (f32x2){u0[2], u0[3]});
                const f32x2 h2 = swiglu2((f32x2){g1[0], g1[1]}, (f32x2){u1[0], u1[1]}), h3 = swiglu2((f32x2){g1[2], g1[3]}, (f32x2){u1[2], u1[3]});
                u32x2 w; w.x = pk_fp8x4(h0.x, h0.y, h1.x, h1.y); w.y = pk_fp8x4(h2.x, h2.y, h3.x, h3.y);
                *(u32x2*)(O + (size_t)(row0 + ai * HALF + m * 16) * D + hc) = w;
            }
    }
};

typedef int i32x8 __attribute__((ext_vector_type(8)));
typedef int i32x4 __attribute__((ext_vector_type(4)));
template <class Epi, class Sched, bool GATHER, int ESZ = 2>
__device__ __forceinline__ void gemm_phase(LAS unsigned char* lds, const int K, const Sched& S, const Epi& E) {
    const int tid = tid_(), wid = __builtin_amdgcn_readfirstlane(tid >> 6), lane = tid & 63, wr = wid >> 2, wc = wid & 3, fr = lane & 15, fq = lane >> 4;
    const int nt = K * ESZ / 128, KP = K * ESZ;
    int sR[2], sC[2];
    unsigned voffB[2];
#pragma unroll
    for (int i = 0; i < 2; ++i) { stage_rc(tid * 16 + i * 8192, sR[i], sC[i]); const int Rb = Epi::PERM ? ((sR[i] & ~31) + perm32(sR[i] & 31)) : sR[i]; voffB[i] = (unsigned)(Rb * KP + sC[i] * 2); }
    unsigned cvA0[2], cvA1[2], nvA0[2], nvA1[2];
#define G8_VOFF(u, v0, v1) do { _Pragma("unroll") for (int _i = 0; _i < 2; ++_i) { \
        if (GATHER) { unsigned t0_ = (unsigned)(u).rows[sR[_i]], t1_ = (unsigned)(u).rows[HALF + sR[_i]]; t0_ = t0_ < (unsigned)T ? t0_ : 0u; t1_ = t1_ < (unsigned)T ? t1_ : 0u;     \
            v0[_i] = t0_ * (unsigned)KP + (unsigned)(sC[_i] * 2); v1[_i] = t1_ * (unsigned)KP + (unsigned)(sC[_i] * 2); } \
        else { v0[_i] = (unsigned)(sR[_i] * KP + sC[_i] * 2); v1[_i] = v0[_i]; } } } while (0)
    const size_t kstep = (size_t)(BK * 2);
    const unsigned ldsw = (unsigned)wid * 1024u;
    const int aoff = lds_byte(wr * 64 + fr, fq * 8), boff = lds_byte(wc * 32 + fr, fq * 8);
#define PG8_SA(b, h) (((b) * 2 + (h)) * HTB)
#define PG8_SB(b, h) ((4 + (b) * 2 + (h)) * HTB)
#define PG8_STAGE(bufoff, gbase, voff) do { _Pragma("unroll") for (int _i = 0; _i < 2; ++_i) \
        __builtin_amdgcn_global_load_lds((const unsigned*)((const char*)(gbase) + (voff)[_i]), (LAS unsigned*)(lds + (bufoff) + ldsw + _i * 8192), 16, 0, 0); } while (0)
#define PG8_LDA(dst, b, h) do { _Pragma("unroll") for (int m = 0; m < 4; ++m) { dst[m].lo = *(const LAS i32x4*)(lds + PG8_SA(b, h) + aoff + m * 2048); dst[m].hi = *(const LAS i32x4*)(lds + PG8_SA(b, h) + aoff + m * 2048 + 1024); } } while (0)
#define PG8_LDB(dst, b, h) do { _Pragma("unroll") for (int n = 0; n < 2; ++n) { dst[n].lo = *(const LAS i32x4*)(lds + PG8_SB(b, h) + boff + n * 2048); dst[n].hi = *(const LAS i32x4*)(lds + PG8_SB(b, h) + boff + n * 2048 + 1024); } } while (0)
#define PG8_MMA(ai, bj, At, Bt) do { __builtin_amdgcn_s_setprio(1); _Pragma("unroll") for (int m = 0; m < 4; ++m) _Pragma("unroll") for (int n = 0; n < 2; ++n) { \
        if (ESZ == 2) { acc[ai][bj][m][n] = __builtin_amdgcn_mfma_f32_16x16x32_bf16(__builtin_bit_cast(bf16x8, (i32x4)__builtin_shufflevector(Bt[n], Bt[n], 0, 1, 2, 3)), __builtin_bit_cast(bf16x8, (i32x4)__builtin_shufflevector(At[m], At[m], 0, 1, 2, 3)), acc[ai][bj][m][n], 0, 0, 0); \
                        acc[ai][bj][m][n] = __builtin_amdgcn_mfma_f32_16x16x32_bf16(__builtin_bit_cast(bf16x8, (i32x4)__builtin_shufflevector(Bt[n], Bt[n], 4, 5, 6, 7)), __builtin_bit_cast(bf16x8, (i32x4)__builtin_shufflevector(At[m], At[m], 4, 5, 6, 7)), acc[ai][bj][m][n], 0, 0, 0); } \
        else asm volatile("v_mfma_f32_16x16x128_f8f6f4 %0, %1, %2, %0" : "+v"(acc[ai][bj][m][n]) : "v"(Bt[n]), "v"(At[m])); } __builtin_amdgcn_s_setprio(0); } while (0)
#define PG8_WAIT_V(n) asm volatile("s_waitcnt vmcnt(" #n ")" ::: "memory")
#define PG8_WAIT_L(n) asm volatile("s_waitcnt lgkmcnt(" #n ")" ::: "memory")
#define PG8_BAR __builtin_amdgcn_s_barrier()
#define PG8_SCHED __builtin_amdgcn_sched_barrier(0)
    Unit cur, nxt; int ui = 0;
    if (!S.next(0, cur)) return;
    f32x4 acc[2][2][4][2];
#pragma unroll
    for (int a = 0; a < 2; ++a)
#pragma unroll
        for (int b = 0; b < 2; ++b)
#pragma unroll
            for (int m = 0; m < 4; ++m)
#pragma unroll
                for (int n = 0; n < 2; ++n) acc[a][b][m][n] = (f32x4){0.f, 0.f, 0.f, 0.f};
    i32x8 At[4], B0[2], B1[2];
    const char* cA0 = cur.a0; const char* cA1 = cur.a1; const char* cB0 = cur.b0; const char* cB1 = cur.b1;
    G8_VOFF(cur, cvA0, cvA1);
    PG8_STAGE(PG8_SB(0, 0), cB0, voffB); PG8_STAGE(PG8_SB(0, 1), cB1, voffB); PG8_STAGE(PG8_SA(0, 0), cA0, cvA0); PG8_STAGE(PG8_SA(0, 1), cA1, cvA1);
    if (wr == 1) PG8_BAR;
    PG8_WAIT_V(2); PG8_BAR;
    PG8_STAGE(PG8_SB(1, 0), cB0 + kstep, voffB); PG8_STAGE(PG8_SA(1, 0), cA0 + kstep, cvA0); PG8_STAGE(PG8_SB(1, 1), cB1 + kstep, voffB);
    PG8_WAIT_V(6); PG8_BAR;
    for (;;) {
        const bool has_next = S.next(ui + 1, nxt);
        const char* nA0 = has_next ? nxt.a0 : cA0; const char* nA1 = has_next ? nxt.a1 : cA1; const char* nB0 = has_next ? nxt.b0 : cB0; const char* nB1 = has_next ? nxt.b1 : cB1;
        if (GATHER) { if (has_next) { G8_VOFF(nxt, nvA0, nvA1); } else { nvA0[0] = cvA0[0]; nvA0[1] = cvA0[1]; nvA1[0] = cvA1[0]; nvA1[1] = cvA1[1]; } }
        const LAS float* bl = (const LAS float*)(lds + BIASL_OFF + (ui & 1) * 2048 + wr * 1024);
#pragma unroll 1
        for (int t = 0; t < nt; t += 2) {
            const bool last = (t == nt - 2);
            const char* a1_1 = cA1 + (size_t)(t + 1) * kstep;
            const char* a2_0 = last ? nA0 : cA0 + (size_t)(t + 2) * kstep; const char* a2_1 = last ? nA1 : cA1 + (size_t)(t + 2) * kstep;
            const char* b2_0 = last ? nB0 : cB0 + (size_t)(t + 2) * kstep; const char* b2_1 = last ? nB1 : cB1 + (size_t)(t + 2) * kstep;
            const char* a3_0 = a2_0 + kstep; const char* b3_0 = b2_0 + kstep; const char* b3_1 = b2_1 + kstep;
            unsigned vA0[2], vA1[2];
            if (GATHER) { vA0[0] = last ? nvA0[0] : cvA0[0]; vA0[1] = last ? nvA0[1] : cvA0[1]; vA1[0] = last ? nvA1[0] : cvA1[0]; vA1[1] = last ? nvA1[1] : cvA1[1]; }
            else { vA0[0] = cvA0[0]; vA0[1] = cvA0[1]; vA1[0] = cvA0[0]; vA1[1] = cvA0[1]; }
            PG8_LDB(B0, 0, 0); PG8_LDB(B1, 0, 1); PG8_SCHED; PG8_LDA(At, 0, 0);
            if (Epi::BIASL && t == 0) __builtin_amdgcn_global_load_lds((const unsigned*)E.bias_src(cur, (wid & 3) * 64 + lane), (LAS unsigned*)(lds + BIASL_OFF + (ui & 1) * 2048 + wid * 256), 4, 0, 0);
            PG8_STAGE(PG8_SA(1, 1), a1_1, cvA1);
            PG8_WAIT_V(8); PG8_WAIT_L(0); PG8_BAR; PG8_MMA(0, 0, At, B0); PG8_MMA(0, 1, At, B1); PG8_BAR; PG8_SCHED;
            PG8_LDA(At, 0, 1); PG8_STAGE(PG8_SB(0, 0), b2_0, voffB); PG8_STAGE(PG8_SB(0, 1), b2_1, voffB); PG8_STAGE(PG8_SA(0, 0), a2_0, vA0);
            PG8_WAIT_V(8); PG8_WAIT_L(0); PG8_BAR; PG8_MMA(1, 0, At, B0); PG8_MMA(1, 1, At, B1); PG8_BAR; PG8_SCHED;
            PG8_LDB(B0, 1, 0); PG8_LDB(B1, 1, 1); PG8_SCHED; PG8_LDA(At, 1, 0); PG8_STAGE(PG8_SA(0, 1), a2_1, vA1);
            PG8_WAIT_V(8); PG8_WAIT_L(0); PG8_BAR; PG8_MMA(0, 0, At, B0); PG8_MMA(0, 1, At, B1); PG8_BAR; PG8_SCHED;
            PG8_LDA(At, 1, 1); PG8_STAGE(PG8_SB(1, 0), b3_0, voffB); PG8_STAGE(PG8_SB(1, 1), b3_1, voffB); PG8_STAGE(PG8_SA(1, 0), a3_0, vA0);
            PG8_WAIT_V(8); PG8_WAIT_L(0); PG8_BAR; PG8_MMA(1, 0, At, B0); PG8_MMA(1, 1, At, B1); PG8_BAR; PG8_SCHED;
        }
        if (wr == 0) PG8_BAR;
        if (ESZ == 1) asm volatile("s_nop 15\n\ts_nop 15" ::: "memory");
        if constexpr (Epi::STAGED) E.staged(acc, cur, wr, wc, fr, fq, lds, tid); else E(acc, cur, wr, wc, fr, fq, bl);
        if (!has_next) break;
#pragma unroll
        for (int a = 0; a < 2; ++a)
#pragma unroll
            for (int b = 0; b < 2; ++b)
#pragma unroll
                for (int m = 0; m < 4; ++m)
#pragma unroll
                    for (int n = 0; n < 2; ++n) acc[a][b][m][n] = (f32x4){0.f, 0.f, 0.f, 0.f};
        cur = nxt; cA0 = nA0; cA1 = nA1; cB0 = nB0; cB1 = nB1; ++ui;
        if (GATHER) { cvA0[0] = nvA0[0]; cvA0[1] = nvA0[1]; cvA1[0] = nvA1[0]; cvA1[1] = nvA1[1]; }
        if (wr == 1) PG8_BAR;
    }
    PG8_WAIT_V(0);
    PG8_BAR;
#undef G8_VOFF
#undef PG8_SA
#undef PG8_SB
#undef PG8_STAGE
#undef PG8_LDA
#undef PG8_LDB
#undef PG8_MMA
#undef PG8_WAIT_V
#undef PG8_WAIT_L
#undef PG8_BAR
#undef PG8_SCHED
}
}


template <bool F8>
__device__ __forceinline__ void convert_big(LAS unsigned char* lds, const float* src, void* dstv, int K, int N, int batch, float scale) {
    const int tid = tid_(), lane = tid & 63, wid = tid >> 6;
    const int nbn = N / 256, per = (K / 128) * nbn, total = per * batch, G = (int)gridDim.x;
    constexpr int ESZ = F8 ? 1 : 2, ROWB = 128 * ESZ, TILEB = 256 * ROWB;
    f32x4 ra[16], rb[16];
#define CV_LOAD(uu, reg) do { const int ur_ = total - 1 - (uu), bidx = ur_ / per, r_ = ur_ % per, kb = r_ / nbn, nb = r_ % nbn; \
        const float* sp = src + (size_t)bidx * K * N + (size_t)(kb * 128 + 16 * wid) * N + nb * 256 + 4 * lane; \
        _Pragma("unroll") for (int i = 0; i < 16; ++i) reg[i] = __builtin_nontemporal_load((const f32x4*)(sp + (size_t)i * N)); } while (0)
#define CV_PACK(reg, tl) do { _Pragma("unroll") for (int j = 0; j < 4; ++j) { \
        if (F8) { u32x4 w0; w0.x = pk_fp8x4(reg[0][j] * scale, reg[1][j] * scale, reg[2][j] * scale, reg[3][j] * scale); w0.y = pk_fp8x4(reg[4][j] * scale, reg[5][j] * scale, reg[6][j] * scale, reg[7][j] * scale); \
            w0.z = pk_fp8x4(reg[8][j] * scale, reg[9][j] * scale, reg[10][j] * scale, reg[11][j] * scale); w0.w = pk_fp8x4(reg[12][j] * scale, reg[13][j] * scale, reg[14][j] * scale, reg[15][j] * scale); \
            *(LAS u32x4*)((tl) + (4 * lane + j) * ROWB + ((wid ^ (lane & 7)) * 16)) = w0; } \
        else { u32x4 w0, w1; \
            w0.x = g8::cvt_pk_bf16(reg[0][j], reg[1][j]); w0.y = g8::cvt_pk_bf16(reg[2][j], reg[3][j]); w0.z = g8::cvt_pk_bf16(reg[4][j], reg[5][j]); w0.w = g8::cvt_pk_bf16(reg[6][j], reg[7][j]); \
            w1.x = g8::cvt_pk_bf16(reg[8][j], reg[9][j]); w1.y = g8::cvt_pk_bf16(reg[10][j], reg[11][j]); w1.z = g8::cvt_pk_bf16(reg[12][j], reg[13][j]); w1.w = g8::cvt_pk_bf16(reg[14][j], reg[15][j]); \
            *(LAS u32x4*)((tl) + (4 * lane + j) * ROWB + (((2 * wid) ^ (lane & 15)) * 16)) = w0; *(LAS u32x4*)((tl) + (4 * lane + j) * ROWB + (((2 * wid + 1) ^ (lane & 15)) * 16)) = w1; } } } while (0)
#define CV_STORE(uu, tl) do { const int ur_ = total - 1 - (uu), bidx = ur_ / per, r_ = ur_ % per, kb = r_ / nbn, nb = r_ % nbn; \
        unsigned char* dp = (unsigned char*)dstv + ((size_t)bidx * N * K + (size_t)(nb * 256) * K + kb * 128) * ESZ; \
        _Pragma("unroll") for (int i = 0; i < 4 * ESZ; ++i) { const int pc = tid + NTHREADS * i, n = pc / (8 * ESZ), c = pc % (8 * ESZ); \
            *(u32x4*)(dp + (size_t)n * K * ESZ + c * 16) = *(const LAS u32x4*)((tl) + n * ROWB + ((c ^ ((n >> 2) & (8 * ESZ - 1))) * 16)); } } while (0)
    const int u0 = blockIdx.x;
    if (u0 < total) CV_LOAD(u0, ra);
    if (u0 + G < total) CV_LOAD(u0 + G, rb);
    for (int u = u0; u < total; u += 2 * G) {
        CV_PACK(ra, lds);
        if (u + 2 * G < total) CV_LOAD(u + 2 * G, ra);
        __syncthreads();
        CV_STORE(u, lds);
        const bool has_b = (u + G < total);
        if (has_b) { CV_PACK(rb, lds + TILEB); if (u + 3 * G < total) CV_LOAD(u + 3 * G, rb); }
        __syncthreads();
        if (has_b) CV_STORE(u + G, lds + TILEB);
    }
    __syncthreads();
#undef CV_LOAD
#undef CV_PACK
#undef CV_STORE
}

constexpr int CQ_TAIL_GU = 3, CQ_TAIL_DN = 2;
constexpr int CQ_DED_PER_ROUND = 4;
constexpr int CQ_GU_PER_L = NEXP * 64, CQ_DN_PER_L = NEXP * 32, CQ_PER_L = CQ_GU_PER_L + CQ_DN_PER_L, CQ_TOTAL = (DEPTH - 1) * CQ_PER_L;
struct CvUnit { const float* sp; unsigned char* dp; int N; float scale; };
__device__ __forceinline__ void cq_decode(const Params& p, int q, CvUnit& u) {
    const int layer = 1 + q / CQ_PER_L, r = q % CQ_PER_L; const bool gu = r < CQ_GU_PER_L;
    const int r2 = gu ? r : r - CQ_GU_PER_L, per = gu ? 64 : 32, nbn = gu ? 8 : 4, N = gu ? 2048 : 1024;
    const int e = r2 / per, w = r2 % per, kb = w / nbn, nb = w % nbn;
    const size_t mat = (size_t)(layer * NEXP + e);
    u.sp = (gu ? p.moe_w_gu : p.moe_w_down) + mat * 1024 * N + (size_t)(kb * 128) * N + nb * 256;
    u.dp = p.ws + (gu ? WS_GU : WS_DN) + mat * N * 1024 + (size_t)(nb * 256) * 1024 + kb * 128;
    u.N = N; u.scale = gu ? GU_WSCALE : DN_WSCALE;
}
#define CQ_LOAD(u, reg) do { const float* sp_ = (u).sp + (size_t)(16 * wid) * (u).N + 4 * lane; _Pragma("unroll") for (int i = 0; i < 16; ++i) reg[i] = __builtin_nontemporal_load((const f32x4*)(sp_ + (size_t)i * (u).N)); } while (0)
#define CQ_PACK(reg, tl, sc) do { _Pragma("unroll") for (int j = 0; j < 4; ++j) { u32x4 w0; w0.x = pk_fp8x4(reg[0][j] * sc, reg[1][j] * sc, reg[2][j] * sc, reg[3][j] * sc); w0.y = pk_fp8x4(reg[4][j] * sc, reg[5][j] * sc, reg[6][j] * sc, reg[7][j] * sc); \
            w0.z = pk_fp8x4(reg[8][j] * sc, reg[9][j] * sc, reg[10][j] * sc, reg[11][j] * sc); w0.w = pk_fp8x4(reg[12][j] * sc, reg[13][j] * sc, reg[14][j] * sc, reg[15][j] * sc); \
            *(LAS u32x4*)((tl) + (4 * lane + j) * 128 + ((wid ^ (lane & 7)) * 16)) = w0; } } while (0)
#define CQ_STORE(u, tl) do { _Pragma("unroll") for (int i = 0; i < 4; ++i) { const int pc = tid + NTHREADS * i, n = pc >> 3, c = pc & 7; \
            *(u32x4*)((u).dp + (size_t)n * 1024 + c * 16) = *(const LAS u32x4*)((tl) + n * 128 + ((c ^ ((n >> 2) & 7)) * 16)); } } while (0)
__device__ __forceinline__ void convert_range(LAS unsigned char* lds, const Params& p, int layer, int u0, int end, int stride) {
    const int tid = tid_(), lane = tid & 63, wid = tid >> 6;
    constexpr int TILEB = 256 * 128;
    const int qb = (layer - 1) * CQ_PER_L;
    int u = u0;
    f32x4 ra[16], rb[16];
    CvUnit ua, ub, un;
    if (u < end) { cq_decode(p, qb + u, ua); CQ_LOAD(ua, ra); }
    if (u + stride < end) { cq_decode(p, qb + u + stride, ub); CQ_LOAD(ub, rb); }
    for (; u < end; u += 2 * stride) {
        CQ_PACK(ra, lds, ua.scale);
        const bool ha = u + 2 * stride < end;
        if (ha) { cq_decode(p, qb + u + 2 * stride, un); CQ_LOAD(un, ra); }
        __syncthreads();
        CQ_STORE(ua, lds);
        if (ha) ua = un;
        const bool has_b = u + stride < end, hb = u + 3 * stride < end;
        if (has_b) { CQ_PACK(rb, lds + TILEB, ub.scale); if (hb) { cq_decode(p, qb + u + 3 * stride, un); CQ_LOAD(un, rb); } }
        __syncthreads();
        if (has_b) { CQ_STORE(ub, lds + TILEB); if (hb) ub = un; }
    }
    __syncthreads();
}
__device__ __forceinline__ void convert_tail(LAS unsigned char* lds, const Params& p, int nl, int budget) {
    if (budget <= 0) return;
    unsigned* cq = (unsigned*)(p.ws + WS_CTL) + CW_CQ + 64 * nl;
    LAS int* slot = (LAS int*)(lds + 2 * 256 * 128);
    __syncthreads();
    if (tid_() == 0) { const unsigned g = xb_add(cq, (unsigned)budget); slot[0] = g < (unsigned)CQ_PER_L ? (int)g : CQ_PER_L; }
    __syncthreads();
    const int u0 = slot[0], end = u0 + budget < CQ_PER_L ? u0 + budget : CQ_PER_L;
    convert_range(lds, p, nl, u0, end, 1);
}
__device__ __forceinline__ void convert_rest(LAS unsigned char* lds, const Params& p, int layer) {
    unsigned* cq = (unsigned*)(p.ws + WS_CTL) + CW_CQ + 64 * layer;
    LAS int* slot = (LAS int*)(lds + 2 * 256 * 128);
    __syncthreads();
    if (tid_() == 0) { const unsigned g = xb_ld(cq); slot[0] = g < (unsigned)CQ_PER_L ? (int)g : CQ_PER_L; }
    __syncthreads();
    convert_range(lds, p, layer, slot[0] + (int)blockIdx.x, CQ_PER_L, (int)gridDim.x);
}
#undef CQ_LOAD
#undef CQ_PACK
#undef CQ_STORE

__device__ __forceinline__ float gelu_fast(float x) { const float u2 = 1.5957691216057308f * (x + 0.044715f * x * x * x); return x * __builtin_amdgcn_rcpf(1.0f + __builtin_amdgcn_exp2f(-1.4426950408889634f * u2)); }
__device__ __forceinline__ void lru_gates_phase(LAS unsigned char* lds, const Params& p, int idx) {
    const int tid = tid_(), lane = tid & 63, wid = tid >> 6, fr = lane & 15, fq = lane >> 4;
    LAS bf16_t* xcb = (LAS bf16_t*)lds;
    LAS float* xcf = (LAS float*)(lds + 17408);
    LAS float* sa = (LAS float*)(lds + 17408 + 33792);
    LAS float* sb = sa + 64 * 132;
    LAS float* comb = sb + 64 * 132;
    const unsigned char* u = p.ws + WS_U;
    bf16_t* Carr = (bf16_t*)(p.ws + WS_SCR); bf16_t* Barr = Carr + (size_t)T * D;
    float* SP = (float*)(p.ws + WS_LSUM); float* SH = SP + NBATCH * 32 * D;
    const int hd = blockIdx.x & 7, slot = blockIdx.x >> 3, nslots = gridDim.x >> 3;
    const float* conv_w = p.a_conv_w + (size_t)idx * 4 * D; const float* conv_b = p.a_conv_b + (size_t)idx * D;
    const bf16_t* wrt = (const bf16_t*)(p.ws + WS_AGT) + ((size_t)(idx * 2 + 0) * 8 + hd) * 128 * 128;
    const bf16_t* wit = (const bf16_t*)(p.ws + WS_AGT) + ((size_t)(idx * 2 + 1) * 8 + hd) * 128 * 128;
    bf16x8 Br[4], Bi[4];
#pragma unroll
    for (int ks = 0; ks < 4; ++ks) { Br[ks] = *(const bf16x8*)(wrt + (size_t)(16 * wid + fr) * 128 + 32 * ks + 8 * fq); Bi[ks] = *(const bf16x8*)(wit + (size_t)(16 * wid + fr) * 128 + 32 * ks + 8 * fq); }
    const int cg = hd * 128 + 16 * wid + 4 * fq;
    const f32x4 brv = *(const f32x4*)(p.a_b_rgate + (size_t)idx * D + cg), biv = *(const f32x4*)(p.a_b_igate + (size_t)idx * D + cg), lmv = *(const f32x4*)(p.a_lambda + (size_t)idx * D + cg);
    f32x4 spv;
#pragma unroll
    for (int r = 0; r < 4; ++r) spv[r] = (lmv[r] > 15.f) ? __expf(-lmv[r]) : log1pf(__expf(-lmv[r]));
    const int cc = (tid & 31) * 4, cch = hd * 128 + cc;
    f32x4 cw[4];
#pragma unroll
    for (int j = 0; j < 4; ++j) cw[j] = *(const f32x4*)(conv_w + j * D + cch);
    const f32x4 cb = *(const f32x4*)(conv_b + cch);
    unsigned rvn[4][4];
#define LRU_LOAD(tile_) do { _Pragma("unroll") for (int k = 0; k < 4; ++k) { const int t = (tile_) * 64 + (tid >> 5) + 16 * k, s_ = t & (SEQ - 1); \
        _Pragma("unroll") for (int j = 0; j < 4; ++j) rvn[k][j] = (s_ - 3 + j >= 0) ? *(const unsigned*)(u + (size_t)(t - 3 + j) * 2048 + 1024 + cch) : 0u; } } while (0)
    if (slot < T / 64) LRU_LOAD(slot);
    for (int tile = slot; tile < T / 64; tile += nslots) {
        const int t0 = tile * 64;
#pragma unroll
        for (int k = 0; k < 4; ++k) {
            const int tl = (tid >> 5) + 16 * k;
            f32x4 acc = cb;
#pragma unroll
            for (int j = 0; j < 4; ++j) {
                const f32x2_ r01 = __builtin_amdgcn_cvt_pk_f32_fp8((int)rvn[k][j], false), r23 = __builtin_amdgcn_cvt_pk_f32_fp8((int)rvn[k][j], true);
                acc[0] += cw[j][0] * r01.x; acc[1] += cw[j][1] * r01.y;
                acc[2] += cw[j][2] * r23.x; acc[3] += cw[j][3] * r23.y;
            }
            *(LAS f32x4*)(xcf + tl * 132 + cc) = acc;
            u32x2 w; w.x = pack2(acc[0], acc[1]); w.y = pack2(acc[2], acc[3]);
            *(LAS u32x2*)(xcb + tl * 136 + cc) = w;
        }
        if (tile + nslots < T / 64) LRU_LOAD(tile + nslots);
        __syncthreads();
        f32x4 ar[4], ai[4];
#pragma unroll
        for (int mt = 0; mt < 4; ++mt) { ar[mt] = (f32x4){0.f, 0.f, 0.f, 0.f}; ai[mt] = (f32x4){0.f, 0.f, 0.f, 0.f}; }
#pragma unroll
        for (int ks = 0; ks < 4; ++ks)
#pragma unroll
            for (int mt = 0; mt < 4; ++mt) {
                const bf16x8 af = *(const LAS bf16x8*)(xcb + (mt * 16 + fr) * 136 + 32 * ks + 8 * fq);
                ar[mt] = __builtin_amdgcn_mfma_f32_16x16x32_bf16(Br[ks], af, ar[mt], 0, 0, 0);
                ai[mt] = __builtin_amdgcn_mfma_f32_16x16x32_bf16(Bi[ks], af, ai[mt], 0, 0, 0);
            }
#pragma unroll
        for (int mt = 0; mt < 4; ++mt) {
            const int tl = mt * 16 + fr, cl = 16 * wid + 4 * fq;
            const f32x4 rec = *(const LAS f32x4*)(xcf + tl * 132 + cl);
            f32x4 av, bv, cv;
#pragma unroll
            for (int r = 0; r < 4; ++r) {
                const float rg = sigmoidf_(ar[mt][r] + brv[r]), ig = sigmoidf_(ai[mt][r] + biv[r]);
                const float xl = -8.0f * rg * spv[r];
                const float cex = -xl * (1.0f + xl * (0.5f + xl * (0.16666667f + xl * (0.041666668f + xl * 0.0083333338f))));
                const float cc_ = bf2f(f2bf(cex));
                av[r] = 1.0f - cc_; cv[r] = cc_;
                bv[r] = bf2f(f2bf(__builtin_amdgcn_sqrtf(fmaxf(cex * (2.0f - cex), 0.f)) * ig * rec[r]));
            }
            { u32x2 wc_, wb_; wc_.x = pack2(cv[0], cv[1]); wc_.y = pack2(cv[2], cv[3]); wb_.x = pack2(bv[0], bv[1]); wb_.y = pack2(bv[2], bv[3]);
              *(u32x2*)(Carr + (size_t)(t0 + tl) * D + cg) = wc_; *(u32x2*)(Barr + (size_t)(t0 + tl) * D + cg) = wb_; }
            *(LAS f32x4*)(sa + tl * 132 + cl) = av; *(LAS f32x4*)(sb + tl * 132 + cl) = bv;
        }
        __syncthreads();
        {
            const int j = tid & 127, q = tid >> 7;
            float P = 1.f, H = 0.f;
#pragma unroll
            for (int s_ = 0; s_ < 16; ++s_) { const float a = sa[(q * 16 + s_) * 132 + j], bb = sb[(q * 16 + s_) * 132 + j]; H = a * H + bb; P *= a; }
            comb[(q * 128 + j) * 2 + 0] = P; comb[(q * 128 + j) * 2 + 1] = H;
        }
        __syncthreads();
        if (tid < 128) {
            float P = comb[tid * 2], H = comb[tid * 2 + 1];
#pragma unroll
            for (int q = 1; q < 4; ++q) { const float Pq = comb[(q * 128 + tid) * 2], Hq = comb[(q * 128 + tid) * 2 + 1]; H = Pq * H + Hq; P *= Pq; }
            SP[(size_t)tile * D + hd * 128 + tid] = P; SH[(size_t)tile * D + hd * 128 + tid] = H;
        }
    }
}
#undef LRU_LOAD
__device__ __forceinline__ void lru_scan_phase(const Params& p) {
    const int tid = tid_();
    const unsigned char* u = p.ws + WS_U;
    const bf16_t* Carr = (const bf16_t*)(p.ws + WS_SCR); const bf16_t* Barr = Carr + (size_t)T * D;
    const float* SP = (const float*)(p.ws + WS_LSUM); const float* SH = SP + NBATCH * 32 * D;
    unsigned char* yin = p.ws + WS_YIN;
    typedef float f32x2 __attribute__((ext_vector_type(2)));
    for (int tile = blockIdx.x; tile < NBATCH * 32; tile += gridDim.x) {
        const int c = 2 * tid, b = tile >> 5, chunk = tile & 31;
        const size_t tb = (size_t)tile * 64;
        unsigned cwA[16], bwA[16], gwA[16], cwB[16], bwB[16], gwB[16];
#define SC_LOAD(S, s0) do { _Pragma("unroll") for (int j = 0; j < 16; ++j) { const size_t t = tb + (s0) + j; cw##S[j] = __builtin_nontemporal_load((const unsigned*)(Carr + t * D + c)); \
            bw##S[j] = __builtin_nontemporal_load((const unsigned*)(Barr + t * D + c)); gw##S[j] = (unsigned)__builtin_nontemporal_load((const unsigned short*)(u + t * 2048 + c)); } } while (0)
#define SC_SCAN(S, s0) do { _Pragma("unroll") for (int j = 0; j < 16; ++j) { const size_t t = tb + (s0) + j; \
            h0 = (1.0f - __uint_as_float(cw##S[j] << 16)) * h0 + __uint_as_float(bw##S[j] << 16); h1 = (1.0f - __uint_as_float(cw##S[j] & 0xffff0000u)) * h1 + __uint_as_float(bw##S[j] & 0xffff0000u); \
            const f32x2_ gg = __builtin_amdgcn_cvt_pk_f32_fp8((int)gw##S[j], false); \
            *(unsigned short*)(yin + t * D + c) = (unsigned short)__builtin_amdgcn_cvt_pk_fp8_f32(yq_(gelu_fast(gg.x) * h0), yq_(gelu_fast(gg.y) * h1), 0, false); } } while (0)
        SC_LOAD(A, 0);
        f32x2 sp[31], sh[31];
#pragma unroll
        for (int k = 0; k < 31; ++k) { const bool on = k < chunk; const size_t o = (size_t)(b * 32 + (on ? k : 0)) * D + c;
            sp[k] = *(const f32x2*)(SP + o); sh[k] = *(const f32x2*)(SH + o); if (!on) { sp[k] = (f32x2){1.f, 1.f}; sh[k] = (f32x2){0.f, 0.f}; } }
        float h0 = 0.f, h1 = 0.f;
#pragma unroll
        for (int k = 0; k < 31; ++k) { h0 = sp[k][0] * h0 + sh[k][0]; h1 = sp[k][1] * h1 + sh[k][1]; }
        SC_LOAD(B, 16); SC_SCAN(A, 0);
        SC_LOAD(A, 32); SC_SCAN(B, 16);
        SC_LOAD(B, 48); SC_SCAN(A, 32);
        SC_SCAN(B, 48);
#undef SC_LOAD
#undef SC_SCAN
    }
}

typedef short s16x4 __attribute__((ext_vector_type(4)));
__device__ __forceinline__ s16x4 tr4(LAS const unsigned char* base, int row0, int col0, int stride, int lane) {
    const int q = (lane & 15) >> 2, pp = lane & 3;
    return __builtin_amdgcn_ds_read_tr16_b64_v4i16((LAS s16x4*)(base + (row0 + q) * stride + (col0 + 4 * pp) * 2));
}
__device__ __forceinline__ bf16x8 cat8(s16x4 a, s16x4 b) { return (bf16x8){a[0], a[1], a[2], a[3], b[0], b[1], b[2], b[3]}; }
__device__ __forceinline__ void ret_core_phase(LAS unsigned char* lds, const Params& p) {
    const int tid0_ = tid_(); const int tid = tid0_, lane = tid & 63, wid = tid >> 6, fr = lane & 15, fq = lane >> 4;
    constexpr int KS = 528, VS = 160, SS = 528;
    LAS unsigned char* Kl = lds;
    LAS unsigned char* Vl = lds + 128 * KS;
    LAS unsigned char* Sl = Vl + 128 * VS;
    const bf16_t* ul_ = (const bf16_t*)(p.ws + WS_U);
    const unsigned char* ul8_ = p.ws + WS_UKV;
    bf16_t* RO = (bf16_t*)(p.ws + WS_SCR);
    for (int un = blockIdx.x; un < NBATCH * 4 * 8; un += gridDim.x) {
        const int b = un >> 5, h = (un >> 3) & 3, vs = un & 7;
        const float lg2 = log2f(1.0f - exp2f(-5.0f - (float)h));
        f32x4 Sacc[2][4];
#pragma unroll
        for (int dt = 0; dt < 2; ++dt)
#pragma unroll
            for (int vt = 0; vt < 4; ++vt) Sacc[dt][vt] = (f32x4){0.f, 0.f, 0.f, 0.f};
        for (int i = tid; i < 64 * SS / 16; i += NTHREADS) ((LAS u32x4*)Sl)[i] = (u32x4){0u, 0u, 0u, 0u};
        u32x4 kraw[8]; u32x2 vraw[2]; bf16x8 Qf[8];
#define RET_LOAD(ch_) do { const size_t tl_ = (size_t)b * SEQ + (ch_) * 128; const bf16_t* u = ul_; const unsigned char* u8 = ul8_; int tid = tid0_; asm volatile("" : "+s"(u), "+s"(u8), "+v"(tid));     \
            _Pragma("unroll") for (int i = 0; i < 8; ++i) { const int piece = tid + NTHREADS * i, m = piece >> 5, ch = piece & 31; kraw[i] = *(const u32x4*)(u + (tl_ + m) * 2048 + 1024 + h * 256 + ch * 8); } \
            _Pragma("unroll") for (int i = 0; i < 2; ++i) { const int piece = tid + NTHREADS * i, m = piece >> 3, ch = piece & 7; vraw[i] = *(const u32x2*)(u8 + (tl_ + m) * 4096 + h * 512 + vs * 64 + ch * 8); } } while (0)
#define RET_LOADQ(ch_) do { const size_t tl_ = (size_t)b * SEQ + (ch_) * 128; const bf16_t* u = ul_; int tid = tid0_; asm volatile("" : "+s"(u), "+v"(tid)); const int wid = tid >> 6, fr = tid & 15, fq = (tid & 63) >> 4; \
            _Pragma("unroll") for (int ks = 0; ks < 8; ++ks) Qf[ks] = *(const bf16x8*)(u + (tl_ + 16 * wid + fr) * 2048 + h * 256 + 32 * ks + 8 * fq); } while (0)
        RET_LOAD(0); RET_LOADQ(0);
        for (int chunk = 0; chunk < 16; ++chunk) {
            const size_t t0 = (size_t)b * SEQ + chunk * 128;
            int tst = tid0_; asm volatile("" : "+v"(tst));
#pragma unroll
            for (int i = 0; i < 8; ++i) {
                const int piece = tst + NTHREADS * i, m = piece >> 5, ch = piece & 31;
                *(LAS u32x4*)(Kl + m * KS + ch * 16) = kraw[i];
            }
#pragma unroll
            for (int i = 0; i < 2; ++i) {
                const int piece = tst + NTHREADS * i, m = piece >> 3, ch = piece & 7;
                const u32x2 kv = vraw[i];
                const float sc = __builtin_amdgcn_exp2f(-(float)(m + 1) * lg2) * 0.0625f;
                const f32x2_ v0 = __builtin_amdgcn_cvt_pk_f32_fp8((int)kv.x, false), v1 = __builtin_amdgcn_cvt_pk_f32_fp8((int)kv.x, true), v2 = __builtin_amdgcn_cvt_pk_f32_fp8((int)kv.y, false), v3 = __builtin_amdgcn_cvt_pk_f32_fp8((int)kv.y, true);
                u32x4 w;
                w.x = pack2(v0.x * sc, v0.y * sc); w.y = pack2(v1.x * sc, v1.y * sc); w.z = pack2(v2.x * sc, v2.y * sc); w.w = pack2(v3.x * sc, v3.y * sc);
                *(LAS u32x4*)(Vl + m * VS + ch * 16) = w;
            }
            __syncthreads();
            if (chunk + 1 < 16) RET_LOAD(chunk + 1);
            f32x4 sc[8];
#pragma unroll
            for (int mt = 0; mt < 8; ++mt) {
                sc[mt] = (f32x4){0.f, 0.f, 0.f, 0.f};
#pragma unroll
                for (int ks = 0; ks < 8; ++ks) {
                    const bf16x8 kf = *(const LAS bf16x8*)(Kl + (16 * mt + fr) * KS + (32 * ks + 8 * fq) * 2);
                    sc[mt] = __builtin_amdgcn_mfma_f32_16x16x32_bf16(kf, Qf[ks], sc[mt], 0, 0, 0);
                }
                if (mt & 1) __builtin_amdgcn_sched_barrier(0);
            }
            bf16x8 pf[4];
            const int nloc = 16 * wid + fr;
#pragma unroll
            for (int ks2 = 0; ks2 < 4; ++ks2) {
                float v[8];
#pragma unroll
                for (int t = 0; t < 2; ++t)
#pragma unroll
                    for (int r = 0; r < 4; ++r) { const int m = 32 * ks2 + 16 * t + 4 * fq + r; v[4 * t + r] = (m <= nloc) ? sc[2 * ks2 + t][r] : 0.f; }
                u32x4 w; w.x = pack2(v[0], v[1]); w.y = pack2(v[2], v[3]); w.z = pack2(v[4], v[5]); w.w = pack2(v[6], v[7]);
                pf[ks2] = __builtin_bit_cast(bf16x8, w);
            }
            f32x4 O[4];
#pragma unroll
            for (int vt = 0; vt < 4; ++vt) {
                O[vt] = (f32x4){0.f, 0.f, 0.f, 0.f};
#pragma unroll
                for (int ks2 = 0; ks2 < 4; ++ks2) {
                    const bf16x8 vf = cat8(tr4(Vl, 32 * ks2 + 4 * fq, 16 * vt, VS, lane), tr4(Vl, 32 * ks2 + 16 + 4 * fq, 16 * vt, VS, lane));
                    O[vt] = __builtin_amdgcn_mfma_f32_16x16x32_bf16(pf[ks2], vf, O[vt], 0, 0, 0);
                }
#pragma unroll
                for (int ks = 0; ks < 8; ++ks) {
                    const bf16x8 sf = *(const LAS bf16x8*)(Sl + (16 * vt + fr) * SS + (32 * ks + 8 * fq) * 2);
                    O[vt] = __builtin_amdgcn_mfma_f32_16x16x32_bf16(Qf[ks], sf, O[vt], 0, 0, 0);
                }
                __builtin_amdgcn_sched_barrier(0);
            }
#pragma unroll
            for (int r = 0; r < 4; ++r) {
                const int n = 16 * wid + 4 * fq + r;
                const float qd = exp2f((float)(n + 1) * lg2);
                bf16_t* op = RO + (t0 + n) * 2048 + h * 512 + vs * 64 + fr;
#pragma unroll
                for (int vt = 0; vt < 4; ++vt) op[16 * vt] = f2bf(O[vt][r] * qd);
            }
            if (chunk + 1 < 16) RET_LOADQ(chunk + 1);
#pragma unroll
            for (int ks3 = 0; ks3 < 4; ++ks3) {
                bf16x8 kt[2], vf[4];
#pragma unroll
                for (int dt = 0; dt < 2; ++dt) kt[dt] = cat8(tr4(Kl, 32 * ks3 + 8 * fq, 32 * wid + 16 * dt, KS, lane), tr4(Kl, 32 * ks3 + 8 * fq + 4, 32 * wid + 16 * dt, KS, lane));
#pragma unroll
                for (int vt = 0; vt < 4; ++vt) vf[vt] = cat8(tr4(Vl, 32 * ks3 + 8 * fq, 16 * vt, VS, lane), tr4(Vl, 32 * ks3 + 8 * fq + 4, 16 * vt, VS, lane));
#pragma unroll
                for (int dt = 0; dt < 2; ++dt)
#pragma unroll
                    for (int vt = 0; vt < 4; ++vt) Sacc[dt][vt] = __builtin_amdgcn_mfma_f32_16x16x32_bf16(kt[dt], vf[vt], Sacc[dt][vt], 0, 0, 0);
                __builtin_amdgcn_sched_barrier(0);
            }
            __syncthreads();
            const float cd = exp2f(128.0f * lg2);
#pragma unroll
            for (int dt = 0; dt < 2; ++dt)
#pragma unroll
                for (int vt = 0; vt < 4; ++vt) {
                    Sacc[dt][vt] *= cd;
                    u32x2 w; w.x = pack2(Sacc[dt][vt][0], Sacc[dt][vt][1]); w.y = pack2(Sacc[dt][vt][2], Sacc[dt][vt][3]);
                    *(LAS u32x2*)(Sl + (16 * vt + fr) * SS + (32 * wid + 16 * dt + 4 * fq) * 2) = w;
                }
        }
        __syncthreads();
#undef RET_LOAD
#undef RET_LOADQ
    }
}
__device__ __forceinline__ void ret_norm_phase(LAS unsigned char* lds, const Params& p) {
    const int tid = tid_(), lane = tid & 63, wid = tid >> 6;
    const unsigned char* u8 = p.ws + WS_UKV;
    const bf16_t* RO = (const bf16_t*)(p.ws + WS_SCR);
    unsigned char* yin = p.ws + WS_YIN;
    const int nwu = T * 4, stride = (int)gridDim.x * 8;
    for (int wu0 = blockIdx.x * 8 + wid; wu0 < nwu; wu0 += 4 * stride) {
        u32x4 ov[4]; u32x2 gv[4];
#pragma unroll
        for (int q = 0; q < 4; ++q) { const int wu = wu0 + q * stride; const size_t t = (size_t)(wu >> 2); const int h = wu & 3;
            if (wu < nwu) { ov[q] = __builtin_nontemporal_load((const u32x4*)(RO + t * 2048 + h * 512 + lane * 8)); gv[q] = __builtin_nontemporal_load((const u32x2*)(u8 + t * 4096 + 2048 + h * 512 + lane * 8)); } }
#pragma unroll
        for (int q = 0; q < 4; ++q) { const int wu = wu0 + q * stride; const size_t t = (size_t)(wu >> 2); const int h = wu & 3;
            if (wu < nwu) {
                float o[8], g[8];
                o[0] = __uint_as_float(ov[q].x << 16); o[1] = __uint_as_float(ov[q].x & 0xffff0000u); o[2] = __uint_as_float(ov[q].y << 16); o[3] = __uint_as_float(ov[q].y & 0xffff0000u);
                o[4] = __uint_as_float(ov[q].z << 16); o[5] = __uint_as_float(ov[q].z & 0xffff0000u); o[6] = __uint_as_float(ov[q].w << 16); o[7] = __uint_as_float(ov[q].w & 0xffff0000u);
                { const f32x2_ g0 = __builtin_amdgcn_cvt_pk_f32_fp8((int)gv[q].x, false), g1 = __builtin_amdgcn_cvt_pk_f32_fp8((int)gv[q].x, true), g2 = __builtin_amdgcn_cvt_pk_f32_fp8((int)gv[q].y, false), g3 = __builtin_amdgcn_cvt_pk_f32_fp8((int)gv[q].y, true);
                  g[0] = g0.x; g[1] = g0.y; g[2] = g1.x; g[3] = g1.y; g[4] = g2.x; g[5] = g2.y; g[6] = g3.x; g[7] = g3.y; }
                float ss = 0.f;
#pragma unroll
                for (int j = 0; j < 8; ++j) ss += o[j] * o[j];
                const float rstd = rsqrtf(wave_sum(ss) * (1.0f / 512.0f) + 1e-6f);
                float y[8];
#pragma unroll
                for (int j = 0; j < 8; ++j) y[j] = g[j] * sigmoidf_(g[j]) * o[j] * rstd;
                u32x2 w; w.x = pk_yq4(y[0], y[1], y[2], y[3]); w.y = pk_yq4(y[4], y[5], y[6], y[7]);
                *(u32x2*)(yin + t * 2048 + h * 512 + lane * 8) = w;
            } }
    }
}

__device__ __forceinline__ void attn_core_phase(LAS unsigned char* lds, const Params& p) {
    const int tid0_ = tid_(); const int tid = tid0_, lane = tid & 63, wid = tid >> 6, fr = lane & 15, fq = lane >> 4;
    constexpr int RS = 144, TILE = 272 * RS;
    LAS unsigned char* Kl = lds;
    LAS unsigned char* Vl = lds + TILE;
    const bf16_t* u = (const bf16_t*)(p.ws + WS_U);
    const unsigned char* ukv = p.ws + WS_UKV;
    bf16_t* OP = (bf16_t*)(p.ws + WS_SCR);
    float* LSE = (float*)(p.ws + WS_SCR + 96 * MB);
    for (int i = tid; i < 16 * RS / 16; i += NTHREADS) { ((LAS u32x4*)(Kl + 256 * RS))[i] = (u32x4){0u, 0u, 0u, 0u}; ((LAS u32x4*)(Vl + 256 * RS))[i] = (u32x4){0u, 0u, 0u, 0u}; }
    u32x2 kraw[4], vraw[4]; bf16x8 Qn[2];
#define ATT_DECODE(un_) const int g = (un_) >> 11, rem = (un_) & 2047, b = rem >> 8, h = (rem >> 4) & 15, x = rem & 15; \
        const int dl = (g == 0) ? 1 : (g == 1 ? 4 : 16), r_ = x & (dl - 1), n = x / dl
#define ATT_LOAD(un_) do { ATT_DECODE(un_); int tl_ = tid0_; const bf16_t* ub = u; const unsigned char* ub8 = ukv; asm volatile("" : "+v"(tl_), "+s"(ub), "+s"(ub8)); ub += (size_t)b * SEQ * 3072; ub8 += (size_t)b * SEQ * 6144; \
        _Pragma("unroll") for (int i = 0; i < 4; ++i) { const int piece = tl_ + NTHREADS * i, row = piece >> 3, ch = piece & 7; const int sk = ((n - 1) * 128 + row) * dl + r_; \
            kraw[i] = (u32x2){0u, 0u}; vraw[i] = (u32x2){0u, 0u}; \
            if (sk >= 0) { const unsigned char* src = ub8 + (size_t)sk * 6144 + g * 1024 + h * 64 + ch * 8; kraw[i] = *(const u32x2*)(src); vraw[i] = *(const u32x2*)(src + 3072); } } \
        { const int sq_ = (n * 128 + 16 * (tl_ >> 6) + (tl_ & 15)) * dl + r_; \
          _Pragma("unroll") for (int ks = 0; ks < 2; ++ks) Qn[ks] = *(const bf16x8*)(ub + (size_t)sq_ * 3072 + g * 1024 + h * 64 + 32 * ks + 8 * ((tl_ & 63) >> 4)); } } while (0)
    if ((int)blockIdx.x < 3 * 2048) ATT_LOAD((int)blockIdx.x);
    for (int un = blockIdx.x; un < 3 * 2048; un += gridDim.x) {
        ATT_DECODE(un);
        const float slope = exp2f(-0.5f * (float)(h + 1)) * (float)dl;
        { int tl_ = tid0_; asm volatile("" : "+v"(tl_));
#pragma unroll
          for (int i = 0; i < 4; ++i) {
            const int piece = tl_ + NTHREADS * i, row = piece >> 3, ch = piece & 7;
            *(LAS u32x4*)(Kl + row * RS + ch * 16) = fp8x8_to_bf16x8(kraw[i]); *(LAS u32x4*)(Vl + row * RS + ch * 16) = fp8x8_to_bf16x8(vraw[i]);
          } }
        const int qi = 16 * wid + fr, sq = (n * 128 + qi) * dl + r_;
        bf16x8 Qf[2];
#pragma unroll
        for (int ks = 0; ks < 2; ++ks) Qf[ks] = Qn[ks];
        __syncthreads();
        if (un + (int)gridDim.x < 3 * 2048) ATT_LOAD(un + (int)gridDim.x);
        f32x4 sc[9];
        float mx = -INFINITY;
#pragma unroll
        for (int kt = 0; kt < 9; ++kt) {
            sc[kt] = (f32x4){0.f, 0.f, 0.f, 0.f};
#pragma unroll
            for (int ks = 0; ks < 2; ++ks) {
                const bf16x8 kf = *(const LAS bf16x8*)(Kl + (16 * (wid + kt) + fr) * RS + (32 * ks + 8 * fq) * 2);
                sc[kt] = __builtin_amdgcn_mfma_f32_16x16x32_bf16(kf, Qf[ks], sc[kt], 0, 0, 0);
            }
#pragma unroll
            for (int r = 0; r < 4; ++r) {
                const int ki = 16 * (wid + kt) + 4 * fq + r, steps = qi + 128 - ki;
                const bool ok = (steps >= 0) && (steps <= 128) && (n > 0 || ki >= 128);
                const float v = ok ? sc[kt][r] * 0.125f - slope * (float)steps : -INFINITY;
                sc[kt][r] = v; mx = fmaxf(mx, v);
            }
        }
        mx = fmaxf(mx, __shfl_xor(mx, 16)); mx = fmaxf(mx, __shfl_xor(mx, 32));
        float l = 0.f;
#pragma unroll
        for (int kt = 0; kt < 9; ++kt)
#pragma unroll
            for (int r = 0; r < 4; ++r) { const float pv = __expf(sc[kt][r] - mx); sc[kt][r] = pv; l += pv; }
        l += __shfl_xor(l, 16); l += __shfl_xor(l, 32);
        f32x4 O[4];
#pragma unroll
        for (int dt = 0; dt < 4; ++dt) O[dt] = (f32x4){0.f, 0.f, 0.f, 0.f};
#pragma unroll
        for (int ks5 = 0; ks5 < 5; ++ks5) {
            const f32x4 p0 = sc[2 * ks5], p1 = (ks5 < 4) ? sc[(ks5 < 4) ? 2 * ks5 + 1 : 0] : (f32x4){0.f, 0.f, 0.f, 0.f};
            u32x4 w; w.x = pack2(p0[0], p0[1]); w.y = pack2(p0[2], p0[3]); w.z = pack2(p1[0], p1[1]); w.w = pack2(p1[2], p1[3]);
            const bf16x8 pf = __builtin_bit_cast(bf16x8, w);
#pragma unroll
            for (int dt = 0; dt < 4; ++dt) {
                const bf16x8 vf = cat8(tr4(Vl, 16 * (wid + 2 * ks5) + 4 * fq, 16 * dt, RS, lane), tr4(Vl, 16 * (wid + 2 * ks5 + 1) + 4 * fq, 16 * dt, RS, lane));
                O[dt] = __builtin_amdgcn_mfma_f32_16x16x32_bf16(vf, pf, O[dt], 0, 0, 0);
            }
        }
        const float inv = __builtin_amdgcn_rcpf(l);
        const size_t tq = (size_t)b * SEQ + sq;
#pragma unroll
        for (int dt = 0; dt < 4; ++dt) {
            u32x2 w; w.x = pack2(O[dt][0] * inv, O[dt][1] * inv); w.y = pack2(O[dt][2] * inv, O[dt][3] * inv);
            *(u32x2*)(OP + ((size_t)g * T + tq) * D + h * 64 + 16 * dt + 4 * fq) = w;
        }
        if (fq == 0) LSE[((size_t)g * T + tq) * 16 + h] = mx + __logf(l);
        __syncthreads();
    }
#undef ATT_DECODE
#undef ATT_LOAD
}
__device__ __forceinline__ void attn_merge_phase(const Params& p) {
    const int tid = tid_();
    const bf16_t* OP = (const bf16_t*)(p.ws + WS_SCR);
    const float* LSE = (const float*)(p.ws + WS_SCR + 96 * MB);
    unsigned char* yin = p.ws + WS_YIN;
    const size_t n = (size_t)T * D / 8, stride = (size_t)gridDim.x * NTHREADS;
    for (size_t i0 = (size_t)blockIdx.x * NTHREADS + tid; i0 < n; i0 += 4 * stride) {
        u32x4 a[4], bq[4], c[4]; float l0[4], l1[4], l2[4];
#pragma unroll
        for (int q = 0; q < 4; ++q) { const size_t i = i0 + q * stride; if (i < n) { const size_t t = i >> 7; const int c8 = (int)(i & 127), h = c8 >> 3;
            l0[q] = LSE[t * 16 + h]; l1[q] = LSE[((size_t)T + t) * 16 + h]; l2[q] = LSE[((size_t)2 * T + t) * 16 + h];
            a[q] = __builtin_nontemporal_load((const u32x4*)(OP + t * D + c8 * 8)); bq[q] = __builtin_nontemporal_load((const u32x4*)(OP + ((size_t)T + t) * D + c8 * 8)); c[q] = __builtin_nontemporal_load((const u32x4*)(OP + ((size_t)2 * T + t) * D + c8 * 8)); } }
#pragma unroll
        for (int q = 0; q < 4; ++q) { const size_t i = i0 + q * stride; if (i < n) { const size_t t = i >> 7; const int c8 = (int)(i & 127);
            const float m = fmaxf(l0[q], fmaxf(l1[q], l2[q]));
            float w0 = __expf(l0[q] - m), w1 = __expf(l1[q] - m), w2 = __expf(l2[q] - m);
            const float inv = __builtin_amdgcn_rcpf(w0 + w1 + w2); w0 *= inv; w1 *= inv; w2 *= inv;
            u32x2 o;
#define MRGL(f) (w0 * __uint_as_float(a[q].f << 16) + w1 * __uint_as_float(bq[q].f << 16) + w2 * __uint_as_float(c[q].f << 16))
#define MRGH(f) (w0 * __uint_as_float(a[q].f & 0xffff0000u) + w1 * __uint_as_float(bq[q].f & 0xffff0000u) + w2 * __uint_as_float(c[q].f & 0xffff0000u))
            o.x = pk_yq4(MRGL(x), MRGH(x), MRGL(y), MRGH(y)); o.y = pk_yq4(MRGL(z), MRGH(z), MRGL(w), MRGH(w));
#undef MRGL
#undef MRGH
            *(u32x2*)(yin + t * D + c8 * 8) = o; } }
    }
}

__device__ __forceinline__ void ln1_router_phase(LAS unsigned char* lds, const Params& p, int layer) {
    const int tid = tid_(), lane = tid & 63, wid = tid >> 6, fr = lane & 15, fq = lane >> 4;
    constexpr int XS = 2064;
    LAS unsigned char* xh = lds;
    LAS unsigned char* xl = lds + 16 * XS;
    LAS float* part = (LAS float*)(lds + 32 * XS);
    LAS float* logit = part + 8 * 16 * 32;
    LAS int* tkE = (LAS int*)(logit + 16 * 32);
    LAS int* tkR = tkE + 512;
    LAS int* hist = tkR + 512;
    LAS int* hbase = hist + 32;
    bf16_t* xres = (bf16_t*)(p.ws + WS_XF);
    const unsigned char* ymix = p.ws + WS_YMIX;
    int* tope = (int*)(p.ws + WS_TOPE); float* gates = (float*)(p.ws + WS_GATES); int* pos = (int*)(p.ws + WS_POS);
    unsigned char* xq = p.ws + WS_XQ; int* elist = (int*)(p.ws + WS_LIST);
    unsigned* ctl = (unsigned*)(p.ws + WS_CTL);
    const float* gain = p.ln_gain + (size_t)(layer * 2) * D; const float* bias = p.ln_bias + (size_t)(layer * 2) * D;
    const float* brt = p.moe_b_router + (size_t)layer * NEXP;
    const bf16_t* rth = (const bf16_t*)(p.ws + WS_RT) + (size_t)layer * 2 * NEXP * D; const bf16_t* rtl = rth + NEXP * D;
    bf16x8 Wh[2][4], Wl[2][4];
#pragma unroll
    for (int nt = 0; nt < 2; ++nt)
#pragma unroll
        for (int ks = 0; ks < 4; ++ks) { const size_t o = (size_t)(16 * nt + fr) * D + 128 * wid + 32 * ks + 8 * fq; Wh[nt][ks] = *(const bf16x8*)(rth + o); Wl[nt][ks] = *(const bf16x8*)(rtl + o); }
    if (tid < NEXP) hist[tid] = 0;
    int it = 0;
    f32x4 xr4[2][4]; u32x2 xr2[2][4]; unsigned ymr[2][4];
#define LN1_LOAD(tile_) do { _Pragma("unroll") for (int tt = 0; tt < 2; ++tt) { const size_t t = (size_t)(tile_) * 16 + 2 * wid + tt; \
        _Pragma("unroll") for (int i = 0; i < 4; ++i) { const int c = 256 * i + 4 * lane; ymr[tt][i] = __builtin_nontemporal_load((const unsigned*)(ymix + t * D + c)); \
            if (layer == 0) xr4[tt][i] = *(const f32x4*)(p.x + t * D + c); else xr2[tt][i] = *(const u32x2*)(xres + t * D + c); } } } while (0)
    if ((int)blockIdx.x < T / 16) LN1_LOAD((int)blockIdx.x);
    const float my_brt = brt[lane & 31];
    for (int tile = blockIdx.x; tile < T / 16; tile += gridDim.x) {
#pragma unroll
        for (int tt = 0; tt < 2; ++tt) {
            const int trow = 2 * wid + tt; const size_t t = (size_t)tile * 16 + trow;
            f32x4 z[4];
#pragma unroll
            for (int i = 0; i < 4; ++i) { const f32x2_ y01 = __builtin_amdgcn_cvt_pk_f32_fp8((int)ymr[tt][i], false), y23 = __builtin_amdgcn_cvt_pk_f32_fp8((int)ymr[tt][i], true);
                f32x4 xv_;
                if (layer == 0) xv_ = xr4[tt][i];
                else { const u32x2 xw = xr2[tt][i]; xv_ = (f32x4){__uint_as_float(xw.x << 16), __uint_as_float(xw.x & 0xffff0000u), __uint_as_float(xw.y << 16), __uint_as_float(xw.y & 0xffff0000u)}; }
                z[i] = DN_ALPHA * xv_ + (f32x4){y01.x, y01.y, y23.x, y23.y} * (1.0f / YMSCALE); }
            float sm = 0.f;
#pragma unroll
            for (int i = 0; i < 4; ++i) sm += (z[i][0] + z[i][1]) + (z[i][2] + z[i][3]);
            const float mean = wave_sum(sm) * (1.0f / D);
            float sq = 0.f;
#pragma unroll
            for (int i = 0; i < 4; ++i) { const f32x4 dd = z[i] - mean; sq += (dd[0] * dd[0] + dd[1] * dd[1]) + (dd[2] * dd[2] + dd[3] * dd[3]); }
            const float rstd = rsqrtf(wave_sum(sq) * (1.0f / D) + LN_EPS);
#pragma unroll
            for (int i = 0; i < 4; ++i) {
                const int c = 256 * i + 4 * lane;
                const f32x4 v = (z[i] - mean) * rstd * *(const f32x4*)(gain + c) + *(const f32x4*)(bias + c);
                u32x2 wh; wh.x = pack2(v[0], v[1]); wh.y = pack2(v[2], v[3]);
                *(u32x2*)(xres + t * D + c) = wh;
                *(unsigned*)(xq + t * D + c) = pk_fp8x4(v[0], v[1], v[2], v[3]);
                const float r0 = v[0] - __uint_as_float(wh.x << 16), r1 = v[1] - __uint_as_float(wh.x & 0xffff0000u), r2 = v[2] - __uint_as_float(wh.y << 16), r3 = v[3] - __uint_as_float(wh.y & 0xffff0000u);
                u32x2 wl; wl.x = pack2(r0, r1); wl.y = pack2(r2, r3);
                *(LAS u32x2*)(xh + trow * XS + c * 2) = wh; *(LAS u32x2*)(xl + trow * XS + c * 2) = wl;
            }
        }
        if (tile + (int)gridDim.x < T / 16) LN1_LOAD(tile + (int)gridDim.x);
        __syncthreads();
        {
            f32x4 acc[2] = {(f32x4){0.f, 0.f, 0.f, 0.f}, (f32x4){0.f, 0.f, 0.f, 0.f}};
#pragma unroll
            for (int ks = 0; ks < 4; ++ks) {
                const bf16x8 ah = *(const LAS bf16x8*)(xh + fr * XS + (128 * wid + 32 * ks + 8 * fq) * 2), al = *(const LAS bf16x8*)(xl + fr * XS + (128 * wid + 32 * ks + 8 * fq) * 2);
#pragma unroll
                for (int nt = 0; nt < 2; ++nt) {
                    acc[nt] = __builtin_amdgcn_mfma_f32_16x16x32_bf16(Wh[nt][ks], ah, acc[nt], 0, 0, 0);
                    acc[nt] = __builtin_amdgcn_mfma_f32_16x16x32_bf16(Wh[nt][ks], al, acc[nt], 0, 0, 0);
                    acc[nt] = __builtin_amdgcn_mfma_f32_16x16x32_bf16(Wl[nt][ks], ah, acc[nt], 0, 0, 0);
                }
            }
#pragma unroll
            for (int nt = 0; nt < 2; ++nt) *(LAS f32x4*)(part + (wid * 16 + fr) * 32 + 16 * nt + 4 * fq) = acc[nt];
        }
        __syncthreads();
        {
            const int e = lane & 31;
            float vv[2]; unsigned key[2];
#pragma unroll
            for (int tt = 0; tt < 2; ++tt) {
                float v = my_brt;
#pragma unroll
                for (int w = 0; w < 8; ++w) v += part[(w * 16 + 2 * wid + tt) * 32 + e];
                vv[tt] = v;
                const unsigned ub = __float_as_uint(v);
                key[tt] = ((ub ^ (unsigned)(((int)ub >> 31) | 0x80000000)) & ~31u) | (unsigned)(31 - e);
            }
            float tv[2][4]; int te[2][4];
#pragma unroll
            for (int k = 0; k < 4; ++k) {
                const unsigned m[2] = {half_umax(key[0]), half_umax(key[1])};
#pragma unroll
                for (int tt = 0; tt < 2; ++tt) { const int idx = 31 - (int)(m[tt] & 31u); te[tt][k] = idx; tv[tt][k] = __shfl(vv[tt], idx); if (e == idx) key[tt] = 0u; }
            }
            if (lane == 0) {
#pragma unroll
                for (int tt = 0; tt < 2; ++tt) {
                    const int trow = 2 * wid + tt; const size_t t = (size_t)tile * 16 + trow;
                    const float e1 = __expf(tv[tt][1] - tv[tt][0]), e2 = __expf(tv[tt][2] - tv[tt][0]), e3 = __expf(tv[tt][3] - tv[tt][0]), inv = 1.0f / (1.0f + e1 + e2 + e3);
                    *(i32x4v*)(tope + t * 4) = (i32x4v){te[tt][0], te[tt][1], te[tt][2], te[tt][3]};
                    *(f32x4*)(gates + t * 4) = (f32x4){inv, e1 * inv, e2 * inv, e3 * inv};
                    const int sl = (it & 7) * 16 + trow;
#pragma unroll
                    for (int k = 0; k < 4; ++k) { tkE[sl * 4 + k] = te[tt][k]; tkR[sl * 4 + k] = (int)atomicAdd((unsigned*)(hist + te[tt][k]), 1u); }
                }
            }
        }
        ++it;
        if ((it & 7) == 0 || tile + (int)gridDim.x >= T / 16) {
            __syncthreads();
            if (tid < NEXP) { const unsigned h = (unsigned)hist[tid]; hbase[tid] = h ? (int)atomicAdd(ctl + CW_CNT + layer * 64 + tid, h) : 0; hist[tid] = 0; }
            __syncthreads();
            const int nsl = (((it - 1) & 7) + 1) * 16;
            for (int a = tid; a < nsl * 4; a += NTHREADS) {
                const int sl = a >> 2, e = tkE[a], ps = hbase[e] + tkR[a];
                const int t = (tile - (((it - 1) & 7) - (sl >> 4)) * (int)gridDim.x) * 16 + (sl & 15);
                pos[t * 4 + (a & 3)] = ps; elist[(size_t)e * T + ps] = t;
            }
            __syncthreads();
        }
    }
    __syncthreads();
#undef LN1_LOAD
}
__device__ __forceinline__ void ln2_phase(LAS unsigned char* lds, const Params& p, int layer) {
    const int tid = tid_(), lane = tid & 63, wid = tid >> 6;
    moe_tables(lds, (const unsigned*)(p.ws + WS_CTL), layer);
    LAS const int* tab = (LAS const int*)(lds + TAB_OFF);
    const int* tope = (const int*)(p.ws + WS_TOPE); const int* pos = (const int*)(p.ws + WS_POS);
    bf16_t* xh = (bf16_t*)(p.ws + WS_XF);
    const unsigned char* yrows = p.ws + WS_YROWS;
    const float* gates = (const float*)(p.ws + WS_GATES);
    const float* gain = p.ln_gain + (size_t)(layer * 2 + 1) * D; const float* bias = p.ln_bias + (size_t)(layer * 2 + 1) * D;
    const int stride = (int)gridDim.x * 8;
    i32x4v ten[2], psn[2]; f32x4 gtn[2];
#define LN2_REC(t0_) do { _Pragma("unroll") for (int q = 0; q < 2; ++q) { const int t = ((t0_) + q * stride < T) ? (t0_) + q * stride : (t0_); \
        ten[q] = *(const i32x4v*)(tope + t * 4); psn[q] = *(const i32x4v*)(pos + t * 4); gtn[q] = *(const f32x4*)(gates + t * 4); } } while (0)
    if ((int)blockIdx.x * 8 + wid < T) LN2_REC((int)blockIdx.x * 8 + wid);
    for (int t0 = blockIdx.x * 8 + wid; t0 < T; t0 += 2 * stride) {
        int dk[2][4]; float gk[2][4];
#pragma unroll
        for (int q = 0; q < 2; ++q)
#pragma unroll
            for (int k = 0; k < 4; ++k) { dk[q][k] = tab[ten[q][k]] * 256 + psn[q][k]; gk[q][k] = gtn[q][k]; }
        if (t0 + 2 * stride < T) LN2_REC(t0 + 2 * stride);
        unsigned yv[2][4][4]; u32x2 xv[2][4];
#pragma unroll
        for (int q = 0; q < 2; ++q) { const int t = (t0 + q * stride < T) ? t0 + q * stride : t0;
#pragma unroll
            for (int i = 0; i < 4; ++i) { const int c = 256 * i + 4 * lane; xv[q][i] = *(const u32x2*)(xh + (size_t)t * D + c);
#pragma unroll
                for (int k = 0; k < 4; ++k) yv[q][i][k] = __builtin_nontemporal_load((const unsigned*)(yrows + (size_t)dk[q][k] * D + c)); } }
#pragma unroll
        for (int q = 0; q < 2; ++q) { const int t = t0 + q * stride; if (t < T) {
            f32x4 z[4];
#pragma unroll
            for (int i = 0; i < 4; ++i) {
                f32x4 f = (f32x4){0.f, 0.f, 0.f, 0.f};
#pragma unroll
                for (int k = 0; k < 4; ++k) { const int y4 = (int)yv[q][i][k]; const float gg = gk[q][k];
                    const f32x2 lo = __builtin_amdgcn_cvt_pk_f32_fp8(y4, false), hi = __builtin_amdgcn_cvt_pk_f32_fp8(y4, true);
                    f[0] += gg * lo.x; f[1] += gg * lo.y; f[2] += gg * hi.x; f[3] += gg * hi.y; }
                const u32x2 xw = xv[q][i];
                z[i] = DN_ALPHA * (f32x4){__uint_as_float(xw.x << 16), __uint_as_float(xw.x & 0xffff0000u), __uint_as_float(xw.y << 16), __uint_as_float(xw.y & 0xffff0000u)} + f;
            }
            float sm = 0.f;
#pragma unroll
            for (int i = 0; i < 4; ++i) sm += (z[i][0] + z[i][1]) + (z[i][2] + z[i][3]);
            const float mean = wave_sum(sm) * (1.0f / D);
            float sq = 0.f;
#pragma unroll
            for (int i = 0; i < 4; ++i) { const f32x4 dd = z[i] - mean; sq += (dd[0] * dd[0] + dd[1] * dd[1]) + (dd[2] * dd[2] + dd[3] * dd[3]); }
            const float rstd = rsqrtf(wave_sum(sq) * (1.0f / D) + LN_EPS);
#pragma unroll
            for (int i = 0; i < 4; ++i) {
                const int c = 256 * i + 4 * lane;
                z[i] = (z[i] - mean) * rstd * *(const f32x4*)(gain + c) + *(const f32x4*)(bias + c);
                if (layer == DEPTH - 1) __builtin_nontemporal_store(z[i], (f32x4*)(p.out + (size_t)t * D + c));
                else { u32x2 w; w.x = pack2(z[i][0], z[i][1]); w.y = pack2(z[i][2], z[i][3]); *(u32x2*)(xh + (size_t)t * D + c) = w; *(unsigned*)(p.ws + WS_XQ + (size_t)t * D + c) = pk_fp8x4(z[i][0], z[i][1], z[i][2], z[i][3]); }
            }
        } }
    }
#undef LN2_REC
}

constexpr int PH_PER_LAYER = 9;
constexpr int NPHASES = 1 + DEPTH * PH_PER_LAYER;
constexpr int LDS_BYTES = 150 * 1024;


#ifndef PHMASK
#define PHMASK 0x3FF
#endif
#define PHK(j) ((PHMASK >> (j)) & 1)
#ifndef PROBE_MASK
#define PROBE_MASK 0
#endif
#ifndef PROBE_LAYERS
#define PROBE_LAYERS 0xF
#endif
#define REPS(j) ((((PROBE_MASK) >> (j)) & 1) ? 2 : 1)
#define REPSL(j) (((((PROBE_MASK) >> (j)) & 1) && (((PROBE_LAYERS) >> layer) & 1)) ? 2 : 1)
#define IN(k) (lo <= (k) && (k) < hi)
#if MK_ONE_LAUNCH
#define SEAM(k) do { if (IN(k) && IN((k) + 1)) xcd_barrier_nv(bar.bar, bar.x, bar.st); } while (0)
#else
#define SEAM(k) do {} while (0)
#endif
template <int layer>
__device__ __forceinline__ void run_layer(const Params& p, LAS unsigned char* lds, const XcdBarrier& bar) {
    const int lo = p.ph_lo, hi = p.ph_hi;
    unsigned char* ws = p.ws;
    unsigned* ctl = (unsigned*)(ws + WS_CTL);
        constexpr int base = 1 + layer * PH_PER_LAYER, kind = layer % 3, idx = layer / 3;
        for (int rep_ = 0; rep_ < REPSL(1); ++rep_) if (PHK(1) && IN(base + 0)) {
            constexpr int N = (kind == 0) ? 2048 : (kind == 1 ? 6144 : 9216);
            const unsigned char* Bt = (kind == 0) ? ws + WS_AWIN + (size_t)idx * 2048 * D : (kind == 1 ? ws + WS_BWIN : ws + WS_CWIN);
            g8::SchedPlain S; S.init(ws + WS_XQ, Bt, T, N, D / 2, (int)gridDim.x, (int)blockIdx.x);
            if (kind != 0) { g8::EpiQKV E{(bf16_t*)(ws + WS_U), ws + WS_UKV, 1.0f / GU_WSCALE, kind == 2 ? 3072 : 2048, kind == 2 ? 6144 : 4096}; g8::gemm_phase<g8::EpiQKV, g8::SchedPlain, false, 1>(lds, D, S, E); }
            else { g8::EpiQKV E{(bf16_t*)(ws + WS_U), ws + WS_U, 1.0f / GU_WSCALE, 0, 2048}; g8::gemm_phase<g8::EpiQKV, g8::SchedPlain, false, 1>(lds, D, S, E); }
        }
        SEAM(base + 0);
        for (int rep_ = 0; rep_ < REPSL(2); ++rep_) if (PHK(2) && IN(base + 1)) {
            if (kind == 0) lru_gates_phase(lds, p, idx);
            else if (kind == 1) ret_core_phase(lds, p);
            else attn_core_phase(lds, p);
        }
        SEAM(base + 1);
        for (int rep_ = 0; rep_ < REPSL(3); ++rep_) if (PHK(3) && IN(base + 2)) {
            if (kind == 0) lru_scan_phase(p);
            else if (kind == 1) ret_norm_phase(lds, p);
            else attn_merge_phase(p);
        }
        SEAM(base + 2);
        for (int rep_ = 0; rep_ < REPSL(4); ++rep_) if (PHK(4) && IN(base + 3)) {
            constexpr int K = (kind == 1) ? 2048 : D;
            const unsigned char* Bt = (kind == 0) ? ws + WS_AWOUT + (size_t)idx * D * D : (kind == 1 ? ws + WS_BWOUT : ws + WS_CWOUT);
            g8::SchedPlain S; S.init(ws + WS_YIN, Bt, T, D, K / 2, (int)gridDim.x, (int)blockIdx.x);
            g8::EpiQKV E{(bf16_t*)(ws + WS_YMIX), ws + WS_YMIX, YMSCALE / (OUT_WSCALE * YSCALE), 0, D};
            g8::gemm_phase<g8::EpiQKV, g8::SchedPlain, false, 1>(lds, K, S, E);
        }
        SEAM(base + 3);
        for (int rep_ = 0; rep_ < REPSL(5); ++rep_) if (PHK(5) && IN(base + 4)) {
            if (layer > 0) convert_rest(lds, p, layer);
            ln1_router_phase(lds, p, layer);
        }
        SEAM(base + 4);
        for (int rep_ = 0; rep_ < REPSL(7); ++rep_) if (PHK(7) && IN(base + 6)) {
            moe_tables(lds, ctl, layer);
            g8::SchedGU S{(const char*)(ws + WS_XQ), (const char*)(ws + WS_GU) + (size_t)layer * NEXP * 2048 * D, (const int*)(ws + WS_LIST), (LAS const int*)(lds + TAB_OFF), (int)gridDim.x, (int)blockIdx.x};
            g8::EpiSwiglu E{ws + WS_HID, p.moe_b_gu + (size_t)layer * NEXP * 2048, 1.0f / GU_WSCALE};
            g8::gemm_phase<g8::EpiSwiglu, g8::SchedGU, true, 1>(lds, D, S, E);
            if (layer < DEPTH - 1) {
                const int nblk = __builtin_amdgcn_readfirstlane(((LAS const int*)(lds + TAB_OFF))[32]), c = (int)blockIdx.x, off = (((c >> 3) >> 1) << 1) + ((c & 7) >> 2), nmax = (nblk + 31) >> 5;
                convert_tail(lds, p, layer + 1, ((nmax - 1) * 32 + off >= nblk) ? CQ_TAIL_GU : 0);
            }
        }
        SEAM(base + 6);
        for (int rep_ = 0; rep_ < REPSL(8); ++rep_) if (PHK(8) && IN(base + 7)) {
            moe_tables(lds, ctl, layer);
            const int dn_units = __builtin_amdgcn_readfirstlane(((LAS const int*)(lds + TAB_OFF))[32]) * 4, dn_rounds = (dn_units + (int)gridDim.x - 1) / (int)gridDim.x;
            const int dn_G = (layer < DEPTH - 1 && dn_rounds > 0) ? (dn_units + dn_rounds - 1) / dn_rounds : (int)gridDim.x;
            g8::SchedDown S{(const char*)(ws + WS_HID), (const char*)(ws + WS_DN) + (size_t)layer * NEXP * D * D, (LAS const int*)(lds + TAB_OFF), dn_G, (int)blockIdx.x};
            g8::EpiFp8 E{ws + WS_YROWS, D, p.moe_b_down + (size_t)layer * NEXP * D, D, 1.0f / DN_WSCALE};
            g8::gemm_phase<g8::EpiFp8, g8::SchedDown, false, 1>(lds, D, S, E);
            if (layer < DEPTH - 1) {
                const int c = (int)blockIdx.x;
                convert_tail(lds, p, layer + 1, c >= dn_G ? dn_rounds * CQ_DED_PER_ROUND : (((dn_rounds - 1) * dn_G + c >= dn_units) ? CQ_TAIL_DN : 0));
            }
        }
        SEAM(base + 7);
        for (int rep_ = 0; rep_ < REPSL(9); ++rep_) if (PHK(9) && IN(base + 8)) ln2_phase(lds, p, layer);
        SEAM(base + 8);
    }
#undef IN
#undef SEAM
__global__ void __launch_bounds__(NTHREADS, 2) fwd_kernel(Params p) {
    extern __shared__ __attribute__((aligned(16))) unsigned char lds_raw[];
    LAS unsigned char* lds = (LAS unsigned char*)lds_raw;
    const int lo = p.ph_lo, hi = p.ph_hi;
    unsigned char* ws = p.ws;
    unsigned* ctl = (unsigned*)(ws + WS_CTL);
#if MK_ONE_LAUNCH
    volatile LAS unsigned* bst = (volatile LAS unsigned*)(lds + LDS_BYTES - 16);
    if (threadIdx.x == 0) { bst[0] = 0u; bst[1] = 0u; bst[2] = 0u; bst[3] = 0u; }
    __syncthreads();
    XcdBarrier bar = xcd_barrier_post(ctl, bst);
#define GRID_BAR() xcd_barrier_nv(bar.bar, bar.x, bar.st)
#else
    XcdBarrier bar; bar.bar = ctl; bar.x = 0; bar.st = nullptr;
#define GRID_BAR() do {} while (0)
#endif
#define IN(k) (lo <= (k) && (k) < hi)
#define SEAM(k) do { if (IN(k) && IN((k) + 1)) GRID_BAR(); } while (0)

    for (int rep_ = 0; rep_ < REPS(0); ++rep_) if (PHK(0) && IN(0)) {
        LAS float* tile = (LAS float*)lds;
#pragma unroll 1
        for (int j = 0; j < 5; ++j) {
            const float* src = j == 0 ? p.moe_w_gu : (j == 1 ? p.moe_w_down : (j == 2 ? p.a_w_in : (j == 3 ? p.b_w_in : p.c_w_in)));
            const size_t dsto = j == 0 ? WS_GU : (j == 1 ? WS_DN : (j == 2 ? WS_AWIN : (j == 3 ? WS_BWIN : WS_CWIN)));
            const int N = j == 0 ? 2048 : (j == 1 ? D : (j == 2 ? 2048 : (j == 3 ? 6144 : 9216)));
            const int batch = j < 2 ? NEXP : (j == 2 ? 2 : 1);
            convert_big<true>(lds, src, ws + dsto, D, N, batch, j == 1 ? DN_WSCALE : GU_WSCALE);
        }
#pragma unroll 1
        for (int j = 0; j < 3; ++j) {
            const float* src = j == 0 ? p.a_w_out : (j == 1 ? p.b_w_out : p.c_w_out);
            const size_t dsto = j == 0 ? WS_AWOUT : (j == 1 ? WS_BWOUT : WS_CWOUT);
            convert_big<true>(lds, src, ws + dsto, j == 1 ? 2048 : D, D, j == 0 ? 2 : 1, OUT_WSCALE);
        }
        convert_job(tile, p.a_w_rgate, (bf16_t*)(ws + WS_AGT), 128, 128, 8);
        convert_job(tile, p.a_w_igate, (bf16_t*)(ws + WS_AGT) + (size_t)8 * 128 * 128, 128, 128, 8);
        convert_job(tile, p.a_w_rgate + (size_t)8 * 128 * 128, (bf16_t*)(ws + WS_AGT) + (size_t)16 * 128 * 128, 128, 128, 8);
        convert_job(tile, p.a_w_igate + (size_t)8 * 128 * 128, (bf16_t*)(ws + WS_AGT) + (size_t)24 * 128 * 128, 128, 128, 8);
        {
            bf16_t* rt = (bf16_t*)(ws + WS_RT);
            for (int i = blockIdx.x * NTHREADS + threadIdx.x; i < DEPTH * NEXP * D; i += gridDim.x * NTHREADS) {
                const int l = i / (NEXP * D), r_ = i % (NEXP * D), e = r_ / D, k = r_ % D;
                const float w = p.moe_w_router[((size_t)l * D + k) * NEXP + e];
                const bf16_t hi = f2bf(w); const bf16_t lo = f2bf(w - bf2f(hi));
                rt[((size_t)l * 2 + 0) * NEXP * D + (size_t)e * D + k] = hi; rt[((size_t)l * 2 + 1) * NEXP * D + (size_t)e * D + k] = lo;
            }
        }
        {
            const size_t stride = (size_t)gridDim.x * NTHREADS;
            for (size_t i = (size_t)blockIdx.x * NTHREADS + threadIdx.x; i < (size_t)T * D / 4; i += 4 * stride) {
                f32x4 v[4];
#pragma unroll
                for (int q = 0; q < 4; ++q) v[q] = *(const f32x4*)(p.x + (i + q * stride) * 4);
#pragma unroll
                for (int q = 0; q < 4; ++q) *(unsigned*)(ws + WS_XQ + (i + q * stride) * 4) = pk_fp8x4(v[q][0], v[q][1], v[q][2], v[q][3]);
            }
        }
    }
    SEAM(0);

    run_layer<0>(p, lds, bar); run_layer<1>(p, lds, bar); run_layer<2>(p, lds, bar); run_layer<3>(p, lds, bar);
#undef IN
#undef SEAM
}

extern "C" void kernel_launch(void* const* d_in, const int* in_sizes, int n_in, void* d_out, int out_size, void* d_ws, size_t ws_size, hipStream_t stream) {
    static int grid = 0;
    if (grid == 0) {
        if (n_in != 22 || out_size != T * D || ws_size < WS_END) { fprintf(stderr, "kernel_launch: unexpected shapes (n_in %d out %d ws %zu need %zu)\n", n_in, out_size, ws_size, (size_t)WS_END); grid = -1; return; }
        if (hipFuncSetAttribute((const void*)fwd_kernel, hipFuncAttributeMaxDynamicSharedMemorySize, LDS_BYTES) != hipSuccess) { fprintf(stderr, "kernel_launch: hipFuncSetAttribute failed\n"); grid = -1; return; }
        int dev = 0, cus = 0;
        if (hipGetDevice(&dev) != hipSuccess || hipDeviceGetAttribute(&cus, hipDeviceAttributeMultiprocessorCount, dev) != hipSuccess) { grid = -1; return; }
        grid = cus;
    }
    if (grid < 0) return;
    (void)hipMemsetAsync((char*)d_ws + WS_CTL, 0, CTL_BYTES, stream);
    Params p{};
    const float** pp = (const float**)&p;
    for (int i = 0; i < 22; ++i) pp[i] = (const float*)d_in[i];
    p.out = (float*)d_out; p.ws = (unsigned char*)d_ws;
#if MK_ONE_LAUNCH
    p.ph_lo = 0; p.ph_hi = NPHASES;
    hipLaunchKernelGGL(fwd_kernel, dim3(grid), dim3(NTHREADS), LDS_BYTES, stream, p);
#else
    for (int ph = 0; ph < NPHASES; ++ph) {
        p.ph_lo = ph; p.ph_hi = ph + 1;
        hipLaunchKernelGGL(fwd_kernel, dim3(grid), dim3(NTHREADS), LDS_BYTES, stream, p);
    }
#endif
}
```

```cpp
#include <hip/hip_runtime.h>
#include <stdint.h>
#include <stdio.h>

#ifndef MK_ONE_LAUNCH
#define MK_ONE_LAUNCH 1
#endif

#define LAS __attribute__((address_space(3)))
typedef unsigned short bf16_t;
typedef short bf16x8 __attribute__((ext_vector_type(8)));
typedef float f32x4 __attribute__((ext_vector_type(4)));
typedef unsigned u32x4 __attribute__((ext_vector_type(4)));
typedef unsigned u32x2 __attribute__((ext_vector_type(2)));
typedef int i32x4v __attribute__((ext_vector_type(4)));

constexpr int T = 16384, D = 1024, SEQ = 2048, NBATCH = 8, DEPTH = 4;
constexpr int NEXP = 32, TOPK = 4;
constexpr int MAXROWS = 73728;
constexpr float DN_ALPHA = 1.681792830507429f;
constexpr float LN_EPS = 1e-5f;
constexpr float GU_WSCALE = 64.0f, DN_WSCALE = 128.0f;
constexpr float OUT_WSCALE = 128.0f, YSCALE = 4.0f;
constexpr int NTHREADS = 512;

constexpr size_t MB = 1ull << 20;
constexpr size_t WS_CTL = 0;
constexpr size_t CTL_BYTES = 65536;
constexpr size_t WS_AWIN = 1 * MB;
constexpr size_t WS_AWOUT = WS_AWIN + 8 * MB;
constexpr size_t WS_BWIN = WS_AWOUT + 4 * MB;
constexpr size_t WS_BWOUT = WS_BWIN + 12 * MB;
constexpr size_t WS_CWIN = WS_BWOUT + 4 * MB;
constexpr size_t WS_CWOUT = WS_CWIN + 18 * MB;
constexpr size_t WS_GU = WS_CWOUT + 2 * MB;
constexpr size_t WS_DN = WS_GU + 512 * MB;
constexpr size_t WS_XF = WS_DN + 256 * MB;
constexpr size_t WS_XB = WS_XF + 64 * MB;
constexpr size_t WS_U = WS_XB + 32 * MB;
constexpr size_t WS_UKV = WS_U + 128 * MB;
constexpr size_t WS_YIN = WS_U + 288 * MB;
constexpr size_t WS_YMIX = WS_YIN + 64 * MB;
constexpr size_t WS_SCR = WS_YMIX + 64 * MB;
constexpr size_t WS_TOPE = WS_SCR + 128 * MB;
constexpr size_t WS_GATES = WS_TOPE + 256 * 1024;
constexpr size_t WS_POS = WS_GATES + 256 * 1024;
constexpr size_t WS_DEST = WS_POS + 256 * 1024;
constexpr size_t WS_ROWTOK = WS_DEST + 256 * 1024;
constexpr size_t WS_HID = WS_ROWTOK + 1 * MB;
constexpr size_t WS_YROWS = WS_HID + 144 * MB;
constexpr size_t WS_LSUM = WS_YROWS + 288 * MB;
constexpr size_t WS_AGT = WS_LSUM + 2 * MB;
constexpr size_t WS_RT = WS_AGT + 1 * MB;
constexpr size_t WS_XQ = WS_RT + 1 * MB;
constexpr size_t WS_LIST = WS_XQ + 16 * MB;
constexpr size_t WS_END = WS_LIST + 2 * MB;

constexpr int CW_CNT = 4096;
constexpr int CW_MDYN = 8192;
constexpr int CW_TEXP = 12288;
constexpr int CW_CQ = 15360;

#define XB_TMO      128
#define XB_XCNT(j)  (256  + 64 * (j))
#define XB_XSUB(j)  (1280 + 64 * (j))
#define XB_XGEN(j)  (2304 + 64 * (j))
#define XB_TOP      3328
#define XB_TOPGEN   3392
#define XCD_BAR_WORDS 3456
#define XB_SPIN_CAP (1u << 22)

__device__ __forceinline__ unsigned xb_ld(unsigned* p)              { return __hip_atomic_load(p, __ATOMIC_RELAXED, __HIP_MEMORY_SCOPE_AGENT); }
__device__ __forceinline__ unsigned xb_add(unsigned* p, unsigned v) { return __hip_atomic_fetch_add(p, v, __ATOMIC_RELAXED, __HIP_MEMORY_SCOPE_AGENT); }
__device__ __forceinline__ unsigned xb_xcc_id() { return (unsigned)__builtin_amdgcn_s_getreg((3 << 11) | 20) & 0xFu; }
#define XB_SPIN(cond, bar) do { unsigned _sp = 0; while (cond) { __builtin_amdgcn_s_sleep(1); \
    if ((++_sp & 255u) == 0u) { if (xb_ld(&(bar)[XB_TMO])) break; if (_sp > XB_SPIN_CAP) { atomicAdd(&(bar)[XB_TMO], 1u); break; } } } } while (0)

struct XcdBarrier { unsigned* bar; unsigned x; volatile LAS unsigned* st; };

__device__ __forceinline__ XcdBarrier xcd_barrier_post(unsigned* bar, volatile LAS unsigned* st) {
    XcdBarrier b; b.bar = bar; b.x = xb_xcc_id(); b.st = st;
    if (threadIdx.x == 0) (void)xb_add(&bar[XB_XCNT(b.x)], 1u);
    return b;
}
__device__ __forceinline__ void xcd_barrier_complete(unsigned* bar, unsigned x, unsigned& nloc, unsigned& nx) {
    const unsigned G = gridDim.x * gridDim.y * gridDim.z;
    unsigned sum, cnt, mine, sp = 0u;
    for (;;) {
        sum = 0u; cnt = 0u; mine = 0u;
#pragma unroll
        for (unsigned j = 0; j < 16; ++j) { const unsigned c = xb_ld(&bar[XB_XCNT(j)]); sum += c; cnt += (c > 0u) ? 1u : 0u; mine = (j == x) ? c : mine; }
        if (sum == G) break;
        __builtin_amdgcn_s_sleep(1);
        if ((++sp & 255u) == 0u) { if (xb_ld(&bar[XB_TMO])) break; if (sp > XB_SPIN_CAP) { atomicAdd(&bar[XB_TMO], 1u); break; } }
    }
    nloc = mine > 0u ? mine : 1u; nx = cnt > 0u ? cnt : 1u;
}
__device__ __forceinline__ void xcd_barrier_nv(unsigned* bbar, unsigned bx, volatile LAS unsigned* bst) {
    XcdBarrier b; b.bar = bbar; b.x = bx; b.st = bst;
    asm volatile("s_waitcnt vmcnt(0)" ::: "memory");
    __syncthreads();
    if (threadIdx.x == 0) {
        unsigned* bar = b.bar;
        __builtin_amdgcn_s_waitcnt(0);
        unsigned nloc = b.st[0], nx = b.st[1];
        if (nloc == 0u) { xcd_barrier_complete(bar, b.x, nloc, nx); b.st[0] = nloc; b.st[1] = nx; }
        const unsigned old = xb_add(&bar[XB_XSUB(b.x)], 1u);
        const unsigned gen = old / nloc;
        if (old + 1u == (gen + 1u) * nloc) {
            __builtin_amdgcn_fence(__ATOMIC_RELEASE, "agent");
            asm volatile("s_waitcnt vmcnt(0)" ::: "memory");
            const unsigned og = xb_add(&bar[XB_TOP], 1u);
            const unsigned tg = og / nx;
            if (og + 1u == (tg + 1u) * nx) xb_add(&bar[XB_TOPGEN], 1u);
            else XB_SPIN(xb_ld(&bar[XB_TOPGEN]) == tg, bar);
            __builtin_amdgcn_fence(__ATOMIC_ACQUIRE, "agent");
            xb_add(&bar[XB_XGEN(b.x)], 1u);
            asm volatile("s_waitcnt vmcnt(0)" ::: "memory");
        } else {
            XB_SPIN(xb_ld(&bar[XB_XGEN(b.x)]) == gen, bar);
            __builtin_amdgcn_fence(__ATOMIC_ACQUIRE, "agent");
            asm volatile("s_waitcnt vmcnt(0)" ::: "memory");
        }
    }
    __syncthreads();
}

__device__ __forceinline__ int tid_() { int t = threadIdx.x; asm volatile("" : "+v"(t)); return t; }
__device__ __forceinline__ float bf2f(bf16_t v) { return __uint_as_float(((unsigned)v) << 16); }
__device__ __forceinline__ unsigned pack2(float lo, float hi) { unsigned r; asm("v_cvt_pk_bf16_f32 %0, %1, %2" : "=v"(r) : "v"(lo), "v"(hi)); return r; }
__device__ __forceinline__ bf16_t f2bf(float f) { return (bf16_t)(pack2(f, f) & 0xffffu); }
#define DPPF_(v, ctrl) __int_as_float(__builtin_amdgcn_update_dpp(0, __float_as_int(v), ctrl, 0xf, 0xf, false))
#define DPPU_(v, ctrl) ((unsigned)__builtin_amdgcn_update_dpp(0, (int)(v), ctrl, 0xf, 0xf, false))
__device__ __forceinline__ float wave_sum(float v) {
    v += DPPF_(v, 0xB1); v += DPPF_(v, 0x4E); v += DPPF_(v, 0x141); v += DPPF_(v, 0x140);
    const float r0 = __int_as_float(__builtin_amdgcn_readlane(__float_as_int(v), 0)), r1 = __int_as_float(__builtin_amdgcn_readlane(__float_as_int(v), 16));
    const float r2 = __int_as_float(__builtin_amdgcn_readlane(__float_as_int(v), 32)), r3 = __int_as_float(__builtin_amdgcn_readlane(__float_as_int(v), 48));
    return (r0 + r1) + (r2 + r3);
}
__device__ __forceinline__ unsigned half_umax(unsigned m) {
    unsigned a;
    a = DPPU_(m, 0xB1); m = m > a ? m : a; a = DPPU_(m, 0x4E); m = m > a ? m : a; a = DPPU_(m, 0x141); m = m > a ? m : a; a = DPPU_(m, 0x140); m = m > a ? m : a;
    const unsigned r0 = (unsigned)__builtin_amdgcn_readlane((int)m, 0), r1 = (unsigned)__builtin_amdgcn_readlane((int)m, 16);
    return r0 > r1 ? r0 : r1;
}
__device__ __forceinline__ float wave_max(float v) {
#pragma unroll
    for (int o = 32; o >= 1; o >>= 1) v = fmaxf(v, __shfl_xor(v, o));
    return v;
}
__device__ __forceinline__ float sigmoidf_(float x) { return __builtin_amdgcn_rcpf(1.0f + __builtin_amdgcn_exp2f(-1.4426950408889634f * x)); }
__device__ __forceinline__ float gelu_tanh(float x) { const float u = 0.7978845608028654f * (x + 0.044715f * x * x * x); return 0.5f * x * (1.0f + tanhf(u)); }
__device__ __forceinline__ unsigned pk_fp8x4(float a, float b, float c, float d) { int w = 0; w = __builtin_amdgcn_cvt_pk_fp8_f32(a, b, w, false); w = __builtin_amdgcn_cvt_pk_fp8_f32(c, d, w, true); return (unsigned)w; }
__device__ __forceinline__ float yq_(float v) { return __builtin_amdgcn_fmed3f(v * YSCALE, -448.0f, 448.0f); }
__device__ __forceinline__ unsigned pk_yq4(float a, float b, float c, float d) { return pk_fp8x4(yq_(a), yq_(b), yq_(c), yq_(d)); }
typedef float f32x2_ __attribute__((ext_vector_type(2)));
__device__ __forceinline__ u32x4 fp8x8_to_bf16x8(u32x2 w) {
    const f32x2_ a = __builtin_amdgcn_cvt_pk_f32_fp8((int)w.x, false), b = __builtin_amdgcn_cvt_pk_f32_fp8((int)w.x, true), c = __builtin_amdgcn_cvt_pk_f32_fp8((int)w.y, false), d = __builtin_amdgcn_cvt_pk_f32_fp8((int)w.y, true);
    u32x4 r; r.x = pack2(a.x, a.y); r.y = pack2(b.x, b.y); r.z = pack2(c.x, c.y); r.w = pack2(d.x, d.y); return r;
}
typedef float f32x2 __attribute__((ext_vector_type(2)));
__device__ __forceinline__ f32x2 swiglu2(f32x2 gate, f32x2 up) {
    f32x2 g, u; g.x = fminf(gate.x, 7.0f); g.y = fminf(gate.y, 7.0f); u.x = __builtin_amdgcn_fmed3f(up.x, -7.0f, 7.0f); u.y = __builtin_amdgcn_fmed3f(up.y, -7.0f, 7.0f);
    const f32x2 t = g * (-1.702f * 1.4426950408889634f);
    f32x2 e; e.x = __builtin_amdgcn_exp2f(t.x); e.y = __builtin_amdgcn_exp2f(t.y);
    const f32x2 d = e + 1.0f;
    f32x2 r; r.x = __builtin_amdgcn_rcpf(d.x); r.y = __builtin_amdgcn_rcpf(d.y);
    return ((u + 1.0f) * g) * r;
}
__device__ __forceinline__ float swiglu(float gate, float up) {
    const float g = fminf(gate, 7.0f), u = fminf(fmaxf(up, -7.0f), 7.0f);
    return (u + 1.0f) * g * sigmoidf_(1.702f * g);
}

struct Params {
    const float* x; const float* a_w_in; const float* a_conv_w; const float* a_conv_b; const float* a_w_rgate; const float* a_b_rgate;
    const float* a_w_igate; const float* a_b_igate; const float* a_lambda; const float* a_w_out; const float* b_w_in; const float* b_w_out;
    const float* c_w_in; const float* c_w_out; const float* ln_gain; const float* ln_bias; const float* moe_w_router; const float* moe_b_router;
    const float* moe_w_gu; const float* moe_b_gu; const float* moe_w_down; const float* moe_b_down;
    float* out; unsigned char* ws;
    int ph_lo, ph_hi;
};

__device__ __forceinline__ void convert_job(LAS float* tile, const float* src, bf16_t* dst, int K, int N, int batch) {
    const int tid = tid_();
    const int tk = K / 64, tn = N / 64, per = tk * tn; const long total = (long)per * batch;
    for (long u = blockIdx.x; u < total; u += gridDim.x) {
        const int bidx = (int)(u / per), r = (int)(u % per), kt = r / tn, nt = r % tn;
        const float* s = src + (size_t)bidx * K * N + (size_t)(kt * 64) * N + nt * 64;
#pragma unroll
        for (int pass = 0; pass < 2; ++pass) {
            const int row = (tid >> 4) + 32 * pass, c4 = tid & 15;
            const f32x4 v = *(const f32x4*)(s + (size_t)row * N + c4 * 4);
            tile[row * 65 + c4 * 4 + 0] = v[0]; tile[row * 65 + c4 * 4 + 1] = v[1]; tile[row * 65 + c4 * 4 + 2] = v[2]; tile[row * 65 + c4 * 4 + 3] = v[3];
        }
        __syncthreads();
        {
            const int n = tid >> 3, k8 = tid & 7;
            float v[8];
#pragma unroll
            for (int j = 0; j < 8; ++j) v[j] = tile[(k8 * 8 + j) * 65 + n];
            u32x4 w; w.x = pack2(v[0], v[1]); w.y = pack2(v[2], v[3]); w.z = pack2(v[4], v[5]); w.w = pack2(v[6], v[7]);
            *(u32x4*)(dst + (size_t)bidx * N * K + (size_t)(nt * 64 + n) * K + kt * 64 + k8 * 8) = w;
        }
        __syncthreads();
    }
}


constexpr int TAB_OFF = 131072;
constexpr int BIASL_OFF = TAB_OFF + 4096;
__device__ __forceinline__ void moe_tables(LAS unsigned char* lds, const unsigned* ctl, int layer) {
    LAS int* tab = (LAS int*)(lds + TAB_OFF);
    const int tid = tid_();
    __syncthreads();
    if (tid == 0) { int acc = 0; for (int e = 0; e < NEXP; ++e) { tab[e] = acc; acc += ((int)ctl[CW_CNT + layer * 64 + e] + 255) >> 8; } tab[32] = acc; }
    __syncthreads();
    if (tid < 288) { int e = 0; for (int q = 1; q < NEXP; ++q) e += (tab[q] <= tid) ? 1 : 0; tab[64 + tid] = e; }
    __syncthreads();
}

namespace g8 {
constexpr int BM = 256, BK = 64, HALF = 128, HTB = HALF * BK * 2, STAGE_BYTES = 8 * HTB, NXCD = 8, WGM = 8;
__device__ __forceinline__ int lds_byte(int r, int c) { const int st = (r >> 4) * 2 + (c >> 5), rr = r & 15, cc = c & 31, ob = rr * 64 + cc * 2; return st * 1024 + (ob ^ (((ob >> 9) & 1) << 5)); }
__device__ __forceinline__ void stage_rc(int b, int& R, int& C) { const int st = b / 1024, sb = b % 1024, swz = sb ^ (((sb >> 9) & 1) << 5); R = (st >> 1) * 16 + swz / 64; C = (st & 1) * 32 + (swz % 64) / 2; }
__device__ __forceinline__ int perm32(int rho) { const int n = rho >> 4, i = rho & 15; return 8 * (i >> 2) + 4 * n + (i & 3); }
__device__ __forceinline__ unsigned cvt_pk_bf16(float lo, float hi) { unsigned r; asm volatile("v_cvt_pk_bf16_f32 %0, %1, %2" : "=v"(r) : "v"(lo), "v"(hi)); return r; }

struct Unit { const char* a0; const char* a1; const char* b0; const char* b1; const int* rows; int row0, col0, e; };

struct SchedPlain {
    const char* A; const char* Bt; size_t hstepA, hstepB; int nM, nN, nwg, G, c;
    __device__ __forceinline__ void init(const void* A_, const void* Bt_, int M, int N, int K, int G_, int c_) { A = (const char*)A_; Bt = (const char*)Bt_; hstepA = (size_t)HALF * K * 2; hstepB = hstepA; nM = M / BM; nN = N / BM; nwg = nM * nN; G = G_; c = c_; }
    __device__ __forceinline__ bool next(int i, Unit& u) const {
        const long L = (long)i * G + c; if (L >= nwg) return false;
        int wgid = (int)L; { const int q = nwg / NXCD, r = nwg % NXCD, xcd = wgid % NXCD, off = wgid / NXCD; wgid = (xcd < r ? xcd * (q + 1) : r * (q + 1) + (xcd - r) * q) + off; }
        const int nig = WGM * nN, gid = wgid / nig, fm = gid * WGM, gsz = (nM - fm) < WGM ? (nM - fm) : WGM;
        const int pm = fm + ((wgid % nig) % gsz), pn = (wgid % nig) / gsz;
        u.a0 = A + (size_t)pm * 2 * hstepA; u.a1 = u.a0 + hstepA; u.b0 = Bt + (size_t)pn * 2 * hstepB; u.b1 = u.b0 + hstepB; u.rows = nullptr; u.row0 = pm * BM; u.col0 = pn * BM; u.e = 0;
        return true;
    }
};
struct SchedGU {
    const char* A; const char* W; const int* elist; LAS const int* tab; int G, c, rpr;
    __device__ __forceinline__ bool next(int i, Unit& u) const {
        const int xx = c & 7, jj = c >> 3, rt = i * rpr + ((jj >> 1) << 1) + (xx >> 2), pn = 2 * (xx & 3) + (jj & 1); if (jj >= rpr || rt >= __builtin_amdgcn_readfirstlane(tab[32])) return false;
        const int e = __builtin_amdgcn_readfirstlane(tab[64 + rt]), j = rt - __builtin_amdgcn_readfirstlane(tab[e]);
        u.a0 = A; u.a1 = A; u.rows = elist + (size_t)e * T + j * BM; u.b0 = W + ((size_t)e * 2048 + pn * 128) * D; u.b1 = u.b0 + (size_t)1024 * D; u.row0 = rt * BM; u.col0 = pn * 128; u.e = e;
        return true;
    }
};
struct SchedDown {
    const char* A; const char* W; LAS const int* tab; int G, c;
    __device__ __forceinline__ bool next(int i, Unit& u) const {
        const int L = i * G + c, rt = L >> 2, pn = L & 3; if (c >= G || rt >= __builtin_amdgcn_readfirstlane(tab[32])) return false;
        const int e = __builtin_amdgcn_readfirstlane(tab[64 + rt]);
        u.a0 = A + (size_t)rt * BM * D; u.a1 = u.a0 + (size_t)HALF * D; u.rows = nullptr; u.b0 = W + ((size_t)e * 1024 + pn * BM) * D; u.b1 = u.b0 + (size_t)HALF * D; u.row0 = rt * BM; u.col0 = pn * BM; u.e = e;
        return true;
    }
};

struct EpiF32 {
    static constexpr bool PERM = false, STAGED = false, BIASL = false;
    float* C; int ldc; const float* bias; int bias_es;
    __device__ __forceinline__ const float* bias_src(const Unit& u, int i) const { return bias; }
    __device__ __forceinline__ void operator()(const f32x4 (&acc)[2][2][4][2], const Unit& u, int wr, int wc, int fr, int fq, const LAS float* bl) const {
        const int row0 = u.row0 + wr * 64 + fr, col0 = u.col0 + wc * 32 + 4 * fq;
        f32x4 bv[2][2];
#pragma unroll
        for (int bj = 0; bj < 2; ++bj)
#pragma unroll
            for (int n = 0; n < 2; ++n) bv[bj][n] = bias ? *(const f32x4*)(bias + (size_t)u.e * bias_es + col0 + bj * HALF + n * 16) : (f32x4){0.f, 0.f, 0.f, 0.f};
#pragma unroll
        for (int ai = 0; ai < 2; ++ai)
#pragma unroll
            for (int m = 0; m < 4; ++m) { float* rowp = C + (size_t)(row0 + ai * HALF + m * 16) * ldc + col0;
#pragma unroll
                for (int bj = 0; bj < 2; ++bj)
#pragma unroll
                    for (int n = 0; n < 2; ++n) *(f32x4*)(rowp + bj * HALF + n * 16) = acc[ai][bj][m][n] + bv[bj][n]; }
    }
};
struct EpiBf16 {
    static constexpr bool PERM = true, STAGED = true, BIASL = false;
    bf16_t* O; int ldc; const float* bias; int bias_es; float scale;
    __device__ __forceinline__ const float* bias_src(const Unit& u, int i) const { return bias; }
    __device__ __forceinline__ void staged(const f32x4 (&acc)[2][2][4][2], const Unit& u, int wr, int wc, int fr, int fq, LAS unsigned char* lds, int tid) const {
        LAS unsigned char* slab = lds + (wr ? (TAB_OFF + 2048) : 3 * HTB);
        const int j = tid & 255, rrow = j >> 5, rc = j & 31;
#pragma unroll
        for (int ai = 0; ai < 2; ++ai)
#pragma unroll
            for (int mp = 0; mp < 2; ++mp) {
#pragma unroll
                for (int mm = 0; mm < 2; ++mm)
#pragma unroll
                    for (int bj = 0; bj < 2; ++bj) {
                        const int m = 2 * mp + mm, row = 16 * mm + fr, chunk = 16 * bj + 4 * wc + fq;
                        const f32x4 v0 = acc[ai][bj][m][0] * scale, v1 = acc[ai][bj][m][1] * scale;
                        u32x4 w; w.x = cvt_pk_bf16(v0[0], v0[1]); w.y = cvt_pk_bf16(v0[2], v0[3]); w.z = cvt_pk_bf16(v1[0], v1[1]); w.w = cvt_pk_bf16(v1[2], v1[3]);
                        *(LAS u32x4*)(slab + row * 512 + ((chunk ^ (row & 15)) * 16)) = w;
                    }
                asm volatile("s_waitcnt lgkmcnt(0)" ::: "memory"); __builtin_amdgcn_s_barrier(); asm volatile("" ::: "memory");
#pragma unroll
                for (int i = 0; i < 4; ++i) {
                    const int row = rrow + 8 * i;
                    const u32x4 w = *(const LAS u32x4*)(slab + row * 512 + ((rc ^ (row & 15)) * 16));
                    __builtin_nontemporal_store(w, (u32x4*)(O + (size_t)(u.row0 + 128 * ai + 64 * wr + 32 * mp + row) * ldc + u.col0 + rc * 8));
                }
                asm volatile("s_waitcnt lgkmcnt(0)" ::: "memory"); __builtin_amdgcn_s_barrier(); asm volatile("" ::: "memory");
            }
    }
};
struct EpiQKV {
    static constexpr bool PERM = true, STAGED = true, BIASL = false;
    bf16_t* Oq; unsigned char* Okv; float scale; int csplit, kvp;
    __device__ __forceinline__ const float* bias_src(const Unit& u, int i) const { return nullptr; }
    __device__ __forceinline__ void staged(const f32x4 (&acc)[2][2][4][2], const Unit& u, int wr, int wc, int fr, int fq, LAS unsigned char* lds, int tid) const {
        if (u.col0 < csplit) { const EpiBf16 E{Oq, csplit, nullptr, 0, scale}; E.staged(acc, u, wr, wc, fr, fq, lds, tid); return; }
        LAS unsigned char* slab = lds + (wr ? (TAB_OFF + 2048) : 3 * HTB);
        const int j = tid & 255, rrow = j >> 4, rc = j & 15, sub = (fq & 1) * 8;
#pragma unroll
        for (int ai = 0; ai < 2; ++ai) {
#pragma unroll
            for (int m = 0; m < 4; ++m)
#pragma unroll
                for (int bj = 0; bj < 2; ++bj) { const f32x4 v0 = acc[ai][bj][m][0] * scale, v1 = acc[ai][bj][m][1] * scale;
                    u32x2 w; w.x = pk_fp8x4(v0[0], v0[1], v0[2], v0[3]); w.y = pk_fp8x4(v1[0], v1[1], v1[2], v1[3]);
                    const int row = 16 * m + fr, chunk = 8 * bj + 2 * wc + (fq >> 1);
                    *(LAS u32x2*)(slab + row * 256 + ((chunk ^ (row & 15)) * 16) + sub) = w; }
            asm volatile("s_waitcnt lgkmcnt(0)" ::: "memory"); __builtin_amdgcn_s_barrier(); asm volatile("" ::: "memory");
#pragma unroll
            for (int i = 0; i < 4; ++i) {
                const int row = rrow + 16 * i;
                const u32x4 w = *(const LAS u32x4*)(slab + row * 256 + ((rc ^ (row & 15)) * 16));
                __builtin_nontemporal_store(w, (u32x4*)(Okv + (size_t)(u.row0 + 128 * ai + 64 * wr + row) * kvp + (u.col0 - csplit) + rc * 16));
            }
            asm volatile("s_waitcnt lgkmcnt(0)" ::: "memory"); __builtin_amdgcn_s_barrier(); asm volatile("" ::: "memory");
        }
    }
};
struct EpiFp8 {
    static constexpr bool PERM = true, STAGED = false, BIASL = true;
    unsigned char* O; int ldc; const float* bias; int bias_es; float scale;
    __device__ __forceinline__ const float* bias_src(const Unit& u, int i) const { return bias + (size_t)u.e * bias_es + u.col0 + i; }
    __device__ __forceinline__ void operator()(const f32x4 (&acc)[2][2][4][2], const Unit& u, int wr, int wc, int fr, int fq, const LAS float* bl) const {
        const int row0 = u.row0 + wr * 64 + fr, col0 = u.col0 + wc * 32 + 8 * fq;
        f32x4 bv[2][2];
#pragma unroll
        for (int bj = 0; bj < 2; ++bj)
#pragma unroll
            for (int n = 0; n < 2; ++n) bv[bj][n] = *(const LAS f32x4*)(bl + bj * HALF + wc * 32 + 8 * fq + 4 * n);
#pragma unroll
        for (int ai = 0; ai < 2; ++ai)
#pragma unroll
            for (int m = 0; m < 4; ++m) { unsigned char* rowp = O + (size_t)(row0 + ai * HALF + m * 16) * ldc + col0;
#pragma unroll
                for (int bj = 0; bj < 2; ++bj) { const f32x4 v0 = acc[ai][bj][m][0] * scale + bv[bj][0], v1 = acc[ai][bj][m][1] * scale + bv[bj][1];
                    u32x2 w; w.x = pk_fp8x4(v0[0], v0[1], v0[2], v0[3]); w.y = pk_fp8x4(v1[0], v1[1], v1[2], v1[3]);
                    *(u32x2*)(rowp + bj * HALF) = w; } }
    }
};
struct EpiSwiglu {
    static constexpr bool PERM = true, STAGED = false, BIASL = true;
    unsigned char* O; const float* bias; float scale;
    __device__ __forceinline__ const float* bias_src(const Unit& u, int i) const { return bias + (size_t)u.e * 2048 + (i >> 7) * 1024 + u.col0 + (i & 127); }
    __device__ __forceinline__ void operator()(const f32x4 (&acc)[2][2][4][2], const Unit& u, int wr, int wc, int fr, int fq, const LAS float* bl) const {
        const int row0 = u.row0 + wr * 64 + fr, hc = u.col0 + wc * 32 + 8 * fq;
        const LAS float* bp = bl + wc * 32 + 8 * fq;
        const f32x4 bg0 = *(const LAS f32x4*)(bp), bg1 = *(const LAS f32x4*)(bp + 4), bu0 = *(const LAS f32x4*)(bp + 128), bu1 = *(const LAS f32x4*)(bp + 132);
#pragma unroll
        for (int ai = 0; ai < 2; ++ai)
#pragma unroll
            for (int m = 0; m < 4; ++m) {
                const f32x4 g0 = acc[ai][0][m][0] * scale + bg0, g1 = acc[ai][0][m][1] * scale + bg1, u0 = acc[ai][1][m][0] * scale + bu0, u1 = acc[ai][1][m][1] * scale + bu1;
                const f32x2 h0 = swiglu2((f32x2){g0[0], g0[1]}, (f32x2){u0[0], u0[1]}), h1 = swiglu2((f32x2){g0[2], g0[3]}, (f32x2){u0[2], u0[3]});
                const f32x2 h2 = swiglu2((f32x2){g1[0], g1[1]}, (f32x2){u1[0], u1[1]}), h3 = swiglu2((f32x2){g1[2], g1[3]}, (f32x2){u1[2], u1[3]});
                u32x2 w; w.x = pk_fp8x4(h0.x, h0.y, h1.x, h1.y); w.y = pk_fp8x4(h2.x, h2.y, h3.x, h3.y);
                *(u32x2*)(O + (size_t)(row0 + ai * HALF + m * 16) * D + hc) = w;
            }
    }
};

typedef int i32x8 __attribute__((ext_vector_type(8)));
typedef int i32x4 __attribute__((ext_vector_type(4)));
template <class Epi, class Sched, bool GATHER, int ESZ = 2>
__device__ __forceinline__ void gemm_phase(LAS unsigned char* lds, const int K, const Sched& S, const Epi& E) {
    const int tid = tid_(), wid = __builtin_amdgcn_readfirstlane(tid >> 6), lane = tid & 63, wr = wid >> 2, wc = wid & 3, fr = lane & 15, fq = lane >> 4;
    const int nt = K * ESZ / 128, KP = K * ESZ;
    int sR[2], sC[2];
    unsigned voffB[2];
#pragma unroll
    for (int i = 0; i < 2; ++i) { stage_rc(tid * 16 + i * 8192, sR[i], sC[i]); const int Rb = Epi::PERM ? ((sR[i] & ~31) + perm32(sR[i] & 31)) : sR[i]; voffB[i] = (unsigned)(Rb * KP + sC[i] * 2); }
    unsigned cvA0[2], cvA1[2], nvA0[2], nvA1[2];
#define G8_VOFF(u, v0, v1) do { _Pragma("unroll") for (int _i = 0; _i < 2; ++_i) { \
        if (GATHER) { unsigned t0_ = (unsigned)(u).rows[sR[_i]], t1_ = (unsigned)(u).rows[HALF + sR[_i]]; t0_ = t0_ < (unsigned)T ? t0_ : 0u; t1_ = t1_ < (unsigned)T ? t1_ : 0u;     \
            v0[_i] = t0_ * (unsigned)KP + (unsigned)(sC[_i] * 2); v1[_i] = t1_ * (unsigned)KP + (unsigned)(sC[_i] * 2); } \
        else { v0[_i] = (unsigned)(sR[_i] * KP + sC[_i] * 2); v1[_i] = v0[_i]; } } } while (0)
    const size_t kstep = (size_t)(BK * 2);
    const unsigned ldsw = (unsigned)wid * 1024u;
    const int aoff = lds_byte(wr * 64 + fr, fq * 8), boff = lds_byte(wc * 32 + fr, fq * 8);
#define PG8_SA(b, h) (((b) * 2 + (h)) * HTB)
#define PG8_SB(b, h) ((4 + (b) * 2 + (h)) * HTB)
#define PG8_STAGE(bufoff, gbase, voff) do { _Pragma("unroll") for (int _i = 0; _i < 2; ++_i) \
        __builtin_amdgcn_global_load_lds((const unsigned*)((const char*)(gbase) + (voff)[_i]), (LAS unsigned*)(lds + (bufoff) + ldsw + _i * 8192), 16, 0, 0); } while (0)
#define PG8_LDA(dst, b, h) do { _Pragma("unroll") for (int m = 0; m < 4; ++m) { dst[m].lo = *(const LAS i32x4*)(lds + PG8_SA(b, h) + aoff + m * 2048); dst[m].hi = *(const LAS i32x4*)(lds + PG8_SA(b, h) + aoff + m * 2048 + 1024); } } while (0)
#define PG8_LDB(dst, b, h) do { _Pragma("unroll") for (int n = 0; n < 2; ++n) { dst[n].lo = *(const LAS i32x4*)(lds + PG8_SB(b, h) + boff + n * 2048); dst[n].hi = *(const LAS i32x4*)(lds + PG8_SB(b, h) + boff + n * 2048 + 1024); } } while (0)
#define PG8_MMA(ai, bj, At, Bt) do { __builtin_amdgcn_s_setprio(1); _Pragma("unroll") for (int m = 0; m < 4; ++m) _Pragma("unroll") for (int n = 0; n < 2; ++n) { \
        if (ESZ == 2) { acc[ai][bj][m][n] = __builtin_amdgcn_mfma_f32_16x16x32_bf16(__builtin_bit_cast(bf16x8, (i32x4)__builtin_shufflevector(Bt[n], Bt[n], 0, 1, 2, 3)), __builtin_bit_cast(bf16x8, (i32x4)__builtin_shufflevector(At[m], At[m], 0, 1, 2, 3)), acc[ai][bj][m][n], 0, 0, 0); \
                        acc[ai][bj][m][n] = __builtin_amdgcn_mfma_f32_16x16x32_bf16(__builtin_bit_cast(bf16x8, (i32x4)__builtin_shufflevector(Bt[n], Bt[n], 4, 5, 6, 7)), __builtin_bit_cast(bf16x8, (i32x4)__builtin_shufflevector(At[m], At[m], 4, 5, 6, 7)), acc[ai][bj][m][n], 0, 0, 0); } \
        else asm volatile("v_mfma_f32_16x16x128_f8f6f4 %0, %1, %2, %0" : "+v"(acc[ai][bj][m][n]) : "v"(Bt[n]), "v"(At[m])); } __builtin_amdgcn_s_setprio(0); } while (0)
#define PG8_WAIT_V(n) asm volatile("s_waitcnt vmcnt(" #n ")" ::: "memory")
#define PG8_WAIT_L(n) asm volatile("s_waitcnt lgkmcnt(" #n ")" ::: "memory")
#define PG8_BAR __builtin_amdgcn_s_barrier()
#define PG8_SCHED __builtin_amdgcn_sched_barrier(0)
    Unit cur, nxt; int ui = 0;
    if (!S.next(0, cur)) return;
    f32x4 acc[2][2][4][2];
#pragma unroll
    for (int a = 0; a < 2; ++a)
#pragma unroll
        for (int b = 0; b < 2; ++b)
#pragma unroll
            for (int m = 0; m < 4; ++m)
#pragma unroll
                for (int n = 0; n < 2; ++n) acc[a][b][m][n] = (f32x4){0.f, 0.f, 0.f, 0.f};
    i32x8 At[4], B0[2], B1[2];
    const char* cA0 = cur.a0; const char* cA1 = cur.a1; const char* cB0 = cur.b0; const char* cB1 = cur.b1;
    G8_VOFF(cur, cvA0, cvA1);
    PG8_STAGE(PG8_SB(0, 0), cB0, voffB); PG8_STAGE(PG8_SB(0, 1), cB1, voffB); PG8_STAGE(PG8_SA(0, 0), cA0, cvA0); PG8_STAGE(PG8_SA(0, 1), cA1, cvA1);
    if (wr == 1) PG8_BAR;
    PG8_WAIT_V(2); PG8_BAR;
    PG8_STAGE(PG8_SB(1, 0), cB0 + kstep, voffB); PG8_STAGE(PG8_SA(1, 0), cA0 + kstep, cvA0); PG8_STAGE(PG8_SB(1, 1), cB1 + kstep, voffB);
    PG8_WAIT_V(6); PG8_BAR;
    for (;;) {
        const bool has_next = S.next(ui + 1, nxt);
        const char* nA0 = has_next ? nxt.a0 : cA0; const char* nA1 = has_next ? nxt.a1 : cA1; const char* nB0 = has_next ? nxt.b0 : cB0; const char* nB1 = has_next ? nxt.b1 : cB1;
        if (GATHER) { if (has_next) { G8_VOFF(nxt, nvA0, nvA1); } else { nvA0[0] = cvA0[0]; nvA0[1] = cvA0[1]; nvA1[0] = cvA1[0]; nvA1[1] = cvA1[1]; } }
        const LAS float* bl = (const LAS float*)(lds + BIASL_OFF + (ui & 1) * 2048 + wr * 1024);
#pragma unroll 1
        for (int t = 0; t < nt; t += 2) {
            const bool last = (t == nt - 2);
            const char* a1_1 = cA1 + (size_t)(t + 1) * kstep;
            const char* a2_0 = last ? nA0 : cA0 + (size_t)(t + 2) * kstep; const char* a2_1 = last ? nA1 : cA1 + (size_t)(t + 2) * kstep;
            const char* b2_0 = last ? nB0 : cB0 + (size_t)(t + 2) * kstep; const char* b2_1 = last ? nB1 : cB1 + (size_t)(t + 2) * kstep;
            const char* a3_0 = a2_0 + kstep; const char* b3_0 = b2_0 + kstep; const char* b3_1 = b2_1 + kstep;
            unsigned vA0[2], vA1[2];
            if (GATHER) { vA0[0] = last ? nvA0[0] : cvA0[0]; vA0[1] = last ? nvA0[1] : cvA0[1]; vA1[0] = last ? nvA1[0] : cvA1[0]; vA1[1] = last ? nvA1[1] : cvA1[1]; }
            else { vA0[0] = cvA0[0]; vA0[1] = cvA0[1]; vA1[0] = cvA0[0]; vA1[1] = cvA0[1]; }
            PG8_LDB(B0, 0, 0); PG8_LDB(B1, 0, 1); PG8_SCHED; PG8_LDA(At, 0, 0);
            if (Epi::BIASL && t == 0) __builtin_amdgcn_global_load_lds((const unsigned*)E.bias_src(cur, (wid & 3) * 64 + lane), (LAS unsigned*)(lds + BIASL_OFF + (ui & 1) * 2048 + wid * 256), 4, 0, 0);
            PG8_STAGE(PG8_SA(1, 1), a1_1, cvA1);
            PG8_WAIT_V(8); PG8_WAIT_L(0); PG8_BAR; PG8_MMA(0, 0, At, B0); PG8_MMA(0, 1, At, B1); PG8_BAR; PG8_SCHED;
            PG8_LDA(At, 0, 1); PG8_STAGE(PG8_SB(0, 0), b2_0, voffB); PG8_STAGE(PG8_SB(0, 1), b2_1, voffB); PG8_STAGE(PG8_SA(0, 0), a2_0, vA0);
            PG8_WAIT_V(8); PG8_WAIT_L(0); PG8_BAR; PG8_MMA(1, 0, At, B0); PG8_MMA(1, 1, At, B1); PG8_BAR; PG8_SCHED;
            PG8_LDB(B0, 1, 0); PG8_LDB(B1, 1, 1); PG8_SCHED; PG8_LDA(At, 1, 0); PG8_STAGE(PG8_SA(0, 1), a2_1, vA1);
            PG8_WAIT_V(8); PG8_WAIT_L(0); PG8_BAR; PG8_MMA(0, 0, At, B0); PG8_MMA(0, 1, At, B1); PG8_BAR; PG8_SCHED;
            PG8_LDA(At, 1, 1); PG8_STAGE(PG8_SB(1, 0), b3_0, voffB); PG8_STAGE(PG8_SB(1, 1), b3_1, voffB); PG8_STAGE(PG8_SA(1, 0), a3_0, vA0);
            PG8_WAIT_V(8); PG8_WAIT_L(0); PG8_BAR; PG8_MMA(1, 0, At, B0); PG8_MMA(1, 1, At, B1); PG8_BAR; PG8_SCHED;
        }
        if (wr == 0) PG8_BAR;
        if (ESZ == 1) asm volatile("s_nop 15\n\ts_nop 15" ::: "memory");
        if constexpr (Epi::STAGED) E.staged(acc, cur, wr, wc, fr, fq, lds, tid); else E(acc, cur, wr, wc, fr, fq, bl);
        if (!has_next) break;
#pragma unroll
        for (int a = 0; a < 2; ++a)
#pragma unroll
            for (int b = 0; b < 2; ++b)
#pragma unroll
                for (int m = 0; m < 4; ++m)
#pragma unroll
                    for (int n = 0; n < 2; ++n) acc[a][b][m][n] = (f32x4){0.f, 0.f, 0.f, 0.f};
        cur = nxt; cA0 = nA0; cA1 = nA1; cB0 = nB0; cB1 = nB1; ++ui;
        if (GATHER) { cvA0[0] = nvA0[0]; cvA0[1] = nvA0[1]; cvA1[0] = nvA1[0]; cvA1[1] = nvA1[1]; }
        if (wr == 1) PG8_BAR;
    }
    PG8_WAIT_V(0);
    PG8_BAR;
#undef G8_VOFF
#undef PG8_SA
#undef PG8_SB
#undef PG8_STAGE
#undef PG8_LDA
#undef PG8_LDB
#undef PG8_MMA
#undef PG8_WAIT_V
#undef PG8_WAIT_L
#undef PG8_BAR
#undef PG8_SCHED
}
}


template <bool F8>
__device__ __forceinline__ void convert_big(LAS unsigned char* lds, const float* src, void* dstv, int K, int N, int batch, float scale) {
    const int tid = tid_(), lane = tid & 63, wid = tid >> 6;
    const int nbn = N / 256, per = (K / 128) * nbn, total = per * batch, G = (int)gridDim.x;
    constexpr int ESZ = F8 ? 1 : 2, ROWB = 128 * ESZ, TILEB = 256 * ROWB;
    f32x4 ra[16], rb[16];
#define CV_LOAD(uu, reg) do { const int ur_ = total - 1 - (uu), bidx = ur_ / per, r_ = ur_ % per, kb = r_ / nbn, nb = r_ % nbn; \
        const float* sp = src + (size_t)bidx * K * N + (size_t)(kb * 128 + 16 * wid) * N + nb * 256 + 4 * lane; \
        _Pragma("unroll") for (int i = 0; i < 16; ++i) reg[i] = __builtin_nontemporal_load((const f32x4*)(sp + (size_t)i * N)); } while (0)
#define CV_PACK(reg, tl) do { _Pragma("unroll") for (int j = 0; j < 4; ++j) { \
        if (F8) { u32x4 w0; w0.x = pk_fp8x4(reg[0][j] * scale, reg[1][j] * scale, reg[2][j] * scale, reg[3][j] * scale); w0.y = pk_fp8x4(reg[4][j] * scale, reg[5][j] * scale, reg[6][j] * scale, reg[7][j] * scale); \
            w0.z = pk_fp8x4(reg[8][j] * scale, reg[9][j] * scale, reg[10][j] * scale, reg[11][j] * scale); w0.w = pk_fp8x4(reg[12][j] * scale, reg[13][j] * scale, reg[14][j] * scale, reg[15][j] * scale); \
            *(LAS u32x4*)((tl) + (4 * lane + j) * ROWB + ((wid ^ (lane & 7)) * 16)) = w0; } \
        else { u32x4 w0, w1; \
            w0.x = g8::cvt_pk_bf16(reg[0][j], reg[1][j]); w0.y = g8::cvt_pk_bf16(reg[2][j], reg[3][j]); w0.z = g8::cvt_pk_bf16(reg[4][j], reg[5][j]); w0.w = g8::cvt_pk_bf16(reg[6][j], reg[7][j]); \
            w1.x = g8::cvt_pk_bf16(reg[8][j], reg[9][j]); w1.y = g8::cvt_pk_bf16(reg[10][j], reg[11][j]); w1.z = g8::cvt_pk_bf16(reg[12][j], reg[13][j]); w1.w = g8::cvt_pk_bf16(reg[14][j], reg[15][j]); \
            *(LAS u32x4*)((tl) + (4 * lane + j) * ROWB + (((2 * wid) ^ (lane & 15)) * 16)) = w0; *(LAS u32x4*)((tl) + (4 * lane + j) * ROWB + (((2 * wid + 1) ^ (lane & 15)) * 16)) = w1; } } } while (0)
#define CV_STORE(uu, tl) do { const int ur_ = total - 1 - (uu), bidx = ur_ / per, r_ = ur_ % per, kb = r_ / nbn, nb = r_ % nbn; \
        unsigned char* dp = (unsigned char*)dstv + ((size_t)bidx * N * K + (size_t)(nb * 256) * K + kb * 128) * ESZ; \
        _Pragma("unroll") for (int i = 0; i < 4 * ESZ; ++i) { const int pc = tid + NTHREADS * i, n = pc / (8 * ESZ), c = pc % (8 * ESZ); \
            *(u32x4*)(dp + (size_t)n * K * ESZ + c * 16) = *(const LAS u32x4*)((tl) + n * ROWB + ((c ^ ((n >> 2) & (8 * ESZ - 1))) * 16)); } } while (0)
    const int u0 = blockIdx.x;
    if (u0 < total) CV_LOAD(u0, ra);
    if (u0 + G < total) CV_LOAD(u0 + G, rb);
    for (int u = u0; u < total; u += 2 * G) {
        CV_PACK(ra, lds);
        if (u + 2 * G < total) CV_LOAD(u + 2 * G, ra);
        __syncthreads();
        CV_STORE(u, lds);
        const bool has_b = (u + G < total);
        if (has_b) { CV_PACK(rb, lds + TILEB); if (u + 3 * G < total) CV_LOAD(u + 3 * G, rb); }
        __syncthreads();
        if (has_b) CV_STORE(u + G, lds + TILEB);
    }
    __syncthreads();
#undef CV_LOAD
#undef CV_PACK
#undef CV_STORE
}

constexpr int CQ_TAIL_GU = 2, CQ_TAIL_DN = 2;
constexpr int GU_EXTRA_ROUNDS = 1;
constexpr int CQ_DED_PER_ROUND = 4;
constexpr int CQ_GU_PER_L = NEXP * 64, CQ_DN_PER_L = NEXP * 32, CQ_PER_L = CQ_GU_PER_L + CQ_DN_PER_L, CQ_TOTAL = (DEPTH - 1) * CQ_PER_L;
struct CvUnit { const float* sp; unsigned char* dp; int N; float scale; };
__device__ __forceinline__ void cq_decode(const Params& p, int q, CvUnit& u) {
    const int layer = 1 + q / CQ_PER_L, r = q % CQ_PER_L; const bool gu = r < CQ_GU_PER_L;
    const int r2 = gu ? r : r - CQ_GU_PER_L, per = gu ? 64 : 32, nbn = gu ? 8 : 4, N = gu ? 2048 : 1024;
    const int e = r2 / per, w = r2 % per, kb = w / nbn, nb = w % nbn;
    const size_t mat = (size_t)(layer * NEXP + e);
    u.sp = (gu ? p.moe_w_gu : p.moe_w_down) + mat * 1024 * N + (size_t)(kb * 128) * N + nb * 256;
    u.dp = p.ws + (gu ? WS_GU : WS_DN) + mat * N * 1024 + (size_t)(nb * 256) * 1024 + kb * 128;
    u.N = N; u.scale = gu ? GU_WSCALE : DN_WSCALE;
}
#define CQ_LOAD(u, reg) do { const float* sp_ = (u).sp + (size_t)(16 * wid) * (u).N + 4 * lane; _Pragma("unroll") for (int i = 0; i < 16; ++i) reg[i] = __builtin_nontemporal_load((const f32x4*)(sp_ + (size_t)i * (u).N)); } while (0)
#define CQ_PACK(reg, tl, sc) do { _Pragma("unroll") for (int j = 0; j < 4; ++j) { u32x4 w0; w0.x = pk_fp8x4(reg[0][j] * sc, reg[1][j] * sc, reg[2][j] * sc, reg[3][j] * sc); w0.y = pk_fp8x4(reg[4][j] * sc, reg[5][j] * sc, reg[6][j] * sc, reg[7][j] * sc); \
            w0.z = pk_fp8x4(reg[8][j] * sc, reg[9][j] * sc, reg[10][j] * sc, reg[11][j] * sc); w0.w = pk_fp8x4(reg[12][j] * sc, reg[13][j] * sc, reg[14][j] * sc, reg[15][j] * sc); \
            *(LAS u32x4*)((tl) + (4 * lane + j) * 128 + ((wid ^ (lane & 7)) * 16)) = w0; } } while (0)
#define CQ_STORE(u, tl) do { _Pragma("unroll") for (int i = 0; i < 4; ++i) { const int pc = tid + NTHREADS * i, n = pc >> 3, c = pc & 7; \
            *(u32x4*)((u).dp + (size_t)n * 1024 + c * 16) = *(const LAS u32x4*)((tl) + n * 128 + ((c ^ ((n >> 2) & 7)) * 16)); } } while (0)
__device__ __forceinline__ void convert_range(LAS unsigned char* lds, const Params& p, int layer, int u0, int end, int stride) {
    const int tid = tid_(), lane = tid & 63, wid = tid >> 6;
    constexpr int TILEB = 256 * 128;
    const int qb = (layer - 1) * CQ_PER_L;
    int u = u0;
    f32x4 ra[16], rb[16];
    CvUnit ua, ub, un;
    if (u < end) { cq_decode(p, qb + u, ua); CQ_LOAD(ua, ra); }
    if (u + stride < end) { cq_decode(p, qb + u + stride, ub); CQ_LOAD(ub, rb); }
    for (; u < end; u += 2 * stride) {
        CQ_PACK(ra, lds, ua.scale);
        const bool ha = u + 2 * stride < end;
        if (ha) { cq_decode(p, qb + u + 2 * stride, un); CQ_LOAD(un, ra); }
        __syncthreads();
        CQ_STORE(ua, lds);
        if (ha) ua = un;
        const bool has_b = u + stride < end, hb = u + 3 * stride < end;
        if (has_b) { CQ_PACK(rb, lds + TILEB, ub.scale); if (hb) { cq_decode(p, qb + u + 3 * stride, un); CQ_LOAD(un, rb); } }
        __syncthreads();
        if (has_b) { CQ_STORE(ub, lds + TILEB); if (hb) ub = un; }
    }
    __syncthreads();
}
__device__ __forceinline__ void convert_tail(LAS unsigned char* lds, const Params& p, int nl, int budget) {
    if (budget <= 0) return;
    unsigned* cq = (unsigned*)(p.ws + WS_CTL) + CW_CQ + 64 * nl;
    LAS int* slot = (LAS int*)(lds + 2 * 256 * 128);
    __syncthreads();
    if (tid_() == 0) { const unsigned g = xb_add(cq, (unsigned)budget); slot[0] = g < (unsigned)CQ_PER_L ? (int)g : CQ_PER_L; }
    __syncthreads();
    const int u0 = slot[0], end = u0 + budget < CQ_PER_L ? u0 + budget : CQ_PER_L;
    convert_range(lds, p, nl, u0, end, 1);
}
__device__ __forceinline__ void convert_rest(LAS unsigned char* lds, const Params& p, int layer) {
    unsigned* cq = (unsigned*)(p.ws + WS_CTL) + CW_CQ + 64 * layer;
    LAS int* slot = (LAS int*)(lds + 2 * 256 * 128);
    __syncthreads();
    if (tid_() == 0) { const unsigned g = xb_ld(cq); slot[0] = g < (unsigned)CQ_PER_L ? (int)g : CQ_PER_L; }
    __syncthreads();
    convert_range(lds, p, layer, slot[0] + (int)blockIdx.x, CQ_PER_L, (int)gridDim.x);
}
#undef CQ_LOAD
#undef CQ_PACK
#undef CQ_STORE

__device__ __forceinline__ float gelu_fast(float x) { const float u2 = 1.5957691216057308f * (x + 0.044715f * x * x * x); return x * __builtin_amdgcn_rcpf(1.0f + __builtin_amdgcn_exp2f(-1.4426950408889634f * u2)); }
__device__ __forceinline__ void lru_gates_phase(LAS unsigned char* lds, const Params& p, int idx) {
    const int tid = tid_(), lane = tid & 63, wid = tid >> 6, fr = lane & 15, fq = lane >> 4;
    LAS bf16_t* xcb = (LAS bf16_t*)lds;
    LAS float* xcf = (LAS float*)(lds + 17408);
    LAS float* sa = (LAS float*)(lds + 17408 + 33792);
    LAS float* sb = sa + 64 * 132;
    LAS float* comb = sb + 64 * 132;
    const unsigned char* u = p.ws + WS_U;
    bf16_t* Carr = (bf16_t*)(p.ws + WS_SCR); bf16_t* Barr = Carr + (size_t)T * D;
    float* SP = (float*)(p.ws + WS_LSUM); float* SH = SP + NBATCH * 32 * D;
    const int hd = blockIdx.x & 7, slot = blockIdx.x >> 3, nslots = gridDim.x >> 3;
    const float* conv_w = p.a_conv_w + (size_t)idx * 4 * D; const float* conv_b = p.a_conv_b + (size_t)idx * D;
    const bf16_t* wrt = (const bf16_t*)(p.ws + WS_AGT) + ((size_t)(idx * 2 + 0) * 8 + hd) * 128 * 128;
    const bf16_t* wit = (const bf16_t*)(p.ws + WS_AGT) + ((size_t)(idx * 2 + 1) * 8 + hd) * 128 * 128;
    bf16x8 Br[4], Bi[4];
#pragma unroll
    for (int ks = 0; ks < 4; ++ks) { Br[ks] = *(const bf16x8*)(wrt + (size_t)(16 * wid + fr) * 128 + 32 * ks + 8 * fq); Bi[ks] = *(const bf16x8*)(wit + (size_t)(16 * wid + fr) * 128 + 32 * ks + 8 * fq); }
    const int cg = hd * 128 + 16 * wid + 4 * fq;
    const f32x4 brv = *(const f32x4*)(p.a_b_rgate + (size_t)idx * D + cg), biv = *(const f32x4*)(p.a_b_igate + (size_t)idx * D + cg), lmv = *(const f32x4*)(p.a_lambda + (size_t)idx * D + cg);
    f32x4 spv;
#pragma unroll
    for (int r = 0; r < 4; ++r) spv[r] = (lmv[r] > 15.f) ? __expf(-lmv[r]) : log1pf(__expf(-lmv[r]));
    const int cc = (tid & 31) * 4, cch = hd * 128 + cc;
    f32x4 cw[4];
#pragma unroll
    for (int j = 0; j < 4; ++j) cw[j] = *(const f32x4*)(conv_w + j * D + cch);
    const f32x4 cb = *(const f32x4*)(conv_b + cch);
    unsigned rvn[4][4];
#define LRU_LOAD(tile_) do { _Pragma("unroll") for (int k = 0; k < 4; ++k) { const int t = (tile_) * 64 + (tid >> 5) + 16 * k, s_ = t & (SEQ - 1); \
        _Pragma("unroll") for (int j = 0; j < 4; ++j) rvn[k][j] = (s_ - 3 + j >= 0) ? *(const unsigned*)(u + (size_t)(t - 3 + j) * 2048 + 1024 + cch) : 0u; } } while (0)
    if (slot < T / 64) LRU_LOAD(slot);
    for (int tile = slot; tile < T / 64; tile += nslots) {
        const int t0 = tile * 64;
#pragma unroll
        for (int k = 0; k < 4; ++k) {
            const int tl = (tid >> 5) + 16 * k;
            f32x4 acc = cb;
#pragma unroll
            for (int j = 0; j < 4; ++j) {
                const f32x2_ r01 = __builtin_amdgcn_cvt_pk_f32_fp8((int)rvn[k][j], false), r23 = __builtin_amdgcn_cvt_pk_f32_fp8((int)rvn[k][j], true);
                acc[0] += cw[j][0] * r01.x; acc[1] += cw[j][1] * r01.y;
                acc[2] += cw[j][2] * r23.x; acc[3] += cw[j][3] * r23.y;
            }
            *(LAS f32x4*)(xcf + tl * 132 + cc) = acc;
            u32x2 w; w.x = pack2(acc[0], acc[1]); w.y = pack2(acc[2], acc[3]);
            *(LAS u32x2*)(xcb + tl * 136 + cc) = w;
        }
        if (tile + nslots < T / 64) LRU_LOAD(tile + nslots);
        __syncthreads();
        f32x4 ar[4], ai[4];
#pragma unroll
        for (int mt = 0; mt < 4; ++mt) { ar[mt] = (f32x4){0.f, 0.f, 0.f, 0.f}; ai[mt] = (f32x4){0.f, 0.f, 0.f, 0.f}; }
#pragma unroll
        for (int ks = 0; ks < 4; ++ks)
#pragma unroll
            for (int mt = 0; mt < 4; ++mt) {
                const bf16x8 af = *(const LAS bf16x8*)(xcb + (mt * 16 + fr) * 136 + 32 * ks + 8 * fq);
                ar[mt] = __builtin_amdgcn_mfma_f32_16x16x32_bf16(Br[ks], af, ar[mt], 0, 0, 0);
                ai[mt] = __builtin_amdgcn_mfma_f32_16x16x32_bf16(Bi[ks], af, ai[mt], 0, 0, 0);
            }
#pragma unroll
        for (int mt = 0; mt < 4; ++mt) {
            const int tl = mt * 16 + fr, cl = 16 * wid + 4 * fq;
            const f32x4 rec = *(const LAS f32x4*)(xcf + tl * 132 + cl);
            f32x4 av, bv, cv;
#pragma unroll
            for (int r = 0; r < 4; ++r) {
                const float rg = sigmoidf_(ar[mt][r] + brv[r]), ig = sigmoidf_(ai[mt][r] + biv[r]);
                const float xl = -8.0f * rg * spv[r];
                const float cex = -xl * (1.0f + xl * (0.5f + xl * (0.16666667f + xl * (0.041666668f + xl * 0.0083333338f))));
                const float cc_ = bf2f(f2bf(cex));
                av[r] = 1.0f - cc_; cv[r] = cc_;
                bv[r] = bf2f(f2bf(__builtin_amdgcn_sqrtf(fmaxf(cex * (2.0f - cex), 0.f)) * ig * rec[r]));
            }
            { u32x2 wc_, wb_; wc_.x = pack2(cv[0], cv[1]); wc_.y = pack2(cv[2], cv[3]); wb_.x = pack2(bv[0], bv[1]); wb_.y = pack2(bv[2], bv[3]);
              *(u32x2*)(Carr + (size_t)(t0 + tl) * D + cg) = wc_; *(u32x2*)(Barr + (size_t)(t0 + tl) * D + cg) = wb_; }
            *(LAS f32x4*)(sa + tl * 132 + cl) = av; *(LAS f32x4*)(sb + tl * 132 + cl) = bv;
        }
        __syncthreads();
        {
            const int j = tid & 127, q = tid >> 7;
            float P = 1.f, H = 0.f;
#pragma unroll
            for (int s_ = 0; s_ < 16; ++s_) { const float a = sa[(q * 16 + s_) * 132 + j], bb = sb[(q * 16 + s_) * 132 + j]; H = a * H + bb; P *= a; }
            comb[(q * 128 + j) * 2 + 0] = P; comb[(q * 128 + j) * 2 + 1] = H;
        }
        __syncthreads();
        if (tid < 128) {
            float P = comb[tid * 2], H = comb[tid * 2 + 1];
#pragma unroll
            for (int q = 1; q < 4; ++q) { const float Pq = comb[(q * 128 + tid) * 2], Hq = comb[(q * 128 + tid) * 2 + 1]; H = Pq * H + Hq; P *= Pq; }
            SP[(size_t)tile * D + hd * 128 + tid] = P; SH[(size_t)tile * D + hd * 128 + tid] = H;
        }
    }
}
#undef LRU_LOAD
__device__ __forceinline__ void lru_scan_phase(const Params& p) {
    const int tid = tid_();
    const unsigned char* u = p.ws + WS_U;
    const bf16_t* Carr = (const bf16_t*)(p.ws + WS_SCR); const bf16_t* Barr = Carr + (size_t)T * D;
    const float* SP = (const float*)(p.ws + WS_LSUM); const float* SH = SP + NBATCH * 32 * D;
    unsigned char* yin = p.ws + WS_YIN;
    typedef float f32x2 __attribute__((ext_vector_type(2)));
    for (int tile = blockIdx.x; tile < NBATCH * 32; tile += gridDim.x) {
        const int c = 2 * tid, b = tile >> 5, chunk = tile & 31;
        const size_t tb = (size_t)tile * 64;
        unsigned cwA[16], bwA[16], gwA[16], cwB[16], bwB[16], gwB[16];
#define SC_LOAD(S, s0) do { _Pragma("unroll") for (int j = 0; j < 16; ++j) { const size_t t = tb + (s0) + j; cw##S[j] = __builtin_nontemporal_load((const unsigned*)(Carr + t * D + c)); \
            bw##S[j] = __builtin_nontemporal_load((const unsigned*)(Barr + t * D + c)); gw##S[j] = (unsigned)__builtin_nontemporal_load((const unsigned short*)(u + t * 2048 + c)); } } while (0)
#define SC_SCAN(S, s0) do { _Pragma("unroll") for (int j = 0; j < 16; ++j) { const size_t t = tb + (s0) + j; \
            h0 = (1.0f - __uint_as_float(cw##S[j] << 16)) * h0 + __uint_as_float(bw##S[j] << 16); h1 = (1.0f - __uint_as_float(cw##S[j] & 0xffff0000u)) * h1 + __uint_as_float(bw##S[j] & 0xffff0000u); \
            const f32x2_ gg = __builtin_amdgcn_cvt_pk_f32_fp8((int)gw##S[j], false); \
            *(unsigned short*)(yin + t * D + c) = (unsigned short)__builtin_amdgcn_cvt_pk_fp8_f32(yq_(gelu_fast(gg.x) * h0), yq_(gelu_fast(gg.y) * h1), 0, false); } } while (0)
        SC_LOAD(A, 0);
        f32x2 sp[31], sh[31];
#pragma unroll
        for (int k = 0; k < 31; ++k) { const bool on = k < chunk; const size_t o = (size_t)(b * 32 + (on ? k : 0)) * D + c;
            sp[k] = *(const f32x2*)(SP + o); sh[k] = *(const f32x2*)(SH + o); if (!on) { sp[k] = (f32x2){1.f, 1.f}; sh[k] = (f32x2){0.f, 0.f}; } }
        float h0 = 0.f, h1 = 0.f;
#pragma unroll
        for (int k = 0; k < 31; ++k) { h0 = sp[k][0] * h0 + sh[k][0]; h1 = sp[k][1] * h1 + sh[k][1]; }
        SC_LOAD(B, 16); SC_SCAN(A, 0);
        SC_LOAD(A, 32); SC_SCAN(B, 16);
        SC_LOAD(B, 48); SC_SCAN(A, 32);
        SC_SCAN(B, 48);
#undef SC_LOAD
#undef SC_SCAN
    }
}

typedef short s16x4 __attribute__((ext_vector_type(4)));
__device__ __forceinline__ s16x4 tr4(LAS const unsigned char* base, int row0, int col0, int stride, int lane) {
    const int q = (lane & 15) >> 2, pp = lane & 3;
    return __builtin_amdgcn_ds_read_tr16_b64_v4i16((LAS s16x4*)(base + (row0 + q) * stride + (col0 + 4 * pp) * 2));
}
__device__ __forceinline__ bf16x8 cat8(s16x4 a, s16x4 b) { return (bf16x8){a[0], a[1], a[2], a[3], b[0], b[1], b[2], b[3]}; }
__device__ __forceinline__ void ret_core_phase(LAS unsigned char* lds, const Params& p) {
    const int tid0_ = tid_(); const int tid = tid0_, lane = tid & 63, wid = tid >> 6, fr = lane & 15, fq = lane >> 4;
    constexpr int KS = 528, VS = 160, SS = 528;
    LAS unsigned char* Kl = lds;
    LAS unsigned char* Vl = lds + 128 * KS;
    LAS unsigned char* Sl = Vl + 128 * VS;
    const bf16_t* ul_ = (const bf16_t*)(p.ws + WS_U);
    const unsigned char* ul8_ = p.ws + WS_UKV;
    bf16_t* RO = (bf16_t*)(p.ws + WS_SCR);
    for (int un = blockIdx.x; un < NBATCH * 4 * 8; un += gridDim.x) {
        const int b = un >> 5, h = (un >> 3) & 3, vs = un & 7;
        const float lg2 = log2f(1.0f - exp2f(-5.0f - (float)h));
        f32x4 Sacc[2][4];
#pragma unroll
        for (int dt = 0; dt < 2; ++dt)
#pragma unroll
            for (int vt = 0; vt < 4; ++vt) Sacc[dt][vt] = (f32x4){0.f, 0.f, 0.f, 0.f};
        for (int i = tid; i < 64 * SS / 16; i += NTHREADS) ((LAS u32x4*)Sl)[i] = (u32x4){0u, 0u, 0u, 0u};
        u32x4 kraw[8]; u32x2 vraw[2]; bf16x8 Qf[8];
#define RET_LOAD(ch_) do { const size_t tl_ = (size_t)b * SEQ + (ch_) * 128; const bf16_t* u = ul_; const unsigned char* u8 = ul8_; int tid = tid0_; asm volatile("" : "+s"(u), "+s"(u8), "+v"(tid));     \
            _Pragma("unroll") for (int i = 0; i < 8; ++i) { const int piece = tid + NTHREADS * i, m = piece >> 5, ch = piece & 31; kraw[i] = *(const u32x4*)(u + (tl_ + m) * 2048 + 1024 + h * 256 + ch * 8); } \
            _Pragma("unroll") for (int i = 0; i < 2; ++i) { const int piece = tid + NTHREADS * i, m = piece >> 3, ch = piece & 7; vraw[i] = *(const u32x2*)(u8 + (tl_ + m) * 4096 + h * 512 + vs * 64 + ch * 8); } } while (0)
#define RET_LOADQ(ch_) do { const size_t tl_ = (size_t)b * SEQ + (ch_) * 128; const bf16_t* u = ul_; int tid = tid0_; asm volatile("" : "+s"(u), "+v"(tid)); const int wid = tid >> 6, fr = tid & 15, fq = (tid & 63) >> 4; \
            _Pragma("unroll") for (int ks = 0; ks < 8; ++ks) Qf[ks] = *(const bf16x8*)(u + (tl_ + 16 * wid + fr) * 2048 + h * 256 + 32 * ks + 8 * fq); } while (0)
        RET_LOAD(0); RET_LOADQ(0);
        for (int chunk = 0; chunk < 16; ++chunk) {
            const size_t t0 = (size_t)b * SEQ + chunk * 128;
            int tst = tid0_; asm volatile("" : "+v"(tst));
#pragma unroll
            for (int i = 0; i < 8; ++i) {
                const int piece = tst + NTHREADS * i, m = piece >> 5, ch = piece & 31;
                *(LAS u32x4*)(Kl + m * KS + ch * 16) = kraw[i];
            }
#pragma unroll
            for (int i = 0; i < 2; ++i) {
                const int piece = tst + NTHREADS * i, m = piece >> 3, ch = piece & 7;
                const u32x2 kv = vraw[i];
                const float sc = __builtin_amdgcn_exp2f(-(float)(m + 1) * lg2) * 0.0625f;
                const f32x2_ v0 = __builtin_amdgcn_cvt_pk_f32_fp8((int)kv.x, false), v1 = __builtin_amdgcn_cvt_pk_f32_fp8((int)kv.x, true), v2 = __builtin_amdgcn_cvt_pk_f32_fp8((int)kv.y, false), v3 = __builtin_amdgcn_cvt_pk_f32_fp8((int)kv.y, true);
                u32x4 w;
                w.x = pack2(v0.x * sc, v0.y * sc); w.y = pack2(v1.x * sc, v1.y * sc); w.z = pack2(v2.x * sc, v2.y * sc); w.w = pack2(v3.x * sc, v3.y * sc);
                *(LAS u32x4*)(Vl + m * VS + ch * 16) = w;
            }
            __syncthreads();
            if (chunk + 1 < 16) RET_LOAD(chunk + 1);
            f32x4 sc[8];
#pragma unroll
            for (int mt = 0; mt < 8; ++mt) {
                sc[mt] = (f32x4){0.f, 0.f, 0.f, 0.f};
#pragma unroll
                for (int ks = 0; ks < 8; ++ks) {
                    const bf16x8 kf = *(const LAS bf16x8*)(Kl + (16 * mt + fr) * KS + (32 * ks + 8 * fq) * 2);
                    sc[mt] = __builtin_amdgcn_mfma_f32_16x16x32_bf16(kf, Qf[ks], sc[mt], 0, 0, 0);
                }
                if (mt & 1) __builtin_amdgcn_sched_barrier(0);
            }
            bf16x8 pf[4];
            const int nloc = 16 * wid + fr;
#pragma unroll
            for (int ks2 = 0; ks2 < 4; ++ks2) {
                float v[8];
#pragma unroll
                for (int t = 0; t < 2; ++t)
#pragma unroll
                    for (int r = 0; r < 4; ++r) { const int m = 32 * ks2 + 16 * t + 4 * fq + r; v[4 * t + r] = (m <= nloc) ? sc[2 * ks2 + t][r] : 0.f; }
                u32x4 w; w.x = pack2(v[0], v[1]); w.y = pack2(v[2], v[3]); w.z = pack2(v[4], v[5]); w.w = pack2(v[6], v[7]);
                pf[ks2] = __builtin_bit_cast(bf16x8, w);
            }
            f32x4 O[4];
#pragma unroll
            for (int vt = 0; vt < 4; ++vt) {
                O[vt] = (f32x4){0.f, 0.f, 0.f, 0.f};
#pragma unroll
                for (int ks2 = 0; ks2 < 4; ++ks2) {
                    const bf16x8 vf = cat8(tr4(Vl, 32 * ks2 + 4 * fq, 16 * vt, VS, lane), tr4(Vl, 32 * ks2 + 16 + 4 * fq, 16 * vt, VS, lane));
                    O[vt] = __builtin_amdgcn_mfma_f32_16x16x32_bf16(pf[ks2], vf, O[vt], 0, 0, 0);
                }
#pragma unroll
                for (int ks = 0; ks < 8; ++ks) {
                    const bf16x8 sf = *(const LAS bf16x8*)(Sl + (16 * vt + fr) * SS + (32 * ks + 8 * fq) * 2);
                    O[vt] = __builtin_amdgcn_mfma_f32_16x16x32_bf16(Qf[ks], sf, O[vt], 0, 0, 0);
                }
                __builtin_amdgcn_sched_barrier(0);
            }
#pragma unroll
            for (int r = 0; r < 4; ++r) {
                const int n = 16 * wid + 4 * fq + r;
                const float qd = exp2f((float)(n + 1) * lg2);
                bf16_t* op = RO + (t0 + n) * 2048 + h * 512 + vs * 64 + fr;
#pragma unroll
                for (int vt = 0; vt < 4; ++vt) op[16 * vt] = f2bf(O[vt][r] * qd);
            }
            if (chunk + 1 < 16) RET_LOADQ(chunk + 1);
#pragma unroll
            for (int ks3 = 0; ks3 < 4; ++ks3) {
                bf16x8 kt[2], vf[4];
#pragma unroll
                for (int dt = 0; dt < 2; ++dt) kt[dt] = cat8(tr4(Kl, 32 * ks3 + 8 * fq, 32 * wid + 16 * dt, KS, lane), tr4(Kl, 32 * ks3 + 8 * fq + 4, 32 * wid + 16 * dt, KS, lane));
#pragma unroll
                for (int vt = 0; vt < 4; ++vt) vf[vt] = cat8(tr4(Vl, 32 * ks3 + 8 * fq, 16 * vt, VS, lane), tr4(Vl, 32 * ks3 + 8 * fq + 4, 16 * vt, VS, lane));
#pragma unroll
                for (int dt = 0; dt < 2; ++dt)
#pragma unroll
                    for (int vt = 0; vt < 4; ++vt) Sacc[dt][vt] = __builtin_amdgcn_mfma_f32_16x16x32_bf16(kt[dt], vf[vt], Sacc[dt][vt], 0, 0, 0);
                __builtin_amdgcn_sched_barrier(0);
            }
            __syncthreads();
            const float cd = exp2f(128.0f * lg2);
#pragma unroll
            for (int dt = 0; dt < 2; ++dt)
#pragma unroll
                for (int vt = 0; vt < 4; ++vt) {
                    Sacc[dt][vt] *= cd;
                    u32x2 w; w.x = pack2(Sacc[dt][vt][0], Sacc[dt][vt][1]); w.y = pack2(Sacc[dt][vt][2], Sacc[dt][vt][3]);
                    *(LAS u32x2*)(Sl + (16 * vt + fr) * SS + (32 * wid + 16 * dt + 4 * fq) * 2) = w;
                }
        }
        __syncthreads();
#undef RET_LOAD
#undef RET_LOADQ
    }
}
__device__ __forceinline__ void ret_norm_phase(LAS unsigned char* lds, const Params& p) {
    const int tid = tid_(), lane = tid & 63, wid = tid >> 6;
    const unsigned char* u8 = p.ws + WS_UKV;
    const bf16_t* RO = (const bf16_t*)(p.ws + WS_SCR);
    unsigned char* yin = p.ws + WS_YIN;
    const int nwu = T * 4, stride = (int)gridDim.x * 8;
    for (int wu0 = blockIdx.x * 8 + wid; wu0 < nwu; wu0 += 4 * stride) {
        u32x4 ov[4]; u32x2 gv[4];
#pragma unroll
        for (int q = 0; q < 4; ++q) { const int wu = wu0 + q * stride; const size_t t = (size_t)(wu >> 2); const int h = wu & 3;
            if (wu < nwu) { ov[q] = __builtin_nontemporal_load((const u32x4*)(RO + t * 2048 + h * 512 + lane * 8)); gv[q] = __builtin_nontemporal_load((const u32x2*)(u8 + t * 4096 + 2048 + h * 512 + lane * 8)); } }
#pragma unroll
        for (int q = 0; q < 4; ++q) { const int wu = wu0 + q * stride; const size_t t = (size_t)(wu >> 2); const int h = wu & 3;
            if (wu < nwu) {
                float o[8], g[8];
                o[0] = __uint_as_float(ov[q].x << 16); o[1] = __uint_as_float(ov[q].x & 0xffff0000u); o[2] = __uint_as_float(ov[q].y << 16); o[3] = __uint_as_float(ov[q].y & 0xffff0000u);
                o[4] = __uint_as_float(ov[q].z << 16); o[5] = __uint_as_float(ov[q].z & 0xffff0000u); o[6] = __uint_as_float(ov[q].w << 16); o[7] = __uint_as_float(ov[q].w & 0xffff0000u);
                { const f32x2_ g0 = __builtin_amdgcn_cvt_pk_f32_fp8((int)gv[q].x, false), g1 = __builtin_amdgcn_cvt_pk_f32_fp8((int)gv[q].x, true), g2 = __builtin_amdgcn_cvt_pk_f32_fp8((int)gv[q].y, false), g3 = __builtin_amdgcn_cvt_pk_f32_fp8((int)gv[q].y, true);
                  g[0] = g0.x; g[1] = g0.y; g[2] = g1.x; g[3] = g1.y; g[4] = g2.x; g[5] = g2.y; g[6] = g3.x; g[7] = g3.y; }
                float ss = 0.f;
#pragma unroll
                for (int j = 0; j < 8; ++j) ss += o[j] * o[j];
                const float rstd = rsqrtf(wave_sum(ss) * (1.0f / 512.0f) + 1e-6f);
                float y[8];
#pragma unroll
                for (int j = 0; j < 8; ++j) y[j] = g[j] * sigmoidf_(g[j]) * o[j] * rstd;
                u32x2 w; w.x = pk_yq4(y[0], y[1], y[2], y[3]); w.y = pk_yq4(y[4], y[5], y[6], y[7]);
                *(u32x2*)(yin + t * 2048 + h * 512 + lane * 8) = w;
            } }
    }
}

__device__ __forceinline__ void attn_core_phase(LAS unsigned char* lds, const Params& p) {
    const int tid0_ = tid_(); const int tid = tid0_, lane = tid & 63, wid = tid >> 6, fr = lane & 15, fq = lane >> 4;
    constexpr int RS = 144, TILE = 272 * RS;
    LAS unsigned char* Kl = lds;
    LAS unsigned char* Vl = lds + TILE;
    const bf16_t* u = (const bf16_t*)(p.ws + WS_U);
    const unsigned char* ukv = p.ws + WS_UKV;
    bf16_t* OP = (bf16_t*)(p.ws + WS_SCR);
    float* LSE = (float*)(p.ws + WS_SCR + 96 * MB);
    for (int i = tid; i < 16 * RS / 16; i += NTHREADS) { ((LAS u32x4*)(Kl + 256 * RS))[i] = (u32x4){0u, 0u, 0u, 0u}; ((LAS u32x4*)(Vl + 256 * RS))[i] = (u32x4){0u, 0u, 0u, 0u}; }
    u32x2 kraw[4], vraw[4]; bf16x8 Qn[2];
#define ATT_DECODE(un_) const int g = (un_) >> 11, rem = (un_) & 2047, b = rem >> 8, h = (rem >> 4) & 15, x = rem & 15; \
        const int dl = (g == 0) ? 1 : (g == 1 ? 4 : 16), r_ = x & (dl - 1), n = x / dl
#define ATT_LOAD(un_) do { ATT_DECODE(un_); int tl_ = tid0_; const bf16_t* ub = u; const unsigned char* ub8 = ukv; asm volatile("" : "+v"(tl_), "+s"(ub), "+s"(ub8)); ub += (size_t)b * SEQ * 3072; ub8 += (size_t)b * SEQ * 6144; \
        _Pragma("unroll") for (int i = 0; i < 4; ++i) { const int piece = tl_ + NTHREADS * i, row = piece >> 3, ch = piece & 7; const int sk = ((n - 1) * 128 + row) * dl + r_; \
            kraw[i] = (u32x2){0u, 0u}; vraw[i] = (u32x2){0u, 0u}; \
            if (sk >= 0) { const unsigned char* src = ub8 + (size_t)sk * 6144 + g * 1024 + h * 64 + ch * 8; kraw[i] = *(const u32x2*)(src); vraw[i] = *(const u32x2*)(src + 3072); } } \
        { const int sq_ = (n * 128 + 16 * (tl_ >> 6) + (tl_ & 15)) * dl + r_; \
          _Pragma("unroll") for (int ks = 0; ks < 2; ++ks) Qn[ks] = *(const bf16x8*)(ub + (size_t)sq_ * 3072 + g * 1024 + h * 64 + 32 * ks + 8 * ((tl_ & 63) >> 4)); } } while (0)
    if ((int)blockIdx.x < 3 * 2048) ATT_LOAD((int)blockIdx.x);
    for (int un = blockIdx.x; un < 3 * 2048; un += gridDim.x) {
        ATT_DECODE(un);
        const float slope = exp2f(-0.5f * (float)(h + 1)) * (float)dl;
        { int tl_ = tid0_; asm volatile("" : "+v"(tl_));
#pragma unroll
          for (int i = 0; i < 4; ++i) {
            const int piece = tl_ + NTHREADS * i, row = piece >> 3, ch = piece & 7;
            *(LAS u32x4*)(Kl + row * RS + ch * 16) = fp8x8_to_bf16x8(kraw[i]); *(LAS u32x4*)(Vl + row * RS + ch * 16) = fp8x8_to_bf16x8(vraw[i]);
          } }
        const int qi = 16 * wid + fr, sq = (n * 128 + qi) * dl + r_;
        bf16x8 Qf[2];
#pragma unroll
        for (int ks = 0; ks < 2; ++ks) Qf[ks] = Qn[ks];
        __syncthreads();
        if (un + (int)gridDim.x < 3 * 2048) ATT_LOAD(un + (int)gridDim.x);
        f32x4 sc[9];
        float mx = -INFINITY;
#pragma unroll
        for (int kt = 0; kt < 9; ++kt) {
            sc[kt] = (f32x4){0.f, 0.f, 0.f, 0.f};
#pragma unroll
            for (int ks = 0; ks < 2; ++ks) {
                const bf16x8 kf = *(const LAS bf16x8*)(Kl + (16 * (wid + kt) + fr) * RS + (32 * ks + 8 * fq) * 2);
                sc[kt] = __builtin_amdgcn_mfma_f32_16x16x32_bf16(kf, Qf[ks], sc[kt], 0, 0, 0);
            }
#pragma unroll
            for (int r = 0; r < 4; ++r) {
                const int ki = 16 * (wid + kt) + 4 * fq + r, steps = qi + 128 - ki;
                const bool ok = (steps >= 0) && (steps <= 128) && (n > 0 || ki >= 128);
                const float v = ok ? sc[kt][r] * 0.125f - slope * (float)steps : -INFINITY;
                sc[kt][r] = v; mx = fmaxf(mx, v);
            }
        }
        mx = fmaxf(mx, __shfl_xor(mx, 16)); mx = fmaxf(mx, __shfl_xor(mx, 32));
        float l = 0.f;
#pragma unroll
        for (int kt = 0; kt < 9; ++kt)
#pragma unroll
            for (int r = 0; r < 4; ++r) { const float pv = __expf(sc[kt][r] - mx); sc[kt][r] = pv; l += pv; }
        l += __shfl_xor(l, 16); l += __shfl_xor(l, 32);
        f32x4 O[4];
#pragma unroll
        for (int dt = 0; dt < 4; ++dt) O[dt] = (f32x4){0.f, 0.f, 0.f, 0.f};
#pragma unroll
        for (int ks5 = 0; ks5 < 5; ++ks5) {
            const f32x4 p0 = sc[2 * ks5], p1 = (ks5 < 4) ? sc[(ks5 < 4) ? 2 * ks5 + 1 : 0] : (f32x4){0.f, 0.f, 0.f, 0.f};
            u32x4 w; w.x = pack2(p0[0], p0[1]); w.y = pack2(p0[2], p0[3]); w.z = pack2(p1[0], p1[1]); w.w = pack2(p1[2], p1[3]);
            const bf16x8 pf = __builtin_bit_cast(bf16x8, w);
#pragma unroll
            for (int dt = 0; dt < 4; ++dt) {
                const bf16x8 vf = cat8(tr4(Vl, 16 * (wid + 2 * ks5) + 4 * fq, 16 * dt, RS, lane), tr4(Vl, 16 * (wid + 2 * ks5 + 1) + 4 * fq, 16 * dt, RS, lane));
                O[dt] = __builtin_amdgcn_mfma_f32_16x16x32_bf16(vf, pf, O[dt], 0, 0, 0);
            }
        }
        const float inv = __builtin_amdgcn_rcpf(l);
        const size_t tq = (size_t)b * SEQ + sq;
#pragma unroll
        for (int dt = 0; dt < 4; ++dt) {
            u32x2 w; w.x = pack2(O[dt][0] * inv, O[dt][1] * inv); w.y = pack2(O[dt][2] * inv, O[dt][3] * inv);
            *(u32x2*)(OP + ((size_t)g * T + tq) * D + h * 64 + 16 * dt + 4 * fq) = w;
        }
        if (fq == 0) LSE[((size_t)g * T + tq) * 16 + h] = mx + __logf(l);
        __syncthreads();
    }
#undef ATT_DECODE
#undef ATT_LOAD
}
__device__ __forceinline__ void attn_merge_phase(const Params& p) {
    const int tid = tid_();
    const bf16_t* OP = (const bf16_t*)(p.ws + WS_SCR);
    const float* LSE = (const float*)(p.ws + WS_SCR + 96 * MB);
    unsigned char* yin = p.ws + WS_YIN;
    const size_t n = (size_t)T * D / 8, stride = (size_t)gridDim.x * NTHREADS;
    for (size_t i0 = (size_t)blockIdx.x * NTHREADS + tid; i0 < n; i0 += 4 * stride) {
        u32x4 a[4], bq[4], c[4]; float l0[4], l1[4], l2[4];
#pragma unroll
        for (int q = 0; q < 4; ++q) { const size_t i = i0 + q * stride; if (i < n) { const size_t t = i >> 7; const int c8 = (int)(i & 127), h = c8 >> 3;
            l0[q] = LSE[t * 16 + h]; l1[q] = LSE[((size_t)T + t) * 16 + h]; l2[q] = LSE[((size_t)2 * T + t) * 16 + h];
            a[q] = __builtin_nontemporal_load((const u32x4*)(OP + t * D + c8 * 8)); bq[q] = __builtin_nontemporal_load((const u32x4*)(OP + ((size_t)T + t) * D + c8 * 8)); c[q] = __builtin_nontemporal_load((const u32x4*)(OP + ((size_t)2 * T + t) * D + c8 * 8)); } }
#pragma unroll
        for (int q = 0; q < 4; ++q) { const size_t i = i0 + q * stride; if (i < n) { const size_t t = i >> 7; const int c8 = (int)(i & 127);
            const float m = fmaxf(l0[q], fmaxf(l1[q], l2[q]));
            float w0 = __expf(l0[q] - m), w1 = __expf(l1[q] - m), w2 = __expf(l2[q] - m);
            const float inv = __builtin_amdgcn_rcpf(w0 + w1 + w2); w0 *= inv; w1 *= inv; w2 *= inv;
            u32x2 o;
#define MRGL(f) (w0 * __uint_as_float(a[q].f << 16) + w1 * __uint_as_float(bq[q].f << 16) + w2 * __uint_as_float(c[q].f << 16))
#define MRGH(f) (w0 * __uint_as_float(a[q].f & 0xffff0000u) + w1 * __uint_as_float(bq[q].f & 0xffff0000u) + w2 * __uint_as_float(c[q].f & 0xffff0000u))
            o.x = pk_yq4(MRGL(x), MRGH(x), MRGL(y), MRGH(y)); o.y = pk_yq4(MRGL(z), MRGH(z), MRGL(w), MRGH(w));
#undef MRGL
#undef MRGH
            *(u32x2*)(yin + t * D + c8 * 8) = o; } }
    }
}

__device__ __forceinline__ void ln1_router_phase(LAS unsigned char* lds, const Params& p, int layer) {
    const int tid = tid_(), lane = tid & 63, wid = tid >> 6, fr = lane & 15, fq = lane >> 4;
    constexpr int XS = 2064;
    LAS unsigned char* xh = lds;
    LAS unsigned char* xl = lds + 16 * XS;
    LAS float* part = (LAS float*)(lds + 32 * XS);
    LAS float* logit = part + 8 * 16 * 32;
    LAS int* tkE = (LAS int*)(logit + 16 * 32);
    LAS int* tkR = tkE + 512;
    LAS int* hist = tkR + 512;
    LAS int* hbase = hist + 32;
    bf16_t* xres = (bf16_t*)(p.ws + WS_XF);
    const bf16_t* ymix = (const bf16_t*)(p.ws + WS_YMIX);
    int* tope = (int*)(p.ws + WS_TOPE); float* gates = (float*)(p.ws + WS_GATES); int* pos = (int*)(p.ws + WS_POS);
    unsigned char* xq = p.ws + WS_XQ; int* elist = (int*)(p.ws + WS_LIST);
    unsigned* ctl = (unsigned*)(p.ws + WS_CTL);
    const float* gain = p.ln_gain + (size_t)(layer * 2) * D; const float* bias = p.ln_bias + (size_t)(layer * 2) * D;
    const float* brt = p.moe_b_router + (size_t)layer * NEXP;
    const bf16_t* rth = (const bf16_t*)(p.ws + WS_RT) + (size_t)layer * 2 * NEXP * D; const bf16_t* rtl = rth + NEXP * D;
    bf16x8 Wh[2][4], Wl[2][4];
#pragma unroll
    for (int nt = 0; nt < 2; ++nt)
#pragma unroll
        for (int ks = 0; ks < 4; ++ks) { const size_t o = (size_t)(16 * nt + fr) * D + 128 * wid + 32 * ks + 8 * fq; Wh[nt][ks] = *(const bf16x8*)(rth + o); Wl[nt][ks] = *(const bf16x8*)(rtl + o); }
    if (tid < NEXP) hist[tid] = 0;
    int it = 0;
    f32x4 xr4[2][4]; u32x2 xr2[2][4], ymr[2][4];
#define LN1_LOAD(tile_) do { _Pragma("unroll") for (int tt = 0; tt < 2; ++tt) { const size_t t = (size_t)(tile_) * 16 + 2 * wid + tt; \
        _Pragma("unroll") for (int i = 0; i < 4; ++i) { const int c = 256 * i + 4 * lane; ymr[tt][i] = __builtin_nontemporal_load((const u32x2*)(ymix + t * D + c)); \
            if (layer == 0) xr4[tt][i] = *(const f32x4*)(p.x + t * D + c); else xr2[tt][i] = *(const u32x2*)(xres + t * D + c); } } } while (0)
    if ((int)blockIdx.x < T / 16) LN1_LOAD((int)blockIdx.x);
    const float my_brt = brt[lane & 31];
    for (int tile = blockIdx.x; tile < T / 16; tile += gridDim.x) {
#pragma unroll
        for (int tt = 0; tt < 2; ++tt) {
            const int trow = 2 * wid + tt; const size_t t = (size_t)tile * 16 + trow;
            f32x4 z[4];
#pragma unroll
            for (int i = 0; i < 4; ++i) { const u32x2 yv = ymr[tt][i];
                f32x4 xv_;
                if (layer == 0) xv_ = xr4[tt][i];
                else { const u32x2 xw = xr2[tt][i]; xv_ = (f32x4){__uint_as_float(xw.x << 16), __uint_as_float(xw.x & 0xffff0000u), __uint_as_float(xw.y << 16), __uint_as_float(xw.y & 0xffff0000u)}; }
                z[i] = DN_ALPHA * xv_ + (f32x4){__uint_as_float(yv.x << 16), __uint_as_float(yv.x & 0xffff0000u), __uint_as_float(yv.y << 16), __uint_as_float(yv.y & 0xffff0000u)}; }
            float sm = 0.f;
#pragma unroll
            for (int i = 0; i < 4; ++i) sm += (z[i][0] + z[i][1]) + (z[i][2] + z[i][3]);
            const float mean = wave_sum(sm) * (1.0f / D);
            float sq = 0.f;
#pragma unroll
            for (int i = 0; i < 4; ++i) { const f32x4 dd = z[i] - mean; sq += (dd[0] * dd[0] + dd[1] * dd[1]) + (dd[2] * dd[2] + dd[3] * dd[3]); }
            const float rstd = rsqrtf(wave_sum(sq) * (1.0f / D) + LN_EPS);
#pragma unroll
            for (int i = 0; i < 4; ++i) {
                const int c = 256 * i + 4 * lane;
                const f32x4 v = (z[i] - mean) * rstd * *(const f32x4*)(gain + c) + *(const f32x4*)(bias + c);
                u32x2 wh; wh.x = pack2(v[0], v[1]); wh.y = pack2(v[2], v[3]);
                *(u32x2*)(xres + t * D + c) = wh;
                *(unsigned*)(xq + t * D + c) = pk_fp8x4(v[0], v[1], v[2], v[3]);
                const float r0 = v[0] - __uint_as_float(wh.x << 16), r1 = v[1] - __uint_as_float(wh.x & 0xffff0000u), r2 = v[2] - __uint_as_float(wh.y << 16), r3 = v[3] - __uint_as_float(wh.y & 0xffff0000u);
                u32x2 wl; wl.x = pack2(r0, r1); wl.y = pack2(r2, r3);
                *(LAS u32x2*)(xh + trow * XS + c * 2) = wh; *(LAS u32x2*)(xl + trow * XS + c * 2) = wl;
            }
        }
        if (tile + (int)gridDim.x < T / 16) LN1_LOAD(tile + (int)gridDim.x);
        __syncthreads();
        {
            f32x4 acc[2] = {(f32x4){0.f, 0.f, 0.f, 0.f}, (f32x4){0.f, 0.f, 0.f, 0.f}};
#pragma unroll
            for (int ks = 0; ks < 4; ++ks) {
                const bf16x8 ah = *(const LAS bf16x8*)(xh + fr * XS + (128 * wid + 32 * ks + 8 * fq) * 2), al = *(const LAS bf16x8*)(xl + fr * XS + (128 * wid + 32 * ks + 8 * fq) * 2);
#pragma unroll
                for (int nt = 0; nt < 2; ++nt) {
                    acc[nt] = __builtin_amdgcn_mfma_f32_16x16x32_bf16(Wh[nt][ks], ah, acc[nt], 0, 0, 0);
                    acc[nt] = __builtin_amdgcn_mfma_f32_16x16x32_bf16(Wh[nt][ks], al, acc[nt], 0, 0, 0);
                    acc[nt] = __builtin_amdgcn_mfma_f32_16x16x32_bf16(Wl[nt][ks], ah, acc[nt], 0, 0, 0);
                }
            }
#pragma unroll
            for (int nt = 0; nt < 2; ++nt) *(LAS f32x4*)(part + (wid * 16 + fr) * 32 + 16 * nt + 4 * fq) = acc[nt];
        }
        __syncthreads();
        {
            const int e = lane & 31;
            float vv[2]; unsigned key[2];
#pragma unroll
            for (int tt = 0; tt < 2; ++tt) {
                float v = my_brt;
#pragma unroll
                for (int w = 0; w < 8; ++w) v += part[(w * 16 + 2 * wid + tt) * 32 + e];
                vv[tt] = v;
                const unsigned ub = __float_as_uint(v);
                key[tt] = ((ub ^ (unsigned)(((int)ub >> 31) | 0x80000000)) & ~31u) | (unsigned)(31 - e);
            }
            float tv[2][4]; int te[2][4];
#pragma unroll
            for (int k = 0; k < 4; ++k) {
                const unsigned m[2] = {half_umax(key[0]), half_umax(key[1])};
#pragma unroll
                for (int tt = 0; tt < 2; ++tt) { const int idx = 31 - (int)(m[tt] & 31u); te[tt][k] = idx; tv[tt][k] = __shfl(vv[tt], idx); if (e == idx) key[tt] = 0u; }
            }
            if (lane == 0) {
#pragma unroll
                for (int tt = 0; tt < 2; ++tt) {
                    const int trow = 2 * wid + tt; const size_t t = (size_t)tile * 16 + trow;
                    const float e1 = __expf(tv[tt][1] - tv[tt][0]), e2 = __expf(tv[tt][2] - tv[tt][0]), e3 = __expf(tv[tt][3] - tv[tt][0]), inv = 1.0f / (1.0f + e1 + e2 + e3);
                    *(i32x4v*)(tope + t * 4) = (i32x4v){te[tt][0], te[tt][1], te[tt][2], te[tt][3]};
                    *(f32x4*)(gates + t * 4) = (f32x4){inv, e1 * inv, e2 * inv, e3 * inv};
                    const int sl = (it & 7) * 16 + trow;
#pragma unroll
                    for (int k = 0; k < 4; ++k) { tkE[sl * 4 + k] = te[tt][k]; tkR[sl * 4 + k] = (int)atomicAdd((unsigned*)(hist + te[tt][k]), 1u); }
                }
            }
        }
        ++it;
        if ((it & 7) == 0 || tile + (int)gridDim.x >= T / 16) {
            __syncthreads();
            if (tid < NEXP) { const unsigned h = (unsigned)hist[tid]; hbase[tid] = h ? (int)atomicAdd(ctl + CW_CNT + layer * 64 + tid, h) : 0; hist[tid] = 0; }
            __syncthreads();
            const int nsl = (((it - 1) & 7) + 1) * 16;
            for (int a = tid; a < nsl * 4; a += NTHREADS) {
                const int sl = a >> 2, e = tkE[a], ps = hbase[e] + tkR[a];
                const int t = (tile - (((it - 1) & 7) - (sl >> 4)) * (int)gridDim.x) * 16 + (sl & 15);
                pos[t * 4 + (a & 3)] = ps; elist[(size_t)e * T + ps] = t;
            }
            __syncthreads();
        }
    }
    __syncthreads();
#undef LN1_LOAD
}
__device__ __forceinline__ void ln2_phase(LAS unsigned char* lds, const Params& p, int layer) {
    const int tid = tid_(), lane = tid & 63, wid = tid >> 6;
    moe_tables(lds, (const unsigned*)(p.ws + WS_CTL), layer);
    LAS const int* tab = (LAS const int*)(lds + TAB_OFF);
    const int* tope = (const int*)(p.ws + WS_TOPE); const int* pos = (const int*)(p.ws + WS_POS);
    bf16_t* xh = (bf16_t*)(p.ws + WS_XF);
    const unsigned char* yrows = p.ws + WS_YROWS;
    const float* gates = (const float*)(p.ws + WS_GATES);
    const float* gain = p.ln_gain + (size_t)(layer * 2 + 1) * D; const float* bias = p.ln_bias + (size_t)(layer * 2 + 1) * D;
    const int stride = (int)gridDim.x * 8;
    i32x4v ten[2], psn[2]; f32x4 gtn[2];
#define LN2_REC(t0_) do { _Pragma("unroll") for (int q = 0; q < 2; ++q) { const int t = ((t0_) + q * stride < T) ? (t0_) + q * stride : (t0_); \
        ten[q] = *(const i32x4v*)(tope + t * 4); psn[q] = *(const i32x4v*)(pos + t * 4); gtn[q] = *(const f32x4*)(gates + t * 4); } } while (0)
    if ((int)blockIdx.x * 8 + wid < T) LN2_REC((int)blockIdx.x * 8 + wid);
    for (int t0 = blockIdx.x * 8 + wid; t0 < T; t0 += 2 * stride) {
        int dk[2][4]; float gk[2][4];
#pragma unroll
        for (int q = 0; q < 2; ++q)
#pragma unroll
            for (int k = 0; k < 4; ++k) { dk[q][k] = tab[ten[q][k]] * 256 + psn[q][k]; gk[q][k] = gtn[q][k]; }
        if (t0 + 2 * stride < T) LN2_REC(t0 + 2 * stride);
        unsigned yv[2][4][4]; u32x2 xv[2][4];
#pragma unroll
        for (int q = 0; q < 2; ++q) { const int t = (t0 + q * stride < T) ? t0 + q * stride : t0;
#pragma unroll
            for (int i = 0; i < 4; ++i) { const int c = 256 * i + 4 * lane; xv[q][i] = *(const u32x2*)(xh + (size_t)t * D + c);
#pragma unroll
                for (int k = 0; k < 4; ++k) yv[q][i][k] = __builtin_nontemporal_load((const unsigned*)(yrows + (size_t)dk[q][k] * D + c)); } }
#pragma unroll
        for (int q = 0; q < 2; ++q) { const int t = t0 + q * stride; if (t < T) {
            f32x4 z[4];
#pragma unroll
            for (int i = 0; i < 4; ++i) {
                f32x4 f = (f32x4){0.f, 0.f, 0.f, 0.f};
#pragma unroll
                for (int k = 0; k < 4; ++k) { const int y4 = (int)yv[q][i][k]; const float gg = gk[q][k];
                    const f32x2 lo = __builtin_amdgcn_cvt_pk_f32_fp8(y4, false), hi = __builtin_amdgcn_cvt_pk_f32_fp8(y4, true);
                    f[0] += gg * lo.x; f[1] += gg * lo.y; f[2] += gg * hi.x; f[3] += gg * hi.y; }
                const u32x2 xw = xv[q][i];
                z[i] = DN_ALPHA * (f32x4){__uint_as_float(xw.x << 16), __uint_as_float(xw.x & 0xffff0000u), __uint_as_float(xw.y << 16), __uint_as_float(xw.y & 0xffff0000u)} + f;
            }
            float sm = 0.f;
#pragma unroll
            for (int i = 0; i < 4; ++i) sm += (z[i][0] + z[i][1]) + (z[i][2] + z[i][3]);
            const float mean = wave_sum(sm) * (1.0f / D);
            float sq = 0.f;
#pragma unroll
            for (int i = 0; i < 4; ++i) { const f32x4 dd = z[i] - mean; sq += (dd[0] * dd[0] + dd[1] * dd[1]) + (dd[2] * dd[2] + dd[3] * dd[3]); }
            const float rstd = rsqrtf(wave_sum(sq) * (1.0f / D) + LN_EPS);
#pragma unroll
            for (int i = 0; i < 4; ++i) {
                const int c = 256 * i + 4 * lane;
                z[i] = (z[i] - mean) * rstd * *(const f32x4*)(gain + c) + *(const f32x4*)(bias + c);
                if (layer == DEPTH - 1) __builtin_nontemporal_store(z[i], (f32x4*)(p.out + (size_t)t * D + c));
                else { u32x2 w; w.x = pack2(z[i][0], z[i][1]); w.y = pack2(z[i][2], z[i][3]); *(u32x2*)(xh + (size_t)t * D + c) = w; *(unsigned*)(p.ws + WS_XQ + (size_t)t * D + c) = pk_fp8x4(z[i][0], z[i][1], z[i][2], z[i][3]); }
            }
        } }
    }
#undef LN2_REC
}

constexpr int PH_PER_LAYER = 9;
constexpr int NPHASES = 1 + DEPTH * PH_PER_LAYER;
constexpr int LDS_BYTES = 150 * 1024;


#ifndef PHMASK
#define PHMASK 0x3FF
#endif
#define PHK(j) ((PHMASK >> (j)) & 1)
#ifndef PROBE_MASK
#define PROBE_MASK 0
#endif
#ifndef PROBE_LAYERS
#define PROBE_LAYERS 0xF
#endif
#define REPS(j) ((((PROBE_MASK) >> (j)) & 1) ? 2 : 1)
#define REPSL(j) (((((PROBE_MASK) >> (j)) & 1) && (((PROBE_LAYERS) >> layer) & 1)) ? 2 : 1)
#define IN(k) (lo <= (k) && (k) < hi)
#if MK_ONE_LAUNCH
#define SEAM(k) do { if (IN(k) && IN((k) + 1)) xcd_barrier_nv(bar.bar, bar.x, bar.st); } while (0)
#else
#define SEAM(k) do {} while (0)
#endif
template <int layer>
__device__ __forceinline__ void run_layer(const Params& p, LAS unsigned char* lds, const XcdBarrier& bar) {
    const int lo = p.ph_lo, hi = p.ph_hi;
    unsigned char* ws = p.ws;
    unsigned* ctl = (unsigned*)(ws + WS_CTL);
        constexpr int base = 1 + layer * PH_PER_LAYER, kind = layer % 3, idx = layer / 3;
        for (int rep_ = 0; rep_ < REPSL(1); ++rep_) if (PHK(1) && IN(base + 0)) {
            constexpr int N = (kind == 0) ? 2048 : (kind == 1 ? 6144 : 9216);
            const unsigned char* Bt = (kind == 0) ? ws + WS_AWIN + (size_t)idx * 2048 * D : (kind == 1 ? ws + WS_BWIN : ws + WS_CWIN);
            g8::SchedPlain S; S.init(ws + WS_XQ, Bt, T, N, D / 2, (int)gridDim.x, (int)blockIdx.x);
            if (kind != 0) { g8::EpiQKV E{(bf16_t*)(ws + WS_U), ws + WS_UKV, 1.0f / GU_WSCALE, kind == 2 ? 3072 : 2048, kind == 2 ? 6144 : 4096}; g8::gemm_phase<g8::EpiQKV, g8::SchedPlain, false, 1>(lds, D, S, E); }
            else { g8::EpiQKV E{(bf16_t*)(ws + WS_U), ws + WS_U, 1.0f / GU_WSCALE, 0, 2048}; g8::gemm_phase<g8::EpiQKV, g8::SchedPlain, false, 1>(lds, D, S, E); }
        }
        SEAM(base + 0);
        for (int rep_ = 0; rep_ < REPSL(2); ++rep_) if (PHK(2) && IN(base + 1)) {
            if (kind == 0) lru_gates_phase(lds, p, idx);
            else if (kind == 1) ret_core_phase(lds, p);
            else attn_core_phase(lds, p);
        }
        SEAM(base + 1);
        for (int rep_ = 0; rep_ < REPSL(3); ++rep_) if (PHK(3) && IN(base + 2)) {
            if (kind == 0) lru_scan_phase(p);
            else if (kind == 1) ret_norm_phase(lds, p);
            else attn_merge_phase(p);
        }
        SEAM(base + 2);
        for (int rep_ = 0; rep_ < REPSL(4); ++rep_) if (PHK(4) && IN(base + 3)) {
            constexpr int K = (kind == 1) ? 2048 : D;
            const unsigned char* Bt = (kind == 0) ? ws + WS_AWOUT + (size_t)idx * D * D : (kind == 1 ? ws + WS_BWOUT : ws + WS_CWOUT);
            g8::SchedPlain S; S.init(ws + WS_YIN, Bt, T, D, K / 2, (int)gridDim.x, (int)blockIdx.x);
            g8::EpiBf16 E{(bf16_t*)(ws + WS_YMIX), D, nullptr, 0, 1.0f / (OUT_WSCALE * YSCALE)};
            g8::gemm_phase<g8::EpiBf16, g8::SchedPlain, false, 1>(lds, K, S, E);
        }
        SEAM(base + 3);
        for (int rep_ = 0; rep_ < REPSL(5); ++rep_) if (PHK(5) && IN(base + 4)) {
            if (layer > 0) convert_rest(lds, p, layer);
            ln1_router_phase(lds, p, layer);
        }
        SEAM(base + 4);
        for (int rep_ = 0; rep_ < REPSL(7); ++rep_) if (PHK(7) && IN(base + 6)) {
            moe_tables(lds, ctl, layer);
            const int gu_nblk = __builtin_amdgcn_readfirstlane(((LAS const int*)(lds + TAB_OFF))[32]), gu_full = (int)gridDim.x >> 3;
            const int gu_rounds = (gu_nblk + gu_full - 1) / gu_full + (layer < DEPTH - 1 ? GU_EXTRA_ROUNDS : 0);
            int gu_rpr = (layer < DEPTH - 1 && GU_EXTRA_ROUNDS > 0) ? (((gu_nblk + gu_rounds - 1) / gu_rounds + 1) & ~1) : gu_full; if (gu_rpr > gu_full) gu_rpr = gu_full;
            g8::SchedGU S{(const char*)(ws + WS_XQ), (const char*)(ws + WS_GU) + (size_t)layer * NEXP * 2048 * D, (const int*)(ws + WS_LIST), (LAS const int*)(lds + TAB_OFF), (int)gridDim.x, (int)blockIdx.x, gu_rpr};
            g8::EpiSwiglu E{ws + WS_HID, p.moe_b_gu + (size_t)layer * NEXP * 2048, 1.0f / GU_WSCALE};
            g8::gemm_phase<g8::EpiSwiglu, g8::SchedGU, true, 1>(lds, D, S, E);
            if (layer < DEPTH - 1) {
                const int nblk = gu_nblk, c = (int)blockIdx.x, off = (((c >> 3) >> 1) << 1) + ((c & 7) >> 2), nmax = (nblk + gu_rpr - 1) / gu_rpr;
                convert_tail(lds, p, layer + 1, (c >> 3) >= gu_rpr ? gu_rounds * CQ_DED_PER_ROUND : (((nmax - 1) * gu_rpr + off >= nblk) ? CQ_TAIL_GU : 0));
            }
        }
        SEAM(base + 6);
        for (int rep_ = 0; rep_ < REPSL(8); ++rep_) if (PHK(8) && IN(base + 7)) {
            moe_tables(lds, ctl, layer);
            const int dn_units = __builtin_amdgcn_readfirstlane(((LAS const int*)(lds + TAB_OFF))[32]) * 4, dn_rounds = (dn_units + (int)gridDim.x - 1) / (int)gridDim.x + (layer < DEPTH - 1 ? 1 : 0);
            const int dn_G = (layer < DEPTH - 1 && dn_rounds > 0) ? (dn_units + dn_rounds - 1) / dn_rounds : (int)gridDim.x;
            g8::SchedDown S{(const char*)(ws + WS_HID), (const char*)(ws + WS_DN) + (size_t)layer * NEXP * D * D, (LAS const int*)(lds + TAB_OFF), dn_G, (int)blockIdx.x};
            g8::EpiFp8 E{ws + WS_YROWS, D, p.moe_b_down + (size_t)layer * NEXP * D, D, 1.0f / DN_WSCALE};
            g8::gemm_phase<g8::EpiFp8, g8::SchedDown, false, 1>(lds, D, S, E);
            if (layer < DEPTH - 1) {
                const int c = (int)blockIdx.x;
                convert_tail(lds, p, layer + 1, c >= dn_G ? dn_rounds * CQ_DED_PER_ROUND : (((dn_rounds - 1) * dn_G + c >= dn_units) ? CQ_TAIL_DN : 0));
            }
        }
        SEAM(base + 7);
        for (int rep_ = 0; rep_ < REPSL(9); ++rep_) if (PHK(9) && IN(base + 8)) ln2_phase(lds, p, layer);
        SEAM(base + 8);
    }
#undef IN
#undef SEAM
__global__ void __launch_bounds__(NTHREADS, 2) fwd_kernel(Params p) {
    extern __shared__ __attribute__((aligned(16))) unsigned char lds_raw[];
    LAS unsigned char* lds = (LAS unsigned char*)lds_raw;
    const int lo = p.ph_lo, hi = p.ph_hi;
    unsigned char* ws = p.ws;
    unsigned* ctl = (unsigned*)(ws + WS_CTL);
#if MK_ONE_LAUNCH
    volatile LAS unsigned* bst = (volatile LAS unsigned*)(lds + LDS_BYTES - 16);
    if (threadIdx.x == 0) { bst[0] = 0u; bst[1] = 0u; bst[2] = 0u; bst[3] = 0u; }
    __syncthreads();
    XcdBarrier bar = xcd_barrier_post(ctl, bst);
#define GRID_BAR() xcd_barrier_nv(bar.bar, bar.x, bar.st)
#else
    XcdBarrier bar; bar.bar = ctl; bar.x = 0; bar.st = nullptr;
#define GRID_BAR() do {} while (0)
#endif
#define IN(k) (lo <= (k) && (k) < hi)
#define SEAM(k) do { if (IN(k) && IN((k) + 1)) GRID_BAR(); } while (0)

    for (int rep_ = 0; rep_ < REPS(0); ++rep_) if (PHK(0) && IN(0)) {
        LAS float* tile = (LAS float*)lds;
#pragma unroll 1
        for (int j = 0; j < 5; ++j) {
            const float* src = j == 0 ? p.moe_w_gu : (j == 1 ? p.moe_w_down : (j == 2 ? p.a_w_in : (j == 3 ? p.b_w_in : p.c_w_in)));
            const size_t dsto = j == 0 ? WS_GU : (j == 1 ? WS_DN : (j == 2 ? WS_AWIN : (j == 3 ? WS_BWIN : WS_CWIN)));
            const int N = j == 0 ? 2048 : (j == 1 ? D : (j == 2 ? 2048 : (j == 3 ? 6144 : 9216)));
            const int batch = j < 2 ? NEXP : (j == 2 ? 2 : 1);
            convert_big<true>(lds, src, ws + dsto, D, N, batch, j == 1 ? DN_WSCALE : GU_WSCALE);
        }
#pragma unroll 1
        for (int j = 0; j < 3; ++j) {
            const float* src = j == 0 ? p.a_w_out : (j == 1 ? p.b_w_out : p.c_w_out);
            const size_t dsto = j == 0 ? WS_AWOUT : (j == 1 ? WS_BWOUT : WS_CWOUT);
            convert_big<true>(lds, src, ws + dsto, j == 1 ? 2048 : D, D, j == 0 ? 2 : 1, OUT_WSCALE);
        }
        convert_job(tile, p.a_w_rgate, (bf16_t*)(ws + WS_AGT), 128, 128, 8);
        convert_job(tile, p.a_w_igate, (bf16_t*)(ws + WS_AGT) + (size_t)8 * 128 * 128, 128, 128, 8);
        convert_job(tile, p.a_w_rgate + (size_t)8 * 128 * 128, (bf16_t*)(ws + WS_AGT) + (size_t)16 * 128 * 128, 128, 128, 8);
        convert_job(tile, p.a_w_igate + (size_t)8 * 128 * 128, (bf16_t*)(ws + WS_AGT) + (size_t)24 * 128 * 128, 128, 128, 8);
        {
            bf16_t* rt = (bf16_t*)(ws + WS_RT);
            for (int i = blockIdx.x * NTHREADS + threadIdx.x; i < DEPTH * NEXP * D; i += gridDim.x * NTHREADS) {
                const int l = i / (NEXP * D), r_ = i % (NEXP * D), e = r_ / D, k = r_ % D;
                const float w = p.moe_w_router[((size_t)l * D + k) * NEXP + e];
                const bf16_t hi = f2bf(w); const bf16_t lo = f2bf(w - bf2f(hi));
                rt[((size_t)l * 2 + 0) * NEXP * D + (size_t)e * D + k] = hi; rt[((size_t)l * 2 + 1) * NEXP * D + (size_t)e * D + k] = lo;
            }
        }
        {
            const size_t stride = (size_t)gridDim.x * NTHREADS;
            for (size_t i = (size_t)blockIdx.x * NTHREADS + threadIdx.x; i < (size_t)T * D / 4; i += 4 * stride) {
                f32x4 v[4];
#pragma unroll
                for (int q = 0; q < 4; ++q) v[q] = *(const f32x4*)(p.x + (i + q * stride) * 4);
#pragma unroll
                for (int q = 0; q < 4; ++q) *(unsigned*)(ws + WS_XQ + (i + q * stride) * 4) = pk_fp8x4(v[q][0], v[q][1], v[q][2], v[q][3]);
            }
        }
    }
    SEAM(0);

    run_layer<0>(p, lds, bar); run_layer<1>(p, lds, bar); run_layer<2>(p, lds, bar); run_layer<3>(p, lds, bar);
#undef IN
#undef SEAM
}

extern "C" void kernel_launch(void* const* d_in, const int* in_sizes, int n_in, void* d_out, int out_size, void* d_ws, size_t ws_size, hipStream_t stream) {
    static int grid = 0;
    if (grid == 0) {
        if (n_in != 22 || out_size != T * D || ws_size < WS_END) { fprintf(stderr, "kernel_launch: unexpected shapes (n_in %d out %d ws %zu need %zu)\n", n_in, out_size, ws_size, (size_t)WS_END); grid = -1; return; }
        if (hipFuncSetAttribute((const void*)fwd_kernel, hipFuncAttributeMaxDynamicSharedMemorySize, LDS_BYTES) != hipSuccess) { fprintf(stderr, "kernel_launch: hipFuncSetAttribute failed\n"); grid = -1; return; }
        int dev = 0, cus = 0;
        if (hipGetDevice(&dev) != hipSuccess || hipDeviceGetAttribute(&cus, hipDeviceAttributeMultiprocessorCount, dev) != hipSuccess) { grid = -1; return; }
        grid = cus;
    }
    if (grid < 0) return;
    (void)hipMemsetAsync((char*)d_ws + WS_CTL, 0, CTL_BYTES, stream);
    Params p{};
    const float** pp = (const float**)&p;
    for (int i = 0; i < 22; ++i) pp[i] = (const float*)d_in[i];
    p.out = (float*)d_out; p.ws = (unsigned char*)d_ws;
#if MK_ONE_LAUNCH
    p.ph_lo = 0; p.ph_hi = NPHASES;
    hipLaunchKernelGGL(fwd_kernel, dim3(grid), dim3(NTHREADS), LDS_BYTES, stream, p);
#else
    for (int ph = 0; ph < NPHASES; ++ph) {
        p.ph_lo = ph; p.ph_hi = ph + 1;
        hipLaunchKernelGGL(fwd_kernel, dim3(grid), dim3(NTHREADS), LDS_BYTES, stream, p);
    }
#endif
}
```
